# Optimizing an MI355X kernel written in HIP

```python
import math
import jax
import jax.numpy as jnp
from jax import lax
import numpy as np

D_MODEL = 2048
BATCH = 4
SEQ = 4096
DEPTH = 2

HEAD_DIM = 128
FNET_GROUPS = 4
FNET_GROUP_DIM = 128
FNET_WIDTH = FNET_GROUPS * FNET_GROUP_DIM
DIL_PATTERNS = ((128, 1), (512, 4), (2048, 16))
DIL_GROUPS = len(DIL_PATTERNS)
DIL_HEADS = 4
DIL_RADII = tuple((w // 2) // d for w, d in DIL_PATTERNS)
DIL_BLOCK = max(DIL_RADII)
DIL_QKV_WIDTH = DIL_GROUPS * DIL_HEADS * HEAD_DIM
DIL_OUT_WIDTH = DIL_HEADS * HEAD_DIM
DIFF_HEADS = 4
DIFF_QK_WIDTH = DIFF_HEADS * 2 * HEAD_DIM
DIFF_V_DIM = 2 * HEAD_DIM
DIFF_V_WIDTH = DIFF_HEADS * DIFF_V_DIM
DIFF_Q_BLOCK = 128
N_BRANCHES = 3
COL_FNET = 0
COL_DIL = COL_FNET + FNET_WIDTH
COL_DIFF = COL_DIL + 3 * DIL_QKV_WIDTH
COL_GATE = COL_DIFF + 2 * DIFF_QK_WIDTH + DIFF_V_WIDTH
IN_WIDTH = COL_GATE + N_BRANCHES * D_MODEL
REL_BUCKETS = 32
REL_MAX_DISTANCE = 2048
REL_HEADS = DIL_GROUPS * DIL_HEADS + DIFF_HEADS
PEER_HEADS = 8
PEER_NKEYS = 128
PEER_EXPERTS = PEER_NKEYS * PEER_NKEYS
PEER_TOPK = 16
PEER_QDIM = 256
PEER_CHUNK = 64
RMS_EPS = 1e-6
NEG_INF = -1e30

kernel_name = "hybrid_fnet_dilated_diffattn_peer_encoder"


def rms_norm(x, g):
    xf = x.astype(jnp.float32)
    xf = xf * lax.rsqrt(jnp.mean(xf * xf, axis=-1, keepdims=True) + RMS_EPS)
    return (xf * g.astype(jnp.float32)).astype(x.dtype)


def rel_bucket(rel):
    half = REL_BUCKETS // 2
    max_exact = half // 2
    n = jnp.abs(rel)
    big = max_exact + (jnp.log(jnp.maximum(n, 1).astype(jnp.float32) / max_exact)
                       / math.log(REL_MAX_DISTANCE / max_exact) * (half - max_exact)).astype(jnp.int32)
    big = jnp.minimum(big, half - 1)
    return jnp.where(rel > 0, half, 0) + jnp.where(n < max_exact, n, big)


def fourier_mixer(a):
    b, s, _ = a.shape
    z = a.reshape(b, s, FNET_GROUPS, FNET_GROUP_DIM).astype(jnp.float32)
    y = jnp.fft.fft2(z, axes=(1, 3), norm='ortho').real
    return y.reshape(b, s, FNET_WIDTH).astype(a.dtype)


def dilated_group(q, k, v, dilation, radius, bias_tab):
    b, s, h, dh = q.shape
    sub_len = s // dilation
    n_blk = -(-sub_len // DIL_BLOCK)
    pad_len = n_blk * DIL_BLOCK

    def to_sub(t):
        t = t.reshape(b, sub_len, dilation, h, dh).transpose(0, 2, 1, 3, 4)
        return jnp.pad(t, ((0, 0), (0, 0), (0, pad_len - sub_len), (0, 0), (0, 0)))

    def neighbours(t):
        t = jnp.pad(to_sub(t), ((0, 0), (0, 0), (DIL_BLOCK, DIL_BLOCK), (0, 0), (0, 0)))
        t = t.reshape(b, dilation, n_blk + 2, DIL_BLOCK, h, dh)
        return jnp.concatenate([t[:, :, :-2], t[:, :, 1:-1], t[:, :, 2:]], axis=3)

    qs = to_sub(q).reshape(b, dilation, n_blk, DIL_BLOCK, h, dh)
    ks = neighbours(k)
    vs = neighbours(v)
    a_idx = jnp.arange(DIL_BLOCK, dtype=jnp.int32)
    c_idx = jnp.arange(3 * DIL_BLOCK, dtype=jnp.int32)
    offset = c_idx[None, :] - DIL_BLOCK - a_idx[:, None]
    key_m = (jnp.arange(n_blk, dtype=jnp.int32)[:, None] - 1) * DIL_BLOCK + c_idx[None, :]
    valid = (jnp.abs(offset) <= radius)[None] & ((key_m >= 0) & (key_m < sub_len))[:, None, :]
    bias = bias_tab[rel_bucket(offset * dilation)].astype(jnp.float32).transpose(2, 0, 1)
    logits = jnp.einsum('brnahe,brnche->brnhac', qs, ks,
                        preferred_element_type=jnp.float32) * (dh ** -0.5) + bias
    logits = jnp.where(valid[:, None], logits, NEG_INF)
    mx = jnp.max(logits, axis=-1, keepdims=True)
    p = jnp.exp(logits - mx)
    den = jnp.sum(p, axis=-1, keepdims=True)
    o = jnp.einsum('brnhac,brnche->brnahe', p / den, vs.astype(jnp.float32))
    lse = jnp.swapaxes((mx + jnp.log(den))[..., 0], 3, 4)

    def from_sub(t):
        t = t.reshape(b, dilation, pad_len, *t.shape[4:])[:, :, :sub_len]
        return jnp.swapaxes(t, 1, 2).reshape(b, s, *t.shape[3:])

    return from_sub(o), from_sub(lse)


def dilated_mixer(q, k, v, bias_tab):
    outs, lses = [], []
    for g, (window, dilation) in enumerate(DIL_PATTERNS):
        o, lse = dilated_group(q[:, :, g], k[:, :, g], v[:, :, g], dilation, DIL_RADII[g],
                               bias_tab[:, g * DIL_HEADS:(g + 1) * DIL_HEADS])
        outs.append(o)
        lses.append(lse)
    w = jax.nn.softmax(jnp.stack(lses, axis=2), axis=2)
    return jnp.sum(jnp.stack(outs, axis=2) * w[..., None], axis=2).astype(q.dtype)


def diff_attention(q, k, v, lam, subln_g, bias_tab, lambda_init):
    b, s, h = q.shape[:3]
    dh = q.shape[-1]
    n_qb = s // DIFF_Q_BLOCK
    lamf = lam.astype(jnp.float32)
    lam_full = (jnp.exp(jnp.sum(lamf[0] * lamf[1])) - jnp.exp(jnp.sum(lamf[2] * lamf[3]))
                + lambda_init)
    kpos = jnp.arange(s, dtype=jnp.int32)
    vf = v.astype(jnp.float32)
    q_blocks = jnp.swapaxes(q.reshape(b, n_qb, DIFF_Q_BLOCK, h, 2, dh), 0, 1)
    starts = jnp.arange(n_qb, dtype=jnp.int32) * DIFF_Q_BLOCK

    def block(args):
        q_blk, start = args
        qpos = start + jnp.arange(DIFF_Q_BLOCK, dtype=jnp.int32)
        bias = bias_tab[rel_bucket(kpos[None, :] - qpos[:, None])].astype(jnp.float32)
        logits = jnp.einsum('bqhmd,bkhmd->bhmqk', q_blk, k,
                            preferred_element_type=jnp.float32) * (dh ** -0.5)
        logits = logits + bias.transpose(2, 0, 1)[:, None]
        p = jax.nn.softmax(logits, axis=-1)
        attn = p[:, :, 0] - lam_full * p[:, :, 1]
        return jnp.einsum('bhqk,bkhe->bqhe', attn, vf)

    o = lax.map(block, (q_blocks, starts))
    o = jnp.swapaxes(o, 0, 1).reshape(b, s, h, DIFF_V_DIM)
    return (rms_norm(o, subln_g) * (1.0 - lambda_init)).astype(q.dtype)


def peer_ffn(h, wq, subkeys, u, v):
    b, s, d = h.shape
    q = (h @ wq).reshape(b, s, PEER_HEADS, 2, PEER_QDIM // 2)
    scores = jnp.einsum('bshpc,pkc->bshpk', q, subkeys, preferred_element_type=jnp.float32)
    top_s, top_i = lax.top_k(scores, PEER_TOPK)
    cand_s = top_s[..., 0, :, None] + top_s[..., 1, None, :]
    cand_id = top_i[..., 0, :, None] * PEER_NKEYS + top_i[..., 1, None, :]
    best_s, best_j = lax.top_k(cand_s.reshape(b, s, PEER_HEADS, PEER_TOPK * PEER_TOPK), PEER_TOPK)
    ids = jnp.take_along_axis(cand_id.reshape(b, s, PEER_HEADS, PEER_TOPK * PEER_TOPK), best_j, axis=-1)
    gates = jax.nn.softmax(best_s, axis=-1)
    n_chunks = (b * s) // PEER_CHUNK
    xs = (h.reshape(n_chunks, PEER_CHUNK, d),
          ids.reshape(n_chunks, PEER_CHUNK, PEER_HEADS * PEER_TOPK),
          gates.reshape(n_chunks, PEER_CHUNK, PEER_HEADS * PEER_TOPK))

    def chunk(args):
        xc, ic, gc = args
        pre = jnp.einsum('td,ted->te', xc, u[ic], preferred_element_type=jnp.float32)
        act = jax.nn.gelu(pre, approximate=False) * gc
        return jnp.einsum('te,ted->td', act, v[ic].astype(jnp.float32))

    out = lax.map(chunk, xs)
    return out.reshape(b, s, d).astype(h.dtype)


def setup_inputs(seed: int = 0) -> dict:
    key = jax.random.key(seed)
    ks = jax.random.split(key, 17)

    def nrm(k, shape, scale):
        return jax.random.normal(k, shape, jnp.float32) * scale

    return {
        'x': nrm(ks[0], (BATCH, SEQ, D_MODEL), 1.0),
        'rel_bias': nrm(ks[1], (REL_BUCKETS, REL_HEADS), 0.2),
        'final_norm_g': 1.0 + nrm(ks[2], (D_MODEL,), 0.02),
        'mix_norm_g': 1.0 + nrm(ks[3], (DEPTH, D_MODEL), 0.02),
        'w_in': nrm(ks[4], (DEPTH, D_MODEL, IN_WIDTH), D_MODEL ** -0.5),
        'b_gate': nrm(ks[5], (DEPTH, N_BRANCHES * D_MODEL), 0.02),
        'w_up_a': nrm(ks[6], (DEPTH, FNET_WIDTH, D_MODEL), FNET_WIDTH ** -0.5),
        'w_up_b': nrm(ks[7], (DEPTH, DIL_OUT_WIDTH, D_MODEL), DIL_OUT_WIDTH ** -0.5),
        'w_up_c': nrm(ks[8], (DEPTH, DIFF_V_WIDTH, D_MODEL), DIFF_V_WIDTH ** -0.5),
        'diff_lambda': nrm(ks[9], (DEPTH, 4, HEAD_DIM), 0.1),
        'diff_subln_g': 1.0 + nrm(ks[10], (DEPTH, DIFF_V_DIM), 0.02),
        'w_o': nrm(ks[11], (DEPTH, D_MODEL, D_MODEL), D_MODEL ** -0.5),
        'ffn_norm_g': 1.0 + nrm(ks[12], (DEPTH, D_MODEL), 0.02),
        'peer_wq': nrm(ks[13], (DEPTH, D_MODEL, PEER_HEADS * PEER_QDIM), D_MODEL ** -0.5),
        'peer_subkeys': nrm(ks[14], (DEPTH, 2, PEER_NKEYS, PEER_QDIM // 2), (PEER_QDIM // 2) ** -0.5),
        'peer_u': nrm(ks[15], (DEPTH, PEER_EXPERTS, D_MODEL), D_MODEL ** -0.5),
        'peer_v': nrm(ks[16], (DEPTH, PEER_EXPERTS, D_MODEL), PEER_TOPK ** -0.5),
    }


def reference(x, rel_bias, final_norm_g, mix_norm_g, w_in, b_gate, w_up_a, w_up_b, w_up_c,
              diff_lambda, diff_subln_g, w_o, ffn_norm_g, peer_wq, peer_subkeys, peer_u, peer_v):
    b, s, d = x.shape
    dil_bias = rel_bias[:, :DIL_GROUPS * DIL_HEADS]
    diff_bias = rel_bias[:, DIL_GROUPS * DIL_HEADS:]
    for layer in range(DEPTH):
        h = rms_norm(x, mix_norm_g[layer])
        proj = h @ w_in[layer]
        p_fnet = proj[..., COL_FNET:COL_DIL]
        p_dil = proj[..., COL_DIL:COL_DIFF].reshape(b, s, 3, DIL_GROUPS, DIL_HEADS, HEAD_DIM)
        p_diff = proj[..., COL_DIFF:COL_GATE]
        dq = p_diff[..., :DIFF_QK_WIDTH].reshape(b, s, DIFF_HEADS, 2, HEAD_DIM)
        dk = p_diff[..., DIFF_QK_WIDTH:2 * DIFF_QK_WIDTH].reshape(b, s, DIFF_HEADS, 2, HEAD_DIM)
        dv = p_diff[..., 2 * DIFF_QK_WIDTH:].reshape(b, s, DIFF_HEADS, DIFF_V_DIM)
        gates = jax.nn.sigmoid((proj[..., COL_GATE:] + b_gate[layer]).astype(jnp.float32))
        gates = gates.reshape(b, s, N_BRANCHES, d)

        y_a = fourier_mixer(p_fnet) @ w_up_a[layer]
        o_b = dilated_mixer(p_dil[:, :, 0], p_dil[:, :, 1], p_dil[:, :, 2], dil_bias)
        y_b = o_b.reshape(b, s, DIL_OUT_WIDTH) @ w_up_b[layer]
        lambda_init = 0.8 - 0.6 * math.exp(-0.3 * layer)
        o_c = diff_attention(dq, dk, dv, diff_lambda[layer], diff_subln_g[layer], diff_bias, lambda_init)
        y_c = o_c.reshape(b, s, DIFF_V_WIDTH) @ w_up_c[layer]

        merged = gates[:, :, 0] * y_a + gates[:, :, 1] * y_b + gates[:, :, 2] * y_c
        x = x + merged.astype(x.dtype) @ w_o[layer]
        h = rms_norm(x, ffn_norm_g[layer])
        x = x + peer_ffn(h, peer_wq[layer], peer_subkeys[layer], peer_u[layer], peer_v[layer])
    return rms_norm(x, final_norm_g)
```

```cpp
#include <hip/hip_runtime.h>
#include <cstdio>
#include <cstdint>

constexpr int DM = 2048, NB = 4, SEQ = 4096, MTOK = NB * SEQ;
constexpr int INW = 14336, PJW = 8192, GTW = 6144;
constexpr int COL_DIL = 512, COL_DIFF = 5120;
constexpr int NEXP = 16384;
constexpr float RMS_EPS = 1e-6f;

typedef unsigned short bf16;
#define GAS __attribute__((address_space(1)))
#define LAS __attribute__((address_space(3)))
typedef unsigned v4u __attribute__((ext_vector_type(4)));
typedef float f32x4 __attribute__((ext_vector_type(4)));
typedef GAS unsigned gu32;

__device__ __forceinline__ int opaque_tid(int wave_sgpr) { int l; asm volatile("v_mbcnt_lo_u32_b32 %0, -1, 0\n\tv_mbcnt_hi_u32_b32 %0, -1, %0" : "=v"(l)); return wave_sgpr * 64 + l; }
namespace pg8 {
#define PG8_LAS __attribute__((address_space(3)))
typedef unsigned short bf16_t;
typedef short bf16x8 __attribute__((ext_vector_type(8)));
typedef float f32x4 __attribute__((ext_vector_type(4)));
typedef unsigned u32x4 __attribute__((ext_vector_type(4)));
constexpr int BM = 256, BK = 64, HALF = 128, HTB = HALF * BK * 2, STAGE_BYTES = 8 * HTB, NXCD = 8, WGM = 8;

__host__ __device__ __forceinline__ int lds_byte(int r, int c) { const int st = (r >> 4) * 2 + (c >> 5), rr = r & 15, cc = c & 31, ob = rr * 64 + cc * 2; return st * 1024 + (ob ^ (((ob >> 9) & 1) << 5)); }
__host__ __device__ __forceinline__ void stage_rc(int b, int& R, int& C) { const int st = b / 1024, sb = b % 1024, swz = sb ^ (((sb >> 9) & 1) << 5); R = (st >> 1) * 16 + swz / 64; C = (st & 1) * 32 + (swz % 64) / 2; }
__host__ __device__ __forceinline__ int perm32(int rho) { const int n = rho >> 4, i = rho & 15; return 8 * (i >> 2) + 4 * n + (i & 3); }

struct Unit { int pm, pn; long aoff, boff; int orow, ocol; };
struct Gemm { const bf16_t* A; const bf16_t* Bt; };

struct StaticOrder {
    int nM, nN, nwg, G, c; long sa, sb;
    __device__ void init(int M, int N, int G_, int c_, int lda, int ldb) { nM = M / BM; nN = N / BM; nwg = nM * nN; G = G_; c = c_; sa = 512L * lda; sb = 512L * ldb; }
    __device__ bool next(int i, Unit& u) const {
        const long L = (long)i * G + c; if (L >= nwg) return false;
        int wgid = (int)L; { const int q = nwg / NXCD, r = nwg % NXCD, xcd = wgid % NXCD, off = wgid / NXCD; wgid = (xcd < r ? xcd * (q + 1) : r * (q + 1) + (xcd - r) * q) + off; }
        const int nig = WGM * nN, gid = wgid / nig, fm = gid * WGM, gsz = (nM - fm) < WGM ? (nM - fm) : WGM;
        u.pm = fm + ((wgid % nig) % gsz); u.pn = (wgid % nig) / gsz;
        u.aoff = u.pm * sa; u.boff = u.pn * sb; u.orow = u.pm * BM; u.ocol = u.pn * BM; return true;
    }
};
struct F2Order : StaticOrder {
    __device__ bool next(int i, Unit& u) const { if (!StaticOrder::next(i, u)) return false; u.orow = (u.pn >> 1) * 4096 + u.pm * BM; u.ocol = (u.pn & 1) * BM; return true; }
};
struct F1Order {
    int G, c;
    __device__ bool next(int i, Unit& u) const {
        const int idx = i * G + c; if (idx >= 256) return false;
        const int bg = idx >> 4, st = idx & 15, b = bg >> 2, g = bg & 3;
        u.pm = 0; u.pn = idx; u.aoff = 0; u.boff = ((long)(b * 4096 + st * 256) * PJW + g * 128) * 2; u.orow = bg * 128; u.ocol = st * 256; return true;
    }
};

__device__ __forceinline__ unsigned cvt_pk_bf16(float lo, float hi) { unsigned r; asm volatile("v_cvt_pk_bf16_f32 %0, %1, %2" : "=v"(r) : "v"(lo), "v"(hi)); return r; }
__device__ __forceinline__ float bf_lo(unsigned w) { return __uint_as_float(w << 16); }
__device__ __forceinline__ float bf_hi(unsigned w) { return __uint_as_float(w & 0xffff0000u); }

#define PG8_PACK(v0, v1, w) do { (w).x = cvt_pk_bf16((v0)[0], (v0)[1]); (w).y = cvt_pk_bf16((v0)[2], (v0)[3]); (w).z = cvt_pk_bf16((v1)[0], (v1)[1]); (w).w = cvt_pk_bf16((v1)[2], (v1)[3]); } while (0)

struct EpiStore {
    static constexpr bool PERM = true;
    bf16_t* O; int ldo;
    __device__ __forceinline__ void operator()(const f32x4 (&acc)[2][2][4][2], const Unit& u, int wr, int wc, int fr, int fq) const {
        const int row0 = u.orow + wr * 64 + fr, col0 = u.ocol + wc * 32 + 8 * fq;
#pragma unroll
        for (int ai = 0; ai < 2; ++ai)
#pragma unroll
            for (int m = 0; m < 4; ++m) { bf16_t* rowp = O + (size_t)(row0 + ai * HALF + m * 16) * ldo + col0;
#pragma unroll
                for (int bj = 0; bj < 2; ++bj) { u32x4 w; PG8_PACK(acc[ai][bj][m][0], acc[ai][bj][m][1], w); *(u32x4*)(rowp + bj * HALF) = w; } }
    }
};
struct EpiZT {
    static constexpr bool PERM = true;
    bf16_t* O;
    __device__ __forceinline__ void operator()(const f32x4 (&acc)[2][2][4][2], const Unit& u, int wr, int wc, int fr, int fq) const {
        const int row0 = u.orow + wr * 64 + fr, col0 = u.ocol + wc * 32 + 8 * fq;
#pragma unroll
        for (int ai = 0; ai < 2; ++ai)
#pragma unroll
            for (int m = 0; m < 4; ++m) { bf16_t* rowp = O + (size_t)(row0 + m * 16) * 8192 + ai * 4096 + col0;
#pragma unroll
                for (int bj = 0; bj < 2; ++bj) { u32x4 w; PG8_PACK(acc[ai][bj][m][0], acc[ai][bj][m][1], w); *(u32x4*)(rowp + bj * HALF) = w; } }
    }
};
struct EpiProj {
    static constexpr bool PERM = true;
    bf16_t* P; bf16_t* Gt; const float* bg;
    __device__ __forceinline__ void operator()(const f32x4 (&acc)[2][2][4][2], const Unit& u, int wr, int wc, int fr, int fq) const {
        const bool isg = u.pn >= 32;
        const int row0 = u.pm * BM + wr * 64 + fr, col0 = (isg ? u.pn - 32 : u.pn) * BM + wc * 32 + 8 * fq, ldc = isg ? GTW : PJW;
        bf16_t* base = isg ? Gt : P;
        f32x4 bv[2][2];
#pragma unroll
        for (int bj = 0; bj < 2; ++bj)
#pragma unroll
            for (int n = 0; n < 2; ++n) bv[bj][n] = isg ? *(const f32x4*)(bg + col0 + bj * HALF + 4 * n) : (f32x4){0.f, 0.f, 0.f, 0.f};
#pragma unroll
        for (int ai = 0; ai < 2; ++ai)
#pragma unroll
            for (int m = 0; m < 4; ++m) { bf16_t* rowp = base + (size_t)(row0 + ai * HALF + m * 16) * ldc + col0;
#pragma unroll
                for (int bj = 0; bj < 2; ++bj) { f32x4 v0 = acc[ai][bj][m][0] + bv[bj][0], v1 = acc[ai][bj][m][1] + bv[bj][1];
                    if (isg) {
#pragma unroll
                        for (int j = 0; j < 4; ++j) { v0[j] = __builtin_amdgcn_rcpf(1.0f + __builtin_amdgcn_exp2f(-1.4426950408889634f * v0[j])); v1[j] = __builtin_amdgcn_rcpf(1.0f + __builtin_amdgcn_exp2f(-1.4426950408889634f * v1[j])); } }
                    u32x4 w; PG8_PACK(v0, v1, w); *(u32x4*)(rowp + bj * HALF) = w; } }
    }
};
struct EpiMerge3 {
    static constexpr bool PERM = true;
    const bf16_t* Gt; bf16_t* O; int br;
    __device__ __forceinline__ void operator()(const f32x4 (&acc)[2][2][4][2], const Unit& u, int wr, int wc, int fr, int fq) const {
        const int row0 = u.pm * BM + wr * 64 + fr, col0 = u.pn * BM + wc * 32 + 8 * fq;
#pragma unroll
        for (int ai = 0; ai < 2; ++ai)
#pragma unroll
            for (int m = 0; m < 4; ++m) { const bf16_t* gp = Gt + (size_t)(row0 + ai * HALF + m * 16) * GTW + br * DM + col0; bf16_t* rowp = O + (size_t)(row0 + ai * HALF + m * 16) * DM + col0;
#pragma unroll
                for (int bj = 0; bj < 2; ++bj) { const u32x4 g = *(const u32x4*)(gp + bj * HALF);
                    f32x4 v0 = acc[ai][bj][m][0], v1 = acc[ai][bj][m][1];
                    v0[0] *= bf_lo(g.x); v0[1] *= bf_hi(g.x); v0[2] *= bf_lo(g.y); v0[3] *= bf_hi(g.y);
                    v1[0] *= bf_lo(g.z); v1[1] *= bf_hi(g.z); v1[2] *= bf_lo(g.w); v1[3] *= bf_hi(g.w);
                    if (br) { const u32x4 p = *(const u32x4*)(rowp + bj * HALF);
                        v0[0] += bf_lo(p.x); v0[1] += bf_hi(p.x); v0[2] += bf_lo(p.y); v0[3] += bf_hi(p.y);
                        v1[0] += bf_lo(p.z); v1[1] += bf_hi(p.z); v1[2] += bf_lo(p.w); v1[3] += bf_hi(p.w); }
                    u32x4 w; PG8_PACK(v0, v1, w); *(u32x4*)(rowp + bj * HALF) = w; }
                asm volatile("" ::: "memory"); }
    }
};
struct EpiResF32 {
    static constexpr bool PERM = false;
    const float* base; float* out; int ldc;
    __device__ __forceinline__ void operator()(const f32x4 (&acc)[2][2][4][2], const Unit& u, int wr, int wc, int fr, int fq) const {
        const int row0 = u.orow + wr * 64 + fr, col0 = u.ocol + wc * 32 + 4 * fq;
#pragma unroll
        for (int ai = 0; ai < 2; ++ai)
#pragma unroll
            for (int m = 0; m < 4; ++m) { const size_t off = (size_t)(row0 + ai * HALF + m * 16) * ldc + col0;
#pragma unroll
                for (int bj = 0; bj < 2; ++bj)
#pragma unroll
                    for (int n = 0; n < 2; ++n) { f32x4 v = acc[ai][bj][m][n]; if (base) v += *(const f32x4*)(base + off + bj * HALF + n * 16); *(f32x4*)(out + off + bj * HALF + n * 16) = v; }
                asm volatile("" ::: "memory"); }
    }
};

template <class Epi, class Sched, bool ALIGN_EPI, int LDA, int LDB, int KK>
__device__ __forceinline__ void gemm_phase(PG8_LAS unsigned char* lds, const Gemm g, const Sched& S, const Epi& E, int wave0) {
    const int tid = opaque_tid(wave0), wid = wave0, lane = tid & 63, wr = wid >> 2, wc = wid & 3, fr = lane & 15, fq = lane >> 4;
    constexpr int nt = KK / BK;
    unsigned voffA[2], voffB[2];
#pragma unroll
    for (int i = 0; i < 2; ++i) { int R, C; stage_rc(tid * 16 + i * 8192, R, C); const int Rb = Epi::PERM ? ((R & ~31) + perm32(R & 31)) : R;
        voffA[i] = (unsigned)(R * LDA + C) * 2u; voffB[i] = (unsigned)(Rb * LDB + C) * 2u; }
    const size_t kstep = (size_t)(BK * 2);
    constexpr size_t hstepA = (size_t)HALF * LDA * 2, hstepB = (size_t)HALF * LDB * 2;
    const unsigned ldsw = (unsigned)wid * 1024u;
    const int aoff = lds_byte(wr * 64 + fr, fq * 8), boff = lds_byte(wc * 32 + fr, fq * 8);
#define PG8_SA(b, h) (((b) * 2 + (h)) * HTB)
#define PG8_SB(b, h) ((4 + (b) * 2 + (h)) * HTB)
#define PG8_STAGE(bufoff, gbase, voff) do { _Pragma("unroll") for (int _i = 0; _i < 2; ++_i) \
        __builtin_amdgcn_global_load_lds((const unsigned*)((const char*)(gbase) + (voff)[_i]), (PG8_LAS unsigned*)(lds + (bufoff) + ldsw + _i * 8192), 16, 0, 0); } while (0)
#define PG8_LDA(dst, b, h) do { _Pragma("unroll") for (int m = 0; m < 4; ++m) _Pragma("unroll") for (int k = 0; k < 2; ++k) dst[m][k] = *(const PG8_LAS bf16x8*)(lds + PG8_SA(b, h) + aoff + m * 2048 + k * 1024); } while (0)
#define PG8_LDB(dst, b, h) do { _Pragma("unroll") for (int n = 0; n < 2; ++n) _Pragma("unroll") for (int k = 0; k < 2; ++k) dst[n][k] = *(const PG8_LAS bf16x8*)(lds + PG8_SB(b, h) + boff + n * 2048 + k * 1024); } while (0)
#define PG8_MMA(ai, bj, At, Bt) do { __builtin_amdgcn_s_setprio(1); _Pragma("unroll") for (int m = 0; m < 4; ++m) _Pragma("unroll") for (int n = 0; n < 2; ++n) _Pragma("unroll") for (int k = 0; k < 2; ++k) \
        acc[ai][bj][m][n] = __builtin_amdgcn_mfma_f32_16x16x32_bf16(Bt[n][k], At[m][k], acc[ai][bj][m][n], 0, 0, 0); __builtin_amdgcn_s_setprio(0); } while (0)
#define PG8_WAIT_V(n) asm volatile("s_waitcnt vmcnt(" #n ")" ::: "memory")
#define PG8_WAIT_L(n) asm volatile("s_waitcnt lgkmcnt(" #n ")" ::: "memory")
#define PG8_BAR __builtin_amdgcn_s_barrier()
#define PG8_SCHED __builtin_amdgcn_sched_barrier(0)
    Unit cur, nxt; int ui = 0;
    if (!S.next(0, cur)) return;
    f32x4 acc[2][2][4][2];
#pragma unroll
    for (int a = 0; a < 2; ++a)
#pragma unroll
        for (int b = 0; b < 2; ++b)
#pragma unroll
            for (int m = 0; m < 4; ++m)
#pragma unroll
                for (int n = 0; n < 2; ++n) acc[a][b][m][n] = (f32x4){0.f, 0.f, 0.f, 0.f};
    bf16x8 At[4][2], B0[2][2], B1[2][2];
    const char* cA = (const char*)g.A + cur.aoff; const char* cB = (const char*)g.Bt + cur.boff;
    PG8_STAGE(PG8_SB(0, 0), cB, voffB); PG8_STAGE(PG8_SB(0, 1), cB + hstepB, voffB); PG8_STAGE(PG8_SA(0, 0), cA, voffA); PG8_STAGE(PG8_SA(0, 1), cA + hstepA, voffA);
    if (wr == 1) PG8_BAR;
    PG8_WAIT_V(2); PG8_BAR;
    PG8_STAGE(PG8_SB(1, 0), cB + kstep, voffB); PG8_STAGE(PG8_SA(1, 0), cA + kstep, voffA); PG8_STAGE(PG8_SB(1, 1), cB + hstepB + kstep, voffB);
    PG8_WAIT_V(6); PG8_BAR;
    for (;;) {
        const bool has_next = S.next(ui + 1, nxt);
        const char* nA = has_next ? (const char*)g.A + nxt.aoff : cA; const char* nB = has_next ? (const char*)g.Bt + nxt.boff : cB;
        for (int t = 0; t < nt; t += 2) {
            const bool last = (t == nt - 2);
            const char* a1 = cA + (size_t)(t + 1) * kstep;
            const char* a2 = last ? nA : cA + (size_t)(t + 2) * kstep; const char* b2 = last ? nB : cB + (size_t)(t + 2) * kstep;
            const char* a3 = a2 + kstep; const char* b3 = b2 + kstep;
            PG8_LDB(B0, 0, 0); PG8_LDB(B1, 0, 1); PG8_SCHED; PG8_LDA(At, 0, 0); PG8_STAGE(PG8_SA(1, 1), a1 + hstepA, voffA);
            PG8_WAIT_V(8); PG8_WAIT_L(0); PG8_BAR; PG8_MMA(0, 0, At, B0); PG8_MMA(0, 1, At, B1); PG8_BAR; PG8_SCHED;
            PG8_LDA(At, 0, 1); PG8_STAGE(PG8_SB(0, 0), b2, voffB); PG8_STAGE(PG8_SB(0, 1), b2 + hstepB, voffB); PG8_STAGE(PG8_SA(0, 0), a2, voffA);
            PG8_WAIT_V(8); PG8_WAIT_L(0); PG8_BAR; PG8_MMA(1, 0, At, B0); PG8_MMA(1, 1, At, B1); PG8_BAR; PG8_SCHED;
            PG8_LDB(B0, 1, 0); PG8_LDB(B1, 1, 1); PG8_SCHED; PG8_LDA(At, 1, 0); PG8_STAGE(PG8_SA(0, 1), a2 + hstepA, voffA);
            PG8_WAIT_V(8); PG8_WAIT_L(0); PG8_BAR; PG8_MMA(0, 0, At, B0); PG8_MMA(0, 1, At, B1); PG8_BAR; PG8_SCHED;
            PG8_LDA(At, 1, 1); PG8_STAGE(PG8_SB(1, 0), b3, voffB); PG8_STAGE(PG8_SB(1, 1), b3 + hstepB, voffB); PG8_STAGE(PG8_SA(1, 0), a3, voffA);
            PG8_WAIT_V(8); PG8_WAIT_L(0); PG8_BAR; PG8_MMA(1, 0, At, B0); PG8_MMA(1, 1, At, B1); PG8_BAR; PG8_SCHED;
        }
        if constexpr (ALIGN_EPI) { if (wr == 0) PG8_BAR; }
        E(acc, cur, wr, wc, fr, fq);
        if (!has_next) break;
#pragma unroll
        for (int a = 0; a < 2; ++a)
#pragma unroll
            for (int b = 0; b < 2; ++b)
#pragma unroll
                for (int m = 0; m < 4; ++m)
#pragma unroll
                    for (int n = 0; n < 2; ++n) acc[a][b][m][n] = (f32x4){0.f, 0.f, 0.f, 0.f};
        cur = nxt; cA = nA; cB = nB; ++ui;
        if constexpr (ALIGN_EPI) { if (wr == 1) PG8_BAR; }
    }
    PG8_WAIT_V(0);
    if constexpr (!ALIGN_EPI) { if (wr == 0) PG8_BAR; }
    PG8_BAR;
#undef PG8_SA
#undef PG8_SB
#undef PG8_STAGE
#undef PG8_LDA
#undef PG8_LDB
#undef PG8_MMA
#undef PG8_WAIT_V
#undef PG8_WAIT_L
#undef PG8_BAR
#undef PG8_SCHED
}
}

namespace attn {
using bf16x8 = __attribute__((ext_vector_type(8))) short;
using s16x4  = __attribute__((ext_vector_type(4))) short;
using f32x16 = __attribute__((ext_vector_type(16))) float;
using u32x4  = __attribute__((ext_vector_type(4))) unsigned;
constexpr int   D = 128, NW = 8, QBLK = 32, KVBLK = 64;
constexpr float SCALE = 0.088388347648318440f;
constexpr float THR = 8.f;
constexpr size_t SHM_V = KVBLK * D * 2, SHM_K = KVBLK * D * 2;
constexpr int LDS_WS = 2 * SHM_V + 2 * SHM_K, LDS_TAB = LDS_WS + NW * 64 * 4, LDS_END = LDS_TAB + 8192 * 4;
#define KSWZ(row, colB) ((row) * 256 + ((colB) ^ (((row) & 7) << 4)))
#define SBAR() __builtin_amdgcn_sched_barrier(0)
__device__ __forceinline__ int crow(int r, int hi) { return (r & 3) + 8 * (r >> 2) + 4 * hi; }
__device__ __forceinline__ unsigned cvtpk(float lo, float hi) { unsigned r; asm volatile("v_cvt_pk_bf16_f32 %0, %1, %2" : "=v"(r) : "v"(lo), "v"(hi)); return r; }

__device__ __forceinline__ void partialSM(f32x16& p0, f32x16& p1, float& m_reg, float& mn, float& alpha) {
  constexpr float C = SCALE * 1.4426950408889634f;
  float pmax = p0[0]; for (int r = 1; r < 16; ++r) pmax = fmaxf(pmax, p0[r]); for (int r = 0; r < 16; ++r) pmax = fmaxf(pmax, p1[r]);
  { auto rr = __builtin_amdgcn_permlane32_swap(__float_as_uint(pmax), __float_as_uint(pmax), false, false);
    pmax = fmaxf(__uint_as_float(rr[0]), __uint_as_float(rr[1])); }
  if (__builtin_expect(__all(pmax - m_reg <= THR / SCALE), 1)) { mn = m_reg; alpha = 1.f; }
  else { mn = fmaxf(m_reg, pmax); alpha = __builtin_amdgcn_exp2f((m_reg - mn) * C); m_reg = mn; }
  float mnC = -mn * C;
  for (int r = 0; r < 16; ++r) p0[r] = fmaf(p0[r], C, mnC); for (int r = 0; r < 16; ++r) p1[r] = fmaf(p1[r], C, mnC);
  for (int r = 0; r < 16; ++r) p0[r] = __builtin_amdgcn_exp2f(p0[r]);
}
__device__ __forceinline__ void finishSM(f32x16& p0, f32x16& p1, float alpha, float& l_reg, bf16x8& pa0, bf16x8& pa1, bf16x8& pa2, bf16x8& pa3) {
  for (int r = 0; r < 16; ++r) p1[r] = __builtin_amdgcn_exp2f(p1[r]);
  float ps = 0; for (int r = 0; r < 16; ++r) ps += p0[r]; for (int r = 0; r < 16; ++r) ps += p1[r];
  { auto rr = __builtin_amdgcn_permlane32_swap(__float_as_uint(ps), __float_as_uint(ps), false, false);
    ps = __uint_as_float(rr[0]) + __uint_as_float(rr[1]); }
  l_reg = l_reg * alpha + ps;
#define PK4(P, BASE, OUT) do { unsigned a0 = cvtpk(P[BASE + 0], P[BASE + 1]), a1 = cvtpk(P[BASE + 2], P[BASE + 3]);   \
    unsigned b0 = cvtpk(P[BASE + 4], P[BASE + 5]), b1 = cvtpk(P[BASE + 6], P[BASE + 7]);                              \
    auto r0 = __builtin_amdgcn_permlane32_swap(a0, b0, false, false); auto r1 = __builtin_amdgcn_permlane32_swap(a1, b1, false, false); \
    u32x4 w = {r0[0], r1[0], r0[1], r1[1]}; OUT = *reinterpret_cast<bf16x8*>(&w); } while (0)
  PK4(p0, 0, pa0); PK4(p0, 8, pa1); PK4(p1, 0, pa2); PK4(p1, 8, pa3);
#undef PK4
}
__device__ __forceinline__ void qkt(f32x16& p0, f32x16& p1, const bf16* Ks, const bf16x8* qr, int r32, int hi, const float* tl) {
#pragma unroll
  for (int r = 0; r < 16; ++r) { p0[r] = tl[(r & 3) + 8 * (r >> 2)]; p1[r] = tl[32 + (r & 3) + 8 * (r >> 2)]; }
#pragma unroll
  for (int d0 = 0; d0 < 8; ++d0) { int cb = (d0 * 16 + hi * 8) * 2;
    bf16x8 b0 = *reinterpret_cast<const bf16x8*>((const char*)Ks + KSWZ(r32, cb));
    bf16x8 b1 = *reinterpret_cast<const bf16x8*>((const char*)Ks + KSWZ(32 + r32, cb));
    p0 = __builtin_amdgcn_mfma_f32_32x32x16_bf16(b0, qr[d0], p0, 0, 0, 0);
    p1 = __builtin_amdgcn_mfma_f32_32x32x16_bf16(b1, qr[d0], p1, 0, 0, 0); }
}
__device__ __forceinline__ int v_st(int k, int c) { const int kk = (k & ~0xC) | ((k & 4) << 1) | ((k & 8) >> 1); return ((kk >> 3) * 4 + (c >> 5)) * 512 + ((kk & 7) * 32 + (c & 31)) * 2; }
__device__ __forceinline__ int v_rd_base(int lane) { return ((lane & 3) << 3) | (((lane >> 2) & 3) << 6) | (((lane >> 4) & 1) << 5) | (((lane >> 5) & 1) << 8); }
constexpr int v_rd_off(int d0, int ks, int half) { return d0 * 512 + ks * 4096 + half * 2048; }
template <int OFF> __device__ __forceinline__ s16x4 tr_read(int vb) {
  s16x4 r; asm volatile("ds_read_b64_tr_b16 %0, %1 offset:%2" : "=&v"(r) : "v"(vb), "i"(OFF) : "memory"); return r;
}
template <int D0> __device__ __forceinline__ void pv_one(f32x16& od, int vb, bf16x8 pa0, bf16x8 pa1, bf16x8 pa2, bf16x8 pa3) {
  const s16x4 l0 = tr_read<v_rd_off(D0, 0, 0)>(vb), h0 = tr_read<v_rd_off(D0, 0, 1)>(vb), l1 = tr_read<v_rd_off(D0, 1, 0)>(vb), h1 = tr_read<v_rd_off(D0, 1, 1)>(vb);
  const s16x4 l2 = tr_read<v_rd_off(D0, 2, 0)>(vb), h2 = tr_read<v_rd_off(D0, 2, 1)>(vb), l3 = tr_read<v_rd_off(D0, 3, 0)>(vb), h3 = tr_read<v_rd_off(D0, 3, 1)>(vb);
  asm volatile("s_waitcnt lgkmcnt(0)" ::: "memory"); SBAR();
#define PK(L, H) (bf16x8){L[0], L[1], L[2], L[3], H[0], H[1], H[2], H[3]}
  od = __builtin_amdgcn_mfma_f32_32x32x16_bf16(pa0, PK(l0, h0), od, 0, 0, 0);
  od = __builtin_amdgcn_mfma_f32_32x32x16_bf16(pa1, PK(l1, h1), od, 0, 0, 0);
  od = __builtin_amdgcn_mfma_f32_32x32x16_bf16(pa2, PK(l2, h2), od, 0, 0, 0);
  od = __builtin_amdgcn_mfma_f32_32x32x16_bf16(pa3, PK(l3, h3), od, 0, 0, 0);
#undef PK
}
__device__ __forceinline__ void pv_d0(f32x16* o, int vb, bf16x8 pa0, bf16x8 pa1, bf16x8 pa2, bf16x8 pa3) {
  pv_one<0>(o[0], vb, pa0, pa1, pa2, pa3); pv_one<1>(o[1], vb, pa0, pa1, pa2, pa3); pv_one<2>(o[2], vb, pa0, pa1, pa2, pa3); pv_one<3>(o[3], vb, pa0, pa1, pa2, pa3);
}

struct Unit { const bf16* Q; const bf16* K; const bf16* V; bf16* O; float* lse; long ldq, ldk, ldo; int lse_ld, kt0, nt, qoff; };
__device__ __forceinline__ void attn_unit(const Unit& u, char* lds, int wave0) {
  const int tid = opaque_tid(wave0), wid = wave0, lane = tid & 63, r32 = lane & 31, hi = lane >> 5;
  bf16* V_lds = (bf16*)lds; bf16* K_lds = (bf16*)(lds + 2 * SHM_V);
  float* ws = (float*)(lds + LDS_WS) + wid * 64; float* li_l = ws; float* al_l = ws + 32;
  const float* tabL = (const float*)(lds + LDS_TAB);
  float m_reg = -1e30f, l_reg = 0; f32x16 o[4] = {}; bf16x8 qr[8];
  const bf16* Qw = u.Q + (long)(wid * QBLK + r32) * u.ldq + hi * 8;
#pragma unroll
  for (int d0 = 0; d0 < 8; ++d0) qr[d0] = *reinterpret_cast<const bf16x8*>(Qw + d0 * 16);
  const int sr = tid >> 4, sc = (tid & 15) * 8, vst0 = v_st(sr, sc), vst1 = v_st(32 + sr, sc);
  const int vb0 = (int)(uintptr_t)V_lds + v_rd_base(lane);
  const long tstep = (long)KVBLK * u.ldk * 2;
  const char* Kh = (const char*)u.K + (long)u.kt0 * tstep; const char* Vh = (const char*)u.V + (long)u.kt0 * tstep;
  const unsigned lo0 = (unsigned)((sr * (int)u.ldk + sc) * 2), lo1 = lo0 + (unsigned)(32 * (int)u.ldk * 2);
  const float* tl0 = tabL + (4096 + u.kt0 * KVBLK + 4 * hi - (u.qoff + wid * QBLK + r32));
  struct { bf16x8 vs0, vs1, ks0, ks1; } sr_[2];
#define SLOAD(i, tj) do { const char* vt_ = Vh + (long)(tj) * tstep; const char* kt_ = Kh + (long)(tj) * tstep; \
    sr_[i].vs0 = *reinterpret_cast<const bf16x8*>(vt_ + lo0); sr_[i].vs1 = *reinterpret_cast<const bf16x8*>(vt_ + lo1); \
    sr_[i].ks0 = *reinterpret_cast<const bf16x8*>(kt_ + lo0); sr_[i].ks1 = *reinterpret_cast<const bf16x8*>(kt_ + lo1); } while (0)
#define SWRITE(b, i) do { *(bf16x8*)((char*)V_lds + (b) * SHM_V + vst0) = sr_[i].vs0;          \
    *(bf16x8*)((char*)V_lds + (b) * SHM_V + vst1) = sr_[i].vs1; int kc = sc * 2;               \
    *(bf16x8*)((char*)K_lds + (b) * SHM_K + KSWZ(sr, kc)) = sr_[i].ks0;                       \
    *(bf16x8*)((char*)K_lds + (b) * SHM_K + KSWZ(32 + sr, kc)) = sr_[i].ks1; } while (0)
#define SWAIT() asm volatile("s_waitcnt vmcnt(4)" ::: "memory")
#define RESC(a) do { if (__any((a) < 1.f)) { if (hi == 0) al_l[r32] = (a); asm volatile("s_waitcnt lgkmcnt(0)" ::: "memory"); \
    for (int d = 0; d < 4; ++d) for (int r = 0; r < 16; ++r) o[d][r] *= al_l[crow(r, hi)]; } } while (0)
  f32x16 pA0, pA1, pB0, pB1; float mnA, mnB, alA, alB; bf16x8 pa0, pa1, pa2, pa3; const int NT = u.nt;
  constexpr int SE = 0, SO = 1;
  SLOAD(SE, 0); asm volatile("s_waitcnt vmcnt(0)" ::: "memory"); SWRITE(0, SE); __syncthreads();
  qkt(pA0, pA1, K_lds, qr, r32, hi, tl0); partialSM(pA0, pA1, m_reg, mnA, alA);
  SLOAD(SO, 1); if (2 < NT) SLOAD(SE, 2);
  SWAIT(); SWRITE(1, SO); __syncthreads();
  for (int j = 1; j + 1 < NT; j += 2) {
    SBAR(); qkt(pB0, pB1, (bf16*)((char*)K_lds + SHM_K), qr, r32, hi, tl0 + j * KVBLK);
    finishSM(pA0, pA1, alA, l_reg, pa0, pa1, pa2, pa3); SBAR();
    SLOAD(SO, j + 2); SBAR();
    pv_d0(o, vb0, pa0, pa1, pa2, pa3); partialSM(pB0, pB1, m_reg, mnB, alB);
    __syncthreads(); SWAIT(); SWRITE(0, SE);
    RESC(alB); __syncthreads();
    SBAR(); qkt(pA0, pA1, K_lds, qr, r32, hi, tl0 + (j + 1) * KVBLK);
    finishSM(pB0, pB1, alB, l_reg, pa0, pa1, pa2, pa3); SBAR();
    if (j + 3 < NT) SLOAD(SE, j + 3); SBAR();
    pv_d0(o, vb0 + (int)SHM_V, pa0, pa1, pa2, pa3); partialSM(pA0, pA1, m_reg, mnA, alA);
    __syncthreads(); SWAIT(); SWRITE(1, SO);
    RESC(alA); __syncthreads();
  }
  SBAR(); qkt(pB0, pB1, (bf16*)((char*)K_lds + SHM_K), qr, r32, hi, tl0 + (NT - 1) * KVBLK);
  finishSM(pA0, pA1, alA, l_reg, pa0, pa1, pa2, pa3); SBAR();
  pv_d0(o, vb0, pa0, pa1, pa2, pa3); partialSM(pB0, pB1, m_reg, mnB, alB);
  __syncthreads(); RESC(alB);
  finishSM(pB0, pB1, alB, l_reg, pa0, pa1, pa2, pa3); SBAR();
  pv_d0(o, vb0 + (int)SHM_V, pa0, pa1, pa2, pa3);
  if (hi == 0) li_l[r32] = l_reg; asm volatile("s_waitcnt lgkmcnt(0)" ::: "memory");
  float rli[16];
#pragma unroll
  for (int r = 0; r < 16; ++r) rli[r] = __builtin_amdgcn_rcpf(li_l[crow(r, hi)]);
  bf16* Ow = u.O + (long)(wid * QBLK) * u.ldo;
#pragma unroll
  for (int r = 0; r < 16; ++r) { int orow = crow(r, hi);
#pragma unroll
    for (int d0 = 0; d0 < 4; ++d0) { const float v = o[d0][r] * rli[r]; Ow[(long)orow * u.ldo + d0 * 32 + r32] = (bf16)(cvtpk(v, v) & 0xffffu); } }
  if (u.lse != nullptr && hi == 0) u.lse[(long)(wid * QBLK + r32) * u.lse_ld] = m_reg * SCALE + __logf(l_reg);
#undef SLOAD
#undef SWRITE
#undef SWAIT
#undef RESC
}
#undef KSWZ
#undef SBAR
}

constexpr int NWAVES = 8;
constexpr size_t MiB = 1u << 20;
constexpr size_t WS_CTL = 0, CTL_ZERO_BYTES = 1 * MiB;
constexpr size_t WS_CS   = 1 * MiB;
constexpr size_t WS_SKBD = 1 * MiB + 256 * 1024;
constexpr size_t WS_TAB  = 2 * MiB;
constexpr size_t WS_LSE  = 3 * MiB;
constexpr size_t WS_WCAT = 4 * MiB, WS_WO = 12 * MiB, WS_WQ = 20 * MiB;
constexpr size_t WS_WIN  = 28 * MiB;
constexpr size_t WS_DFT  = 84 * MiB;
constexpr size_t WS_U    = 148 * MiB, WS_V = 212 * MiB;
constexpr size_t WS_H    = 276 * MiB;
constexpr size_t WS_PROJ = 340 * MiB;
constexpr size_t WS_G    = 596 * MiB;
constexpr size_t WS_ZT   = 788 * MiB;
constexpr size_t WS_OC   = 820 * MiB;
constexpr size_t WS_MG   = 884 * MiB;
constexpr size_t WS_END  = 948 * MiB;
constexpr size_t WS_Q = WS_PROJ, WS_SC = WS_PROJ + 64 * MiB, WS_IDS = WS_PROJ + 192 * MiB, WS_GATES = WS_PROJ + 200 * MiB;
constexpr int CW_BAR = 4096;
constexpr int CW_QUEUE = 16384;
constexpr int RING_BYTES = 131072, LDSCTL_OFF = RING_BYTES, MISC_OFF = LDSCTL_OFF + 320, LDS_BYTES = 147456;

#define LDS_WAIT() asm volatile("s_waitcnt lgkmcnt(0)" ::: "memory")
#define VM_WAIT() asm volatile("s_waitcnt vmcnt(0)" ::: "memory")
__device__ __forceinline__ unsigned f2bf(float f) { unsigned u = __builtin_bit_cast(unsigned, f); return (u + 0x7fffu + ((u >> 16) & 1u)) >> 16; }
__device__ __forceinline__ unsigned pk2(float lo, float hi) { return f2bf(lo) | (f2bf(hi) << 16); }
__device__ __forceinline__ float bflo(unsigned w) { return __uint_as_float(w << 16); }
__device__ __forceinline__ float bfhi(unsigned w) { return __uint_as_float(w & 0xffff0000u); }

#define XB_TMO      128
#define XB_XCNT(j)  (256  + 64 * (j))
#define XB_XSUB(j)  (1280 + 64 * (j))
#define XB_XGEN(j)  (2304 + 64 * (j))
#define XB_TOP      3328
#define XB_TOPGEN   3392
#define XCD_BAR_WORDS 3456
#define XB_SPIN_CAP (1u << 20)
__device__ __forceinline__ unsigned xb_ld(unsigned* p)              { return __hip_atomic_load(p, __ATOMIC_RELAXED, __HIP_MEMORY_SCOPE_AGENT); }
__device__ __forceinline__ unsigned xb_add(unsigned* p, unsigned v) { return __hip_atomic_fetch_add(p, v, __ATOMIC_RELAXED, __HIP_MEMORY_SCOPE_AGENT); }
__device__ __forceinline__ unsigned xb_xcc_id() { return (unsigned)__builtin_amdgcn_s_getreg((3 << 11) | 20) & 0xFu; }
#define XB_SPIN(cond, bar) do { unsigned _sp = 0; while (cond) { __builtin_amdgcn_s_sleep(1); \
    if ((++_sp & 255u) == 0u) { if (xb_ld(&(bar)[XB_TMO])) break; if (_sp > XB_SPIN_CAP) { atomicAdd(&(bar)[XB_TMO], 1u); break; } } } } while (0)
struct XcdBarrier { unsigned* bar; unsigned x; volatile LAS unsigned* st; };
__device__ __forceinline__ XcdBarrier xcd_barrier_post(unsigned* bar, volatile LAS unsigned* st) {
    XcdBarrier b; b.bar = bar; b.x = xb_xcc_id(); b.st = st;
    if (threadIdx.x == 0) (void)xb_add(&bar[XB_XCNT(b.x)], 1u);
    return b;
}
__device__ __forceinline__ void xcd_barrier_complete(unsigned* bar, unsigned x, unsigned& nloc, unsigned& nx) {
    const unsigned G = gridDim.x * gridDim.y * gridDim.z;
    unsigned sum, cnt, mine, sp = 0u;
    for (;;) {
        sum = 0u; cnt = 0u; mine = 0u;
#pragma unroll
        for (unsigned j = 0; j < 16; ++j) { const unsigned c = xb_ld(&bar[XB_XCNT(j)]); sum += c; cnt += (c > 0u) ? 1u : 0u; mine = (j == x) ? c : mine; }
        if (sum == G) break;
        __builtin_amdgcn_s_sleep(1);
        if ((++sp & 255u) == 0u) { if (xb_ld(&bar[XB_TMO])) break; if (sp > XB_SPIN_CAP) { atomicAdd(&bar[XB_TMO], 1u); break; } }
    }
    nloc = mine > 0u ? mine : 1u; nx = cnt > 0u ? cnt : 1u;
}
__device__ __forceinline__ void xcd_barrier(const XcdBarrier& b) {
    asm volatile("s_waitcnt vmcnt(0)" ::: "memory");
    __syncthreads();
    if (threadIdx.x == 0) {
        unsigned* bar = b.bar;
        __builtin_amdgcn_s_waitcnt(0);
        unsigned nloc = b.st[0], nx = b.st[1];
        if (nloc == 0u) { xcd_barrier_complete(bar, b.x, nloc, nx); b.st[0] = nloc; b.st[1] = nx; }
        const unsigned old = xb_add(&bar[XB_XSUB(b.x)], 1u);
        const unsigned gen = old / nloc;
        if (old + 1u == (gen + 1u) * nloc) {
            __builtin_amdgcn_fence(__ATOMIC_RELEASE, "agent");
            asm volatile("s_waitcnt vmcnt(0)" ::: "memory");
            const unsigned og = xb_add(&bar[XB_TOP], 1u);
            const unsigned tg = og / nx;
            if (og + 1u == (tg + 1u) * nx) xb_add(&bar[XB_TOPGEN], 1u);
            else XB_SPIN(xb_ld(&bar[XB_TOPGEN]) == tg, bar);
            __builtin_amdgcn_fence(__ATOMIC_ACQUIRE, "agent");
            xb_add(&bar[XB_XGEN(b.x)], 1u);
            asm volatile("s_waitcnt vmcnt(0)" ::: "memory");
        } else {
            XB_SPIN(xb_ld(&bar[XB_XGEN(b.x)]) == gen, bar);
            __builtin_amdgcn_fence(__ATOMIC_ACQUIRE, "agent");
            asm volatile("s_waitcnt vmcnt(0)" ::: "memory");
        }
    }
    __syncthreads();
}

template <int MASK> __device__ __forceinline__ int sx_i(int v) { return __builtin_amdgcn_ds_swizzle(v, 0x1f | (MASK << 10)); }
template <int MASK> __device__ __forceinline__ float sx_f(float v) { return __int_as_float(sx_i<MASK>(__float_as_int(v))); }
__device__ __forceinline__ float add32(float v) { auto rr = __builtin_amdgcn_permlane32_swap(__float_as_uint(v), __float_as_uint(v), false, false); return __uint_as_float(rr[0]) + __uint_as_float(rr[1]); }
__device__ __forceinline__ unsigned max32(unsigned v) { auto rr = __builtin_amdgcn_permlane32_swap(v, v, false, false); return rr[0] > rr[1] ? rr[0] : rr[1]; }
__device__ __forceinline__ float other32(float v, bool upper) { auto rr = __builtin_amdgcn_permlane32_swap(__float_as_uint(v), __float_as_uint(v), false, false); return __uint_as_float(upper ? rr[0] : rr[1]); }
__device__ __forceinline__ float bperm_f(float v, int src_lane) { return __int_as_float(__builtin_amdgcn_ds_bpermute(src_lane * 4, __float_as_int(v))); }
__device__ __forceinline__ int bperm_i(int v, int src_lane) { return __builtin_amdgcn_ds_bpermute(src_lane * 4, v); }
__device__ __forceinline__ float wave_sum(float v) {
    v += sx_f<1>(v); v += sx_f<2>(v); v += sx_f<4>(v); v += sx_f<8>(v); v += sx_f<16>(v); return add32(v);
}
__device__ __forceinline__ unsigned umax(unsigned a, unsigned b) { return a > b ? a : b; }
__device__ __forceinline__ unsigned wave_max_u32(unsigned v) {
    v = umax(v, (unsigned)sx_i<1>((int)v)); v = umax(v, (unsigned)sx_i<2>((int)v)); v = umax(v, (unsigned)sx_i<4>((int)v)); v = umax(v, (unsigned)sx_i<8>((int)v)); v = umax(v, (unsigned)sx_i<16>((int)v)); return max32(v);
}
__device__ __forceinline__ unsigned okey(float f) { const unsigned u = __float_as_uint(f); return (u & 0x80000000u) ? ~u : (u | 0x80000000u); }

__device__ __forceinline__ void transpose_item(const float* W, int N, bf16* WT, int ldo, int col_off, LAS float* scr, int item, int lane) {
    const int nblk = N / 32, kb = item / nblk, nb = item % nblk, k0 = 64 * kb, n0 = 32 * nb;
#pragma unroll 8
    for (int i = 0; i < 32; ++i) { const int kk = 2 * i + (lane >> 5); scr[kk * 33 + (lane & 31)] = W[(size_t)(k0 + kk) * N + n0 + (lane & 31)]; }
    LDS_WAIT(); asm volatile("" ::: "memory");
    const int c = lane & 7;
#pragma unroll
    for (int j = 0; j < 4; ++j) { const int n = (lane >> 3) + 8 * j; const LAS float* s = scr + (8 * c) * 33 + n;
        v4u o; o.x = pk2(s[0 * 33], s[1 * 33]); o.y = pk2(s[2 * 33], s[3 * 33]); o.z = pk2(s[4 * 33], s[5 * 33]); o.w = pk2(s[6 * 33], s[7 * 33]);
        *(GAS v4u*)(WT + (size_t)(n0 + n) * ldo + col_off + k0 + 8 * c) = o; }
    LDS_WAIT(); asm volatile("" ::: "memory");
}
__device__ __forceinline__ void rms_row_to_bf16(const float* xrow, const float* g, bf16* orow, int lane) {
    const GAS f32x4* xr = (const GAS f32x4*)xrow + lane; const GAS f32x4* gr = (const GAS f32x4*)g + lane;
    f32x4 v[8]; float s = 0.f;
#pragma unroll
    for (int j = 0; j < 8; ++j) { v[j] = xr[64 * j]; s += (v[j].x * v[j].x + v[j].y * v[j].y) + (v[j].z * v[j].z + v[j].w * v[j].w); }
    const float rstd = 1.0f / sqrtf(wave_sum(s) * (1.f / DM) + RMS_EPS);
    GAS unsigned long long* o8 = (GAS unsigned long long*)orow + lane;
#pragma unroll
    for (int j = 0; j < 8; ++j) { const f32x4 gg = gr[64 * j]; o8[64 * j] = (unsigned long long)pk2(v[j].x * rstd * gg.x, v[j].y * rstd * gg.y) | ((unsigned long long)pk2(v[j].z * rstd * gg.z, v[j].w * rstd * gg.w) << 32); }
}
typedef __bf16 bf2_t __attribute__((ext_vector_type(2)));
__device__ __forceinline__ float DOT2(unsigned a, unsigned b, float c) { return __builtin_amdgcn_fdot2_f32_bf16(__builtin_bit_cast(bf2_t, a), __builtin_bit_cast(bf2_t, b), c, false); }
__device__ __forceinline__ int rel_bucket(int rel) {
    const int n = rel < 0 ? -rel : rel;
    int b = n;
    if (n >= 8) { b = 5 + (31 - __builtin_clz((unsigned)n)); if (b > 15) b = 15; }
    return b + (rel > 0 ? 16 : 0);
}

#ifndef PH_D1
#define PH_D1 1
#endif
#ifndef PH_D2
#define PH_D2 1
#endif
#ifndef PH_A
#define PH_A 1
#endif
#ifndef PH_B
#define PH_B 1
#endif
#ifndef PH_C
#define PH_C 1
#endif
#ifndef PH_D
#define PH_D 1
#endif
#ifndef PH_E
#define PH_E 1
#endif
#ifndef PH_F
#define PH_F 1
#endif
#ifndef PH_G
#define PH_G 1
#endif
#ifndef PH_H
#define PH_H 1
#endif
#ifndef PH_I
#define PH_I 1
#endif
#ifndef PH_J
#define PH_J 1
#endif
#ifndef PH_K
#define PH_K 1
#endif
#ifndef PH_L
#define PH_L 1
#endif
struct Args { const float* in[17]; float* out; unsigned char* ws; };

#define CAS __attribute__((address_space(4)))
__device__ __forceinline__ const void* karg(int k) { const CAS char* ka = (const CAS char*)__builtin_amdgcn_kernarg_segment_ptr(); asm volatile("" : "+s"(ka)); return *(const void* const CAS*)(ka + 8 * k); }
#define WSP(T, off) ((T*)((unsigned char*)karg(18) + (off)))
#define INP(k) ((const float*)karg(k))
#define INL(k, stride) (INP(k) + (size_t)layer * (size_t)(stride))
#define X ((float*)karg(17))
__global__ void __launch_bounds__(NWAVES * 64, 2) mk_fwd(Args args_unused) {
    extern __shared__ __attribute__((aligned(16))) unsigned char lds[];
    LAS unsigned char* ldsl = (LAS unsigned char*)lds;
    volatile LAS unsigned* MISC = (volatile LAS unsigned*)(ldsl + MISC_OFF);
    const int wave0 = __builtin_amdgcn_readfirstlane((int)threadIdx.x >> 6);
    const int G = gridDim.x; const int bx = blockIdx.x; const int vcu = (G % 8 == 0) ? (bx % 8) * (G / 8) + bx / 8 : bx;
    const int NGW = G * NWAVES, NGT = NGW * 64;
#define PH_IDS() const int tid = opaque_tid(wave0), lane = tid & 63, wave = wave0, gw = vcu * NWAVES + wave, gt = gw * 64 + lane; (void)gt; (void)gw; (void)lane
    gu32* ctl = (gu32*)WSP(unsigned char, WS_CTL);
    for (int u = threadIdx.x; u < (LDS_BYTES - LDSCTL_OFF) / 4; u += NWAVES * 64) ((LAS unsigned*)(ldsl + LDSCTL_OFF))[u] = 0u;
    __syncthreads();
    XcdBarrier bar = xcd_barrier_post((unsigned*)(ctl + CW_BAR), MISC + 8);
#define GRID_BAR() xcd_barrier(bar)

    for (int layer = 0; layer < 2; ++layer) {

#if PH_A
        {
            PH_IDS();
            LAS float* scr = (LAS float*)(ldsl + wave * 16384);
            const float* w_in = INL(4, (size_t)DM * INW); const float* w_up_a = INL(6, 512 * DM); const float* w_up_b = INL(7, 512 * DM); const float* w_up_c = INL(8, 1024 * DM);
            const float* w_o = INL(11, DM * DM); const float* wq = INL(13, DM * DM); const float* subk = INL(14, 2 * 128 * 128);
            const float* pu = INL(15, (size_t)NEXP * DM); const float* pv = INL(16, (size_t)NEXP * DM); const float* mix_g = INL(3, DM); const float* rel_bias = INP(1);
            bf16* WIN = WSP(bf16, WS_WIN); bf16* WCAT = WSP(bf16, WS_WCAT); bf16* WO = WSP(bf16, WS_WO); bf16* WQ = WSP(bf16, WS_WQ); bf16* UB = WSP(bf16, WS_U); bf16* VB = WSP(bf16, WS_V);
            bf16* SKBD = WSP(bf16, WS_SKBD); bf16* H = WSP(bf16, WS_H); bf16* DFT = WSP(bf16, WS_DFT); bf16* CS = WSP(bf16, WS_CS); float* TAB = WSP(float, WS_TAB);
            constexpr int I_IN = (DM / 64) * (INW / 32), I_A = (512 / 64) * (DM / 32), I_C = (1024 / 64) * (DM / 32), I_SQ = (DM / 64) * (DM / 32);
            constexpr int NITEMS = I_IN + 2 * I_A + I_C + 2 * I_SQ;
            for (int it = gw; it < NITEMS; it += NGW) {
                int r = it;
                if (r < I_IN) { transpose_item(w_in, INW, WIN, DM, 0, scr, r, lane); continue; } r -= I_IN;
                if (r < I_A) { transpose_item(w_up_a, DM, WCAT, DM, 0, scr, r, lane); continue; } r -= I_A;
                if (r < I_A) { transpose_item(w_up_b, DM, WCAT, DM, 512, scr, r, lane); continue; } r -= I_A;
                if (r < I_C) { transpose_item(w_up_c, DM, WCAT, DM, 1024, scr, r, lane); continue; } r -= I_C;
                if (r < I_SQ) { transpose_item(w_o, DM, WO, DM, 0, scr, r, lane); continue; } r -= I_SQ;
                transpose_item(wq, DM, WQ, DM, 0, scr, r, lane);
            }
            for (size_t i = (size_t)gt; i < (size_t)NEXP * DM / 8; i += (size_t)NGT) {
                { const f32x4 a = ((const GAS f32x4*)pu)[2 * i], b = ((const GAS f32x4*)pu)[2 * i + 1]; v4u o; o.x = pk2(a.x, a.y); o.y = pk2(a.z, a.w); o.z = pk2(b.x, b.y); o.w = pk2(b.z, b.w); ((GAS v4u*)UB)[i] = o; }
                { const f32x4 a = ((const GAS f32x4*)pv)[2 * i], b = ((const GAS f32x4*)pv)[2 * i + 1]; v4u o; o.x = pk2(a.x, a.y); o.y = pk2(a.z, a.w); o.z = pk2(b.x, b.y); o.w = pk2(b.z, b.w); ((GAS v4u*)VB)[i] = o; }
            }
            for (int i = gt; i < 65536; i += NGT) { const int n = i >> 8, kk = i & 255, p = n >> 7; SKBD[i] = ((kk >> 7) == p) ? (bf16)f2bf(subk[(size_t)(p * 128 + (n & 127)) * 128 + (kk & 127)]) : (bf16)0; }
            for (int m = gw; m < MTOK; m += NGW) rms_row_to_bf16((layer == 0 ? INP(0) : (const float*)X) + (size_t)m * DM, mix_g, H + (size_t)m * DM, lane);
            if (layer == 0) {
                for (size_t i = (size_t)gt; i < (size_t)4096 * 8192 / 8; i += (size_t)NGT) {
                    const int sp = (int)(i >> 10), k0 = (int)(i & 1023) * 8, part = k0 >> 12, s0 = k0 & 4095; float v[8];
#pragma unroll
                    for (int j = 0; j < 8; ++j) { const float ang = (float)(((s0 + j) * sp) & 4095) * (1.f / 4096.f); v[j] = (part ? -__builtin_amdgcn_sinf(ang) : __builtin_amdgcn_cosf(ang)) * (1.f / 64.f); }
                    v4u o; o.x = pk2(v[0], v[1]); o.y = pk2(v[2], v[3]); o.z = pk2(v[4], v[5]); o.w = pk2(v[6], v[7]); ((GAS v4u*)DFT)[i] = o;
                }
                for (int i = gt; i < 65536; i += NGT) { const int r = i >> 8, c = i & 255, part = r >> 7, cp = r & 127; float v = 0.f;
                    if (c < 128) { const float ang = (float)((c * cp) & 127) * (1.f / 128.f); v = (part ? __builtin_amdgcn_sinf(ang) : __builtin_amdgcn_cosf(ang)) * 0.08838834764831845f; }
                    CS[i] = (bf16)f2bf(v); }
                for (int i = gt; i < 16 * 8192; i += NGT) { const int hd = i >> 13, off = (i & 8191) - 4096; float v;
                    if (hd < 12) { const int g = hd >> 2, dil = g == 0 ? 1 : (g == 1 ? 4 : 16); v = (off >= -64 && off <= 64) ? rel_bias[rel_bucket(off * dil) * 16 + hd] * 11.313708498984761f : -1.0e5f; }
                    else v = rel_bias[rel_bucket(off) * 16 + hd] * 11.313708498984761f;
                    TAB[i] = v; }
            }
        }
#endif
        GRID_BAR();

#if PH_B
        {
            pg8::Gemm g{WSP(bf16, WS_H), WSP(bf16, WS_WIN)}; pg8::StaticOrder S; S.init(MTOK, INW, G, bx, DM, DM);
            pg8::EpiProj E{WSP(bf16, WS_PROJ), WSP(bf16, WS_G), INL(5, GTW)};
            pg8::gemm_phase<pg8::EpiProj, pg8::StaticOrder, true, DM, DM, DM>(ldsl, g, S, E, wave0);
        }
#endif
        GRID_BAR();

#if PH_C
        {
            pg8::Gemm g{WSP(bf16, WS_CS), WSP(bf16, WS_PROJ)}; pg8::F1Order S{G, bx};
            pg8::EpiZT E{WSP(bf16, WS_ZT)};
            pg8::gemm_phase<pg8::EpiZT, pg8::F1Order, false, 256, PJW, 256>(ldsl, g, S, E, wave0);
        }
#endif
        GRID_BAR();

#if PH_D
#if PH_D1
        {
            pg8::Gemm g{WSP(bf16, WS_DFT), WSP(bf16, WS_ZT)}; pg8::F2Order S; S.init(4096, 2048, G, bx, 8192, 8192);
            pg8::EpiStore E{WSP(bf16, WS_OC), DM};
            pg8::gemm_phase<pg8::EpiStore, pg8::F2Order, false, 8192, 8192, 8192>(ldsl, g, S, E, wave0);
        }
#endif
#if PH_D2
        {
            PH_IDS();
            gu32* qhead = ctl + CW_QUEUE + 64 * layer;
            bf16* PROJ = WSP(bf16, WS_PROJ); bf16* DO = WSP(bf16, WS_MG); bf16* DL = WSP(bf16, WS_H); float* LSE = WSP(float, WS_LSE); const float* TAB = WSP(float, WS_TAB);
            const float* cur_tab = nullptr;
            for (;;) {
                __syncthreads();
                if (tid == 0) MISC[0] = __hip_atomic_fetch_add(qhead, 1u, __ATOMIC_RELAXED, __HIP_MEMORY_SCOPE_AGENT);
                __syncthreads();
                const int ui = __builtin_amdgcn_readfirstlane((int)MISC[0]);
                if (ui >= 1792) break;
                attn::Unit u; int hd;
                if (ui < 1024) {
                    const int qb = ui & 15, vh = (ui >> 4) & 1, m = (ui >> 5) & 1, h = (ui >> 6) & 3, b = ui >> 8;
                    const bf16* base = PROJ + (size_t)b * SEQ * PJW;
                    u.Q = base + (size_t)(qb * 256) * PJW + COL_DIFF + (h * 2 + m) * 128; u.K = base + COL_DIFF + 1024 + (h * 2 + m) * 128; u.V = base + COL_DIFF + 2048 + h * 256 + vh * 128;
                    u.O = DO + (size_t)(b * SEQ + qb * 256) * DM + (h * 2 + m) * 256 + vh * 128; u.lse = nullptr; u.ldq = PJW; u.ldk = PJW; u.ldo = DM; u.lse_ld = 0;
                    u.kt0 = 0; u.nt = SEQ / 64; u.qoff = qb * 256; hd = 12 + h;
                } else {
                    const int v = ui - 1024, qb16 = v & 15, hh = (v >> 4) & 3, bg = v >> 6, g = bg % 3, b = bg / 3;
                    const int dil = g == 0 ? 1 : (g == 1 ? 4 : 16), bpc = 16 / dil, r = qb16 / bpc, qblk = qb16 % bpc, q0 = qblk * 256, ntot = (SEQ / dil) / 64;
                    int kt0 = q0 / 64 - 1; if (kt0 < 0) kt0 = 0; int kt1 = q0 / 64 + 5; if (kt1 > ntot) kt1 = ntot;
                    if ((kt1 - kt0) & 1) { if (kt0 > 0) --kt0; else ++kt1; }
                    const bf16* base = PROJ + (size_t)(b * SEQ + r) * PJW + COL_DIL + g * 512 + hh * 128;
                    u.Q = base + (size_t)q0 * dil * PJW; u.K = base + 1536; u.V = base + 3072;
                    u.O = DL + ((size_t)g * MTOK + b * SEQ + r + (size_t)q0 * dil) * 512 + hh * 128; u.lse = LSE + ((size_t)g * MTOK + b * SEQ + r + (size_t)q0 * dil) * 4 + hh;
                    u.ldq = (long)PJW * dil; u.ldk = (long)PJW * dil; u.ldo = 512L * dil; u.lse_ld = 4 * dil; u.kt0 = kt0; u.nt = kt1 - kt0; u.qoff = q0; hd = g * 4 + hh;
                }
                const float* tab = TAB + (size_t)hd * 8192;
                if (tab != cur_tab) {
                    cur_tab = tab;
                    LAS f32x4* tl = (LAS f32x4*)(ldsl + attn::LDS_TAB); const int t2 = opaque_tid(wave0);
#pragma unroll
                    for (int j = 0; j < 4; ++j) tl[t2 + 512 * j] = ((const GAS f32x4*)tab)[t2 + 512 * j];
                }
                attn::attn_unit(u, (char*)lds, wave0);
            }
        }
#endif
#endif
        GRID_BAR();

#if PH_E
        {
            PH_IDS();
            const float* dlam = INL(9, 512); const float* subln = INL(10, 256); const float lambda_init = layer == 0 ? 0.2f : 0.35550906759f;
            const float* LSE = WSP(float, WS_LSE); const bf16* DL = WSP(bf16, WS_H); const bf16* DO = WSP(bf16, WS_MG); bf16* OC = WSP(bf16, WS_OC);
            float s1 = dlam[lane] * dlam[128 + lane] + dlam[64 + lane] * dlam[192 + lane], s2 = dlam[256 + lane] * dlam[384 + lane] + dlam[320 + lane] * dlam[448 + lane];
            s1 = wave_sum(s1); s2 = wave_sum(s2);
            const float lam = __expf(s1) - __expf(s2) + lambda_init, osc = 1.0f - lambda_init;
            const int hq = lane >> 4, l16 = lane & 15;
            for (int t = gw; t < MTOK; t += NGW) {
                float ls[3], mx = -3e38f;
#pragma unroll
                for (int g = 0; g < 3; ++g) { ls[g] = LSE[((size_t)g * MTOK + t) * 4 + hq]; mx = fmaxf(mx, ls[g]); }
                float wsum = 0.f;
#pragma unroll
                for (int g = 0; g < 3; ++g) { ls[g] = __expf(ls[g] - mx); wsum += ls[g]; }
                const float winv = 1.0f / wsum; float acc8[8] = {0.f, 0.f, 0.f, 0.f, 0.f, 0.f, 0.f, 0.f};
#pragma unroll
                for (int g = 0; g < 3; ++g) { const v4u o = *(const GAS v4u*)(DL + ((size_t)g * MTOK + t) * 512 + lane * 8); const float w = ls[g] * winv;
                    acc8[0] += w * bflo(o.x); acc8[1] += w * bfhi(o.x); acc8[2] += w * bflo(o.y); acc8[3] += w * bfhi(o.y); acc8[4] += w * bflo(o.z); acc8[5] += w * bfhi(o.z); acc8[6] += w * bflo(o.w); acc8[7] += w * bfhi(o.w); }
#if defined(DBG_ZERO_OB)
                for (int j = 0; j < 8; ++j) acc8[j] = 0.f;
#endif
                { v4u o; o.x = pk2(acc8[0], acc8[1]); o.y = pk2(acc8[2], acc8[3]); o.z = pk2(acc8[4], acc8[5]); o.w = pk2(acc8[6], acc8[7]); *(GAS v4u*)(OC + (size_t)t * DM + 512 + lane * 8) = o; }
                const bf16* dp = DO + (size_t)t * DM + hq * 512 + l16 * 16;
                const v4u a0 = *(const GAS v4u*)(dp), a1 = *(const GAS v4u*)(dp + 8), b0 = *(const GAS v4u*)(dp + 256), b1 = *(const GAS v4u*)(dp + 264);
                float d[16];
                d[0] = bflo(a0.x) - lam * bflo(b0.x); d[1] = bfhi(a0.x) - lam * bfhi(b0.x); d[2] = bflo(a0.y) - lam * bflo(b0.y); d[3] = bfhi(a0.y) - lam * bfhi(b0.y);
                d[4] = bflo(a0.z) - lam * bflo(b0.z); d[5] = bfhi(a0.z) - lam * bfhi(b0.z); d[6] = bflo(a0.w) - lam * bflo(b0.w); d[7] = bfhi(a0.w) - lam * bfhi(b0.w);
                d[8] = bflo(a1.x) - lam * bflo(b1.x); d[9] = bfhi(a1.x) - lam * bfhi(b1.x); d[10] = bflo(a1.y) - lam * bflo(b1.y); d[11] = bfhi(a1.y) - lam * bfhi(b1.y);
                d[12] = bflo(a1.z) - lam * bflo(b1.z); d[13] = bfhi(a1.z) - lam * bfhi(b1.z); d[14] = bflo(a1.w) - lam * bflo(b1.w); d[15] = bfhi(a1.w) - lam * bfhi(b1.w);
                float ss = 0.f;
#pragma unroll
                for (int j = 0; j < 16; ++j) ss += d[j] * d[j];
                ss += sx_f<1>(ss); ss += sx_f<2>(ss); ss += sx_f<4>(ss); ss += sx_f<8>(ss);
                const float rs = osc / sqrtf(ss * (1.f / 256.f) + RMS_EPS);
                const f32x4 g0 = *(const GAS f32x4*)(subln + l16 * 16), g1 = *(const GAS f32x4*)(subln + l16 * 16 + 4), g2 = *(const GAS f32x4*)(subln + l16 * 16 + 8), g3 = *(const GAS f32x4*)(subln + l16 * 16 + 12);
                v4u o0, o1;
                o0.x = pk2(d[0] * rs * g0.x, d[1] * rs * g0.y); o0.y = pk2(d[2] * rs * g0.z, d[3] * rs * g0.w); o0.z = pk2(d[4] * rs * g1.x, d[5] * rs * g1.y); o0.w = pk2(d[6] * rs * g1.z, d[7] * rs * g1.w);
                o1.x = pk2(d[8] * rs * g2.x, d[9] * rs * g2.y); o1.y = pk2(d[10] * rs * g2.z, d[11] * rs * g2.w); o1.z = pk2(d[12] * rs * g3.x, d[13] * rs * g3.y); o1.w = pk2(d[14] * rs * g3.z, d[15] * rs * g3.w);
                bf16* op = OC + (size_t)t * DM + 1024 + hq * 256 + l16 * 16;
                *(GAS v4u*)(op) = o0; *(GAS v4u*)(op + 8) = o1;
            }
        }
#endif
        GRID_BAR();

#if PH_F
        {
            pg8::StaticOrder S; S.init(MTOK, DM, G, bx, DM, DM);
            { pg8::Gemm g{WSP(bf16, WS_OC), WSP(bf16, WS_WCAT)}; pg8::EpiMerge3 E{WSP(bf16, WS_G), WSP(bf16, WS_MG), 0}; pg8::gemm_phase<pg8::EpiMerge3, pg8::StaticOrder, true, DM, DM, 512>(ldsl, g, S, E, wave0); }
            { pg8::Gemm g{WSP(bf16, WS_OC) + 512, WSP(bf16, WS_WCAT) + 512}; pg8::EpiMerge3 E{WSP(bf16, WS_G), WSP(bf16, WS_MG), 1}; pg8::gemm_phase<pg8::EpiMerge3, pg8::StaticOrder, true, DM, DM, 512>(ldsl, g, S, E, wave0); }
            { pg8::Gemm g{WSP(bf16, WS_OC) + 1024, WSP(bf16, WS_WCAT) + 1024}; pg8::EpiMerge3 E{WSP(bf16, WS_G), WSP(bf16, WS_MG), 2}; pg8::gemm_phase<pg8::EpiMerge3, pg8::StaticOrder, true, DM, DM, 1024>(ldsl, g, S, E, wave0); }
        }
#endif
        GRID_BAR();

#if PH_G
        {
            pg8::Gemm g{WSP(bf16, WS_MG), WSP(bf16, WS_WO)}; pg8::StaticOrder S; S.init(MTOK, DM, G, bx, DM, DM);
            pg8::EpiResF32 E{layer == 0 ? INP(0) : (const float*)X, X, DM};
            pg8::gemm_phase<pg8::EpiResF32, pg8::StaticOrder, true, DM, DM, DM>(ldsl, g, S, E, wave0);
        }
#endif
        GRID_BAR();

#if PH_H
        { PH_IDS(); const float* ffn_g = INL(12, DM); bf16* H = WSP(bf16, WS_H);
          for (int m = gw; m < MTOK; m += NGW) rms_row_to_bf16(X + (size_t)m * DM, ffn_g, H + (size_t)m * DM, lane); }
#endif
        GRID_BAR();

#if PH_I
        {
            pg8::Gemm g{WSP(bf16, WS_H), WSP(bf16, WS_WQ)}; pg8::StaticOrder S; S.init(MTOK, DM, G, bx, DM, DM);
            pg8::EpiStore E{WSP(bf16, WS_Q), DM};
            pg8::gemm_phase<pg8::EpiStore, pg8::StaticOrder, true, DM, DM, DM>(ldsl, g, S, E, wave0);
        }
#endif
        GRID_BAR();

#if PH_J
        {
            pg8::Gemm g{WSP(bf16, WS_Q), WSP(bf16, WS_SKBD)}; pg8::StaticOrder S; S.init(MTOK * 8, 256, G, bx, 256, 256);
            pg8::EpiResF32 E{nullptr, WSP(float, WS_SC), 256};
            pg8::gemm_phase<pg8::EpiResF32, pg8::StaticOrder, true, 256, 256, 256>(ldsl, g, S, E, wave0);
        }
#endif
        GRID_BAR();

#if PH_K
        {
            PH_IDS();
            const float* SC = WSP(float, WS_SC); int* IDS = WSP(int, WS_IDS); float* GATES = WSP(float, WS_GATES);
            int ci = -1, cj = 0; { int c = lane; for (int i = 0; i < 16; ++i) { const int cnt = 16 / (i + 1); if (ci < 0) { if (c < cnt) { ci = i; cj = c; } else c -= cnt; } } }
            for (int row = gw; row < MTOK * 8; row += NGW) {
                const float* sc = SC + (size_t)row * 256;
                const float s0 = sc[lane], s1 = sc[64 + lane], s2 = sc[128 + lane], s3 = sc[192 + lane];
                unsigned k0 = (okey(s0) & ~127u) | (unsigned)(127 - lane), k1 = (okey(s1) & ~127u) | (unsigned)(63 - lane);
                unsigned k2 = (okey(s2) & ~127u) | (unsigned)(127 - lane), k3 = (okey(s3) & ~127u) | (unsigned)(63 - lane);
                unsigned ta = 0u, tb = 0u;
                for (int r = 0; r < 16; ++r) {
                    const unsigned ma = wave_max_u32(k0 > k1 ? k0 : k1), mb = wave_max_u32(k2 > k3 ? k2 : k3);
                    if (k0 == ma) k0 = 0u; if (k1 == ma) k1 = 0u; if (k2 == mb) k2 = 0u; if (k3 == mb) k3 = 0u;
                    if (lane == r) { ta = ma; tb = mb; }
                }
                const int ia = 127 - (int)(ta & 127u), ib = 127 - (int)(tb & 127u);
                const float va = sc[ia], vb = sc[128 + ib];
                const float cs = bperm_f(va, ci < 0 ? 0 : ci) + bperm_f(vb, cj);
                unsigned ck = ci < 0 ? 0u : ((okey(cs) & ~255u) | (unsigned)(255 - (ci * 16 + cj)));
                unsigned tw = 0u;
                for (int r = 0; r < 16; ++r) { const unsigned mm = wave_max_u32(ck); if (ck == mm) ck = 0u; if (lane == r) tw = mm; }
                const int code = 255 - (int)(tw & 255u), wi = (code >> 4) & 15, wj = code & 15;
                const float bs = bperm_f(va, wi) + bperm_f(vb, wj);
                const int eid = bperm_i(ia, wi) * 128 + bperm_i(ib, wj);
                float mx = lane < 16 ? bs : -3e38f;
                mx = fmaxf(mx, sx_f<8>(mx)); mx = fmaxf(mx, sx_f<4>(mx)); mx = fmaxf(mx, sx_f<2>(mx)); mx = fmaxf(mx, sx_f<1>(mx));
                const float e = lane < 16 ? __expf(bs - mx) : 0.f; float es = e;
                es += sx_f<8>(es); es += sx_f<4>(es); es += sx_f<2>(es); es += sx_f<1>(es);
                if (lane < 16) { IDS[(size_t)row * 16 + lane] = eid; GATES[(size_t)row * 16 + lane] = e / es; }
            }
        }
#endif
        GRID_BAR();

#if PH_L
        {
            PH_IDS();
            const bf16* H = WSP(bf16, WS_H); const bf16* UB = WSP(bf16, WS_U); const bf16* VB = WSP(bf16, WS_V); const int* IDS = WSP(int, WS_IDS); const float* GATES = WSP(float, WS_GATES);
            for (int t = gw; t < MTOK; t += NGW) {
                const GAS v4u* hp = (const GAS v4u*)(H + (size_t)t * DM) + lane;
                v4u hq4[4];
#pragma unroll
                for (int c = 0; c < 4; ++c) hq4[c] = hp[64 * c];
                const int id0 = IDS[(size_t)t * 128 + lane], id1 = IDS[(size_t)t * 128 + 64 + lane];
                const float gt0 = GATES[(size_t)t * 128 + lane], gt1 = GATES[(size_t)t * 128 + 64 + lane];
                float pre0 = 0.f, pre1 = 0.f;
                for (int half = 0; half < 2; ++half) {
                    const int idr = half ? id1 : id0; float prer = 0.f;
                    for (int e4 = 0; e4 < 64; e4 += 4) {
                        float p[4];
#pragma unroll
                        for (int x = 0; x < 4; ++x) {
                            const int id = __builtin_amdgcn_readlane(idr, e4 + x);
                            const GAS v4u* rp = (const GAS v4u*)(UB + (size_t)id * DM) + lane;
                            const v4u a0 = rp[0], a1 = rp[64], a2 = rp[128], a3 = rp[192];
                            float s = 0.f;
                            s = DOT2(hq4[0].x, a0.x, s); s = DOT2(hq4[0].y, a0.y, s); s = DOT2(hq4[0].z, a0.z, s); s = DOT2(hq4[0].w, a0.w, s);
                            s = DOT2(hq4[1].x, a1.x, s); s = DOT2(hq4[1].y, a1.y, s); s = DOT2(hq4[1].z, a1.z, s); s = DOT2(hq4[1].w, a1.w, s);
                            s = DOT2(hq4[2].x, a2.x, s); s = DOT2(hq4[2].y, a2.y, s); s = DOT2(hq4[2].z, a2.z, s); s = DOT2(hq4[2].w, a2.w, s);
                            s = DOT2(hq4[3].x, a3.x, s); s = DOT2(hq4[3].y, a3.y, s); s = DOT2(hq4[3].z, a3.z, s); s = DOT2(hq4[3].w, a3.w, s);
                            p[x] = s;
                        }
                        const bool up = lane >= 32;
                        float kA = up ? p[2] : p[0], kB = up ? p[3] : p[1];
                        kA += other32(up ? p[0] : p[2], up); kB += other32(up ? p[1] : p[3], up);
                        const bool up2 = (lane & 16) != 0;
                        float k2 = up2 ? kB : kA; k2 += sx_f<16>(up2 ? kA : kB);
                        k2 += sx_f<8>(k2); k2 += sx_f<4>(k2); k2 += sx_f<2>(k2); k2 += sx_f<1>(k2);
                        const float dv = bperm_f(k2, 16 * (lane & 3));
                        if ((lane & ~3) == e4) prer = dv;
                    }
                    if (half) pre1 = prer; else pre0 = prer;
                }
                const float ac0 = 0.5f * pre0 * (1.0f + erff(pre0 * 0.70710678118654752f)) * gt0, ac1 = 0.5f * pre1 * (1.0f + erff(pre1 * 0.70710678118654752f)) * gt1;
                float oacc[32];
#pragma unroll
                for (int j = 0; j < 32; ++j) oacc[j] = 0.f;
                for (int half = 0; half < 2; ++half) {
                    const int idr = half ? id1 : id0; const float acr = half ? ac1 : ac0;
                    for (int e4 = 0; e4 < 64; e4 += 4) {
#pragma unroll
                        for (int x = 0; x < 4; ++x) {
                            const int id = __builtin_amdgcn_readlane(idr, e4 + x);
                            const float a = __uint_as_float((unsigned)__builtin_amdgcn_readlane((int)__float_as_uint(acr), e4 + x));
                            const GAS v4u* rp = (const GAS v4u*)(VB + (size_t)id * DM) + lane;
#pragma unroll
                            for (int c = 0; c < 4; ++c) { const v4u w = rp[64 * c];
                                oacc[c * 8 + 0] += a * bflo(w.x); oacc[c * 8 + 1] += a * bfhi(w.x); oacc[c * 8 + 2] += a * bflo(w.y); oacc[c * 8 + 3] += a * bfhi(w.y);
                                oacc[c * 8 + 4] += a * bflo(w.z); oacc[c * 8 + 5] += a * bfhi(w.z); oacc[c * 8 + 6] += a * bflo(w.w); oacc[c * 8 + 7] += a * bfhi(w.w); }
                        }
                    }
                }
                float* xp = X + (size_t)t * DM + lane * 8;
#pragma unroll
                for (int c = 0; c < 4; ++c) { GAS f32x4* q = (GAS f32x4*)(xp + c * 512);
                    f32x4 lo = q[0], hi = q[1];
                    lo.x += oacc[c * 8 + 0]; lo.y += oacc[c * 8 + 1]; lo.z += oacc[c * 8 + 2]; lo.w += oacc[c * 8 + 3];
                    hi.x += oacc[c * 8 + 4]; hi.y += oacc[c * 8 + 5]; hi.z += oacc[c * 8 + 6]; hi.w += oacc[c * 8 + 7];
                    q[0] = lo; q[1] = hi; }
            }
        }
#endif
        GRID_BAR();
    }

    { PH_IDS();
    for (int m = gw; m < MTOK; m += NGW) {
        GAS f32x4* xr = (GAS f32x4*)(X + (size_t)m * DM) + lane; const GAS f32x4* gr = (const GAS f32x4*)INP(2) + lane;
        f32x4 v[8]; float s = 0.f;
#pragma unroll
        for (int j = 0; j < 8; ++j) { v[j] = xr[64 * j]; s += (v[j].x * v[j].x + v[j].y * v[j].y) + (v[j].z * v[j].z + v[j].w * v[j].w); }
        const float rstd = 1.0f / sqrtf(wave_sum(s) * (1.f / DM) + RMS_EPS);
#pragma unroll
        for (int j = 0; j < 8; ++j) { const f32x4 gg = gr[64 * j]; xr[64 * j] = v[j] * rstd * gg; }
    } }
}

extern "C" void kernel_launch(void* const* d_in, const int* in_sizes, int n_in, void* d_out, int out_size, void* d_ws, size_t ws_size, hipStream_t stream) {
    static int grid = 0;
    if (grid == 0) {
        if (n_in != 17 || in_sizes[0] != MTOK * DM || out_size != MTOK * DM || ws_size < WS_END) {
            fprintf(stderr, "kernel_launch: shape/workspace mismatch: n_in %d in0 %d out %d ws %zu (need %zu); nothing launched\n", n_in, n_in > 0 ? in_sizes[0] : -1, out_size, ws_size, (size_t)WS_END); grid = -1; return; }
        int dev = 0, cus = 0, per_cu = 0;
        if (hipGetDevice(&dev) != hipSuccess || hipDeviceGetAttribute(&cus, hipDeviceAttributeMultiprocessorCount, dev) != hipSuccess) { grid = -1; return; }
        if (hipFuncSetAttribute((const void*)mk_fwd, hipFuncAttributeMaxDynamicSharedMemorySize, LDS_BYTES) != hipSuccess) { fprintf(stderr, "kernel_launch: hipFuncSetAttribute failed\n"); grid = -1; return; }
        if (hipOccupancyMaxActiveBlocksPerMultiprocessor(&per_cu, (const void*)mk_fwd, NWAVES * 64, LDS_BYTES) != hipSuccess || per_cu < 1)
            fprintf(stderr, "kernel_launch: note: occupancy query reports %d workgroups per CU\n", per_cu);
        (void)hipGetLastError();
        grid = cus;
    }
    if (grid < 0) return;
    if (hipMemsetAsync((char*)d_ws + WS_CTL, 0, CTL_ZERO_BYTES, stream) != hipSuccess) { fprintf(stderr, "kernel_launch: memset failed\n"); return; }
    Args a{};
    for (int i = 0; i < 17; ++i) a.in[i] = (const float*)d_in[i];
    a.out = (float*)d_out; a.ws = (unsigned char*)d_ws;
    hipLaunchKernelGGL(mk_fwd, dim3(grid), dim3(NWAVES * 64), LDS_BYTES, stream, a);
    const hipError_t le = hipPeekAtLastError();
    if (le != hipSuccess) fprintf(stderr, "kernel_launch: launch failed: %s\n", hipGetErrorName(le));
}
```

```cpp
#include <hip/hip_runtime.h>
#include <cstdio>
#include <cstdint>

constexpr int DM = 2048, NB = 4, SEQ = 4096, MTOK = NB * SEQ;
constexpr int INW = 14336, PJW = 8192, GTW = 6144;
constexpr int COL_DIL = 512, COL_DIFF = 5120;
constexpr int NEXP = 16384;
constexpr float RMS_EPS = 1e-6f;

typedef unsigned short bf16;
#define GAS __attribute__((address_space(1)))
#define LAS __attribute__((address_space(3)))
typedef unsigned v4u __attribute__((ext_vector_type(4)));
typedef float f32x4 __attribute__((ext_vector_type(4)));
typedef GAS unsigned gu32;

__device__ __forceinline__ int opaque_tid(int wave_sgpr) { int l; asm volatile("v_mbcnt_lo_u32_b32 %0, -1, 0\n\tv_mbcnt_hi_u32_b32 %0, -1, %0" : "=v"(l)); return wave_sgpr * 64 + l; }
namespace pg8 {
#define PG8_LAS __attribute__((address_space(3)))
typedef unsigned short bf16_t;
typedef short bf16x8 __attribute__((ext_vector_type(8)));
typedef float f32x4 __attribute__((ext_vector_type(4)));
typedef unsigned u32x4 __attribute__((ext_vector_type(4)));
constexpr int BM = 256, BK = 64, HALF = 128, HTB = HALF * BK * 2, STAGE_BYTES = 8 * HTB, NXCD = 8, WGM = 8;

__host__ __device__ __forceinline__ int lds_byte(int r, int c) { const int st = (r >> 4) * 2 + (c >> 5), rr = r & 15, cc = c & 31, ob = rr * 64 + cc * 2; return st * 1024 + (ob ^ (((ob >> 9) & 1) << 5)); }
__host__ __device__ __forceinline__ void stage_rc(int b, int& R, int& C) { const int st = b / 1024, sb = b % 1024, swz = sb ^ (((sb >> 9) & 1) << 5); R = (st >> 1) * 16 + swz / 64; C = (st & 1) * 32 + (swz % 64) / 2; }
__host__ __device__ __forceinline__ int perm32(int rho) { const int n = rho >> 4, i = rho & 15; return 8 * (i >> 2) + 4 * n + (i & 3); }

struct Unit { int pm, pn; long aoff, boff; int orow, ocol; };
struct Gemm { const bf16_t* A; const bf16_t* Bt; };

struct StaticOrder {
    int nM, nN, nwg, G, c; long sa, sb;
    __device__ void init(int M, int N, int G_, int c_, int lda, int ldb) { nM = M / BM; nN = N / BM; nwg = nM * nN; G = G_; c = c_; sa = 512L * lda; sb = 512L * ldb; }
    __device__ bool next(int i, Unit& u) const {
        const long L = (long)i * G + c; if (L >= nwg) return false;
        int wgid = (int)L; { const int q = nwg / NXCD, r = nwg % NXCD, xcd = wgid % NXCD, off = wgid / NXCD; wgid = (xcd < r ? xcd * (q + 1) : r * (q + 1) + (xcd - r) * q) + off; }
        const int nig = WGM * nN, gid = wgid / nig, fm = gid * WGM, gsz = (nM - fm) < WGM ? (nM - fm) : WGM;
        u.pm = fm + ((wgid % nig) % gsz); u.pn = (wgid % nig) / gsz;
        u.aoff = u.pm * sa; u.boff = u.pn * sb; u.orow = u.pm * BM; u.ocol = u.pn * BM; return true;
    }
};
struct F2Order : StaticOrder {
    __device__ bool next(int i, Unit& u) const { if (!StaticOrder::next(i, u)) return false; u.orow = (u.pn >> 1) * 4096 + u.pm * BM; u.ocol = (u.pn & 1) * BM; return true; }
};
struct F1Order {
    int G, c;
    __device__ bool next(int i, Unit& u) const {
        const int idx = i * G + c; if (idx >= 256) return false;
        const int bg = idx >> 4, st = idx & 15, b = bg >> 2, g = bg & 3;
        u.pm = 0; u.pn = idx; u.aoff = 0; u.boff = ((long)(b * 4096 + st * 256) * PJW + g * 128) * 2; u.orow = bg * 128; u.ocol = st * 256; return true;
    }
};

__device__ __forceinline__ unsigned cvt_pk_bf16(float lo, float hi) { unsigned r; asm volatile("v_cvt_pk_bf16_f32 %0, %1, %2" : "=v"(r) : "v"(lo), "v"(hi)); return r; }
__device__ __forceinline__ float bf_lo(unsigned w) { return __uint_as_float(w << 16); }
__device__ __forceinline__ float bf_hi(unsigned w) { return __uint_as_float(w & 0xffff0000u); }

#define PG8_PACK(v0, v1, w) do { (w).x = cvt_pk_bf16((v0)[0], (v0)[1]); (w).y = cvt_pk_bf16((v0)[2], (v0)[3]); (w).z = cvt_pk_bf16((v1)[0], (v1)[1]); (w).w = cvt_pk_bf16((v1)[2], (v1)[3]); } while (0)

struct EpiStore {
    static constexpr bool PERM = true;
    bf16_t* O; int ldo;
    __device__ __forceinline__ void operator()(const f32x4 (&acc)[2][2][4][2], const Unit& u, int wr, int wc, int fr, int fq) const {
        const int row0 = u.orow + wr * 64 + fr, col0 = u.ocol + wc * 32 + 8 * fq;
#pragma unroll
        for (int ai = 0; ai < 2; ++ai)
#pragma unroll
            for (int m = 0; m < 4; ++m) { bf16_t* rowp = O + (size_t)(row0 + ai * HALF + m * 16) * ldo + col0;
#pragma unroll
                for (int bj = 0; bj < 2; ++bj) { u32x4 w; PG8_PACK(acc[ai][bj][m][0], acc[ai][bj][m][1], w); *(u32x4*)(rowp + bj * HALF) = w; } }
    }
};
struct EpiZT {
    static constexpr bool PERM = true;
    bf16_t* O;
    __device__ __forceinline__ void operator()(const f32x4 (&acc)[2][2][4][2], const Unit& u, int wr, int wc, int fr, int fq) const {
        const int row0 = u.orow + wr * 64 + fr, col0 = u.ocol + wc * 32 + 8 * fq;
#pragma unroll
        for (int ai = 0; ai < 2; ++ai)
#pragma unroll
            for (int m = 0; m < 4; ++m) { bf16_t* rowp = O + (size_t)(row0 + m * 16) * 8192 + ai * 4096 + col0;
#pragma unroll
                for (int bj = 0; bj < 2; ++bj) { u32x4 w; PG8_PACK(acc[ai][bj][m][0], acc[ai][bj][m][1], w); *(u32x4*)(rowp + bj * HALF) = w; } }
    }
};
struct EpiProj {
    static constexpr bool PERM = true;
    bf16_t* P; bf16_t* Gt; const float* bg;
    __device__ __forceinline__ void operator()(const f32x4 (&acc)[2][2][4][2], const Unit& u, int wr, int wc, int fr, int fq) const {
        const bool isg = u.pn >= 32;
        const int row0 = u.pm * BM + wr * 64 + fr, col0 = (isg ? u.pn - 32 : u.pn) * BM + wc * 32 + 8 * fq, ldc = isg ? GTW : PJW;
        bf16_t* base = isg ? Gt : P;
        f32x4 bv[2][2];
#pragma unroll
        for (int bj = 0; bj < 2; ++bj)
#pragma unroll
            for (int n = 0; n < 2; ++n) bv[bj][n] = isg ? *(const f32x4*)(bg + col0 + bj * HALF + 4 * n) : (f32x4){0.f, 0.f, 0.f, 0.f};
#pragma unroll
        for (int ai = 0; ai < 2; ++ai)
#pragma unroll
            for (int m = 0; m < 4; ++m) { bf16_t* rowp = base + (size_t)(row0 + ai * HALF + m * 16) * ldc + col0;
#pragma unroll
                for (int bj = 0; bj < 2; ++bj) { f32x4 v0 = acc[ai][bj][m][0] + bv[bj][0], v1 = acc[ai][bj][m][1] + bv[bj][1];
                    if (isg) {
#pragma unroll
                        for (int j = 0; j < 4; ++j) { v0[j] = __builtin_amdgcn_rcpf(1.0f + __builtin_amdgcn_exp2f(-1.4426950408889634f * v0[j])); v1[j] = __builtin_amdgcn_rcpf(1.0f + __builtin_amdgcn_exp2f(-1.4426950408889634f * v1[j])); } }
                    u32x4 w; PG8_PACK(v0, v1, w); *(u32x4*)(rowp + bj * HALF) = w; } }
    }
};
struct EpiMerge3 {
    static constexpr bool PERM = true;
    const bf16_t* Gt; bf16_t* O; int br;
    __device__ __forceinline__ void operator()(const f32x4 (&acc)[2][2][4][2], const Unit& u, int wr, int wc, int fr, int fq) const {
        const int row0 = u.pm * BM + wr * 64 + fr, col0 = u.pn * BM + wc * 32 + 8 * fq;
#pragma unroll
        for (int ai = 0; ai < 2; ++ai)
#pragma unroll
            for (int m = 0; m < 4; ++m) { const bf16_t* gp = Gt + (size_t)(row0 + ai * HALF + m * 16) * GTW + br * DM + col0; bf16_t* rowp = O + (size_t)(row0 + ai * HALF + m * 16) * DM + col0;
#pragma unroll
                for (int bj = 0; bj < 2; ++bj) { const u32x4 g = *(const u32x4*)(gp + bj * HALF);
                    f32x4 v0 = acc[ai][bj][m][0], v1 = acc[ai][bj][m][1];
                    v0[0] *= bf_lo(g.x); v0[1] *= bf_hi(g.x); v0[2] *= bf_lo(g.y); v0[3] *= bf_hi(g.y);
                    v1[0] *= bf_lo(g.z); v1[1] *= bf_hi(g.z); v1[2] *= bf_lo(g.w); v1[3] *= bf_hi(g.w);
                    if (br) { const u32x4 p = *(const u32x4*)(rowp + bj * HALF);
                        v0[0] += bf_lo(p.x); v0[1] += bf_hi(p.x); v0[2] += bf_lo(p.y); v0[3] += bf_hi(p.y);
                        v1[0] += bf_lo(p.z); v1[1] += bf_hi(p.z); v1[2] += bf_lo(p.w); v1[3] += bf_hi(p.w); }
                    u32x4 w; PG8_PACK(v0, v1, w); *(u32x4*)(rowp + bj * HALF) = w; }
                asm volatile("" ::: "memory"); }
    }
};
struct EpiResF32 {
    static constexpr bool PERM = false;
    const float* base; float* out; int ldc;
    __device__ __forceinline__ void operator()(const f32x4 (&acc)[2][2][4][2], const Unit& u, int wr, int wc, int fr, int fq) const {
        const int row0 = u.orow + wr * 64 + fr, col0 = u.ocol + wc * 32 + 4 * fq;
#pragma unroll
        for (int ai = 0; ai < 2; ++ai)
#pragma unroll
            for (int m = 0; m < 4; ++m) { const size_t off = (size_t)(row0 + ai * HALF + m * 16) * ldc + col0;
#pragma unroll
                for (int bj = 0; bj < 2; ++bj)
#pragma unroll
                    for (int n = 0; n < 2; ++n) { f32x4 v = acc[ai][bj][m][n]; if (base) v += *(const f32x4*)(base + off + bj * HALF + n * 16); *(f32x4*)(out + off + bj * HALF + n * 16) = v; }
                asm volatile("" ::: "memory"); }
    }
};

template <class Epi, class Sched, bool ALIGN_EPI, int LDA, int LDB, int KK>
__device__ __forceinline__ void gemm_phase(PG8_LAS unsigned char* lds, const Gemm g, const Sched& S, const Epi& E, int wave0) {
    const int tid = opaque_tid(wave0), wid = wave0, lane = tid & 63, wr = wid >> 2, wc = wid & 3, fr = lane & 15, fq = lane >> 4;
    constexpr int nt = KK / BK;
    unsigned voffA[2], voffB[2];
#pragma unroll
    for (int i = 0; i < 2; ++i) { int R, C; stage_rc(tid * 16 + i * 8192, R, C); const int Rb = Epi::PERM ? ((R & ~31) + perm32(R & 31)) : R;
        voffA[i] = (unsigned)(R * LDA + C) * 2u; voffB[i] = (unsigned)(Rb * LDB + C) * 2u; }
    const size_t kstep = (size_t)(BK * 2);
    constexpr size_t hstepA = (size_t)HALF * LDA * 2, hstepB = (size_t)HALF * LDB * 2;
    const unsigned ldsw = (unsigned)wid * 1024u;
    const int aoff = lds_byte(wr * 64 + fr, fq * 8), boff = lds_byte(wc * 32 + fr, fq * 8);
#define PG8_SA(b, h) (((b) * 2 + (h)) * HTB)
#define PG8_SB(b, h) ((4 + (b) * 2 + (h)) * HTB)
#define PG8_STAGE(bufoff, gbase, voff) do { _Pragma("unroll") for (int _i = 0; _i < 2; ++_i) \
        __builtin_amdgcn_global_load_lds((const unsigned*)((const char*)(gbase) + (voff)[_i]), (PG8_LAS unsigned*)(lds + (bufoff) + ldsw + _i * 8192), 16, 0, 0); } while (0)
#define PG8_LDA(dst, b, h) do { _Pragma("unroll") for (int m = 0; m < 4; ++m) _Pragma("unroll") for (int k = 0; k < 2; ++k) dst[m][k] = *(const PG8_LAS bf16x8*)(lds + PG8_SA(b, h) + aoff + m * 2048 + k * 1024); } while (0)
#define PG8_LDB(dst, b, h) do { _Pragma("unroll") for (int n = 0; n < 2; ++n) _Pragma("unroll") for (int k = 0; k < 2; ++k) dst[n][k] = *(const PG8_LAS bf16x8*)(lds + PG8_SB(b, h) + boff + n * 2048 + k * 1024); } while (0)
#define PG8_MMA(ai, bj, At, Bt) do { __builtin_amdgcn_s_setprio(1); _Pragma("unroll") for (int m = 0; m < 4; ++m) _Pragma("unroll") for (int n = 0; n < 2; ++n) _Pragma("unroll") for (int k = 0; k < 2; ++k) \
        acc[ai][bj][m][n] = __builtin_amdgcn_mfma_f32_16x16x32_bf16(Bt[n][k], At[m][k], acc[ai][bj][m][n], 0, 0, 0); __builtin_amdgcn_s_setprio(0); } while (0)
#define PG8_WAIT_V(n) asm volatile("s_waitcnt vmcnt(" #n ")" ::: "memory")
#define PG8_WAIT_L(n) asm volatile("s_waitcnt lgkmcnt(" #n ")" ::: "memory")
#define PG8_BAR __builtin_amdgcn_s_barrier()
#define PG8_SCHED __builtin_amdgcn_sched_barrier(0)
    Unit cur, nxt; int ui = 0;
    if (!S.next(0, cur)) return;
    f32x4 acc[2][2][4][2];
#pragma unroll
    for (int a = 0; a < 2; ++a)
#pragma unroll
        for (int b = 0; b < 2; ++b)
#pragma unroll
            for (int m = 0; m < 4; ++m)
#pragma unroll
                for (int n = 0; n < 2; ++n) acc[a][b][m][n] = (f32x4){0.f, 0.f, 0.f, 0.f};
    bf16x8 At[4][2], B0[2][2], B1[2][2];
    const char* cA = (const char*)g.A + cur.aoff; const char* cB = (const char*)g.Bt + cur.boff;
    PG8_STAGE(PG8_SB(0, 0), cB, voffB); PG8_STAGE(PG8_SB(0, 1), cB + hstepB, voffB); PG8_STAGE(PG8_SA(0, 0), cA, voffA); PG8_STAGE(PG8_SA(0, 1), cA + hstepA, voffA);
    if (wr == 1) PG8_BAR;
    PG8_WAIT_V(2); PG8_BAR;
    PG8_STAGE(PG8_SB(1, 0), cB + kstep, voffB); PG8_STAGE(PG8_SA(1, 0), cA + kstep, voffA); PG8_STAGE(PG8_SB(1, 1), cB + hstepB + kstep, voffB);
    PG8_WAIT_V(6); PG8_BAR;
    for (;;) {
        const bool has_next = S.next(ui + 1, nxt);
        const char* nA = has_next ? (const char*)g.A + nxt.aoff : cA; const char* nB = has_next ? (const char*)g.Bt + nxt.boff : cB;
        for (int t = 0; t < nt; t += 2) {
            const bool last = (t == nt - 2);
            const char* a1 = cA + (size_t)(t + 1) * kstep;
            const char* a2 = last ? nA : cA + (size_t)(t + 2) * kstep; const char* b2 = last ? nB : cB + (size_t)(t + 2) * kstep;
            const char* a3 = a2 + kstep; const char* b3 = b2 + kstep;
            PG8_LDB(B0, 0, 0); PG8_LDB(B1, 0, 1); PG8_SCHED; PG8_LDA(At, 0, 0); PG8_STAGE(PG8_SA(1, 1), a1 + hstepA, voffA);
            PG8_WAIT_V(8); PG8_WAIT_L(0); PG8_BAR; PG8_MMA(0, 0, At, B0); PG8_MMA(0, 1, At, B1); PG8_BAR; PG8_SCHED;
            PG8_LDA(At, 0, 1); PG8_STAGE(PG8_SB(0, 0), b2, voffB); PG8_STAGE(PG8_SB(0, 1), b2 + hstepB, voffB); PG8_STAGE(PG8_SA(0, 0), a2, voffA);
            PG8_WAIT_V(8); PG8_WAIT_L(0); PG8_BAR; PG8_MMA(1, 0, At, B0); PG8_MMA(1, 1, At, B1); PG8_BAR; PG8_SCHED;
            PG8_LDB(B0, 1, 0); PG8_LDB(B1, 1, 1); PG8_SCHED; PG8_LDA(At, 1, 0); PG8_STAGE(PG8_SA(0, 1), a2 + hstepA, voffA);
            PG8_WAIT_V(8); PG8_WAIT_L(0); PG8_BAR; PG8_MMA(0, 0, At, B0); PG8_MMA(0, 1, At, B1); PG8_BAR; PG8_SCHED;
            PG8_LDA(At, 1, 1); PG8_STAGE(PG8_SB(1, 0), b3, voffB); PG8_STAGE(PG8_SB(1, 1), b3 + hstepB, voffB); PG8_STAGE(PG8_SA(1, 0), a3, voffA);
            PG8_WAIT_V(8); PG8_WAIT_L(0); PG8_BAR; PG8_MMA(1, 0, At, B0); PG8_MMA(1, 1, At, B1); PG8_BAR; PG8_SCHED;
        }
        if constexpr (ALIGN_EPI) { if (wr == 0) PG8_BAR; }
        E(acc, cur, wr, wc, fr, fq);
        if (!has_next) break;
#pragma unroll
        for (int a = 0; a < 2; ++a)
#pragma unroll
            for (int b = 0; b < 2; ++b)
#pragma unroll
                for (int m = 0; m < 4; ++m)
#pragma unroll
                    for (int n = 0; n < 2; ++n) acc[a][b][m][n] = (f32x4){0.f, 0.f, 0.f, 0.f};
        cur = nxt; cA = nA; cB = nB; ++ui;
        if constexpr (ALIGN_EPI) { if (wr == 1) PG8_BAR; }
    }
    PG8_WAIT_V(0);
    if constexpr (!ALIGN_EPI) { if (wr == 0) PG8_BAR; }
    PG8_BAR;
#undef PG8_SA
#undef PG8_SB
#undef PG8_STAGE
#undef PG8_LDA
#undef PG8_LDB
#undef PG8_MMA
#undef PG8_WAIT_V
#undef PG8_WAIT_L
#undef PG8_BAR
#undef PG8_SCHED
}
}

namespace attn {
using bf16x8 = __attribute__((ext_vector_type(8))) short;
using s16x4  = __attribute__((ext_vector_type(4))) short;
using f32x16 = __attribute__((ext_vector_type(16))) float;
using u32x4  = __attribute__((ext_vector_type(4))) unsigned;
constexpr int   D = 128, NW = 8, QBLK = 32, KVBLK = 64;
constexpr float SCALE = 0.088388347648318440f;
constexpr float THR = 8.f;
constexpr size_t SHM_V = KVBLK * D * 2, SHM_K = KVBLK * D * 2;
constexpr int LDS_WS = 2 * SHM_V + 2 * SHM_K, LDS_TAB = LDS_WS + NW * 64 * 4, LDS_END = LDS_TAB + 8192 * 4;
#define KSWZ(row, colB) ((row) * 256 + ((colB) ^ (((row) & 7) << 4)))
#define SBAR() __builtin_amdgcn_sched_barrier(0)
__device__ __forceinline__ int crow(int r, int hi) { return (r & 3) + 8 * (r >> 2) + 4 * hi; }
__device__ __forceinline__ unsigned cvtpk(float lo, float hi) { unsigned r; asm volatile("v_cvt_pk_bf16_f32 %0, %1, %2" : "=v"(r) : "v"(lo), "v"(hi)); return r; }

__device__ __forceinline__ void partialSM(f32x16& p0, f32x16& p1, float& m_reg, float& mn, float& alpha) {
  constexpr float C = SCALE * 1.4426950408889634f;
  float pmax = p0[0]; for (int r = 1; r < 16; ++r) pmax = fmaxf(pmax, p0[r]); for (int r = 0; r < 16; ++r) pmax = fmaxf(pmax, p1[r]);
  { auto rr = __builtin_amdgcn_permlane32_swap(__float_as_uint(pmax), __float_as_uint(pmax), false, false);
    pmax = fmaxf(__uint_as_float(rr[0]), __uint_as_float(rr[1])); }
  if (__builtin_expect(__all(pmax - m_reg <= THR / SCALE), 1)) { mn = m_reg; alpha = 1.f; }
  else { mn = fmaxf(m_reg, pmax); alpha = __builtin_amdgcn_exp2f((m_reg - mn) * C); m_reg = mn; }
  float mnC = -mn * C;
  for (int r = 0; r < 16; ++r) p0[r] = fmaf(p0[r], C, mnC); for (int r = 0; r < 16; ++r) p1[r] = fmaf(p1[r], C, mnC);
  for (int r = 0; r < 16; ++r) p0[r] = __builtin_amdgcn_exp2f(p0[r]);
}
__device__ __forceinline__ void finishSM(f32x16& p0, f32x16& p1, float alpha, float& l_reg, bf16x8& pa0, bf16x8& pa1, bf16x8& pa2, bf16x8& pa3) {
  for (int r = 0; r < 16; ++r) p1[r] = __builtin_amdgcn_exp2f(p1[r]);
  float ps = 0; for (int r = 0; r < 16; ++r) ps += p0[r]; for (int r = 0; r < 16; ++r) ps += p1[r];
  { auto rr = __builtin_amdgcn_permlane32_swap(__float_as_uint(ps), __float_as_uint(ps), false, false);
    ps = __uint_as_float(rr[0]) + __uint_as_float(rr[1]); }
  l_reg = l_reg * alpha + ps;
#define PK4(P, BASE, OUT) do { unsigned a0 = cvtpk(P[BASE + 0], P[BASE + 1]), a1 = cvtpk(P[BASE + 2], P[BASE + 3]);   \
    unsigned b0 = cvtpk(P[BASE + 4], P[BASE + 5]), b1 = cvtpk(P[BASE + 6], P[BASE + 7]);                              \
    auto r0 = __builtin_amdgcn_permlane32_swap(a0, b0, false, false); auto r1 = __builtin_amdgcn_permlane32_swap(a1, b1, false, false); \
    u32x4 w = {r0[0], r1[0], r0[1], r1[1]}; OUT = *reinterpret_cast<bf16x8*>(&w); } while (0)
  PK4(p0, 0, pa0); PK4(p0, 8, pa1); PK4(p1, 0, pa2); PK4(p1, 8, pa3);
#undef PK4
}
__device__ __forceinline__ void qkt(f32x16& p0, f32x16& p1, const bf16* Ks, const bf16x8* qr, int r32, int hi, const float* tl) {
#pragma unroll
  for (int r = 0; r < 16; ++r) { p0[r] = tl[(r & 3) + 8 * (r >> 2)]; p1[r] = tl[32 + (r & 3) + 8 * (r >> 2)]; }
#pragma unroll
  for (int d0 = 0; d0 < 8; ++d0) { int cb = (d0 * 16 + hi * 8) * 2;
    bf16x8 b0 = *reinterpret_cast<const bf16x8*>((const char*)Ks + KSWZ(r32, cb));
    bf16x8 b1 = *reinterpret_cast<const bf16x8*>((const char*)Ks + KSWZ(32 + r32, cb));
    p0 = __builtin_amdgcn_mfma_f32_32x32x16_bf16(b0, qr[d0], p0, 0, 0, 0);
    p1 = __builtin_amdgcn_mfma_f32_32x32x16_bf16(b1, qr[d0], p1, 0, 0, 0); }
}
__device__ __forceinline__ int v_st(int k, int c) { const int kk = (k & ~0xC) | ((k & 4) << 1) | ((k & 8) >> 1); return ((kk >> 3) * 4 + (c >> 5)) * 512 + ((kk & 7) * 32 + (c & 31)) * 2; }
__device__ __forceinline__ int v_rd_base(int lane) { return ((lane & 3) << 3) | (((lane >> 2) & 3) << 6) | (((lane >> 4) & 1) << 5) | (((lane >> 5) & 1) << 8); }
constexpr int v_rd_off(int d0, int ks, int half) { return d0 * 512 + ks * 4096 + half * 2048; }
template <int OFF> __device__ __forceinline__ s16x4 tr_read(int vb) {
  s16x4 r; asm volatile("ds_read_b64_tr_b16 %0, %1 offset:%2" : "=&v"(r) : "v"(vb), "i"(OFF) : "memory"); return r;
}
template <int D0> __device__ __forceinline__ void pv_one(f32x16& od, int vb, bf16x8 pa0, bf16x8 pa1, bf16x8 pa2, bf16x8 pa3) {
  const s16x4 l0 = tr_read<v_rd_off(D0, 0, 0)>(vb), h0 = tr_read<v_rd_off(D0, 0, 1)>(vb), l1 = tr_read<v_rd_off(D0, 1, 0)>(vb), h1 = tr_read<v_rd_off(D0, 1, 1)>(vb);
  const s16x4 l2 = tr_read<v_rd_off(D0, 2, 0)>(vb), h2 = tr_read<v_rd_off(D0, 2, 1)>(vb), l3 = tr_read<v_rd_off(D0, 3, 0)>(vb), h3 = tr_read<v_rd_off(D0, 3, 1)>(vb);
  asm volatile("s_waitcnt lgkmcnt(0)" ::: "memory"); SBAR();
#define PK(L, H) (bf16x8){L[0], L[1], L[2], L[3], H[0], H[1], H[2], H[3]}
  od = __builtin_amdgcn_mfma_f32_32x32x16_bf16(pa0, PK(l0, h0), od, 0, 0, 0);
  od = __builtin_amdgcn_mfma_f32_32x32x16_bf16(pa1, PK(l1, h1), od, 0, 0, 0);
  od = __builtin_amdgcn_mfma_f32_32x32x16_bf16(pa2, PK(l2, h2), od, 0, 0, 0);
  od = __builtin_amdgcn_mfma_f32_32x32x16_bf16(pa3, PK(l3, h3), od, 0, 0, 0);
#undef PK
}
__device__ __forceinline__ void pv_d0(f32x16* o, int vb, bf16x8 pa0, bf16x8 pa1, bf16x8 pa2, bf16x8 pa3) {
  pv_one<0>(o[0], vb, pa0, pa1, pa2, pa3); pv_one<1>(o[1], vb, pa0, pa1, pa2, pa3); pv_one<2>(o[2], vb, pa0, pa1, pa2, pa3); pv_one<3>(o[3], vb, pa0, pa1, pa2, pa3);
}

struct Unit { const bf16* Q; const bf16* K; const bf16* V; bf16* O; float* lse; long ldq, ldk, ldo; int lse_ld, kt0, nt, qoff; };
__device__ __forceinline__ void attn_unit(const Unit& u, char* lds, int wave0) {
  const int tid = opaque_tid(wave0), wid = wave0, lane = tid & 63, r32 = lane & 31, hi = lane >> 5;
  bf16* V_lds = (bf16*)lds; bf16* K_lds = (bf16*)(lds + 2 * SHM_V);
  float* ws = (float*)(lds + LDS_WS) + wid * 64; float* li_l = ws; float* al_l = ws + 32;
  const float* tabL = (const float*)(lds + LDS_TAB);
  float m_reg = -1e30f, l_reg = 0; f32x16 o[4] = {}; bf16x8 qr[8];
  const bf16* Qw = u.Q + (long)(wid * QBLK + r32) * u.ldq + hi * 8;
#pragma unroll
  for (int d0 = 0; d0 < 8; ++d0) qr[d0] = *reinterpret_cast<const bf16x8*>(Qw + d0 * 16);
  const int sr = tid >> 4, sc = (tid & 15) * 8, vst0 = v_st(sr, sc), vst1 = v_st(32 + sr, sc);
  const int vb0 = (int)(uintptr_t)V_lds + v_rd_base(lane);
  const long tstep = (long)KVBLK * u.ldk * 2;
  const char* Kh = (const char*)u.K + (long)u.kt0 * tstep; const char* Vh = (const char*)u.V + (long)u.kt0 * tstep;
  const unsigned lo0 = (unsigned)((sr * (int)u.ldk + sc) * 2), lo1 = lo0 + (unsigned)(32 * (int)u.ldk * 2);
  const float* tl0 = tabL + (4096 + u.kt0 * KVBLK + 4 * hi - (u.qoff + wid * QBLK + r32));
  struct { bf16x8 vs0, vs1, ks0, ks1; } sr_[2];
#define SLOAD(i, tj) do { const char* vt_ = Vh + (long)(tj) * tstep; const char* kt_ = Kh + (long)(tj) * tstep; \
    sr_[i].vs0 = *reinterpret_cast<const bf16x8*>(vt_ + lo0); sr_[i].vs1 = *reinterpret_cast<const bf16x8*>(vt_ + lo1); \
    sr_[i].ks0 = *reinterpret_cast<const bf16x8*>(kt_ + lo0); sr_[i].ks1 = *reinterpret_cast<const bf16x8*>(kt_ + lo1); } while (0)
#define SWRITE(b, i) do { *(bf16x8*)((char*)V_lds + (b) * SHM_V + vst0) = sr_[i].vs0;          \
    *(bf16x8*)((char*)V_lds + (b) * SHM_V + vst1) = sr_[i].vs1; int kc = sc * 2;               \
    *(bf16x8*)((char*)K_lds + (b) * SHM_K + KSWZ(sr, kc)) = sr_[i].ks0;                       \
    *(bf16x8*)((char*)K_lds + (b) * SHM_K + KSWZ(32 + sr, kc)) = sr_[i].ks1; } while (0)
#define SWAIT() asm volatile("s_waitcnt vmcnt(4)" ::: "memory")
#define RESC(a) do { if (__any((a) < 1.f)) { if (hi == 0) al_l[r32] = (a); asm volatile("s_waitcnt lgkmcnt(0)" ::: "memory"); \
    for (int d = 0; d < 4; ++d) for (int r = 0; r < 16; ++r) o[d][r] *= al_l[crow(r, hi)]; } } while (0)
  f32x16 pA0, pA1, pB0, pB1; float mnA, mnB, alA, alB; bf16x8 pa0, pa1, pa2, pa3; const int NT = u.nt;
  constexpr int SE = 0, SO = 1;
  SLOAD(SE, 0); asm volatile("s_waitcnt vmcnt(0)" ::: "memory"); SWRITE(0, SE); __syncthreads();
  qkt(pA0, pA1, K_lds, qr, r32, hi, tl0); partialSM(pA0, pA1, m_reg, mnA, alA);
  SLOAD(SO, 1); if (2 < NT) SLOAD(SE, 2);
  SWAIT(); SWRITE(1, SO); __syncthreads();
  for (int j = 1; j + 1 < NT; j += 2) {
    SBAR(); qkt(pB0, pB1, (bf16*)((char*)K_lds + SHM_K), qr, r32, hi, tl0 + j * KVBLK);
    finishSM(pA0, pA1, alA, l_reg, pa0, pa1, pa2, pa3); SBAR();
    SLOAD(SO, j + 2); SBAR();
    pv_d0(o, vb0, pa0, pa1, pa2, pa3); partialSM(pB0, pB1, m_reg, mnB, alB);
    __syncthreads(); SWAIT(); SWRITE(0, SE);
    RESC(alB); __syncthreads();
    SBAR(); qkt(pA0, pA1, K_lds, qr, r32, hi, tl0 + (j + 1) * KVBLK);
    finishSM(pB0, pB1, alB, l_reg, pa0, pa1, pa2, pa3); SBAR();
    if (j + 3 < NT) SLOAD(SE, j + 3); SBAR();
    pv_d0(o, vb0 + (int)SHM_V, pa0, pa1, pa2, pa3); partialSM(pA0, pA1, m_reg, mnA, alA);
    __syncthreads(); SWAIT(); SWRITE(1, SO);
    RESC(alA); __syncthreads();
  }
  SBAR(); qkt(pB0, pB1, (bf16*)((char*)K_lds + SHM_K), qr, r32, hi, tl0 + (NT - 1) * KVBLK);
  finishSM(pA0, pA1, alA, l_reg, pa0, pa1, pa2, pa3); SBAR();
  pv_d0(o, vb0, pa0, pa1, pa2, pa3); partialSM(pB0, pB1, m_reg, mnB, alB);
  __syncthreads(); RESC(alB);
  finishSM(pB0, pB1, alB, l_reg, pa0, pa1, pa2, pa3); SBAR();
  pv_d0(o, vb0 + (int)SHM_V, pa0, pa1, pa2, pa3);
  if (hi == 0) li_l[r32] = l_reg; asm volatile("s_waitcnt lgkmcnt(0)" ::: "memory");
  float rli[16];
#pragma unroll
  for (int r = 0; r < 16; ++r) rli[r] = __builtin_amdgcn_rcpf(li_l[crow(r, hi)]);
  bf16* Ow = u.O + (long)(wid * QBLK) * u.ldo;
#pragma unroll
  for (int r = 0; r < 16; ++r) { int orow = crow(r, hi);
#pragma unroll
    for (int d0 = 0; d0 < 4; ++d0) { const float v = o[d0][r] * rli[r]; Ow[(long)orow * u.ldo + d0 * 32 + r32] = (bf16)(cvtpk(v, v) & 0xffffu); } }
  if (u.lse != nullptr && hi == 0) u.lse[(long)(wid * QBLK + r32) * u.lse_ld] = m_reg * SCALE + __logf(l_reg);
#undef SLOAD
#undef SWRITE
#undef SWAIT
#undef RESC
}
#undef KSWZ
#undef SBAR
}

constexpr int NWAVES = 8;
constexpr size_t MiB = 1u << 20;
constexpr size_t WS_CTL = 0, CTL_ZERO_BYTES = 1 * MiB;
constexpr size_t WS_CS   = 1 * MiB;
constexpr size_t WS_SKBD = 1 * MiB + 256 * 1024;
constexpr size_t WS_TAB  = 2 * MiB;
constexpr size_t WS_LSE  = 3 * MiB;
constexpr size_t WS_WCAT = 4 * MiB, WS_WO = 12 * MiB, WS_WQ = 20 * MiB;
constexpr size_t WS_WIN  = 28 * MiB;
constexpr size_t WS_DFT  = 84 * MiB;
constexpr size_t WS_U    = 148 * MiB, WS_V = 212 * MiB;
constexpr size_t WS_H    = 276 * MiB;
constexpr size_t WS_PROJ = 340 * MiB;
constexpr size_t WS_G    = 596 * MiB;
constexpr size_t WS_ZT   = 788 * MiB;
constexpr size_t WS_OC   = 820 * MiB;
constexpr size_t WS_MG   = 884 * MiB;
constexpr size_t WS_END  = 948 * MiB;
constexpr size_t WS_Q = WS_PROJ, WS_SC = WS_PROJ + 64 * MiB, WS_IDS = WS_PROJ + 192 * MiB, WS_GATES = WS_PROJ + 200 * MiB;
constexpr int CW_BAR = 4096;
constexpr int CW_QUEUE = 16384;
constexpr int RING_BYTES = 131072, LDSCTL_OFF = RING_BYTES, MISC_OFF = LDSCTL_OFF + 320, LDS_BYTES = 147456;

#define LDS_WAIT() asm volatile("s_waitcnt lgkmcnt(0)" ::: "memory")
#define VM_WAIT() asm volatile("s_waitcnt vmcnt(0)" ::: "memory")
__device__ __forceinline__ unsigned f2bf(float f) { unsigned u = __builtin_bit_cast(unsigned, f); return (u + 0x7fffu + ((u >> 16) & 1u)) >> 16; }
__device__ __forceinline__ unsigned pk2(float lo, float hi) { return f2bf(lo) | (f2bf(hi) << 16); }
__device__ __forceinline__ float bflo(unsigned w) { return __uint_as_float(w << 16); }
__device__ __forceinline__ float bfhi(unsigned w) { return __uint_as_float(w & 0xffff0000u); }

#define XB_TMO      128
#define XB_XCNT(j)  (256  + 64 * (j))
#define XB_XSUB(j)  (1280 + 64 * (j))
#define XB_XGEN(j)  (2304 + 64 * (j))
#define XB_TOP      3328
#define XB_TOPGEN   3392
#define XCD_BAR_WORDS 3456
#define XB_SPIN_CAP (1u << 20)
__device__ __forceinline__ unsigned xb_ld(unsigned* p)              { return __hip_atomic_load(p, __ATOMIC_RELAXED, __HIP_MEMORY_SCOPE_AGENT); }
__device__ __forceinline__ unsigned xb_add(unsigned* p, unsigned v) { return __hip_atomic_fetch_add(p, v, __ATOMIC_RELAXED, __HIP_MEMORY_SCOPE_AGENT); }
__device__ __forceinline__ unsigned xb_xcc_id() { return (unsigned)__builtin_amdgcn_s_getreg((3 << 11) | 20) & 0xFu; }
#define XB_SPIN(cond, bar) do { unsigned _sp = 0; while (cond) { __builtin_amdgcn_s_sleep(1); \
    if ((++_sp & 255u) == 0u) { if (xb_ld(&(bar)[XB_TMO])) break; if (_sp > XB_SPIN_CAP) { atomicAdd(&(bar)[XB_TMO], 1u); break; } } } } while (0)
struct XcdBarrier { unsigned* bar; unsigned x; volatile LAS unsigned* st; };
__device__ __forceinline__ XcdBarrier xcd_barrier_post(unsigned* bar, volatile LAS unsigned* st) {
    XcdBarrier b; b.bar = bar; b.x = xb_xcc_id(); b.st = st;
    if (threadIdx.x == 0) (void)xb_add(&bar[XB_XCNT(b.x)], 1u);
    return b;
}
__device__ __forceinline__ void xcd_barrier_complete(unsigned* bar, unsigned x, unsigned& nloc, unsigned& nx) {
    const unsigned G = gridDim.x * gridDim.y * gridDim.z;
    unsigned sum, cnt, mine, sp = 0u;
    for (;;) {
        sum = 0u; cnt = 0u; mine = 0u;
#pragma unroll
        for (unsigned j = 0; j < 16; ++j) { const unsigned c = xb_ld(&bar[XB_XCNT(j)]); sum += c; cnt += (c > 0u) ? 1u : 0u; mine = (j == x) ? c : mine; }
        if (sum == G) break;
        __builtin_amdgcn_s_sleep(1);
        if ((++sp & 255u) == 0u) { if (xb_ld(&bar[XB_TMO])) break; if (sp > XB_SPIN_CAP) { atomicAdd(&bar[XB_TMO], 1u); break; } }
    }
    nloc = mine > 0u ? mine : 1u; nx = cnt > 0u ? cnt : 1u;
}
__device__ __forceinline__ void xcd_barrier(const XcdBarrier& b) {
    asm volatile("s_waitcnt vmcnt(0)" ::: "memory");
    __syncthreads();
    if (threadIdx.x == 0) {
        unsigned* bar = b.bar;
        __builtin_amdgcn_s_waitcnt(0);
        unsigned nloc = b.st[0], nx = b.st[1];
        if (nloc == 0u) { xcd_barrier_complete(bar, b.x, nloc, nx); b.st[0] = nloc; b.st[1] = nx; }
        const unsigned old = xb_add(&bar[XB_XSUB(b.x)], 1u);
        const unsigned gen = old / nloc;
        if (old + 1u == (gen + 1u) * nloc) {
            __builtin_amdgcn_fence(__ATOMIC_RELEASE, "agent");
            asm volatile("s_waitcnt vmcnt(0)" ::: "memory");
            const unsigned og = xb_add(&bar[XB_TOP], 1u);
            const unsigned tg = og / nx;
            if (og + 1u == (tg + 1u) * nx) xb_add(&bar[XB_TOPGEN], 1u);
            else XB_SPIN(xb_ld(&bar[XB_TOPGEN]) == tg, bar);
            __builtin_amdgcn_fence(__ATOMIC_ACQUIRE, "agent");
            xb_add(&bar[XB_XGEN(b.x)], 1u);
            asm volatile("s_waitcnt vmcnt(0)" ::: "memory");
        } else {
            XB_SPIN(xb_ld(&bar[XB_XGEN(b.x)]) == gen, bar);
            __builtin_amdgcn_fence(__ATOMIC_ACQUIRE, "agent");
            asm volatile("s_waitcnt vmcnt(0)" ::: "memory");
        }
    }
    __syncthreads();
}

template <int MASK> __device__ __forceinline__ int sx_i(int v) { return __builtin_amdgcn_ds_swizzle(v, 0x1f | (MASK << 10)); }
template <int MASK> __device__ __forceinline__ float sx_f(float v) { return __int_as_float(sx_i<MASK>(__float_as_int(v))); }
__device__ __forceinline__ float add32(float v) { auto rr = __builtin_amdgcn_permlane32_swap(__float_as_uint(v), __float_as_uint(v), false, false); return __uint_as_float(rr[0]) + __uint_as_float(rr[1]); }
__device__ __forceinline__ unsigned max32(unsigned v) { auto rr = __builtin_amdgcn_permlane32_swap(v, v, false, false); return rr[0] > rr[1] ? rr[0] : rr[1]; }
__device__ __forceinline__ float other32(float v, bool upper) { auto rr = __builtin_amdgcn_permlane32_swap(__float_as_uint(v), __float_as_uint(v), false, false); return __uint_as_float(upper ? rr[0] : rr[1]); }
__device__ __forceinline__ float bperm_f(float v, int src_lane) { return __int_as_float(__builtin_amdgcn_ds_bpermute(src_lane * 4, __float_as_int(v))); }
__device__ __forceinline__ int bperm_i(int v, int src_lane) { return __builtin_amdgcn_ds_bpermute(src_lane * 4, v); }
__device__ __forceinline__ float wave_sum(float v) {
    v += sx_f<1>(v); v += sx_f<2>(v); v += sx_f<4>(v); v += sx_f<8>(v); v += sx_f<16>(v); return add32(v);
}
__device__ __forceinline__ unsigned umax(unsigned a, unsigned b) { return a > b ? a : b; }
__device__ __forceinline__ unsigned wave_max_u32(unsigned v) {
    v = umax(v, (unsigned)sx_i<1>((int)v)); v = umax(v, (unsigned)sx_i<2>((int)v)); v = umax(v, (unsigned)sx_i<4>((int)v)); v = umax(v, (unsigned)sx_i<8>((int)v)); v = umax(v, (unsigned)sx_i<16>((int)v)); return max32(v);
}
template <int CTRL, int RMASK> __device__ __forceinline__ unsigned dpp_max_u(unsigned v) { const unsigned t = (unsigned)__builtin_amdgcn_update_dpp((int)v, (int)v, CTRL, RMASK, 0xF, false); return t > v ? t : v; }
__device__ __forceinline__ unsigned wave_max_dpp(unsigned v) {
    v = dpp_max_u<0xB1, 0xF>(v); v = dpp_max_u<0x4E, 0xF>(v); v = dpp_max_u<0x141, 0xF>(v); v = dpp_max_u<0x140, 0xF>(v); v = dpp_max_u<0x142, 0xA>(v); v = dpp_max_u<0x143, 0xC>(v);
    return (unsigned)__builtin_amdgcn_readlane((int)v, 63);
}
__device__ __forceinline__ unsigned okey(float f) { const unsigned u = __float_as_uint(f); return (u & 0x80000000u) ? ~u : (u | 0x80000000u); }

__device__ __forceinline__ void transpose_item(const float* W, int N, bf16* WT, int ldo, int col_off, LAS float* scr, int item, int lane) {
    const int nblk = N / 32, kb = item / nblk, nb = item % nblk, k0 = 64 * kb, n0 = 32 * nb;
#pragma unroll 8
    for (int i = 0; i < 32; ++i) { const int kk = 2 * i + (lane >> 5); scr[kk * 33 + (lane & 31)] = W[(size_t)(k0 + kk) * N + n0 + (lane & 31)]; }
    LDS_WAIT(); asm volatile("" ::: "memory");
    const int c = lane & 7;
#pragma unroll
    for (int j = 0; j < 4; ++j) { const int n = (lane >> 3) + 8 * j; const LAS float* s = scr + (8 * c) * 33 + n;
        v4u o; o.x = pk2(s[0 * 33], s[1 * 33]); o.y = pk2(s[2 * 33], s[3 * 33]); o.z = pk2(s[4 * 33], s[5 * 33]); o.w = pk2(s[6 * 33], s[7 * 33]);
        *(GAS v4u*)(WT + (size_t)(n0 + n) * ldo + col_off + k0 + 8 * c) = o; }
    LDS_WAIT(); asm volatile("" ::: "memory");
}
__device__ __forceinline__ void rms_row_to_bf16(const float* xrow, const float* g, bf16* orow, int lane) {
    const GAS f32x4* xr = (const GAS f32x4*)xrow + lane; const GAS f32x4* gr = (const GAS f32x4*)g + lane;
    f32x4 v[8]; float s = 0.f;
#pragma unroll
    for (int j = 0; j < 8; ++j) { v[j] = xr[64 * j]; s += (v[j].x * v[j].x + v[j].y * v[j].y) + (v[j].z * v[j].z + v[j].w * v[j].w); }
    const float rstd = 1.0f / sqrtf(wave_sum(s) * (1.f / DM) + RMS_EPS);
    GAS unsigned long long* o8 = (GAS unsigned long long*)orow + lane;
#pragma unroll
    for (int j = 0; j < 8; ++j) { const f32x4 gg = gr[64 * j]; o8[64 * j] = (unsigned long long)pk2(v[j].x * rstd * gg.x, v[j].y * rstd * gg.y) | ((unsigned long long)pk2(v[j].z * rstd * gg.z, v[j].w * rstd * gg.w) << 32); }
}
typedef __bf16 bf2_t __attribute__((ext_vector_type(2)));
__device__ __forceinline__ float DOT2(unsigned a, unsigned b, float c) { return __builtin_amdgcn_fdot2_f32_bf16(__builtin_bit_cast(bf2_t, a), __builtin_bit_cast(bf2_t, b), c, false); }
__device__ __forceinline__ int rel_bucket(int rel) {
    const int n = rel < 0 ? -rel : rel;
    int b = n;
    if (n >= 8) { b = 5 + (31 - __builtin_clz((unsigned)n)); if (b > 15) b = 15; }
    return b + (rel > 0 ? 16 : 0);
}

#ifndef PH_D1
#define PH_D1 1
#endif
#ifndef PH_D2
#define PH_D2 1
#endif
#ifndef PH_A
#define PH_A 1
#endif
#ifndef PH_B
#define PH_B 1
#endif
#ifndef PH_C
#define PH_C 1
#endif
#ifndef PH_D
#define PH_D 1
#endif
#ifndef PH_E
#define PH_E 1
#endif
#ifndef PH_F
#define PH_F 1
#endif
#ifndef PH_G
#define PH_G 1
#endif
#ifndef PH_H
#define PH_H 1
#endif
#ifndef PH_I
#define PH_I 1
#endif
#ifndef PH_J
#define PH_J 1
#endif
#ifndef PH_K
#define PH_K 1
#endif
#ifndef PH_L
#define PH_L 1
#endif
struct Args { const float* in[17]; float* out; unsigned char* ws; };

#define CAS __attribute__((address_space(4)))
__device__ __forceinline__ const void* karg(int k) { const CAS char* ka = (const CAS char*)__builtin_amdgcn_kernarg_segment_ptr(); asm volatile("" : "+s"(ka)); return *(const void* const CAS*)(ka + 8 * k); }
#define WSP(T, off) ((T*)((unsigned char*)karg(18) + (off)))
#define INP(k) ((const float*)karg(k))
#define INL(k, stride) (INP(k) + (size_t)layer * (size_t)(stride))
#define X ((float*)karg(17))
__global__ void __launch_bounds__(NWAVES * 64, 2) mk_fwd(Args args_unused) {
    extern __shared__ __attribute__((aligned(16))) unsigned char lds[];
    LAS unsigned char* ldsl = (LAS unsigned char*)lds;
    volatile LAS unsigned* MISC = (volatile LAS unsigned*)(ldsl + MISC_OFF);
    const int wave0 = __builtin_amdgcn_readfirstlane((int)threadIdx.x >> 6);
    const int G = gridDim.x; const int bx = blockIdx.x; const int vcu = (G % 8 == 0) ? (bx % 8) * (G / 8) + bx / 8 : bx;
    const int NGW = G * NWAVES, NGT = NGW * 64;
#define PH_IDS() const int tid = opaque_tid(wave0), lane = tid & 63, wave = wave0, gw = vcu * NWAVES + wave, gt = gw * 64 + lane; (void)gt; (void)gw; (void)lane
    gu32* ctl = (gu32*)WSP(unsigned char, WS_CTL);
    for (int u = threadIdx.x; u < (LDS_BYTES - LDSCTL_OFF) / 4; u += NWAVES * 64) ((LAS unsigned*)(ldsl + LDSCTL_OFF))[u] = 0u;
    __syncthreads();
    XcdBarrier bar = xcd_barrier_post((unsigned*)(ctl + CW_BAR), MISC + 8);
#define GRID_BAR() xcd_barrier(bar)

    for (int layer = 0; layer < 2; ++layer) {

#if PH_A
        {
            PH_IDS();
            LAS float* scr = (LAS float*)(ldsl + wave * 16384);
            const float* w_in = INL(4, (size_t)DM * INW); const float* w_up_a = INL(6, 512 * DM); const float* w_up_b = INL(7, 512 * DM); const float* w_up_c = INL(8, 1024 * DM);
            const float* w_o = INL(11, DM * DM); const float* wq = INL(13, DM * DM); const float* subk = INL(14, 2 * 128 * 128);
            const float* pu = INL(15, (size_t)NEXP * DM); const float* pv = INL(16, (size_t)NEXP * DM); const float* mix_g = INL(3, DM); const float* rel_bias = INP(1);
            bf16* WIN = WSP(bf16, WS_WIN); bf16* WCAT = WSP(bf16, WS_WCAT); bf16* WO = WSP(bf16, WS_WO); bf16* WQ = WSP(bf16, WS_WQ); bf16* UB = WSP(bf16, WS_U); bf16* VB = WSP(bf16, WS_V);
            bf16* SKBD = WSP(bf16, WS_SKBD); bf16* H = WSP(bf16, WS_H); bf16* DFT = WSP(bf16, WS_DFT); bf16* CS = WSP(bf16, WS_CS); float* TAB = WSP(float, WS_TAB);
            constexpr int I_IN = (DM / 64) * (INW / 32), I_A = (512 / 64) * (DM / 32), I_C = (1024 / 64) * (DM / 32), I_SQ = (DM / 64) * (DM / 32);
            constexpr int NITEMS = I_IN + 2 * I_A + I_C + 2 * I_SQ;
            for (int it = gw; it < NITEMS; it += NGW) {
                int r = it;
                if (r < I_IN) { transpose_item(w_in, INW, WIN, DM, 0, scr, r, lane); continue; } r -= I_IN;
                if (r < I_A) { transpose_item(w_up_a, DM, WCAT, DM, 0, scr, r, lane); continue; } r -= I_A;
                if (r < I_A) { transpose_item(w_up_b, DM, WCAT, DM, 512, scr, r, lane); continue; } r -= I_A;
                if (r < I_C) { transpose_item(w_up_c, DM, WCAT, DM, 1024, scr, r, lane); continue; } r -= I_C;
                if (r < I_SQ) { transpose_item(w_o, DM, WO, DM, 0, scr, r, lane); continue; } r -= I_SQ;
                transpose_item(wq, DM, WQ, DM, 0, scr, r, lane);
            }
            for (size_t i = (size_t)gt; i < (size_t)NEXP * DM / 8; i += (size_t)NGT) {
                { const f32x4 a = ((const GAS f32x4*)pu)[2 * i], b = ((const GAS f32x4*)pu)[2 * i + 1]; v4u o; o.x = pk2(a.x, a.y); o.y = pk2(a.z, a.w); o.z = pk2(b.x, b.y); o.w = pk2(b.z, b.w); ((GAS v4u*)UB)[i] = o; }
                { const f32x4 a = ((const GAS f32x4*)pv)[2 * i], b = ((const GAS f32x4*)pv)[2 * i + 1]; v4u o; o.x = pk2(a.x, a.y); o.y = pk2(a.z, a.w); o.z = pk2(b.x, b.y); o.w = pk2(b.z, b.w); ((GAS v4u*)VB)[i] = o; }
            }
            for (int i = gt; i < 65536; i += NGT) { const int n = i >> 8, kk = i & 255, p = n >> 7; SKBD[i] = ((kk >> 7) == p) ? (bf16)f2bf(subk[(size_t)(p * 128 + (n & 127)) * 128 + (kk & 127)]) : (bf16)0; }
            for (int m = gw; m < MTOK; m += NGW) rms_row_to_bf16((layer == 0 ? INP(0) : (const float*)X) + (size_t)m * DM, mix_g, H + (size_t)m * DM, lane);
            if (layer == 0) {
                for (size_t i = (size_t)gt; i < (size_t)4096 * 8192 / 8; i += (size_t)NGT) {
                    const int sp = (int)(i >> 10), k0 = (int)(i & 1023) * 8, part = k0 >> 12, s0 = k0 & 4095; float v[8];
#pragma unroll
                    for (int j = 0; j < 8; ++j) { const float ang = (float)(((s0 + j) * sp) & 4095) * (1.f / 4096.f); v[j] = (part ? -__builtin_amdgcn_sinf(ang) : __builtin_amdgcn_cosf(ang)) * (1.f / 64.f); }
                    v4u o; o.x = pk2(v[0], v[1]); o.y = pk2(v[2], v[3]); o.z = pk2(v[4], v[5]); o.w = pk2(v[6], v[7]); ((GAS v4u*)DFT)[i] = o;
                }
                for (int i = gt; i < 65536; i += NGT) { const int r = i >> 8, c = i & 255, part = r >> 7, cp = r & 127; float v = 0.f;
                    if (c < 128) { const float ang = (float)((c * cp) & 127) * (1.f / 128.f); v = (part ? __builtin_amdgcn_sinf(ang) : __builtin_amdgcn_cosf(ang)) * 0.08838834764831845f; }
                    CS[i] = (bf16)f2bf(v); }
                for (int i = gt; i < 16 * 8192; i += NGT) { const int hd = i >> 13, off = (i & 8191) - 4096; float v;
                    if (hd < 12) { const int g = hd >> 2, dil = g == 0 ? 1 : (g == 1 ? 4 : 16); v = (off >= -64 && off <= 64) ? rel_bias[rel_bucket(off * dil) * 16 + hd] * 11.313708498984761f : -1.0e5f; }
                    else v = rel_bias[rel_bucket(off) * 16 + hd] * 11.313708498984761f;
                    TAB[i] = v; }
            }
        }
#endif
        GRID_BAR();

#if PH_B
        {
            pg8::Gemm g{WSP(bf16, WS_H), WSP(bf16, WS_WIN)}; pg8::StaticOrder S; S.init(MTOK, INW, G, bx, DM, DM);
            pg8::EpiProj E{WSP(bf16, WS_PROJ), WSP(bf16, WS_G), INL(5, GTW)};
            pg8::gemm_phase<pg8::EpiProj, pg8::StaticOrder, true, DM, DM, DM>(ldsl, g, S, E, wave0);
        }
#endif
        GRID_BAR();

#if PH_C
        {
            pg8::Gemm g{WSP(bf16, WS_CS), WSP(bf16, WS_PROJ)}; pg8::F1Order S{G, bx};
            pg8::EpiZT E{WSP(bf16, WS_ZT)};
            pg8::gemm_phase<pg8::EpiZT, pg8::F1Order, false, 256, PJW, 256>(ldsl, g, S, E, wave0);
        }
#endif
        GRID_BAR();

#if PH_D
#if PH_D1
        {
            pg8::Gemm g{WSP(bf16, WS_DFT), WSP(bf16, WS_ZT)}; pg8::F2Order S; S.init(4096, 2048, G, bx, 8192, 8192);
            pg8::EpiStore E{WSP(bf16, WS_OC), DM};
            pg8::gemm_phase<pg8::EpiStore, pg8::F2Order, false, 8192, 8192, 8192>(ldsl, g, S, E, wave0);
        }
#endif
#if PH_D2
        {
            PH_IDS();
            gu32* qhead = ctl + CW_QUEUE + 64 * layer;
            bf16* PROJ = WSP(bf16, WS_PROJ); bf16* DO = WSP(bf16, WS_MG); bf16* DL = WSP(bf16, WS_H); float* LSE = WSP(float, WS_LSE); const float* TAB = WSP(float, WS_TAB);
            const float* cur_tab = nullptr;
            for (;;) {
                __syncthreads();
                if (tid == 0) MISC[0] = __hip_atomic_fetch_add(qhead, 1u, __ATOMIC_RELAXED, __HIP_MEMORY_SCOPE_AGENT);
                __syncthreads();
                const int ui = __builtin_amdgcn_readfirstlane((int)MISC[0]);
                if (ui >= 1792) break;
                attn::Unit u; int hd;
                if (ui < 1024) {
                    const int qb = ui & 15, vh = (ui >> 4) & 1, m = (ui >> 5) & 1, h = (ui >> 6) & 3, b = ui >> 8;
                    const bf16* base = PROJ + (size_t)b * SEQ * PJW;
                    u.Q = base + (size_t)(qb * 256) * PJW + COL_DIFF + (h * 2 + m) * 128; u.K = base + COL_DIFF + 1024 + (h * 2 + m) * 128; u.V = base + COL_DIFF + 2048 + h * 256 + vh * 128;
                    u.O = DO + (size_t)(b * SEQ + qb * 256) * DM + (h * 2 + m) * 256 + vh * 128; u.lse = nullptr; u.ldq = PJW; u.ldk = PJW; u.ldo = DM; u.lse_ld = 0;
                    u.kt0 = 0; u.nt = SEQ / 64; u.qoff = qb * 256; hd = 12 + h;
                } else {
                    const int v = ui - 1024, qb16 = v & 15, hh = (v >> 4) & 3, bg = v >> 6, g = bg % 3, b = bg / 3;
                    const int dil = g == 0 ? 1 : (g == 1 ? 4 : 16), bpc = 16 / dil, r = qb16 / bpc, qblk = qb16 % bpc, q0 = qblk * 256, ntot = (SEQ / dil) / 64;
                    int kt0 = q0 / 64 - 1; if (kt0 < 0) kt0 = 0; int kt1 = q0 / 64 + 5; if (kt1 > ntot) kt1 = ntot;
                    if ((kt1 - kt0) & 1) { if (kt0 > 0) --kt0; else ++kt1; }
                    const bf16* base = PROJ + (size_t)(b * SEQ + r) * PJW + COL_DIL + g * 512 + hh * 128;
                    u.Q = base + (size_t)q0 * dil * PJW; u.K = base + 1536; u.V = base + 3072;
                    u.O = DL + ((size_t)g * MTOK + b * SEQ + r + (size_t)q0 * dil) * 512 + hh * 128; u.lse = LSE + ((size_t)g * MTOK + b * SEQ + r + (size_t)q0 * dil) * 4 + hh;
                    u.ldq = (long)PJW * dil; u.ldk = (long)PJW * dil; u.ldo = 512L * dil; u.lse_ld = 4 * dil; u.kt0 = kt0; u.nt = kt1 - kt0; u.qoff = q0; hd = g * 4 + hh;
                }
                const float* tab = TAB + (size_t)hd * 8192;
                if (tab != cur_tab) {
                    cur_tab = tab;
                    LAS f32x4* tl = (LAS f32x4*)(ldsl + attn::LDS_TAB); const int t2 = opaque_tid(wave0);
#pragma unroll
                    for (int j = 0; j < 4; ++j) tl[t2 + 512 * j] = ((const GAS f32x4*)tab)[t2 + 512 * j];
                }
                attn::attn_unit(u, (char*)lds, wave0);
            }
        }
#endif
#endif
        GRID_BAR();

#if PH_E
        {
            PH_IDS();
            const float* dlam = INL(9, 512); const float* subln = INL(10, 256); const float lambda_init = layer == 0 ? 0.2f : 0.35550906759f;
            const float* LSE = WSP(float, WS_LSE); const bf16* DL = WSP(bf16, WS_H); const bf16* DO = WSP(bf16, WS_MG); bf16* OC = WSP(bf16, WS_OC);
            float s1 = dlam[lane] * dlam[128 + lane] + dlam[64 + lane] * dlam[192 + lane], s2 = dlam[256 + lane] * dlam[384 + lane] + dlam[320 + lane] * dlam[448 + lane];
            s1 = wave_sum(s1); s2 = wave_sum(s2);
            const float lam = __expf(s1) - __expf(s2) + lambda_init, osc = 1.0f - lambda_init;
            const int hq = lane >> 4, l16 = lane & 15;
            for (int t = gw; t < MTOK; t += NGW) {
                float ls[3], mx = -3e38f;
#pragma unroll
                for (int g = 0; g < 3; ++g) { ls[g] = LSE[((size_t)g * MTOK + t) * 4 + hq]; mx = fmaxf(mx, ls[g]); }
                float wsum = 0.f;
#pragma unroll
                for (int g = 0; g < 3; ++g) { ls[g] = __expf(ls[g] - mx); wsum += ls[g]; }
                const float winv = 1.0f / wsum; float acc8[8] = {0.f, 0.f, 0.f, 0.f, 0.f, 0.f, 0.f, 0.f};
#pragma unroll
                for (int g = 0; g < 3; ++g) { const v4u o = *(const GAS v4u*)(DL + ((size_t)g * MTOK + t) * 512 + lane * 8); const float w = ls[g] * winv;
                    acc8[0] += w * bflo(o.x); acc8[1] += w * bfhi(o.x); acc8[2] += w * bflo(o.y); acc8[3] += w * bfhi(o.y); acc8[4] += w * bflo(o.z); acc8[5] += w * bfhi(o.z); acc8[6] += w * bflo(o.w); acc8[7] += w * bfhi(o.w); }
#if defined(DBG_ZERO_OB)
                for (int j = 0; j < 8; ++j) acc8[j] = 0.f;
#endif
                { v4u o; o.x = pk2(acc8[0], acc8[1]); o.y = pk2(acc8[2], acc8[3]); o.z = pk2(acc8[4], acc8[5]); o.w = pk2(acc8[6], acc8[7]); *(GAS v4u*)(OC + (size_t)t * DM + 512 + lane * 8) = o; }
                const bf16* dp = DO + (size_t)t * DM + hq * 512 + l16 * 16;
                const v4u a0 = *(const GAS v4u*)(dp), a1 = *(const GAS v4u*)(dp + 8), b0 = *(const GAS v4u*)(dp + 256), b1 = *(const GAS v4u*)(dp + 264);
                float d[16];
                d[0] = bflo(a0.x) - lam * bflo(b0.x); d[1] = bfhi(a0.x) - lam * bfhi(b0.x); d[2] = bflo(a0.y) - lam * bflo(b0.y); d[3] = bfhi(a0.y) - lam * bfhi(b0.y);
                d[4] = bflo(a0.z) - lam * bflo(b0.z); d[5] = bfhi(a0.z) - lam * bfhi(b0.z); d[6] = bflo(a0.w) - lam * bflo(b0.w); d[7] = bfhi(a0.w) - lam * bfhi(b0.w);
                d[8] = bflo(a1.x) - lam * bflo(b1.x); d[9] = bfhi(a1.x) - lam * bfhi(b1.x); d[10] = bflo(a1.y) - lam * bflo(b1.y); d[11] = bfhi(a1.y) - lam * bfhi(b1.y);
                d[12] = bflo(a1.z) - lam * bflo(b1.z); d[13] = bfhi(a1.z) - lam * bfhi(b1.z); d[14] = bflo(a1.w) - lam * bflo(b1.w); d[15] = bfhi(a1.w) - lam * bfhi(b1.w);
                float ss = 0.f;
#pragma unroll
                for (int j = 0; j < 16; ++j) ss += d[j] * d[j];
                ss += sx_f<1>(ss); ss += sx_f<2>(ss); ss += sx_f<4>(ss); ss += sx_f<8>(ss);
                const float rs = osc / sqrtf(ss * (1.f / 256.f) + RMS_EPS);
                const f32x4 g0 = *(const GAS f32x4*)(subln + l16 * 16), g1 = *(const GAS f32x4*)(subln + l16 * 16 + 4), g2 = *(const GAS f32x4*)(subln + l16 * 16 + 8), g3 = *(const GAS f32x4*)(subln + l16 * 16 + 12);
                v4u o0, o1;
                o0.x = pk2(d[0] * rs * g0.x, d[1] * rs * g0.y); o0.y = pk2(d[2] * rs * g0.z, d[3] * rs * g0.w); o0.z = pk2(d[4] * rs * g1.x, d[5] * rs * g1.y); o0.w = pk2(d[6] * rs * g1.z, d[7] * rs * g1.w);
                o1.x = pk2(d[8] * rs * g2.x, d[9] * rs * g2.y); o1.y = pk2(d[10] * rs * g2.z, d[11] * rs * g2.w); o1.z = pk2(d[12] * rs * g3.x, d[13] * rs * g3.y); o1.w = pk2(d[14] * rs * g3.z, d[15] * rs * g3.w);
                bf16* op = OC + (size_t)t * DM + 1024 + hq * 256 + l16 * 16;
                *(GAS v4u*)(op) = o0; *(GAS v4u*)(op + 8) = o1;
            }
        }
#endif
        GRID_BAR();

#if PH_F
        {
            pg8::StaticOrder S; S.init(MTOK, DM, G, bx, DM, DM);
            { pg8::Gemm g{WSP(bf16, WS_OC), WSP(bf16, WS_WCAT)}; pg8::EpiMerge3 E{WSP(bf16, WS_G), WSP(bf16, WS_MG), 0}; pg8::gemm_phase<pg8::EpiMerge3, pg8::StaticOrder, true, DM, DM, 512>(ldsl, g, S, E, wave0); }
            { pg8::Gemm g{WSP(bf16, WS_OC) + 512, WSP(bf16, WS_WCAT) + 512}; pg8::EpiMerge3 E{WSP(bf16, WS_G), WSP(bf16, WS_MG), 1}; pg8::gemm_phase<pg8::EpiMerge3, pg8::StaticOrder, true, DM, DM, 512>(ldsl, g, S, E, wave0); }
            { pg8::Gemm g{WSP(bf16, WS_OC) + 1024, WSP(bf16, WS_WCAT) + 1024}; pg8::EpiMerge3 E{WSP(bf16, WS_G), WSP(bf16, WS_MG), 2}; pg8::gemm_phase<pg8::EpiMerge3, pg8::StaticOrder, true, DM, DM, 1024>(ldsl, g, S, E, wave0); }
        }
#endif
        GRID_BAR();

#if PH_G
        {
            pg8::Gemm g{WSP(bf16, WS_MG), WSP(bf16, WS_WO)}; pg8::StaticOrder S; S.init(MTOK, DM, G, bx, DM, DM);
            pg8::EpiResF32 E{layer == 0 ? INP(0) : (const float*)X, X, DM};
            pg8::gemm_phase<pg8::EpiResF32, pg8::StaticOrder, true, DM, DM, DM>(ldsl, g, S, E, wave0);
        }
#endif
        GRID_BAR();

#if PH_H
        { PH_IDS(); const float* ffn_g = INL(12, DM); bf16* H = WSP(bf16, WS_H);
          for (int m = gw; m < MTOK; m += NGW) rms_row_to_bf16(X + (size_t)m * DM, ffn_g, H + (size_t)m * DM, lane); }
#endif
        GRID_BAR();

#if PH_I
        {
            pg8::Gemm g{WSP(bf16, WS_H), WSP(bf16, WS_WQ)}; pg8::StaticOrder S; S.init(MTOK, DM, G, bx, DM, DM);
            pg8::EpiStore E{WSP(bf16, WS_Q), DM};
            pg8::gemm_phase<pg8::EpiStore, pg8::StaticOrder, true, DM, DM, DM>(ldsl, g, S, E, wave0);
        }
#endif
        GRID_BAR();

#if PH_J
        {
            pg8::Gemm g{WSP(bf16, WS_Q), WSP(bf16, WS_SKBD)}; pg8::StaticOrder S; S.init(MTOK * 8, 256, G, bx, 256, 256);
            pg8::EpiResF32 E{nullptr, WSP(float, WS_SC), 256};
            pg8::gemm_phase<pg8::EpiResF32, pg8::StaticOrder, true, 256, 256, 256>(ldsl, g, S, E, wave0);
        }
#endif
        GRID_BAR();

#if PH_K
        {
            PH_IDS();
            const float* SC = WSP(float, WS_SC); int* IDS = WSP(int, WS_IDS); float* GATES = WSP(float, WS_GATES);
            int ci = -1, cj = 0; { int c = lane; for (int i = 0; i < 16; ++i) { const int cnt = 16 / (i + 1); if (ci < 0) { if (c < cnt) { ci = i; cj = c; } else c -= cnt; } } }
            for (int row = gw; row < MTOK * 8; row += NGW) {
                const float* sc = SC + (size_t)row * 256;
                const float s0 = sc[lane], s1 = sc[64 + lane], s2 = sc[128 + lane], s3 = sc[192 + lane];
                unsigned k0 = (okey(s0) & ~127u) | (unsigned)(127 - lane), k1 = (okey(s1) & ~127u) | (unsigned)(63 - lane);
                unsigned k2 = (okey(s2) & ~127u) | (unsigned)(127 - lane), k3 = (okey(s3) & ~127u) | (unsigned)(63 - lane);
                unsigned ta = 0u, tb = 0u;
                for (int r = 0; r < 16; ++r) {
                    const unsigned ma = wave_max_dpp(k0 > k1 ? k0 : k1), mb = wave_max_dpp(k2 > k3 ? k2 : k3);
                    if (k0 == ma) k0 = 0u; if (k1 == ma) k1 = 0u; if (k2 == mb) k2 = 0u; if (k3 == mb) k3 = 0u;
                    if (lane == r) { ta = ma; tb = mb; }
                }
                const int ia = 127 - (int)(ta & 127u), ib = 127 - (int)(tb & 127u);
                const float va = sc[ia], vb = sc[128 + ib];
                const float cs = bperm_f(va, ci < 0 ? 0 : ci) + bperm_f(vb, cj);
                unsigned ck = ci < 0 ? 0u : ((okey(cs) & ~255u) | (unsigned)(255 - (ci * 16 + cj)));
                unsigned tw = 0u;
                for (int r = 0; r < 16; ++r) { const unsigned mm = wave_max_dpp(ck); if (ck == mm) ck = 0u; if (lane == r) tw = mm; }
                const int code = 255 - (int)(tw & 255u), wi = (code >> 4) & 15, wj = code & 15;
                const float bs = bperm_f(va, wi) + bperm_f(vb, wj);
                const int eid = bperm_i(ia, wi) * 128 + bperm_i(ib, wj);
                float mx = lane < 16 ? bs : -3e38f;
                mx = fmaxf(mx, sx_f<8>(mx)); mx = fmaxf(mx, sx_f<4>(mx)); mx = fmaxf(mx, sx_f<2>(mx)); mx = fmaxf(mx, sx_f<1>(mx));
                const float e = lane < 16 ? __expf(bs - mx) : 0.f; float es = e;
                es += sx_f<8>(es); es += sx_f<4>(es); es += sx_f<2>(es); es += sx_f<1>(es);
                if (lane < 16) { IDS[(size_t)row * 16 + lane] = eid; GATES[(size_t)row * 16 + lane] = e / es; }
            }
        }
#endif
        GRID_BAR();

#if PH_L
        {
            PH_IDS();
            const bf16* H = WSP(bf16, WS_H); const bf16* UB = WSP(bf16, WS_U); const bf16* VB = WSP(bf16, WS_V); const int* IDS = WSP(int, WS_IDS); const float* GATES = WSP(float, WS_GATES);
            for (int t = gw; t < MTOK; t += NGW) {
                const GAS v4u* hp = (const GAS v4u*)(H + (size_t)t * DM) + lane;
                v4u hq4[4];
#pragma unroll
                for (int c = 0; c < 4; ++c) hq4[c] = hp[64 * c];
                const int id0 = IDS[(size_t)t * 128 + lane], id1 = IDS[(size_t)t * 128 + 64 + lane];
                const float gt0 = GATES[(size_t)t * 128 + lane], gt1 = GATES[(size_t)t * 128 + 64 + lane];
                float pre0 = 0.f, pre1 = 0.f;
                for (int half = 0; half < 2; ++half) {
                    const int idr = half ? id1 : id0; float prer = 0.f;
                    for (int e4 = 0; e4 < 64; e4 += 4) {
                        float p[4];
#pragma unroll
                        for (int x = 0; x < 4; ++x) {
                            const int id = __builtin_amdgcn_readlane(idr, e4 + x);
                            const GAS v4u* rp = (const GAS v4u*)(UB + (size_t)id * DM) + lane;
                            const v4u a0 = rp[0], a1 = rp[64], a2 = rp[128], a3 = rp[192];
                            float s = 0.f;
                            s = DOT2(hq4[0].x, a0.x, s); s = DOT2(hq4[0].y, a0.y, s); s = DOT2(hq4[0].z, a0.z, s); s = DOT2(hq4[0].w, a0.w, s);
                            s = DOT2(hq4[1].x, a1.x, s); s = DOT2(hq4[1].y, a1.y, s); s = DOT2(hq4[1].z, a1.z, s); s = DOT2(hq4[1].w, a1.w, s);
                            s = DOT2(hq4[2].x, a2.x, s); s = DOT2(hq4[2].y, a2.y, s); s = DOT2(hq4[2].z, a2.z, s); s = DOT2(hq4[2].w, a2.w, s);
                            s = DOT2(hq4[3].x, a3.x, s); s = DOT2(hq4[3].y, a3.y, s); s = DOT2(hq4[3].z, a3.z, s); s = DOT2(hq4[3].w, a3.w, s);
                            p[x] = s;
                        }
                        const bool up = lane >= 32;
                        float kA = up ? p[2] : p[0], kB = up ? p[3] : p[1];
                        kA += other32(up ? p[0] : p[2], up); kB += other32(up ? p[1] : p[3], up);
                        const bool up2 = (lane & 16) != 0;
                        float k2 = up2 ? kB : kA; k2 += sx_f<16>(up2 ? kA : kB);
                        k2 += sx_f<8>(k2); k2 += sx_f<4>(k2); k2 += sx_f<2>(k2); k2 += sx_f<1>(k2);
                        const float dv = bperm_f(k2, 16 * (lane & 3));
                        if ((lane & ~3) == e4) prer = dv;
                    }
                    if (half) pre1 = prer; else pre0 = prer;
                }
                const float ac0 = 0.5f * pre0 * (1.0f + erff(pre0 * 0.70710678118654752f)) * gt0, ac1 = 0.5f * pre1 * (1.0f + erff(pre1 * 0.70710678118654752f)) * gt1;
                float oacc[32];
#pragma unroll
                for (int j = 0; j < 32; ++j) oacc[j] = 0.f;
                for (int half = 0; half < 2; ++half) {
                    const int idr = half ? id1 : id0; const float acr = half ? ac1 : ac0;
                    for (int e4 = 0; e4 < 64; e4 += 4) {
#pragma unroll
                        for (int x = 0; x < 4; ++x) {
                            const int id = __builtin_amdgcn_readlane(idr, e4 + x);
                            const float a = __uint_as_float((unsigned)__builtin_amdgcn_readlane((int)__float_as_uint(acr), e4 + x));
                            const GAS v4u* rp = (const GAS v4u*)(VB + (size_t)id * DM) + lane;
#pragma unroll
                            for (int c = 0; c < 4; ++c) { const v4u w = rp[64 * c];
                                oacc[c * 8 + 0] += a * bflo(w.x); oacc[c * 8 + 1] += a * bfhi(w.x); oacc[c * 8 + 2] += a * bflo(w.y); oacc[c * 8 + 3] += a * bfhi(w.y);
                                oacc[c * 8 + 4] += a * bflo(w.z); oacc[c * 8 + 5] += a * bfhi(w.z); oacc[c * 8 + 6] += a * bflo(w.w); oacc[c * 8 + 7] += a * bfhi(w.w); }
                        }
                    }
                }
                float* xp = X + (size_t)t * DM + lane * 8;
#pragma unroll
                for (int c = 0; c < 4; ++c) { GAS f32x4* q = (GAS f32x4*)(xp + c * 512);
                    f32x4 lo = q[0], hi = q[1];
                    lo.x += oacc[c * 8 + 0]; lo.y += oacc[c * 8 + 1]; lo.z += oacc[c * 8 + 2]; lo.w += oacc[c * 8 + 3];
                    hi.x += oacc[c * 8 + 4]; hi.y += oacc[c * 8 + 5]; hi.z += oacc[c * 8 + 6]; hi.w += oacc[c * 8 + 7];
                    q[0] = lo; q[1] = hi; }
            }
        }
#endif
        GRID_BAR();
    }

    { PH_IDS();
    for (int m = gw; m < MTOK; m += NGW) {
        GAS f32x4* xr = (GAS f32x4*)(X + (size_t)m * DM) + lane; const GAS f32x4* gr = (const GAS f32x4*)INP(2) + lane;
        f32x4 v[8]; float s = 0.f;
#pragma unroll
        for (int j = 0; j < 8; ++j) { v[j] = xr[64 * j]; s += (v[j].x * v[j].x + v[j].y * v[j].y) + (v[j].z * v[j].z + v[j].w * v[j].w); }
        const float rstd = 1.0f / sqrtf(wave_sum(s) * (1.f / DM) + RMS_EPS);
#pragma unroll
        for (int j = 0; j < 8; ++j) { const f32x4 gg = gr[64 * j]; xr[64 * j] = v[j] * rstd * gg; }
    } }
}

extern "C" void kernel_launch(void* const* d_in, const int* in_sizes, int n_in, void* d_out, int out_size, void* d_ws, size_t ws_size, hipStream_t stream) {
    static int grid = 0;
    if (grid == 0) {
        if (n_in != 17 || in_sizes[0] != MTOK * DM || out_size != MTOK * DM || ws_size < WS_END) {
            fprintf(stderr, "kernel_launch: shape/workspace mismatch: n_in %d in0 %d out %d ws %zu (need %zu); nothing launched\n", n_in, n_in > 0 ? in_sizes[0] : -1, out_size, ws_size, (size_t)WS_END); grid = -1; return; }
        int dev = 0, cus = 0, per_cu = 0;
        if (hipGetDevice(&dev) != hipSuccess || hipDeviceGetAttribute(&cus, hipDeviceAttributeMultiprocessorCount, dev) != hipSuccess) { grid = -1; return; }
        if (hipFuncSetAttribute((const void*)mk_fwd, hipFuncAttributeMaxDynamicSharedMemorySize, LDS_BYTES) != hipSuccess) { fprintf(stderr, "kernel_launch: hipFuncSetAttribute failed\n"); grid = -1; return; }
        if (hipOccupancyMaxActiveBlocksPerMultiprocessor(&per_cu, (const void*)mk_fwd, NWAVES * 64, LDS_BYTES) != hipSuccess || per_cu < 1)
            fprintf(stderr, "kernel_launch: note: occupancy query reports %d workgroups per CU\n", per_cu);
        (void)hipGetLastError();
        grid = cus;
    }
    if (grid < 0) return;
    if (hipMemsetAsync((char*)d_ws + WS_CTL, 0, CTL_ZERO_BYTES, stream) != hipSuccess) { fprintf(stderr, "kernel_launch: memset failed\n"); return; }
    Args a{};
    for (int i = 0; i < 17; ++i) a.in[i] = (const float*)d_in[i];
    a.out = (float*)d_out; a.ws = (unsigned char*)d_ws;
    hipLaunchKernelGGL(mk_fwd, dim3(grid), dim3(NWAVES * 64), LDS_BYTES, stream, a);
    const hipError_t le = hipPeekAtLastError();
    if (le != hipSuccess) fprintf(stderr, "kernel_launch: launch failed: %s\n", hipGetErrorName(le));
}
```

```cpp
#include <hip/hip_runtime.h>
#include <cstdio>
#include <cstdint>

constexpr int DM = 2048, NB = 4, SEQ = 4096, MTOK = NB * SEQ;
constexpr int INW = 14336, PJW = 8192, GTW = 6144;
constexpr int COL_DIL = 512, COL_DIFF = 5120;
constexpr int NEXP = 16384;
constexpr float RMS_EPS = 1e-6f;

typedef unsigned short bf16;
#define GAS __attribute__((address_space(1)))
#define LAS __attribute__((address_space(3)))
typedef unsigned v4u __attribute__((ext_vector_type(4)));
typedef float f32x4 __attribute__((ext_vector_type(4)));
typedef GAS unsigned gu32;

__device__ __forceinline__ int opaque_tid(int wave_sgpr) { int l; asm volatile("v_mbcnt_lo_u32_b32 %0, -1, 0\n\tv_mbcnt_hi_u32_b32 %0, -1, %0" : "=v"(l)); return wave_sgpr * 64 + l; }
namespace pg8 {
#define PG8_LAS __attribute__((address_space(3)))
typedef unsigned short bf16_t;
typedef short bf16x8 __attribute__((ext_vector_type(8)));
typedef float f32x4 __attribute__((ext_vector_type(4)));
typedef unsigned u32x4 __attribute__((ext_vector_type(4)));
constexpr int BM = 256, BK = 64, HALF = 128, HTB = HALF * BK * 2, STAGE_BYTES = 8 * HTB, NXCD = 8, WGM = 8;

__host__ __device__ __forceinline__ int lds_byte(int r, int c) { const int st = (r >> 4) * 2 + (c >> 5), rr = r & 15, cc = c & 31, ob = rr * 64 + cc * 2; return st * 1024 + (ob ^ (((ob >> 9) & 1) << 5)); }
__host__ __device__ __forceinline__ void stage_rc(int b, int& R, int& C) { const int st = b / 1024, sb = b % 1024, swz = sb ^ (((sb >> 9) & 1) << 5); R = (st >> 1) * 16 + swz / 64; C = (st & 1) * 32 + (swz % 64) / 2; }
__host__ __device__ __forceinline__ int perm32(int rho) { const int n = rho >> 4, i = rho & 15; return 8 * (i >> 2) + 4 * n + (i & 3); }

struct Unit { int pm, pn; long aoff, boff; int orow, ocol; };
struct Gemm { const bf16_t* A; const bf16_t* Bt; };

struct StaticOrder {
    int nM, nN, nwg, G, c; long sa, sb;
    __device__ void init(int M, int N, int G_, int c_, int lda, int ldb) { nM = M / BM; nN = N / BM; nwg = nM * nN; G = G_; c = c_; sa = 512L * lda; sb = 512L * ldb; }
    __device__ bool next(int i, Unit& u) const {
        const long L = (long)i * G + c; if (L >= nwg) return false;
        int wgid = (int)L; { const int q = nwg / NXCD, r = nwg % NXCD, xcd = wgid % NXCD, off = wgid / NXCD; wgid = (xcd < r ? xcd * (q + 1) : r * (q + 1) + (xcd - r) * q) + off; }
        const int nig = WGM * nN, gid = wgid / nig, fm = gid * WGM, gsz = (nM - fm) < WGM ? (nM - fm) : WGM;
        u.pm = fm + ((wgid % nig) % gsz); u.pn = (wgid % nig) / gsz;
        u.aoff = u.pm * sa; u.boff = u.pn * sb; u.orow = u.pm * BM; u.ocol = u.pn * BM; return true;
    }
};
struct F2Order : StaticOrder {
    __device__ bool next(int i, Unit& u) const { if (!StaticOrder::next(i, u)) return false; u.orow = (u.pn >> 1) * 4096 + u.pm * BM; u.ocol = (u.pn & 1) * BM; return true; }
};
struct F1Order {
    int G, c;
    __device__ bool next(int i, Unit& u) const {
        const int idx = i * G + c; if (idx >= 256) return false;
        const int bg = idx >> 4, st = idx & 15, b = bg >> 2, g = bg & 3;
        u.pm = 0; u.pn = idx; u.aoff = 0; u.boff = ((long)(b * 4096 + st * 256) * PJW + g * 128) * 2; u.orow = bg * 128; u.ocol = st * 256; return true;
    }
};

__device__ __forceinline__ unsigned cvt_pk_bf16(float lo, float hi) { unsigned r; asm volatile("v_cvt_pk_bf16_f32 %0, %1, %2" : "=v"(r) : "v"(lo), "v"(hi)); return r; }
__device__ __forceinline__ float bf_lo(unsigned w) { return __uint_as_float(w << 16); }
__device__ __forceinline__ float bf_hi(unsigned w) { return __uint_as_float(w & 0xffff0000u); }

#define PG8_PACK(v0, v1, w) do { (w).x = cvt_pk_bf16((v0)[0], (v0)[1]); (w).y = cvt_pk_bf16((v0)[2], (v0)[3]); (w).z = cvt_pk_bf16((v1)[0], (v1)[1]); (w).w = cvt_pk_bf16((v1)[2], (v1)[3]); } while (0)

struct EpiStore {
    static constexpr bool PERM = true;
    bf16_t* O; int ldo;
    __device__ __forceinline__ void operator()(const f32x4 (&acc)[2][2][4][2], const Unit& u, int wr, int wc, int fr, int fq) const {
        const int row0 = u.orow + wr * 64 + fr, col0 = u.ocol + wc * 32 + 8 * fq;
#pragma unroll
        for (int ai = 0; ai < 2; ++ai)
#pragma unroll
            for (int m = 0; m < 4; ++m) { bf16_t* rowp = O + (size_t)(row0 + ai * HALF + m * 16) * ldo + col0;
#pragma unroll
                for (int bj = 0; bj < 2; ++bj) { u32x4 w; PG8_PACK(acc[ai][bj][m][0], acc[ai][bj][m][1], w); *(u32x4*)(rowp + bj * HALF) = w; } }
    }
};
struct EpiZT {
    static constexpr bool PERM = true;
    bf16_t* O;
    __device__ __forceinline__ void operator()(const f32x4 (&acc)[2][2][4][2], const Unit& u, int wr, int wc, int fr, int fq) const {
        const int row0 = u.orow + wr * 64 + fr, col0 = u.ocol + wc * 32 + 8 * fq;
#pragma unroll
        for (int ai = 0; ai < 2; ++ai)
#pragma unroll
            for (int m = 0; m < 4; ++m) { bf16_t* rowp = O + (size_t)(row0 + m * 16) * 8192 + ai * 4096 + col0;
#pragma unroll
                for (int bj = 0; bj < 2; ++bj) { u32x4 w; PG8_PACK(acc[ai][bj][m][0], acc[ai][bj][m][1], w); *(u32x4*)(rowp + bj * HALF) = w; } }
    }
};
struct EpiProj {
    static constexpr bool PERM = true;
    bf16_t* P; bf16_t* Gt; const float* bg;
    __device__ __forceinline__ void operator()(const f32x4 (&acc)[2][2][4][2], const Unit& u, int wr, int wc, int fr, int fq) const {
        const bool isg = u.pn >= 32;
        const int row0 = u.pm * BM + wr * 64 + fr, col0 = (isg ? u.pn - 32 : u.pn) * BM + wc * 32 + 8 * fq, ldc = isg ? GTW : PJW;
        bf16_t* base = isg ? Gt : P;
        f32x4 bv[2][2];
#pragma unroll
        for (int bj = 0; bj < 2; ++bj)
#pragma unroll
            for (int n = 0; n < 2; ++n) bv[bj][n] = isg ? *(const f32x4*)(bg + col0 + bj * HALF + 4 * n) : (f32x4){0.f, 0.f, 0.f, 0.f};
#pragma unroll
        for (int ai = 0; ai < 2; ++ai)
#pragma unroll
            for (int m = 0; m < 4; ++m) { bf16_t* rowp = base + (size_t)(row0 + ai * HALF + m * 16) * ldc + col0;
#pragma unroll
                for (int bj = 0; bj < 2; ++bj) { f32x4 v0 = acc[ai][bj][m][0] + bv[bj][0], v1 = acc[ai][bj][m][1] + bv[bj][1];
                    if (isg) {
#pragma unroll
                        for (int j = 0; j < 4; ++j) { v0[j] = __builtin_amdgcn_rcpf(1.0f + __builtin_amdgcn_exp2f(-1.4426950408889634f * v0[j])); v1[j] = __builtin_amdgcn_rcpf(1.0f + __builtin_amdgcn_exp2f(-1.4426950408889634f * v1[j])); } }
                    u32x4 w; PG8_PACK(v0, v1, w); *(u32x4*)(rowp + bj * HALF) = w; } }
    }
};
struct EpiMerge3 {
    static constexpr bool PERM = true;
    const bf16_t* Gt; bf16_t* O; int br;
    __device__ __forceinline__ void operator()(const f32x4 (&acc)[2][2][4][2], const Unit& u, int wr, int wc, int fr, int fq) const {
        const int row0 = u.pm * BM + wr * 64 + fr, col0 = u.pn * BM + wc * 32 + 8 * fq;
#pragma unroll
        for (int ai = 0; ai < 2; ++ai)
#pragma unroll
            for (int m = 0; m < 4; ++m) { const bf16_t* gp = Gt + (size_t)(row0 + ai * HALF + m * 16) * GTW + br * DM + col0; bf16_t* rowp = O + (size_t)(row0 + ai * HALF + m * 16) * DM + col0;
#pragma unroll
                for (int bj = 0; bj < 2; ++bj) { const u32x4 g = *(const u32x4*)(gp + bj * HALF);
                    f32x4 v0 = acc[ai][bj][m][0], v1 = acc[ai][bj][m][1];
                    v0[0] *= bf_lo(g.x); v0[1] *= bf_hi(g.x); v0[2] *= bf_lo(g.y); v0[3] *= bf_hi(g.y);
                    v1[0] *= bf_lo(g.z); v1[1] *= bf_hi(g.z); v1[2] *= bf_lo(g.w); v1[3] *= bf_hi(g.w);
                    if (br) { const u32x4 p = *(const u32x4*)(rowp + bj * HALF);
                        v0[0] += bf_lo(p.x); v0[1] += bf_hi(p.x); v0[2] += bf_lo(p.y); v0[3] += bf_hi(p.y);
                        v1[0] += bf_lo(p.z); v1[1] += bf_hi(p.z); v1[2] += bf_lo(p.w); v1[3] += bf_hi(p.w); }
                    u32x4 w; PG8_PACK(v0, v1, w); *(u32x4*)(rowp + bj * HALF) = w; }
                asm volatile("" ::: "memory"); }
    }
};
struct EpiResF32 {
    static constexpr bool PERM = false;
    const float* base; float* out; int ldc;
    __device__ __forceinline__ void operator()(const f32x4 (&acc)[2][2][4][2], const Unit& u, int wr, int wc, int fr, int fq) const {
        const int row0 = u.orow + wr * 64 + fr, col0 = u.ocol + wc * 32 + 4 * fq;
#pragma unroll
        for (int ai = 0; ai < 2; ++ai)
#pragma unroll
            for (int m = 0; m < 4; ++m) { const size_t off = (size_t)(row0 + ai * HALF + m * 16) * ldc + col0;
#pragma unroll
                for (int bj = 0; bj < 2; ++bj)
#pragma unroll
                    for (int n = 0; n < 2; ++n) { f32x4 v = acc[ai][bj][m][n]; if (base) v += *(const f32x4*)(base + off + bj * HALF + n * 16); *(f32x4*)(out + off + bj * HALF + n * 16) = v; }
                asm volatile("" ::: "memory"); }
    }
};

template <class Epi, class Sched, bool ALIGN_EPI, int LDA, int LDB, int KK>
__device__ __forceinline__ void gemm_phase(PG8_LAS unsigned char* lds, const Gemm g, const Sched& S, const Epi& E, int wave0) {
    const int tid = opaque_tid(wave0), wid = wave0, lane = tid & 63, wr = wid >> 2, wc = wid & 3, fr = lane & 15, fq = lane >> 4;
    constexpr int nt = KK / BK;
    unsigned voffA[2], voffB[2];
#pragma unroll
    for (int i = 0; i < 2; ++i) { int R, C; stage_rc(tid * 16 + i * 8192, R, C); const int Rb = Epi::PERM ? ((R & ~31) + perm32(R & 31)) : R;
        voffA[i] = (unsigned)(R * LDA + C) * 2u; voffB[i] = (unsigned)(Rb * LDB + C) * 2u; }
    const size_t kstep = (size_t)(BK * 2);
    constexpr size_t hstepA = (size_t)HALF * LDA * 2, hstepB = (size_t)HALF * LDB * 2;
    const unsigned ldsw = (unsigned)wid * 1024u;
    const int aoff = lds_byte(wr * 64 + fr, fq * 8), boff = lds_byte(wc * 32 + fr, fq * 8);
#define PG8_SA(b, h) (((b) * 2 + (h)) * HTB)
#define PG8_SB(b, h) ((4 + (b) * 2 + (h)) * HTB)
#define PG8_STAGE(bufoff, gbase, voff) do { _Pragma("unroll") for (int _i = 0; _i < 2; ++_i) \
        __builtin_amdgcn_global_load_lds((const unsigned*)((const char*)(gbase) + (voff)[_i]), (PG8_LAS unsigned*)(lds + (bufoff) + ldsw + _i * 8192), 16, 0, 0); } while (0)
#define PG8_LDA(dst, b, h) do { _Pragma("unroll") for (int m = 0; m < 4; ++m) _Pragma("unroll") for (int k = 0; k < 2; ++k) dst[m][k] = *(const PG8_LAS bf16x8*)(lds + PG8_SA(b, h) + aoff + m * 2048 + k * 1024); } while (0)
#define PG8_LDB(dst, b, h) do { _Pragma("unroll") for (int n = 0; n < 2; ++n) _Pragma("unroll") for (int k = 0; k < 2; ++k) dst[n][k] = *(const PG8_LAS bf16x8*)(lds + PG8_SB(b, h) + boff + n * 2048 + k * 1024); } while (0)
#define PG8_MMA(ai, bj, At, Bt) do { __builtin_amdgcn_s_setprio(1); _Pragma("unroll") for (int m = 0; m < 4; ++m) _Pragma("unroll") for (int n = 0; n < 2; ++n) _Pragma("unroll") for (int k = 0; k < 2; ++k) \
        acc[ai][bj][m][n] = __builtin_amdgcn_mfma_f32_16x16x32_bf16(Bt[n][k], At[m][k], acc[ai][bj][m][n], 0, 0, 0); __builtin_amdgcn_s_setprio(0); } while (0)
#define PG8_WAIT_V(n) asm volatile("s_waitcnt vmcnt(" #n ")" ::: "memory")
#define PG8_WAIT_L(n) asm volatile("s_waitcnt lgkmcnt(" #n ")" ::: "memory")
#define PG8_BAR __builtin_amdgcn_s_barrier()
#define PG8_SCHED __builtin_amdgcn_sched_barrier(0)
    Unit cur, nxt; int ui = 0;
    if (!S.next(0, cur)) return;
    f32x4 acc[2][2][4][2];
#pragma unroll
    for (int a = 0; a < 2; ++a)
#pragma unroll
        for (int b = 0; b < 2; ++b)
#pragma unroll
            for (int m = 0; m < 4; ++m)
#pragma unroll
                for (int n = 0; n < 2; ++n) acc[a][b][m][n] = (f32x4){0.f, 0.f, 0.f, 0.f};
    bf16x8 At[4][2], B0[2][2], B1[2][2];
    const char* cA = (const char*)g.A + cur.aoff; const char* cB = (const char*)g.Bt + cur.boff;
    PG8_STAGE(PG8_SB(0, 0), cB, voffB); PG8_STAGE(PG8_SB(0, 1), cB + hstepB, voffB); PG8_STAGE(PG8_SA(0, 0), cA, voffA); PG8_STAGE(PG8_SA(0, 1), cA + hstepA, voffA);
    if (wr == 1) PG8_BAR;
    PG8_WAIT_V(2); PG8_BAR;
    PG8_STAGE(PG8_SB(1, 0), cB + kstep, voffB); PG8_STAGE(PG8_SA(1, 0), cA + kstep, voffA); PG8_STAGE(PG8_SB(1, 1), cB + hstepB + kstep, voffB);
    PG8_WAIT_V(6); PG8_BAR;
    for (;;) {
        const bool has_next = S.next(ui + 1, nxt);
        const char* nA = has_next ? (const char*)g.A + nxt.aoff : cA; const char* nB = has_next ? (const char*)g.Bt + nxt.boff : cB;
        for (int t = 0; t < nt; t += 2) {
            const bool last = (t == nt - 2);
            const char* a1 = cA + (size_t)(t + 1) * kstep;
            const char* a2 = last ? nA : cA + (size_t)(t + 2) * kstep; const char* b2 = last ? nB : cB + (size_t)(t + 2) * kstep;
            const char* a3 = a2 + kstep; const char* b3 = b2 + kstep;
            PG8_LDB(B0, 0, 0); PG8_LDB(B1, 0, 1); PG8_SCHED; PG8_LDA(At, 0, 0); PG8_STAGE(PG8_SA(1, 1), a1 + hstepA, voffA);
            PG8_WAIT_V(8); PG8_WAIT_L(0); PG8_BAR; PG8_MMA(0, 0, At, B0); PG8_MMA(0, 1, At, B1); PG8_BAR; PG8_SCHED;
            PG8_LDA(At, 0, 1); PG8_STAGE(PG8_SB(0, 0), b2, voffB); PG8_STAGE(PG8_SB(0, 1), b2 + hstepB, voffB); PG8_STAGE(PG8_SA(0, 0), a2, voffA);
            PG8_WAIT_V(8); PG8_WAIT_L(0); PG8_BAR; PG8_MMA(1, 0, At, B0); PG8_MMA(1, 1, At, B1); PG8_BAR; PG8_SCHED;
            PG8_LDB(B0, 1, 0); PG8_LDB(B1, 1, 1); PG8_SCHED; PG8_LDA(At, 1, 0); PG8_STAGE(PG8_SA(0, 1), a2 + hstepA, voffA);
            PG8_WAIT_V(8); PG8_WAIT_L(0); PG8_BAR; PG8_MMA(0, 0, At, B0); PG8_MMA(0, 1, At, B1); PG8_BAR; PG8_SCHED;
            PG8_LDA(At, 1, 1); PG8_STAGE(PG8_SB(1, 0), b3, voffB); PG8_STAGE(PG8_SB(1, 1), b3 + hstepB, voffB); PG8_STAGE(PG8_SA(1, 0), a3, voffA);
            PG8_WAIT_V(8); PG8_WAIT_L(0); PG8_BAR; PG8_MMA(1, 0, At, B0); PG8_MMA(1, 1, At, B1); PG8_BAR; PG8_SCHED;
        }
        if constexpr (ALIGN_EPI) { if (wr == 0) PG8_BAR; }
        E(acc, cur, wr, wc, fr, fq);
        if (!has_next) break;
#pragma unroll
        for (int a = 0; a < 2; ++a)
#pragma unroll
            for (int b = 0; b < 2; ++b)
#pragma unroll
                for (int m = 0; m < 4; ++m)
#pragma unroll
                    for (int n = 0; n < 2; ++n) acc[a][b][m][n] = (f32x4){0.f, 0.f, 0.f, 0.f};
        cur = nxt; cA = nA; cB = nB; ++ui;
        if constexpr (ALIGN_EPI) { if (wr == 1) PG8_BAR; }
    }
    PG8_WAIT_V(0);
    if constexpr (!ALIGN_EPI) { if (wr == 0) PG8_BAR; }
    PG8_BAR;
#undef PG8_SA
#undef PG8_SB
#undef PG8_STAGE
#undef PG8_LDA
#undef PG8_LDB
#undef PG8_MMA
#undef PG8_WAIT_V
#undef PG8_WAIT_L
#undef PG8_BAR
#undef PG8_SCHED
}
}

namespace attn {
using bf16x8 = __attribute__((ext_vector_type(8))) short;
using s16x4  = __attribute__((ext_vector_type(4))) short;
using f32x16 = __attribute__((ext_vector_type(16))) float;
using u32x4  = __attribute__((ext_vector_type(4))) unsigned;
constexpr int   D = 128, NW = 8, QBLK = 32, KVBLK = 64;
constexpr float SCALE = 0.088388347648318440f;
constexpr float THR = 8.f;
constexpr size_t SHM_V = KVBLK * D * 2, SHM_K = KVBLK * D * 2;
constexpr int LDS_WS = 2 * SHM_V + 2 * SHM_K, LDS_TAB = LDS_WS + NW * 64 * 4, LDS_END = LDS_TAB + 8192 * 4;
#define KSWZ(row, colB) ((row) * 256 + ((colB) ^ (((row) & 7) << 4)))
#define SBAR() __builtin_amdgcn_sched_barrier(0)
__device__ __forceinline__ int crow(int r, int hi) { return (r & 3) + 8 * (r >> 2) + 4 * hi; }
__device__ __forceinline__ unsigned cvtpk(float lo, float hi) { unsigned r; asm volatile("v_cvt_pk_bf16_f32 %0, %1, %2" : "=v"(r) : "v"(lo), "v"(hi)); return r; }

__device__ __forceinline__ void partialSM(f32x16& p0, f32x16& p1, float& m_reg, float& mn, float& alpha) {
  constexpr float C = SCALE * 1.4426950408889634f;
  float pmax = p0[0]; for (int r = 1; r < 16; ++r) pmax = fmaxf(pmax, p0[r]); for (int r = 0; r < 16; ++r) pmax = fmaxf(pmax, p1[r]);
  { auto rr = __builtin_amdgcn_permlane32_swap(__float_as_uint(pmax), __float_as_uint(pmax), false, false);
    pmax = fmaxf(__uint_as_float(rr[0]), __uint_as_float(rr[1])); }
  if (__builtin_expect(__all(pmax - m_reg <= THR / SCALE), 1)) { mn = m_reg; alpha = 1.f; }
  else { mn = fmaxf(m_reg, pmax); alpha = __builtin_amdgcn_exp2f((m_reg - mn) * C); m_reg = mn; }
  float mnC = -mn * C;
  for (int r = 0; r < 16; ++r) p0[r] = fmaf(p0[r], C, mnC); for (int r = 0; r < 16; ++r) p1[r] = fmaf(p1[r], C, mnC);
  for (int r = 0; r < 16; ++r) p0[r] = __builtin_amdgcn_exp2f(p0[r]);
}
__device__ __forceinline__ void finishSM(f32x16& p0, f32x16& p1, float alpha, float& l_reg, bf16x8& pa0, bf16x8& pa1, bf16x8& pa2, bf16x8& pa3) {
  for (int r = 0; r < 16; ++r) p1[r] = __builtin_amdgcn_exp2f(p1[r]);
  float ps = 0; for (int r = 0; r < 16; ++r) ps += p0[r]; for (int r = 0; r < 16; ++r) ps += p1[r];
  { auto rr = __builtin_amdgcn_permlane32_swap(__float_as_uint(ps), __float_as_uint(ps), false, false);
    ps = __uint_as_float(rr[0]) + __uint_as_float(rr[1]); }
  l_reg = l_reg * alpha + ps;
#define PK4(P, BASE, OUT) do { unsigned a0 = cvtpk(P[BASE + 0], P[BASE + 1]), a1 = cvtpk(P[BASE + 2], P[BASE + 3]);   \
    unsigned b0 = cvtpk(P[BASE + 4], P[BASE + 5]), b1 = cvtpk(P[BASE + 6], P[BASE + 7]);                              \
    auto r0 = __builtin_amdgcn_permlane32_swap(a0, b0, false, false); auto r1 = __builtin_amdgcn_permlane32_swap(a1, b1, false, false); \
    u32x4 w = {r0[0], r1[0], r0[1], r1[1]}; OUT = *reinterpret_cast<bf16x8*>(&w); } while (0)
  PK4(p0, 0, pa0); PK4(p0, 8, pa1); PK4(p1, 0, pa2); PK4(p1, 8, pa3);
#undef PK4
}
__device__ __forceinline__ void qkt(f32x16& p0, f32x16& p1, const bf16* Ks, const bf16x8* qr, int r32, int hi, const float* tl) {
#pragma unroll
  for (int r = 0; r < 16; ++r) { p0[r] = tl[(r & 3) + 8 * (r >> 2)]; p1[r] = tl[32 + (r & 3) + 8 * (r >> 2)]; }
#pragma unroll
  for (int d0 = 0; d0 < 8; ++d0) { int cb = (d0 * 16 + hi * 8) * 2;
    bf16x8 b0 = *reinterpret_cast<const bf16x8*>((const char*)Ks + KSWZ(r32, cb));
    bf16x8 b1 = *reinterpret_cast<const bf16x8*>((const char*)Ks + KSWZ(32 + r32, cb));
    p0 = __builtin_amdgcn_mfma_f32_32x32x16_bf16(b0, qr[d0], p0, 0, 0, 0);
    p1 = __builtin_amdgcn_mfma_f32_32x32x16_bf16(b1, qr[d0], p1, 0, 0, 0); }
}
__device__ __forceinline__ int v_st(int k, int c) { const int kk = (k & ~0xC) | ((k & 4) << 1) | ((k & 8) >> 1); return ((kk >> 3) * 4 + (c >> 5)) * 512 + ((kk & 7) * 32 + (c & 31)) * 2; }
__device__ __forceinline__ int v_rd_base(int lane) { return ((lane & 3) << 3) | (((lane >> 2) & 3) << 6) | (((lane >> 4) & 1) << 5) | (((lane >> 5) & 1) << 8); }
constexpr int v_rd_off(int d0, int ks, int half) { return d0 * 512 + ks * 4096 + half * 2048; }
template <int OFF> __device__ __forceinline__ s16x4 tr_read(int vb) {
  s16x4 r; asm volatile("ds_read_b64_tr_b16 %0, %1 offset:%2" : "=&v"(r) : "v"(vb), "i"(OFF) : "memory"); return r;
}
template <int D0> __device__ __forceinline__ void pv_one(f32x16& od, int vb, bf16x8 pa0, bf16x8 pa1, bf16x8 pa2, bf16x8 pa3) {
  const s16x4 l0 = tr_read<v_rd_off(D0, 0, 0)>(vb), h0 = tr_read<v_rd_off(D0, 0, 1)>(vb), l1 = tr_read<v_rd_off(D0, 1, 0)>(vb), h1 = tr_read<v_rd_off(D0, 1, 1)>(vb);
  const s16x4 l2 = tr_read<v_rd_off(D0, 2, 0)>(vb), h2 = tr_read<v_rd_off(D0, 2, 1)>(vb), l3 = tr_read<v_rd_off(D0, 3, 0)>(vb), h3 = tr_read<v_rd_off(D0, 3, 1)>(vb);
  asm volatile("s_waitcnt lgkmcnt(0)" ::: "memory"); SBAR();
#define PK(L, H) (bf16x8){L[0], L[1], L[2], L[3], H[0], H[1], H[2], H[3]}
  od = __builtin_amdgcn_mfma_f32_32x32x16_bf16(pa0, PK(l0, h0), od, 0, 0, 0);
  od = __builtin_amdgcn_mfma_f32_32x32x16_bf16(pa1, PK(l1, h1), od, 0, 0, 0);
  od = __builtin_amdgcn_mfma_f32_32x32x16_bf16(pa2, PK(l2, h2), od, 0, 0, 0);
  od = __builtin_amdgcn_mfma_f32_32x32x16_bf16(pa3, PK(l3, h3), od, 0, 0, 0);
#undef PK
}
__device__ __forceinline__ void pv_d0(f32x16* o, int vb, bf16x8 pa0, bf16x8 pa1, bf16x8 pa2, bf16x8 pa3) {
  pv_one<0>(o[0], vb, pa0, pa1, pa2, pa3); pv_one<1>(o[1], vb, pa0, pa1, pa2, pa3); pv_one<2>(o[2], vb, pa0, pa1, pa2, pa3); pv_one<3>(o[3], vb, pa0, pa1, pa2, pa3);
}

struct Unit { const bf16* Q; const bf16* K; const bf16* V; bf16* O; float* lse; long ldq, ldk, ldo; int lse_ld, kt0, nt, qoff; };
__device__ __forceinline__ void attn_unit(const Unit& u, char* lds, int wave0) {
  const int tid = opaque_tid(wave0), wid = wave0, lane = tid & 63, r32 = lane & 31, hi = lane >> 5;
  bf16* V_lds = (bf16*)lds; bf16* K_lds = (bf16*)(lds + 2 * SHM_V);
  float* ws = (float*)(lds + LDS_WS) + wid * 64; float* li_l = ws; float* al_l = ws + 32;
  const float* tabL = (const float*)(lds + LDS_TAB);
  float m_reg = -1e30f, l_reg = 0; f32x16 o[4] = {}; bf16x8 qr[8];
  const bf16* Qw = u.Q + (long)(wid * QBLK + r32) * u.ldq + hi * 8;
#pragma unroll
  for (int d0 = 0; d0 < 8; ++d0) qr[d0] = *reinterpret_cast<const bf16x8*>(Qw + d0 * 16);
  const int sr = tid >> 4, sc = (tid & 15) * 8, vst0 = v_st(sr, sc), vst1 = v_st(32 + sr, sc);
  const int vb0 = (int)(uintptr_t)V_lds + v_rd_base(lane);
  const long tstep = (long)KVBLK * u.ldk * 2;
  const char* Kh = (const char*)u.K + (long)u.kt0 * tstep; const char* Vh = (const char*)u.V + (long)u.kt0 * tstep;
  const unsigned lo0 = (unsigned)((sr * (int)u.ldk + sc) * 2), lo1 = lo0 + (unsigned)(32 * (int)u.ldk * 2);
  const float* tl0 = tabL + (4096 + u.kt0 * KVBLK + 4 * hi - (u.qoff + wid * QBLK + r32));
  struct { bf16x8 vs0, vs1, ks0, ks1; } sr_[2];
#define SLOAD(i, tj) do { const char* vt_ = Vh + (long)(tj) * tstep; const char* kt_ = Kh + (long)(tj) * tstep; \
    sr_[i].vs0 = *reinterpret_cast<const bf16x8*>(vt_ + lo0); sr_[i].vs1 = *reinterpret_cast<const bf16x8*>(vt_ + lo1); \
    sr_[i].ks0 = *reinterpret_cast<const bf16x8*>(kt_ + lo0); sr_[i].ks1 = *reinterpret_cast<const bf16x8*>(kt_ + lo1); } while (0)
#define SWRITE(b, i) do { *(bf16x8*)((char*)V_lds + (b) * SHM_V + vst0) = sr_[i].vs0;          \
    *(bf16x8*)((char*)V_lds + (b) * SHM_V + vst1) = sr_[i].vs1; int kc = sc * 2;               \
    *(bf16x8*)((char*)K_lds + (b) * SHM_K + KSWZ(sr, kc)) = sr_[i].ks0;                       \
    *(bf16x8*)((char*)K_lds + (b) * SHM_K + KSWZ(32 + sr, kc)) = sr_[i].ks1; } while (0)
#define SWAIT() asm volatile("s_waitcnt vmcnt(4)" ::: "memory")
#define RESC(a) do { if (__any((a) < 1.f)) { if (hi == 0) al_l[r32] = (a); asm volatile("s_waitcnt lgkmcnt(0)" ::: "memory"); \
    for (int d = 0; d < 4; ++d) for (int r = 0; r < 16; ++r) o[d][r] *= al_l[crow(r, hi)]; } } while (0)
  f32x16 pA0, pA1, pB0, pB1; float mnA, mnB, alA, alB; bf16x8 pa0, pa1, pa2, pa3; const int NT = u.nt;
  constexpr int SE = 0, SO = 1;
  SLOAD(SE, 0); asm volatile("s_waitcnt vmcnt(0)" ::: "memory"); SWRITE(0, SE); __syncthreads();
  qkt(pA0, pA1, K_lds, qr, r32, hi, tl0); partialSM(pA0, pA1, m_reg, mnA, alA);
  SLOAD(SO, 1); if (2 < NT) SLOAD(SE, 2);
  SWAIT(); SWRITE(1, SO); __syncthreads();
  for (int j = 1; j + 1 < NT; j += 2) {
    SBAR(); qkt(pB0, pB1, (bf16*)((char*)K_lds + SHM_K), qr, r32, hi, tl0 + j * KVBLK);
    finishSM(pA0, pA1, alA, l_reg, pa0, pa1, pa2, pa3); SBAR();
    SLOAD(SO, j + 2); SBAR();
    pv_d0(o, vb0, pa0, pa1, pa2, pa3); partialSM(pB0, pB1, m_reg, mnB, alB);
    __syncthreads(); SWAIT(); SWRITE(0, SE);
    RESC(alB); __syncthreads();
    SBAR(); qkt(pA0, pA1, K_lds, qr, r32, hi, tl0 + (j + 1) * KVBLK);
    finishSM(pB0, pB1, alB, l_reg, pa0, pa1, pa2, pa3); SBAR();
    if (j + 3 < NT) SLOAD(SE, j + 3); SBAR();
    pv_d0(o, vb0 + (int)SHM_V, pa0, pa1, pa2, pa3); partialSM(pA0, pA1, m_reg, mnA, alA);
    __syncthreads(); SWAIT(); SWRITE(1, SO);
    RESC(alA); __syncthreads();
  }
  SBAR(); qkt(pB0, pB1, (bf16*)((char*)K_lds + SHM_K), qr, r32, hi, tl0 + (NT - 1) * KVBLK);
  finishSM(pA0, pA1, alA, l_reg, pa0, pa1, pa2, pa3); SBAR();
  pv_d0(o, vb0, pa0, pa1, pa2, pa3); partialSM(pB0, pB1, m_reg, mnB, alB);
  __syncthreads(); RESC(alB);
  finishSM(pB0, pB1, alB, l_reg, pa0, pa1, pa2, pa3); SBAR();
  pv_d0(o, vb0 + (int)SHM_V, pa0, pa1, pa2, pa3);
  if (hi == 0) li_l[r32] = l_reg; asm volatile("s_waitcnt lgkmcnt(0)" ::: "memory");
  float rli[16];
#pragma unroll
  for (int r = 0; r < 16; ++r) rli[r] = __builtin_amdgcn_rcpf(li_l[crow(r, hi)]);
  bf16* Ow = u.O + (long)(wid * QBLK) * u.ldo;
#pragma unroll
  for (int r = 0; r < 16; ++r) { int orow = crow(r, hi);
#pragma unroll
    for (int d0 = 0; d0 < 4; ++d0) { const float v = o[d0][r] * rli[r]; Ow[(long)orow * u.ldo + d0 * 32 + r32] = (bf16)(cvtpk(v, v) & 0xffffu); } }
  if (u.lse != nullptr && hi == 0) u.lse[(long)(wid * QBLK + r32) * u.lse_ld] = m_reg * SCALE + __logf(l_reg);
#undef SLOAD
#undef SWRITE
#undef SWAIT
#undef RESC
}
#undef KSWZ
#undef SBAR
}

constexpr int NWAVES = 8;
constexpr size_t MiB = 1u << 20;
constexpr size_t WS_CTL = 0, CTL_ZERO_BYTES = 1 * MiB;
constexpr size_t WS_CS   = 1 * MiB;
constexpr size_t WS_SKBD = 1 * MiB + 256 * 1024;
constexpr size_t WS_TAB  = 2 * MiB;
constexpr size_t WS_LSE  = 3 * MiB;
constexpr size_t WS_WCAT = 4 * MiB, WS_WO = 12 * MiB, WS_WQ = 20 * MiB;
constexpr size_t WS_WIN  = 28 * MiB;
constexpr size_t WS_DFT  = 84 * MiB;
constexpr size_t WS_U    = 148 * MiB, WS_V = 180 * MiB;
constexpr size_t WS_H    = 276 * MiB;
constexpr size_t WS_PROJ = 340 * MiB;
constexpr size_t WS_G    = 596 * MiB;
constexpr size_t WS_ZT   = 788 * MiB;
constexpr size_t WS_OC   = 820 * MiB;
constexpr size_t WS_MG   = 884 * MiB;
constexpr size_t WS_END  = 948 * MiB;
constexpr size_t WS_Q = WS_PROJ, WS_SC = WS_PROJ + 64 * MiB, WS_IDS = WS_PROJ + 192 * MiB, WS_GATES = WS_PROJ + 200 * MiB;
constexpr int CW_BAR = 4096;
constexpr int CW_QUEUE = 16384;
constexpr int RING_BYTES = 131072, LDSCTL_OFF = RING_BYTES, MISC_OFF = LDSCTL_OFF + 320, LDS_BYTES = 147456;

#define LDS_WAIT() asm volatile("s_waitcnt lgkmcnt(0)" ::: "memory")
#define VM_WAIT() asm volatile("s_waitcnt vmcnt(0)" ::: "memory")
__device__ __forceinline__ unsigned f2bf(float f) { unsigned u = __builtin_bit_cast(unsigned, f); return (u + 0x7fffu + ((u >> 16) & 1u)) >> 16; }
__device__ __forceinline__ unsigned pk2(float lo, float hi) { return f2bf(lo) | (f2bf(hi) << 16); }
__device__ __forceinline__ float bflo(unsigned w) { return __uint_as_float(w << 16); }
__device__ __forceinline__ float bfhi(unsigned w) { return __uint_as_float(w & 0xffff0000u); }

#define XB_TMO      128
#define XB_XCNT(j)  (256  + 64 * (j))
#define XB_XSUB(j)  (1280 + 64 * (j))
#define XB_XGEN(j)  (2304 + 64 * (j))
#define XB_TOP      3328
#define XB_TOPGEN   3392
#define XCD_BAR_WORDS 3456
#define XB_SPIN_CAP (1u << 20)
__device__ __forceinline__ unsigned xb_ld(unsigned* p)              { return __hip_atomic_load(p, __ATOMIC_RELAXED, __HIP_MEMORY_SCOPE_AGENT); }
__device__ __forceinline__ unsigned xb_add(unsigned* p, unsigned v) { return __hip_atomic_fetch_add(p, v, __ATOMIC_RELAXED, __HIP_MEMORY_SCOPE_AGENT); }
__device__ __forceinline__ unsigned xb_xcc_id() { return (unsigned)__builtin_amdgcn_s_getreg((3 << 11) | 20) & 0xFu; }
#define XB_SPIN(cond, bar) do { unsigned _sp = 0; while (cond) { __builtin_amdgcn_s_sleep(1); \
    if ((++_sp & 255u) == 0u) { if (xb_ld(&(bar)[XB_TMO])) break; if (_sp > XB_SPIN_CAP) { atomicAdd(&(bar)[XB_TMO], 1u); break; } } } } while (0)
struct XcdBarrier { unsigned* bar; unsigned x; volatile LAS unsigned* st; };
__device__ __forceinline__ XcdBarrier xcd_barrier_post(unsigned* bar, volatile LAS unsigned* st) {
    XcdBarrier b; b.bar = bar; b.x = xb_xcc_id(); b.st = st;
    if (threadIdx.x == 0) (void)xb_add(&bar[XB_XCNT(b.x)], 1u);
    return b;
}
__device__ __forceinline__ void xcd_barrier_complete(unsigned* bar, unsigned x, unsigned& nloc, unsigned& nx) {
    const unsigned G = gridDim.x * gridDim.y * gridDim.z;
    unsigned sum, cnt, mine, sp = 0u;
    for (;;) {
        sum = 0u; cnt = 0u; mine = 0u;
#pragma unroll
        for (unsigned j = 0; j < 16; ++j) { const unsigned c = xb_ld(&bar[XB_XCNT(j)]); sum += c; cnt += (c > 0u) ? 1u : 0u; mine = (j == x) ? c : mine; }
        if (sum == G) break;
        __builtin_amdgcn_s_sleep(1);
        if ((++sp & 255u) == 0u) { if (xb_ld(&bar[XB_TMO])) break; if (sp > XB_SPIN_CAP) { atomicAdd(&bar[XB_TMO], 1u); break; } }
    }
    nloc = mine > 0u ? mine : 1u; nx = cnt > 0u ? cnt : 1u;
}
__device__ __forceinline__ void xcd_barrier(const XcdBarrier& b) {
    asm volatile("s_waitcnt vmcnt(0)" ::: "memory");
    __syncthreads();
    if (threadIdx.x == 0) {
        unsigned* bar = b.bar;
        __builtin_amdgcn_s_waitcnt(0);
        unsigned nloc = b.st[0], nx = b.st[1];
        if (nloc == 0u) { xcd_barrier_complete(bar, b.x, nloc, nx); b.st[0] = nloc; b.st[1] = nx; }
        const unsigned old = xb_add(&bar[XB_XSUB(b.x)], 1u);
        const unsigned gen = old / nloc;
        if (old + 1u == (gen + 1u) * nloc) {
            __builtin_amdgcn_fence(__ATOMIC_RELEASE, "agent");
            asm volatile("s_waitcnt vmcnt(0)" ::: "memory");
            const unsigned og = xb_add(&bar[XB_TOP], 1u);
            const unsigned tg = og / nx;
            if (og + 1u == (tg + 1u) * nx) xb_add(&bar[XB_TOPGEN], 1u);
            else XB_SPIN(xb_ld(&bar[XB_TOPGEN]) == tg, bar);
            __builtin_amdgcn_fence(__ATOMIC_ACQUIRE, "agent");
            xb_add(&bar[XB_XGEN(b.x)], 1u);
            asm volatile("s_waitcnt vmcnt(0)" ::: "memory");
        } else {
            XB_SPIN(xb_ld(&bar[XB_XGEN(b.x)]) == gen, bar);
            __builtin_amdgcn_fence(__ATOMIC_ACQUIRE, "agent");
            asm volatile("s_waitcnt vmcnt(0)" ::: "memory");
        }
    }
    __syncthreads();
}

template <int MASK> __device__ __forceinline__ int sx_i(int v) { return __builtin_amdgcn_ds_swizzle(v, 0x1f | (MASK << 10)); }
template <int MASK> __device__ __forceinline__ float sx_f(float v) { return __int_as_float(sx_i<MASK>(__float_as_int(v))); }
__device__ __forceinline__ float add32(float v) { auto rr = __builtin_amdgcn_permlane32_swap(__float_as_uint(v), __float_as_uint(v), false, false); return __uint_as_float(rr[0]) + __uint_as_float(rr[1]); }
__device__ __forceinline__ unsigned max32(unsigned v) { auto rr = __builtin_amdgcn_permlane32_swap(v, v, false, false); return rr[0] > rr[1] ? rr[0] : rr[1]; }
__device__ __forceinline__ float other32(float v, bool upper) { auto rr = __builtin_amdgcn_permlane32_swap(__float_as_uint(v), __float_as_uint(v), false, false); return __uint_as_float(upper ? rr[0] : rr[1]); }
__device__ __forceinline__ float bperm_f(float v, int src_lane) { return __int_as_float(__builtin_amdgcn_ds_bpermute(src_lane * 4, __float_as_int(v))); }
__device__ __forceinline__ int bperm_i(int v, int src_lane) { return __builtin_amdgcn_ds_bpermute(src_lane * 4, v); }
__device__ __forceinline__ float wave_sum(float v) {
    v += sx_f<1>(v); v += sx_f<2>(v); v += sx_f<4>(v); v += sx_f<8>(v); v += sx_f<16>(v); return add32(v);
}
__device__ __forceinline__ unsigned umax(unsigned a, unsigned b) { return a > b ? a : b; }
__device__ __forceinline__ unsigned wave_max_u32(unsigned v) {
    v = umax(v, (unsigned)sx_i<1>((int)v)); v = umax(v, (unsigned)sx_i<2>((int)v)); v = umax(v, (unsigned)sx_i<4>((int)v)); v = umax(v, (unsigned)sx_i<8>((int)v)); v = umax(v, (unsigned)sx_i<16>((int)v)); return max32(v);
}
template <int CTRL, int RMASK> __device__ __forceinline__ unsigned dpp_max_u(unsigned v) { const unsigned t = (unsigned)__builtin_amdgcn_update_dpp((int)v, (int)v, CTRL, RMASK, 0xF, false); return t > v ? t : v; }
__device__ __forceinline__ unsigned wave_max_dpp(unsigned v) {
    v = dpp_max_u<0xB1, 0xF>(v); v = dpp_max_u<0x4E, 0xF>(v); v = dpp_max_u<0x141, 0xF>(v); v = dpp_max_u<0x140, 0xF>(v); v = dpp_max_u<0x142, 0xA>(v); v = dpp_max_u<0x143, 0xC>(v);
    return (unsigned)__builtin_amdgcn_readlane((int)v, 63);
}
__device__ __forceinline__ unsigned okey(float f) { const unsigned u = __float_as_uint(f); return (u & 0x80000000u) ? ~u : (u | 0x80000000u); }

__device__ __forceinline__ void transpose_item(const float* W, int N, bf16* WT, int ldo, int col_off, LAS float* scr, int item, int lane) {
    const int nblk = N / 32, kb = item / nblk, nb = item % nblk, k0 = 64 * kb, n0 = 32 * nb;
#pragma unroll 8
    for (int i = 0; i < 32; ++i) { const int kk = 2 * i + (lane >> 5); scr[kk * 33 + (lane & 31)] = W[(size_t)(k0 + kk) * N + n0 + (lane & 31)]; }
    LDS_WAIT(); asm volatile("" ::: "memory");
    const int c = lane & 7;
#pragma unroll
    for (int j = 0; j < 4; ++j) { const int n = (lane >> 3) + 8 * j; const LAS float* s = scr + (8 * c) * 33 + n;
        v4u o; o.x = pk2(s[0 * 33], s[1 * 33]); o.y = pk2(s[2 * 33], s[3 * 33]); o.z = pk2(s[4 * 33], s[5 * 33]); o.w = pk2(s[6 * 33], s[7 * 33]);
        *(GAS v4u*)(WT + (size_t)(n0 + n) * ldo + col_off + k0 + 8 * c) = o; }
    LDS_WAIT(); asm volatile("" ::: "memory");
}
__device__ __forceinline__ void rms_row_to_bf16(const float* xrow, const float* g, bf16* orow, int lane) {
    const GAS f32x4* xr = (const GAS f32x4*)xrow + lane; const GAS f32x4* gr = (const GAS f32x4*)g + lane;
    f32x4 v[8]; float s = 0.f;
#pragma unroll
    for (int j = 0; j < 8; ++j) { v[j] = xr[64 * j]; s += (v[j].x * v[j].x + v[j].y * v[j].y) + (v[j].z * v[j].z + v[j].w * v[j].w); }
    const float rstd = 1.0f / sqrtf(wave_sum(s) * (1.f / DM) + RMS_EPS);
    GAS unsigned long long* o8 = (GAS unsigned long long*)orow + lane;
#pragma unroll
    for (int j = 0; j < 8; ++j) { const f32x4 gg = gr[64 * j]; o8[64 * j] = (unsigned long long)pk2(v[j].x * rstd * gg.x, v[j].y * rstd * gg.y) | ((unsigned long long)pk2(v[j].z * rstd * gg.z, v[j].w * rstd * gg.w) << 32); }
}
typedef __bf16 bf2_t __attribute__((ext_vector_type(2)));
__device__ __forceinline__ float DOT2(unsigned a, unsigned b, float c) { return __builtin_amdgcn_fdot2_f32_bf16(__builtin_bit_cast(bf2_t, a), __builtin_bit_cast(bf2_t, b), c, false); }
__device__ __forceinline__ int rel_bucket(int rel) {
    const int n = rel < 0 ? -rel : rel;
    int b = n;
    if (n >= 8) { b = 5 + (31 - __builtin_clz((unsigned)n)); if (b > 15) b = 15; }
    return b + (rel > 0 ? 16 : 0);
}

#ifndef DBG_MODE
#define DBG_MODE 0
#endif
#ifndef PH_D1
#define PH_D1 1
#endif
#ifndef PH_D2
#define PH_D2 1
#endif
#ifndef PH_A
#define PH_A 1
#endif
#ifndef PH_B
#define PH_B 1
#endif
#ifndef PH_C
#define PH_C 1
#endif
#ifndef PH_D
#define PH_D 1
#endif
#ifndef PH_E
#define PH_E 1
#endif
#ifndef PH_F
#define PH_F 1
#endif
#ifndef PH_G
#define PH_G 1
#endif
#ifndef PH_H
#define PH_H 1
#endif
#ifndef PH_I
#define PH_I 1
#endif
#ifndef PH_J
#define PH_J 1
#endif
#ifndef PH_K
#define PH_K 1
#endif
#ifndef PH_L
#define PH_L 1
#endif
struct Args { const float* in[17]; float* out; unsigned char* ws; };

#define CAS __attribute__((address_space(4)))
__device__ __forceinline__ const void* karg(int k) { const CAS char* ka = (const CAS char*)__builtin_amdgcn_kernarg_segment_ptr(); asm volatile("" : "+s"(ka)); return *(const void* const CAS*)(ka + 8 * k); }
#define WSP(T, off) ((T*)((unsigned char*)karg(18) + (off)))
#define INP(k) ((const float*)karg(k))
#define INL(k, stride) (INP(k) + (size_t)layer * (size_t)(stride))
#define X ((float*)karg(17))
__global__ void __launch_bounds__(NWAVES * 64, 2) mk_fwd(Args args_unused) {
    extern __shared__ __attribute__((aligned(16))) unsigned char lds[];
    LAS unsigned char* ldsl = (LAS unsigned char*)lds;
    volatile LAS unsigned* MISC = (volatile LAS unsigned*)(ldsl + MISC_OFF);
    const int wave0 = __builtin_amdgcn_readfirstlane((int)threadIdx.x >> 6);
    const int G = gridDim.x; const int bx = blockIdx.x; const int vcu = (G % 8 == 0) ? (bx % 8) * (G / 8) + bx / 8 : bx;
    const int NGW = G * NWAVES, NGT = NGW * 64;
#define PH_IDS() const int tid = opaque_tid(wave0), lane = tid & 63, wave = wave0, gw = vcu * NWAVES + wave, gt = gw * 64 + lane; (void)gt; (void)gw; (void)lane
    gu32* ctl = (gu32*)WSP(unsigned char, WS_CTL);
    for (int u = threadIdx.x; u < (LDS_BYTES - LDSCTL_OFF) / 4; u += NWAVES * 64) ((LAS unsigned*)(ldsl + LDSCTL_OFF))[u] = 0u;
    __syncthreads();
    XcdBarrier bar = xcd_barrier_post((unsigned*)(ctl + CW_BAR), MISC + 8);
#define GRID_BAR() xcd_barrier(bar)

    for (int layer = 0; layer < 2; ++layer) {

#if PH_A
        {
            PH_IDS();
            LAS float* scr = (LAS float*)(ldsl + wave * 16384);
            const float* w_in = INL(4, (size_t)DM * INW); const float* w_up_a = INL(6, 512 * DM); const float* w_up_b = INL(7, 512 * DM); const float* w_up_c = INL(8, 1024 * DM);
            const float* w_o = INL(11, DM * DM); const float* wq = INL(13, DM * DM); const float* subk = INL(14, 2 * 128 * 128);
            const float* pu = INL(15, (size_t)NEXP * DM); const float* pv = INL(16, (size_t)NEXP * DM); const float* mix_g = INL(3, DM); const float* rel_bias = INP(1);
            bf16* WIN = WSP(bf16, WS_WIN); bf16* WCAT = WSP(bf16, WS_WCAT); bf16* WO = WSP(bf16, WS_WO); bf16* WQ = WSP(bf16, WS_WQ); unsigned char* U8 = WSP(unsigned char, WS_U); unsigned char* V8 = WSP(unsigned char, WS_V);
            bf16* SKBD = WSP(bf16, WS_SKBD); bf16* H = WSP(bf16, WS_H); bf16* DFT = WSP(bf16, WS_DFT); bf16* CS = WSP(bf16, WS_CS); float* TAB = WSP(float, WS_TAB);
            constexpr int I_IN = (DM / 64) * (INW / 32), I_A = (512 / 64) * (DM / 32), I_C = (1024 / 64) * (DM / 32), I_SQ = (DM / 64) * (DM / 32);
            constexpr int NITEMS = I_IN + 2 * I_A + I_C + 2 * I_SQ;
            for (int it = gw; it < NITEMS; it += NGW) {
                int r = it;
                if (r < I_IN) { transpose_item(w_in, INW, WIN, DM, 0, scr, r, lane); continue; } r -= I_IN;
                if (r < I_A) { transpose_item(w_up_a, DM, WCAT, DM, 0, scr, r, lane); continue; } r -= I_A;
                if (r < I_A) { transpose_item(w_up_b, DM, WCAT, DM, 512, scr, r, lane); continue; } r -= I_A;
                if (r < I_C) { transpose_item(w_up_c, DM, WCAT, DM, 1024, scr, r, lane); continue; } r -= I_C;
                if (r < I_SQ) { transpose_item(w_o, DM, WO, DM, 0, scr, r, lane); continue; } r -= I_SQ;
                transpose_item(wq, DM, WQ, DM, 0, scr, r, lane);
            }
            for (size_t i = (size_t)gt; i < (size_t)NEXP * DM / 16; i += (size_t)NGT) {
#pragma unroll
                for (int tb = 0; tb < 2; ++tb) {
                    const GAS f32x4* src = (const GAS f32x4*)(tb ? pv : pu) + 4 * i; const float sc = tb ? 64.f : 1024.f;
                    const f32x4 a = src[0], b = src[1], c = src[2], d = src[3]; v4u o;
                    int w;
                    w = __builtin_amdgcn_cvt_pk_fp8_f32(a.x * sc, a.y * sc, 0, false); w = __builtin_amdgcn_cvt_pk_fp8_f32(a.z * sc, a.w * sc, w, true); o.x = (unsigned)w;
                    w = __builtin_amdgcn_cvt_pk_fp8_f32(b.x * sc, b.y * sc, 0, false); w = __builtin_amdgcn_cvt_pk_fp8_f32(b.z * sc, b.w * sc, w, true); o.y = (unsigned)w;
                    w = __builtin_amdgcn_cvt_pk_fp8_f32(c.x * sc, c.y * sc, 0, false); w = __builtin_amdgcn_cvt_pk_fp8_f32(c.z * sc, c.w * sc, w, true); o.z = (unsigned)w;
                    w = __builtin_amdgcn_cvt_pk_fp8_f32(d.x * sc, d.y * sc, 0, false); w = __builtin_amdgcn_cvt_pk_fp8_f32(d.z * sc, d.w * sc, w, true); o.w = (unsigned)w;
                    ((GAS v4u*)(tb ? V8 : U8))[i] = o;
                }
            }
            for (int i = gt; i < 65536; i += NGT) { const int n = i >> 8, kk = i & 255, p = n >> 7; SKBD[i] = ((kk >> 7) == p) ? (bf16)f2bf(subk[(size_t)(p * 128 + (n & 127)) * 128 + (kk & 127)]) : (bf16)0; }
            for (int m = gw; m < MTOK; m += NGW) rms_row_to_bf16((layer == 0 ? INP(0) : (const float*)X) + (size_t)m * DM, mix_g, H + (size_t)m * DM, lane);
            if (layer == 0) {
                for (size_t i = (size_t)gt; i < (size_t)4096 * 8192 / 8; i += (size_t)NGT) {
                    const int sp = (int)(i >> 10), k0 = (int)(i & 1023) * 8, part = k0 >> 12, s0 = k0 & 4095; float v[8];
#pragma unroll
                    for (int j = 0; j < 8; ++j) { const float ang = (float)(((s0 + j) * sp) & 4095) * (1.f / 4096.f); v[j] = (part ? -__builtin_amdgcn_sinf(ang) : __builtin_amdgcn_cosf(ang)) * (1.f / 64.f); }
                    v4u o; o.x = pk2(v[0], v[1]); o.y = pk2(v[2], v[3]); o.z = pk2(v[4], v[5]); o.w = pk2(v[6], v[7]); ((GAS v4u*)DFT)[i] = o;
                }
                for (int i = gt; i < 65536; i += NGT) { const int r = i >> 8, c = i & 255, part = r >> 7, cp = r & 127; float v = 0.f;
                    if (c < 128) { const float ang = (float)((c * cp) & 127) * (1.f / 128.f); v = (part ? __builtin_amdgcn_sinf(ang) : __builtin_amdgcn_cosf(ang)) * 0.08838834764831845f; }
                    CS[i] = (bf16)f2bf(v); }
                for (int i = gt; i < 16 * 8192; i += NGT) { const int hd = i >> 13, off = (i & 8191) - 4096; float v;
                    if (hd < 12) { const int g = hd >> 2, dil = g == 0 ? 1 : (g == 1 ? 4 : 16); v = (off >= -64 && off <= 64) ? rel_bias[rel_bucket(off * dil) * 16 + hd] * 11.313708498984761f : -1.0e5f; }
                    else v = rel_bias[rel_bucket(off) * 16 + hd] * 11.313708498984761f;
                    TAB[i] = v; }
            }
        }
#endif
        GRID_BAR();

#if PH_B
        {
            pg8::Gemm g{WSP(bf16, WS_H), WSP(bf16, WS_WIN)}; pg8::StaticOrder S; S.init(MTOK, INW, G, bx, DM, DM);
            pg8::EpiProj E{WSP(bf16, WS_PROJ), WSP(bf16, WS_G), INL(5, GTW)};
            pg8::gemm_phase<pg8::EpiProj, pg8::StaticOrder, true, DM, DM, DM>(ldsl, g, S, E, wave0);
        }
#endif
        GRID_BAR();

#if PH_C
        {
            pg8::Gemm g{WSP(bf16, WS_CS), WSP(bf16, WS_PROJ)}; pg8::F1Order S{G, bx};
            pg8::EpiZT E{WSP(bf16, WS_ZT)};
            pg8::gemm_phase<pg8::EpiZT, pg8::F1Order, false, 256, PJW, 256>(ldsl, g, S, E, wave0);
        }
#endif
        GRID_BAR();

#if PH_D
#if PH_D1
        {
            pg8::Gemm g{WSP(bf16, WS_DFT), WSP(bf16, WS_ZT)}; pg8::F2Order S; S.init(4096, 2048, G, bx, 8192, 8192);
            pg8::EpiStore E{WSP(bf16, WS_OC), DM};
            pg8::gemm_phase<pg8::EpiStore, pg8::F2Order, false, 8192, 8192, 8192>(ldsl, g, S, E, wave0);
        }
#endif
#if PH_D2
        {
            PH_IDS();
            gu32* qhead = ctl + CW_QUEUE + 64 * layer;
            bf16* PROJ = WSP(bf16, WS_PROJ); bf16* DO = WSP(bf16, WS_MG); bf16* DL = WSP(bf16, WS_H); float* LSE = WSP(float, WS_LSE); const float* TAB = WSP(float, WS_TAB);
            const float* cur_tab = nullptr;
            for (;;) {
                __syncthreads();
                if (tid == 0) MISC[0] = __hip_atomic_fetch_add(qhead, 1u, __ATOMIC_RELAXED, __HIP_MEMORY_SCOPE_AGENT);
                __syncthreads();
                const int ui = __builtin_amdgcn_readfirstlane((int)MISC[0]);
                if (ui >= 1792) break;
                attn::Unit u; int hd;
                if (ui < 1024) {
                    const int qb = ui & 15, vh = (ui >> 4) & 1, m = (ui >> 5) & 1, h = (ui >> 6) & 3, b = ui >> 8;
                    const bf16* base = PROJ + (size_t)b * SEQ * PJW;
                    u.Q = base + (size_t)(qb * 256) * PJW + COL_DIFF + (h * 2 + m) * 128; u.K = base + COL_DIFF + 1024 + (h * 2 + m) * 128; u.V = base + COL_DIFF + 2048 + h * 256 + vh * 128;
                    u.O = DO + (size_t)(b * SEQ + qb * 256) * DM + (h * 2 + m) * 256 + vh * 128; u.lse = nullptr; u.ldq = PJW; u.ldk = PJW; u.ldo = DM; u.lse_ld = 0;
                    u.kt0 = 0; u.nt = SEQ / 64; u.qoff = qb * 256; hd = 12 + h;
                } else {
                    const int v = ui - 1024, qb16 = v & 15, hh = (v >> 4) & 3, bg = v >> 6, g = bg % 3, b = bg / 3;
                    const int dil = g == 0 ? 1 : (g == 1 ? 4 : 16), bpc = 16 / dil, r = qb16 / bpc, qblk = qb16 % bpc, q0 = qblk * 256, ntot = (SEQ / dil) / 64;
                    int kt0 = q0 / 64 - 1; if (kt0 < 0) kt0 = 0; int kt1 = q0 / 64 + 5; if (kt1 > ntot) kt1 = ntot;
                    if ((kt1 - kt0) & 1) { if (kt0 > 0) --kt0; else ++kt1; }
                    const bf16* base = PROJ + (size_t)(b * SEQ + r) * PJW + COL_DIL + g * 512 + hh * 128;
                    u.Q = base + (size_t)q0 * dil * PJW; u.K = base + 1536; u.V = base + 3072;
                    u.O = DL + ((size_t)g * MTOK + b * SEQ + r + (size_t)q0 * dil) * 512 + hh * 128; u.lse = LSE + ((size_t)g * MTOK + b * SEQ + r + (size_t)q0 * dil) * 4 + hh;
                    u.ldq = (long)PJW * dil; u.ldk = (long)PJW * dil; u.ldo = 512L * dil; u.lse_ld = 4 * dil; u.kt0 = kt0; u.nt = kt1 - kt0; u.qoff = q0; hd = g * 4 + hh;
                }
                const float* tab = TAB + (size_t)hd * 8192;
                if (tab != cur_tab) {
                    cur_tab = tab;
                    LAS f32x4* tl = (LAS f32x4*)(ldsl + attn::LDS_TAB); const int t2 = opaque_tid(wave0);
#pragma unroll
                    for (int j = 0; j < 4; ++j) tl[t2 + 512 * j] = ((const GAS f32x4*)tab)[t2 + 512 * j];
                }
                attn::attn_unit(u, (char*)lds, wave0);
            }
        }
#endif
#endif
        GRID_BAR();

#if PH_E
        {
            PH_IDS();
            const float* dlam = INL(9, 512); const float* subln = INL(10, 256); const float lambda_init = layer == 0 ? 0.2f : 0.35550906759f;
            const float* LSE = WSP(float, WS_LSE); const bf16* DL = WSP(bf16, WS_H); const bf16* DO = WSP(bf16, WS_MG); bf16* OC = WSP(bf16, WS_OC);
            float s1 = dlam[lane] * dlam[128 + lane] + dlam[64 + lane] * dlam[192 + lane], s2 = dlam[256 + lane] * dlam[384 + lane] + dlam[320 + lane] * dlam[448 + lane];
            s1 = wave_sum(s1); s2 = wave_sum(s2);
            const float lam = __expf(s1) - __expf(s2) + lambda_init, osc = 1.0f - lambda_init;
            const int hq = lane >> 4, l16 = lane & 15;
            for (int t = gw; t < MTOK; t += NGW) {
                float ls[3], mx = -3e38f;
#pragma unroll
                for (int g = 0; g < 3; ++g) { ls[g] = LSE[((size_t)g * MTOK + t) * 4 + hq]; mx = fmaxf(mx, ls[g]); }
                float wsum = 0.f;
#pragma unroll
                for (int g = 0; g < 3; ++g) { ls[g] = __expf(ls[g] - mx); wsum += ls[g]; }
                const float winv = 1.0f / wsum; float acc8[8] = {0.f, 0.f, 0.f, 0.f, 0.f, 0.f, 0.f, 0.f};
#pragma unroll
                for (int g = 0; g < 3; ++g) { const v4u o = *(const GAS v4u*)(DL + ((size_t)g * MTOK + t) * 512 + lane * 8); const float w = ls[g] * winv;
                    acc8[0] += w * bflo(o.x); acc8[1] += w * bfhi(o.x); acc8[2] += w * bflo(o.y); acc8[3] += w * bfhi(o.y); acc8[4] += w * bflo(o.z); acc8[5] += w * bfhi(o.z); acc8[6] += w * bflo(o.w); acc8[7] += w * bfhi(o.w); }
#if defined(DBG_ZERO_OB)
                for (int j = 0; j < 8; ++j) acc8[j] = 0.f;
#endif
                { v4u o; o.x = pk2(acc8[0], acc8[1]); o.y = pk2(acc8[2], acc8[3]); o.z = pk2(acc8[4], acc8[5]); o.w = pk2(acc8[6], acc8[7]); *(GAS v4u*)(OC + (size_t)t * DM + 512 + lane * 8) = o; }
                const bf16* dp = DO + (size_t)t * DM + hq * 512 + l16 * 16;
                const v4u a0 = *(const GAS v4u*)(dp), a1 = *(const GAS v4u*)(dp + 8), b0 = *(const GAS v4u*)(dp + 256), b1 = *(const GAS v4u*)(dp + 264);
                float d[16];
                d[0] = bflo(a0.x) - lam * bflo(b0.x); d[1] = bfhi(a0.x) - lam * bfhi(b0.x); d[2] = bflo(a0.y) - lam * bflo(b0.y); d[3] = bfhi(a0.y) - lam * bfhi(b0.y);
                d[4] = bflo(a0.z) - lam * bflo(b0.z); d[5] = bfhi(a0.z) - lam * bfhi(b0.z); d[6] = bflo(a0.w) - lam * bflo(b0.w); d[7] = bfhi(a0.w) - lam * bfhi(b0.w);
                d[8] = bflo(a1.x) - lam * bflo(b1.x); d[9] = bfhi(a1.x) - lam * bfhi(b1.x); d[10] = bflo(a1.y) - lam * bflo(b1.y); d[11] = bfhi(a1.y) - lam * bfhi(b1.y);
                d[12] = bflo(a1.z) - lam * bflo(b1.z); d[13] = bfhi(a1.z) - lam * bfhi(b1.z); d[14] = bflo(a1.w) - lam * bflo(b1.w); d[15] = bfhi(a1.w) - lam * bfhi(b1.w);
                float ss = 0.f;
#pragma unroll
                for (int j = 0; j < 16; ++j) ss += d[j] * d[j];
                ss += sx_f<1>(ss); ss += sx_f<2>(ss); ss += sx_f<4>(ss); ss += sx_f<8>(ss);
                const float rs = osc / sqrtf(ss * (1.f / 256.f) + RMS_EPS);
                const f32x4 g0 = *(const GAS f32x4*)(subln + l16 * 16), g1 = *(const GAS f32x4*)(subln + l16 * 16 + 4), g2 = *(const GAS f32x4*)(subln + l16 * 16 + 8), g3 = *(const GAS f32x4*)(subln + l16 * 16 + 12);
                v4u o0, o1;
                o0.x = pk2(d[0] * rs * g0.x, d[1] * rs * g0.y); o0.y = pk2(d[2] * rs * g0.z, d[3] * rs * g0.w); o0.z = pk2(d[4] * rs * g1.x, d[5] * rs * g1.y); o0.w = pk2(d[6] * rs * g1.z, d[7] * rs * g1.w);
                o1.x = pk2(d[8] * rs * g2.x, d[9] * rs * g2.y); o1.y = pk2(d[10] * rs * g2.z, d[11] * rs * g2.w); o1.z = pk2(d[12] * rs * g3.x, d[13] * rs * g3.y); o1.w = pk2(d[14] * rs * g3.z, d[15] * rs * g3.w);
                bf16* op = OC + (size_t)t * DM + 1024 + hq * 256 + l16 * 16;
                *(GAS v4u*)(op) = o0; *(GAS v4u*)(op + 8) = o1;
            }
        }
#endif
        GRID_BAR();

#if PH_F
        {
            pg8::StaticOrder S; S.init(MTOK, DM, G, bx, DM, DM);
            { pg8::Gemm g{WSP(bf16, WS_OC), WSP(bf16, WS_WCAT)}; pg8::EpiMerge3 E{WSP(bf16, WS_G), WSP(bf16, WS_MG), 0}; pg8::gemm_phase<pg8::EpiMerge3, pg8::StaticOrder, true, DM, DM, 512>(ldsl, g, S, E, wave0); }
            { pg8::Gemm g{WSP(bf16, WS_OC) + 512, WSP(bf16, WS_WCAT) + 512}; pg8::EpiMerge3 E{WSP(bf16, WS_G), WSP(bf16, WS_MG), 1}; pg8::gemm_phase<pg8::EpiMerge3, pg8::StaticOrder, true, DM, DM, 512>(ldsl, g, S, E, wave0); }
            { pg8::Gemm g{WSP(bf16, WS_OC) + 1024, WSP(bf16, WS_WCAT) + 1024}; pg8::EpiMerge3 E{WSP(bf16, WS_G), WSP(bf16, WS_MG), 2}; pg8::gemm_phase<pg8::EpiMerge3, pg8::StaticOrder, true, DM, DM, 1024>(ldsl, g, S, E, wave0); }
        }
#endif
        GRID_BAR();

#if PH_G
        {
            pg8::Gemm g{WSP(bf16, WS_MG), WSP(bf16, WS_WO)}; pg8::StaticOrder S; S.init(MTOK, DM, G, bx, DM, DM);
            pg8::EpiResF32 E{layer == 0 ? INP(0) : (const float*)X, X, DM};
            pg8::gemm_phase<pg8::EpiResF32, pg8::StaticOrder, true, DM, DM, DM>(ldsl, g, S, E, wave0);
        }
#endif
        GRID_BAR();

#if PH_H
        { PH_IDS(); const float* ffn_g = INL(12, DM); bf16* H = WSP(bf16, WS_H);
          for (int m = gw; m < MTOK; m += NGW) rms_row_to_bf16(X + (size_t)m * DM, ffn_g, H + (size_t)m * DM, lane); }
#endif
        GRID_BAR();

#if PH_I
        {
            pg8::Gemm g{WSP(bf16, WS_H), WSP(bf16, WS_WQ)}; pg8::StaticOrder S; S.init(MTOK, DM, G, bx, DM, DM);
            pg8::EpiStore E{WSP(bf16, WS_Q), DM};
            pg8::gemm_phase<pg8::EpiStore, pg8::StaticOrder, true, DM, DM, DM>(ldsl, g, S, E, wave0);
        }
#endif
        GRID_BAR();

#if PH_J
        {
            pg8::Gemm g{WSP(bf16, WS_Q), WSP(bf16, WS_SKBD)}; pg8::StaticOrder S; S.init(MTOK * 8, 256, G, bx, 256, 256);
            pg8::EpiResF32 E{nullptr, WSP(float, WS_SC), 256};
            pg8::gemm_phase<pg8::EpiResF32, pg8::StaticOrder, true, 256, 256, 256>(ldsl, g, S, E, wave0);
        }
#endif
        GRID_BAR();

#if PH_K
        {
            PH_IDS();
            const float* SC = WSP(float, WS_SC); int* IDS = WSP(int, WS_IDS); float* GATES = WSP(float, WS_GATES);
            int ci = -1, cj = 0; { int c = lane; for (int i = 0; i < 16; ++i) { const int cnt = 16 / (i + 1); if (ci < 0) { if (c < cnt) { ci = i; cj = c; } else c -= cnt; } } }
            for (int row = gw; row < MTOK * 8; row += NGW) {
                const float* sc = SC + (size_t)row * 256;
                const float s0 = sc[lane], s1 = sc[64 + lane], s2 = sc[128 + lane], s3 = sc[192 + lane];
                unsigned k0 = (okey(s0) & ~127u) | (unsigned)(127 - lane), k1 = (okey(s1) & ~127u) | (unsigned)(63 - lane);
                unsigned k2 = (okey(s2) & ~127u) | (unsigned)(127 - lane), k3 = (okey(s3) & ~127u) | (unsigned)(63 - lane);
                unsigned ta = 0u, tb = 0u;
                for (int r = 0; r < 16; ++r) {
                    const unsigned ma = wave_max_dpp(k0 > k1 ? k0 : k1), mb = wave_max_dpp(k2 > k3 ? k2 : k3);
                    if (k0 == ma) k0 = 0u; if (k1 == ma) k1 = 0u; if (k2 == mb) k2 = 0u; if (k3 == mb) k3 = 0u;
                    if (lane == r) { ta = ma; tb = mb; }
                }
                const int ia = 127 - (int)(ta & 127u), ib = 127 - (int)(tb & 127u);
                const float va = sc[ia], vb = sc[128 + ib];
                const float cs = bperm_f(va, ci < 0 ? 0 : ci) + bperm_f(vb, cj);
                unsigned ck = ci < 0 ? 0u : ((okey(cs) & ~255u) | (unsigned)(255 - (ci * 16 + cj)));
                unsigned tw = 0u;
                for (int r = 0; r < 16; ++r) { const unsigned mm = wave_max_dpp(ck); if (ck == mm) ck = 0u; if (lane == r) tw = mm; }
                const int code = 255 - (int)(tw & 255u), wi = (code >> 4) & 15, wj = code & 15;
                const float bs = bperm_f(va, wi) + bperm_f(vb, wj);
                const int eid = bperm_i(ia, wi) * 128 + bperm_i(ib, wj);
                float mx = lane < 16 ? bs : -3e38f;
                mx = fmaxf(mx, sx_f<8>(mx)); mx = fmaxf(mx, sx_f<4>(mx)); mx = fmaxf(mx, sx_f<2>(mx)); mx = fmaxf(mx, sx_f<1>(mx));
                const float e = lane < 16 ? __expf(bs - mx) : 0.f; float es = e;
                es += sx_f<8>(es); es += sx_f<4>(es); es += sx_f<2>(es); es += sx_f<1>(es);
                if (lane < 16) { IDS[(size_t)row * 16 + lane] = eid; GATES[(size_t)row * 16 + lane] = e / es; }
            }
        }
#endif
        GRID_BAR();

#if PH_L
        {
            PH_IDS();
            const bf16* H = WSP(bf16, WS_H); const unsigned char* U8 = WSP(unsigned char, WS_U); const unsigned char* V8 = WSP(unsigned char, WS_V); const int* IDS = WSP(int, WS_IDS); const float* GATES = WSP(float, WS_GATES);
            typedef float f32x2 __attribute__((ext_vector_type(2)));
            for (int t = gw; t < MTOK; t += NGW) {
                f32x2 hf[16];
#pragma unroll
                for (int c = 0; c < 2; ++c) { const GAS v4u* hp = (const GAS v4u*)(H + (size_t)t * DM + c * 1024 + lane * 16); const v4u h0 = hp[0], h1 = hp[1];
                    hf[c * 8 + 0] = (f32x2){bflo(h0.x), bfhi(h0.x)}; hf[c * 8 + 1] = (f32x2){bflo(h0.y), bfhi(h0.y)}; hf[c * 8 + 2] = (f32x2){bflo(h0.z), bfhi(h0.z)}; hf[c * 8 + 3] = (f32x2){bflo(h0.w), bfhi(h0.w)};
                    hf[c * 8 + 4] = (f32x2){bflo(h1.x), bfhi(h1.x)}; hf[c * 8 + 5] = (f32x2){bflo(h1.y), bfhi(h1.y)}; hf[c * 8 + 6] = (f32x2){bflo(h1.z), bfhi(h1.z)}; hf[c * 8 + 7] = (f32x2){bflo(h1.w), bfhi(h1.w)}; }
                const int id0 = IDS[(size_t)t * 128 + lane], id1 = IDS[(size_t)t * 128 + 64 + lane];
                const float gt0 = GATES[(size_t)t * 128 + lane], gt1 = GATES[(size_t)t * 128 + 64 + lane];
                float pre0 = 0.f, pre1 = 0.f;
                for (int half = 0; half < 2; ++half) {
                    const int idr = half ? id1 : id0; float prer = 0.f;
                    for (int e8 = 0; e8 < 64; e8 += 8) {
                        v4u w[8][2];
#pragma unroll
                        for (int x = 0; x < 8; ++x) { const int id = __builtin_amdgcn_readlane(idr, e8 + x); const GAS v4u* rp = (const GAS v4u*)(U8 + (size_t)id * DM) + lane; w[x][0] = rp[0]; w[x][1] = rp[64]; }
                        float p[8];
#pragma unroll
                        for (int x = 0; x < 8; ++x) { f32x2 s2 = (f32x2){0.f, 0.f};
#pragma unroll
                            for (int c = 0; c < 2; ++c) { const v4u ww = w[x][c]; const unsigned d0 = ww.x, d1 = ww.y, d2 = ww.z, d3 = ww.w;
                                s2 += __builtin_amdgcn_cvt_pk_f32_fp8((int)d0, false) * hf[c * 8 + 0]; s2 += __builtin_amdgcn_cvt_pk_f32_fp8((int)d0, true) * hf[c * 8 + 1];
                                s2 += __builtin_amdgcn_cvt_pk_f32_fp8((int)d1, false) * hf[c * 8 + 2]; s2 += __builtin_amdgcn_cvt_pk_f32_fp8((int)d1, true) * hf[c * 8 + 3];
                                s2 += __builtin_amdgcn_cvt_pk_f32_fp8((int)d2, false) * hf[c * 8 + 4]; s2 += __builtin_amdgcn_cvt_pk_f32_fp8((int)d2, true) * hf[c * 8 + 5];
                                s2 += __builtin_amdgcn_cvt_pk_f32_fp8((int)d3, false) * hf[c * 8 + 6]; s2 += __builtin_amdgcn_cvt_pk_f32_fp8((int)d3, true) * hf[c * 8 + 7]; }
                            p[x] = s2.x + s2.y; }
                        const bool u32 = lane >= 32, u16 = (lane & 16) != 0, u8 = (lane & 8) != 0;
                        float a0 = u32 ? p[4] : p[0], a1 = u32 ? p[5] : p[1], a2 = u32 ? p[6] : p[2], a3 = u32 ? p[7] : p[3];
                        a0 += other32(u32 ? p[0] : p[4], u32); a1 += other32(u32 ? p[1] : p[5], u32); a2 += other32(u32 ? p[2] : p[6], u32); a3 += other32(u32 ? p[3] : p[7], u32);
                        float b0 = u16 ? a2 : a0, b1 = u16 ? a3 : a1;
                        b0 += sx_f<16>(u16 ? a0 : a2); b1 += sx_f<16>(u16 ? a1 : a3);
                        float k2 = u8 ? b1 : b0; k2 += sx_f<8>(u8 ? b0 : b1);
                        k2 += sx_f<4>(k2); k2 += sx_f<2>(k2); k2 += sx_f<1>(k2);
                        const float dv = bperm_f(k2, 8 * (lane & 7));
                        if ((lane & ~7) == e8) prer = dv;
                    }
                    if (half) pre1 = prer; else pre0 = prer;
                }
                pre0 *= (1.f / 1024.f); pre1 *= (1.f / 1024.f);
                const float ac0 = 0.5f * pre0 * (1.0f + erff(pre0 * 0.70710678118654752f)) * gt0 * (1.f / 64.f), ac1 = 0.5f * pre1 * (1.0f + erff(pre1 * 0.70710678118654752f)) * gt1 * (1.f / 64.f);
                f32x2 oacc[16];
#pragma unroll
                for (int j = 0; j < 16; ++j) oacc[j] = (f32x2){0.f, 0.f};
                for (int half = 0; half < 2; ++half) {
                    const int idr = half ? id1 : id0; const float acr = half ? ac1 : ac0;
                    for (int e8 = 0; e8 < 64; e8 += 8) {
                        v4u w[8][2];
#pragma unroll
                        for (int x = 0; x < 8; ++x) { const int id = __builtin_amdgcn_readlane(idr, e8 + x); const GAS v4u* rp = (const GAS v4u*)(V8 + (size_t)id * DM) + lane; w[x][0] = rp[0]; w[x][1] = rp[64]; }
#pragma unroll
                        for (int x = 0; x < 8; ++x) { const float a = __uint_as_float((unsigned)__builtin_amdgcn_readlane((int)__float_as_uint(acr), e8 + x)); const f32x2 aa = (f32x2){a, a};
#pragma unroll
                            for (int c = 0; c < 2; ++c) { const v4u ww = w[x][c]; const unsigned d0 = ww.x, d1 = ww.y, d2 = ww.z, d3 = ww.w;
                                oacc[c * 8 + 0] += aa * __builtin_amdgcn_cvt_pk_f32_fp8((int)d0, false); oacc[c * 8 + 1] += aa * __builtin_amdgcn_cvt_pk_f32_fp8((int)d0, true);
                                oacc[c * 8 + 2] += aa * __builtin_amdgcn_cvt_pk_f32_fp8((int)d1, false); oacc[c * 8 + 3] += aa * __builtin_amdgcn_cvt_pk_f32_fp8((int)d1, true);
                                oacc[c * 8 + 4] += aa * __builtin_amdgcn_cvt_pk_f32_fp8((int)d2, false); oacc[c * 8 + 5] += aa * __builtin_amdgcn_cvt_pk_f32_fp8((int)d2, true);
                                oacc[c * 8 + 6] += aa * __builtin_amdgcn_cvt_pk_f32_fp8((int)d3, false); oacc[c * 8 + 7] += aa * __builtin_amdgcn_cvt_pk_f32_fp8((int)d3, true); }
                        }
                    }
                }
                float* xp = X + (size_t)t * DM + lane * 16;
#pragma unroll
                for (int c = 0; c < 2; ++c) { GAS f32x4* q = (GAS f32x4*)(xp + c * 1024);
#pragma unroll
                    for (int k = 0; k < 4; ++k) { f32x4 v = q[k];
#if DBG_MODE == 2
                        v = (f32x4){0.f, 0.f, 0.f, 0.f};
#endif
                        v.x += oacc[c * 8 + 2 * k].x; v.y += oacc[c * 8 + 2 * k].y; v.z += oacc[c * 8 + 2 * k + 1].x; v.w += oacc[c * 8 + 2 * k + 1].y; q[k] = v; } }
            }
        }
#endif
        GRID_BAR();
    }

    { PH_IDS();
    for (int m = gw; m < MTOK; m += NGW) {
        GAS f32x4* xr = (GAS f32x4*)(X + (size_t)m * DM) + lane; const GAS f32x4* gr = (const GAS f32x4*)INP(2) + lane;
        f32x4 v[8]; float s = 0.f;
#pragma unroll
        for (int j = 0; j < 8; ++j) { v[j] = xr[64 * j]; s += (v[j].x * v[j].x + v[j].y * v[j].y) + (v[j].z * v[j].z + v[j].w * v[j].w); }
        const float rstd = 1.0f / sqrtf(wave_sum(s) * (1.f / DM) + RMS_EPS);
#pragma unroll
        for (int j = 0; j < 8; ++j) { const f32x4 gg = gr[64 * j]; xr[64 * j] = v[j] * rstd * gg; }
    } }
}

extern "C" void kernel_launch(void* const* d_in, const int* in_sizes, int n_in, void* d_out, int out_size, void* d_ws, size_t ws_size, hipStream_t stream) {
    static int grid = 0;
    if (grid == 0) {
        if (n_in != 17 || in_sizes[0] != MTOK * DM || out_size != MTOK * DM || ws_size < WS_END) {
            fprintf(stderr, "kernel_launch: shape/workspace mismatch: n_in %d in0 %d out %d ws %zu (need %zu); nothing launched\n", n_in, n_in > 0 ? in_sizes[0] : -1, out_size, ws_size, (size_t)WS_END); grid = -1; return; }
        int dev = 0, cus = 0, per_cu = 0;
        if (hipGetDevice(&dev) != hipSuccess || hipDeviceGetAttribute(&cus, hipDeviceAttributeMultiprocessorCount, dev) != hipSuccess) { grid = -1; return; }
        if (hipFuncSetAttribute((const void*)mk_fwd, hipFuncAttributeMaxDynamicSharedMemorySize, LDS_BYTES) != hipSuccess) { fprintf(stderr, "kernel_launch: hipFuncSetAttribute failed\n"); grid = -1; return; }
        if (hipOccupancyMaxActiveBlocksPerMultiprocessor(&per_cu, (const void*)mk_fwd, NWAVES * 64, LDS_BYTES) != hipSuccess || per_cu < 1)
            fprintf(stderr, "kernel_launch: note: occupancy query reports %d workgroups per CU\n", per_cu);
        (void)hipGetLastError();
        grid = cus;
    }
    if (grid < 0) return;
    if (hipMemsetAsync((char*)d_ws + WS_CTL, 0, CTL_ZERO_BYTES, stream) != hipSuccess) { fprintf(stderr, "kernel_launch: memset failed\n"); return; }
    Args a{};
    for (int i = 0; i < 17; ++i) a.in[i] = (const float*)d_in[i];
    a.out = (float*)d_out; a.ws = (unsigned char*)d_ws;
    hipLaunchKernelGGL(mk_fwd, dim3(grid), dim3(NWAVES * 64), LDS_BYTES, stream, a);
    const hipError_t le = hipPeekAtLastError();
    if (le != hipSuccess) fprintf(stderr, "kernel_launch: launch failed: %s\n", hipGetErrorName(le));
}
```

```cpp
#include <hip/hip_runtime.h>
#include <cstdio>
#include <cstdint>

#ifndef DBG_MODE
#define DBG_MODE 0
#endif
constexpr int DM = 2048, NB = 4, SEQ = 4096, MTOK = NB * SEQ;
constexpr int INW = 14336, PJW = 8192, GTW = 6144;
constexpr int COL_DIL = 512, COL_DIFF = 5120;
constexpr int NEXP = 16384;
constexpr float RMS_EPS = 1e-6f;

typedef unsigned short bf16;
#define GAS __attribute__((address_space(1)))
#define LAS __attribute__((address_space(3)))
typedef unsigned v4u __attribute__((ext_vector_type(4)));
typedef float f32x4 __attribute__((ext_vector_type(4)));
typedef GAS unsigned gu32;

__device__ __forceinline__ int opaque_tid(int wave_sgpr) { int l; asm volatile("v_mbcnt_lo_u32_b32 %0, -1, 0\n\tv_mbcnt_hi_u32_b32 %0, -1, %0" : "=v"(l)); return wave_sgpr * 64 + l; }
namespace pg8 {
#define PG8_LAS __attribute__((address_space(3)))
typedef unsigned short bf16_t;
typedef short bf16x8 __attribute__((ext_vector_type(8)));
typedef float f32x4 __attribute__((ext_vector_type(4)));
typedef unsigned u32x4 __attribute__((ext_vector_type(4)));
constexpr int BM = 256, BK = 64, HALF = 128, HTB = HALF * BK * 2, STAGE_BYTES = 8 * HTB, NXCD = 8, WGM = 8;

__host__ __device__ __forceinline__ int lds_byte(int r, int c) { const int st = (r >> 4) * 2 + (c >> 5), rr = r & 15, cc = c & 31, ob = rr * 64 + cc * 2; return st * 1024 + (ob ^ (((ob >> 9) & 1) << 5)); }
__host__ __device__ __forceinline__ void stage_rc(int b, int& R, int& C) { const int st = b / 1024, sb = b % 1024, swz = sb ^ (((sb >> 9) & 1) << 5); R = (st >> 1) * 16 + swz / 64; C = (st & 1) * 32 + (swz % 64) / 2; }
__host__ __device__ __forceinline__ int perm32(int rho) { const int n = rho >> 4, i = rho & 15; return 8 * (i >> 2) + 4 * n + (i & 3); }

struct Unit { int pm, pn; long aoff, boff; int orow, ocol; };
struct Gemm { const bf16_t* A; const bf16_t* Bt; };

struct StaticOrder {
    int nM, nN, nwg, G, c; long sa, sb;
    __device__ void init(int M, int N, int G_, int c_, int lda, int ldb) { nM = M / BM; nN = N / BM; nwg = nM * nN; G = G_; c = c_; sa = 512L * lda; sb = 512L * ldb; }
    __device__ bool next(int i, Unit& u) const {
        const long L = (long)i * G + c; if (L >= nwg) return false;
        int wgid = (int)L; { const int q = nwg / NXCD, r = nwg % NXCD, xcd = wgid % NXCD, off = wgid / NXCD; wgid = (xcd < r ? xcd * (q + 1) : r * (q + 1) + (xcd - r) * q) + off; }
        const int nig = WGM * nN, gid = wgid / nig, fm = gid * WGM, gsz = (nM - fm) < WGM ? (nM - fm) : WGM;
        u.pm = fm + ((wgid % nig) % gsz); u.pn = (wgid % nig) / gsz;
        u.aoff = u.pm * sa; u.boff = u.pn * sb; u.orow = u.pm * BM; u.ocol = u.pn * BM; return true;
    }
};
struct F2Order : StaticOrder {
    __device__ bool next(int i, Unit& u) const { if (!StaticOrder::next(i, u)) return false; u.orow = (u.pn >> 1) * 4096 + u.pm * BM; u.ocol = (u.pn & 1) * BM; return true; }
};
struct F1Order {
    int G, c;
    __device__ bool next(int i, Unit& u) const {
        const int idx = i * G + c; if (idx >= 256) return false;
        const int bg = idx >> 4, st = idx & 15, b = bg >> 2, g = bg & 3;
        u.pm = 0; u.pn = idx; u.aoff = 0; u.boff = ((long)(b * 4096 + st * 256) * PJW + g * 128) * 2; u.orow = bg * 128; u.ocol = st * 256; return true;
    }
};

__device__ __forceinline__ unsigned cvt_pk_bf16(float lo, float hi) { unsigned r; asm volatile("v_cvt_pk_bf16_f32 %0, %1, %2" : "=v"(r) : "v"(lo), "v"(hi)); return r; }
__device__ __forceinline__ float bf_lo(unsigned w) { return __uint_as_float(w << 16); }
__device__ __forceinline__ float bf_hi(unsigned w) { return __uint_as_float(w & 0xffff0000u); }

#define PG8_PACK(v0, v1, w) do { (w).x = cvt_pk_bf16((v0)[0], (v0)[1]); (w).y = cvt_pk_bf16((v0)[2], (v0)[3]); (w).z = cvt_pk_bf16((v1)[0], (v1)[1]); (w).w = cvt_pk_bf16((v1)[2], (v1)[3]); } while (0)

struct EpiStore {
    static constexpr bool PERM = true;
    bf16_t* O; int ldo;
    __device__ __forceinline__ void operator()(const f32x4 (&acc)[2][2][4][2], const Unit& u, int wr, int wc, int fr, int fq) const {
        const int row0 = u.orow + wr * 64 + fr, col0 = u.ocol + wc * 32 + 8 * fq;
#pragma unroll
        for (int ai = 0; ai < 2; ++ai)
#pragma unroll
            for (int m = 0; m < 4; ++m) { bf16_t* rowp = O + (size_t)(row0 + ai * HALF + m * 16) * ldo + col0;
#pragma unroll
                for (int bj = 0; bj < 2; ++bj) { u32x4 w; PG8_PACK(acc[ai][bj][m][0], acc[ai][bj][m][1], w); *(u32x4*)(rowp + bj * HALF) = w; } }
    }
};
struct EpiZT {
    static constexpr bool PERM = true;
    bf16_t* O;
    __device__ __forceinline__ void operator()(const f32x4 (&acc)[2][2][4][2], const Unit& u, int wr, int wc, int fr, int fq) const {
        const int row0 = u.orow + wr * 64 + fr, col0 = u.ocol + wc * 32 + 8 * fq;
#pragma unroll
        for (int ai = 0; ai < 2; ++ai)
#pragma unroll
            for (int m = 0; m < 4; ++m) { bf16_t* rowp = O + (size_t)(row0 + m * 16) * 8192 + ai * 4096 + col0;
#pragma unroll
                for (int bj = 0; bj < 2; ++bj) { u32x4 w; PG8_PACK(acc[ai][bj][m][0], acc[ai][bj][m][1], w); *(u32x4*)(rowp + bj * HALF) = w; } }
    }
};
struct EpiProj {
    static constexpr bool PERM = true;
    bf16_t* P; bf16_t* Gt; const float* bg;
    __device__ __forceinline__ void operator()(const f32x4 (&acc)[2][2][4][2], const Unit& u, int wr, int wc, int fr, int fq) const {
        const bool isg = u.pn >= 32;
        const int row0 = u.pm * BM + wr * 64 + fr, col0 = (isg ? u.pn - 32 : u.pn) * BM + wc * 32 + 8 * fq, ldc = isg ? GTW : PJW;
        bf16_t* base = isg ? Gt : P;
        f32x4 bv[2][2];
#pragma unroll
        for (int bj = 0; bj < 2; ++bj)
#pragma unroll
            for (int n = 0; n < 2; ++n) bv[bj][n] = isg ? *(const f32x4*)(bg + col0 + bj * HALF + 4 * n) : (f32x4){0.f, 0.f, 0.f, 0.f};
#pragma unroll
        for (int ai = 0; ai < 2; ++ai)
#pragma unroll
            for (int m = 0; m < 4; ++m) { bf16_t* rowp = base + (size_t)(row0 + ai * HALF + m * 16) * ldc + col0;
#pragma unroll
                for (int bj = 0; bj < 2; ++bj) { f32x4 v0 = acc[ai][bj][m][0] + bv[bj][0], v1 = acc[ai][bj][m][1] + bv[bj][1];
                    if (isg) {
#pragma unroll
                        for (int j = 0; j < 4; ++j) { v0[j] = __builtin_amdgcn_rcpf(1.0f + __builtin_amdgcn_exp2f(-1.4426950408889634f * v0[j])); v1[j] = __builtin_amdgcn_rcpf(1.0f + __builtin_amdgcn_exp2f(-1.4426950408889634f * v1[j])); } }
                    u32x4 w; PG8_PACK(v0, v1, w); *(u32x4*)(rowp + bj * HALF) = w; } }
    }
};
struct EpiMerge3 {
    static constexpr bool PERM = true;
    const bf16_t* Gt; bf16_t* O; int br;
    __device__ __forceinline__ void operator()(const f32x4 (&acc)[2][2][4][2], const Unit& u, int wr, int wc, int fr, int fq) const {
        const int row0 = u.pm * BM + wr * 64 + fr, col0 = u.pn * BM + wc * 32 + 8 * fq;
#pragma unroll
        for (int ai = 0; ai < 2; ++ai)
#pragma unroll
            for (int m = 0; m < 4; ++m) { const bf16_t* gp = Gt + (size_t)(row0 + ai * HALF + m * 16) * GTW + br * DM + col0; bf16_t* rowp = O + (size_t)(row0 + ai * HALF + m * 16) * DM + col0;
#pragma unroll
                for (int bj = 0; bj < 2; ++bj) { const u32x4 g = *(const u32x4*)(gp + bj * HALF);
                    f32x4 v0 = acc[ai][bj][m][0], v1 = acc[ai][bj][m][1];
                    v0[0] *= bf_lo(g.x); v0[1] *= bf_hi(g.x); v0[2] *= bf_lo(g.y); v0[3] *= bf_hi(g.y);
                    v1[0] *= bf_lo(g.z); v1[1] *= bf_hi(g.z); v1[2] *= bf_lo(g.w); v1[3] *= bf_hi(g.w);
                    if (br) { const u32x4 p = *(const u32x4*)(rowp + bj * HALF);
                        v0[0] += bf_lo(p.x); v0[1] += bf_hi(p.x); v0[2] += bf_lo(p.y); v0[3] += bf_hi(p.y);
                        v1[0] += bf_lo(p.z); v1[1] += bf_hi(p.z); v1[2] += bf_lo(p.w); v1[3] += bf_hi(p.w); }
                    u32x4 w; PG8_PACK(v0, v1, w); *(u32x4*)(rowp + bj * HALF) = w; }
                asm volatile("" ::: "memory"); }
    }
};
struct EpiResF32 {
    static constexpr bool PERM = false;
    const float* base; float* out; int ldc;
    __device__ __forceinline__ void operator()(const f32x4 (&acc)[2][2][4][2], const Unit& u, int wr, int wc, int fr, int fq) const {
        const int row0 = u.orow + wr * 64 + fr, col0 = u.ocol + wc * 32 + 4 * fq;
#pragma unroll
        for (int ai = 0; ai < 2; ++ai)
#pragma unroll
            for (int m = 0; m < 4; ++m) { const size_t off = (size_t)(row0 + ai * HALF + m * 16) * ldc + col0;
#pragma unroll
                for (int bj = 0; bj < 2; ++bj)
#pragma unroll
                    for (int n = 0; n < 2; ++n) { f32x4 v = acc[ai][bj][m][n]; if (base) v += *(const f32x4*)(base + off + bj * HALF + n * 16); *(f32x4*)(out + off + bj * HALF + n * 16) = v; }
                asm volatile("" ::: "memory"); }
    }
};

template <class Epi, class Sched, bool ALIGN_EPI, int LDA, int LDB, int KK>
__device__ __forceinline__ void gemm_phase(PG8_LAS unsigned char* lds, const Gemm g, const Sched& S, const Epi& E, int wave0) {
    const int tid = opaque_tid(wave0), wid = wave0, lane = tid & 63, wr = wid >> 2, wc = wid & 3, fr = lane & 15, fq = lane >> 4;
    constexpr int nt = KK / BK;
    unsigned voffA[2], voffB[2];
#pragma unroll
    for (int i = 0; i < 2; ++i) { int R, C; stage_rc(tid * 16 + i * 8192, R, C); const int Rb = Epi::PERM ? ((R & ~31) + perm32(R & 31)) : R;
        voffA[i] = (unsigned)(R * LDA + C) * 2u; voffB[i] = (unsigned)(Rb * LDB + C) * 2u; }
    const size_t kstep = (size_t)(BK * 2);
    constexpr size_t hstepA = (size_t)HALF * LDA * 2, hstepB = (size_t)HALF * LDB * 2;
    const unsigned ldsw = (unsigned)wid * 1024u;
    const int aoff = lds_byte(wr * 64 + fr, fq * 8), boff = lds_byte(wc * 32 + fr, fq * 8);
#define PG8_SA(b, h) (((b) * 2 + (h)) * HTB)
#define PG8_SB(b, h) ((4 + (b) * 2 + (h)) * HTB)
#define PG8_STAGE(bufoff, gbase, voff) do { _Pragma("unroll") for (int _i = 0; _i < 2; ++_i) \
        __builtin_amdgcn_global_load_lds((const unsigned*)((const char*)(gbase) + (voff)[_i]), (PG8_LAS unsigned*)(lds + (bufoff) + ldsw + _i * 8192), 16, 0, 0); } while (0)
#define PG8_LDA(dst, b, h) do { _Pragma("unroll") for (int m = 0; m < 4; ++m) _Pragma("unroll") for (int k = 0; k < 2; ++k) dst[m][k] = *(const PG8_LAS bf16x8*)(lds + PG8_SA(b, h) + aoff + m * 2048 + k * 1024); } while (0)
#define PG8_LDB(dst, b, h) do { _Pragma("unroll") for (int n = 0; n < 2; ++n) _Pragma("unroll") for (int k = 0; k < 2; ++k) dst[n][k] = *(const PG8_LAS bf16x8*)(lds + PG8_SB(b, h) + boff + n * 2048 + k * 1024); } while (0)
#define PG8_MMA(ai, bj, At, Bt) do { __builtin_amdgcn_s_setprio(1); _Pragma("unroll") for (int m = 0; m < 4; ++m) _Pragma("unroll") for (int n = 0; n < 2; ++n) _Pragma("unroll") for (int k = 0; k < 2; ++k) \
        acc[ai][bj][m][n] = __builtin_amdgcn_mfma_f32_16x16x32_bf16(Bt[n][k], At[m][k], acc[ai][bj][m][n], 0, 0, 0); __builtin_amdgcn_s_setprio(0); } while (0)
#define PG8_WAIT_V(n) asm volatile("s_waitcnt vmcnt(" #n ")" ::: "memory")
#define PG8_WAIT_L(n) asm volatile("s_waitcnt lgkmcnt(" #n ")" ::: "memory")
#define PG8_BAR __builtin_amdgcn_s_barrier()
#define PG8_SCHED __builtin_amdgcn_sched_barrier(0)
    Unit cur, nxt; int ui = 0;
    if (!S.next(0, cur)) return;
    f32x4 acc[2][2][4][2];
#pragma unroll
    for (int a = 0; a < 2; ++a)
#pragma unroll
        for (int b = 0; b < 2; ++b)
#pragma unroll
            for (int m = 0; m < 4; ++m)
#pragma unroll
                for (int n = 0; n < 2; ++n) acc[a][b][m][n] = (f32x4){0.f, 0.f, 0.f, 0.f};
    bf16x8 At[4][2], B0[2][2], B1[2][2];
    const char* cA = (const char*)g.A + cur.aoff; const char* cB = (const char*)g.Bt + cur.boff;
    PG8_STAGE(PG8_SB(0, 0), cB, voffB); PG8_STAGE(PG8_SB(0, 1), cB + hstepB, voffB); PG8_STAGE(PG8_SA(0, 0), cA, voffA); PG8_STAGE(PG8_SA(0, 1), cA + hstepA, voffA);
    if (wr == 1) PG8_BAR;
    PG8_WAIT_V(2); PG8_BAR;
    PG8_STAGE(PG8_SB(1, 0), cB + kstep, voffB); PG8_STAGE(PG8_SA(1, 0), cA + kstep, voffA); PG8_STAGE(PG8_SB(1, 1), cB + hstepB + kstep, voffB);
    PG8_WAIT_V(6); PG8_BAR;
    for (;;) {
        const bool has_next = S.next(ui + 1, nxt);
        const char* nA = has_next ? (const char*)g.A + nxt.aoff : cA; const char* nB = has_next ? (const char*)g.Bt + nxt.boff : cB;
        for (int t = 0; t < nt; t += 2) {
            const bool last = (t == nt - 2);
            const char* a1 = cA + (size_t)(t + 1) * kstep;
            const char* a2 = last ? nA : cA + (size_t)(t + 2) * kstep; const char* b2 = last ? nB : cB + (size_t)(t + 2) * kstep;
            const char* a3 = a2 + kstep; const char* b3 = b2 + kstep;
            PG8_LDB(B0, 0, 0); PG8_LDB(B1, 0, 1); PG8_SCHED; PG8_LDA(At, 0, 0); PG8_STAGE(PG8_SA(1, 1), a1 + hstepA, voffA);
            PG8_WAIT_V(8); PG8_WAIT_L(0); PG8_BAR; PG8_MMA(0, 0, At, B0); PG8_MMA(0, 1, At, B1); PG8_BAR; PG8_SCHED;
            PG8_LDA(At, 0, 1); PG8_STAGE(PG8_SB(0, 0), b2, voffB); PG8_STAGE(PG8_SB(0, 1), b2 + hstepB, voffB); PG8_STAGE(PG8_SA(0, 0), a2, voffA);
            PG8_WAIT_V(8); PG8_WAIT_L(0); PG8_BAR; PG8_MMA(1, 0, At, B0); PG8_MMA(1, 1, At, B1); PG8_BAR; PG8_SCHED;
            PG8_LDB(B0, 1, 0); PG8_LDB(B1, 1, 1); PG8_SCHED; PG8_LDA(At, 1, 0); PG8_STAGE(PG8_SA(0, 1), a2 + hstepA, voffA);
            PG8_WAIT_V(8); PG8_WAIT_L(0); PG8_BAR; PG8_MMA(0, 0, At, B0); PG8_MMA(0, 1, At, B1); PG8_BAR; PG8_SCHED;
            PG8_LDA(At, 1, 1); PG8_STAGE(PG8_SB(1, 0), b3, voffB); PG8_STAGE(PG8_SB(1, 1), b3 + hstepB, voffB); PG8_STAGE(PG8_SA(1, 0), a3, voffA);
            PG8_WAIT_V(8); PG8_WAIT_L(0); PG8_BAR; PG8_MMA(1, 0, At, B0); PG8_MMA(1, 1, At, B1); PG8_BAR; PG8_SCHED;
        }
        if constexpr (ALIGN_EPI) { if (wr == 0) PG8_BAR; }
        E(acc, cur, wr, wc, fr, fq);
        if (!has_next) break;
#pragma unroll
        for (int a = 0; a < 2; ++a)
#pragma unroll
            for (int b = 0; b < 2; ++b)
#pragma unroll
                for (int m = 0; m < 4; ++m)
#pragma unroll
                    for (int n = 0; n < 2; ++n) acc[a][b][m][n] = (f32x4){0.f, 0.f, 0.f, 0.f};
        cur = nxt; cA = nA; cB = nB; ++ui;
        if constexpr (ALIGN_EPI) { if (wr == 1) PG8_BAR; }
    }
    PG8_WAIT_V(0);
    if constexpr (!ALIGN_EPI) { if (wr == 0) PG8_BAR; }
    PG8_BAR;
#undef PG8_SA
#undef PG8_SB
#undef PG8_STAGE
#undef PG8_LDA
#undef PG8_LDB
#undef PG8_MMA
#undef PG8_WAIT_V
#undef PG8_WAIT_L
#undef PG8_BAR
#undef PG8_SCHED
}
}

namespace attn {
using bf16x8 = __attribute__((ext_vector_type(8))) short;
using s16x4  = __attribute__((ext_vector_type(4))) short;
using f32x16 = __attribute__((ext_vector_type(16))) float;
using u32x4  = __attribute__((ext_vector_type(4))) unsigned;
constexpr int   D = 128, NW = 8, QBLK = 32, KVBLK = 64;
constexpr float SCALE = 0.088388347648318440f;
constexpr float THR = 8.f;
constexpr size_t SHM_V = KVBLK * D * 2, SHM_K = KVBLK * D * 2;
constexpr int LDS_WS = 2 * SHM_V + 2 * SHM_K, LDS_TAB = LDS_WS + NW * 64 * 4, LDS_END = LDS_TAB + 8192 * 4;
#define KSWZ(row, colB) ((row) * 256 + ((colB) ^ (((row) & 7) << 4)))
#define SBAR() __builtin_amdgcn_sched_barrier(0)
__device__ __forceinline__ int crow(int r, int hi) { return (r & 3) + 8 * (r >> 2) + 4 * hi; }
__device__ __forceinline__ unsigned cvtpk(float lo, float hi) { unsigned r; asm volatile("v_cvt_pk_bf16_f32 %0, %1, %2" : "=v"(r) : "v"(lo), "v"(hi)); return r; }

__device__ __forceinline__ void partialSM(f32x16& p0, f32x16& p1, float& m_reg, float& mn, float& alpha) {
  constexpr float C = SCALE * 1.4426950408889634f;
  float pmax = p0[0]; for (int r = 1; r < 16; ++r) pmax = fmaxf(pmax, p0[r]); for (int r = 0; r < 16; ++r) pmax = fmaxf(pmax, p1[r]);
  { auto rr = __builtin_amdgcn_permlane32_swap(__float_as_uint(pmax), __float_as_uint(pmax), false, false);
    pmax = fmaxf(__uint_as_float(rr[0]), __uint_as_float(rr[1])); }
  if (__builtin_expect(__all(pmax - m_reg <= THR / SCALE), 1)) { mn = m_reg; alpha = 1.f; }
  else { mn = fmaxf(m_reg, pmax); alpha = __builtin_amdgcn_exp2f((m_reg - mn) * C); m_reg = mn; }
  float mnC = -mn * C;
  for (int r = 0; r < 16; ++r) p0[r] = fmaf(p0[r], C, mnC); for (int r = 0; r < 16; ++r) p1[r] = fmaf(p1[r], C, mnC);
  for (int r = 0; r < 16; ++r) p0[r] = __builtin_amdgcn_exp2f(p0[r]);
}
__device__ __forceinline__ void finishSM(f32x16& p0, f32x16& p1, float alpha, float& l_reg, bf16x8& pa0, bf16x8& pa1, bf16x8& pa2, bf16x8& pa3) {
  for (int r = 0; r < 16; ++r) p1[r] = __builtin_amdgcn_exp2f(p1[r]);
  float ps = 0; for (int r = 0; r < 16; ++r) ps += p0[r]; for (int r = 0; r < 16; ++r) ps += p1[r];
  { auto rr = __builtin_amdgcn_permlane32_swap(__float_as_uint(ps), __float_as_uint(ps), false, false);
    ps = __uint_as_float(rr[0]) + __uint_as_float(rr[1]); }
  l_reg = l_reg * alpha + ps;
#define PK4(P, BASE, OUT) do { unsigned a0 = cvtpk(P[BASE + 0], P[BASE + 1]), a1 = cvtpk(P[BASE + 2], P[BASE + 3]);   \
    unsigned b0 = cvtpk(P[BASE + 4], P[BASE + 5]), b1 = cvtpk(P[BASE + 6], P[BASE + 7]);                              \
    auto r0 = __builtin_amdgcn_permlane32_swap(a0, b0, false, false); auto r1 = __builtin_amdgcn_permlane32_swap(a1, b1, false, false); \
    u32x4 w = {r0[0], r1[0], r0[1], r1[1]}; OUT = *reinterpret_cast<bf16x8*>(&w); } while (0)
  PK4(p0, 0, pa0); PK4(p0, 8, pa1); PK4(p1, 0, pa2); PK4(p1, 8, pa3);
#undef PK4
}
__device__ __forceinline__ void qkt(f32x16& p0, f32x16& p1, const bf16* Ks, const bf16x8* qr, int r32, int hi, const float* tl) {
#pragma unroll
  for (int r = 0; r < 16; ++r) { p0[r] = tl[(r & 3) + 8 * (r >> 2)]; p1[r] = tl[32 + (r & 3) + 8 * (r >> 2)]; }
#pragma unroll
  for (int d0 = 0; d0 < 8; ++d0) { int cb = (d0 * 16 + hi * 8) * 2;
    bf16x8 b0 = *reinterpret_cast<const bf16x8*>((const char*)Ks + KSWZ(r32, cb));
    bf16x8 b1 = *reinterpret_cast<const bf16x8*>((const char*)Ks + KSWZ(32 + r32, cb));
    p0 = __builtin_amdgcn_mfma_f32_32x32x16_bf16(b0, qr[d0], p0, 0, 0, 0);
    p1 = __builtin_amdgcn_mfma_f32_32x32x16_bf16(b1, qr[d0], p1, 0, 0, 0); }
}
__device__ __forceinline__ int v_st(int k, int c) { const int kk = (k & ~0xC) | ((k & 4) << 1) | ((k & 8) >> 1); return ((kk >> 3) * 4 + (c >> 5)) * 512 + ((kk & 7) * 32 + (c & 31)) * 2; }
__device__ __forceinline__ int v_rd_base(int lane) { return ((lane & 3) << 3) | (((lane >> 2) & 3) << 6) | (((lane >> 4) & 1) << 5) | (((lane >> 5) & 1) << 8); }
constexpr int v_rd_off(int d0, int ks, int half) { return d0 * 512 + ks * 4096 + half * 2048; }
template <int OFF> __device__ __forceinline__ s16x4 tr_read(int vb) {
  s16x4 r; asm volatile("ds_read_b64_tr_b16 %0, %1 offset:%2" : "=&v"(r) : "v"(vb), "i"(OFF) : "memory"); return r;
}
template <int D0> __device__ __forceinline__ void pv_one(f32x16& od, int vb, bf16x8 pa0, bf16x8 pa1, bf16x8 pa2, bf16x8 pa3) {
  const s16x4 l0 = tr_read<v_rd_off(D0, 0, 0)>(vb), h0 = tr_read<v_rd_off(D0, 0, 1)>(vb), l1 = tr_read<v_rd_off(D0, 1, 0)>(vb), h1 = tr_read<v_rd_off(D0, 1, 1)>(vb);
  const s16x4 l2 = tr_read<v_rd_off(D0, 2, 0)>(vb), h2 = tr_read<v_rd_off(D0, 2, 1)>(vb), l3 = tr_read<v_rd_off(D0, 3, 0)>(vb), h3 = tr_read<v_rd_off(D0, 3, 1)>(vb);
  asm volatile("s_waitcnt lgkmcnt(0)" ::: "memory"); SBAR();
#define PK(L, H) (bf16x8){L[0], L[1], L[2], L[3], H[0], H[1], H[2], H[3]}
  od = __builtin_amdgcn_mfma_f32_32x32x16_bf16(pa0, PK(l0, h0), od, 0, 0, 0);
  od = __builtin_amdgcn_mfma_f32_32x32x16_bf16(pa1, PK(l1, h1), od, 0, 0, 0);
  od = __builtin_amdgcn_mfma_f32_32x32x16_bf16(pa2, PK(l2, h2), od, 0, 0, 0);
  od = __builtin_amdgcn_mfma_f32_32x32x16_bf16(pa3, PK(l3, h3), od, 0, 0, 0);
#undef PK
}
__device__ __forceinline__ void pv_d0(f32x16* o, int vb, bf16x8 pa0, bf16x8 pa1, bf16x8 pa2, bf16x8 pa3) {
  pv_one<0>(o[0], vb, pa0, pa1, pa2, pa3); pv_one<1>(o[1], vb, pa0, pa1, pa2, pa3); pv_one<2>(o[2], vb, pa0, pa1, pa2, pa3); pv_one<3>(o[3], vb, pa0, pa1, pa2, pa3);
}

struct Unit { const bf16* Q; const bf16* K; const bf16* V; bf16* O; float* lse; long ldq, ldk, ldo; int lse_ld, kt0, nt, qoff; };
__device__ __forceinline__ void attn_unit(const Unit& u, char* lds, int wave0) {
  const int tid = opaque_tid(wave0), wid = wave0, lane = tid & 63, r32 = lane & 31, hi = lane >> 5;
  bf16* V_lds = (bf16*)lds; bf16* K_lds = (bf16*)(lds + 2 * SHM_V);
  float* ws = (float*)(lds + LDS_WS) + wid * 64; float* li_l = ws; float* al_l = ws + 32;
  const float* tabL = (const float*)(lds + LDS_TAB);
  float m_reg = -1e30f, l_reg = 0; f32x16 o[4] = {}; bf16x8 qr[8];
  const bf16* Qw = u.Q + (long)(wid * QBLK + r32) * u.ldq + hi * 8;
#pragma unroll
  for (int d0 = 0; d0 < 8; ++d0) qr[d0] = *reinterpret_cast<const bf16x8*>(Qw + d0 * 16);
  const int sr = tid >> 4, sc = (tid & 15) * 8, vst0 = v_st(sr, sc), vst1 = v_st(32 + sr, sc);
  const int vb0 = (int)(uintptr_t)V_lds + v_rd_base(lane);
  const long tstep = (long)KVBLK * u.ldk * 2;
  const char* Kh = (const char*)u.K + (long)u.kt0 * tstep; const char* Vh = (const char*)u.V + (long)u.kt0 * tstep;
  const unsigned lo0 = (unsigned)((sr * (int)u.ldk + sc) * 2), lo1 = lo0 + (unsigned)(32 * (int)u.ldk * 2);
  const float* tl0 = tabL + (4096 + u.kt0 * KVBLK + 4 * hi - (u.qoff + wid * QBLK + r32));
  struct { bf16x8 vs0, vs1, ks0, ks1; } sr_[2];
#define SLOAD(i, tj) do { const char* vt_ = Vh + (long)(tj) * tstep; const char* kt_ = Kh + (long)(tj) * tstep; \
    sr_[i].vs0 = *reinterpret_cast<const bf16x8*>(vt_ + lo0); sr_[i].vs1 = *reinterpret_cast<const bf16x8*>(vt_ + lo1); \
    sr_[i].ks0 = *reinterpret_cast<const bf16x8*>(kt_ + lo0); sr_[i].ks1 = *reinterpret_cast<const bf16x8*>(kt_ + lo1); } while (0)
#define SWRITE(b, i) do { *(bf16x8*)((char*)V_lds + (b) * SHM_V + vst0) = sr_[i].vs0;          \
    *(bf16x8*)((char*)V_lds + (b) * SHM_V + vst1) = sr_[i].vs1; int kc = sc * 2;               \
    *(bf16x8*)((char*)K_lds + (b) * SHM_K + KSWZ(sr, kc)) = sr_[i].ks0;                       \
    *(bf16x8*)((char*)K_lds + (b) * SHM_K + KSWZ(32 + sr, kc)) = sr_[i].ks1; } while (0)
#define SWAIT() asm volatile("s_waitcnt vmcnt(4)" ::: "memory")
#define RESC(a) do { if (__any((a) < 1.f)) { if (hi == 0) al_l[r32] = (a); asm volatile("s_waitcnt lgkmcnt(0)" ::: "memory"); \
    for (int d = 0; d < 4; ++d) for (int r = 0; r < 16; ++r) o[d][r] *= al_l[crow(r, hi)]; } } while (0)
  f32x16 pA0, pA1, pB0, pB1; float mnA, mnB, alA, alB; bf16x8 pa0, pa1, pa2, pa3; const int NT = u.nt;
  constexpr int SE = 0, SO = 1;
  SLOAD(SE, 0); asm volatile("s_waitcnt vmcnt(0)" ::: "memory"); SWRITE(0, SE); __syncthreads();
  qkt(pA0, pA1, K_lds, qr, r32, hi, tl0); partialSM(pA0, pA1, m_reg, mnA, alA);
  SLOAD(SO, 1); if (2 < NT) SLOAD(SE, 2);
  SWAIT(); SWRITE(1, SO); __syncthreads();
  for (int j = 1; j + 1 < NT; j += 2) {
    SBAR(); qkt(pB0, pB1, (bf16*)((char*)K_lds + SHM_K), qr, r32, hi, tl0 + j * KVBLK);
    finishSM(pA0, pA1, alA, l_reg, pa0, pa1, pa2, pa3); SBAR();
    SLOAD(SO, j + 2); SBAR();
    pv_d0(o, vb0, pa0, pa1, pa2, pa3); partialSM(pB0, pB1, m_reg, mnB, alB);
    __syncthreads(); SWAIT(); SWRITE(0, SE);
    RESC(alB); __syncthreads();
    SBAR(); qkt(pA0, pA1, K_lds, qr, r32, hi, tl0 + (j + 1) * KVBLK);
    finishSM(pB0, pB1, alB, l_reg, pa0, pa1, pa2, pa3); SBAR();
    if (j + 3 < NT) SLOAD(SE, j + 3); SBAR();
    pv_d0(o, vb0 + (int)SHM_V, pa0, pa1, pa2, pa3); partialSM(pA0, pA1, m_reg, mnA, alA);
    __syncthreads(); SWAIT(); SWRITE(1, SO);
    RESC(alA); __syncthreads();
  }
  SBAR(); qkt(pB0, pB1, (bf16*)((char*)K_lds + SHM_K), qr, r32, hi, tl0 + (NT - 1) * KVBLK);
  finishSM(pA0, pA1, alA, l_reg, pa0, pa1, pa2, pa3); SBAR();
  pv_d0(o, vb0, pa0, pa1, pa2, pa3); partialSM(pB0, pB1, m_reg, mnB, alB);
  __syncthreads(); RESC(alB);
  finishSM(pB0, pB1, alB, l_reg, pa0, pa1, pa2, pa3); SBAR();
  pv_d0(o, vb0 + (int)SHM_V, pa0, pa1, pa2, pa3);
  if (hi == 0) li_l[r32] = l_reg; asm volatile("s_waitcnt lgkmcnt(0)" ::: "memory");
  float rli[16];
#pragma unroll
  for (int r = 0; r < 16; ++r) rli[r] = __builtin_amdgcn_rcpf(li_l[crow(r, hi)]);
  bf16* Ow = u.O + (long)(wid * QBLK) * u.ldo;
#pragma unroll
  for (int r = 0; r < 16; ++r) { int orow = crow(r, hi);
#pragma unroll
    for (int d0 = 0; d0 < 4; ++d0) { const float v = o[d0][r] * rli[r]; Ow[(long)orow * u.ldo + d0 * 32 + r32] = (bf16)(cvtpk(v, v) & 0xffffu); } }
  if (u.lse != nullptr && hi == 0) u.lse[(long)(wid * QBLK + r32) * u.lse_ld] = m_reg * SCALE + __logf(l_reg);
#undef SLOAD
#undef SWRITE
#undef SWAIT
#undef RESC
}
#undef KSWZ
#undef SBAR
}

constexpr int NWAVES = 8;
constexpr size_t MiB = 1u << 20;
constexpr size_t WS_CTL = 0, CTL_ZERO_BYTES = 1 * MiB;
constexpr size_t WS_CS   = 1 * MiB;
constexpr size_t WS_SKBD = 1 * MiB + 256 * 1024;
constexpr size_t WS_TAB  = 2 * MiB;
constexpr size_t WS_LSE  = 3 * MiB;
constexpr size_t WS_WCAT = 4 * MiB, WS_WO = 12 * MiB, WS_WQ = 20 * MiB;
constexpr size_t WS_WIN  = 28 * MiB;
constexpr size_t WS_DFT  = 84 * MiB;
constexpr size_t WS_U    = 148 * MiB, WS_V = 180 * MiB;
constexpr size_t WS_H    = 276 * MiB;
constexpr size_t WS_PROJ = 340 * MiB;
constexpr size_t WS_G    = 596 * MiB;
constexpr size_t WS_ZT   = 788 * MiB;
constexpr size_t WS_OC   = 820 * MiB;
constexpr size_t WS_MG   = 884 * MiB;
constexpr size_t WS_END  = 948 * MiB;
#if DBG_MODE == 2
constexpr size_t WS_ACT = WS_PROJ + 208 * MiB;
#else
constexpr size_t WS_ACT = WS_PROJ + 200 * MiB;
#endif
constexpr size_t WS_Q = WS_PROJ, WS_SC = WS_PROJ + 64 * MiB, WS_IDS = WS_PROJ + 192 * MiB, WS_GATES = WS_PROJ + 200 * MiB;
constexpr int CW_BAR = 4096;
constexpr int CW_XRANK = 12288;
constexpr int CW_QUEUE = 16384;
constexpr int RING_BYTES = 131072, LDSCTL_OFF = RING_BYTES, MISC_OFF = LDSCTL_OFF + 320, LDS_BYTES = 147456;

#define LDS_WAIT() asm volatile("s_waitcnt lgkmcnt(0)" ::: "memory")
#define VM_WAIT() asm volatile("s_waitcnt vmcnt(0)" ::: "memory")
__device__ __forceinline__ unsigned f2bf(float f) { unsigned u = __builtin_bit_cast(unsigned, f); return (u + 0x7fffu + ((u >> 16) & 1u)) >> 16; }
__device__ __forceinline__ unsigned pk2(float lo, float hi) { return f2bf(lo) | (f2bf(hi) << 16); }
__device__ __forceinline__ float bflo(unsigned w) { return __uint_as_float(w << 16); }
__device__ __forceinline__ float bfhi(unsigned w) { return __uint_as_float(w & 0xffff0000u); }

#define XB_TMO      128
#define XB_XCNT(j)  (256  + 64 * (j))
#define XB_XSUB(j)  (1280 + 64 * (j))
#define XB_XGEN(j)  (2304 + 64 * (j))
#define XB_TOP      3328
#define XB_TOPGEN   3392
#define XCD_BAR_WORDS 3456
#define XB_SPIN_CAP (1u << 20)
__device__ __forceinline__ unsigned xb_ld(unsigned* p)              { return __hip_atomic_load(p, __ATOMIC_RELAXED, __HIP_MEMORY_SCOPE_AGENT); }
__device__ __forceinline__ unsigned xb_add(unsigned* p, unsigned v) { return __hip_atomic_fetch_add(p, v, __ATOMIC_RELAXED, __HIP_MEMORY_SCOPE_AGENT); }
__device__ __forceinline__ unsigned xb_xcc_id() { return (unsigned)__builtin_amdgcn_s_getreg((3 << 11) | 20) & 0xFu; }
#define XB_SPIN(cond, bar) do { unsigned _sp = 0; while (cond) { __builtin_amdgcn_s_sleep(1); \
    if ((++_sp & 255u) == 0u) { if (xb_ld(&(bar)[XB_TMO])) break; if (_sp > XB_SPIN_CAP) { atomicAdd(&(bar)[XB_TMO], 1u); break; } } } } while (0)
struct XcdBarrier { unsigned* bar; unsigned x; volatile LAS unsigned* st; };
__device__ __forceinline__ XcdBarrier xcd_barrier_post(unsigned* bar, volatile LAS unsigned* st) {
    XcdBarrier b; b.bar = bar; b.x = xb_xcc_id(); b.st = st;
    if (threadIdx.x == 0) (void)xb_add(&bar[XB_XCNT(b.x)], 1u);
    return b;
}
__device__ __forceinline__ void xcd_barrier_complete(unsigned* bar, unsigned x, unsigned& nloc, unsigned& nx) {
    const unsigned G = gridDim.x * gridDim.y * gridDim.z;
    unsigned sum, cnt, mine, sp = 0u;
    for (;;) {
        sum = 0u; cnt = 0u; mine = 0u;
#pragma unroll
        for (unsigned j = 0; j < 16; ++j) { const unsigned c = xb_ld(&bar[XB_XCNT(j)]); sum += c; cnt += (c > 0u) ? 1u : 0u; mine = (j == x) ? c : mine; }
        if (sum == G) break;
        __builtin_amdgcn_s_sleep(1);
        if ((++sp & 255u) == 0u) { if (xb_ld(&bar[XB_TMO])) break; if (sp > XB_SPIN_CAP) { atomicAdd(&bar[XB_TMO], 1u); break; } }
    }
    nloc = mine > 0u ? mine : 1u; nx = cnt > 0u ? cnt : 1u;
}
__device__ __forceinline__ void xcd_barrier(const XcdBarrier& b) {
    asm volatile("s_waitcnt vmcnt(0)" ::: "memory");
    __syncthreads();
    if (threadIdx.x == 0) {
        unsigned* bar = b.bar;
        __builtin_amdgcn_s_waitcnt(0);
        unsigned nloc = b.st[0], nx = b.st[1];
        if (nloc == 0u) { xcd_barrier_complete(bar, b.x, nloc, nx); b.st[0] = nloc; b.st[1] = nx; }
        const unsigned old = xb_add(&bar[XB_XSUB(b.x)], 1u);
        const unsigned gen = old / nloc;
        if (old + 1u == (gen + 1u) * nloc) {
            __builtin_amdgcn_fence(__ATOMIC_RELEASE, "agent");
            asm volatile("s_waitcnt vmcnt(0)" ::: "memory");
            const unsigned og = xb_add(&bar[XB_TOP], 1u);
            const unsigned tg = og / nx;
            if (og + 1u == (tg + 1u) * nx) xb_add(&bar[XB_TOPGEN], 1u);
            else XB_SPIN(xb_ld(&bar[XB_TOPGEN]) == tg, bar);
            __builtin_amdgcn_fence(__ATOMIC_ACQUIRE, "agent");
            xb_add(&bar[XB_XGEN(b.x)], 1u);
            asm volatile("s_waitcnt vmcnt(0)" ::: "memory");
        } else {
            XB_SPIN(xb_ld(&bar[XB_XGEN(b.x)]) == gen, bar);
            __builtin_amdgcn_fence(__ATOMIC_ACQUIRE, "agent");
            asm volatile("s_waitcnt vmcnt(0)" ::: "memory");
        }
    }
    __syncthreads();
}

template <int MASK> __device__ __forceinline__ int sx_i(int v) { return __builtin_amdgcn_ds_swizzle(v, 0x1f | (MASK << 10)); }
template <int MASK> __device__ __forceinline__ float sx_f(float v) { return __int_as_float(sx_i<MASK>(__float_as_int(v))); }
__device__ __forceinline__ float add32(float v) { auto rr = __builtin_amdgcn_permlane32_swap(__float_as_uint(v), __float_as_uint(v), false, false); return __uint_as_float(rr[0]) + __uint_as_float(rr[1]); }
__device__ __forceinline__ unsigned max32(unsigned v) { auto rr = __builtin_amdgcn_permlane32_swap(v, v, false, false); return rr[0] > rr[1] ? rr[0] : rr[1]; }
__device__ __forceinline__ float other32(float v, bool upper) { auto rr = __builtin_amdgcn_permlane32_swap(__float_as_uint(v), __float_as_uint(v), false, false); return __uint_as_float(upper ? rr[0] : rr[1]); }
__device__ __forceinline__ float bperm_f(float v, int src_lane) { return __int_as_float(__builtin_amdgcn_ds_bpermute(src_lane * 4, __float_as_int(v))); }
__device__ __forceinline__ int bperm_i(int v, int src_lane) { return __builtin_amdgcn_ds_bpermute(src_lane * 4, v); }
__device__ __forceinline__ float wave_sum(float v) {
    v += sx_f<1>(v); v += sx_f<2>(v); v += sx_f<4>(v); v += sx_f<8>(v); v += sx_f<16>(v); return add32(v);
}
__device__ __forceinline__ unsigned umax(unsigned a, unsigned b) { return a > b ? a : b; }
__device__ __forceinline__ unsigned wave_max_u32(unsigned v) {
    v = umax(v, (unsigned)sx_i<1>((int)v)); v = umax(v, (unsigned)sx_i<2>((int)v)); v = umax(v, (unsigned)sx_i<4>((int)v)); v = umax(v, (unsigned)sx_i<8>((int)v)); v = umax(v, (unsigned)sx_i<16>((int)v)); return max32(v);
}
template <int CTRL, int RMASK> __device__ __forceinline__ unsigned dpp_max_u(unsigned v) { const unsigned t = (unsigned)__builtin_amdgcn_update_dpp((int)v, (int)v, CTRL, RMASK, 0xF, false); return t > v ? t : v; }
__device__ __forceinline__ unsigned wave_max_dpp(unsigned v) {
    v = dpp_max_u<0xB1, 0xF>(v); v = dpp_max_u<0x4E, 0xF>(v); v = dpp_max_u<0x141, 0xF>(v); v = dpp_max_u<0x140, 0xF>(v); v = dpp_max_u<0x142, 0xA>(v); v = dpp_max_u<0x143, 0xC>(v);
    return (unsigned)__builtin_amdgcn_readlane((int)v, 63);
}
template <int CTRL> __device__ __forceinline__ float dpp_add_f(float v) { return v + __int_as_float(__builtin_amdgcn_update_dpp(__float_as_int(v), __float_as_int(v), CTRL, 0xF, 0xF, false)); }
__device__ __forceinline__ float row_sum16(float v) { v = dpp_add_f<0xB1>(v); v = dpp_add_f<0x4E>(v); v = dpp_add_f<0x141>(v); return dpp_add_f<0x140>(v); }
__device__ __forceinline__ unsigned okey(float f) { const unsigned u = __float_as_uint(f); return (u & 0x80000000u) ? ~u : (u | 0x80000000u); }

__device__ __forceinline__ void transpose_item(const float* W, int N, bf16* WT, int ldo, int col_off, LAS float* scr, int item, int lane) {
    const int nblk = N / 32, kb = item / nblk, nb = item % nblk, k0 = 64 * kb, n0 = 32 * nb;
#pragma unroll 8
    for (int i = 0; i < 32; ++i) { const int kk = 2 * i + (lane >> 5); scr[kk * 33 + (lane & 31)] = W[(size_t)(k0 + kk) * N + n0 + (lane & 31)]; }
    LDS_WAIT(); asm volatile("" ::: "memory");
    const int c = lane & 7;
#pragma unroll
    for (int j = 0; j < 4; ++j) { const int n = (lane >> 3) + 8 * j; const LAS float* s = scr + (8 * c) * 33 + n;
        v4u o; o.x = pk2(s[0 * 33], s[1 * 33]); o.y = pk2(s[2 * 33], s[3 * 33]); o.z = pk2(s[4 * 33], s[5 * 33]); o.w = pk2(s[6 * 33], s[7 * 33]);
        *(GAS v4u*)(WT + (size_t)(n0 + n) * ldo + col_off + k0 + 8 * c) = o; }
    LDS_WAIT(); asm volatile("" ::: "memory");
}
__device__ __forceinline__ void rms_row_to_bf16(const float* xrow, const float* g, bf16* orow, int lane) {
    const GAS f32x4* xr = (const GAS f32x4*)xrow + lane; const GAS f32x4* gr = (const GAS f32x4*)g + lane;
    f32x4 v[8]; float s = 0.f;
#pragma unroll
    for (int j = 0; j < 8; ++j) { v[j] = xr[64 * j]; s += (v[j].x * v[j].x + v[j].y * v[j].y) + (v[j].z * v[j].z + v[j].w * v[j].w); }
    const float rstd = 1.0f / sqrtf(wave_sum(s) * (1.f / DM) + RMS_EPS);
    GAS unsigned long long* o8 = (GAS unsigned long long*)orow + lane;
#pragma unroll
    for (int j = 0; j < 8; ++j) { const f32x4 gg = gr[64 * j]; o8[64 * j] = (unsigned long long)pk2(v[j].x * rstd * gg.x, v[j].y * rstd * gg.y) | ((unsigned long long)pk2(v[j].z * rstd * gg.z, v[j].w * rstd * gg.w) << 32); }
}
typedef __bf16 bf2_t __attribute__((ext_vector_type(2)));
__device__ __forceinline__ float DOT2(unsigned a, unsigned b, float c) { return __builtin_amdgcn_fdot2_f32_bf16(__builtin_bit_cast(bf2_t, a), __builtin_bit_cast(bf2_t, b), c, false); }
__device__ __forceinline__ int rel_bucket(int rel) {
    const int n = rel < 0 ? -rel : rel;
    int b = n;
    if (n >= 8) { b = 5 + (31 - __builtin_clz((unsigned)n)); if (b > 15) b = 15; }
    return b + (rel > 0 ? 16 : 0);
}

#ifndef PH_D1
#define PH_D1 1
#endif
#ifndef PH_D2
#define PH_D2 1
#endif
#ifndef PH_A
#define PH_A 1
#endif
#ifndef PH_B
#define PH_B 1
#endif
#ifndef PH_C
#define PH_C 1
#endif
#ifndef PH_D
#define PH_D 1
#endif
#ifndef PH_E
#define PH_E 1
#endif
#ifndef PH_F
#define PH_F 1
#endif
#ifndef PH_G
#define PH_G 1
#endif
#ifndef PH_H
#define PH_H 1
#endif
#ifndef PH_I
#define PH_I 1
#endif
#ifndef PH_J
#define PH_J 1
#endif
#ifndef PH_K
#define PH_K 1
#endif
#ifndef PH_L
#define PH_L 1
#endif
struct Args { const float* in[17]; float* out; unsigned char* ws; };

#define CAS __attribute__((address_space(4)))
__device__ __forceinline__ const void* karg(int k) { const CAS char* ka = (const CAS char*)__builtin_amdgcn_kernarg_segment_ptr(); asm volatile("" : "+s"(ka)); return *(const void* const CAS*)(ka + 8 * k); }
#define WSP(T, off) ((T*)((unsigned char*)karg(18) + (off)))
#define INP(k) ((const float*)karg(k))
#define INL(k, stride) (INP(k) + (size_t)layer * (size_t)(stride))
#define X ((float*)karg(17))
__global__ void __launch_bounds__(NWAVES * 64, 2) mk_fwd(Args args_unused) {
    extern __shared__ __attribute__((aligned(16))) unsigned char lds[];
    LAS unsigned char* ldsl = (LAS unsigned char*)lds;
    volatile LAS unsigned* MISC = (volatile LAS unsigned*)(ldsl + MISC_OFF);
    const int wave0 = __builtin_amdgcn_readfirstlane((int)threadIdx.x >> 6);
    const int G = gridDim.x; const int bx = blockIdx.x; const int vcu = (G % 8 == 0) ? (bx % 8) * (G / 8) + bx / 8 : bx;
    const int NGW = G * NWAVES, NGT = NGW * 64;
#define PH_IDS() const int tid = opaque_tid(wave0), lane = tid & 63, wave = wave0, gw = vcu * NWAVES + wave, gt = gw * 64 + lane; (void)gt; (void)gw; (void)lane
    gu32* ctl = (gu32*)WSP(unsigned char, WS_CTL);
    for (int u = threadIdx.x; u < (LDS_BYTES - LDSCTL_OFF) / 4; u += NWAVES * 64) ((LAS unsigned*)(ldsl + LDSCTL_OFF))[u] = 0u;
    __syncthreads();
    XcdBarrier bar = xcd_barrier_post((unsigned*)(ctl + CW_BAR), MISC + 8);
    if (threadIdx.x == 0) MISC[1] = __hip_atomic_fetch_add(ctl + CW_XRANK + 64 * (int)(xb_xcc_id() & 7u), 1u, __ATOMIC_RELAXED, __HIP_MEMORY_SCOPE_AGENT);
#define GRID_BAR() xcd_barrier(bar)

    for (int layer = 0; layer < 2; ++layer) {

#if PH_A
        {
            PH_IDS();
            LAS float* scr = (LAS float*)(ldsl + wave * 16384);
            const float* w_in = INL(4, (size_t)DM * INW); const float* w_up_a = INL(6, 512 * DM); const float* w_up_b = INL(7, 512 * DM); const float* w_up_c = INL(8, 1024 * DM);
            const float* w_o = INL(11, DM * DM); const float* wq = INL(13, DM * DM); const float* subk = INL(14, 2 * 128 * 128);
            const float* pu = INL(15, (size_t)NEXP * DM); const float* pv = INL(16, (size_t)NEXP * DM); const float* mix_g = INL(3, DM); const float* rel_bias = INP(1);
            bf16* WIN = WSP(bf16, WS_WIN); bf16* WCAT = WSP(bf16, WS_WCAT); bf16* WO = WSP(bf16, WS_WO); bf16* WQ = WSP(bf16, WS_WQ); unsigned char* U8 = WSP(unsigned char, WS_U); unsigned char* V8 = WSP(unsigned char, WS_V);
            bf16* SKBD = WSP(bf16, WS_SKBD); bf16* H = WSP(bf16, WS_H); bf16* DFT = WSP(bf16, WS_DFT); bf16* CS = WSP(bf16, WS_CS); float* TAB = WSP(float, WS_TAB);
            constexpr int I_IN = (DM / 64) * (INW / 32), I_A = (512 / 64) * (DM / 32), I_C = (1024 / 64) * (DM / 32), I_SQ = (DM / 64) * (DM / 32);
            constexpr int NITEMS = I_IN + 2 * I_A + I_C + 2 * I_SQ;
            for (int it = gw; it < NITEMS; it += NGW) {
                int r = it;
                if (r < I_IN) { transpose_item(w_in, INW, WIN, DM, 0, scr, r, lane); continue; } r -= I_IN;
                if (r < I_A) { transpose_item(w_up_a, DM, WCAT, DM, 0, scr, r, lane); continue; } r -= I_A;
                if (r < I_A) { transpose_item(w_up_b, DM, WCAT, DM, 512, scr, r, lane); continue; } r -= I_A;
                if (r < I_C) { transpose_item(w_up_c, DM, WCAT, DM, 1024, scr, r, lane); continue; } r -= I_C;
                if (r < I_SQ) { transpose_item(w_o, DM, WO, DM, 0, scr, r, lane); continue; } r -= I_SQ;
                transpose_item(wq, DM, WQ, DM, 0, scr, r, lane);
            }
            for (size_t i = (size_t)gt; i < (size_t)NEXP * DM / 16; i += (size_t)NGT) {
#pragma unroll
                for (int tb = 0; tb < 2; ++tb) {
                    const GAS f32x4* src = (const GAS f32x4*)(tb ? pv : pu) + 4 * i; const float sc = tb ? 64.f : 1024.f;
                    const f32x4 a = src[0], b = src[1], c = src[2], d = src[3]; v4u o;
                    int w;
                    w = __builtin_amdgcn_cvt_pk_fp8_f32(a.x * sc, a.y * sc, 0, false); w = __builtin_amdgcn_cvt_pk_fp8_f32(a.z * sc, a.w * sc, w, true); o.x = (unsigned)w;
                    w = __builtin_amdgcn_cvt_pk_fp8_f32(b.x * sc, b.y * sc, 0, false); w = __builtin_amdgcn_cvt_pk_fp8_f32(b.z * sc, b.w * sc, w, true); o.y = (unsigned)w;
                    w = __builtin_amdgcn_cvt_pk_fp8_f32(c.x * sc, c.y * sc, 0, false); w = __builtin_amdgcn_cvt_pk_fp8_f32(c.z * sc, c.w * sc, w, true); o.z = (unsigned)w;
                    w = __builtin_amdgcn_cvt_pk_fp8_f32(d.x * sc, d.y * sc, 0, false); w = __builtin_amdgcn_cvt_pk_fp8_f32(d.z * sc, d.w * sc, w, true); o.w = (unsigned)w;
                    ((GAS v4u*)(tb ? V8 : U8))[i] = o;
                }
            }
            for (int i = gt; i < 65536; i += NGT) { const int n = i >> 8, kk = i & 255, p = n >> 7; SKBD[i] = ((kk >> 7) == p) ? (bf16)f2bf(subk[(size_t)(p * 128 + (n & 127)) * 128 + (kk & 127)]) : (bf16)0; }
            for (int m = gw; m < MTOK; m += NGW) rms_row_to_bf16((layer == 0 ? INP(0) : (const float*)X) + (size_t)m * DM, mix_g, H + (size_t)m * DM, lane);
            if (layer == 0) {
                for (size_t i = (size_t)gt; i < (size_t)4096 * 8192 / 8; i += (size_t)NGT) {
                    const int sp = (int)(i >> 10), k0 = (int)(i & 1023) * 8, part = k0 >> 12, s0 = k0 & 4095; float v[8];
#pragma unroll
                    for (int j = 0; j < 8; ++j) { const float ang = (float)(((s0 + j) * sp) & 4095) * (1.f / 4096.f); v[j] = (part ? -__builtin_amdgcn_sinf(ang) : __builtin_amdgcn_cosf(ang)) * (1.f / 64.f); }
                    v4u o; o.x = pk2(v[0], v[1]); o.y = pk2(v[2], v[3]); o.z = pk2(v[4], v[5]); o.w = pk2(v[6], v[7]); ((GAS v4u*)DFT)[i] = o;
                }
                for (int i = gt; i < 65536; i += NGT) { const int r = i >> 8, c = i & 255, part = r >> 7, cp = r & 127; float v = 0.f;
                    if (c < 128) { const float ang = (float)((c * cp) & 127) * (1.f / 128.f); v = (part ? __builtin_amdgcn_sinf(ang) : __builtin_amdgcn_cosf(ang)) * 0.08838834764831845f; }
                    CS[i] = (bf16)f2bf(v); }
                for (int i = gt; i < 16 * 8192; i += NGT) { const int hd = i >> 13, off = (i & 8191) - 4096; float v;
                    if (hd < 12) { const int g = hd >> 2, dil = g == 0 ? 1 : (g == 1 ? 4 : 16); v = (off >= -64 && off <= 64) ? rel_bias[rel_bucket(off * dil) * 16 + hd] * 11.313708498984761f : -1.0e5f; }
                    else v = rel_bias[rel_bucket(off) * 16 + hd] * 11.313708498984761f;
                    TAB[i] = v; }
            }
        }
#endif
        GRID_BAR();

#if PH_B
        {
            pg8::Gemm g{WSP(bf16, WS_H), WSP(bf16, WS_WIN)}; pg8::StaticOrder S; S.init(MTOK, INW, G, bx, DM, DM);
            pg8::EpiProj E{WSP(bf16, WS_PROJ), WSP(bf16, WS_G), INL(5, GTW)};
            pg8::gemm_phase<pg8::EpiProj, pg8::StaticOrder, true, DM, DM, DM>(ldsl, g, S, E, wave0);
        }
#endif
        GRID_BAR();

#if PH_C
        {
            pg8::Gemm g{WSP(bf16, WS_CS), WSP(bf16, WS_PROJ)}; pg8::F1Order S{G, bx};
            pg8::EpiZT E{WSP(bf16, WS_ZT)};
            pg8::gemm_phase<pg8::EpiZT, pg8::F1Order, false, 256, PJW, 256>(ldsl, g, S, E, wave0);
        }
#endif
        GRID_BAR();

#if PH_D
#if PH_D1
        {
            pg8::Gemm g{WSP(bf16, WS_DFT), WSP(bf16, WS_ZT)}; pg8::F2Order S; S.init(4096, 2048, G, bx, 8192, 8192);
            pg8::EpiStore E{WSP(bf16, WS_OC), DM};
            pg8::gemm_phase<pg8::EpiStore, pg8::F2Order, false, 8192, 8192, 8192>(ldsl, g, S, E, wave0);
        }
#endif
#if PH_D2
        {
            PH_IDS();
            gu32* qhead = ctl + CW_QUEUE + 64 * layer;
            bf16* PROJ = WSP(bf16, WS_PROJ); bf16* DO = WSP(bf16, WS_MG); bf16* DL = WSP(bf16, WS_H); float* LSE = WSP(float, WS_LSE); const float* TAB = WSP(float, WS_TAB);
            const float* cur_tab = nullptr;
            for (;;) {
                __syncthreads();
                if (tid == 0) MISC[0] = __hip_atomic_fetch_add(qhead, 1u, __ATOMIC_RELAXED, __HIP_MEMORY_SCOPE_AGENT);
                __syncthreads();
                const int ui = __builtin_amdgcn_readfirstlane((int)MISC[0]);
                if (ui >= 1792) break;
                attn::Unit u; int hd;
                if (ui < 1024) {
                    const int qb = ui & 15, vh = (ui >> 4) & 1, m = (ui >> 5) & 1, h = (ui >> 6) & 3, b = ui >> 8;
                    const bf16* base = PROJ + (size_t)b * SEQ * PJW;
                    u.Q = base + (size_t)(qb * 256) * PJW + COL_DIFF + (h * 2 + m) * 128; u.K = base + COL_DIFF + 1024 + (h * 2 + m) * 128; u.V = base + COL_DIFF + 2048 + h * 256 + vh * 128;
                    u.O = DO + (size_t)(b * SEQ + qb * 256) * DM + (h * 2 + m) * 256 + vh * 128; u.lse = nullptr; u.ldq = PJW; u.ldk = PJW; u.ldo = DM; u.lse_ld = 0;
                    u.kt0 = 0; u.nt = SEQ / 64; u.qoff = qb * 256; hd = 12 + h;
                } else {
                    const int v = ui - 1024, qb16 = v & 15, hh = (v >> 4) & 3, bg = v >> 6, g = bg % 3, b = bg / 3;
                    const int dil = g == 0 ? 1 : (g == 1 ? 4 : 16), bpc = 16 / dil, r = qb16 / bpc, qblk = qb16 % bpc, q0 = qblk * 256, ntot = (SEQ / dil) / 64;
                    int kt0 = q0 / 64 - 1; if (kt0 < 0) kt0 = 0; int kt1 = q0 / 64 + 5; if (kt1 > ntot) kt1 = ntot;
                    if ((kt1 - kt0) & 1) { if (kt0 > 0) --kt0; else ++kt1; }
                    const bf16* base = PROJ + (size_t)(b * SEQ + r) * PJW + COL_DIL + g * 512 + hh * 128;
                    u.Q = base + (size_t)q0 * dil * PJW; u.K = base + 1536; u.V = base + 3072;
                    u.O = DL + ((size_t)g * MTOK + b * SEQ + r + (size_t)q0 * dil) * 512 + hh * 128; u.lse = LSE + ((size_t)g * MTOK + b * SEQ + r + (size_t)q0 * dil) * 4 + hh;
                    u.ldq = (long)PJW * dil; u.ldk = (long)PJW * dil; u.ldo = 512L * dil; u.lse_ld = 4 * dil; u.kt0 = kt0; u.nt = kt1 - kt0; u.qoff = q0; hd = g * 4 + hh;
                }
                const float* tab = TAB + (size_t)hd * 8192;
                if (tab != cur_tab) {
                    cur_tab = tab;
                    LAS f32x4* tl = (LAS f32x4*)(ldsl + attn::LDS_TAB); const int t2 = opaque_tid(wave0);
#pragma unroll
                    for (int j = 0; j < 4; ++j) tl[t2 + 512 * j] = ((const GAS f32x4*)tab)[t2 + 512 * j];
                }
                attn::attn_unit(u, (char*)lds, wave0);
            }
        }
#endif
#endif
        GRID_BAR();

#if PH_E
        {
            PH_IDS();
            const float* dlam = INL(9, 512); const float* subln = INL(10, 256); const float lambda_init = layer == 0 ? 0.2f : 0.35550906759f;
            const float* LSE = WSP(float, WS_LSE); const bf16* DL = WSP(bf16, WS_H); const bf16* DO = WSP(bf16, WS_MG); bf16* OC = WSP(bf16, WS_OC);
            float s1 = dlam[lane] * dlam[128 + lane] + dlam[64 + lane] * dlam[192 + lane], s2 = dlam[256 + lane] * dlam[384 + lane] + dlam[320 + lane] * dlam[448 + lane];
            s1 = wave_sum(s1); s2 = wave_sum(s2);
            const float lam = __expf(s1) - __expf(s2) + lambda_init, osc = 1.0f - lambda_init;
            const int hq = lane >> 4, l16 = lane & 15;
            for (int t = gw; t < MTOK; t += NGW) {
                float ls[3], mx = -3e38f;
#pragma unroll
                for (int g = 0; g < 3; ++g) { ls[g] = LSE[((size_t)g * MTOK + t) * 4 + hq]; mx = fmaxf(mx, ls[g]); }
                float wsum = 0.f;
#pragma unroll
                for (int g = 0; g < 3; ++g) { ls[g] = __expf(ls[g] - mx); wsum += ls[g]; }
                const float winv = 1.0f / wsum; float acc8[8] = {0.f, 0.f, 0.f, 0.f, 0.f, 0.f, 0.f, 0.f};
#pragma unroll
                for (int g = 0; g < 3; ++g) { const v4u o = *(const GAS v4u*)(DL + ((size_t)g * MTOK + t) * 512 + lane * 8); const float w = ls[g] * winv;
                    acc8[0] += w * bflo(o.x); acc8[1] += w * bfhi(o.x); acc8[2] += w * bflo(o.y); acc8[3] += w * bfhi(o.y); acc8[4] += w * bflo(o.z); acc8[5] += w * bfhi(o.z); acc8[6] += w * bflo(o.w); acc8[7] += w * bfhi(o.w); }
#if defined(DBG_ZERO_OB)
                for (int j = 0; j < 8; ++j) acc8[j] = 0.f;
#endif
                { v4u o; o.x = pk2(acc8[0], acc8[1]); o.y = pk2(acc8[2], acc8[3]); o.z = pk2(acc8[4], acc8[5]); o.w = pk2(acc8[6], acc8[7]); *(GAS v4u*)(OC + (size_t)t * DM + 512 + lane * 8) = o; }
                const bf16* dp = DO + (size_t)t * DM + hq * 512 + l16 * 16;
                const v4u a0 = *(const GAS v4u*)(dp), a1 = *(const GAS v4u*)(dp + 8), b0 = *(const GAS v4u*)(dp + 256), b1 = *(const GAS v4u*)(dp + 264);
                float d[16];
                d[0] = bflo(a0.x) - lam * bflo(b0.x); d[1] = bfhi(a0.x) - lam * bfhi(b0.x); d[2] = bflo(a0.y) - lam * bflo(b0.y); d[3] = bfhi(a0.y) - lam * bfhi(b0.y);
                d[4] = bflo(a0.z) - lam * bflo(b0.z); d[5] = bfhi(a0.z) - lam * bfhi(b0.z); d[6] = bflo(a0.w) - lam * bflo(b0.w); d[7] = bfhi(a0.w) - lam * bfhi(b0.w);
                d[8] = bflo(a1.x) - lam * bflo(b1.x); d[9] = bfhi(a1.x) - lam * bfhi(b1.x); d[10] = bflo(a1.y) - lam * bflo(b1.y); d[11] = bfhi(a1.y) - lam * bfhi(b1.y);
                d[12] = bflo(a1.z) - lam * bflo(b1.z); d[13] = bfhi(a1.z) - lam * bfhi(b1.z); d[14] = bflo(a1.w) - lam * bflo(b1.w); d[15] = bfhi(a1.w) - lam * bfhi(b1.w);
                float ss = 0.f;
#pragma unroll
                for (int j = 0; j < 16; ++j) ss += d[j] * d[j];
                ss += sx_f<1>(ss); ss += sx_f<2>(ss); ss += sx_f<4>(ss); ss += sx_f<8>(ss);
                const float rs = osc / sqrtf(ss * (1.f / 256.f) + RMS_EPS);
                const f32x4 g0 = *(const GAS f32x4*)(subln + l16 * 16), g1 = *(const GAS f32x4*)(subln + l16 * 16 + 4), g2 = *(const GAS f32x4*)(subln + l16 * 16 + 8), g3 = *(const GAS f32x4*)(subln + l16 * 16 + 12);
                v4u o0, o1;
                o0.x = pk2(d[0] * rs * g0.x, d[1] * rs * g0.y); o0.y = pk2(d[2] * rs * g0.z, d[3] * rs * g0.w); o0.z = pk2(d[4] * rs * g1.x, d[5] * rs * g1.y); o0.w = pk2(d[6] * rs * g1.z, d[7] * rs * g1.w);
                o1.x = pk2(d[8] * rs * g2.x, d[9] * rs * g2.y); o1.y = pk2(d[10] * rs * g2.z, d[11] * rs * g2.w); o1.z = pk2(d[12] * rs * g3.x, d[13] * rs * g3.y); o1.w = pk2(d[14] * rs * g3.z, d[15] * rs * g3.w);
                bf16* op = OC + (size_t)t * DM + 1024 + hq * 256 + l16 * 16;
                *(GAS v4u*)(op) = o0; *(GAS v4u*)(op + 8) = o1;
            }
        }
#endif
        GRID_BAR();

#if PH_F
        {
            pg8::StaticOrder S; S.init(MTOK, DM, G, bx, DM, DM);
            { pg8::Gemm g{WSP(bf16, WS_OC), WSP(bf16, WS_WCAT)}; pg8::EpiMerge3 E{WSP(bf16, WS_G), WSP(bf16, WS_MG), 0}; pg8::gemm_phase<pg8::EpiMerge3, pg8::StaticOrder, true, DM, DM, 512>(ldsl, g, S, E, wave0); }
            { pg8::Gemm g{WSP(bf16, WS_OC) + 512, WSP(bf16, WS_WCAT) + 512}; pg8::EpiMerge3 E{WSP(bf16, WS_G), WSP(bf16, WS_MG), 1}; pg8::gemm_phase<pg8::EpiMerge3, pg8::StaticOrder, true, DM, DM, 512>(ldsl, g, S, E, wave0); }
            { pg8::Gemm g{WSP(bf16, WS_OC) + 1024, WSP(bf16, WS_WCAT) + 1024}; pg8::EpiMerge3 E{WSP(bf16, WS_G), WSP(bf16, WS_MG), 2}; pg8::gemm_phase<pg8::EpiMerge3, pg8::StaticOrder, true, DM, DM, 1024>(ldsl, g, S, E, wave0); }
        }
#endif
        GRID_BAR();

#if PH_G
        {
            pg8::Gemm g{WSP(bf16, WS_MG), WSP(bf16, WS_WO)}; pg8::StaticOrder S; S.init(MTOK, DM, G, bx, DM, DM);
            pg8::EpiResF32 E{layer == 0 ? INP(0) : (const float*)X, X, DM};
            pg8::gemm_phase<pg8::EpiResF32, pg8::StaticOrder, true, DM, DM, DM>(ldsl, g, S, E, wave0);
        }
#endif
        GRID_BAR();

#if PH_H
        { PH_IDS(); const float* ffn_g = INL(12, DM); bf16* H = WSP(bf16, WS_H);
          for (int m = gw; m < MTOK; m += NGW) rms_row_to_bf16(X + (size_t)m * DM, ffn_g, H + (size_t)m * DM, lane); }
#endif
        GRID_BAR();

#if PH_I
        {
            pg8::Gemm g{WSP(bf16, WS_H), WSP(bf16, WS_WQ)}; pg8::StaticOrder S; S.init(MTOK, DM, G, bx, DM, DM);
            pg8::EpiStore E{WSP(bf16, WS_Q), DM};
            pg8::gemm_phase<pg8::EpiStore, pg8::StaticOrder, true, DM, DM, DM>(ldsl, g, S, E, wave0);
        }
#endif
        GRID_BAR();

#if PH_J
        {
            pg8::Gemm g{WSP(bf16, WS_Q), WSP(bf16, WS_SKBD)}; pg8::StaticOrder S; S.init(MTOK * 8, 256, G, bx, 256, 256);
            pg8::EpiResF32 E{nullptr, WSP(float, WS_SC), 256};
            pg8::gemm_phase<pg8::EpiResF32, pg8::StaticOrder, true, 256, 256, 256>(ldsl, g, S, E, wave0);
        }
#endif
        GRID_BAR();

#if PH_K
        {
            PH_IDS();
            const float* SC = WSP(float, WS_SC); int* IDS = WSP(int, WS_IDS); float* GATES = WSP(float, WS_GATES);
            int ci = -1, cj = 0; { int c = lane; for (int i = 0; i < 16; ++i) { const int cnt = 16 / (i + 1); if (ci < 0) { if (c < cnt) { ci = i; cj = c; } else c -= cnt; } } }
            for (int row = gw; row < MTOK * 8; row += NGW) {
                const float* sc = SC + (size_t)row * 256;
                const float s0 = sc[lane], s1 = sc[64 + lane], s2 = sc[128 + lane], s3 = sc[192 + lane];
                unsigned k0 = (okey(s0) & ~127u) | (unsigned)(127 - lane), k1 = (okey(s1) & ~127u) | (unsigned)(63 - lane);
                unsigned k2 = (okey(s2) & ~127u) | (unsigned)(127 - lane), k3 = (okey(s3) & ~127u) | (unsigned)(63 - lane);
                unsigned ta = 0u, tb = 0u;
                for (int r = 0; r < 16; ++r) {
                    const unsigned ma = wave_max_dpp(k0 > k1 ? k0 : k1), mb = wave_max_dpp(k2 > k3 ? k2 : k3);
                    if (k0 == ma) k0 = 0u; if (k1 == ma) k1 = 0u; if (k2 == mb) k2 = 0u; if (k3 == mb) k3 = 0u;
                    if (lane == r) { ta = ma; tb = mb; }
                }
                const int ia = 127 - (int)(ta & 127u), ib = 127 - (int)(tb & 127u);
                const float va = sc[ia], vb = sc[128 + ib];
                const float cs = bperm_f(va, ci < 0 ? 0 : ci) + bperm_f(vb, cj);
                unsigned ck = ci < 0 ? 0u : ((okey(cs) & ~255u) | (unsigned)(255 - (ci * 16 + cj)));
                unsigned tw = 0u;
                for (int r = 0; r < 16; ++r) { const unsigned mm = wave_max_dpp(ck); if (ck == mm) ck = 0u; if (lane == r) tw = mm; }
                const int code = 255 - (int)(tw & 255u), wi = (code >> 4) & 15, wj = code & 15;
                const float bs = bperm_f(va, wi) + bperm_f(vb, wj);
                const int eid = bperm_i(ia, wi) * 128 + bperm_i(ib, wj);
                float mx = lane < 16 ? bs : -3e38f;
                mx = fmaxf(mx, sx_f<8>(mx)); mx = fmaxf(mx, sx_f<4>(mx)); mx = fmaxf(mx, sx_f<2>(mx)); mx = fmaxf(mx, sx_f<1>(mx));
                const float e = lane < 16 ? __expf(bs - mx) : 0.f; float es = e;
                es += sx_f<8>(es); es += sx_f<4>(es); es += sx_f<2>(es); es += sx_f<1>(es);
                if (lane < 16) { IDS[(size_t)row * 16 + lane] = eid; GATES[(size_t)row * 16 + lane] = e / es; }
            }
        }
#endif
        GRID_BAR();

#if PH_L
#define L_LDIDS(I, tt, hh) do { const GAS v4u* ip_ = (const GAS v4u*)(IDS + (size_t)(tt) * 128 + (hh) * 64 + lrow * 16); I##0 = ip_[0]; I##1 = ip_[1]; I##2 = ip_[2]; I##3 = ip_[3]; } while (0)
#define L_ISSUE(W, I, base) do { \
    W[0] = *(const GAS v4u*)((base) + (size_t)(I##0).x * DM); W[1] = *(const GAS v4u*)((base) + (size_t)(I##0).y * DM); W[2] = *(const GAS v4u*)((base) + (size_t)(I##0).z * DM); W[3] = *(const GAS v4u*)((base) + (size_t)(I##0).w * DM); \
    W[4] = *(const GAS v4u*)((base) + (size_t)(I##1).x * DM); W[5] = *(const GAS v4u*)((base) + (size_t)(I##1).y * DM); W[6] = *(const GAS v4u*)((base) + (size_t)(I##1).z * DM); W[7] = *(const GAS v4u*)((base) + (size_t)(I##1).w * DM); \
    W[8] = *(const GAS v4u*)((base) + (size_t)(I##2).x * DM); W[9] = *(const GAS v4u*)((base) + (size_t)(I##2).y * DM); W[10] = *(const GAS v4u*)((base) + (size_t)(I##2).z * DM); W[11] = *(const GAS v4u*)((base) + (size_t)(I##2).w * DM); \
    W[12] = *(const GAS v4u*)((base) + (size_t)(I##3).x * DM); W[13] = *(const GAS v4u*)((base) + (size_t)(I##3).y * DM); W[14] = *(const GAS v4u*)((base) + (size_t)(I##3).z * DM); W[15] = *(const GAS v4u*)((base) + (size_t)(I##3).w * DM); } while (0)
#define L_CVT(d, hi) __builtin_amdgcn_cvt_pk_f32_fp8((int)(d), (hi))
        {
            PH_IDS();
            const bf16* H = WSP(bf16, WS_H); const unsigned char* U8 = WSP(unsigned char, WS_U); const int* IDS = WSP(int, WS_IDS); float* PART = WSP(float, WS_G);
            typedef float f32x2 __attribute__((ext_vector_type(2)));
            const int myx = (int)(xb_xcc_id() & 7u); int nx = 0, xi = 0, nloc = 1;
            for (int j = 0; j < 8; ++j) { const int c = (int)__hip_atomic_load(ctl + CW_XRANK + 64 * j, __ATOMIC_RELAXED, __HIP_MEMORY_SCOPE_AGENT); if (c > 0) { ++nx; if (j < myx) ++xi; } if (j == myx) nloc = c; }
            const int rw = (int)MISC[1] * NWAVES + wave, nW = nloc * NWAVES; const int l16 = lane & 15, lrow = lane >> 4;
#define L1_COMPUTE(W, dst) do { float prer_ = 0.f; _Pragma("unroll") for (int k = 0; k < 16; ++k) { const v4u ww = W[k]; const unsigned d0 = ww.x, d1 = ww.y, d2 = ww.z, d3 = ww.w; f32x2 s2; \
        s2 = L_CVT(d0, false) * hf[0]; s2 += L_CVT(d0, true) * hf[1]; s2 += L_CVT(d1, false) * hf[2]; s2 += L_CVT(d1, true) * hf[3]; \
        s2 += L_CVT(d2, false) * hf[4]; s2 += L_CVT(d2, true) * hf[5]; s2 += L_CVT(d3, false) * hf[6]; s2 += L_CVT(d3, true) * hf[7]; \
        const float rs = row_sum16(s2.x + s2.y); prer_ = (l16 == k) ? rs : prer_; } dst = prer_; } while (0)
            for (int sl = xi; sl < 8; sl += nx) {
                const unsigned char* ub = U8 + sl * 256 + l16 * 16; const bf16* hb = H + sl * 256 + l16 * 16;
                int t = rw;
                if (t < MTOK) {
                    v4u Wa[16], Wb[16]; v4u ia0, ia1, ia2, ia3, ib0, ib1, ib2, ib3; v4u h0, h1;
                    L_LDIDS(ia, t, 0); L_LDIDS(ib, t, 1); { const GAS v4u* hp = (const GAS v4u*)(hb + (size_t)t * DM); h0 = hp[0]; h1 = hp[1]; }
                    L_ISSUE(Wa, ia, ub);
                    for (;;) {
                        const int tn = t + nW; const bool more = tn < MTOK; const int tp = more ? tn : t;
                        L_ISSUE(Wb, ib, ub);
                        L_LDIDS(ia, tp, 0); v4u hn0, hn1; { const GAS v4u* hp = (const GAS v4u*)(hb + (size_t)tp * DM); hn0 = hp[0]; hn1 = hp[1]; }
                        f32x2 hf[8];
                        hf[0] = (f32x2){bflo(h0.x), bfhi(h0.x)}; hf[1] = (f32x2){bflo(h0.y), bfhi(h0.y)}; hf[2] = (f32x2){bflo(h0.z), bfhi(h0.z)}; hf[3] = (f32x2){bflo(h0.w), bfhi(h0.w)};
                        hf[4] = (f32x2){bflo(h1.x), bfhi(h1.x)}; hf[5] = (f32x2){bflo(h1.y), bfhi(h1.y)}; hf[6] = (f32x2){bflo(h1.z), bfhi(h1.z)}; hf[7] = (f32x2){bflo(h1.w), bfhi(h1.w)};
                        float pre0, pre1;
                        L1_COMPUTE(Wa, pre0);
                        L_ISSUE(Wa, ia, ub);
                        L_LDIDS(ib, tp, 1);
                        L1_COMPUTE(Wb, pre1);
                        float* pp = PART + ((size_t)sl * MTOK + t) * 128; pp[lane] = pre0; pp[64 + lane] = pre1;
                        h0 = hn0; h1 = hn1;
                        if (!more) break;
                        t = tn;
                    }
                }
            }
#undef L1_COMPUTE
        }
        GRID_BAR();
        {
            PH_IDS();
            const float* PART = WSP(float, WS_G); const float* GATES = WSP(float, WS_GATES); float* ACTW = WSP(float, WS_ACT);
            for (int t = gw; t < MTOK; t += NGW) {
                float q0 = 0.f, q1 = 0.f;
#pragma unroll
                for (int s8 = 0; s8 < 8; ++s8) { const float* pp = PART + ((size_t)s8 * MTOK + t) * 128; q0 += pp[lane]; q1 += pp[64 + lane]; }
                q0 *= (1.f / 1024.f); q1 *= (1.f / 1024.f);
                const float* gp = GATES + (size_t)t * 128; float* ap = ACTW + (size_t)t * 128;
                const float g0 = gp[lane], g1 = gp[64 + lane];
                ap[lane] = 0.5f * q0 * (1.0f + erff(q0 * 0.70710678118654752f)) * g0 * (1.f / 64.f); ap[64 + lane] = 0.5f * q1 * (1.0f + erff(q1 * 0.70710678118654752f)) * g1 * (1.f / 64.f);
            }
        }
        GRID_BAR();
        {
            PH_IDS();
            const unsigned char* V8 = WSP(unsigned char, WS_V); const int* IDS = WSP(int, WS_IDS); const float* ACT = WSP(float, WS_ACT);
            typedef float f32x2 __attribute__((ext_vector_type(2)));
            const int myx = (int)(xb_xcc_id() & 7u); int nx = 0, xi = 0, nloc = 1;
            for (int j = 0; j < 8; ++j) { const int c = (int)__hip_atomic_load(ctl + CW_XRANK + 64 * j, __ATOMIC_RELAXED, __HIP_MEMORY_SCOPE_AGENT); if (c > 0) { ++nx; if (j < myx) ++xi; } if (j == myx) nloc = c; }
            const int rw = (int)MISC[1] * NWAVES + wave, nW = nloc * NWAVES; const int l16 = lane & 15, lrow = lane >> 4;
#if DBG_MODE == 2
            float* XO = WSP(float, WS_OC);
#else
            float* XO = X;
#endif
#define L2_COMPUTE(W, acr) do { _Pragma("unroll") for (int k = 0; k < 16; ++k) { const float a = bperm_f(acr, (lane & 48) + k); const f32x2 aa = (f32x2){a, a}; \
        const v4u ww = W[k]; const unsigned d0 = ww.x, d1 = ww.y, d2 = ww.z, d3 = ww.w; \
        oacc[0] += aa * L_CVT(d0, false); oacc[1] += aa * L_CVT(d0, true); oacc[2] += aa * L_CVT(d1, false); oacc[3] += aa * L_CVT(d1, true); \
        oacc[4] += aa * L_CVT(d2, false); oacc[5] += aa * L_CVT(d2, true); oacc[6] += aa * L_CVT(d3, false); oacc[7] += aa * L_CVT(d3, true); } } while (0)
            for (int sl = xi; sl < 8; sl += nx) {
                const unsigned char* vb = V8 + sl * 256 + l16 * 16; float* xb = XO + sl * 256 + l16 * 16;
                int t = rw;
                if (t < MTOK) {
                    v4u Wa[16], Wb[16]; v4u ia0, ia1, ia2, ia3, ib0, ib1, ib2, ib3; float ac0, ac1;
                    L_LDIDS(ia, t, 0); L_LDIDS(ib, t, 1); ac0 = ACT[(size_t)t * 128 + lane]; ac1 = ACT[(size_t)t * 128 + 64 + lane];
                    L_ISSUE(Wa, ia, vb);
                    for (;;) {
                        const int tn = t + nW; const bool more = tn < MTOK; const int tp = more ? tn : t;
                        L_ISSUE(Wb, ib, vb);
                        L_LDIDS(ia, tp, 0); const float an0 = ACT[(size_t)tp * 128 + lane], an1 = ACT[(size_t)tp * 128 + 64 + lane];
                        f32x2 oacc[8];
#pragma unroll
                        for (int k = 0; k < 8; ++k) oacc[k] = (f32x2){0.f, 0.f};
                        L2_COMPUTE(Wa, ac0);
                        L_ISSUE(Wa, ia, vb);
                        L_LDIDS(ib, tp, 1);
                        f32x4 xv[4]; { const GAS f32x4* q = (const GAS f32x4*)(xb + (size_t)t * DM); xv[0] = q[0]; xv[1] = q[1]; xv[2] = q[2]; xv[3] = q[3]; }
                        L2_COMPUTE(Wb, ac1);
#pragma unroll
                        for (int k = 0; k < 8; ++k) { float a = oacc[k].x, b = oacc[k].y; a += sx_f<16>(a); b += sx_f<16>(b); a = add32(a); b = add32(b); oacc[k] = (f32x2){a, b}; }
                        if (lane < 16) { GAS f32x4* q = (GAS f32x4*)(xb + (size_t)t * DM);
#pragma unroll
                            for (int k = 0; k < 4; ++k) { f32x4 v = xv[k];
#if DBG_MODE == 2
                                v = (f32x4){0.f, 0.f, 0.f, 0.f};
#endif
                                v.x += oacc[2 * k].x; v.y += oacc[2 * k].y; v.z += oacc[2 * k + 1].x; v.w += oacc[2 * k + 1].y; q[k] = v; } }
                        ac0 = an0; ac1 = an1;
                        if (!more) break;
                        t = tn;
                    }
                }
            }
#undef L2_COMPUTE
        }
#undef L_LDIDS
#undef L_ISSUE
#undef L_CVT
#endif
        GRID_BAR();
    }

    { PH_IDS();
    for (int m = gw; m < MTOK; m += NGW) {
        GAS f32x4* xr = (GAS f32x4*)(X + (size_t)m * DM) + lane; const GAS f32x4* gr = (const GAS f32x4*)INP(2) + lane;
        f32x4 v[8]; float s = 0.f;
#pragma unroll
        for (int j = 0; j < 8; ++j) { v[j] = xr[64 * j]; s += (v[j].x * v[j].x + v[j].y * v[j].y) + (v[j].z * v[j].z + v[j].w * v[j].w); }
        const float rstd = 1.0f / sqrtf(wave_sum(s) * (1.f / DM) + RMS_EPS);
#pragma unroll
        for (int j = 0; j < 8; ++j) { const f32x4 gg = gr[64 * j]; xr[64 * j] = v[j] * rstd * gg; }
    } }
}

extern "C" void kernel_launch(void* const* d_in, const int* in_sizes, int n_in, void* d_out, int out_size, void* d_ws, size_t ws_size, hipStream_t stream) {
    static int grid = 0;
    if (grid == 0) {
        if (n_in != 17 || in_sizes[0] != MTOK * DM || out_size != MTOK * DM || ws_size < WS_END) {
            fprintf(stderr, "kernel_launch: shape/workspace mismatch: n_in %d in0 %d out %d ws %zu (need %zu); nothing launched\n", n_in, n_in > 0 ? in_sizes[0] : -1, out_size, ws_size, (size_t)WS_END); grid = -1; return; }
        int dev = 0, cus = 0, per_cu = 0;
        if (hipGetDevice(&dev) != hipSuccess || hipDeviceGetAttribute(&cus, hipDeviceAttributeMultiprocessorCount, dev) != hipSuccess) { grid = -1; return; }
        if (hipFuncSetAttribute((const void*)mk_fwd, hipFuncAttributeMaxDynamicSharedMemorySize, LDS_BYTES) != hipSuccess) { fprintf(stderr, "kernel_launch: hipFuncSetAttribute failed\n"); grid = -1; return; }
        if (hipOccupancyMaxActiveBlocksPerMultiprocessor(&per_cu, (const void*)mk_fwd, NWAVES * 64, LDS_BYTES) != hipSuccess || per_cu < 1)
            fprintf(stderr, "kernel_launch: note: occupancy query reports %d workgroups per CU\n", per_cu);
        (void)hipGetLastError();
        grid = cus;
    }
    if (grid < 0) return;
    if (hipMemsetAsync((char*)d_ws + WS_CTL, 0, CTL_ZERO_BYTES, stream) != hipSuccess) { fprintf(stderr, "kernel_launch: memset failed\n"); return; }
    Args a{};
    for (int i = 0; i < 17; ++i) a.in[i] = (const float*)d_in[i];
    a.out = (float*)d_out; a.ws = (unsigned char*)d_ws;
    hipLaunchKernelGGL(mk_fwd, dim3(grid), dim3(NWAVES * 64), LDS_BYTES, stream, a);
    const hipError_t le = hipPeekAtLastError();
    if (le != hipSuccess) fprintf(stderr, "kernel_launch: launch failed: %s\n", hipGetErrorName(le));
}
```

```cpp
#include <hip/hip_runtime.h>
#include <cstdio>
#include <cstdint>

#ifndef DBG_MODE
#define DBG_MODE 0
#endif
constexpr int DM = 2048, NB = 4, SEQ = 4096, MTOK = NB * SEQ;
constexpr int INW = 14336, PJW = 8192, GTW = 6144;
constexpr int COL_DIL = 512, COL_DIFF = 5120;
constexpr int NEXP = 16384;
constexpr float RMS_EPS = 1e-6f;

typedef unsigned short bf16;
#define GAS __attribute__((address_space(1)))
#define LAS __attribute__((address_space(3)))
typedef unsigned v4u __attribute__((ext_vector_type(4)));
typedef float f32x4 __attribute__((ext_vector_type(4)));
typedef GAS unsigned gu32;

__device__ __forceinline__ int opaque_tid(int wave_sgpr) { int l; asm volatile("v_mbcnt_lo_u32_b32 %0, -1, 0\n\tv_mbcnt_hi_u32_b32 %0, -1, %0" : "=v"(l)); return wave_sgpr * 64 + l; }
namespace pg8 {
#define PG8_LAS __attribute__((address_space(3)))
typedef unsigned short bf16_t;
typedef short bf16x8 __attribute__((ext_vector_type(8)));
typedef float f32x4 __attribute__((ext_vector_type(4)));
typedef unsigned u32x4 __attribute__((ext_vector_type(4)));
constexpr int BM = 256, BK = 64, HALF = 128, HTB = HALF * BK * 2, STAGE_BYTES = 8 * HTB, NXCD = 8, WGM = 8;

__host__ __device__ __forceinline__ int lds_byte(int r, int c) { const int st = (r >> 4) * 2 + (c >> 5), rr = r & 15, cc = c & 31, ob = rr * 64 + cc * 2; return st * 1024 + (ob ^ (((ob >> 9) & 1) << 5)); }
__host__ __device__ __forceinline__ void stage_rc(int b, int& R, int& C) { const int st = b / 1024, sb = b % 1024, swz = sb ^ (((sb >> 9) & 1) << 5); R = (st >> 1) * 16 + swz / 64; C = (st & 1) * 32 + (swz % 64) / 2; }
__host__ __device__ __forceinline__ int perm32(int rho) { const int n = rho >> 4, i = rho & 15; return 8 * (i >> 2) + 4 * n + (i & 3); }

struct Unit { int pm, pn; long aoff, boff; int orow, ocol; };
struct Gemm { const bf16_t* A; const bf16_t* Bt; };

struct StaticOrder {
    int nM, nN, nwg, G, c; long sa, sb;
    __device__ void init(int M, int N, int G_, int c_, int lda, int ldb) { nM = M / BM; nN = N / BM; nwg = nM * nN; G = G_; c = c_; sa = 512L * lda; sb = 512L * ldb; }
    __device__ bool next(int i, Unit& u) const {
        const long L = (long)i * G + c; if (L >= nwg) return false;
        int wgid = (int)L; { const int q = nwg / NXCD, r = nwg % NXCD, xcd = wgid % NXCD, off = wgid / NXCD; wgid = (xcd < r ? xcd * (q + 1) : r * (q + 1) + (xcd - r) * q) + off; }
        const int nig = WGM * nN, gid = wgid / nig, fm = gid * WGM, gsz = (nM - fm) < WGM ? (nM - fm) : WGM;
        u.pm = fm + ((wgid % nig) % gsz); u.pn = (wgid % nig) / gsz;
        u.aoff = u.pm * sa; u.boff = u.pn * sb; u.orow = u.pm * BM; u.ocol = u.pn * BM; return true;
    }
};
struct F2Order : StaticOrder {
    __device__ bool next(int i, Unit& u) const { if (!StaticOrder::next(i, u)) return false; u.orow = (u.pn >> 1) * 4096 + u.pm * BM; u.ocol = (u.pn & 1) * BM; return true; }
};
struct F1Order {
    int G, c;
    __device__ bool next(int i, Unit& u) const {
        const int idx = i * G + c; if (idx >= 256) return false;
        const int bg = idx >> 4, st = idx & 15, b = bg >> 2, g = bg & 3;
        u.pm = 0; u.pn = idx; u.aoff = 0; u.boff = ((long)(b * 4096 + st * 256) * PJW + g * 128) * 2; u.orow = bg * 128; u.ocol = st * 256; return true;
    }
};

__device__ __forceinline__ unsigned cvt_pk_bf16(float lo, float hi) { unsigned r; asm volatile("v_cvt_pk_bf16_f32 %0, %1, %2" : "=v"(r) : "v"(lo), "v"(hi)); return r; }
__device__ __forceinline__ float bf_lo(unsigned w) { return __uint_as_float(w << 16); }
__device__ __forceinline__ float bf_hi(unsigned w) { return __uint_as_float(w & 0xffff0000u); }

#define PG8_PACK(v0, v1, w) do { (w).x = cvt_pk_bf16((v0)[0], (v0)[1]); (w).y = cvt_pk_bf16((v0)[2], (v0)[3]); (w).z = cvt_pk_bf16((v1)[0], (v1)[1]); (w).w = cvt_pk_bf16((v1)[2], (v1)[3]); } while (0)

struct EpiStore {
    static constexpr bool PERM = true;
    bf16_t* O; int ldo;
    __device__ __forceinline__ void operator()(const f32x4 (&acc)[2][2][4][2], const Unit& u, int wr, int wc, int fr, int fq) const {
        const int row0 = u.orow + wr * 64 + fr, col0 = u.ocol + wc * 32 + 8 * fq;
#pragma unroll
        for (int ai = 0; ai < 2; ++ai)
#pragma unroll
            for (int m = 0; m < 4; ++m) { bf16_t* rowp = O + (size_t)(row0 + ai * HALF + m * 16) * ldo + col0;
#pragma unroll
                for (int bj = 0; bj < 2; ++bj) { u32x4 w; PG8_PACK(acc[ai][bj][m][0], acc[ai][bj][m][1], w); *(u32x4*)(rowp + bj * HALF) = w; } }
    }
};
struct EpiZT {
    static constexpr bool PERM = true;
    bf16_t* O;
    __device__ __forceinline__ void operator()(const f32x4 (&acc)[2][2][4][2], const Unit& u, int wr, int wc, int fr, int fq) const {
        const int row0 = u.orow + wr * 64 + fr, col0 = u.ocol + wc * 32 + 8 * fq;
#pragma unroll
        for (int ai = 0; ai < 2; ++ai)
#pragma unroll
            for (int m = 0; m < 4; ++m) { bf16_t* rowp = O + (size_t)(row0 + m * 16) * 8192 + ai * 4096 + col0;
#pragma unroll
                for (int bj = 0; bj < 2; ++bj) { u32x4 w; PG8_PACK(acc[ai][bj][m][0], acc[ai][bj][m][1], w); *(u32x4*)(rowp + bj * HALF) = w; } }
    }
};
struct EpiProj {
    static constexpr bool PERM = true;
    bf16_t* P; bf16_t* Gt; const float* bg;
    __device__ __forceinline__ void operator()(const f32x4 (&acc)[2][2][4][2], const Unit& u, int wr, int wc, int fr, int fq) const {
        const bool isg = u.pn >= 32;
        const int row0 = u.pm * BM + wr * 64 + fr, col0 = (isg ? u.pn - 32 : u.pn) * BM + wc * 32 + 8 * fq, ldc = isg ? GTW : PJW;
        bf16_t* base = isg ? Gt : P;
        f32x4 bv[2][2];
#pragma unroll
        for (int bj = 0; bj < 2; ++bj)
#pragma unroll
            for (int n = 0; n < 2; ++n) bv[bj][n] = isg ? *(const f32x4*)(bg + col0 + bj * HALF + 4 * n) : (f32x4){0.f, 0.f, 0.f, 0.f};
#pragma unroll
        for (int ai = 0; ai < 2; ++ai)
#pragma unroll
            for (int m = 0; m < 4; ++m) { bf16_t* rowp = base + (size_t)(row0 + ai * HALF + m * 16) * ldc + col0;
#pragma unroll
                for (int bj = 0; bj < 2; ++bj) { f32x4 v0 = acc[ai][bj][m][0] + bv[bj][0], v1 = acc[ai][bj][m][1] + bv[bj][1];
                    if (isg) {
#pragma unroll
                        for (int j = 0; j < 4; ++j) { v0[j] = __builtin_amdgcn_rcpf(1.0f + __builtin_amdgcn_exp2f(-1.4426950408889634f * v0[j])); v1[j] = __builtin_amdgcn_rcpf(1.0f + __builtin_amdgcn_exp2f(-1.4426950408889634f * v1[j])); } }
                    u32x4 w; PG8_PACK(v0, v1, w); *(u32x4*)(rowp + bj * HALF) = w; } }
    }
};
struct EpiMerge3 {
    static constexpr bool PERM = true;
    const bf16_t* Gt; bf16_t* O; int br;
    __device__ __forceinline__ void operator()(const f32x4 (&acc)[2][2][4][2], const Unit& u, int wr, int wc, int fr, int fq) const {
        const int row0 = u.pm * BM + wr * 64 + fr, col0 = u.pn * BM + wc * 32 + 8 * fq;
#pragma unroll
        for (int ai = 0; ai < 2; ++ai)
#pragma unroll
            for (int m = 0; m < 4; ++m) { const bf16_t* gp = Gt + (size_t)(row0 + ai * HALF + m * 16) * GTW + br * DM + col0; bf16_t* rowp = O + (size_t)(row0 + ai * HALF + m * 16) * DM + col0;
#pragma unroll
                for (int bj = 0; bj < 2; ++bj) { const u32x4 g = *(const u32x4*)(gp + bj * HALF);
                    f32x4 v0 = acc[ai][bj][m][0], v1 = acc[ai][bj][m][1];
                    v0[0] *= bf_lo(g.x); v0[1] *= bf_hi(g.x); v0[2] *= bf_lo(g.y); v0[3] *= bf_hi(g.y);
                    v1[0] *= bf_lo(g.z); v1[1] *= bf_hi(g.z); v1[2] *= bf_lo(g.w); v1[3] *= bf_hi(g.w);
                    if (br) { const u32x4 p = *(const u32x4*)(rowp + bj * HALF);
                        v0[0] += bf_lo(p.x); v0[1] += bf_hi(p.x); v0[2] += bf_lo(p.y); v0[3] += bf_hi(p.y);
                        v1[0] += bf_lo(p.z); v1[1] += bf_hi(p.z); v1[2] += bf_lo(p.w); v1[3] += bf_hi(p.w); }
                    u32x4 w; PG8_PACK(v0, v1, w); *(u32x4*)(rowp + bj * HALF) = w; }
                asm volatile("" ::: "memory"); }
    }
};
struct EpiResF32 {
    static constexpr bool PERM = false;
    const float* base; float* out; int ldc;
    __device__ __forceinline__ void operator()(const f32x4 (&acc)[2][2][4][2], const Unit& u, int wr, int wc, int fr, int fq) const {
        const int row0 = u.orow + wr * 64 + fr, col0 = u.ocol + wc * 32 + 4 * fq;
#pragma unroll
        for (int ai = 0; ai < 2; ++ai)
#pragma unroll
            for (int m = 0; m < 4; ++m) { const size_t off = (size_t)(row0 + ai * HALF + m * 16) * ldc + col0;
#pragma unroll
                for (int bj = 0; bj < 2; ++bj)
#pragma unroll
                    for (int n = 0; n < 2; ++n) { f32x4 v = acc[ai][bj][m][n]; if (base) v += *(const f32x4*)(base + off + bj * HALF + n * 16); *(f32x4*)(out + off + bj * HALF + n * 16) = v; }
                asm volatile("" ::: "memory"); }
    }
};

template <class Epi, class Sched, bool ALIGN_EPI, int LDA, int LDB, int KK>
__device__ __forceinline__ void gemm_phase(PG8_LAS unsigned char* lds, const Gemm g, const Sched& S, const Epi& E, int wave0) {
    const int tid = opaque_tid(wave0), wid = wave0, lane = tid & 63, wr = wid >> 2, wc = wid & 3, fr = lane & 15, fq = lane >> 4;
    constexpr int nt = KK / BK;
    unsigned voffA[2], voffB[2];
#pragma unroll
    for (int i = 0; i < 2; ++i) { int R, C; stage_rc(tid * 16 + i * 8192, R, C); const int Rb = Epi::PERM ? ((R & ~31) + perm32(R & 31)) : R;
        voffA[i] = (unsigned)(R * LDA + C) * 2u; voffB[i] = (unsigned)(Rb * LDB + C) * 2u; }
    const size_t kstep = (size_t)(BK * 2);
    constexpr size_t hstepA = (size_t)HALF * LDA * 2, hstepB = (size_t)HALF * LDB * 2;
    const unsigned ldsw = (unsigned)wid * 1024u;
    const int aoff = lds_byte(wr * 64 + fr, fq * 8), boff = lds_byte(wc * 32 + fr, fq * 8);
#define PG8_SA(b, h) (((b) * 2 + (h)) * HTB)
#define PG8_SB(b, h) ((4 + (b) * 2 + (h)) * HTB)
#define PG8_STAGE(bufoff, gbase, voff) do { _Pragma("unroll") for (int _i = 0; _i < 2; ++_i) \
        __builtin_amdgcn_global_load_lds((const unsigned*)((const char*)(gbase) + (voff)[_i]), (PG8_LAS unsigned*)(lds + (bufoff) + ldsw + _i * 8192), 16, 0, 0); } while (0)
#define PG8_LDA(dst, b, h) do { _Pragma("unroll") for (int m = 0; m < 4; ++m) _Pragma("unroll") for (int k = 0; k < 2; ++k) dst[m][k] = *(const PG8_LAS bf16x8*)(lds + PG8_SA(b, h) + aoff + m * 2048 + k * 1024); } while (0)
#define PG8_LDB(dst, b, h) do { _Pragma("unroll") for (int n = 0; n < 2; ++n) _Pragma("unroll") for (int k = 0; k < 2; ++k) dst[n][k] = *(const PG8_LAS bf16x8*)(lds + PG8_SB(b, h) + boff + n * 2048 + k * 1024); } while (0)
#define PG8_MMA(ai, bj, At, Bt) do { __builtin_amdgcn_s_setprio(1); _Pragma("unroll") for (int m = 0; m < 4; ++m) _Pragma("unroll") for (int n = 0; n < 2; ++n) _Pragma("unroll") for (int k = 0; k < 2; ++k) \
        acc[ai][bj][m][n] = __builtin_amdgcn_mfma_f32_16x16x32_bf16(Bt[n][k], At[m][k], acc[ai][bj][m][n], 0, 0, 0); __builtin_amdgcn_s_setprio(0); } while (0)
#define PG8_WAIT_V(n) asm volatile("s_waitcnt vmcnt(" #n ")" ::: "memory")
#define PG8_WAIT_L(n) asm volatile("s_waitcnt lgkmcnt(" #n ")" ::: "memory")
#define PG8_BAR __builtin_amdgcn_s_barrier()
#define PG8_SCHED __builtin_amdgcn_sched_barrier(0)
    Unit cur, nxt; int ui = 0;
    if (!S.next(0, cur)) return;
    f32x4 acc[2][2][4][2];
#pragma unroll
    for (int a = 0; a < 2; ++a)
#pragma unroll
        for (int b = 0; b < 2; ++b)
#pragma unroll
            for (int m = 0; m < 4; ++m)
#pragma unroll
                for (int n = 0; n < 2; ++n) acc[a][b][m][n] = (f32x4){0.f, 0.f, 0.f, 0.f};
    bf16x8 At[4][2], B0[2][2], B1[2][2];
    const char* cA = (const char*)g.A + cur.aoff; const char* cB = (const char*)g.Bt + cur.boff;
    PG8_STAGE(PG8_SB(0, 0), cB, voffB); PG8_STAGE(PG8_SB(0, 1), cB + hstepB, voffB); PG8_STAGE(PG8_SA(0, 0), cA, voffA); PG8_STAGE(PG8_SA(0, 1), cA + hstepA, voffA);
    if (wr == 1) PG8_BAR;
    PG8_WAIT_V(2); PG8_BAR;
    PG8_STAGE(PG8_SB(1, 0), cB + kstep, voffB); PG8_STAGE(PG8_SA(1, 0), cA + kstep, voffA); PG8_STAGE(PG8_SB(1, 1), cB + hstepB + kstep, voffB);
    PG8_WAIT_V(6); PG8_BAR;
    for (;;) {
        const bool has_next = S.next(ui + 1, nxt);
        const char* nA = has_next ? (const char*)g.A + nxt.aoff : cA; const char* nB = has_next ? (const char*)g.Bt + nxt.boff : cB;
        for (int t = 0; t < nt; t += 2) {
            const bool last = (t == nt - 2);
            const char* a1 = cA + (size_t)(t + 1) * kstep;
            const char* a2 = last ? nA : cA + (size_t)(t + 2) * kstep; const char* b2 = last ? nB : cB + (size_t)(t + 2) * kstep;
            const char* a3 = a2 + kstep; const char* b3 = b2 + kstep;
            PG8_LDB(B0, 0, 0); PG8_LDB(B1, 0, 1); PG8_SCHED; PG8_LDA(At, 0, 0); PG8_STAGE(PG8_SA(1, 1), a1 + hstepA, voffA);
            PG8_WAIT_V(8); PG8_WAIT_L(0); PG8_BAR; PG8_MMA(0, 0, At, B0); PG8_MMA(0, 1, At, B1); PG8_BAR; PG8_SCHED;
            PG8_LDA(At, 0, 1); PG8_STAGE(PG8_SB(0, 0), b2, voffB); PG8_STAGE(PG8_SB(0, 1), b2 + hstepB, voffB); PG8_STAGE(PG8_SA(0, 0), a2, voffA);
            PG8_WAIT_V(8); PG8_WAIT_L(0); PG8_BAR; PG8_MMA(1, 0, At, B0); PG8_MMA(1, 1, At, B1); PG8_BAR; PG8_SCHED;
            PG8_LDB(B0, 1, 0); PG8_LDB(B1, 1, 1); PG8_SCHED; PG8_LDA(At, 1, 0); PG8_STAGE(PG8_SA(0, 1), a2 + hstepA, voffA);
            PG8_WAIT_V(8); PG8_WAIT_L(0); PG8_BAR; PG8_MMA(0, 0, At, B0); PG8_MMA(0, 1, At, B1); PG8_BAR; PG8_SCHED;
            PG8_LDA(At, 1, 1); PG8_STAGE(PG8_SB(1, 0), b3, voffB); PG8_STAGE(PG8_SB(1, 1), b3 + hstepB, voffB); PG8_STAGE(PG8_SA(1, 0), a3, voffA);
            PG8_WAIT_V(8); PG8_WAIT_L(0); PG8_BAR; PG8_MMA(1, 0, At, B0); PG8_MMA(1, 1, At, B1); PG8_BAR; PG8_SCHED;
        }
        if constexpr (ALIGN_EPI) { if (wr == 0) PG8_BAR; }
        E(acc, cur, wr, wc, fr, fq);
        if (!has_next) break;
#pragma unroll
        for (int a = 0; a < 2; ++a)
#pragma unroll
            for (int b = 0; b < 2; ++b)
#pragma unroll
                for (int m = 0; m < 4; ++m)
#pragma unroll
                    for (int n = 0; n < 2; ++n) acc[a][b][m][n] = (f32x4){0.f, 0.f, 0.f, 0.f};
        cur = nxt; cA = nA; cB = nB; ++ui;
        if constexpr (ALIGN_EPI) { if (wr == 1) PG8_BAR; }
    }
    PG8_WAIT_V(0);
    if constexpr (!ALIGN_EPI) { if (wr == 0) PG8_BAR; }
    PG8_BAR;
#undef PG8_SA
#undef PG8_SB
#undef PG8_STAGE
#undef PG8_LDA
#undef PG8_LDB
#undef PG8_MMA
#undef PG8_WAIT_V
#undef PG8_WAIT_L
#undef PG8_BAR
#undef PG8_SCHED
}
}

namespace attn {
using bf16x8 = __attribute__((ext_vector_type(8))) short;
using s16x4  = __attribute__((ext_vector_type(4))) short;
using f32x16 = __attribute__((ext_vector_type(16))) float;
using u32x4  = __attribute__((ext_vector_type(4))) unsigned;
constexpr int   D = 128, NW = 8, QBLK = 32, KVBLK = 64;
constexpr float SCALE = 0.088388347648318440f;
constexpr float THR = 8.f;
constexpr size_t SHM_V = KVBLK * D * 2, SHM_K = KVBLK * D * 2;
constexpr int LDS_WS = 2 * SHM_V + 2 * SHM_K, LDS_TAB = LDS_WS + NW * 64 * 4, LDS_END = LDS_TAB + 8192 * 4;
#define KSWZ(row, colB) ((row) * 256 + ((colB) ^ (((row) & 7) << 4)))
#define SBAR() __builtin_amdgcn_sched_barrier(0)
__device__ __forceinline__ int crow(int r, int hi) { return (r & 3) + 8 * (r >> 2) + 4 * hi; }
__device__ __forceinline__ unsigned cvtpk(float lo, float hi) { unsigned r; asm volatile("v_cvt_pk_bf16_f32 %0, %1, %2" : "=v"(r) : "v"(lo), "v"(hi)); return r; }

__device__ __forceinline__ void partialSM(f32x16& p0, f32x16& p1, float& m_reg, float& mn, float& alpha) {
  constexpr float C = SCALE * 1.4426950408889634f;
  float pmax = p0[0]; for (int r = 1; r < 16; ++r) pmax = fmaxf(pmax, p0[r]); for (int r = 0; r < 16; ++r) pmax = fmaxf(pmax, p1[r]);
  { auto rr = __builtin_amdgcn_permlane32_swap(__float_as_uint(pmax), __float_as_uint(pmax), false, false);
    pmax = fmaxf(__uint_as_float(rr[0]), __uint_as_float(rr[1])); }
  if (__builtin_expect(__all(pmax - m_reg <= THR / SCALE), 1)) { mn = m_reg; alpha = 1.f; }
  else { mn = fmaxf(m_reg, pmax); alpha = __builtin_amdgcn_exp2f((m_reg - mn) * C); m_reg = mn; }
  float mnC = -mn * C;
  for (int r = 0; r < 16; ++r) p0[r] = fmaf(p0[r], C, mnC); for (int r = 0; r < 16; ++r) p1[r] = fmaf(p1[r], C, mnC);
  for (int r = 0; r < 16; ++r) p0[r] = __builtin_amdgcn_exp2f(p0[r]);
}
__device__ __forceinline__ void finishSM(f32x16& p0, f32x16& p1, float alpha, float& l_reg, bf16x8& pa0, bf16x8& pa1, bf16x8& pa2, bf16x8& pa3) {
  for (int r = 0; r < 16; ++r) p1[r] = __builtin_amdgcn_exp2f(p1[r]);
  float ps = 0; for (int r = 0; r < 16; ++r) ps += p0[r]; for (int r = 0; r < 16; ++r) ps += p1[r];
  { auto rr = __builtin_amdgcn_permlane32_swap(__float_as_uint(ps), __float_as_uint(ps), false, false);
    ps = __uint_as_float(rr[0]) + __uint_as_float(rr[1]); }
  l_reg = l_reg * alpha + ps;
#define PK4(P, BASE, OUT) do { unsigned a0 = cvtpk(P[BASE + 0], P[BASE + 1]), a1 = cvtpk(P[BASE + 2], P[BASE + 3]);   \
    unsigned b0 = cvtpk(P[BASE + 4], P[BASE + 5]), b1 = cvtpk(P[BASE + 6], P[BASE + 7]);                              \
    auto r0 = __builtin_amdgcn_permlane32_swap(a0, b0, false, false); auto r1 = __builtin_amdgcn_permlane32_swap(a1, b1, false, false); \
    u32x4 w = {r0[0], r1[0], r0[1], r1[1]}; OUT = *reinterpret_cast<bf16x8*>(&w); } while (0)
  PK4(p0, 0, pa0); PK4(p0, 8, pa1); PK4(p1, 0, pa2); PK4(p1, 8, pa3);
#undef PK4
}
__device__ __forceinline__ void qkt(f32x16& p0, f32x16& p1, const bf16* Ks, const bf16x8* qr, int r32, int hi, const float* tl) {
#pragma unroll
  for (int r = 0; r < 16; ++r) { p0[r] = tl[(r & 3) + 8 * (r >> 2)]; p1[r] = tl[32 + (r & 3) + 8 * (r >> 2)]; }
#pragma unroll
  for (int d0 = 0; d0 < 8; ++d0) { int cb = (d0 * 16 + hi * 8) * 2;
    bf16x8 b0 = *reinterpret_cast<const bf16x8*>((const char*)Ks + KSWZ(r32, cb));
    bf16x8 b1 = *reinterpret_cast<const bf16x8*>((const char*)Ks + KSWZ(32 + r32, cb));
    p0 = __builtin_amdgcn_mfma_f32_32x32x16_bf16(b0, qr[d0], p0, 0, 0, 0);
    p1 = __builtin_amdgcn_mfma_f32_32x32x16_bf16(b1, qr[d0], p1, 0, 0, 0); }
}
__device__ __forceinline__ int v_st(int k, int c) { const int kk = (k & ~0xC) | ((k & 4) << 1) | ((k & 8) >> 1); return ((kk >> 3) * 4 + (c >> 5)) * 512 + ((kk & 7) * 32 + (c & 31)) * 2; }
__device__ __forceinline__ int v_rd_base(int lane) { return ((lane & 3) << 3) | (((lane >> 2) & 3) << 6) | (((lane >> 4) & 1) << 5) | (((lane >> 5) & 1) << 8); }
constexpr int v_rd_off(int d0, int ks, int half) { return d0 * 512 + ks * 4096 + half * 2048; }
template <int OFF> __device__ __forceinline__ s16x4 tr_read(int vb) {
  s16x4 r; asm volatile("ds_read_b64_tr_b16 %0, %1 offset:%2" : "=&v"(r) : "v"(vb), "i"(OFF) : "memory"); return r;
}
template <int D0> __device__ __forceinline__ void pv_one(f32x16& od, int vb, bf16x8 pa0, bf16x8 pa1, bf16x8 pa2, bf16x8 pa3) {
  const s16x4 l0 = tr_read<v_rd_off(D0, 0, 0)>(vb), h0 = tr_read<v_rd_off(D0, 0, 1)>(vb), l1 = tr_read<v_rd_off(D0, 1, 0)>(vb), h1 = tr_read<v_rd_off(D0, 1, 1)>(vb);
  const s16x4 l2 = tr_read<v_rd_off(D0, 2, 0)>(vb), h2 = tr_read<v_rd_off(D0, 2, 1)>(vb), l3 = tr_read<v_rd_off(D0, 3, 0)>(vb), h3 = tr_read<v_rd_off(D0, 3, 1)>(vb);
  asm volatile("s_waitcnt lgkmcnt(0)" ::: "memory"); SBAR();
#define PK(L, H) (bf16x8){L[0], L[1], L[2], L[3], H[0], H[1], H[2], H[3]}
  od = __builtin_amdgcn_mfma_f32_32x32x16_bf16(pa0, PK(l0, h0), od, 0, 0, 0);
  od = __builtin_amdgcn_mfma_f32_32x32x16_bf16(pa1, PK(l1, h1), od, 0, 0, 0);
  od = __builtin_amdgcn_mfma_f32_32x32x16_bf16(pa2, PK(l2, h2), od, 0, 0, 0);
  od = __builtin_amdgcn_mfma_f32_32x32x16_bf16(pa3, PK(l3, h3), od, 0, 0, 0);
#undef PK
}
__device__ __forceinline__ void pv_d0(f32x16* o, int vb, bf16x8 pa0, bf16x8 pa1, bf16x8 pa2, bf16x8 pa3) {
  pv_one<0>(o[0], vb, pa0, pa1, pa2, pa3); pv_one<1>(o[1], vb, pa0, pa1, pa2, pa3); pv_one<2>(o[2], vb, pa0, pa1, pa2, pa3); pv_one<3>(o[3], vb, pa0, pa1, pa2, pa3);
}

struct Unit { const bf16* Q; const bf16* K; const bf16* V; bf16* O; float* lse; long ldq, ldk, ldo; int lse_ld, kt0, nt, qoff; };
__device__ __forceinline__ void attn_unit(const Unit& u, char* lds, int wave0) {
  const int tid = opaque_tid(wave0), wid = wave0, lane = tid & 63, r32 = lane & 31, hi = lane >> 5;
  bf16* V_lds = (bf16*)lds; bf16* K_lds = (bf16*)(lds + 2 * SHM_V);
  float* ws = (float*)(lds + LDS_WS) + wid * 64; float* li_l = ws; float* al_l = ws + 32;
  const float* tabL = (const float*)(lds + LDS_TAB);
  float m_reg = -1e30f, l_reg = 0; f32x16 o[4] = {}; bf16x8 qr[8];
  const bf16* Qw = u.Q + (long)(wid * QBLK + r32) * u.ldq + hi * 8;
#pragma unroll
  for (int d0 = 0; d0 < 8; ++d0) qr[d0] = *reinterpret_cast<const bf16x8*>(Qw + d0 * 16);
  const int sr = tid >> 4, sc = (tid & 15) * 8, vst0 = v_st(sr, sc), vst1 = v_st(32 + sr, sc);
  const int vb0 = (int)(uintptr_t)V_lds + v_rd_base(lane);
  const long tstep = (long)KVBLK * u.ldk * 2;
  const char* Kh = (const char*)u.K + (long)u.kt0 * tstep; const char* Vh = (const char*)u.V + (long)u.kt0 * tstep;
  const unsigned lo0 = (unsigned)((sr * (int)u.ldk + sc) * 2), lo1 = lo0 + (unsigned)(32 * (int)u.ldk * 2);
  const float* tl0 = tabL + (4096 + u.kt0 * KVBLK + 4 * hi - (u.qoff + wid * QBLK + r32));
  struct { bf16x8 vs0, vs1, ks0, ks1; } sr_[2];
#define SLOAD(i, tj) do { const char* vt_ = Vh + (long)(tj) * tstep; const char* kt_ = Kh + (long)(tj) * tstep; \
    sr_[i].vs0 = *reinterpret_cast<const bf16x8*>(vt_ + lo0); sr_[i].vs1 = *reinterpret_cast<const bf16x8*>(vt_ + lo1); \
    sr_[i].ks0 = *reinterpret_cast<const bf16x8*>(kt_ + lo0); sr_[i].ks1 = *reinterpret_cast<const bf16x8*>(kt_ + lo1); } while (0)
#define SWRITE(b, i) do { *(bf16x8*)((char*)V_lds + (b) * SHM_V + vst0) = sr_[i].vs0;          \
    *(bf16x8*)((char*)V_lds + (b) * SHM_V + vst1) = sr_[i].vs1; int kc = sc * 2;               \
    *(bf16x8*)((char*)K_lds + (b) * SHM_K + KSWZ(sr, kc)) = sr_[i].ks0;                       \
    *(bf16x8*)((char*)K_lds + (b) * SHM_K + KSWZ(32 + sr, kc)) = sr_[i].ks1; } while (0)
#define SWAIT() asm volatile("s_waitcnt vmcnt(4)" ::: "memory")
#define RESC(a) do { if (__any((a) < 1.f)) { if (hi == 0) al_l[r32] = (a); asm volatile("s_waitcnt lgkmcnt(0)" ::: "memory"); \
    for (int d = 0; d < 4; ++d) for (int r = 0; r < 16; ++r) o[d][r] *= al_l[crow(r, hi)]; } } while (0)
  f32x16 pA0, pA1, pB0, pB1; float mnA, mnB, alA, alB; bf16x8 pa0, pa1, pa2, pa3; const int NT = u.nt;
  constexpr int SE = 0, SO = 1;
  SLOAD(SE, 0); asm volatile("s_waitcnt vmcnt(0)" ::: "memory"); SWRITE(0, SE); __syncthreads();
  qkt(pA0, pA1, K_lds, qr, r32, hi, tl0); partialSM(pA0, pA1, m_reg, mnA, alA);
  SLOAD(SO, 1); if (2 < NT) SLOAD(SE, 2);
  SWAIT(); SWRITE(1, SO); __syncthreads();
  for (int j = 1; j + 1 < NT; j += 2) {
    SBAR(); qkt(pB0, pB1, (bf16*)((char*)K_lds + SHM_K), qr, r32, hi, tl0 + j * KVBLK);
    finishSM(pA0, pA1, alA, l_reg, pa0, pa1, pa2, pa3); SBAR();
    SLOAD(SO, j + 2); SBAR();
    pv_d0(o, vb0, pa0, pa1, pa2, pa3); partialSM(pB0, pB1, m_reg, mnB, alB);
    __syncthreads(); SWAIT(); SWRITE(0, SE);
    RESC(alB); __syncthreads();
    SBAR(); qkt(pA0, pA1, K_lds, qr, r32, hi, tl0 + (j + 1) * KVBLK);
    finishSM(pB0, pB1, alB, l_reg, pa0, pa1, pa2, pa3); SBAR();
    if (j + 3 < NT) SLOAD(SE, j + 3); SBAR();
    pv_d0(o, vb0 + (int)SHM_V, pa0, pa1, pa2, pa3); partialSM(pA0, pA1, m_reg, mnA, alA);
    __syncthreads(); SWAIT(); SWRITE(1, SO);
    RESC(alA); __syncthreads();
  }
  SBAR(); qkt(pB0, pB1, (bf16*)((char*)K_lds + SHM_K), qr, r32, hi, tl0 + (NT - 1) * KVBLK);
  finishSM(pA0, pA1, alA, l_reg, pa0, pa1, pa2, pa3); SBAR();
  pv_d0(o, vb0, pa0, pa1, pa2, pa3); partialSM(pB0, pB1, m_reg, mnB, alB);
  __syncthreads(); RESC(alB);
  finishSM(pB0, pB1, alB, l_reg, pa0, pa1, pa2, pa3); SBAR();
  pv_d0(o, vb0 + (int)SHM_V, pa0, pa1, pa2, pa3);
  if (hi == 0) li_l[r32] = l_reg; asm volatile("s_waitcnt lgkmcnt(0)" ::: "memory");
  float rli[16];
#pragma unroll
  for (int r = 0; r < 16; ++r) rli[r] = __builtin_amdgcn_rcpf(li_l[crow(r, hi)]);
  bf16* Ow = u.O + (long)(wid * QBLK) * u.ldo;
#pragma unroll
  for (int r = 0; r < 16; ++r) { int orow = crow(r, hi);
#pragma unroll
    for (int d0 = 0; d0 < 4; ++d0) { const float v = o[d0][r] * rli[r]; Ow[(long)orow * u.ldo + d0 * 32 + r32] = (bf16)(cvtpk(v, v) & 0xffffu); } }
  if (u.lse != nullptr && hi == 0) u.lse[(long)(wid * QBLK + r32) * u.lse_ld] = m_reg * SCALE + __logf(l_reg);
#undef SLOAD
#undef SWRITE
#undef SWAIT
#undef RESC
}
#undef KSWZ
#undef SBAR
}

constexpr int NWAVES = 8;
constexpr size_t MiB = 1u << 20;
constexpr size_t WS_CTL = 0, CTL_ZERO_BYTES = 1 * MiB;
constexpr size_t WS_CS   = 1 * MiB;
constexpr size_t WS_SKBD = 1 * MiB + 256 * 1024;
constexpr size_t WS_TAB  = 2 * MiB;
constexpr size_t WS_LSE  = 3 * MiB;
constexpr size_t WS_WCAT = 4 * MiB, WS_WO = 12 * MiB, WS_WQ = 20 * MiB;
constexpr size_t WS_WIN  = 28 * MiB;
constexpr size_t WS_DFT  = 84 * MiB;
constexpr size_t WS_U    = 148 * MiB, WS_V = 180 * MiB;
constexpr size_t WS_H    = 276 * MiB;
constexpr size_t WS_PROJ = 340 * MiB;
constexpr size_t WS_G    = 596 * MiB;
constexpr size_t WS_ZT   = 788 * MiB;
constexpr size_t WS_OC   = 820 * MiB;
constexpr size_t WS_MG   = 884 * MiB;
constexpr size_t WS_END  = 948 * MiB;
#if DBG_MODE == 2
constexpr size_t WS_ACT = WS_PROJ + 208 * MiB;
#else
constexpr size_t WS_ACT = WS_PROJ + 200 * MiB;
#endif
constexpr size_t WS_Q = WS_PROJ, WS_SC = WS_PROJ + 64 * MiB, WS_IDS = WS_PROJ + 192 * MiB, WS_GATES = WS_PROJ + 200 * MiB;
constexpr int CW_BAR = 4096;
constexpr int CW_XRANK = 12288;
constexpr int CW_QUEUE = 16384;
constexpr int RING_BYTES = 131072, LDSCTL_OFF = RING_BYTES, MISC_OFF = LDSCTL_OFF + 320, LDS_BYTES = 147456;

#define LDS_WAIT() asm volatile("s_waitcnt lgkmcnt(0)" ::: "memory")
#define VM_WAIT() asm volatile("s_waitcnt vmcnt(0)" ::: "memory")
__device__ __forceinline__ unsigned f2bf(float f) { unsigned u = __builtin_bit_cast(unsigned, f); return (u + 0x7fffu + ((u >> 16) & 1u)) >> 16; }
__device__ __forceinline__ unsigned pk2(float lo, float hi) { return f2bf(lo) | (f2bf(hi) << 16); }
__device__ __forceinline__ float bflo(unsigned w) { return __uint_as_float(w << 16); }
__device__ __forceinline__ float bfhi(unsigned w) { return __uint_as_float(w & 0xffff0000u); }

#define XB_TMO      128
#define XB_XCNT(j)  (256  + 64 * (j))
#define XB_XSUB(j)  (1280 + 64 * (j))
#define XB_XGEN(j)  (2304 + 64 * (j))
#define XB_TOP      3328
#define XB_TOPGEN   3392
#define XCD_BAR_WORDS 3456
#define XB_SPIN_CAP (1u << 20)
__device__ __forceinline__ unsigned xb_ld(unsigned* p)              { return __hip_atomic_load(p, __ATOMIC_RELAXED, __HIP_MEMORY_SCOPE_AGENT); }
__device__ __forceinline__ unsigned xb_add(unsigned* p, unsigned v) { return __hip_atomic_fetch_add(p, v, __ATOMIC_RELAXED, __HIP_MEMORY_SCOPE_AGENT); }
__device__ __forceinline__ unsigned xb_xcc_id() { return (unsigned)__builtin_amdgcn_s_getreg((3 << 11) | 20) & 0xFu; }
#define XB_SPIN(cond, bar) do { unsigned _sp = 0; while (cond) { __builtin_amdgcn_s_sleep(1); \
    if ((++_sp & 255u) == 0u) { if (xb_ld(&(bar)[XB_TMO])) break; if (_sp > XB_SPIN_CAP) { atomicAdd(&(bar)[XB_TMO], 1u); break; } } } } while (0)
struct XcdBarrier { unsigned* bar; unsigned x; volatile LAS unsigned* st; };
__device__ __forceinline__ XcdBarrier xcd_barrier_post(unsigned* bar, volatile LAS unsigned* st) {
    XcdBarrier b; b.bar = bar; b.x = xb_xcc_id(); b.st = st;
    if (threadIdx.x == 0) (void)xb_add(&bar[XB_XCNT(b.x)], 1u);
    return b;
}
__device__ __forceinline__ void xcd_barrier_complete(unsigned* bar, unsigned x, unsigned& nloc, unsigned& nx) {
    const unsigned G = gridDim.x * gridDim.y * gridDim.z;
    unsigned sum, cnt, mine, sp = 0u;
    for (;;) {
        sum = 0u; cnt = 0u; mine = 0u;
#pragma unroll
        for (unsigned j = 0; j < 16; ++j) { const unsigned c = xb_ld(&bar[XB_XCNT(j)]); sum += c; cnt += (c > 0u) ? 1u : 0u; mine = (j == x) ? c : mine; }
        if (sum == G) break;
        __builtin_amdgcn_s_sleep(1);
        if ((++sp & 255u) == 0u) { if (xb_ld(&bar[XB_TMO])) break; if (sp > XB_SPIN_CAP) { atomicAdd(&bar[XB_TMO], 1u); break; } }
    }
    nloc = mine > 0u ? mine : 1u; nx = cnt > 0u ? cnt : 1u;
}
__device__ __forceinline__ void xcd_barrier(const XcdBarrier& b) {
    asm volatile("s_waitcnt vmcnt(0)" ::: "memory");
    __syncthreads();
    if (threadIdx.x == 0) {
        unsigned* bar = b.bar;
        __builtin_amdgcn_s_waitcnt(0);
        unsigned nloc = b.st[0], nx = b.st[1];
        if (nloc == 0u) { xcd_barrier_complete(bar, b.x, nloc, nx); b.st[0] = nloc; b.st[1] = nx; }
        const unsigned old = xb_add(&bar[XB_XSUB(b.x)], 1u);
        const unsigned gen = old / nloc;
        if (old + 1u == (gen + 1u) * nloc) {
            __builtin_amdgcn_fence(__ATOMIC_RELEASE, "agent");
            asm volatile("s_waitcnt vmcnt(0)" ::: "memory");
            const unsigned og = xb_add(&bar[XB_TOP], 1u);
            const unsigned tg = og / nx;
            if (og + 1u == (tg + 1u) * nx) xb_add(&bar[XB_TOPGEN], 1u);
            else XB_SPIN(xb_ld(&bar[XB_TOPGEN]) == tg, bar);
            __builtin_amdgcn_fence(__ATOMIC_ACQUIRE, "agent");
            xb_add(&bar[XB_XGEN(b.x)], 1u);
            asm volatile("s_waitcnt vmcnt(0)" ::: "memory");
        } else {
            XB_SPIN(xb_ld(&bar[XB_XGEN(b.x)]) == gen, bar);
            __builtin_amdgcn_fence(__ATOMIC_ACQUIRE, "agent");
            asm volatile("s_waitcnt vmcnt(0)" ::: "memory");
        }
    }
    __syncthreads();
}

template <int MASK> __device__ __forceinline__ int sx_i(int v) { return __builtin_amdgcn_ds_swizzle(v, 0x1f | (MASK << 10)); }
template <int MASK> __device__ __forceinline__ float sx_f(float v) { return __int_as_float(sx_i<MASK>(__float_as_int(v))); }
__device__ __forceinline__ float add32(float v) { auto rr = __builtin_amdgcn_permlane32_swap(__float_as_uint(v), __float_as_uint(v), false, false); return __uint_as_float(rr[0]) + __uint_as_float(rr[1]); }
__device__ __forceinline__ unsigned max32(unsigned v) { auto rr = __builtin_amdgcn_permlane32_swap(v, v, false, false); return rr[0] > rr[1] ? rr[0] : rr[1]; }
__device__ __forceinline__ float other32(float v, bool upper) { auto rr = __builtin_amdgcn_permlane32_swap(__float_as_uint(v), __float_as_uint(v), false, false); return __uint_as_float(upper ? rr[0] : rr[1]); }
__device__ __forceinline__ float bperm_f(float v, int src_lane) { return __int_as_float(__builtin_amdgcn_ds_bpermute(src_lane * 4, __float_as_int(v))); }
__device__ __forceinline__ int bperm_i(int v, int src_lane) { return __builtin_amdgcn_ds_bpermute(src_lane * 4, v); }
__device__ __forceinline__ float wave_sum(float v) {
    v += sx_f<1>(v); v += sx_f<2>(v); v += sx_f<4>(v); v += sx_f<8>(v); v += sx_f<16>(v); return add32(v);
}
__device__ __forceinline__ unsigned umax(unsigned a, unsigned b) { return a > b ? a : b; }
__device__ __forceinline__ unsigned wave_max_u32(unsigned v) {
    v = umax(v, (unsigned)sx_i<1>((int)v)); v = umax(v, (unsigned)sx_i<2>((int)v)); v = umax(v, (unsigned)sx_i<4>((int)v)); v = umax(v, (unsigned)sx_i<8>((int)v)); v = umax(v, (unsigned)sx_i<16>((int)v)); return max32(v);
}
template <int CTRL, int RMASK> __device__ __forceinline__ unsigned dpp_max_u(unsigned v) { const unsigned t = (unsigned)__builtin_amdgcn_update_dpp((int)v, (int)v, CTRL, RMASK, 0xF, false); return t > v ? t : v; }
__device__ __forceinline__ unsigned wave_max_dpp(unsigned v) {
    v = dpp_max_u<0xB1, 0xF>(v); v = dpp_max_u<0x4E, 0xF>(v); v = dpp_max_u<0x141, 0xF>(v); v = dpp_max_u<0x140, 0xF>(v); v = dpp_max_u<0x142, 0xA>(v); v = dpp_max_u<0x143, 0xC>(v);
    return (unsigned)__builtin_amdgcn_readlane((int)v, 63);
}
template <int CTRL> __device__ __forceinline__ float dpp_add_f(float v) { return v + __int_as_float(__builtin_amdgcn_update_dpp(__float_as_int(v), __float_as_int(v), CTRL, 0xF, 0xF, false)); }
__device__ __forceinline__ float row_sum16(float v) { v = dpp_add_f<0xB1>(v); v = dpp_add_f<0x4E>(v); v = dpp_add_f<0x141>(v); return dpp_add_f<0x140>(v); }
__device__ __forceinline__ unsigned row_max16_u(unsigned v) { v = dpp_max_u<0xB1, 0xF>(v); v = dpp_max_u<0x4E, 0xF>(v); v = dpp_max_u<0x141, 0xF>(v); return dpp_max_u<0x140, 0xF>(v); }
template <int CTRL> __device__ __forceinline__ float dpp_maxf(float v) { return fmaxf(v, __int_as_float(__builtin_amdgcn_update_dpp(__float_as_int(v), __float_as_int(v), CTRL, 0xF, 0xF, false))); }
__device__ __forceinline__ float row_max16_f(float v) { v = dpp_maxf<0xB1>(v); v = dpp_maxf<0x4E>(v); v = dpp_maxf<0x141>(v); return dpp_maxf<0x140>(v); }
__device__ __forceinline__ float okey_inv(unsigned k) { return __uint_as_float((k & 0x80000000u) ? (k & 0x7fffffffu) : ~k); }
#define CE_DESC(a, b) do { const unsigned hi_ = (a) > (b) ? (a) : (b), lo_ = (a) > (b) ? (b) : (a); (a) = hi_; (b) = lo_; } while (0)
__device__ __forceinline__ unsigned okey(float f) { const unsigned u = __float_as_uint(f); return (u & 0x80000000u) ? ~u : (u | 0x80000000u); }

__device__ __forceinline__ void transpose_item(const float* W, int N, bf16* WT, int ldo, int col_off, LAS float* scr, int item, int lane) {
    const int nblk = N / 32, kb = item / nblk, nb = item % nblk, k0 = 64 * kb, n0 = 32 * nb;
#pragma unroll 8
    for (int i = 0; i < 32; ++i) { const int kk = 2 * i + (lane >> 5); scr[kk * 33 + (lane & 31)] = W[(size_t)(k0 + kk) * N + n0 + (lane & 31)]; }
    LDS_WAIT(); asm volatile("" ::: "memory");
    const int c = lane & 7;
#pragma unroll
    for (int j = 0; j < 4; ++j) { const int n = (lane >> 3) + 8 * j; const LAS float* s = scr + (8 * c) * 33 + n;
        v4u o; o.x = pk2(s[0 * 33], s[1 * 33]); o.y = pk2(s[2 * 33], s[3 * 33]); o.z = pk2(s[4 * 33], s[5 * 33]); o.w = pk2(s[6 * 33], s[7 * 33]);
        *(GAS v4u*)(WT + (size_t)(n0 + n) * ldo + col_off + k0 + 8 * c) = o; }
    LDS_WAIT(); asm volatile("" ::: "memory");
}
__device__ __forceinline__ void rms_row_to_bf16(const float* xrow, const float* g, bf16* orow, int lane) {
    const GAS f32x4* xr = (const GAS f32x4*)xrow + lane; const GAS f32x4* gr = (const GAS f32x4*)g + lane;
    f32x4 v[8]; float s = 0.f;
#pragma unroll
    for (int j = 0; j < 8; ++j) { v[j] = xr[64 * j]; s += (v[j].x * v[j].x + v[j].y * v[j].y) + (v[j].z * v[j].z + v[j].w * v[j].w); }
    const float rstd = 1.0f / sqrtf(wave_sum(s) * (1.f / DM) + RMS_EPS);
    GAS unsigned long long* o8 = (GAS unsigned long long*)orow + lane;
#pragma unroll
    for (int j = 0; j < 8; ++j) { const f32x4 gg = gr[64 * j]; o8[64 * j] = (unsigned long long)pk2(v[j].x * rstd * gg.x, v[j].y * rstd * gg.y) | ((unsigned long long)pk2(v[j].z * rstd * gg.z, v[j].w * rstd * gg.w) << 32); }
}
typedef __bf16 bf2_t __attribute__((ext_vector_type(2)));
__device__ __forceinline__ float DOT2(unsigned a, unsigned b, float c) { return __builtin_amdgcn_fdot2_f32_bf16(__builtin_bit_cast(bf2_t, a), __builtin_bit_cast(bf2_t, b), c, false); }
__device__ __forceinline__ int rel_bucket(int rel) {
    const int n = rel < 0 ? -rel : rel;
    int b = n;
    if (n >= 8) { b = 5 + (31 - __builtin_clz((unsigned)n)); if (b > 15) b = 15; }
    return b + (rel > 0 ? 16 : 0);
}

#ifndef PH_D1
#define PH_D1 1
#endif
#ifndef PH_D2
#define PH_D2 1
#endif
#ifndef PH_A
#define PH_A 1
#endif
#ifndef PH_B
#define PH_B 1
#endif
#ifndef PH_C
#define PH_C 1
#endif
#ifndef PH_D
#define PH_D 1
#endif
#ifndef PH_E
#define PH_E 1
#endif
#ifndef PH_F
#define PH_F 1
#endif
#ifndef PH_G
#define PH_G 1
#endif
#ifndef PH_H
#define PH_H 1
#endif
#ifndef PH_I
#define PH_I 1
#endif
#ifndef PH_J
#define PH_J 1
#endif
#ifndef PH_K
#define PH_K 1
#endif
#ifndef PH_L
#define PH_L 1
#endif
struct Args { const float* in[17]; float* out; unsigned char* ws; };

#define CAS __attribute__((address_space(4)))
__device__ __forceinline__ const void* karg(int k) { const CAS char* ka = (const CAS char*)__builtin_amdgcn_kernarg_segment_ptr(); asm volatile("" : "+s"(ka)); return *(const void* const CAS*)(ka + 8 * k); }
#define WSP(T, off) ((T*)((unsigned char*)karg(18) + (off)))
#define INP(k) ((const float*)karg(k))
#define INL(k, stride) (INP(k) + (size_t)layer * (size_t)(stride))
#define X ((float*)karg(17))
__global__ void __launch_bounds__(NWAVES * 64, 2) mk_fwd(Args args_unused) {
    extern __shared__ __attribute__((aligned(16))) unsigned char lds[];
    LAS unsigned char* ldsl = (LAS unsigned char*)lds;
    volatile LAS unsigned* MISC = (volatile LAS unsigned*)(ldsl + MISC_OFF);
    const int wave0 = __builtin_amdgcn_readfirstlane((int)threadIdx.x >> 6);
    const int G = gridDim.x; const int bx = blockIdx.x; const int vcu = (G % 8 == 0) ? (bx % 8) * (G / 8) + bx / 8 : bx;
    const int NGW = G * NWAVES, NGT = NGW * 64;
#define PH_IDS() const int tid = opaque_tid(wave0), lane = tid & 63, wave = wave0, gw = vcu * NWAVES + wave, gt = gw * 64 + lane; (void)gt; (void)gw; (void)lane
    gu32* ctl = (gu32*)WSP(unsigned char, WS_CTL);
    for (int u = threadIdx.x; u < (LDS_BYTES - LDSCTL_OFF) / 4; u += NWAVES * 64) ((LAS unsigned*)(ldsl + LDSCTL_OFF))[u] = 0u;
    __syncthreads();
    XcdBarrier bar = xcd_barrier_post((unsigned*)(ctl + CW_BAR), MISC + 8);
    if (threadIdx.x == 0) MISC[1] = __hip_atomic_fetch_add(ctl + CW_XRANK + 64 * (int)(xb_xcc_id() & 7u), 1u, __ATOMIC_RELAXED, __HIP_MEMORY_SCOPE_AGENT);
#define GRID_BAR() xcd_barrier(bar)

    for (int layer = 0; layer < 2; ++layer) {

#if PH_A
        {
            PH_IDS();
            LAS float* scr = (LAS float*)(ldsl + wave * 16384);
            const float* w_in = INL(4, (size_t)DM * INW); const float* w_up_a = INL(6, 512 * DM); const float* w_up_b = INL(7, 512 * DM); const float* w_up_c = INL(8, 1024 * DM);
            const float* w_o = INL(11, DM * DM); const float* wq = INL(13, DM * DM); const float* subk = INL(14, 2 * 128 * 128);
            const float* pu = INL(15, (size_t)NEXP * DM); const float* pv = INL(16, (size_t)NEXP * DM); const float* mix_g = INL(3, DM); const float* rel_bias = INP(1);
            bf16* WIN = WSP(bf16, WS_WIN); bf16* WCAT = WSP(bf16, WS_WCAT); bf16* WO = WSP(bf16, WS_WO); bf16* WQ = WSP(bf16, WS_WQ); unsigned char* U8 = WSP(unsigned char, WS_U); unsigned char* V8 = WSP(unsigned char, WS_V);
            bf16* SKBD = WSP(bf16, WS_SKBD); bf16* H = WSP(bf16, WS_H); bf16* DFT = WSP(bf16, WS_DFT); bf16* CS = WSP(bf16, WS_CS); float* TAB = WSP(float, WS_TAB);
            constexpr int I_IN = (DM / 64) * (INW / 32), I_A = (512 / 64) * (DM / 32), I_C = (1024 / 64) * (DM / 32), I_SQ = (DM / 64) * (DM / 32);
            constexpr int NITEMS = I_IN + 2 * I_A + I_C + 2 * I_SQ;
            for (int it = gw; it < NITEMS; it += NGW) {
                int r = it;
                if (r < I_IN) { transpose_item(w_in, INW, WIN, DM, 0, scr, r, lane); continue; } r -= I_IN;
                if (r < I_A) { transpose_item(w_up_a, DM, WCAT, DM, 0, scr, r, lane); continue; } r -= I_A;
                if (r < I_A) { transpose_item(w_up_b, DM, WCAT, DM, 512, scr, r, lane); continue; } r -= I_A;
                if (r < I_C) { transpose_item(w_up_c, DM, WCAT, DM, 1024, scr, r, lane); continue; } r -= I_C;
                if (r < I_SQ) { transpose_item(w_o, DM, WO, DM, 0, scr, r, lane); continue; } r -= I_SQ;
                transpose_item(wq, DM, WQ, DM, 0, scr, r, lane);
            }
            for (size_t i = (size_t)gt; i < (size_t)NEXP * DM / 16; i += (size_t)NGT) {
#pragma unroll
                for (int tb = 0; tb < 2; ++tb) {
                    const GAS f32x4* src = (const GAS f32x4*)(tb ? pv : pu) + 4 * i; const float sc = tb ? 64.f : 1024.f;
                    const f32x4 a = src[0], b = src[1], c = src[2], d = src[3]; v4u o;
                    int w;
                    w = __builtin_amdgcn_cvt_pk_fp8_f32(a.x * sc, a.y * sc, 0, false); w = __builtin_amdgcn_cvt_pk_fp8_f32(a.z * sc, a.w * sc, w, true); o.x = (unsigned)w;
                    w = __builtin_amdgcn_cvt_pk_fp8_f32(b.x * sc, b.y * sc, 0, false); w = __builtin_amdgcn_cvt_pk_fp8_f32(b.z * sc, b.w * sc, w, true); o.y = (unsigned)w;
                    w = __builtin_amdgcn_cvt_pk_fp8_f32(c.x * sc, c.y * sc, 0, false); w = __builtin_amdgcn_cvt_pk_fp8_f32(c.z * sc, c.w * sc, w, true); o.z = (unsigned)w;
                    w = __builtin_amdgcn_cvt_pk_fp8_f32(d.x * sc, d.y * sc, 0, false); w = __builtin_amdgcn_cvt_pk_fp8_f32(d.z * sc, d.w * sc, w, true); o.w = (unsigned)w;
                    ((GAS v4u*)(tb ? V8 : U8))[i] = o;
                }
            }
            for (int i = gt; i < 65536; i += NGT) { const int n = i >> 8, kk = i & 255, p = n >> 7; SKBD[i] = ((kk >> 7) == p) ? (bf16)f2bf(subk[(size_t)(p * 128 + (n & 127)) * 128 + (kk & 127)]) : (bf16)0; }
            for (int m = gw; m < MTOK; m += NGW) rms_row_to_bf16((layer == 0 ? INP(0) : (const float*)X) + (size_t)m * DM, mix_g, H + (size_t)m * DM, lane);
            if (layer == 0) {
                for (size_t i = (size_t)gt; i < (size_t)4096 * 8192 / 8; i += (size_t)NGT) {
                    const int sp = (int)(i >> 10), k0 = (int)(i & 1023) * 8, part = k0 >> 12, s0 = k0 & 4095; float v[8];
#pragma unroll
                    for (int j = 0; j < 8; ++j) { const float ang = (float)(((s0 + j) * sp) & 4095) * (1.f / 4096.f); v[j] = (part ? -__builtin_amdgcn_sinf(ang) : __builtin_amdgcn_cosf(ang)) * (1.f / 64.f); }
                    v4u o; o.x = pk2(v[0], v[1]); o.y = pk2(v[2], v[3]); o.z = pk2(v[4], v[5]); o.w = pk2(v[6], v[7]); ((GAS v4u*)DFT)[i] = o;
                }
                for (int i = gt; i < 65536; i += NGT) { const int r = i >> 8, c = i & 255, part = r >> 7, cp = r & 127; float v = 0.f;
                    if (c < 128) { const float ang = (float)((c * cp) & 127) * (1.f / 128.f); v = (part ? __builtin_amdgcn_sinf(ang) : __builtin_amdgcn_cosf(ang)) * 0.08838834764831845f; }
                    CS[i] = (bf16)f2bf(v); }
                for (int i = gt; i < 16 * 8192; i += NGT) { const int hd = i >> 13, off = (i & 8191) - 4096; float v;
                    if (hd < 12) { const int g = hd >> 2, dil = g == 0 ? 1 : (g == 1 ? 4 : 16); v = (off >= -64 && off <= 64) ? rel_bias[rel_bucket(off * dil) * 16 + hd] * 11.313708498984761f : -1.0e5f; }
                    else v = rel_bias[rel_bucket(off) * 16 + hd] * 11.313708498984761f;
                    TAB[i] = v; }
            }
        }
#endif
        GRID_BAR();

#if PH_B
        {
            pg8::Gemm g{WSP(bf16, WS_H), WSP(bf16, WS_WIN)}; pg8::StaticOrder S; S.init(MTOK, INW, G, bx, DM, DM);
            pg8::EpiProj E{WSP(bf16, WS_PROJ), WSP(bf16, WS_G), INL(5, GTW)};
            pg8::gemm_phase<pg8::EpiProj, pg8::StaticOrder, true, DM, DM, DM>(ldsl, g, S, E, wave0);
        }
#endif
        GRID_BAR();

#if PH_C
        {
            pg8::Gemm g{WSP(bf16, WS_CS), WSP(bf16, WS_PROJ)}; pg8::F1Order S{G, bx};
            pg8::EpiZT E{WSP(bf16, WS_ZT)};
            pg8::gemm_phase<pg8::EpiZT, pg8::F1Order, false, 256, PJW, 256>(ldsl, g, S, E, wave0);
        }
#endif
        GRID_BAR();

#if PH_D
#if PH_D1
        {
            pg8::Gemm g{WSP(bf16, WS_DFT), WSP(bf16, WS_ZT)}; pg8::F2Order S; S.init(4096, 2048, G, bx, 8192, 8192);
            pg8::EpiStore E{WSP(bf16, WS_OC), DM};
            pg8::gemm_phase<pg8::EpiStore, pg8::F2Order, false, 8192, 8192, 8192>(ldsl, g, S, E, wave0);
        }
#endif
#if PH_D2
        {
            PH_IDS();
            gu32* qhead = ctl + CW_QUEUE + 64 * layer;
            bf16* PROJ = WSP(bf16, WS_PROJ); bf16* DO = WSP(bf16, WS_MG); bf16* DL = WSP(bf16, WS_H); float* LSE = WSP(float, WS_LSE); const float* TAB = WSP(float, WS_TAB);
            const float* cur_tab = nullptr;
            for (;;) {
                __syncthreads();
                if (tid == 0) MISC[0] = __hip_atomic_fetch_add(qhead, 1u, __ATOMIC_RELAXED, __HIP_MEMORY_SCOPE_AGENT);
                __syncthreads();
                const int ui = __builtin_amdgcn_readfirstlane((int)MISC[0]);
                if (ui >= 1792) break;
                attn::Unit u; int hd;
                if (ui < 1024) {
                    const int qb = ui & 15, vh = (ui >> 4) & 1, m = (ui >> 5) & 1, h = (ui >> 6) & 3, b = ui >> 8;
                    const bf16* base = PROJ + (size_t)b * SEQ * PJW;
                    u.Q = base + (size_t)(qb * 256) * PJW + COL_DIFF + (h * 2 + m) * 128; u.K = base + COL_DIFF + 1024 + (h * 2 + m) * 128; u.V = base + COL_DIFF + 2048 + h * 256 + vh * 128;
                    u.O = DO + (size_t)(b * SEQ + qb * 256) * DM + (h * 2 + m) * 256 + vh * 128; u.lse = nullptr; u.ldq = PJW; u.ldk = PJW; u.ldo = DM; u.lse_ld = 0;
                    u.kt0 = 0; u.nt = SEQ / 64; u.qoff = qb * 256; hd = 12 + h;
                } else {
                    const int v = ui - 1024, qb16 = v & 15, hh = (v >> 4) & 3, bg = v >> 6, g = bg % 3, b = bg / 3;
                    const int dil = g == 0 ? 1 : (g == 1 ? 4 : 16), bpc = 16 / dil, r = qb16 / bpc, qblk = qb16 % bpc, q0 = qblk * 256, ntot = (SEQ / dil) / 64;
                    int kt0 = q0 / 64 - 1; if (kt0 < 0) kt0 = 0; int kt1 = q0 / 64 + 5; if (kt1 > ntot) kt1 = ntot;
                    if ((kt1 - kt0) & 1) { if (kt0 > 0) --kt0; else ++kt1; }
                    const bf16* base = PROJ + (size_t)(b * SEQ + r) * PJW + COL_DIL + g * 512 + hh * 128;
                    u.Q = base + (size_t)q0 * dil * PJW; u.K = base + 1536; u.V = base + 3072;
                    u.O = DL + ((size_t)g * MTOK + b * SEQ + r + (size_t)q0 * dil) * 512 + hh * 128; u.lse = LSE + ((size_t)g * MTOK + b * SEQ + r + (size_t)q0 * dil) * 4 + hh;
                    u.ldq = (long)PJW * dil; u.ldk = (long)PJW * dil; u.ldo = 512L * dil; u.lse_ld = 4 * dil; u.kt0 = kt0; u.nt = kt1 - kt0; u.qoff = q0; hd = g * 4 + hh;
                }
                const float* tab = TAB + (size_t)hd * 8192;
                if (tab != cur_tab) {
                    cur_tab = tab;
                    LAS f32x4* tl = (LAS f32x4*)(ldsl + attn::LDS_TAB); const int t2 = opaque_tid(wave0);
#pragma unroll
                    for (int j = 0; j < 4; ++j) tl[t2 + 512 * j] = ((const GAS f32x4*)tab)[t2 + 512 * j];
                }
                attn::attn_unit(u, (char*)lds, wave0);
            }
        }
#endif
#endif
        GRID_BAR();

#if PH_E
        {
            PH_IDS();
            const float* dlam = INL(9, 512); const float* subln = INL(10, 256); const float lambda_init = layer == 0 ? 0.2f : 0.35550906759f;
            const float* LSE = WSP(float, WS_LSE); const bf16* DL = WSP(bf16, WS_H); const bf16* DO = WSP(bf16, WS_MG); bf16* OC = WSP(bf16, WS_OC);
            float s1 = dlam[lane] * dlam[128 + lane] + dlam[64 + lane] * dlam[192 + lane], s2 = dlam[256 + lane] * dlam[384 + lane] + dlam[320 + lane] * dlam[448 + lane];
            s1 = wave_sum(s1); s2 = wave_sum(s2);
            const float lam = __expf(s1) - __expf(s2) + lambda_init, osc = 1.0f - lambda_init;
            const int hq = lane >> 4, l16 = lane & 15;
            for (int t = gw; t < MTOK; t += NGW) {
                float ls[3], mx = -3e38f;
#pragma unroll
                for (int g = 0; g < 3; ++g) { ls[g] = LSE[((size_t)g * MTOK + t) * 4 + hq]; mx = fmaxf(mx, ls[g]); }
                float wsum = 0.f;
#pragma unroll
                for (int g = 0; g < 3; ++g) { ls[g] = __expf(ls[g] - mx); wsum += ls[g]; }
                const float winv = 1.0f / wsum; float acc8[8] = {0.f, 0.f, 0.f, 0.f, 0.f, 0.f, 0.f, 0.f};
#pragma unroll
                for (int g = 0; g < 3; ++g) { const v4u o = *(const GAS v4u*)(DL + ((size_t)g * MTOK + t) * 512 + lane * 8); const float w = ls[g] * winv;
                    acc8[0] += w * bflo(o.x); acc8[1] += w * bfhi(o.x); acc8[2] += w * bflo(o.y); acc8[3] += w * bfhi(o.y); acc8[4] += w * bflo(o.z); acc8[5] += w * bfhi(o.z); acc8[6] += w * bflo(o.w); acc8[7] += w * bfhi(o.w); }
#if defined(DBG_ZERO_OB)
                for (int j = 0; j < 8; ++j) acc8[j] = 0.f;
#endif
                { v4u o; o.x = pk2(acc8[0], acc8[1]); o.y = pk2(acc8[2], acc8[3]); o.z = pk2(acc8[4], acc8[5]); o.w = pk2(acc8[6], acc8[7]); *(GAS v4u*)(OC + (size_t)t * DM + 512 + lane * 8) = o; }
                const bf16* dp = DO + (size_t)t * DM + hq * 512 + l16 * 16;
                const v4u a0 = *(const GAS v4u*)(dp), a1 = *(const GAS v4u*)(dp + 8), b0 = *(const GAS v4u*)(dp + 256), b1 = *(const GAS v4u*)(dp + 264);
                float d[16];
                d[0] = bflo(a0.x) - lam * bflo(b0.x); d[1] = bfhi(a0.x) - lam * bfhi(b0.x); d[2] = bflo(a0.y) - lam * bflo(b0.y); d[3] = bfhi(a0.y) - lam * bfhi(b0.y);
                d[4] = bflo(a0.z) - lam * bflo(b0.z); d[5] = bfhi(a0.z) - lam * bfhi(b0.z); d[6] = bflo(a0.w) - lam * bflo(b0.w); d[7] = bfhi(a0.w) - lam * bfhi(b0.w);
                d[8] = bflo(a1.x) - lam * bflo(b1.x); d[9] = bfhi(a1.x) - lam * bfhi(b1.x); d[10] = bflo(a1.y) - lam * bflo(b1.y); d[11] = bfhi(a1.y) - lam * bfhi(b1.y);
                d[12] = bflo(a1.z) - lam * bflo(b1.z); d[13] = bfhi(a1.z) - lam * bfhi(b1.z); d[14] = bflo(a1.w) - lam * bflo(b1.w); d[15] = bfhi(a1.w) - lam * bfhi(b1.w);
                float ss = 0.f;
#pragma unroll
                for (int j = 0; j < 16; ++j) ss += d[j] * d[j];
                ss += sx_f<1>(ss); ss += sx_f<2>(ss); ss += sx_f<4>(ss); ss += sx_f<8>(ss);
                const float rs = osc / sqrtf(ss * (1.f / 256.f) + RMS_EPS);
                const f32x4 g0 = *(const GAS f32x4*)(subln + l16 * 16), g1 = *(const GAS f32x4*)(subln + l16 * 16 + 4), g2 = *(const GAS f32x4*)(subln + l16 * 16 + 8), g3 = *(const GAS f32x4*)(subln + l16 * 16 + 12);
                v4u o0, o1;
                o0.x = pk2(d[0] * rs * g0.x, d[1] * rs * g0.y); o0.y = pk2(d[2] * rs * g0.z, d[3] * rs * g0.w); o0.z = pk2(d[4] * rs * g1.x, d[5] * rs * g1.y); o0.w = pk2(d[6] * rs * g1.z, d[7] * rs * g1.w);
                o1.x = pk2(d[8] * rs * g2.x, d[9] * rs * g2.y); o1.y = pk2(d[10] * rs * g2.z, d[11] * rs * g2.w); o1.z = pk2(d[12] * rs * g3.x, d[13] * rs * g3.y); o1.w = pk2(d[14] * rs * g3.z, d[15] * rs * g3.w);
                bf16* op = OC + (size_t)t * DM + 1024 + hq * 256 + l16 * 16;
                *(GAS v4u*)(op) = o0; *(GAS v4u*)(op + 8) = o1;
            }
        }
#endif
        GRID_BAR();

#if PH_F
        {
            pg8::StaticOrder S; S.init(MTOK, DM, G, bx, DM, DM);
            { pg8::Gemm g{WSP(bf16, WS_OC), WSP(bf16, WS_WCAT)}; pg8::EpiMerge3 E{WSP(bf16, WS_G), WSP(bf16, WS_MG), 0}; pg8::gemm_phase<pg8::EpiMerge3, pg8::StaticOrder, true, DM, DM, 512>(ldsl, g, S, E, wave0); }
            { pg8::Gemm g{WSP(bf16, WS_OC) + 512, WSP(bf16, WS_WCAT) + 512}; pg8::EpiMerge3 E{WSP(bf16, WS_G), WSP(bf16, WS_MG), 1}; pg8::gemm_phase<pg8::EpiMerge3, pg8::StaticOrder, true, DM, DM, 512>(ldsl, g, S, E, wave0); }
            { pg8::Gemm g{WSP(bf16, WS_OC) + 1024, WSP(bf16, WS_WCAT) + 1024}; pg8::EpiMerge3 E{WSP(bf16, WS_G), WSP(bf16, WS_MG), 2}; pg8::gemm_phase<pg8::EpiMerge3, pg8::StaticOrder, true, DM, DM, 1024>(ldsl, g, S, E, wave0); }
        }
#endif
        GRID_BAR();

#if PH_G
        {
            pg8::Gemm g{WSP(bf16, WS_MG), WSP(bf16, WS_WO)}; pg8::StaticOrder S; S.init(MTOK, DM, G, bx, DM, DM);
            pg8::EpiResF32 E{layer == 0 ? INP(0) : (const float*)X, X, DM};
            pg8::gemm_phase<pg8::EpiResF32, pg8::StaticOrder, true, DM, DM, DM>(ldsl, g, S, E, wave0);
        }
#endif
        GRID_BAR();

#if PH_H
        { PH_IDS(); const float* ffn_g = INL(12, DM); bf16* H = WSP(bf16, WS_H);
          for (int m = gw; m < MTOK; m += NGW) rms_row_to_bf16(X + (size_t)m * DM, ffn_g, H + (size_t)m * DM, lane); }
#endif
        GRID_BAR();

#if PH_I
        {
            pg8::Gemm g{WSP(bf16, WS_H), WSP(bf16, WS_WQ)}; pg8::StaticOrder S; S.init(MTOK, DM, G, bx, DM, DM);
            pg8::EpiStore E{WSP(bf16, WS_Q), DM};
            pg8::gemm_phase<pg8::EpiStore, pg8::StaticOrder, true, DM, DM, DM>(ldsl, g, S, E, wave0);
        }
#endif
        GRID_BAR();

#if PH_J
        {
            pg8::Gemm g{WSP(bf16, WS_Q), WSP(bf16, WS_SKBD)}; pg8::StaticOrder S; S.init(MTOK * 8, 256, G, bx, 256, 256);
            pg8::EpiResF32 E{nullptr, WSP(float, WS_SC), 256};
            pg8::gemm_phase<pg8::EpiResF32, pg8::StaticOrder, true, 256, 256, 256>(ldsl, g, S, E, wave0);
        }
#endif
        GRID_BAR();

#if PH_K
        {
            PH_IDS();
            const float* SC = WSP(float, WS_SC); int* IDS = WSP(int, WS_IDS); float* GATES = WSP(float, WS_GATES);
            const int l16 = lane & 15, rbase = lane & 48;
            int cq[4];
#pragma unroll
            for (int q = 0; q < 4; ++q) { int c = l16 + 16 * q, ci = -1, cj = 0; for (int i = 0; i < 16; ++i) { const int cnt = 16 / (i + 1); if (ci < 0) { if (c < cnt) { ci = i; cj = c; } else c -= cnt; } } cq[q] = ci < 0 ? -1 : ci * 16 + cj; }
            for (int row4 = gw * 4; row4 < MTOK * 8; row4 += NGW * 4) {
                const int row = row4 + (lane >> 4);
                const float* sc = SC + (size_t)row * 256 + l16;
                unsigned ka[8], kb[8];
#pragma unroll
                for (int jj = 0; jj < 8; ++jj) { ka[jj] = (okey(sc[jj * 16]) & ~127u) | (unsigned)(127 - (jj * 16 + l16)); kb[jj] = (okey(sc[128 + jj * 16]) & ~127u) | (unsigned)(127 - (jj * 16 + l16)); }
#define SORT8(k) do { CE_DESC(k[0], k[1]); CE_DESC(k[2], k[3]); CE_DESC(k[4], k[5]); CE_DESC(k[6], k[7]); CE_DESC(k[0], k[2]); CE_DESC(k[1], k[3]); CE_DESC(k[4], k[6]); CE_DESC(k[5], k[7]); \
    CE_DESC(k[1], k[2]); CE_DESC(k[5], k[6]); CE_DESC(k[0], k[4]); CE_DESC(k[3], k[7]); CE_DESC(k[1], k[5]); CE_DESC(k[2], k[6]); CE_DESC(k[1], k[4]); CE_DESC(k[3], k[6]); \
    CE_DESC(k[2], k[4]); CE_DESC(k[3], k[5]); CE_DESC(k[3], k[4]); } while (0)
                SORT8(ka); SORT8(kb);
                unsigned ta = 0u, tb = 0u;
#pragma unroll
                for (int r = 0; r < 16; ++r) {
                    const unsigned ma = row_max16_u(ka[0]), mb = row_max16_u(kb[0]);
                    const bool wa = ka[0] == ma, wb = kb[0] == mb;
                    ta = (l16 == r) ? ma : ta; tb = (l16 == r) ? mb : tb;
#pragma unroll
                    for (int q = 0; q < 7; ++q) { ka[q] = wa ? ka[q + 1] : ka[q]; kb[q] = wb ? kb[q + 1] : kb[q]; }
                    ka[7] = wa ? 0u : ka[7]; kb[7] = wb ? 0u : kb[7];
                }
                const int ia = 127 - (int)(ta & 127u), ib = 127 - (int)(tb & 127u);
                const float va = okey_inv(ta & ~127u), vb = okey_inv(tb & ~127u);
                unsigned ck[4];
#pragma unroll
                for (int q = 0; q < 4; ++q) { const int cc = cq[q] < 0 ? 0 : cq[q]; const float cs = bperm_f(va, rbase + (cc >> 4)) + bperm_f(vb, rbase + (cc & 15));
                    ck[q] = cq[q] < 0 ? 0u : ((okey(cs) & ~255u) | (unsigned)(255 - cc)); }
                CE_DESC(ck[0], ck[1]); CE_DESC(ck[2], ck[3]); CE_DESC(ck[0], ck[2]); CE_DESC(ck[1], ck[3]); CE_DESC(ck[1], ck[2]);
                unsigned tw = 0u;
#pragma unroll
                for (int r = 0; r < 16; ++r) { const unsigned mm = row_max16_u(ck[0]); const bool w = ck[0] == mm; tw = (l16 == r) ? mm : tw;
                    ck[0] = w ? ck[1] : ck[0]; ck[1] = w ? ck[2] : ck[1]; ck[2] = w ? ck[3] : ck[2]; ck[3] = w ? 0u : ck[3]; }
                const int code = 255 - (int)(tw & 255u), wi = (code >> 4) & 15, wj = code & 15;
                const float bs = bperm_f(va, rbase + wi) + bperm_f(vb, rbase + wj);
                const int eid = bperm_i(ia, rbase + wi) * 128 + bperm_i(ib, rbase + wj);
                const float mx = row_max16_f(bs), e = __expf(bs - mx), es = row_sum16(e);
                IDS[(size_t)row * 16 + l16] = eid; GATES[(size_t)row * 16 + l16] = e / es;
            }
#undef SORT8
        }
#endif
        GRID_BAR();

#if PH_L
#define L_LDIDS(I, tt, hh) do { const GAS v4u* ip_ = (const GAS v4u*)(IDS + (size_t)(tt) * 128 + (hh) * 64 + lrow * 16); I##0 = ip_[0]; I##1 = ip_[1]; I##2 = ip_[2]; I##3 = ip_[3]; } while (0)
#define L_ISSUE(W, I, base) do { \
    W[0] = *(const GAS v4u*)((base) + (size_t)(I##0).x * DM); W[1] = *(const GAS v4u*)((base) + (size_t)(I##0).y * DM); W[2] = *(const GAS v4u*)((base) + (size_t)(I##0).z * DM); W[3] = *(const GAS v4u*)((base) + (size_t)(I##0).w * DM); \
    W[4] = *(const GAS v4u*)((base) + (size_t)(I##1).x * DM); W[5] = *(const GAS v4u*)((base) + (size_t)(I##1).y * DM); W[6] = *(const GAS v4u*)((base) + (size_t)(I##1).z * DM); W[7] = *(const GAS v4u*)((base) + (size_t)(I##1).w * DM); \
    W[8] = *(const GAS v4u*)((base) + (size_t)(I##2).x * DM); W[9] = *(const GAS v4u*)((base) + (size_t)(I##2).y * DM); W[10] = *(const GAS v4u*)((base) + (size_t)(I##2).z * DM); W[11] = *(const GAS v4u*)((base) + (size_t)(I##2).w * DM); \
    W[12] = *(const GAS v4u*)((base) + (size_t)(I##3).x * DM); W[13] = *(const GAS v4u*)((base) + (size_t)(I##3).y * DM); W[14] = *(const GAS v4u*)((base) + (size_t)(I##3).z * DM); W[15] = *(const GAS v4u*)((base) + (size_t)(I##3).w * DM); } while (0)
#define L_CVT(d, hi) __builtin_amdgcn_cvt_pk_f32_fp8((int)(d), (hi))
        {
            PH_IDS();
            const bf16* H = WSP(bf16, WS_H); const unsigned char* U8 = WSP(unsigned char, WS_U); const int* IDS = WSP(int, WS_IDS); float* PART = WSP(float, WS_G);
            typedef float f32x2 __attribute__((ext_vector_type(2)));
            const int myx = (int)(xb_xcc_id() & 7u); int nx = 0, xi = 0, nloc = 1;
            for (int j = 0; j < 8; ++j) { const int c = (int)__hip_atomic_load(ctl + CW_XRANK + 64 * j, __ATOMIC_RELAXED, __HIP_MEMORY_SCOPE_AGENT); if (c > 0) { ++nx; if (j < myx) ++xi; } if (j == myx) nloc = c; }
            const int rw = (int)MISC[1] * NWAVES + wave, nW = nloc * NWAVES; const int l16 = lane & 15, lrow = lane >> 4;
#define L1_COMPUTE(W, dst) do { float prer_ = 0.f; _Pragma("unroll") for (int k = 0; k < 16; ++k) { const v4u ww = W[k]; const unsigned d0 = ww.x, d1 = ww.y, d2 = ww.z, d3 = ww.w; f32x2 s2; \
        s2 = L_CVT(d0, false) * hf[0]; s2 += L_CVT(d0, true) * hf[1]; s2 += L_CVT(d1, false) * hf[2]; s2 += L_CVT(d1, true) * hf[3]; \
        s2 += L_CVT(d2, false) * hf[4]; s2 += L_CVT(d2, true) * hf[5]; s2 += L_CVT(d3, false) * hf[6]; s2 += L_CVT(d3, true) * hf[7]; \
        const float rs = row_sum16(s2.x + s2.y); prer_ = (l16 == k) ? rs : prer_; } dst = prer_; } while (0)
            for (int sl = xi; sl < 8; sl += nx) {
                const unsigned char* ub = U8 + sl * 256 + l16 * 16; const bf16* hb = H + sl * 256 + l16 * 16;
                int t = rw;
                if (t < MTOK) {
                    v4u Wa[16], Wb[16]; v4u ia0, ia1, ia2, ia3, ib0, ib1, ib2, ib3; v4u h0, h1;
                    L_LDIDS(ia, t, 0); L_LDIDS(ib, t, 1); { const GAS v4u* hp = (const GAS v4u*)(hb + (size_t)t * DM); h0 = hp[0]; h1 = hp[1]; }
                    L_ISSUE(Wa, ia, ub);
                    for (;;) {
                        const int tn = t + nW; const bool more = tn < MTOK; const int tp = more ? tn : t;
                        L_ISSUE(Wb, ib, ub);
                        L_LDIDS(ia, tp, 0); v4u hn0, hn1; { const GAS v4u* hp = (const GAS v4u*)(hb + (size_t)tp * DM); hn0 = hp[0]; hn1 = hp[1]; }
                        f32x2 hf[8];
                        hf[0] = (f32x2){bflo(h0.x), bfhi(h0.x)}; hf[1] = (f32x2){bflo(h0.y), bfhi(h0.y)}; hf[2] = (f32x2){bflo(h0.z), bfhi(h0.z)}; hf[3] = (f32x2){bflo(h0.w), bfhi(h0.w)};
                        hf[4] = (f32x2){bflo(h1.x), bfhi(h1.x)}; hf[5] = (f32x2){bflo(h1.y), bfhi(h1.y)}; hf[6] = (f32x2){bflo(h1.z), bfhi(h1.z)}; hf[7] = (f32x2){bflo(h1.w), bfhi(h1.w)};
                        float pre0, pre1;
                        L1_COMPUTE(Wa, pre0);
                        L_ISSUE(Wa, ia, ub);
                        L_LDIDS(ib, tp, 1);
                        L1_COMPUTE(Wb, pre1);
                        float* pp = PART + ((size_t)sl * MTOK + t) * 128; pp[lane] = pre0; pp[64 + lane] = pre1;
                        h0 = hn0; h1 = hn1;
                        if (!more) break;
                        t = tn;
                    }
                }
            }
#undef L1_COMPUTE
        }
        GRID_BAR();
        {
            PH_IDS();
            const float* PART = WSP(float, WS_G); const float* GATES = WSP(float, WS_GATES); float* ACTW = WSP(float, WS_ACT);
            for (int t = gw; t < MTOK; t += NGW) {
                float q0 = 0.f, q1 = 0.f;
#pragma unroll
                for (int s8 = 0; s8 < 8; ++s8) { const float* pp = PART + ((size_t)s8 * MTOK + t) * 128; q0 += pp[lane]; q1 += pp[64 + lane]; }
                q0 *= (1.f / 1024.f); q1 *= (1.f / 1024.f);
                const float* gp = GATES + (size_t)t * 128; float* ap = ACTW + (size_t)t * 128;
                const float g0 = gp[lane], g1 = gp[64 + lane];
                ap[lane] = 0.5f * q0 * (1.0f + erff(q0 * 0.70710678118654752f)) * g0 * (1.f / 64.f); ap[64 + lane] = 0.5f * q1 * (1.0f + erff(q1 * 0.70710678118654752f)) * g1 * (1.f / 64.f);
            }
        }
        GRID_BAR();
        {
            PH_IDS();
            const unsigned char* V8 = WSP(unsigned char, WS_V); const int* IDS = WSP(int, WS_IDS); const float* ACT = WSP(float, WS_ACT);
            typedef float f32x2 __attribute__((ext_vector_type(2)));
            const int myx = (int)(xb_xcc_id() & 7u); int nx = 0, xi = 0, nloc = 1;
            for (int j = 0; j < 8; ++j) { const int c = (int)__hip_atomic_load(ctl + CW_XRANK + 64 * j, __ATOMIC_RELAXED, __HIP_MEMORY_SCOPE_AGENT); if (c > 0) { ++nx; if (j < myx) ++xi; } if (j == myx) nloc = c; }
            const int rw = (int)MISC[1] * NWAVES + wave, nW = nloc * NWAVES; const int l16 = lane & 15, lrow = lane >> 4;
#if DBG_MODE == 2
            float* XO = WSP(float, WS_OC);
#else
            float* XO = X;
#endif
#define L2_COMPUTE(W, acr) do { _Pragma("unroll") for (int k = 0; k < 16; ++k) { const float a = bperm_f(acr, (lane & 48) + k); const f32x2 aa = (f32x2){a, a}; \
        const v4u ww = W[k]; const unsigned d0 = ww.x, d1 = ww.y, d2 = ww.z, d3 = ww.w; \
        oacc[0] += aa * L_CVT(d0, false); oacc[1] += aa * L_CVT(d0, true); oacc[2] += aa * L_CVT(d1, false); oacc[3] += aa * L_CVT(d1, true); \
        oacc[4] += aa * L_CVT(d2, false); oacc[5] += aa * L_CVT(d2, true); oacc[6] += aa * L_CVT(d3, false); oacc[7] += aa * L_CVT(d3, true); } } while (0)
            for (int sl = xi; sl < 8; sl += nx) {
                const unsigned char* vb = V8 + sl * 256 + l16 * 16; float* xb = XO + sl * 256 + l16 * 16;
                int t = rw;
                if (t < MTOK) {
                    v4u Wa[16], Wb[16]; v4u ia0, ia1, ia2, ia3, ib0, ib1, ib2, ib3; float ac0, ac1;
                    L_LDIDS(ia, t, 0); L_LDIDS(ib, t, 1); ac0 = ACT[(size_t)t * 128 + lane]; ac1 = ACT[(size_t)t * 128 + 64 + lane];
                    L_ISSUE(Wa, ia, vb);
                    for (;;) {
                        const int tn = t + nW; const bool more = tn < MTOK; const int tp = more ? tn : t;
                        L_ISSUE(Wb, ib, vb);
                        L_LDIDS(ia, tp, 0); const float an0 = ACT[(size_t)tp * 128 + lane], an1 = ACT[(size_t)tp * 128 + 64 + lane];
                        f32x2 oacc[8];
#pragma unroll
                        for (int k = 0; k < 8; ++k) oacc[k] = (f32x2){0.f, 0.f};
                        L2_COMPUTE(Wa, ac0);
                        L_ISSUE(Wa, ia, vb);
                        L_LDIDS(ib, tp, 1);
                        f32x4 xv[4]; { const GAS f32x4* q = (const GAS f32x4*)(xb + (size_t)t * DM); xv[0] = q[0]; xv[1] = q[1]; xv[2] = q[2]; xv[3] = q[3]; }
                        L2_COMPUTE(Wb, ac1);
#pragma unroll
                        for (int k = 0; k < 8; ++k) { float a = oacc[k].x, b = oacc[k].y; a += sx_f<16>(a); b += sx_f<16>(b); a = add32(a); b = add32(b); oacc[k] = (f32x2){a, b}; }
                        if (lane < 16) { GAS f32x4* q = (GAS f32x4*)(xb + (size_t)t * DM);
#pragma unroll
                            for (int k = 0; k < 4; ++k) { f32x4 v = xv[k];
#if DBG_MODE == 2
                                v = (f32x4){0.f, 0.f, 0.f, 0.f};
#endif
                                v.x += oacc[2 * k].x; v.y += oacc[2 * k].y; v.z += oacc[2 * k + 1].x; v.w += oacc[2 * k + 1].y; q[k] = v; } }
                        ac0 = an0; ac1 = an1;
                        if (!more) break;
                        t = tn;
                    }
                }
            }
#undef L2_COMPUTE
        }
#undef L_LDIDS
#undef L_ISSUE
#undef L_CVT
#endif
        GRID_BAR();
    }

    { PH_IDS();
    for (int m = gw; m < MTOK; m += NGW) {
        GAS f32x4* xr = (GAS f32x4*)(X + (size_t)m * DM) + lane; const GAS f32x4* gr = (const GAS f32x4*)INP(2) + lane;
        f32x4 v[8]; float s = 0.f;
#pragma unroll
        for (int j = 0; j < 8; ++j) { v[j] = xr[64 * j]; s += (v[j].x * v[j].x + v[j].y * v[j].y) + (v[j].z * v[j].z + v[j].w * v[j].w); }
        const float rstd = 1.0f / sqrtf(wave_sum(s) * (1.f / DM) + RMS_EPS);
#pragma unroll
        for (int j = 0; j < 8; ++j) { const f32x4 gg = gr[64 * j]; xr[64 * j] = v[j] * rstd * gg; }
    } }
}

extern "C" void kernel_launch(void* const* d_in, const int* in_sizes, int n_in, void* d_out, int out_size, void* d_ws, size_t ws_size, hipStream_t stream) {
    static int grid = 0;
    if (grid == 0) {
        if (n_in != 17 || in_sizes[0] != MTOK * DM || out_size != MTOK * DM || ws_size < WS_END) {
            fprintf(stderr, "kernel_launch: shape/workspace mismatch: n_in %d in0 %d out %d ws %zu (need %zu); nothing launched\n", n_in, n_in > 0 ? in_sizes[0] : -1, out_size, ws_size, (size_t)WS_END); grid = -1; return; }
        int dev = 0, cus = 0, per_cu = 0;
        if (hipGetDevice(&dev) != hipSuccess || hipDeviceGetAttribute(&cus, hipDeviceAttributeMultiprocessorCount, dev) != hipSuccess) { grid = -1; return; }
        if (hipFuncSetAttribute((const void*)mk_fwd, hipFuncAttributeMaxDynamicSharedMemorySize, LDS_BYTES) != hipSuccess) { fprintf(stderr, "kernel_launch: hipFuncSetAttribute failed\n"); grid = -1; return; }
        if (hipOccupancyMaxActiveBlocksPerMultiprocessor(&per_cu, (const void*)mk_fwd, NWAVES * 64, LDS_BYTES) != hipSuccess || per_cu < 1)
            fprintf(stderr, "kernel_launch: note: occupancy query reports %d workgroups per CU\n", per_cu);
        (void)hipGetLastError();
        grid = cus;
    }
    if (grid < 0) return;
    if (hipMemsetAsync((char*)d_ws + WS_CTL, 0, CTL_ZERO_BYTES, stream) != hipSuccess) { fprintf(stderr, "kernel_launch: memset failed\n"); return; }
    Args a{};
    for (int i = 0; i < 17; ++i) a.in[i] = (const float*)d_in[i];
    a.out = (float*)d_out; a.ws = (unsigned char*)d_ws;
    hipLaunchKernelGGL(mk_fwd, dim3(grid), dim3(NWAVES * 64), LDS_BYTES, stream, a);
    const hipError_t le = hipPeekAtLastError();
    if (le != hipSuccess) fprintf(stderr, "kernel_launch: launch failed: %s\n", hipGetErrorName(le));
}
```

```cpp
#include <hip/hip_runtime.h>
#include <cstdio>
#include <cstdint>

#ifndef DBG_MODE
#define DBG_MODE 0
#endif
constexpr int DM = 2048, NB = 4, SEQ = 4096, MTOK = NB * SEQ;
constexpr int INW = 14336, PJW = 8192, GTW = 6144;
constexpr int COL_DIL = 512, COL_DIFF = 5120;
constexpr int NEXP = 16384;
constexpr float RMS_EPS = 1e-6f;

typedef unsigned short bf16;
#define GAS __attribute__((address_space(1)))
#define LAS __attribute__((address_space(3)))
typedef unsigned v4u __attribute__((ext_vector_type(4)));
typedef float f32x4 __attribute__((ext_vector_type(4)));
typedef GAS unsigned gu32;

__device__ __forceinline__ int opaque_tid(int wave_sgpr) { int l; asm volatile("v_mbcnt_lo_u32_b32 %0, -1, 0\n\tv_mbcnt_hi_u32_b32 %0, -1, %0" : "=v"(l)); return wave_sgpr * 64 + l; }
namespace pg8 {
#define PG8_LAS __attribute__((address_space(3)))
typedef unsigned short bf16_t;
typedef short bf16x8 __attribute__((ext_vector_type(8)));
typedef float f32x4 __attribute__((ext_vector_type(4)));
typedef unsigned u32x4 __attribute__((ext_vector_type(4)));
constexpr int BM = 256, BK = 64, HALF = 128, HTB = HALF * BK * 2, STAGE_BYTES = 8 * HTB, NXCD = 8, WGM = 8;

__host__ __device__ __forceinline__ int lds_byte(int r, int c) { const int st = (r >> 4) * 2 + (c >> 5), rr = r & 15, cc = c & 31, ob = rr * 64 + cc * 2; return st * 1024 + (ob ^ (((ob >> 9) & 1) << 5)); }
__host__ __device__ __forceinline__ void stage_rc(int b, int& R, int& C) { const int st = b / 1024, sb = b % 1024, swz = sb ^ (((sb >> 9) & 1) << 5); R = (st >> 1) * 16 + swz / 64; C = (st & 1) * 32 + (swz % 64) / 2; }
__host__ __device__ __forceinline__ int perm32(int rho) { const int n = rho >> 4, i = rho & 15; return 8 * (i >> 2) + 4 * n + (i & 3); }

struct Unit { int pm, pn; long aoff, boff; int orow, ocol, sub; };
struct Gemm { const bf16_t* A; const bf16_t* Bt; };

struct StaticOrder {
    int nM, nN, nwg, G, c; long sa, sb;
    __device__ void init(int M, int N, int G_, int c_, int lda, int ldb) { nM = M / BM; nN = N / BM; nwg = nM * nN; G = G_; c = c_; sa = 512L * lda; sb = 512L * ldb; }
    __device__ bool next(int i, Unit& u) const {
        const long L = (long)i * G + c; if (L >= nwg) return false;
        int wgid = (int)L; { const int q = nwg / NXCD, r = nwg % NXCD, xcd = wgid % NXCD, off = wgid / NXCD; wgid = (xcd < r ? xcd * (q + 1) : r * (q + 1) + (xcd - r) * q) + off; }
        const int nig = WGM * nN, gid = wgid / nig, fm = gid * WGM, gsz = (nM - fm) < WGM ? (nM - fm) : WGM;
        u.pm = fm + ((wgid % nig) % gsz); u.pn = (wgid % nig) / gsz;
        u.aoff = u.pm * sa; u.boff = u.pn * sb; u.orow = u.pm * BM; u.ocol = u.pn * BM; u.sub = 0; return true;
    }
};
struct MergeOrder : StaticOrder {
    __device__ bool next(int i, Unit& u) const { if (!StaticOrder::next(i >> 2, u)) return false; u.sub = i & 3; u.aoff += 1024L * u.sub; u.boff += 1024L * u.sub; return true; }
};
struct F2Order : StaticOrder {
    __device__ bool next(int i, Unit& u) const { if (!StaticOrder::next(i, u)) return false; u.orow = (u.pn >> 1) * 4096 + u.pm * BM; u.ocol = (u.pn & 1) * BM; return true; }
};
struct F1Order {
    int G, c;
    __device__ bool next(int i, Unit& u) const {
        const int idx = i * G + c; if (idx >= 256) return false;
        const int bg = idx >> 4, st = idx & 15, b = bg >> 2, g = bg & 3;
        u.pm = 0; u.pn = idx; u.aoff = 0; u.boff = ((long)(b * 4096 + st * 256) * PJW + g * 128) * 2; u.orow = bg * 128; u.ocol = st * 256; return true;
    }
};

__device__ __forceinline__ unsigned cvt_pk_bf16(float lo, float hi) { unsigned r; asm volatile("v_cvt_pk_bf16_f32 %0, %1, %2" : "=v"(r) : "v"(lo), "v"(hi)); return r; }
__device__ __forceinline__ float bf_lo(unsigned w) { return __uint_as_float(w << 16); }
__device__ __forceinline__ float bf_hi(unsigned w) { return __uint_as_float(w & 0xffff0000u); }

#define PG8_PACK(v0, v1, w) do { (w).x = cvt_pk_bf16((v0)[0], (v0)[1]); (w).y = cvt_pk_bf16((v0)[2], (v0)[3]); (w).z = cvt_pk_bf16((v1)[0], (v1)[1]); (w).w = cvt_pk_bf16((v1)[2], (v1)[3]); } while (0)

struct EpiStore {
    static constexpr bool PERM = true;
    bf16_t* O; int ldo;
    __device__ __forceinline__ bool operator()(f32x4 (&acc)[2][2][4][2], const Unit& u, int wr, int wc, int fr, int fq) const {
        const int row0 = u.orow + wr * 64 + fr, col0 = u.ocol + wc * 32 + 8 * fq;
#pragma unroll
        for (int ai = 0; ai < 2; ++ai)
#pragma unroll
            for (int m = 0; m < 4; ++m) { bf16_t* rowp = O + (size_t)(row0 + ai * HALF + m * 16) * ldo + col0;
#pragma unroll
                for (int bj = 0; bj < 2; ++bj) { u32x4 w; PG8_PACK(acc[ai][bj][m][0], acc[ai][bj][m][1], w); *(u32x4*)(rowp + bj * HALF) = w; } }
        return true;
    }
};
struct EpiZT {
    static constexpr bool PERM = true;
    bf16_t* O;
    __device__ __forceinline__ bool operator()(f32x4 (&acc)[2][2][4][2], const Unit& u, int wr, int wc, int fr, int fq) const {
        const int row0 = u.orow + wr * 64 + fr, col0 = u.ocol + wc * 32 + 8 * fq;
#pragma unroll
        for (int ai = 0; ai < 2; ++ai)
#pragma unroll
            for (int m = 0; m < 4; ++m) { bf16_t* rowp = O + (size_t)(row0 + m * 16) * 8192 + ai * 4096 + col0;
#pragma unroll
                for (int bj = 0; bj < 2; ++bj) { u32x4 w; PG8_PACK(acc[ai][bj][m][0], acc[ai][bj][m][1], w); *(u32x4*)(rowp + bj * HALF) = w; } }
        return true;
    }
};
struct EpiProj {
    static constexpr bool PERM = true;
    bf16_t* P; bf16_t* Gt; const float* bg;
    __device__ __forceinline__ bool operator()(f32x4 (&acc)[2][2][4][2], const Unit& u, int wr, int wc, int fr, int fq) const {
        const bool isg = u.pn >= 32;
        const int row0 = u.pm * BM + wr * 64 + fr, col0 = (isg ? u.pn - 32 : u.pn) * BM + wc * 32 + 8 * fq, ldc = isg ? GTW : PJW;
        bf16_t* base = isg ? Gt : P;
        f32x4 bv[2][2];
#pragma unroll
        for (int bj = 0; bj < 2; ++bj)
#pragma unroll
            for (int n = 0; n < 2; ++n) bv[bj][n] = isg ? *(const f32x4*)(bg + col0 + bj * HALF + 4 * n) : (f32x4){0.f, 0.f, 0.f, 0.f};
#pragma unroll
        for (int ai = 0; ai < 2; ++ai)
#pragma unroll
            for (int m = 0; m < 4; ++m) { bf16_t* rowp = base + (size_t)(row0 + ai * HALF + m * 16) * ldc + col0;
#pragma unroll
                for (int bj = 0; bj < 2; ++bj) { f32x4 v0 = acc[ai][bj][m][0] + bv[bj][0], v1 = acc[ai][bj][m][1] + bv[bj][1];
                    if (isg) {
#pragma unroll
                        for (int j = 0; j < 4; ++j) { v0[j] = __builtin_amdgcn_rcpf(1.0f + __builtin_amdgcn_exp2f(-1.4426950408889634f * v0[j])); v1[j] = __builtin_amdgcn_rcpf(1.0f + __builtin_amdgcn_exp2f(-1.4426950408889634f * v1[j])); } }
                    u32x4 w; PG8_PACK(v0, v1, w); *(u32x4*)(rowp + bj * HALF) = w; } }
        return true;
    }
};
struct EpiMerge4 {
    static constexpr bool PERM = true;
    const bf16_t* Gt; bf16_t* O;
    __device__ __forceinline__ bool operator()(f32x4 (&acc)[2][2][4][2], const Unit& u, int wr, int wc, int fr, int fq) const {
        const int row0 = u.pm * BM + wr * 64 + fr, col0 = u.pn * BM + wc * 32 + 8 * fq;
        if (u.sub == 2) return false;
        if (u.sub < 2) {
#pragma unroll
            for (int ai = 0; ai < 2; ++ai)
#pragma unroll
                for (int m = 0; m < 4; ++m) { const bf16_t* gp = Gt + (size_t)(row0 + ai * HALF + m * 16) * GTW + u.sub * DM + col0;
#pragma unroll
                    for (int bj = 0; bj < 2; ++bj) { const u32x4 gn = *(const u32x4*)(gp + bj * HALF), gd = *(const u32x4*)(gp + DM + bj * HALF);
                        f32x4 r0, r1;
                        r0[0] = bf_lo(gn.x) * __builtin_amdgcn_rcpf(bf_lo(gd.x)); r0[1] = bf_hi(gn.x) * __builtin_amdgcn_rcpf(bf_hi(gd.x));
                        r0[2] = bf_lo(gn.y) * __builtin_amdgcn_rcpf(bf_lo(gd.y)); r0[3] = bf_hi(gn.y) * __builtin_amdgcn_rcpf(bf_hi(gd.y));
                        r1[0] = bf_lo(gn.z) * __builtin_amdgcn_rcpf(bf_lo(gd.z)); r1[1] = bf_hi(gn.z) * __builtin_amdgcn_rcpf(bf_hi(gd.z));
                        r1[2] = bf_lo(gn.w) * __builtin_amdgcn_rcpf(bf_lo(gd.w)); r1[3] = bf_hi(gn.w) * __builtin_amdgcn_rcpf(bf_hi(gd.w));
                        acc[ai][bj][m][0] *= r0; acc[ai][bj][m][1] *= r1; }
                    asm volatile("" ::: "memory"); }
            return false;
        }
#pragma unroll
        for (int ai = 0; ai < 2; ++ai)
#pragma unroll
            for (int m = 0; m < 4; ++m) { const bf16_t* gp = Gt + (size_t)(row0 + ai * HALF + m * 16) * GTW + 2 * DM + col0; bf16_t* rowp = O + (size_t)(row0 + ai * HALF + m * 16) * DM + col0;
#pragma unroll
                for (int bj = 0; bj < 2; ++bj) { const u32x4 g = *(const u32x4*)(gp + bj * HALF);
                    f32x4 v0 = acc[ai][bj][m][0], v1 = acc[ai][bj][m][1];
                    v0[0] *= bf_lo(g.x); v0[1] *= bf_hi(g.x); v0[2] *= bf_lo(g.y); v0[3] *= bf_hi(g.y);
                    v1[0] *= bf_lo(g.z); v1[1] *= bf_hi(g.z); v1[2] *= bf_lo(g.w); v1[3] *= bf_hi(g.w);
                    u32x4 w; PG8_PACK(v0, v1, w); *(u32x4*)(rowp + bj * HALF) = w; }
                asm volatile("" ::: "memory"); }
        return true;
    }
};
struct EpiResF32 {
    static constexpr bool PERM = false;
    const float* base; float* out; int ldc;
    __device__ __forceinline__ bool operator()(f32x4 (&acc)[2][2][4][2], const Unit& u, int wr, int wc, int fr, int fq) const {
        const int row0 = u.orow + wr * 64 + fr, col0 = u.ocol + wc * 32 + 4 * fq;
#pragma unroll
        for (int ai = 0; ai < 2; ++ai)
#pragma unroll
            for (int m = 0; m < 4; ++m) { const size_t off = (size_t)(row0 + ai * HALF + m * 16) * ldc + col0;
#pragma unroll
                for (int bj = 0; bj < 2; ++bj)
#pragma unroll
                    for (int n = 0; n < 2; ++n) { f32x4 v = acc[ai][bj][m][n]; if (base) v += *(const f32x4*)(base + off + bj * HALF + n * 16); *(f32x4*)(out + off + bj * HALF + n * 16) = v; }
                asm volatile("" ::: "memory"); }
        return true;
    }
};

template <class Epi, class Sched, bool ALIGN_EPI, int LDA, int LDB, int KK>
__device__ __forceinline__ void gemm_phase(PG8_LAS unsigned char* lds, const Gemm g, const Sched& S, const Epi& E, int wave0) {
    const int tid = opaque_tid(wave0), wid = wave0, lane = tid & 63, wr = wid >> 2, wc = wid & 3, fr = lane & 15, fq = lane >> 4;
    constexpr int nt = KK / BK;
    unsigned voffA[2], voffB[2];
#pragma unroll
    for (int i = 0; i < 2; ++i) { int R, C; stage_rc(tid * 16 + i * 8192, R, C); const int Rb = Epi::PERM ? ((R & ~31) + perm32(R & 31)) : R;
        voffA[i] = (unsigned)(R * LDA + C) * 2u; voffB[i] = (unsigned)(Rb * LDB + C) * 2u; }
    const size_t kstep = (size_t)(BK * 2);
    constexpr size_t hstepA = (size_t)HALF * LDA * 2, hstepB = (size_t)HALF * LDB * 2;
    const unsigned ldsw = (unsigned)wid * 1024u;
    const int aoff = lds_byte(wr * 64 + fr, fq * 8), boff = lds_byte(wc * 32 + fr, fq * 8);
#define PG8_SA(b, h) (((b) * 2 + (h)) * HTB)
#define PG8_SB(b, h) ((4 + (b) * 2 + (h)) * HTB)
#define PG8_STAGE(bufoff, gbase, voff) do { _Pragma("unroll") for (int _i = 0; _i < 2; ++_i) \
        __builtin_amdgcn_global_load_lds((const unsigned*)((const char*)(gbase) + (voff)[_i]), (PG8_LAS unsigned*)(lds + (bufoff) + ldsw + _i * 8192), 16, 0, 0); } while (0)
#define PG8_LDA(dst, b, h) do { _Pragma("unroll") for (int m = 0; m < 4; ++m) _Pragma("unroll") for (int k = 0; k < 2; ++k) dst[m][k] = *(const PG8_LAS bf16x8*)(lds + PG8_SA(b, h) + aoff + m * 2048 + k * 1024); } while (0)
#define PG8_LDB(dst, b, h) do { _Pragma("unroll") for (int n = 0; n < 2; ++n) _Pragma("unroll") for (int k = 0; k < 2; ++k) dst[n][k] = *(const PG8_LAS bf16x8*)(lds + PG8_SB(b, h) + boff + n * 2048 + k * 1024); } while (0)
#define PG8_MMA(ai, bj, At, Bt) do { __builtin_amdgcn_s_setprio(1); _Pragma("unroll") for (int m = 0; m < 4; ++m) _Pragma("unroll") for (int n = 0; n < 2; ++n) _Pragma("unroll") for (int k = 0; k < 2; ++k) \
        acc[ai][bj][m][n] = __builtin_amdgcn_mfma_f32_16x16x32_bf16(Bt[n][k], At[m][k], acc[ai][bj][m][n], 0, 0, 0); __builtin_amdgcn_s_setprio(0); } while (0)
#define PG8_WAIT_V(n) asm volatile("s_waitcnt vmcnt(" #n ")" ::: "memory")
#define PG8_WAIT_L(n) asm volatile("s_waitcnt lgkmcnt(" #n ")" ::: "memory")
#define PG8_BAR __builtin_amdgcn_s_barrier()
#define PG8_SCHED __builtin_amdgcn_sched_barrier(0)
    Unit cur, nxt; int ui = 0;
    if (!S.next(0, cur)) return;
    f32x4 acc[2][2][4][2];
#pragma unroll
    for (int a = 0; a < 2; ++a)
#pragma unroll
        for (int b = 0; b < 2; ++b)
#pragma unroll
            for (int m = 0; m < 4; ++m)
#pragma unroll
                for (int n = 0; n < 2; ++n) acc[a][b][m][n] = (f32x4){0.f, 0.f, 0.f, 0.f};
    bf16x8 At[4][2], B0[2][2], B1[2][2];
    const char* cA = (const char*)g.A + cur.aoff; const char* cB = (const char*)g.Bt + cur.boff;
    PG8_STAGE(PG8_SB(0, 0), cB, voffB); PG8_STAGE(PG8_SB(0, 1), cB + hstepB, voffB); PG8_STAGE(PG8_SA(0, 0), cA, voffA); PG8_STAGE(PG8_SA(0, 1), cA + hstepA, voffA);
    if (wr == 1) PG8_BAR;
    PG8_WAIT_V(2); PG8_BAR;
    PG8_STAGE(PG8_SB(1, 0), cB + kstep, voffB); PG8_STAGE(PG8_SA(1, 0), cA + kstep, voffA); PG8_STAGE(PG8_SB(1, 1), cB + hstepB + kstep, voffB);
    PG8_WAIT_V(6); PG8_BAR;
    for (;;) {
        const bool has_next = S.next(ui + 1, nxt);
        const char* nA = has_next ? (const char*)g.A + nxt.aoff : cA; const char* nB = has_next ? (const char*)g.Bt + nxt.boff : cB;
        for (int t = 0; t < nt; t += 2) {
            const bool last = (t == nt - 2);
            const char* a1 = cA + (size_t)(t + 1) * kstep;
            const char* a2 = last ? nA : cA + (size_t)(t + 2) * kstep; const char* b2 = last ? nB : cB + (size_t)(t + 2) * kstep;
            const char* a3 = a2 + kstep; const char* b3 = b2 + kstep;
            PG8_LDB(B0, 0, 0); PG8_LDB(B1, 0, 1); PG8_SCHED; PG8_LDA(At, 0, 0); PG8_STAGE(PG8_SA(1, 1), a1 + hstepA, voffA);
            PG8_WAIT_V(8); PG8_WAIT_L(0); PG8_BAR; PG8_MMA(0, 0, At, B0); PG8_MMA(0, 1, At, B1); PG8_BAR; PG8_SCHED;
            PG8_LDA(At, 0, 1); PG8_STAGE(PG8_SB(0, 0), b2, voffB); PG8_STAGE(PG8_SB(0, 1), b2 + hstepB, voffB); PG8_STAGE(PG8_SA(0, 0), a2, voffA);
            PG8_WAIT_V(8); PG8_WAIT_L(0); PG8_BAR; PG8_MMA(1, 0, At, B0); PG8_MMA(1, 1, At, B1); PG8_BAR; PG8_SCHED;
            PG8_LDB(B0, 1, 0); PG8_LDB(B1, 1, 1); PG8_SCHED; PG8_LDA(At, 1, 0); PG8_STAGE(PG8_SA(0, 1), a2 + hstepA, voffA);
            PG8_WAIT_V(8); PG8_WAIT_L(0); PG8_BAR; PG8_MMA(0, 0, At, B0); PG8_MMA(0, 1, At, B1); PG8_BAR; PG8_SCHED;
            PG8_LDA(At, 1, 1); PG8_STAGE(PG8_SB(1, 0), b3, voffB); PG8_STAGE(PG8_SB(1, 1), b3 + hstepB, voffB); PG8_STAGE(PG8_SA(1, 0), a3, voffA);
            PG8_WAIT_V(8); PG8_WAIT_L(0); PG8_BAR; PG8_MMA(1, 0, At, B0); PG8_MMA(1, 1, At, B1); PG8_BAR; PG8_SCHED;
        }
        if constexpr (ALIGN_EPI) { if (wr == 0) PG8_BAR; }
        const bool fin = E(acc, cur, wr, wc, fr, fq);
        if (!has_next) break;
        if (fin) {
#pragma unroll
        for (int a = 0; a < 2; ++a)
#pragma unroll
            for (int b = 0; b < 2; ++b)
#pragma unroll
                for (int m = 0; m < 4; ++m)
#pragma unroll
                    for (int n = 0; n < 2; ++n) acc[a][b][m][n] = (f32x4){0.f, 0.f, 0.f, 0.f};
        }
        cur = nxt; cA = nA; cB = nB; ++ui;
        if constexpr (ALIGN_EPI) { if (wr == 1) PG8_BAR; }
    }
    PG8_WAIT_V(0);
    if constexpr (!ALIGN_EPI) { if (wr == 0) PG8_BAR; }
    PG8_BAR;
#undef PG8_SA
#undef PG8_SB
#undef PG8_STAGE
#undef PG8_LDA
#undef PG8_LDB
#undef PG8_MMA
#undef PG8_WAIT_V
#undef PG8_WAIT_L
#undef PG8_BAR
#undef PG8_SCHED
}
}

namespace attn {
using bf16x8 = __attribute__((ext_vector_type(8))) short;
using s16x4  = __attribute__((ext_vector_type(4))) short;
using f32x16 = __attribute__((ext_vector_type(16))) float;
using u32x4  = __attribute__((ext_vector_type(4))) unsigned;
constexpr int   D = 128, NW = 8, QBLK = 32, KVBLK = 64;
constexpr float SCALE = 0.088388347648318440f;
constexpr float THR = 8.f;
constexpr size_t SHM_V = KVBLK * D * 2, SHM_K = KVBLK * D * 2;
constexpr int LDS_WS = 2 * SHM_V + 2 * SHM_K, LDS_TAB = LDS_WS + NW * 64 * 4, LDS_END = LDS_TAB + 8192 * 4;
#define KSWZ(row, colB) ((row) * 256 + ((colB) ^ (((row) & 7) << 4)))
#define SBAR() __builtin_amdgcn_sched_barrier(0)
__device__ __forceinline__ int crow(int r, int hi) { return (r & 3) + 8 * (r >> 2) + 4 * hi; }
__device__ __forceinline__ unsigned cvtpk(float lo, float hi) { unsigned r; asm volatile("v_cvt_pk_bf16_f32 %0, %1, %2" : "=v"(r) : "v"(lo), "v"(hi)); return r; }

__device__ __forceinline__ void partialSM(f32x16& p0, f32x16& p1, float& m_reg, float& mn, float& alpha) {
  constexpr float C = SCALE * 1.4426950408889634f;
  float pmax = p0[0]; for (int r = 1; r < 16; ++r) pmax = fmaxf(pmax, p0[r]); for (int r = 0; r < 16; ++r) pmax = fmaxf(pmax, p1[r]);
  { auto rr = __builtin_amdgcn_permlane32_swap(__float_as_uint(pmax), __float_as_uint(pmax), false, false);
    pmax = fmaxf(__uint_as_float(rr[0]), __uint_as_float(rr[1])); }
  if (__builtin_expect(__all(pmax - m_reg <= THR / SCALE), 1)) { mn = m_reg; alpha = 1.f; }
  else { mn = fmaxf(m_reg, pmax); alpha = __builtin_amdgcn_exp2f((m_reg - mn) * C); m_reg = mn; }
  float mnC = -mn * C;
  for (int r = 0; r < 16; ++r) p0[r] = fmaf(p0[r], C, mnC); for (int r = 0; r < 16; ++r) p1[r] = fmaf(p1[r], C, mnC);
  for (int r = 0; r < 16; ++r) p0[r] = __builtin_amdgcn_exp2f(p0[r]);
}
__device__ __forceinline__ void finishSM(f32x16& p0, f32x16& p1, float alpha, float& l_reg, bf16x8& pa0, bf16x8& pa1, bf16x8& pa2, bf16x8& pa3) {
  for (int r = 0; r < 16; ++r) p1[r] = __builtin_amdgcn_exp2f(p1[r]);
  float ps = 0; for (int r = 0; r < 16; ++r) ps += p0[r]; for (int r = 0; r < 16; ++r) ps += p1[r];
  { auto rr = __builtin_amdgcn_permlane32_swap(__float_as_uint(ps), __float_as_uint(ps), false, false);
    ps = __uint_as_float(rr[0]) + __uint_as_float(rr[1]); }
  l_reg = l_reg * alpha + ps;
#define PK4(P, BASE, OUT) do { unsigned a0 = cvtpk(P[BASE + 0], P[BASE + 1]), a1 = cvtpk(P[BASE + 2], P[BASE + 3]);   \
    unsigned b0 = cvtpk(P[BASE + 4], P[BASE + 5]), b1 = cvtpk(P[BASE + 6], P[BASE + 7]);                              \
    auto r0 = __builtin_amdgcn_permlane32_swap(a0, b0, false, false); auto r1 = __builtin_amdgcn_permlane32_swap(a1, b1, false, false); \
    u32x4 w = {r0[0], r1[0], r0[1], r1[1]}; OUT = *reinterpret_cast<bf16x8*>(&w); } while (0)
  PK4(p0, 0, pa0); PK4(p0, 8, pa1); PK4(p1, 0, pa2); PK4(p1, 8, pa3);
#undef PK4
}
__device__ __forceinline__ void qkt(f32x16& p0, f32x16& p1, const bf16* Ks, const bf16x8* qr, int r32, int hi, const float* tl) {
#pragma unroll
  for (int r = 0; r < 16; ++r) { p0[r] = tl[(r & 3) + 8 * (r >> 2)]; p1[r] = tl[32 + (r & 3) + 8 * (r >> 2)]; }
#pragma unroll
  for (int d0 = 0; d0 < 8; ++d0) { int cb = (d0 * 16 + hi * 8) * 2;
    bf16x8 b0 = *reinterpret_cast<const bf16x8*>((const char*)Ks + KSWZ(r32, cb));
    bf16x8 b1 = *reinterpret_cast<const bf16x8*>((const char*)Ks + KSWZ(32 + r32, cb));
    p0 = __builtin_amdgcn_mfma_f32_32x32x16_bf16(b0, qr[d0], p0, 0, 0, 0);
    p1 = __builtin_amdgcn_mfma_f32_32x32x16_bf16(b1, qr[d0], p1, 0, 0, 0); }
}
__device__ __forceinline__ int v_st(int k, int c) { const int kk = (k & ~0xC) | ((k & 4) << 1) | ((k & 8) >> 1); return ((kk >> 3) * 4 + (c >> 5)) * 512 + ((kk & 7) * 32 + (c & 31)) * 2; }
__device__ __forceinline__ int v_rd_base(int lane) { return ((lane & 3) << 3) | (((lane >> 2) & 3) << 6) | (((lane >> 4) & 1) << 5) | (((lane >> 5) & 1) << 8); }
constexpr int v_rd_off(int d0, int ks, int half) { return d0 * 512 + ks * 4096 + half * 2048; }
template <int OFF> __device__ __forceinline__ s16x4 tr_read(int vb) {
  s16x4 r; asm volatile("ds_read_b64_tr_b16 %0, %1 offset:%2" : "=&v"(r) : "v"(vb), "i"(OFF) : "memory"); return r;
}
template <int D0> __device__ __forceinline__ void pv_one(f32x16& od, int vb, bf16x8 pa0, bf16x8 pa1, bf16x8 pa2, bf16x8 pa3) {
  const s16x4 l0 = tr_read<v_rd_off(D0, 0, 0)>(vb), h0 = tr_read<v_rd_off(D0, 0, 1)>(vb), l1 = tr_read<v_rd_off(D0, 1, 0)>(vb), h1 = tr_read<v_rd_off(D0, 1, 1)>(vb);
  const s16x4 l2 = tr_read<v_rd_off(D0, 2, 0)>(vb), h2 = tr_read<v_rd_off(D0, 2, 1)>(vb), l3 = tr_read<v_rd_off(D0, 3, 0)>(vb), h3 = tr_read<v_rd_off(D0, 3, 1)>(vb);
  asm volatile("s_waitcnt lgkmcnt(0)" ::: "memory"); SBAR();
#define PK(L, H) (bf16x8){L[0], L[1], L[2], L[3], H[0], H[1], H[2], H[3]}
  od = __builtin_amdgcn_mfma_f32_32x32x16_bf16(pa0, PK(l0, h0), od, 0, 0, 0);
  od = __builtin_amdgcn_mfma_f32_32x32x16_bf16(pa1, PK(l1, h1), od, 0, 0, 0);
  od = __builtin_amdgcn_mfma_f32_32x32x16_bf16(pa2, PK(l2, h2), od, 0, 0, 0);
  od = __builtin_amdgcn_mfma_f32_32x32x16_bf16(pa3, PK(l3, h3), od, 0, 0, 0);
#undef PK
}
__device__ __forceinline__ void pv_d0(f32x16* o, int vb, bf16x8 pa0, bf16x8 pa1, bf16x8 pa2, bf16x8 pa3) {
  pv_one<0>(o[0], vb, pa0, pa1, pa2, pa3); pv_one<1>(o[1], vb, pa0, pa1, pa2, pa3); pv_one<2>(o[2], vb, pa0, pa1, pa2, pa3); pv_one<3>(o[3], vb, pa0, pa1, pa2, pa3);
}

struct Unit { const bf16* Q; const bf16* K; const bf16* V; bf16* O; float* lse; long ldq, ldk, ldo; int lse_ld, kt0, nt, qoff; };
__device__ __forceinline__ void attn_unit(const Unit& u, char* lds, int wave0) {
  const int tid = opaque_tid(wave0), wid = wave0, lane = tid & 63, r32 = lane & 31, hi = lane >> 5;
  bf16* V_lds = (bf16*)lds; bf16* K_lds = (bf16*)(lds + 2 * SHM_V);
  float* ws = (float*)(lds + LDS_WS) + wid * 64; float* li_l = ws; float* al_l = ws + 32;
  const float* tabL = (const float*)(lds + LDS_TAB);
  float m_reg = -1e30f, l_reg = 0; f32x16 o[4] = {}; bf16x8 qr[8];
  const bf16* Qw = u.Q + (long)(wid * QBLK + r32) * u.ldq + hi * 8;
#pragma unroll
  for (int d0 = 0; d0 < 8; ++d0) qr[d0] = *reinterpret_cast<const bf16x8*>(Qw + d0 * 16);
  const int sr = tid >> 4, sc = (tid & 15) * 8, vst0 = v_st(sr, sc), vst1 = v_st(32 + sr, sc);
  const int vb0 = (int)(uintptr_t)V_lds + v_rd_base(lane);
  const long tstep = (long)KVBLK * u.ldk * 2;
  const char* Kh = (const char*)u.K + (long)u.kt0 * tstep; const char* Vh = (const char*)u.V + (long)u.kt0 * tstep;
  const unsigned lo0 = (unsigned)((sr * (int)u.ldk + sc) * 2), lo1 = lo0 + (unsigned)(32 * (int)u.ldk * 2);
  const float* tl0 = tabL + (4096 + u.kt0 * KVBLK + 4 * hi - (u.qoff + wid * QBLK + r32));
  struct { bf16x8 vs0, vs1, ks0, ks1; } sr_[2];
#define SLOAD(i, tj) do { const char* vt_ = Vh + (long)(tj) * tstep; const char* kt_ = Kh + (long)(tj) * tstep; \
    sr_[i].vs0 = *reinterpret_cast<const bf16x8*>(vt_ + lo0); sr_[i].vs1 = *reinterpret_cast<const bf16x8*>(vt_ + lo1); \
    sr_[i].ks0 = *reinterpret_cast<const bf16x8*>(kt_ + lo0); sr_[i].ks1 = *reinterpret_cast<const bf16x8*>(kt_ + lo1); } while (0)
#define SWRITE(b, i) do { *(bf16x8*)((char*)V_lds + (b) * SHM_V + vst0) = sr_[i].vs0;          \
    *(bf16x8*)((char*)V_lds + (b) * SHM_V + vst1) = sr_[i].vs1; int kc = sc * 2;               \
    *(bf16x8*)((char*)K_lds + (b) * SHM_K + KSWZ(sr, kc)) = sr_[i].ks0;                       \
    *(bf16x8*)((char*)K_lds + (b) * SHM_K + KSWZ(32 + sr, kc)) = sr_[i].ks1; } while (0)
#define SWAIT() asm volatile("s_waitcnt vmcnt(4)" ::: "memory")
#define RESC(a) do { if (__any((a) < 1.f)) { if (hi == 0) al_l[r32] = (a); asm volatile("s_waitcnt lgkmcnt(0)" ::: "memory"); \
    for (int d = 0; d < 4; ++d) for (int r = 0; r < 16; ++r) o[d][r] *= al_l[crow(r, hi)]; } } while (0)
  f32x16 pA0, pA1, pB0, pB1; float mnA, mnB, alA, alB; bf16x8 pa0, pa1, pa2, pa3; const int NT = u.nt;
  constexpr int SE = 0, SO = 1;
  SLOAD(SE, 0); asm volatile("s_waitcnt vmcnt(0)" ::: "memory"); SWRITE(0, SE); __syncthreads();
  qkt(pA0, pA1, K_lds, qr, r32, hi, tl0); partialSM(pA0, pA1, m_reg, mnA, alA);
  SLOAD(SO, 1); if (2 < NT) SLOAD(SE, 2);
  SWAIT(); SWRITE(1, SO); __syncthreads();
  for (int j = 1; j + 1 < NT; j += 2) {
    SBAR(); qkt(pB0, pB1, (bf16*)((char*)K_lds + SHM_K), qr, r32, hi, tl0 + j * KVBLK);
    finishSM(pA0, pA1, alA, l_reg, pa0, pa1, pa2, pa3); SBAR();
    SLOAD(SO, j + 2); SBAR();
    pv_d0(o, vb0, pa0, pa1, pa2, pa3); partialSM(pB0, pB1, m_reg, mnB, alB);
    __syncthreads(); SWAIT(); SWRITE(0, SE);
    RESC(alB); __syncthreads();
    SBAR(); qkt(pA0, pA1, K_lds, qr, r32, hi, tl0 + (j + 1) * KVBLK);
    finishSM(pB0, pB1, alB, l_reg, pa0, pa1, pa2, pa3); SBAR();
    if (j + 3 < NT) SLOAD(SE, j + 3); SBAR();
    pv_d0(o, vb0 + (int)SHM_V, pa0, pa1, pa2, pa3); partialSM(pA0, pA1, m_reg, mnA, alA);
    __syncthreads(); SWAIT(); SWRITE(1, SO);
    RESC(alA); __syncthreads();
  }
  SBAR(); qkt(pB0, pB1, (bf16*)((char*)K_lds + SHM_K), qr, r32, hi, tl0 + (NT - 1) * KVBLK);
  finishSM(pA0, pA1, alA, l_reg, pa0, pa1, pa2, pa3); SBAR();
  pv_d0(o, vb0, pa0, pa1, pa2, pa3); partialSM(pB0, pB1, m_reg, mnB, alB);
  __syncthreads(); RESC(alB);
  finishSM(pB0, pB1, alB, l_reg, pa0, pa1, pa2, pa3); SBAR();
  pv_d0(o, vb0 + (int)SHM_V, pa0, pa1, pa2, pa3);
  if (hi == 0) li_l[r32] = l_reg; asm volatile("s_waitcnt lgkmcnt(0)" ::: "memory");
  float rli[16];
#pragma unroll
  for (int r = 0; r < 16; ++r) rli[r] = __builtin_amdgcn_rcpf(li_l[crow(r, hi)]);
  bf16* Ow = u.O + (long)(wid * QBLK) * u.ldo;
#pragma unroll
  for (int r = 0; r < 16; ++r) { int orow = crow(r, hi);
#pragma unroll
    for (int d0 = 0; d0 < 4; ++d0) { const float v = o[d0][r] * rli[r]; Ow[(long)orow * u.ldo + d0 * 32 + r32] = (bf16)(cvtpk(v, v) & 0xffffu); } }
  if (u.lse != nullptr && hi == 0) u.lse[(long)(wid * QBLK + r32) * u.lse_ld] = m_reg * SCALE + __logf(l_reg);
#undef SLOAD
#undef SWRITE
#undef SWAIT
#undef RESC
}
#undef KSWZ
#undef SBAR
}

constexpr int NWAVES = 8;
constexpr size_t MiB = 1u << 20;
constexpr size_t WS_CTL = 0, CTL_ZERO_BYTES = 1 * MiB;
constexpr size_t WS_CS   = 1 * MiB;
constexpr size_t WS_SKBD = 1 * MiB + 256 * 1024;
constexpr size_t WS_TAB  = 2 * MiB;
constexpr size_t WS_LSE  = 3 * MiB;
constexpr size_t WS_WCAT = 4 * MiB, WS_WO = 12 * MiB, WS_WQ = 20 * MiB;
constexpr size_t WS_WIN  = 28 * MiB;
constexpr size_t WS_DFT  = 84 * MiB;
constexpr size_t WS_U    = 148 * MiB, WS_V = 180 * MiB;
constexpr size_t WS_H    = 276 * MiB;
constexpr size_t WS_PROJ = 340 * MiB;
constexpr size_t WS_G    = 596 * MiB;
constexpr size_t WS_ZT   = 788 * MiB;
constexpr size_t WS_OC   = 820 * MiB;
constexpr size_t WS_MG   = 884 * MiB;
constexpr size_t WS_END  = 948 * MiB;
#if DBG_MODE == 2
constexpr size_t WS_ACT = WS_PROJ + 208 * MiB;
#else
constexpr size_t WS_ACT = WS_PROJ + 200 * MiB;
#endif
constexpr size_t WS_Q = WS_PROJ, WS_SC = WS_PROJ + 64 * MiB, WS_IDS = WS_PROJ + 192 * MiB, WS_GATES = WS_PROJ + 200 * MiB;
constexpr int CW_BAR = 4096;
constexpr int CW_XRANK = 12288;
constexpr int CW_QUEUE = 16384;
constexpr int RING_BYTES = 131072, LDSCTL_OFF = RING_BYTES, MISC_OFF = LDSCTL_OFF + 320, LDS_BYTES = 147456;

#define LDS_WAIT() asm volatile("s_waitcnt lgkmcnt(0)" ::: "memory")
#define VM_WAIT() asm volatile("s_waitcnt vmcnt(0)" ::: "memory")
__device__ __forceinline__ unsigned f2bf(float f) { unsigned u = __builtin_bit_cast(unsigned, f); return (u + 0x7fffu + ((u >> 16) & 1u)) >> 16; }
__device__ __forceinline__ unsigned pk2(float lo, float hi) { return f2bf(lo) | (f2bf(hi) << 16); }
__device__ __forceinline__ float bflo(unsigned w) { return __uint_as_float(w << 16); }
__device__ __forceinline__ float bfhi(unsigned w) { return __uint_as_float(w & 0xffff0000u); }

#define XB_TMO      128
#define XB_XCNT(j)  (256  + 64 * (j))
#define XB_XSUB(j)  (1280 + 64 * (j))
#define XB_XGEN(j)  (2304 + 64 * (j))
#define XB_TOP      3328
#define XB_TOPGEN   3392
#define XCD_BAR_WORDS 3456
#define XB_SPIN_CAP (1u << 20)
__device__ __forceinline__ unsigned xb_ld(unsigned* p)              { return __hip_atomic_load(p, __ATOMIC_RELAXED, __HIP_MEMORY_SCOPE_AGENT); }
__device__ __forceinline__ unsigned xb_add(unsigned* p, unsigned v) { return __hip_atomic_fetch_add(p, v, __ATOMIC_RELAXED, __HIP_MEMORY_SCOPE_AGENT); }
__device__ __forceinline__ unsigned xb_xcc_id() { return (unsigned)__builtin_amdgcn_s_getreg((3 << 11) | 20) & 0xFu; }
#define XB_SPIN(cond, bar) do { unsigned _sp = 0; while (cond) { __builtin_amdgcn_s_sleep(1); \
    if ((++_sp & 255u) == 0u) { if (xb_ld(&(bar)[XB_TMO])) break; if (_sp > XB_SPIN_CAP) { atomicAdd(&(bar)[XB_TMO], 1u); break; } } } } while (0)
struct XcdBarrier { unsigned* bar; unsigned x; volatile LAS unsigned* st; };
__device__ __forceinline__ XcdBarrier xcd_barrier_post(unsigned* bar, volatile LAS unsigned* st) {
    XcdBarrier b; b.bar = bar; b.x = xb_xcc_id(); b.st = st;
    if (threadIdx.x == 0) (void)xb_add(&bar[XB_XCNT(b.x)], 1u);
    return b;
}
__device__ __forceinline__ void xcd_barrier_complete(unsigned* bar, unsigned x, unsigned& nloc, unsigned& nx) {
    const unsigned G = gridDim.x * gridDim.y * gridDim.z;
    unsigned sum, cnt, mine, sp = 0u;
    for (;;) {
        sum = 0u; cnt = 0u; mine = 0u;
#pragma unroll
        for (unsigned j = 0; j < 16; ++j) { const unsigned c = xb_ld(&bar[XB_XCNT(j)]); sum += c; cnt += (c > 0u) ? 1u : 0u; mine = (j == x) ? c : mine; }
        if (sum == G) break;
        __builtin_amdgcn_s_sleep(1);
        if ((++sp & 255u) == 0u) { if (xb_ld(&bar[XB_TMO])) break; if (sp > XB_SPIN_CAP) { atomicAdd(&bar[XB_TMO], 1u); break; } }
    }
    nloc = mine > 0u ? mine : 1u; nx = cnt > 0u ? cnt : 1u;
}
__device__ __forceinline__ void xcd_barrier(const XcdBarrier& b) {
    asm volatile("s_waitcnt vmcnt(0)" ::: "memory");
    __syncthreads();
    if (threadIdx.x == 0) {
        unsigned* bar = b.bar;
        __builtin_amdgcn_s_waitcnt(0);
        unsigned nloc = b.st[0], nx = b.st[1];
        if (nloc == 0u) { xcd_barrier_complete(bar, b.x, nloc, nx); b.st[0] = nloc; b.st[1] = nx; }
        const unsigned old = xb_add(&bar[XB_XSUB(b.x)], 1u);
        const unsigned gen = old / nloc;
        if (old + 1u == (gen + 1u) * nloc) {
            __builtin_amdgcn_fence(__ATOMIC_RELEASE, "agent");
            asm volatile("s_waitcnt vmcnt(0)" ::: "memory");
            const unsigned og = xb_add(&bar[XB_TOP], 1u);
            const unsigned tg = og / nx;
            if (og + 1u == (tg + 1u) * nx) xb_add(&bar[XB_TOPGEN], 1u);
            else XB_SPIN(xb_ld(&bar[XB_TOPGEN]) == tg, bar);
            __builtin_amdgcn_fence(__ATOMIC_ACQUIRE, "agent");
            xb_add(&bar[XB_XGEN(b.x)], 1u);
            asm volatile("s_waitcnt vmcnt(0)" ::: "memory");
        } else {
            XB_SPIN(xb_ld(&bar[XB_XGEN(b.x)]) == gen, bar);
            __builtin_amdgcn_fence(__ATOMIC_ACQUIRE, "agent");
            asm volatile("s_waitcnt vmcnt(0)" ::: "memory");
        }
    }
    __syncthreads();
}

template <int MASK> __device__ __forceinline__ int sx_i(int v) { return __builtin_amdgcn_ds_swizzle(v, 0x1f | (MASK << 10)); }
template <int MASK> __device__ __forceinline__ float sx_f(float v) { return __int_as_float(sx_i<MASK>(__float_as_int(v))); }
__device__ __forceinline__ float add32(float v) { auto rr = __builtin_amdgcn_permlane32_swap(__float_as_uint(v), __float_as_uint(v), false, false); return __uint_as_float(rr[0]) + __uint_as_float(rr[1]); }
__device__ __forceinline__ unsigned max32(unsigned v) { auto rr = __builtin_amdgcn_permlane32_swap(v, v, false, false); return rr[0] > rr[1] ? rr[0] : rr[1]; }
__device__ __forceinline__ float other32(float v, bool upper) { auto rr = __builtin_amdgcn_permlane32_swap(__float_as_uint(v), __float_as_uint(v), false, false); return __uint_as_float(upper ? rr[0] : rr[1]); }
__device__ __forceinline__ float bperm_f(float v, int src_lane) { return __int_as_float(__builtin_amdgcn_ds_bpermute(src_lane * 4, __float_as_int(v))); }
__device__ __forceinline__ int bperm_i(int v, int src_lane) { return __builtin_amdgcn_ds_bpermute(src_lane * 4, v); }
__device__ __forceinline__ float wave_sum(float v) {
    v += sx_f<1>(v); v += sx_f<2>(v); v += sx_f<4>(v); v += sx_f<8>(v); v += sx_f<16>(v); return add32(v);
}
__device__ __forceinline__ unsigned umax(unsigned a, unsigned b) { return a > b ? a : b; }
__device__ __forceinline__ unsigned wave_max_u32(unsigned v) {
    v = umax(v, (unsigned)sx_i<1>((int)v)); v = umax(v, (unsigned)sx_i<2>((int)v)); v = umax(v, (unsigned)sx_i<4>((int)v)); v = umax(v, (unsigned)sx_i<8>((int)v)); v = umax(v, (unsigned)sx_i<16>((int)v)); return max32(v);
}
template <int CTRL, int RMASK> __device__ __forceinline__ unsigned dpp_max_u(unsigned v) { const unsigned t = (unsigned)__builtin_amdgcn_update_dpp((int)v, (int)v, CTRL, RMASK, 0xF, false); return t > v ? t : v; }
__device__ __forceinline__ unsigned wave_max_dpp(unsigned v) {
    v = dpp_max_u<0xB1, 0xF>(v); v = dpp_max_u<0x4E, 0xF>(v); v = dpp_max_u<0x141, 0xF>(v); v = dpp_max_u<0x140, 0xF>(v); v = dpp_max_u<0x142, 0xA>(v); v = dpp_max_u<0x143, 0xC>(v);
    return (unsigned)__builtin_amdgcn_readlane((int)v, 63);
}
template <int CTRL> __device__ __forceinline__ float dpp_add_f(float v) { return v + __int_as_float(__builtin_amdgcn_update_dpp(__float_as_int(v), __float_as_int(v), CTRL, 0xF, 0xF, false)); }
__device__ __forceinline__ float row_sum16(float v) { v = dpp_add_f<0xB1>(v); v = dpp_add_f<0x4E>(v); v = dpp_add_f<0x141>(v); return dpp_add_f<0x140>(v); }
__device__ __forceinline__ unsigned row_max16_u(unsigned v) { v = dpp_max_u<0xB1, 0xF>(v); v = dpp_max_u<0x4E, 0xF>(v); v = dpp_max_u<0x141, 0xF>(v); return dpp_max_u<0x140, 0xF>(v); }
template <int CTRL> __device__ __forceinline__ float dpp_maxf(float v) { return fmaxf(v, __int_as_float(__builtin_amdgcn_update_dpp(__float_as_int(v), __float_as_int(v), CTRL, 0xF, 0xF, false))); }
__device__ __forceinline__ float row_max16_f(float v) { v = dpp_maxf<0xB1>(v); v = dpp_maxf<0x4E>(v); v = dpp_maxf<0x141>(v); return dpp_maxf<0x140>(v); }
__device__ __forceinline__ float okey_inv(unsigned k) { return __uint_as_float((k & 0x80000000u) ? (k & 0x7fffffffu) : ~k); }
#define CE_DESC(a, b) do { const unsigned hi_ = (a) > (b) ? (a) : (b), lo_ = (a) > (b) ? (b) : (a); (a) = hi_; (b) = lo_; } while (0)
__device__ __forceinline__ unsigned okey(float f) { const unsigned u = __float_as_uint(f); return (u & 0x80000000u) ? ~u : (u | 0x80000000u); }

__device__ __forceinline__ void transpose_item(const float* W, int N, bf16* WT, int ldo, int col_off, LAS float* scr, int item, int lane) {
    const int nblk = N / 32, kb = item / nblk, nb = item % nblk, k0 = 64 * kb, n0 = 32 * nb;
#pragma unroll 8
    for (int i = 0; i < 32; ++i) { const int kk = 2 * i + (lane >> 5); scr[kk * 33 + (lane & 31)] = W[(size_t)(k0 + kk) * N + n0 + (lane & 31)]; }
    LDS_WAIT(); asm volatile("" ::: "memory");
    const int c = lane & 7;
#pragma unroll
    for (int j = 0; j < 4; ++j) { const int n = (lane >> 3) + 8 * j; const LAS float* s = scr + (8 * c) * 33 + n;
        v4u o; o.x = pk2(s[0 * 33], s[1 * 33]); o.y = pk2(s[2 * 33], s[3 * 33]); o.z = pk2(s[4 * 33], s[5 * 33]); o.w = pk2(s[6 * 33], s[7 * 33]);
        *(GAS v4u*)(WT + (size_t)(n0 + n) * ldo + col_off + k0 + 8 * c) = o; }
    LDS_WAIT(); asm volatile("" ::: "memory");
}
__device__ __forceinline__ void rms_row_to_bf16(const float* xrow, const float* g, bf16* orow, int lane) {
    const GAS f32x4* xr = (const GAS f32x4*)xrow + lane; const GAS f32x4* gr = (const GAS f32x4*)g + lane;
    f32x4 v[8]; float s = 0.f;
#pragma unroll
    for (int j = 0; j < 8; ++j) { v[j] = xr[64 * j]; s += (v[j].x * v[j].x + v[j].y * v[j].y) + (v[j].z * v[j].z + v[j].w * v[j].w); }
    const float rstd = 1.0f / sqrtf(wave_sum(s) * (1.f / DM) + RMS_EPS);
    GAS unsigned long long* o8 = (GAS unsigned long long*)orow + lane;
#pragma unroll
    for (int j = 0; j < 8; ++j) { const f32x4 gg = gr[64 * j]; o8[64 * j] = (unsigned long long)pk2(v[j].x * rstd * gg.x, v[j].y * rstd * gg.y) | ((unsigned long long)pk2(v[j].z * rstd * gg.z, v[j].w * rstd * gg.w) << 32); }
}
typedef __bf16 bf2_t __attribute__((ext_vector_type(2)));
__device__ __forceinline__ float DOT2(unsigned a, unsigned b, float c) { return __builtin_amdgcn_fdot2_f32_bf16(__builtin_bit_cast(bf2_t, a), __builtin_bit_cast(bf2_t, b), c, false); }
__device__ __forceinline__ int rel_bucket(int rel) {
    const int n = rel < 0 ? -rel : rel;
    int b = n;
    if (n >= 8) { b = 5 + (31 - __builtin_clz((unsigned)n)); if (b > 15) b = 15; }
    return b + (rel > 0 ? 16 : 0);
}

#ifndef PH_D1
#define PH_D1 1
#endif
#ifndef PH_D2
#define PH_D2 1
#endif
#ifndef PH_A
#define PH_A 1
#endif
#ifndef PH_B
#define PH_B 1
#endif
#ifndef PH_C
#define PH_C 1
#endif
#ifndef PH_D
#define PH_D 1
#endif
#ifndef PH_E
#define PH_E 1
#endif
#ifndef PH_F
#define PH_F 1
#endif
#ifndef PH_G
#define PH_G 1
#endif
#ifndef PH_H
#define PH_H 1
#endif
#ifndef PH_I
#define PH_I 1
#endif
#ifndef PH_J
#define PH_J 1
#endif
#ifndef PH_K
#define PH_K 1
#endif
#ifndef PH_L
#define PH_L 1
#endif
struct Args { const float* in[17]; float* out; unsigned char* ws; };

#define CAS __attribute__((address_space(4)))
__device__ __forceinline__ const void* karg(int k) { const CAS char* ka = (const CAS char*)__builtin_amdgcn_kernarg_segment_ptr(); asm volatile("" : "+s"(ka)); return *(const void* const CAS*)(ka + 8 * k); }
#define WSP(T, off) ((T*)((unsigned char*)karg(18) + (off)))
#define INP(k) ((const float*)karg(k))
#define INL(k, stride) (INP(k) + (size_t)layer * (size_t)(stride))
#define X ((float*)karg(17))
__global__ void __launch_bounds__(NWAVES * 64, 2) mk_fwd(Args args_unused) {
    extern __shared__ __attribute__((aligned(16))) unsigned char lds[];
    LAS unsigned char* ldsl = (LAS unsigned char*)lds;
    volatile LAS unsigned* MISC = (volatile LAS unsigned*)(ldsl + MISC_OFF);
    const int wave0 = __builtin_amdgcn_readfirstlane((int)threadIdx.x >> 6);
    const int G = gridDim.x; const int bx = blockIdx.x; const int vcu = (G % 8 == 0) ? (bx % 8) * (G / 8) + bx / 8 : bx;
    const int NGW = G * NWAVES, NGT = NGW * 64;
#define PH_IDS() const int tid = opaque_tid(wave0), lane = tid & 63, wave = wave0, gw = vcu * NWAVES + wave, gt = gw * 64 + lane; (void)gt; (void)gw; (void)lane
    gu32* ctl = (gu32*)WSP(unsigned char, WS_CTL);
    for (int u = threadIdx.x; u < (LDS_BYTES - LDSCTL_OFF) / 4; u += NWAVES * 64) ((LAS unsigned*)(ldsl + LDSCTL_OFF))[u] = 0u;
    __syncthreads();
    XcdBarrier bar = xcd_barrier_post((unsigned*)(ctl + CW_BAR), MISC + 8);
    if (threadIdx.x == 0) MISC[1] = __hip_atomic_fetch_add(ctl + CW_XRANK + 64 * (int)(xb_xcc_id() & 7u), 1u, __ATOMIC_RELAXED, __HIP_MEMORY_SCOPE_AGENT);
#define GRID_BAR() xcd_barrier(bar)

    for (int layer = 0; layer < 2; ++layer) {

#if PH_A
        {
            PH_IDS();
            LAS float* scr = (LAS float*)(ldsl + wave * 16384);
            const float* w_in = INL(4, (size_t)DM * INW); const float* w_up_a = INL(6, 512 * DM); const float* w_up_b = INL(7, 512 * DM); const float* w_up_c = INL(8, 1024 * DM);
            const float* w_o = INL(11, DM * DM); const float* wq = INL(13, DM * DM); const float* subk = INL(14, 2 * 128 * 128);
            const float* pu = INL(15, (size_t)NEXP * DM); const float* pv = INL(16, (size_t)NEXP * DM); const float* mix_g = INL(3, DM); const float* rel_bias = INP(1);
            bf16* WIN = WSP(bf16, WS_WIN); bf16* WCAT = WSP(bf16, WS_WCAT); bf16* WO = WSP(bf16, WS_WO); bf16* WQ = WSP(bf16, WS_WQ); unsigned char* U8 = WSP(unsigned char, WS_U); unsigned char* V8 = WSP(unsigned char, WS_V);
            bf16* SKBD = WSP(bf16, WS_SKBD); bf16* H = WSP(bf16, WS_H); bf16* DFT = WSP(bf16, WS_DFT); bf16* CS = WSP(bf16, WS_CS); float* TAB = WSP(float, WS_TAB);
            constexpr int I_IN = (DM / 64) * (INW / 32), I_A = (512 / 64) * (DM / 32), I_C = (1024 / 64) * (DM / 32), I_SQ = (DM / 64) * (DM / 32);
            constexpr int NITEMS = I_IN + 2 * I_A + I_C + 2 * I_SQ;
            for (int it = gw; it < NITEMS; it += NGW) {
                int r = it;
                if (r < I_IN) { transpose_item(w_in, INW, WIN, DM, 0, scr, r, lane); continue; } r -= I_IN;
                if (r < I_A) { transpose_item(w_up_a, DM, WCAT, DM, 0, scr, r, lane); continue; } r -= I_A;
                if (r < I_A) { transpose_item(w_up_b, DM, WCAT, DM, 512, scr, r, lane); continue; } r -= I_A;
                if (r < I_C) { transpose_item(w_up_c, DM, WCAT, DM, 1024, scr, r, lane); continue; } r -= I_C;
                if (r < I_SQ) { transpose_item(w_o, DM, WO, DM, 0, scr, r, lane); continue; } r -= I_SQ;
                transpose_item(wq, DM, WQ, DM, 0, scr, r, lane);
            }
            for (size_t i = (size_t)gt; i < (size_t)NEXP * DM / 16; i += (size_t)NGT) {
#pragma unroll
                for (int tb = 0; tb < 2; ++tb) {
                    const GAS f32x4* src = (const GAS f32x4*)(tb ? pv : pu) + 4 * i; const float sc = tb ? 64.f : 1024.f;
                    const f32x4 a = src[0], b = src[1], c = src[2], d = src[3]; v4u o;
                    int w;
                    w = __builtin_amdgcn_cvt_pk_fp8_f32(a.x * sc, a.y * sc, 0, false); w = __builtin_amdgcn_cvt_pk_fp8_f32(a.z * sc, a.w * sc, w, true); o.x = (unsigned)w;
                    w = __builtin_amdgcn_cvt_pk_fp8_f32(b.x * sc, b.y * sc, 0, false); w = __builtin_amdgcn_cvt_pk_fp8_f32(b.z * sc, b.w * sc, w, true); o.y = (unsigned)w;
                    w = __builtin_amdgcn_cvt_pk_fp8_f32(c.x * sc, c.y * sc, 0, false); w = __builtin_amdgcn_cvt_pk_fp8_f32(c.z * sc, c.w * sc, w, true); o.z = (unsigned)w;
                    w = __builtin_amdgcn_cvt_pk_fp8_f32(d.x * sc, d.y * sc, 0, false); w = __builtin_amdgcn_cvt_pk_fp8_f32(d.z * sc, d.w * sc, w, true); o.w = (unsigned)w;
                    ((GAS v4u*)(tb ? V8 : U8))[i] = o;
                }
            }
            for (int i = gt; i < 65536; i += NGT) { const int n = i >> 8, kk = i & 255, p = n >> 7; SKBD[i] = ((kk >> 7) == p) ? (bf16)f2bf(subk[(size_t)(p * 128 + (n & 127)) * 128 + (kk & 127)]) : (bf16)0; }
            for (int m = gw; m < MTOK; m += NGW) rms_row_to_bf16((layer == 0 ? INP(0) : (const float*)X) + (size_t)m * DM, mix_g, H + (size_t)m * DM, lane);
            if (layer == 0) {
                for (size_t i = (size_t)gt; i < (size_t)4096 * 8192 / 8; i += (size_t)NGT) {
                    const int sp = (int)(i >> 10), k0 = (int)(i & 1023) * 8, part = k0 >> 12, s0 = k0 & 4095; float v[8];
#pragma unroll
                    for (int j = 0; j < 8; ++j) { const float ang = (float)(((s0 + j) * sp) & 4095) * (1.f / 4096.f); v[j] = (part ? -__builtin_amdgcn_sinf(ang) : __builtin_amdgcn_cosf(ang)) * (1.f / 64.f); }
                    v4u o; o.x = pk2(v[0], v[1]); o.y = pk2(v[2], v[3]); o.z = pk2(v[4], v[5]); o.w = pk2(v[6], v[7]); ((GAS v4u*)DFT)[i] = o;
                }
                for (int i = gt; i < 65536; i += NGT) { const int r = i >> 8, c = i & 255, part = r >> 7, cp = r & 127; float v = 0.f;
                    if (c < 128) { const float ang = (float)((c * cp) & 127) * (1.f / 128.f); v = (part ? __builtin_amdgcn_sinf(ang) : __builtin_amdgcn_cosf(ang)) * 0.08838834764831845f; }
                    CS[i] = (bf16)f2bf(v); }
                for (int i = gt; i < 16 * 8192; i += NGT) { const int hd = i >> 13, off = (i & 8191) - 4096; float v;
                    if (hd < 12) { const int g = hd >> 2, dil = g == 0 ? 1 : (g == 1 ? 4 : 16); v = (off >= -64 && off <= 64) ? rel_bias[rel_bucket(off * dil) * 16 + hd] * 11.313708498984761f : -1.0e5f; }
                    else v = rel_bias[rel_bucket(off) * 16 + hd] * 11.313708498984761f;
                    TAB[i] = v; }
            }
        }
#endif
        GRID_BAR();

#if PH_B
        {
            pg8::Gemm g{WSP(bf16, WS_H), WSP(bf16, WS_WIN)}; pg8::StaticOrder S; S.init(MTOK, INW, G, bx, DM, DM);
            pg8::EpiProj E{WSP(bf16, WS_PROJ), WSP(bf16, WS_G), INL(5, GTW)};
            pg8::gemm_phase<pg8::EpiProj, pg8::StaticOrder, true, DM, DM, DM>(ldsl, g, S, E, wave0);
        }
#endif
        GRID_BAR();

#if PH_C
        {
            pg8::Gemm g{WSP(bf16, WS_CS), WSP(bf16, WS_PROJ)}; pg8::F1Order S{G, bx};
            pg8::EpiZT E{WSP(bf16, WS_ZT)};
            pg8::gemm_phase<pg8::EpiZT, pg8::F1Order, false, 256, PJW, 256>(ldsl, g, S, E, wave0);
        }
#endif
        GRID_BAR();

#if PH_D
#if PH_D1
        {
            pg8::Gemm g{WSP(bf16, WS_DFT), WSP(bf16, WS_ZT)}; pg8::F2Order S; S.init(4096, 2048, G, bx, 8192, 8192);
            pg8::EpiStore E{WSP(bf16, WS_OC), DM};
            pg8::gemm_phase<pg8::EpiStore, pg8::F2Order, false, 8192, 8192, 8192>(ldsl, g, S, E, wave0);
        }
#endif
#if PH_D2
        {
            PH_IDS();
            gu32* qhead = ctl + CW_QUEUE + 64 * layer;
            bf16* PROJ = WSP(bf16, WS_PROJ); bf16* DO = WSP(bf16, WS_MG); bf16* DL = WSP(bf16, WS_H); float* LSE = WSP(float, WS_LSE); const float* TAB = WSP(float, WS_TAB);
            const float* cur_tab = nullptr;
            for (;;) {
                __syncthreads();
                if (tid == 0) MISC[0] = __hip_atomic_fetch_add(qhead, 1u, __ATOMIC_RELAXED, __HIP_MEMORY_SCOPE_AGENT);
                __syncthreads();
                const int ui = __builtin_amdgcn_readfirstlane((int)MISC[0]);
                if (ui >= 1792) break;
                attn::Unit u; int hd;
                if (ui < 1024) {
                    const int qb = ui & 15, vh = (ui >> 4) & 1, m = (ui >> 5) & 1, h = (ui >> 6) & 3, b = ui >> 8;
                    const bf16* base = PROJ + (size_t)b * SEQ * PJW;
                    u.Q = base + (size_t)(qb * 256) * PJW + COL_DIFF + (h * 2 + m) * 128; u.K = base + COL_DIFF + 1024 + (h * 2 + m) * 128; u.V = base + COL_DIFF + 2048 + h * 256 + vh * 128;
                    u.O = DO + (size_t)(b * SEQ + qb * 256) * DM + (h * 2 + m) * 256 + vh * 128; u.lse = nullptr; u.ldq = PJW; u.ldk = PJW; u.ldo = DM; u.lse_ld = 0;
                    u.kt0 = 0; u.nt = SEQ / 64; u.qoff = qb * 256; hd = 12 + h;
                } else {
                    const int v = ui - 1024, qb16 = v & 15, hh = (v >> 4) & 3, bg = v >> 6, g = bg % 3, b = bg / 3;
                    const int dil = g == 0 ? 1 : (g == 1 ? 4 : 16), bpc = 16 / dil, r = qb16 / bpc, qblk = qb16 % bpc, q0 = qblk * 256, ntot = (SEQ / dil) / 64;
                    int kt0 = q0 / 64 - 1; if (kt0 < 0) kt0 = 0; int kt1 = q0 / 64 + 5; if (kt1 > ntot) kt1 = ntot;
                    if ((kt1 - kt0) & 1) { if (kt0 > 0) --kt0; else ++kt1; }
                    const bf16* base = PROJ + (size_t)(b * SEQ + r) * PJW + COL_DIL + g * 512 + hh * 128;
                    u.Q = base + (size_t)q0 * dil * PJW; u.K = base + 1536; u.V = base + 3072;
                    u.O = DL + ((size_t)g * MTOK + b * SEQ + r + (size_t)q0 * dil) * 512 + hh * 128; u.lse = LSE + ((size_t)g * MTOK + b * SEQ + r + (size_t)q0 * dil) * 4 + hh;
                    u.ldq = (long)PJW * dil; u.ldk = (long)PJW * dil; u.ldo = 512L * dil; u.lse_ld = 4 * dil; u.kt0 = kt0; u.nt = kt1 - kt0; u.qoff = q0; hd = g * 4 + hh;
                }
                const float* tab = TAB + (size_t)hd * 8192;
                if (tab != cur_tab) {
                    cur_tab = tab;
                    LAS f32x4* tl = (LAS f32x4*)(ldsl + attn::LDS_TAB); const int t2 = opaque_tid(wave0);
#pragma unroll
                    for (int j = 0; j < 4; ++j) tl[t2 + 512 * j] = ((const GAS f32x4*)tab)[t2 + 512 * j];
                }
                attn::attn_unit(u, (char*)lds, wave0);
            }
        }
#endif
#endif
        GRID_BAR();

#if PH_E
        {
            PH_IDS();
            const float* dlam = INL(9, 512); const float* subln = INL(10, 256); const float lambda_init = layer == 0 ? 0.2f : 0.35550906759f;
            const float* LSE = WSP(float, WS_LSE); const bf16* DL = WSP(bf16, WS_H); const bf16* DO = WSP(bf16, WS_MG); bf16* OC = WSP(bf16, WS_OC);
            float s1 = dlam[lane] * dlam[128 + lane] + dlam[64 + lane] * dlam[192 + lane], s2 = dlam[256 + lane] * dlam[384 + lane] + dlam[320 + lane] * dlam[448 + lane];
            s1 = wave_sum(s1); s2 = wave_sum(s2);
            const float lam = __expf(s1) - __expf(s2) + lambda_init, osc = 1.0f - lambda_init;
            const int hq = lane >> 4, l16 = lane & 15;
            for (int t = gw; t < MTOK; t += NGW) {
                float ls[3], mx = -3e38f;
#pragma unroll
                for (int g = 0; g < 3; ++g) { ls[g] = LSE[((size_t)g * MTOK + t) * 4 + hq]; mx = fmaxf(mx, ls[g]); }
                float wsum = 0.f;
#pragma unroll
                for (int g = 0; g < 3; ++g) { ls[g] = __expf(ls[g] - mx); wsum += ls[g]; }
                const float winv = 1.0f / wsum; float acc8[8] = {0.f, 0.f, 0.f, 0.f, 0.f, 0.f, 0.f, 0.f};
#pragma unroll
                for (int g = 0; g < 3; ++g) { const v4u o = *(const GAS v4u*)(DL + ((size_t)g * MTOK + t) * 512 + lane * 8); const float w = ls[g] * winv;
                    acc8[0] += w * bflo(o.x); acc8[1] += w * bfhi(o.x); acc8[2] += w * bflo(o.y); acc8[3] += w * bfhi(o.y); acc8[4] += w * bflo(o.z); acc8[5] += w * bfhi(o.z); acc8[6] += w * bflo(o.w); acc8[7] += w * bfhi(o.w); }
#if defined(DBG_ZERO_OB)
                for (int j = 0; j < 8; ++j) acc8[j] = 0.f;
#endif
                { v4u o; o.x = pk2(acc8[0], acc8[1]); o.y = pk2(acc8[2], acc8[3]); o.z = pk2(acc8[4], acc8[5]); o.w = pk2(acc8[6], acc8[7]); *(GAS v4u*)(OC + (size_t)t * DM + 512 + lane * 8) = o; }
                const bf16* dp = DO + (size_t)t * DM + hq * 512 + l16 * 16;
                const v4u a0 = *(const GAS v4u*)(dp), a1 = *(const GAS v4u*)(dp + 8), b0 = *(const GAS v4u*)(dp + 256), b1 = *(const GAS v4u*)(dp + 264);
                float d[16];
                d[0] = bflo(a0.x) - lam * bflo(b0.x); d[1] = bfhi(a0.x) - lam * bfhi(b0.x); d[2] = bflo(a0.y) - lam * bflo(b0.y); d[3] = bfhi(a0.y) - lam * bfhi(b0.y);
                d[4] = bflo(a0.z) - lam * bflo(b0.z); d[5] = bfhi(a0.z) - lam * bfhi(b0.z); d[6] = bflo(a0.w) - lam * bflo(b0.w); d[7] = bfhi(a0.w) - lam * bfhi(b0.w);
                d[8] = bflo(a1.x) - lam * bflo(b1.x); d[9] = bfhi(a1.x) - lam * bfhi(b1.x); d[10] = bflo(a1.y) - lam * bflo(b1.y); d[11] = bfhi(a1.y) - lam * bfhi(b1.y);
                d[12] = bflo(a1.z) - lam * bflo(b1.z); d[13] = bfhi(a1.z) - lam * bfhi(b1.z); d[14] = bflo(a1.w) - lam * bflo(b1.w); d[15] = bfhi(a1.w) - lam * bfhi(b1.w);
                float ss = 0.f;
#pragma unroll
                for (int j = 0; j < 16; ++j) ss += d[j] * d[j];
                ss += sx_f<1>(ss); ss += sx_f<2>(ss); ss += sx_f<4>(ss); ss += sx_f<8>(ss);
                const float rs = osc / sqrtf(ss * (1.f / 256.f) + RMS_EPS);
                const f32x4 g0 = *(const GAS f32x4*)(subln + l16 * 16), g1 = *(const GAS f32x4*)(subln + l16 * 16 + 4), g2 = *(const GAS f32x4*)(subln + l16 * 16 + 8), g3 = *(const GAS f32x4*)(subln + l16 * 16 + 12);
                v4u o0, o1;
                o0.x = pk2(d[0] * rs * g0.x, d[1] * rs * g0.y); o0.y = pk2(d[2] * rs * g0.z, d[3] * rs * g0.w); o0.z = pk2(d[4] * rs * g1.x, d[5] * rs * g1.y); o0.w = pk2(d[6] * rs * g1.z, d[7] * rs * g1.w);
                o1.x = pk2(d[8] * rs * g2.x, d[9] * rs * g2.y); o1.y = pk2(d[10] * rs * g2.z, d[11] * rs * g2.w); o1.z = pk2(d[12] * rs * g3.x, d[13] * rs * g3.y); o1.w = pk2(d[14] * rs * g3.z, d[15] * rs * g3.w);
                bf16* op = OC + (size_t)t * DM + 1024 + hq * 256 + l16 * 16;
                *(GAS v4u*)(op) = o0; *(GAS v4u*)(op + 8) = o1;
            }
        }
#endif
        GRID_BAR();

#if PH_F
        {
            pg8::MergeOrder S; S.init(MTOK, DM, G, bx, DM, DM);
            pg8::Gemm g{WSP(bf16, WS_OC), WSP(bf16, WS_WCAT)}; pg8::EpiMerge4 E{WSP(bf16, WS_G), WSP(bf16, WS_MG)};
            pg8::gemm_phase<pg8::EpiMerge4, pg8::MergeOrder, true, DM, DM, 512>(ldsl, g, S, E, wave0);
        }
#endif
        GRID_BAR();

#if PH_G
        {
            pg8::Gemm g{WSP(bf16, WS_MG), WSP(bf16, WS_WO)}; pg8::StaticOrder S; S.init(MTOK, DM, G, bx, DM, DM);
            pg8::EpiResF32 E{layer == 0 ? INP(0) : (const float*)X, X, DM};
            pg8::gemm_phase<pg8::EpiResF32, pg8::StaticOrder, true, DM, DM, DM>(ldsl, g, S, E, wave0);
        }
#endif
        GRID_BAR();

#if PH_H
        { PH_IDS(); const float* ffn_g = INL(12, DM); bf16* H = WSP(bf16, WS_H);
          for (int m = gw; m < MTOK; m += NGW) rms_row_to_bf16(X + (size_t)m * DM, ffn_g, H + (size_t)m * DM, lane); }
#endif
        GRID_BAR();

#if PH_I
        {
            pg8::Gemm g{WSP(bf16, WS_H), WSP(bf16, WS_WQ)}; pg8::StaticOrder S; S.init(MTOK, DM, G, bx, DM, DM);
            pg8::EpiStore E{WSP(bf16, WS_Q), DM};
            pg8::gemm_phase<pg8::EpiStore, pg8::StaticOrder, true, DM, DM, DM>(ldsl, g, S, E, wave0);
        }
#endif
        GRID_BAR();

#if PH_J
        {
            pg8::Gemm g{WSP(bf16, WS_Q), WSP(bf16, WS_SKBD)}; pg8::StaticOrder S; S.init(MTOK * 8, 256, G, bx, 256, 256);
            pg8::EpiResF32 E{nullptr, WSP(float, WS_SC), 256};
            pg8::gemm_phase<pg8::EpiResF32, pg8::StaticOrder, true, 256, 256, 256>(ldsl, g, S, E, wave0);
        }
#endif
        GRID_BAR();

#if PH_K
        {
            PH_IDS();
            const float* SC = WSP(float, WS_SC); int* IDS = WSP(int, WS_IDS); float* GATES = WSP(float, WS_GATES);
            const int l16 = lane & 15, rbase = lane & 48;
            int cq[4];
#pragma unroll
            for (int q = 0; q < 4; ++q) { int c = l16 + 16 * q, ci = -1, cj = 0; for (int i = 0; i < 16; ++i) { const int cnt = 16 / (i + 1); if (ci < 0) { if (c < cnt) { ci = i; cj = c; } else c -= cnt; } } cq[q] = ci < 0 ? -1 : ci * 16 + cj; }
            for (int row4 = gw * 4; row4 < MTOK * 8; row4 += NGW * 4) {
                const int row = row4 + (lane >> 4);
                const float* sc = SC + (size_t)row * 256 + l16;
                unsigned ka[8], kb[8];
#pragma unroll
                for (int jj = 0; jj < 8; ++jj) { ka[jj] = (okey(sc[jj * 16]) & ~127u) | (unsigned)(127 - (jj * 16 + l16)); kb[jj] = (okey(sc[128 + jj * 16]) & ~127u) | (unsigned)(127 - (jj * 16 + l16)); }
#define SORT8(k) do { CE_DESC(k[0], k[1]); CE_DESC(k[2], k[3]); CE_DESC(k[4], k[5]); CE_DESC(k[6], k[7]); CE_DESC(k[0], k[2]); CE_DESC(k[1], k[3]); CE_DESC(k[4], k[6]); CE_DESC(k[5], k[7]); \
    CE_DESC(k[1], k[2]); CE_DESC(k[5], k[6]); CE_DESC(k[0], k[4]); CE_DESC(k[3], k[7]); CE_DESC(k[1], k[5]); CE_DESC(k[2], k[6]); CE_DESC(k[1], k[4]); CE_DESC(k[3], k[6]); \
    CE_DESC(k[2], k[4]); CE_DESC(k[3], k[5]); CE_DESC(k[3], k[4]); } while (0)
                SORT8(ka); SORT8(kb);
                unsigned ta = 0u, tb = 0u;
#pragma unroll
                for (int r = 0; r < 16; ++r) {
                    const unsigned ma = row_max16_u(ka[0]), mb = row_max16_u(kb[0]);
                    const bool wa = ka[0] == ma, wb = kb[0] == mb;
                    ta = (l16 == r) ? ma : ta; tb = (l16 == r) ? mb : tb;
#pragma unroll
                    for (int q = 0; q < 7; ++q) { ka[q] = wa ? ka[q + 1] : ka[q]; kb[q] = wb ? kb[q + 1] : kb[q]; }
                    ka[7] = wa ? 0u : ka[7]; kb[7] = wb ? 0u : kb[7];
                }
                const int ia = 127 - (int)(ta & 127u), ib = 127 - (int)(tb & 127u);
                const float va = okey_inv(ta & ~127u), vb = okey_inv(tb & ~127u);
                unsigned ck[4];
#pragma unroll
                for (int q = 0; q < 4; ++q) { const int cc = cq[q] < 0 ? 0 : cq[q]; const float cs = bperm_f(va, rbase + (cc >> 4)) + bperm_f(vb, rbase + (cc & 15));
                    ck[q] = cq[q] < 0 ? 0u : ((okey(cs) & ~255u) | (unsigned)(255 - cc)); }
                CE_DESC(ck[0], ck[1]); CE_DESC(ck[2], ck[3]); CE_DESC(ck[0], ck[2]); CE_DESC(ck[1], ck[3]); CE_DESC(ck[1], ck[2]);
                unsigned tw = 0u;
#pragma unroll
                for (int r = 0; r < 16; ++r) { const unsigned mm = row_max16_u(ck[0]); const bool w = ck[0] == mm; tw = (l16 == r) ? mm : tw;
                    ck[0] = w ? ck[1] : ck[0]; ck[1] = w ? ck[2] : ck[1]; ck[2] = w ? ck[3] : ck[2]; ck[3] = w ? 0u : ck[3]; }
                const int code = 255 - (int)(tw & 255u), wi = (code >> 4) & 15, wj = code & 15;
                const float bs = bperm_f(va, rbase + wi) + bperm_f(vb, rbase + wj);
                const int eid = bperm_i(ia, rbase + wi) * 128 + bperm_i(ib, rbase + wj);
                const float mx = row_max16_f(bs), e = __expf(bs - mx), es = row_sum16(e);
                IDS[(size_t)row * 16 + l16] = eid; GATES[(size_t)row * 16 + l16] = e / es;
            }
#undef SORT8
        }
#endif
        GRID_BAR();

#if PH_L
#define L_LDIDS(I, tt, hh) do { const GAS v4u* ip_ = (const GAS v4u*)(IDS + (size_t)(tt) * 128 + (hh) * 64 + lrow * 16); I##0 = ip_[0]; I##1 = ip_[1]; I##2 = ip_[2]; I##3 = ip_[3]; } while (0)
#define L_ISSUE(W, I, base) do { \
    W[0] = *(const GAS v4u*)((base) + (size_t)(I##0).x * DM); W[1] = *(const GAS v4u*)((base) + (size_t)(I##0).y * DM); W[2] = *(const GAS v4u*)((base) + (size_t)(I##0).z * DM); W[3] = *(const GAS v4u*)((base) + (size_t)(I##0).w * DM); \
    W[4] = *(const GAS v4u*)((base) + (size_t)(I##1).x * DM); W[5] = *(const GAS v4u*)((base) + (size_t)(I##1).y * DM); W[6] = *(const GAS v4u*)((base) + (size_t)(I##1).z * DM); W[7] = *(const GAS v4u*)((base) + (size_t)(I##1).w * DM); \
    W[8] = *(const GAS v4u*)((base) + (size_t)(I##2).x * DM); W[9] = *(const GAS v4u*)((base) + (size_t)(I##2).y * DM); W[10] = *(const GAS v4u*)((base) + (size_t)(I##2).z * DM); W[11] = *(const GAS v4u*)((base) + (size_t)(I##2).w * DM); \
    W[12] = *(const GAS v4u*)((base) + (size_t)(I##3).x * DM); W[13] = *(const GAS v4u*)((base) + (size_t)(I##3).y * DM); W[14] = *(const GAS v4u*)((base) + (size_t)(I##3).z * DM); W[15] = *(const GAS v4u*)((base) + (size_t)(I##3).w * DM); } while (0)
#define L_CVT(d, hi) __builtin_amdgcn_cvt_pk_f32_fp8((int)(d), (hi))
        {
            PH_IDS();
            const bf16* H = WSP(bf16, WS_H); const unsigned char* U8 = WSP(unsigned char, WS_U); const int* IDS = WSP(int, WS_IDS); float* PART = WSP(float, WS_G);
            typedef float f32x2 __attribute__((ext_vector_type(2)));
            const int myx = (int)(xb_xcc_id() & 7u); int nx = 0, xi = 0, nloc = 1;
            for (int j = 0; j < 8; ++j) { const int c = (int)__hip_atomic_load(ctl + CW_XRANK + 64 * j, __ATOMIC_RELAXED, __HIP_MEMORY_SCOPE_AGENT); if (c > 0) { ++nx; if (j < myx) ++xi; } if (j == myx) nloc = c; }
            const int rw = (int)MISC[1] * NWAVES + wave, nW = nloc * NWAVES; const int l16 = lane & 15, lrow = lane >> 4;
#define L1_COMPUTE(W, dst) do { float sk[16]; _Pragma("unroll") for (int k = 0; k < 16; ++k) { const v4u ww = W[k]; const unsigned d0 = ww.x, d1 = ww.y, d2 = ww.z, d3 = ww.w; f32x2 s2; \
        s2 = L_CVT(d0, false) * hf[0]; s2 += L_CVT(d0, true) * hf[1]; s2 += L_CVT(d1, false) * hf[2]; s2 += L_CVT(d1, true) * hf[3]; \
        s2 += L_CVT(d2, false) * hf[4]; s2 += L_CVT(d2, true) * hf[5]; s2 += L_CVT(d3, false) * hf[6]; s2 += L_CVT(d3, true) * hf[7]; sk[k] = s2.x + s2.y; } \
          \
        float t8[8]; _Pragma("unroll") for (int j = 0; j < 8; ++j) { const float keep = b8 ? sk[8 + j] : sk[j], send = b8 ? sk[j] : sk[8 + j]; \
            t8[j] = keep + __int_as_float(__builtin_amdgcn_update_dpp(0, __float_as_int(send), 0x128, 0xF, 0xF, false)); } \
        float t4[4]; _Pragma("unroll") for (int j = 0; j < 4; ++j) { const float keep = b4 ? t8[4 + j] : t8[j], send = b4 ? t8[j] : t8[4 + j]; t4[j] = keep + sx_f<4>(send); } \
        float t2[2]; _Pragma("unroll") for (int j = 0; j < 2; ++j) { const float keep = b2 ? t4[2 + j] : t4[j], send = b2 ? t4[j] : t4[2 + j]; \
            t2[j] = keep + __int_as_float(__builtin_amdgcn_update_dpp(0, __float_as_int(send), 0x4E, 0xF, 0xF, false)); } \
        { const float keep = b1 ? t2[1] : t2[0], send = b1 ? t2[0] : t2[1]; dst = keep + __int_as_float(__builtin_amdgcn_update_dpp(0, __float_as_int(send), 0xB1, 0xF, 0xF, false)); } } while (0)
            const bool b8 = (lane & 8) != 0, b4 = (lane & 4) != 0, b2 = (lane & 2) != 0, b1 = (lane & 1) != 0;
            for (int sl = xi; sl < 8; sl += nx) {
                const unsigned char* ub = U8 + sl * 256 + l16 * 16; const bf16* hb = H + sl * 256 + l16 * 16;
                int t = rw;
                if (t < MTOK) {
                    v4u Wa[16], Wb[16]; v4u ia0, ia1, ia2, ia3, ib0, ib1, ib2, ib3; v4u h0, h1;
                    L_LDIDS(ia, t, 0); L_LDIDS(ib, t, 1); { const GAS v4u* hp = (const GAS v4u*)(hb + (size_t)t * DM); h0 = hp[0]; h1 = hp[1]; }
                    L_ISSUE(Wa, ia, ub);
                    for (;;) {
                        const int tn = t + nW; const bool more = tn < MTOK; const int tp = more ? tn : t;
                        L_ISSUE(Wb, ib, ub);
                        L_LDIDS(ia, tp, 0); v4u hn0, hn1; { const GAS v4u* hp = (const GAS v4u*)(hb + (size_t)tp * DM); hn0 = hp[0]; hn1 = hp[1]; }
                        f32x2 hf[8];
                        hf[0] = (f32x2){bflo(h0.x), bfhi(h0.x)}; hf[1] = (f32x2){bflo(h0.y), bfhi(h0.y)}; hf[2] = (f32x2){bflo(h0.z), bfhi(h0.z)}; hf[3] = (f32x2){bflo(h0.w), bfhi(h0.w)};
                        hf[4] = (f32x2){bflo(h1.x), bfhi(h1.x)}; hf[5] = (f32x2){bflo(h1.y), bfhi(h1.y)}; hf[6] = (f32x2){bflo(h1.z), bfhi(h1.z)}; hf[7] = (f32x2){bflo(h1.w), bfhi(h1.w)};
                        float pre0, pre1;
                        L1_COMPUTE(Wa, pre0);
                        L_ISSUE(Wa, ia, ub);
                        L_LDIDS(ib, tp, 1);
                        L1_COMPUTE(Wb, pre1);
                        float* pp = PART + ((size_t)sl * MTOK + t) * 128; pp[lane] = pre0; pp[64 + lane] = pre1;
                        h0 = hn0; h1 = hn1;
                        if (!more) break;
                        t = tn;
                    }
                }
            }
#undef L1_COMPUTE
        }
        GRID_BAR();
        {
            PH_IDS();
            const float* PART = WSP(float, WS_G); const float* GATES = WSP(float, WS_GATES); float* ACTW = WSP(float, WS_ACT);
            for (int t = gw; t < MTOK; t += NGW) {
                float q0 = 0.f, q1 = 0.f;
#pragma unroll
                for (int s8 = 0; s8 < 8; ++s8) { const float* pp = PART + ((size_t)s8 * MTOK + t) * 128; q0 += pp[lane]; q1 += pp[64 + lane]; }
                q0 *= (1.f / 1024.f); q1 *= (1.f / 1024.f);
                const float* gp = GATES + (size_t)t * 128; float* ap = ACTW + (size_t)t * 128;
                const float g0 = gp[lane], g1 = gp[64 + lane];
                ap[lane] = 0.5f * q0 * (1.0f + erff(q0 * 0.70710678118654752f)) * g0 * (1.f / 64.f); ap[64 + lane] = 0.5f * q1 * (1.0f + erff(q1 * 0.70710678118654752f)) * g1 * (1.f / 64.f);
            }
        }
        GRID_BAR();
        {
            PH_IDS();
            const unsigned char* V8 = WSP(unsigned char, WS_V); const int* IDS = WSP(int, WS_IDS); const float* ACT = WSP(float, WS_ACT);
            typedef float f32x2 __attribute__((ext_vector_type(2)));
            const int myx = (int)(xb_xcc_id() & 7u); int nx = 0, xi = 0, nloc = 1;
            for (int j = 0; j < 8; ++j) { const int c = (int)__hip_atomic_load(ctl + CW_XRANK + 64 * j, __ATOMIC_RELAXED, __HIP_MEMORY_SCOPE_AGENT); if (c > 0) { ++nx; if (j < myx) ++xi; } if (j == myx) nloc = c; }
            const int rw = (int)MISC[1] * NWAVES + wave, nW = nloc * NWAVES; const int l16 = lane & 15, lrow = lane >> 4;
#if DBG_MODE == 2
            float* XO = WSP(float, WS_OC);
#else
            float* XO = X;
#endif
#define L2_COMPUTE(W, acr) do { float av[16]; _Pragma("unroll") for (int k = 0; k < 16; ++k) av[k] = bperm_f(acr, (lane & 48) + k); \
        _Pragma("unroll") for (int k = 0; k < 16; ++k) { const float a = av[k]; const f32x2 aa = (f32x2){a, a}; \
        const v4u ww = W[k]; const unsigned d0 = ww.x, d1 = ww.y, d2 = ww.z, d3 = ww.w; \
        oacc[0] += aa * L_CVT(d0, false); oacc[1] += aa * L_CVT(d0, true); oacc[2] += aa * L_CVT(d1, false); oacc[3] += aa * L_CVT(d1, true); \
        oacc[4] += aa * L_CVT(d2, false); oacc[5] += aa * L_CVT(d2, true); oacc[6] += aa * L_CVT(d3, false); oacc[7] += aa * L_CVT(d3, true); } } while (0)
            for (int sl = xi; sl < 8; sl += nx) {
                const unsigned char* vb = V8 + sl * 256 + l16 * 16; float* xb = XO + sl * 256 + l16 * 16;
                int t = rw;
                if (t < MTOK) {
                    v4u Wa[16], Wb[16]; v4u ia0, ia1, ia2, ia3, ib0, ib1, ib2, ib3; float ac0, ac1;
                    L_LDIDS(ia, t, 0); L_LDIDS(ib, t, 1); ac0 = ACT[(size_t)t * 128 + lane]; ac1 = ACT[(size_t)t * 128 + 64 + lane];
                    L_ISSUE(Wa, ia, vb);
                    for (;;) {
                        const int tn = t + nW; const bool more = tn < MTOK; const int tp = more ? tn : t;
                        L_ISSUE(Wb, ib, vb);
                        L_LDIDS(ia, tp, 0); const float an0 = ACT[(size_t)tp * 128 + lane], an1 = ACT[(size_t)tp * 128 + 64 + lane];
                        f32x2 oacc[8];
#pragma unroll
                        for (int k = 0; k < 8; ++k) oacc[k] = (f32x2){0.f, 0.f};
                        L2_COMPUTE(Wa, ac0);
                        L_ISSUE(Wa, ia, vb);
                        L_LDIDS(ib, tp, 1);
                        f32x4 xv[4]; { const GAS f32x4* q = (const GAS f32x4*)(xb + (size_t)t * DM); xv[0] = q[0]; xv[1] = q[1]; xv[2] = q[2]; xv[3] = q[3]; }
                        L2_COMPUTE(Wb, ac1);
#pragma unroll
                        for (int k = 0; k < 8; ++k) { float a = oacc[k].x, b = oacc[k].y; a += sx_f<16>(a); b += sx_f<16>(b); a = add32(a); b = add32(b); oacc[k] = (f32x2){a, b}; }
                        if (lane < 16) { GAS f32x4* q = (GAS f32x4*)(xb + (size_t)t * DM);
#pragma unroll
                            for (int k = 0; k < 4; ++k) { f32x4 v = xv[k];
#if DBG_MODE == 2
                                v = (f32x4){0.f, 0.f, 0.f, 0.f};
#endif
                                v.x += oacc[2 * k].x; v.y += oacc[2 * k].y; v.z += oacc[2 * k + 1].x; v.w += oacc[2 * k + 1].y; q[k] = v; } }
                        ac0 = an0; ac1 = an1;
                        if (!more) break;
                        t = tn;
                    }
                }
            }
#undef L2_COMPUTE
        }
#undef L_LDIDS
#undef L_ISSUE
#undef L_CVT
#endif
        GRID_BAR();
    }

    { PH_IDS();
    for (int m = gw; m < MTOK; m += NGW) {
        GAS f32x4* xr = (GAS f32x4*)(X + (size_t)m * DM) + lane; const GAS f32x4* gr = (const GAS f32x4*)INP(2) + lane;
        f32x4 v[8]; float s = 0.f;
#pragma unroll
        for (int j = 0; j < 8; ++j) { v[j] = xr[64 * j]; s += (v[j].x * v[j].x + v[j].y * v[j].y) + (v[j].z * v[j].z + v[j].w * v[j].w); }
        const float rstd = 1.0f / sqrtf(wave_sum(s) * (1.f / DM) + RMS_EPS);
#pragma unroll
        for (int j = 0; j < 8; ++j) { const f32x4 gg = gr[64 * j]; xr[64 * j] = v[j] * rstd * gg; }
    } }
}

extern "C" void kernel_launch(void* const* d_in, const int* in_sizes, int n_in, void* d_out, int out_size, void* d_ws, size_t ws_size, hipStream_t stream) {
    static int grid = 0;
    if (grid == 0) {
        if (n_in != 17 || in_sizes[0] != MTOK * DM || out_size != MTOK * DM || ws_size < WS_END) {
            fprintf(stderr, "kernel_launch: shape/workspace mismatch: n_in %d in0 %d out %d ws %zu (need %zu); nothing launched\n", n_in, n_in > 0 ? in_sizes[0] : -1, out_size, ws_size, (size_t)WS_END); grid = -1; return; }
        int dev = 0, cus = 0, per_cu = 0;
        if (hipGetDevice(&dev) != hipSuccess || hipDeviceGetAttribute(&cus, hipDeviceAttributeMultiprocessorCount, dev) != hipSuccess) { grid = -1; return; }
        if (hipFuncSetAttribute((const void*)mk_fwd, hipFuncAttributeMaxDynamicSharedMemorySize, LDS_BYTES) != hipSuccess) { fprintf(stderr, "kernel_launch: hipFuncSetAttribute failed\n"); grid = -1; return; }
        if (hipOccupancyMaxActiveBlocksPerMultiprocessor(&per_cu, (const void*)mk_fwd, NWAVES * 64, LDS_BYTES) != hipSuccess || per_cu < 1)
            fprintf(stderr, "kernel_launch: note: occupancy query reports %d workgroups per CU\n", per_cu);
        (void)hipGetLastError();
        grid = cus;
    }
    if (grid < 0) return;
    if (hipMemsetAsync((char*)d_ws + WS_CTL, 0, CTL_ZERO_BYTES, stream) != hipSuccess) { fprintf(stderr, "kernel_launch: memset failed\n"); return; }
    Args a{};
    for (int i = 0; i < 17; ++i) a.in[i] = (const float*)d_in[i];
    a.out = (float*)d_out; a.ws = (unsigned char*)d_ws;
    hipLaunchKernelGGL(mk_fwd, dim3(grid), dim3(NWAVES * 64), LDS_BYTES, stream, a);
    const hipError_t le = hipPeekAtLastError();
    if (le != hipSuccess) fprintf(stderr, "kernel_launch: launch failed: %s\n", hipGetErrorName(le));
}
```

```cpp
#include <hip/hip_runtime.h>
#include <cstdio>
#include <cstdint>

#ifndef DBG_MODE
#define DBG_MODE 0
#endif
constexpr int DM = 2048, NB = 4, SEQ = 4096, MTOK = NB * SEQ;
constexpr int INW = 14336, PJW = 8192, GTW = 6144;
constexpr int COL_DIL = 512, COL_DIFF = 5120;
constexpr int NEXP = 16384;
constexpr float RMS_EPS = 1e-6f;

typedef unsigned short bf16;
#define GAS __attribute__((address_space(1)))
#define LAS __attribute__((address_space(3)))
typedef unsigned v4u __attribute__((ext_vector_type(4)));
typedef float f32x4 __attribute__((ext_vector_type(4)));
typedef GAS unsigned gu32;

__device__ __forceinline__ int opaque_tid(int wave_sgpr) { int l; asm volatile("v_mbcnt_lo_u32_b32 %0, -1, 0\n\tv_mbcnt_hi_u32_b32 %0, -1, %0" : "=v"(l)); return wave_sgpr * 64 + l; }
namespace pg8 {
#define PG8_LAS __attribute__((address_space(3)))
typedef unsigned short bf16_t;
typedef short bf16x8 __attribute__((ext_vector_type(8)));
typedef float f32x4 __attribute__((ext_vector_type(4)));
typedef unsigned u32x4 __attribute__((ext_vector_type(4)));
typedef int i32x4 __attribute__((ext_vector_type(4)));
typedef int i32x8 __attribute__((ext_vector_type(8)));
constexpr int BM = 256, BK = 64, HALF = 128, HTB = HALF * BK * 2, STAGE_BYTES = 8 * HTB, NXCD = 8, WGM = 8;

__host__ __device__ __forceinline__ int lds_byte(int r, int c) { const int st = (r >> 4) * 2 + (c >> 5), rr = r & 15, cc = c & 31, ob = rr * 64 + cc * 2; return st * 1024 + (ob ^ (((ob >> 9) & 1) << 5)); }
__host__ __device__ __forceinline__ void stage_rc(int b, int& R, int& C) { const int st = b / 1024, sb = b % 1024, swz = sb ^ (((sb >> 9) & 1) << 5); R = (st >> 1) * 16 + swz / 64; C = (st & 1) * 32 + (swz % 64) / 2; }
__host__ __device__ __forceinline__ int perm32(int rho) { const int n = rho >> 4, i = rho & 15; return 8 * (i >> 2) + 4 * n + (i & 3); }

struct Unit { int pm, pn; long aoff, boff; int orow, ocol, sub; };
struct Gemm { const bf16_t* A; const bf16_t* Bt; };

struct StaticOrder {
    int nM, nN, nwg, G, c; long sa, sb;
    __device__ void init(int M, int N, int G_, int c_, int lda, int ldb) { nM = M / BM; nN = N / BM; nwg = nM * nN; G = G_; c = c_; sa = 512L * lda; sb = 512L * ldb; }
    __device__ bool next(int i, Unit& u) const {
        const long L = (long)i * G + c; if (L >= nwg) return false;
        int wgid = (int)L; { const int q = nwg / NXCD, r = nwg % NXCD, xcd = wgid % NXCD, off = wgid / NXCD; wgid = (xcd < r ? xcd * (q + 1) : r * (q + 1) + (xcd - r) * q) + off; }
        const int nig = WGM * nN, gid = wgid / nig, fm = gid * WGM, gsz = (nM - fm) < WGM ? (nM - fm) : WGM;
        u.pm = fm + ((wgid % nig) % gsz); u.pn = (wgid % nig) / gsz;
        u.aoff = u.pm * sa; u.boff = u.pn * sb; u.orow = u.pm * BM; u.ocol = u.pn * BM; u.sub = 0; return true;
    }
};
struct MergeOrder : StaticOrder {
    __device__ bool next(int i, Unit& u) const { if (!StaticOrder::next(i >> 2, u)) return false; u.sub = i & 3; u.aoff += 1024L * u.sub; u.boff += 1024L * u.sub; return true; }
};
struct F2Order : StaticOrder {
    __device__ bool next(int i, Unit& u) const { if (!StaticOrder::next(i, u)) return false; u.orow = (u.pn >> 1) * 4096 + u.pm * BM; u.ocol = (u.pn & 1) * BM; return true; }
};
struct F1Order {
    int G, c;
    __device__ bool next(int i, Unit& u) const {
        const int idx = i * G + c; if (idx >= 256) return false;
        const int bg = idx >> 4, st = idx & 15, b = bg >> 2, g = bg & 3;
        u.pm = 0; u.pn = idx; u.aoff = 0; u.boff = ((long)(b * 4096 + st * 256) * PJW + g * 128) * 2; u.orow = bg * 128; u.ocol = st * 256; return true;
    }
};

__device__ __forceinline__ unsigned cvt_pk_bf16(float lo, float hi) { unsigned r; asm volatile("v_cvt_pk_bf16_f32 %0, %1, %2" : "=v"(r) : "v"(lo), "v"(hi)); return r; }
__device__ __forceinline__ float bf_lo(unsigned w) { return __uint_as_float(w << 16); }
__device__ __forceinline__ float bf_hi(unsigned w) { return __uint_as_float(w & 0xffff0000u); }

#define PG8_PACK(v0, v1, w) do { (w).x = cvt_pk_bf16((v0)[0], (v0)[1]); (w).y = cvt_pk_bf16((v0)[2], (v0)[3]); (w).z = cvt_pk_bf16((v1)[0], (v1)[1]); (w).w = cvt_pk_bf16((v1)[2], (v1)[3]); } while (0)

struct EpiStore {
    static constexpr bool PERM = true;
    bf16_t* O; int ldo;
    __device__ __forceinline__ bool operator()(f32x4 (&acc)[2][2][4][2], const Unit& u, int wr, int wc, int fr, int fq) const {
        const int row0 = u.orow + wr * 64 + fr, col0 = u.ocol + wc * 32 + 8 * fq;
#pragma unroll
        for (int ai = 0; ai < 2; ++ai)
#pragma unroll
            for (int m = 0; m < 4; ++m) { bf16_t* rowp = O + (size_t)(row0 + ai * HALF + m * 16) * ldo + col0;
#pragma unroll
                for (int bj = 0; bj < 2; ++bj) { u32x4 w; PG8_PACK(acc[ai][bj][m][0], acc[ai][bj][m][1], w); *(u32x4*)(rowp + bj * HALF) = w; } }
        return true;
    }
};
struct EpiZT {
    static constexpr bool PERM = true;
    bf16_t* O;
    __device__ __forceinline__ bool operator()(f32x4 (&acc)[2][2][4][2], const Unit& u, int wr, int wc, int fr, int fq) const {
        const int row0 = u.orow + wr * 64 + fr, col0 = u.ocol + wc * 32 + 8 * fq;
#pragma unroll
        for (int ai = 0; ai < 2; ++ai)
#pragma unroll
            for (int m = 0; m < 4; ++m) { bf16_t* rowp = O + (size_t)(row0 + m * 16) * 8192 + ai * 4096 + col0;
#pragma unroll
                for (int bj = 0; bj < 2; ++bj) { u32x4 w; PG8_PACK(acc[ai][bj][m][0], acc[ai][bj][m][1], w); *(u32x4*)(rowp + bj * HALF) = w; } }
        return true;
    }
};
struct EpiProj {
    static constexpr bool PERM = true;
    bf16_t* P; bf16_t* Gt; const float* bg; int pnoff; float scale;
    __device__ __forceinline__ bool operator()(f32x4 (&acc)[2][2][4][2], const Unit& u, int wr, int wc, int fr, int fq) const {
        const int pnn = u.pn + pnoff; const bool isg = pnn >= 32;
        const int row0 = u.pm * BM + wr * 64 + fr, col0 = (isg ? pnn - 32 : pnn) * BM + wc * 32 + 8 * fq, ldc = isg ? GTW : PJW;
        bf16_t* base = isg ? Gt : P;
        f32x4 bv[2][2];
#pragma unroll
        for (int bj = 0; bj < 2; ++bj)
#pragma unroll
            for (int n = 0; n < 2; ++n) bv[bj][n] = isg ? *(const f32x4*)(bg + col0 + bj * HALF + 4 * n) : (f32x4){0.f, 0.f, 0.f, 0.f};
#pragma unroll
        for (int ai = 0; ai < 2; ++ai)
#pragma unroll
            for (int m = 0; m < 4; ++m) { bf16_t* rowp = base + (size_t)(row0 + ai * HALF + m * 16) * ldc + col0;
#pragma unroll
                for (int bj = 0; bj < 2; ++bj) { f32x4 v0 = acc[ai][bj][m][0] * scale + bv[bj][0], v1 = acc[ai][bj][m][1] * scale + bv[bj][1];
                    if (isg) {
#pragma unroll
                        for (int j = 0; j < 4; ++j) { v0[j] = __builtin_amdgcn_rcpf(1.0f + __builtin_amdgcn_exp2f(-1.4426950408889634f * v0[j])); v1[j] = __builtin_amdgcn_rcpf(1.0f + __builtin_amdgcn_exp2f(-1.4426950408889634f * v1[j])); } }
                    u32x4 w; PG8_PACK(v0, v1, w); *(u32x4*)(rowp + bj * HALF) = w; } }
        return true;
    }
};
struct EpiMerge4 {
    static constexpr bool PERM = true;
    const bf16_t* Gt; bf16_t* O;
    __device__ __forceinline__ bool operator()(f32x4 (&acc)[2][2][4][2], const Unit& u, int wr, int wc, int fr, int fq) const {
        const int row0 = u.pm * BM + wr * 64 + fr, col0 = u.pn * BM + wc * 32 + 8 * fq;
        if (u.sub == 2) return false;
        if (u.sub < 2) {
#pragma unroll
            for (int ai = 0; ai < 2; ++ai)
#pragma unroll
                for (int m = 0; m < 4; ++m) { const bf16_t* gp = Gt + (size_t)(row0 + ai * HALF + m * 16) * GTW + u.sub * DM + col0;
#pragma unroll
                    for (int bj = 0; bj < 2; ++bj) { const u32x4 gn = *(const u32x4*)(gp + bj * HALF), gd = *(const u32x4*)(gp + DM + bj * HALF);
                        f32x4 r0, r1;
                        r0[0] = bf_lo(gn.x) * __builtin_amdgcn_rcpf(bf_lo(gd.x)); r0[1] = bf_hi(gn.x) * __builtin_amdgcn_rcpf(bf_hi(gd.x));
                        r0[2] = bf_lo(gn.y) * __builtin_amdgcn_rcpf(bf_lo(gd.y)); r0[3] = bf_hi(gn.y) * __builtin_amdgcn_rcpf(bf_hi(gd.y));
                        r1[0] = bf_lo(gn.z) * __builtin_amdgcn_rcpf(bf_lo(gd.z)); r1[1] = bf_hi(gn.z) * __builtin_amdgcn_rcpf(bf_hi(gd.z));
                        r1[2] = bf_lo(gn.w) * __builtin_amdgcn_rcpf(bf_lo(gd.w)); r1[3] = bf_hi(gn.w) * __builtin_amdgcn_rcpf(bf_hi(gd.w));
                        acc[ai][bj][m][0] *= r0; acc[ai][bj][m][1] *= r1; }
                    asm volatile("" ::: "memory"); }
            return false;
        }
#pragma unroll
        for (int ai = 0; ai < 2; ++ai)
#pragma unroll
            for (int m = 0; m < 4; ++m) { const bf16_t* gp = Gt + (size_t)(row0 + ai * HALF + m * 16) * GTW + 2 * DM + col0; bf16_t* rowp = O + (size_t)(row0 + ai * HALF + m * 16) * DM + col0;
#pragma unroll
                for (int bj = 0; bj < 2; ++bj) { const u32x4 g = *(const u32x4*)(gp + bj * HALF);
                    f32x4 v0 = acc[ai][bj][m][0], v1 = acc[ai][bj][m][1];
                    v0[0] *= bf_lo(g.x); v0[1] *= bf_hi(g.x); v0[2] *= bf_lo(g.y); v0[3] *= bf_hi(g.y);
                    v1[0] *= bf_lo(g.z); v1[1] *= bf_hi(g.z); v1[2] *= bf_lo(g.w); v1[3] *= bf_hi(g.w);
                    u32x4 w; PG8_PACK(v0, v1, w); *(u32x4*)(rowp + bj * HALF) = w; }
                asm volatile("" ::: "memory"); }
        return true;
    }
};
struct EpiResF32 {
    static constexpr bool PERM = false;
    const float* base; float* out; int ldc;
    __device__ __forceinline__ bool operator()(f32x4 (&acc)[2][2][4][2], const Unit& u, int wr, int wc, int fr, int fq) const {
        const int row0 = u.orow + wr * 64 + fr, col0 = u.ocol + wc * 32 + 4 * fq;
#pragma unroll
        for (int ai = 0; ai < 2; ++ai)
#pragma unroll
            for (int m = 0; m < 4; ++m) { const size_t off = (size_t)(row0 + ai * HALF + m * 16) * ldc + col0;
#pragma unroll
                for (int bj = 0; bj < 2; ++bj)
#pragma unroll
                    for (int n = 0; n < 2; ++n) { f32x4 v = acc[ai][bj][m][n]; if (base) v += *(const f32x4*)(base + off + bj * HALF + n * 16); *(f32x4*)(out + off + bj * HALF + n * 16) = v; }
                asm volatile("" ::: "memory"); }
        return true;
    }
};

template <class Epi, class Sched, bool ALIGN_EPI, int LDA, int LDB, int KK, bool F8 = false>
__device__ __forceinline__ void gemm_phase(PG8_LAS unsigned char* lds, const Gemm g, const Sched& S, const Epi& E, int wave0) {
    const int tid = opaque_tid(wave0), wid = wave0, lane = tid & 63, wr = wid >> 2, wc = wid & 3, fr = lane & 15, fq = lane >> 4;
    constexpr int nt = KK / BK;
    unsigned voffA[2], voffB[2];
#pragma unroll
    for (int i = 0; i < 2; ++i) { int R, C; stage_rc(tid * 16 + i * 8192, R, C); const int Rb = Epi::PERM ? ((R & ~31) + perm32(R & 31)) : R;
        voffA[i] = (unsigned)(R * LDA + C) * 2u; voffB[i] = (unsigned)(Rb * LDB + C) * 2u; }
    const size_t kstep = (size_t)(BK * 2);
    constexpr size_t hstepA = (size_t)HALF * LDA * 2, hstepB = (size_t)HALF * LDB * 2;
    const unsigned ldsw = (unsigned)wid * 1024u;
    const int aoff = lds_byte(wr * 64 + fr, fq * 8), boff = lds_byte(wc * 32 + fr, fq * 8);
#define PG8_SA(b, h) (((b) * 2 + (h)) * HTB)
#define PG8_SB(b, h) ((4 + (b) * 2 + (h)) * HTB)
#define PG8_STAGE(bufoff, gbase, voff) do { _Pragma("unroll") for (int _i = 0; _i < 2; ++_i) \
        __builtin_amdgcn_global_load_lds((const unsigned*)((const char*)(gbase) + (voff)[_i]), (PG8_LAS unsigned*)(lds + (bufoff) + ldsw + _i * 8192), 16, 0, 0); } while (0)
#define PG8_LDA(dst, b, h) do { _Pragma("unroll") for (int m = 0; m < 4; ++m) _Pragma("unroll") for (int k = 0; k < 2; ++k) dst[m][k] = *(const PG8_LAS bf16x8*)(lds + PG8_SA(b, h) + aoff + m * 2048 + k * 1024); } while (0)
#define PG8_LDB(dst, b, h) do { _Pragma("unroll") for (int n = 0; n < 2; ++n) _Pragma("unroll") for (int k = 0; k < 2; ++k) dst[n][k] = *(const PG8_LAS bf16x8*)(lds + PG8_SB(b, h) + boff + n * 2048 + k * 1024); } while (0)
#define PG8_CAT(x) __builtin_shufflevector(__builtin_bit_cast(i32x4, (x)[0]), __builtin_bit_cast(i32x4, (x)[1]), 0, 1, 2, 3, 4, 5, 6, 7)
#define PG8_MMA(ai, bj, At, Bt) do { __builtin_amdgcn_s_setprio(1); _Pragma("unroll") for (int m = 0; m < 4; ++m) _Pragma("unroll") for (int n = 0; n < 2; ++n) { \
        if constexpr (F8) { const i32x8 a8_ = PG8_CAT(Bt[n]), b8_ = PG8_CAT(At[m]); asm volatile("v_mfma_scale_f32_16x16x128_f8f6f4 %0, %1, %2, %0, %3, %3 op_sel_hi:[0,0,0]" : "+v"(acc[ai][bj][m][n]) : "v"(a8_), "v"(b8_), "v"(one8)); } \
        else { _Pragma("unroll") for (int k = 0; k < 2; ++k) acc[ai][bj][m][n] = __builtin_amdgcn_mfma_f32_16x16x32_bf16(Bt[n][k], At[m][k], acc[ai][bj][m][n], 0, 0, 0); } } __builtin_amdgcn_s_setprio(0); } while (0)
#define PG8_WAIT_V(n) asm volatile("s_waitcnt vmcnt(" #n ")" ::: "memory")
#define PG8_WAIT_L(n) asm volatile("s_waitcnt lgkmcnt(" #n ")" ::: "memory")
#define PG8_BAR __builtin_amdgcn_s_barrier()
#define PG8_SCHED __builtin_amdgcn_sched_barrier(0)
    Unit cur, nxt; int ui = 0;
    if (!S.next(0, cur)) return;
    const int one8 = 0x7f7f7f7f; (void)one8;
    f32x4 acc[2][2][4][2];
#pragma unroll
    for (int a = 0; a < 2; ++a)
#pragma unroll
        for (int b = 0; b < 2; ++b)
#pragma unroll
            for (int m = 0; m < 4; ++m)
#pragma unroll
                for (int n = 0; n < 2; ++n) acc[a][b][m][n] = (f32x4){0.f, 0.f, 0.f, 0.f};
    bf16x8 At[4][2], B0[2][2], B1[2][2];
    const char* cA = (const char*)g.A + cur.aoff; const char* cB = (const char*)g.Bt + cur.boff;
    PG8_STAGE(PG8_SB(0, 0), cB, voffB); PG8_STAGE(PG8_SB(0, 1), cB + hstepB, voffB); PG8_STAGE(PG8_SA(0, 0), cA, voffA); PG8_STAGE(PG8_SA(0, 1), cA + hstepA, voffA);
    if (wr == 1) PG8_BAR;
    PG8_WAIT_V(2); PG8_BAR;
    PG8_STAGE(PG8_SB(1, 0), cB + kstep, voffB); PG8_STAGE(PG8_SA(1, 0), cA + kstep, voffA); PG8_STAGE(PG8_SB(1, 1), cB + hstepB + kstep, voffB);
    PG8_WAIT_V(6); PG8_BAR;
    for (;;) {
        const bool has_next = S.next(ui + 1, nxt);
        const char* nA = has_next ? (const char*)g.A + nxt.aoff : cA; const char* nB = has_next ? (const char*)g.Bt + nxt.boff : cB;
        for (int t = 0; t < nt; t += 2) {
            const bool last = (t == nt - 2);
            const char* a1 = cA + (size_t)(t + 1) * kstep;
            const char* a2 = last ? nA : cA + (size_t)(t + 2) * kstep; const char* b2 = last ? nB : cB + (size_t)(t + 2) * kstep;
            const char* a3 = a2 + kstep; const char* b3 = b2 + kstep;
            PG8_LDB(B0, 0, 0); PG8_LDB(B1, 0, 1); PG8_SCHED; PG8_LDA(At, 0, 0); PG8_STAGE(PG8_SA(1, 1), a1 + hstepA, voffA);
            PG8_WAIT_V(8); PG8_WAIT_L(0); PG8_BAR; PG8_MMA(0, 0, At, B0); PG8_MMA(0, 1, At, B1); PG8_BAR; PG8_SCHED;
            PG8_LDA(At, 0, 1); PG8_STAGE(PG8_SB(0, 0), b2, voffB); PG8_STAGE(PG8_SB(0, 1), b2 + hstepB, voffB); PG8_STAGE(PG8_SA(0, 0), a2, voffA);
            PG8_WAIT_V(8); PG8_WAIT_L(0); PG8_BAR; PG8_MMA(1, 0, At, B0); PG8_MMA(1, 1, At, B1); PG8_BAR; PG8_SCHED;
            PG8_LDB(B0, 1, 0); PG8_LDB(B1, 1, 1); PG8_SCHED; PG8_LDA(At, 1, 0); PG8_STAGE(PG8_SA(0, 1), a2 + hstepA, voffA);
            PG8_WAIT_V(8); PG8_WAIT_L(0); PG8_BAR; PG8_MMA(0, 0, At, B0); PG8_MMA(0, 1, At, B1); PG8_BAR; PG8_SCHED;
            PG8_LDA(At, 1, 1); PG8_STAGE(PG8_SB(1, 0), b3, voffB); PG8_STAGE(PG8_SB(1, 1), b3 + hstepB, voffB); PG8_STAGE(PG8_SA(1, 0), a3, voffA);
            PG8_WAIT_V(8); PG8_WAIT_L(0); PG8_BAR; PG8_MMA(1, 0, At, B0); PG8_MMA(1, 1, At, B1); PG8_BAR; PG8_SCHED;
        }
        if constexpr (ALIGN_EPI) { if (wr == 0) PG8_BAR; }
        if constexpr (F8) asm volatile("s_nop 15\n\ts_nop 15" ::: "memory");
        const bool fin = E(acc, cur, wr, wc, fr, fq);
        if (!has_next) break;
        if (fin) {
#pragma unroll
        for (int a = 0; a < 2; ++a)
#pragma unroll
            for (int b = 0; b < 2; ++b)
#pragma unroll
                for (int m = 0; m < 4; ++m)
#pragma unroll
                    for (int n = 0; n < 2; ++n) acc[a][b][m][n] = (f32x4){0.f, 0.f, 0.f, 0.f};
        }
        cur = nxt; cA = nA; cB = nB; ++ui;
        if constexpr (ALIGN_EPI) { if (wr == 1) PG8_BAR; }
    }
    PG8_WAIT_V(0);
    if constexpr (!ALIGN_EPI) { if (wr == 0) PG8_BAR; }
    PG8_BAR;
#undef PG8_SA
#undef PG8_SB
#undef PG8_STAGE
#undef PG8_LDA
#undef PG8_LDB
#undef PG8_MMA
#undef PG8_CAT
#undef PG8_WAIT_V
#undef PG8_WAIT_L
#undef PG8_BAR
#undef PG8_SCHED
}
}

namespace attn {
using bf16x8 = __attribute__((ext_vector_type(8))) short;
using s16x4  = __attribute__((ext_vector_type(4))) short;
using f32x16 = __attribute__((ext_vector_type(16))) float;
using u32x4  = __attribute__((ext_vector_type(4))) unsigned;
constexpr int   D = 128, NW = 8, QBLK = 32, KVBLK = 64;
constexpr float SCALE = 0.088388347648318440f;
constexpr float THR = 8.f;
constexpr size_t SHM_V = KVBLK * D * 2, SHM_K = KVBLK * D * 2;
constexpr int LDS_WS = 2 * SHM_V + 2 * SHM_K, LDS_TAB = LDS_WS + NW * 64 * 4, LDS_END = LDS_TAB + 8192 * 4;
#define KSWZ(row, colB) ((row) * 256 + ((colB) ^ (((row) & 7) << 4)))
#define SBAR() __builtin_amdgcn_sched_barrier(0)
__device__ __forceinline__ int crow(int r, int hi) { return (r & 3) + 8 * (r >> 2) + 4 * hi; }
__device__ __forceinline__ unsigned cvtpk(float lo, float hi) { unsigned r; asm volatile("v_cvt_pk_bf16_f32 %0, %1, %2" : "=v"(r) : "v"(lo), "v"(hi)); return r; }

__device__ __forceinline__ void partialSM(f32x16& p0, f32x16& p1, float& m_reg, float& mn, float& alpha) {
  constexpr float C = SCALE * 1.4426950408889634f;
  float pmax = p0[0]; for (int r = 1; r < 16; ++r) pmax = fmaxf(pmax, p0[r]); for (int r = 0; r < 16; ++r) pmax = fmaxf(pmax, p1[r]);
  { auto rr = __builtin_amdgcn_permlane32_swap(__float_as_uint(pmax), __float_as_uint(pmax), false, false);
    pmax = fmaxf(__uint_as_float(rr[0]), __uint_as_float(rr[1])); }
  if (__builtin_expect(__all(pmax - m_reg <= THR / SCALE), 1)) { mn = m_reg; alpha = 1.f; }
  else { mn = fmaxf(m_reg, pmax); alpha = __builtin_amdgcn_exp2f((m_reg - mn) * C); m_reg = mn; }
  float mnC = -mn * C;
  for (int r = 0; r < 16; ++r) p0[r] = fmaf(p0[r], C, mnC); for (int r = 0; r < 16; ++r) p1[r] = fmaf(p1[r], C, mnC);
  for (int r = 0; r < 16; ++r) p0[r] = __builtin_amdgcn_exp2f(p0[r]);
}
__device__ __forceinline__ void finishSM(f32x16& p0, f32x16& p1, float alpha, float& l_reg, bf16x8& pa0, bf16x8& pa1, bf16x8& pa2, bf16x8& pa3) {
  for (int r = 0; r < 16; ++r) p1[r] = __builtin_amdgcn_exp2f(p1[r]);
  float ps = 0; for (int r = 0; r < 16; ++r) ps += p0[r]; for (int r = 0; r < 16; ++r) ps += p1[r];
  { auto rr = __builtin_amdgcn_permlane32_swap(__float_as_uint(ps), __float_as_uint(ps), false, false);
    ps = __uint_as_float(rr[0]) + __uint_as_float(rr[1]); }
  l_reg = l_reg * alpha + ps;
#define PK4(P, BASE, OUT) do { unsigned a0 = cvtpk(P[BASE + 0], P[BASE + 1]), a1 = cvtpk(P[BASE + 2], P[BASE + 3]);   \
    unsigned b0 = cvtpk(P[BASE + 4], P[BASE + 5]), b1 = cvtpk(P[BASE + 6], P[BASE + 7]);                              \
    auto r0 = __builtin_amdgcn_permlane32_swap(a0, b0, false, false); auto r1 = __builtin_amdgcn_permlane32_swap(a1, b1, false, false); \
    u32x4 w = {r0[0], r1[0], r0[1], r1[1]}; OUT = *reinterpret_cast<bf16x8*>(&w); } while (0)
  PK4(p0, 0, pa0); PK4(p0, 8, pa1); PK4(p1, 0, pa2); PK4(p1, 8, pa3);
#undef PK4
}
__device__ __forceinline__ void qkt(f32x16& p0, f32x16& p1, const bf16* Ks, const bf16x8* qr, int r32, int hi, const float* tl) {
#pragma unroll
  for (int r = 0; r < 16; ++r) { p0[r] = tl[(r & 3) + 8 * (r >> 2)]; p1[r] = tl[32 + (r & 3) + 8 * (r >> 2)]; }
#pragma unroll
  for (int d0 = 0; d0 < 8; ++d0) { int cb = (d0 * 16 + hi * 8) * 2;
    bf16x8 b0 = *reinterpret_cast<const bf16x8*>((const char*)Ks + KSWZ(r32, cb));
    bf16x8 b1 = *reinterpret_cast<const bf16x8*>((const char*)Ks + KSWZ(32 + r32, cb));
    p0 = __builtin_amdgcn_mfma_f32_32x32x16_bf16(b0, qr[d0], p0, 0, 0, 0);
    p1 = __builtin_amdgcn_mfma_f32_32x32x16_bf16(b1, qr[d0], p1, 0, 0, 0); }
}
__device__ __forceinline__ int v_st(int k, int c) { const int kk = (k & ~0xC) | ((k & 4) << 1) | ((k & 8) >> 1); return ((kk >> 3) * 4 + (c >> 5)) * 512 + ((kk & 7) * 32 + (c & 31)) * 2; }
__device__ __forceinline__ int v_rd_base(int lane) { return ((lane & 3) << 3) | (((lane >> 2) & 3) << 6) | (((lane >> 4) & 1) << 5) | (((lane >> 5) & 1) << 8); }
constexpr int v_rd_off(int d0, int ks, int half) { return d0 * 512 + ks * 4096 + half * 2048; }
template <int OFF> __device__ __forceinline__ s16x4 tr_read(int vb) {
  s16x4 r; asm volatile("ds_read_b64_tr_b16 %0, %1 offset:%2" : "=&v"(r) : "v"(vb), "i"(OFF) : "memory"); return r;
}
template <int D0> __device__ __forceinline__ void pv_one(f32x16& od, int vb, bf16x8 pa0, bf16x8 pa1, bf16x8 pa2, bf16x8 pa3) {
  const s16x4 l0 = tr_read<v_rd_off(D0, 0, 0)>(vb), h0 = tr_read<v_rd_off(D0, 0, 1)>(vb), l1 = tr_read<v_rd_off(D0, 1, 0)>(vb), h1 = tr_read<v_rd_off(D0, 1, 1)>(vb);
  const s16x4 l2 = tr_read<v_rd_off(D0, 2, 0)>(vb), h2 = tr_read<v_rd_off(D0, 2, 1)>(vb), l3 = tr_read<v_rd_off(D0, 3, 0)>(vb), h3 = tr_read<v_rd_off(D0, 3, 1)>(vb);
  asm volatile("s_waitcnt lgkmcnt(0)" ::: "memory"); SBAR();
#define PK(L, H) (bf16x8){L[0], L[1], L[2], L[3], H[0], H[1], H[2], H[3]}
  od = __builtin_amdgcn_mfma_f32_32x32x16_bf16(pa0, PK(l0, h0), od, 0, 0, 0);
  od = __builtin_amdgcn_mfma_f32_32x32x16_bf16(pa1, PK(l1, h1), od, 0, 0, 0);
  od = __builtin_amdgcn_mfma_f32_32x32x16_bf16(pa2, PK(l2, h2), od, 0, 0, 0);
  od = __builtin_amdgcn_mfma_f32_32x32x16_bf16(pa3, PK(l3, h3), od, 0, 0, 0);
#undef PK
}
__device__ __forceinline__ void pv_d0(f32x16* o, int vb, bf16x8 pa0, bf16x8 pa1, bf16x8 pa2, bf16x8 pa3) {
  pv_one<0>(o[0], vb, pa0, pa1, pa2, pa3); pv_one<1>(o[1], vb, pa0, pa1, pa2, pa3); pv_one<2>(o[2], vb, pa0, pa1, pa2, pa3); pv_one<3>(o[3], vb, pa0, pa1, pa2, pa3);
}

struct Unit { const bf16* Q; const bf16* K; const bf16* V; bf16* O; float* lse; long ldq, ldk, ldo; int lse_ld, kt0, nt, qoff; };
__device__ __forceinline__ void attn_unit(const Unit& u, char* lds, int wave0) {
  const int tid = opaque_tid(wave0), wid = wave0, lane = tid & 63, r32 = lane & 31, hi = lane >> 5;
  bf16* V_lds = (bf16*)lds; bf16* K_lds = (bf16*)(lds + 2 * SHM_V);
  float* ws = (float*)(lds + LDS_WS) + wid * 64; float* li_l = ws; float* al_l = ws + 32;
  const float* tabL = (const float*)(lds + LDS_TAB);
  float m_reg = -1e30f, l_reg = 0; f32x16 o[4] = {}; bf16x8 qr[8];
  const bf16* Qw = u.Q + (long)(wid * QBLK + r32) * u.ldq + hi * 8;
#pragma unroll
  for (int d0 = 0; d0 < 8; ++d0) qr[d0] = *reinterpret_cast<const bf16x8*>(Qw + d0 * 16);
  const int sr = tid >> 4, sc = (tid & 15) * 8, vst0 = v_st(sr, sc), vst1 = v_st(32 + sr, sc);
  const int vb0 = (int)(uintptr_t)V_lds + v_rd_base(lane);
  const long tstep = (long)KVBLK * u.ldk * 2;
  const char* Kh = (const char*)u.K + (long)u.kt0 * tstep; const char* Vh = (const char*)u.V + (long)u.kt0 * tstep;
  const unsigned lo0 = (unsigned)((sr * (int)u.ldk + sc) * 2), lo1 = lo0 + (unsigned)(32 * (int)u.ldk * 2);
  const float* tl0 = tabL + (4096 + u.kt0 * KVBLK + 4 * hi - (u.qoff + wid * QBLK + r32));
  struct { bf16x8 vs0, vs1, ks0, ks1; } sr_[2];
#define SLOAD(i, tj) do { const char* vt_ = Vh + (long)(tj) * tstep; const char* kt_ = Kh + (long)(tj) * tstep; \
    sr_[i].vs0 = *reinterpret_cast<const bf16x8*>(vt_ + lo0); sr_[i].vs1 = *reinterpret_cast<const bf16x8*>(vt_ + lo1); \
    sr_[i].ks0 = *reinterpret_cast<const bf16x8*>(kt_ + lo0); sr_[i].ks1 = *reinterpret_cast<const bf16x8*>(kt_ + lo1); } while (0)
#define SWRITE(b, i) do { *(bf16x8*)((char*)V_lds + (b) * SHM_V + vst0) = sr_[i].vs0;          \
    *(bf16x8*)((char*)V_lds + (b) * SHM_V + vst1) = sr_[i].vs1; int kc = sc * 2;               \
    *(bf16x8*)((char*)K_lds + (b) * SHM_K + KSWZ(sr, kc)) = sr_[i].ks0;                       \
    *(bf16x8*)((char*)K_lds + (b) * SHM_K + KSWZ(32 + sr, kc)) = sr_[i].ks1; } while (0)
#define SWAIT() asm volatile("s_waitcnt vmcnt(4)" ::: "memory")
#define RESC(a) do { if (__any((a) < 1.f)) { if (hi == 0) al_l[r32] = (a); asm volatile("s_waitcnt lgkmcnt(0)" ::: "memory"); \
    for (int d = 0; d < 4; ++d) for (int r = 0; r < 16; ++r) o[d][r] *= al_l[crow(r, hi)]; } } while (0)
  f32x16 pA0, pA1, pB0, pB1; float mnA, mnB, alA, alB; bf16x8 pa0, pa1, pa2, pa3; const int NT = u.nt;
  constexpr int SE = 0, SO = 1;
  SLOAD(SE, 0); asm volatile("s_waitcnt vmcnt(0)" ::: "memory"); SWRITE(0, SE); __syncthreads();
  qkt(pA0, pA1, K_lds, qr, r32, hi, tl0); partialSM(pA0, pA1, m_reg, mnA, alA);
  SLOAD(SO, 1); if (2 < NT) SLOAD(SE, 2);
  SWAIT(); SWRITE(1, SO); __syncthreads();
  for (int j = 1; j + 1 < NT; j += 2) {
    SBAR(); qkt(pB0, pB1, (bf16*)((char*)K_lds + SHM_K), qr, r32, hi, tl0 + j * KVBLK);
    finishSM(pA0, pA1, alA, l_reg, pa0, pa1, pa2, pa3); SBAR();
    SLOAD(SO, j + 2); SBAR();
    pv_d0(o, vb0, pa0, pa1, pa2, pa3); partialSM(pB0, pB1, m_reg, mnB, alB);
    __syncthreads(); SWAIT(); SWRITE(0, SE);
    RESC(alB); __syncthreads();
    SBAR(); qkt(pA0, pA1, K_lds, qr, r32, hi, tl0 + (j + 1) * KVBLK);
    finishSM(pB0, pB1, alB, l_reg, pa0, pa1, pa2, pa3); SBAR();
    if (j + 3 < NT) SLOAD(SE, j + 3); SBAR();
    pv_d0(o, vb0 + (int)SHM_V, pa0, pa1, pa2, pa3); partialSM(pA0, pA1, m_reg, mnA, alA);
    __syncthreads(); SWAIT(); SWRITE(1, SO);
    RESC(alA); __syncthreads();
  }
  SBAR(); qkt(pB0, pB1, (bf16*)((char*)K_lds + SHM_K), qr, r32, hi, tl0 + (NT - 1) * KVBLK);
  finishSM(pA0, pA1, alA, l_reg, pa0, pa1, pa2, pa3); SBAR();
  pv_d0(o, vb0, pa0, pa1, pa2, pa3); partialSM(pB0, pB1, m_reg, mnB, alB);
  __syncthreads(); RESC(alB);
  finishSM(pB0, pB1, alB, l_reg, pa0, pa1, pa2, pa3); SBAR();
  pv_d0(o, vb0 + (int)SHM_V, pa0, pa1, pa2, pa3);
  if (hi == 0) li_l[r32] = l_reg; asm volatile("s_waitcnt lgkmcnt(0)" ::: "memory");
  float rli[16];
#pragma unroll
  for (int r = 0; r < 16; ++r) rli[r] = __builtin_amdgcn_rcpf(li_l[crow(r, hi)]);
  bf16* Ow = u.O + (long)(wid * QBLK) * u.ldo;
#pragma unroll
  for (int r = 0; r < 16; ++r) { int orow = crow(r, hi);
#pragma unroll
    for (int d0 = 0; d0 < 4; ++d0) { const float v = o[d0][r] * rli[r]; Ow[(long)orow * u.ldo + d0 * 32 + r32] = (bf16)(cvtpk(v, v) & 0xffffu); } }
  if (u.lse != nullptr && hi == 0) u.lse[(long)(wid * QBLK + r32) * u.lse_ld] = m_reg * SCALE + __logf(l_reg);
#undef SLOAD
#undef SWRITE
#undef SWAIT
#undef RESC
}
#undef KSWZ
#undef SBAR
}

constexpr int NWAVES = 8;
constexpr size_t MiB = 1u << 20;
constexpr size_t WS_CTL = 0, CTL_ZERO_BYTES = 1 * MiB;
constexpr size_t WS_CS   = 1 * MiB;
constexpr size_t WS_SKBD = 1 * MiB + 256 * 1024;
constexpr size_t WS_TAB  = 2 * MiB;
constexpr size_t WS_LSE  = 3 * MiB;
constexpr size_t WS_WCAT = 4 * MiB, WS_WO = 12 * MiB, WS_WQ = 20 * MiB;
constexpr size_t WS_WIN  = 28 * MiB;
constexpr size_t WS_WG8  = WS_WIN + 32 * MiB;
constexpr size_t WS_DFT  = 84 * MiB;
constexpr size_t WS_U    = 148 * MiB, WS_V = 180 * MiB;
constexpr size_t WS_H8   = 212 * MiB;
constexpr size_t WS_H    = 276 * MiB;
constexpr size_t WS_PROJ = 340 * MiB;
constexpr size_t WS_G    = 596 * MiB;
constexpr size_t WS_ZT   = 788 * MiB;
constexpr size_t WS_OC   = 820 * MiB;
constexpr size_t WS_MG   = 884 * MiB;
constexpr size_t WS_END  = 948 * MiB;
#if DBG_MODE == 2
constexpr size_t WS_ACT = WS_PROJ + 208 * MiB;
#else
constexpr size_t WS_ACT = WS_PROJ + 200 * MiB;
#endif
constexpr size_t WS_Q = WS_PROJ, WS_SC = WS_PROJ + 64 * MiB, WS_IDS = WS_PROJ + 192 * MiB, WS_GATES = WS_PROJ + 200 * MiB;
constexpr int CW_BAR = 4096;
constexpr int CW_XRANK = 12288;
constexpr int CW_QUEUE = 16384;
constexpr int RING_BYTES = 131072, LDSCTL_OFF = RING_BYTES, MISC_OFF = LDSCTL_OFF + 320, LDS_BYTES = 147456;

#define LDS_WAIT() asm volatile("s_waitcnt lgkmcnt(0)" ::: "memory")
#define VM_WAIT() asm volatile("s_waitcnt vmcnt(0)" ::: "memory")
__device__ __forceinline__ unsigned f2bf(float f) { unsigned u = __builtin_bit_cast(unsigned, f); return (u + 0x7fffu + ((u >> 16) & 1u)) >> 16; }
__device__ __forceinline__ unsigned pk2(float lo, float hi) { return f2bf(lo) | (f2bf(hi) << 16); }
__device__ __forceinline__ float bflo(unsigned w) { return __uint_as_float(w << 16); }
__device__ __forceinline__ float bfhi(unsigned w) { return __uint_as_float(w & 0xffff0000u); }

#define XB_TMO      128
#define XB_XCNT(j)  (256  + 64 * (j))
#define XB_XSUB(j)  (1280 + 64 * (j))
#define XB_XGEN(j)  (2304 + 64 * (j))
#define XB_TOP      3328
#define XB_TOPGEN   3392
#define XCD_BAR_WORDS 3456
#define XB_SPIN_CAP (1u << 20)
__device__ __forceinline__ unsigned xb_ld(unsigned* p)              { return __hip_atomic_load(p, __ATOMIC_RELAXED, __HIP_MEMORY_SCOPE_AGENT); }
__device__ __forceinline__ unsigned xb_add(unsigned* p, unsigned v) { return __hip_atomic_fetch_add(p, v, __ATOMIC_RELAXED, __HIP_MEMORY_SCOPE_AGENT); }
__device__ __forceinline__ unsigned xb_xcc_id() { return (unsigned)__builtin_amdgcn_s_getreg((3 << 11) | 20) & 0xFu; }
#define XB_SPIN(cond, bar) do { unsigned _sp = 0; while (cond) { __builtin_amdgcn_s_sleep(1); \
    if ((++_sp & 255u) == 0u) { if (xb_ld(&(bar)[XB_TMO])) break; if (_sp > XB_SPIN_CAP) { atomicAdd(&(bar)[XB_TMO], 1u); break; } } } } while (0)
struct XcdBarrier { unsigned* bar; unsigned x; volatile LAS unsigned* st; };
__device__ __forceinline__ XcdBarrier xcd_barrier_post(unsigned* bar, volatile LAS unsigned* st) {
    XcdBarrier b; b.bar = bar; b.x = xb_xcc_id(); b.st = st;
    if (threadIdx.x == 0) (void)xb_add(&bar[XB_XCNT(b.x)], 1u);
    return b;
}
__device__ __forceinline__ void xcd_barrier_complete(unsigned* bar, unsigned x, unsigned& nloc, unsigned& nx) {
    const unsigned G = gridDim.x * gridDim.y * gridDim.z;
    unsigned sum, cnt, mine, sp = 0u;
    for (;;) {
        sum = 0u; cnt = 0u; mine = 0u;
#pragma unroll
        for (unsigned j = 0; j < 16; ++j) { const unsigned c = xb_ld(&bar[XB_XCNT(j)]); sum += c; cnt += (c > 0u) ? 1u : 0u; mine = (j == x) ? c : mine; }
        if (sum == G) break;
        __builtin_amdgcn_s_sleep(1);
        if ((++sp & 255u) == 0u) { if (xb_ld(&bar[XB_TMO])) break; if (sp > XB_SPIN_CAP) { atomicAdd(&bar[XB_TMO], 1u); break; } }
    }
    nloc = mine > 0u ? mine : 1u; nx = cnt > 0u ? cnt : 1u;
}
__device__ __forceinline__ void xcd_barrier(const XcdBarrier& b) {
    asm volatile("s_waitcnt vmcnt(0)" ::: "memory");
    __syncthreads();
    if (threadIdx.x == 0) {
        unsigned* bar = b.bar;
        __builtin_amdgcn_s_waitcnt(0);
        unsigned nloc = b.st[0], nx = b.st[1];
        if (nloc == 0u) { xcd_barrier_complete(bar, b.x, nloc, nx); b.st[0] = nloc; b.st[1] = nx; }
        const unsigned old = xb_add(&bar[XB_XSUB(b.x)], 1u);
        const unsigned gen = old / nloc;
        if (old + 1u == (gen + 1u) * nloc) {
            __builtin_amdgcn_fence(__ATOMIC_RELEASE, "agent");
            asm volatile("s_waitcnt vmcnt(0)" ::: "memory");
            const unsigned og = xb_add(&bar[XB_TOP], 1u);
            const unsigned tg = og / nx;
            if (og + 1u == (tg + 1u) * nx) xb_add(&bar[XB_TOPGEN], 1u);
            else XB_SPIN(xb_ld(&bar[XB_TOPGEN]) == tg, bar);
            __builtin_amdgcn_fence(__ATOMIC_ACQUIRE, "agent");
            xb_add(&bar[XB_XGEN(b.x)], 1u);
            asm volatile("s_waitcnt vmcnt(0)" ::: "memory");
        } else {
            XB_SPIN(xb_ld(&bar[XB_XGEN(b.x)]) == gen, bar);
            __builtin_amdgcn_fence(__ATOMIC_ACQUIRE, "agent");
            asm volatile("s_waitcnt vmcnt(0)" ::: "memory");
        }
    }
    __syncthreads();
}

template <int MASK> __device__ __forceinline__ int sx_i(int v) { return __builtin_amdgcn_ds_swizzle(v, 0x1f | (MASK << 10)); }
template <int MASK> __device__ __forceinline__ float sx_f(float v) { return __int_as_float(sx_i<MASK>(__float_as_int(v))); }
__device__ __forceinline__ float add32(float v) { auto rr = __builtin_amdgcn_permlane32_swap(__float_as_uint(v), __float_as_uint(v), false, false); return __uint_as_float(rr[0]) + __uint_as_float(rr[1]); }
__device__ __forceinline__ unsigned max32(unsigned v) { auto rr = __builtin_amdgcn_permlane32_swap(v, v, false, false); return rr[0] > rr[1] ? rr[0] : rr[1]; }
__device__ __forceinline__ float other32(float v, bool upper) { auto rr = __builtin_amdgcn_permlane32_swap(__float_as_uint(v), __float_as_uint(v), false, false); return __uint_as_float(upper ? rr[0] : rr[1]); }
__device__ __forceinline__ float bperm_f(float v, int src_lane) { return __int_as_float(__builtin_amdgcn_ds_bpermute(src_lane * 4, __float_as_int(v))); }
__device__ __forceinline__ int bperm_i(int v, int src_lane) { return __builtin_amdgcn_ds_bpermute(src_lane * 4, v); }
__device__ __forceinline__ float wave_sum(float v) {
    v += sx_f<1>(v); v += sx_f<2>(v); v += sx_f<4>(v); v += sx_f<8>(v); v += sx_f<16>(v); return add32(v);
}
__device__ __forceinline__ unsigned umax(unsigned a, unsigned b) { return a > b ? a : b; }
__device__ __forceinline__ unsigned wave_max_u32(unsigned v) {
    v = umax(v, (unsigned)sx_i<1>((int)v)); v = umax(v, (unsigned)sx_i<2>((int)v)); v = umax(v, (unsigned)sx_i<4>((int)v)); v = umax(v, (unsigned)sx_i<8>((int)v)); v = umax(v, (unsigned)sx_i<16>((int)v)); return max32(v);
}
template <int CTRL, int RMASK> __device__ __forceinline__ unsigned dpp_max_u(unsigned v) { const unsigned t = (unsigned)__builtin_amdgcn_update_dpp((int)v, (int)v, CTRL, RMASK, 0xF, false); return t > v ? t : v; }
__device__ __forceinline__ unsigned wave_max_dpp(unsigned v) {
    v = dpp_max_u<0xB1, 0xF>(v); v = dpp_max_u<0x4E, 0xF>(v); v = dpp_max_u<0x141, 0xF>(v); v = dpp_max_u<0x140, 0xF>(v); v = dpp_max_u<0x142, 0xA>(v); v = dpp_max_u<0x143, 0xC>(v);
    return (unsigned)__builtin_amdgcn_readlane((int)v, 63);
}
template <int CTRL> __device__ __forceinline__ float dpp_add_f(float v) { return v + __int_as_float(__builtin_amdgcn_update_dpp(__float_as_int(v), __float_as_int(v), CTRL, 0xF, 0xF, false)); }
__device__ __forceinline__ float row_sum16(float v) { v = dpp_add_f<0xB1>(v); v = dpp_add_f<0x4E>(v); v = dpp_add_f<0x141>(v); return dpp_add_f<0x140>(v); }
__device__ __forceinline__ unsigned row_max16_u(unsigned v) { v = dpp_max_u<0xB1, 0xF>(v); v = dpp_max_u<0x4E, 0xF>(v); v = dpp_max_u<0x141, 0xF>(v); return dpp_max_u<0x140, 0xF>(v); }
template <int CTRL> __device__ __forceinline__ float dpp_maxf(float v) { return fmaxf(v, __int_as_float(__builtin_amdgcn_update_dpp(__float_as_int(v), __float_as_int(v), CTRL, 0xF, 0xF, false))); }
__device__ __forceinline__ float row_max16_f(float v) { v = dpp_maxf<0xB1>(v); v = dpp_maxf<0x4E>(v); v = dpp_maxf<0x141>(v); return dpp_maxf<0x140>(v); }
__device__ __forceinline__ float okey_inv(unsigned k) { return __uint_as_float((k & 0x80000000u) ? (k & 0x7fffffffu) : ~k); }
#define CE_DESC(a, b) do { const unsigned hi_ = (a) > (b) ? (a) : (b), lo_ = (a) > (b) ? (b) : (a); (a) = hi_; (b) = lo_; } while (0)
__device__ __forceinline__ unsigned okey(float f) { const unsigned u = __float_as_uint(f); return (u & 0x80000000u) ? ~u : (u | 0x80000000u); }

__device__ __forceinline__ void transpose_item(const float* W, int N, bf16* WT, int ldo, int col_off, LAS float* scr, int item, int lane) {
    const int nblk = N / 32, kb = item / nblk, nb = item % nblk, k0 = 64 * kb, n0 = 32 * nb;
#pragma unroll 8
    for (int i = 0; i < 32; ++i) { const int kk = 2 * i + (lane >> 5); scr[kk * 33 + (lane & 31)] = W[(size_t)(k0 + kk) * N + n0 + (lane & 31)]; }
    LDS_WAIT(); asm volatile("" ::: "memory");
    const int c = lane & 7;
#pragma unroll
    for (int j = 0; j < 4; ++j) { const int n = (lane >> 3) + 8 * j; const LAS float* s = scr + (8 * c) * 33 + n;
        v4u o; o.x = pk2(s[0 * 33], s[1 * 33]); o.y = pk2(s[2 * 33], s[3 * 33]); o.z = pk2(s[4 * 33], s[5 * 33]); o.w = pk2(s[6 * 33], s[7 * 33]);
        *(GAS v4u*)(WT + (size_t)(n0 + n) * ldo + col_off + k0 + 8 * c) = o; }
    LDS_WAIT(); asm volatile("" ::: "memory");
}
__device__ __forceinline__ void transpose_item_fp8(const float* W, int N, int ncol0, unsigned char* WT8, int ldo, float scale, LAS float* scr, int item, int lane) {
    const int nblk = N / 32, kb = item / nblk, nb = item % nblk, k0 = 64 * kb, n0 = 32 * nb;
#pragma unroll 8
    for (int i = 0; i < 32; ++i) { const int kk = 2 * i + (lane >> 5); scr[kk * 33 + (lane & 31)] = W[(size_t)(k0 + kk) * N + n0 + (lane & 31)]; }
    LDS_WAIT(); asm volatile("" ::: "memory");
    const int c = lane & 3;
#pragma unroll
    for (int j = 0; j < 2; ++j) { const int n = (lane >> 2) + 16 * j; const LAS float* s = scr + (16 * c) * 33 + n; v4u o; int w;
        w = __builtin_amdgcn_cvt_pk_fp8_f32(s[0 * 33] * scale, s[1 * 33] * scale, 0, false); w = __builtin_amdgcn_cvt_pk_fp8_f32(s[2 * 33] * scale, s[3 * 33] * scale, w, true); o.x = (unsigned)w;
        w = __builtin_amdgcn_cvt_pk_fp8_f32(s[4 * 33] * scale, s[5 * 33] * scale, 0, false); w = __builtin_amdgcn_cvt_pk_fp8_f32(s[6 * 33] * scale, s[7 * 33] * scale, w, true); o.y = (unsigned)w;
        w = __builtin_amdgcn_cvt_pk_fp8_f32(s[8 * 33] * scale, s[9 * 33] * scale, 0, false); w = __builtin_amdgcn_cvt_pk_fp8_f32(s[10 * 33] * scale, s[11 * 33] * scale, w, true); o.z = (unsigned)w;
        w = __builtin_amdgcn_cvt_pk_fp8_f32(s[12 * 33] * scale, s[13 * 33] * scale, 0, false); w = __builtin_amdgcn_cvt_pk_fp8_f32(s[14 * 33] * scale, s[15 * 33] * scale, w, true); o.w = (unsigned)w;
        *(GAS v4u*)(WT8 + (size_t)(n0 + n - ncol0) * ldo + k0 + 16 * c) = o; }
    LDS_WAIT(); asm volatile("" ::: "memory");
}
template <bool FP8> __device__ __forceinline__ void rms_row_to_bf16(const float* xrow, const float* g, bf16* orow, unsigned char* o8row, int lane) {
    const GAS f32x4* xr = (const GAS f32x4*)xrow + lane; const GAS f32x4* gr = (const GAS f32x4*)g + lane;
    f32x4 v[8]; float s = 0.f;
#pragma unroll
    for (int j = 0; j < 8; ++j) { v[j] = xr[64 * j]; s += (v[j].x * v[j].x + v[j].y * v[j].y) + (v[j].z * v[j].z + v[j].w * v[j].w); }
    const float rstd = 1.0f / sqrtf(wave_sum(s) * (1.f / DM) + RMS_EPS);
    GAS unsigned long long* o8 = (GAS unsigned long long*)orow + lane;
#pragma unroll
    for (int j = 0; j < 8; ++j) { const f32x4 gg = gr[64 * j]; const float a = v[j].x * rstd * gg.x, b = v[j].y * rstd * gg.y, c = v[j].z * rstd * gg.z, d = v[j].w * rstd * gg.w;
        o8[64 * j] = (unsigned long long)pk2(a, b) | ((unsigned long long)pk2(c, d) << 32);
        if (FP8) { int w = __builtin_amdgcn_cvt_pk_fp8_f32(a * 32.f, b * 32.f, 0, false); w = __builtin_amdgcn_cvt_pk_fp8_f32(c * 32.f, d * 32.f, w, true); ((GAS unsigned*)o8row)[lane + 64 * j] = (unsigned)w; } }
}
typedef __bf16 bf2_t __attribute__((ext_vector_type(2)));
__device__ __forceinline__ float DOT2(unsigned a, unsigned b, float c) { return __builtin_amdgcn_fdot2_f32_bf16(__builtin_bit_cast(bf2_t, a), __builtin_bit_cast(bf2_t, b), c, false); }
__device__ __forceinline__ int rel_bucket(int rel) {
    const int n = rel < 0 ? -rel : rel;
    int b = n;
    if (n >= 8) { b = 5 + (31 - __builtin_clz((unsigned)n)); if (b > 15) b = 15; }
    return b + (rel > 0 ? 16 : 0);
}

#ifndef PH_D1
#define PH_D1 1
#endif
#ifndef PH_D2
#define PH_D2 1
#endif
#ifndef PH_A
#define PH_A 1
#endif
#ifndef PH_B
#define PH_B 1
#endif
#ifndef PH_C
#define PH_C 1
#endif
#ifndef PH_D
#define PH_D 1
#endif
#ifndef PH_E
#define PH_E 1
#endif
#ifndef PH_F
#define PH_F 1
#endif
#ifndef PH_G
#define PH_G 1
#endif
#ifndef PH_H
#define PH_H 1
#endif
#ifndef PH_I
#define PH_I 1
#endif
#ifndef PH_J
#define PH_J 1
#endif
#ifndef PH_K
#define PH_K 1
#endif
#ifndef PH_L
#define PH_L 1
#endif
struct Args { const float* in[17]; float* out; unsigned char* ws; };

#define CAS __attribute__((address_space(4)))
__device__ __forceinline__ const void* karg(int k) { const CAS char* ka = (const CAS char*)__builtin_amdgcn_kernarg_segment_ptr(); asm volatile("" : "+s"(ka)); return *(const void* const CAS*)(ka + 8 * k); }
#define WSP(T, off) ((T*)((unsigned char*)karg(18) + (off)))
#define INP(k) ((const float*)karg(k))
#define INL(k, stride) (INP(k) + (size_t)layer * (size_t)(stride))
#define X ((float*)karg(17))
__global__ void __launch_bounds__(NWAVES * 64, 2) mk_fwd(Args args_unused) {
    extern __shared__ __attribute__((aligned(16))) unsigned char lds[];
    LAS unsigned char* ldsl = (LAS unsigned char*)lds;
    volatile LAS unsigned* MISC = (volatile LAS unsigned*)(ldsl + MISC_OFF);
    const int wave0 = __builtin_amdgcn_readfirstlane((int)threadIdx.x >> 6);
    const int G = gridDim.x; const int bx = blockIdx.x; const int vcu = (G % 8 == 0) ? (bx % 8) * (G / 8) + bx / 8 : bx;
    const int NGW = G * NWAVES, NGT = NGW * 64;
#define PH_IDS() const int tid = opaque_tid(wave0), lane = tid & 63, wave = wave0, gw = vcu * NWAVES + wave, gt = gw * 64 + lane; (void)gt; (void)gw; (void)lane
    gu32* ctl = (gu32*)WSP(unsigned char, WS_CTL);
    for (int u = threadIdx.x; u < (LDS_BYTES - LDSCTL_OFF) / 4; u += NWAVES * 64) ((LAS unsigned*)(ldsl + LDSCTL_OFF))[u] = 0u;
    __syncthreads();
    XcdBarrier bar = xcd_barrier_post((unsigned*)(ctl + CW_BAR), MISC + 8);
    if (threadIdx.x == 0) MISC[1] = __hip_atomic_fetch_add(ctl + CW_XRANK + 64 * (int)(xb_xcc_id() & 7u), 1u, __ATOMIC_RELAXED, __HIP_MEMORY_SCOPE_AGENT);
#define GRID_BAR() xcd_barrier(bar)

    for (int layer = 0; layer < 2; ++layer) {

#if PH_A
        {
            PH_IDS();
            LAS float* scr = (LAS float*)(ldsl + wave * 16384);
            const float* w_in = INL(4, (size_t)DM * INW); const float* w_up_a = INL(6, 512 * DM); const float* w_up_b = INL(7, 512 * DM); const float* w_up_c = INL(8, 1024 * DM);
            const float* w_o = INL(11, DM * DM); const float* wq = INL(13, DM * DM); const float* subk = INL(14, 2 * 128 * 128);
            const float* pu = INL(15, (size_t)NEXP * DM); const float* pv = INL(16, (size_t)NEXP * DM); const float* mix_g = INL(3, DM); const float* rel_bias = INP(1);
            bf16* WIN = WSP(bf16, WS_WIN); bf16* WCAT = WSP(bf16, WS_WCAT); bf16* WO = WSP(bf16, WS_WO); bf16* WQ = WSP(bf16, WS_WQ); unsigned char* U8 = WSP(unsigned char, WS_U); unsigned char* V8 = WSP(unsigned char, WS_V);
            bf16* SKBD = WSP(bf16, WS_SKBD); bf16* H = WSP(bf16, WS_H); bf16* DFT = WSP(bf16, WS_DFT); bf16* CS = WSP(bf16, WS_CS); float* TAB = WSP(float, WS_TAB);
            constexpr int I_IN = (DM / 64) * (INW / 32), I_A = (512 / 64) * (DM / 32), I_C = (1024 / 64) * (DM / 32), I_SQ = (DM / 64) * (DM / 32);
            constexpr int NITEMS = I_IN + 2 * I_A + I_C + 2 * I_SQ;
            for (int it = gw; it < NITEMS; it += NGW) {
                int r = it;
                if (r < I_IN) { if ((r % (INW / 32)) * 32 < PJW) transpose_item(w_in, INW, WIN, DM, 0, scr, r, lane); else transpose_item_fp8(w_in, INW, PJW, WSP(unsigned char, WS_WG8), DM, 1024.f, scr, r, lane); continue; } r -= I_IN;
                if (r < I_A) { transpose_item(w_up_a, DM, WCAT, DM, 0, scr, r, lane); continue; } r -= I_A;
                if (r < I_A) { transpose_item(w_up_b, DM, WCAT, DM, 512, scr, r, lane); continue; } r -= I_A;
                if (r < I_C) { transpose_item(w_up_c, DM, WCAT, DM, 1024, scr, r, lane); continue; } r -= I_C;
                if (r < I_SQ) { transpose_item(w_o, DM, WO, DM, 0, scr, r, lane); continue; } r -= I_SQ;
                transpose_item(wq, DM, WQ, DM, 0, scr, r, lane);
            }
            for (size_t i = (size_t)gt; i < (size_t)NEXP * DM / 16; i += (size_t)NGT) {
#pragma unroll
                for (int tb = 0; tb < 2; ++tb) {
                    const GAS f32x4* src = (const GAS f32x4*)(tb ? pv : pu) + 4 * i; const float sc = tb ? 64.f : 1024.f;
                    const f32x4 a = src[0], b = src[1], c = src[2], d = src[3]; v4u o;
                    int w;
                    w = __builtin_amdgcn_cvt_pk_fp8_f32(a.x * sc, a.y * sc, 0, false); w = __builtin_amdgcn_cvt_pk_fp8_f32(a.z * sc, a.w * sc, w, true); o.x = (unsigned)w;
                    w = __builtin_amdgcn_cvt_pk_fp8_f32(b.x * sc, b.y * sc, 0, false); w = __builtin_amdgcn_cvt_pk_fp8_f32(b.z * sc, b.w * sc, w, true); o.y = (unsigned)w;
                    w = __builtin_amdgcn_cvt_pk_fp8_f32(c.x * sc, c.y * sc, 0, false); w = __builtin_amdgcn_cvt_pk_fp8_f32(c.z * sc, c.w * sc, w, true); o.z = (unsigned)w;
                    w = __builtin_amdgcn_cvt_pk_fp8_f32(d.x * sc, d.y * sc, 0, false); w = __builtin_amdgcn_cvt_pk_fp8_f32(d.z * sc, d.w * sc, w, true); o.w = (unsigned)w;
                    ((GAS v4u*)(tb ? V8 : U8))[i] = o;
                }
            }
            for (int i = gt; i < 65536; i += NGT) { const int n = i >> 8, kk = i & 255, p = n >> 7; SKBD[i] = ((kk >> 7) == p) ? (bf16)f2bf(subk[(size_t)(p * 128 + (n & 127)) * 128 + (kk & 127)]) : (bf16)0; }
            for (int m = gw; m < MTOK; m += NGW) rms_row_to_bf16<true>((layer == 0 ? INP(0) : (const float*)X) + (size_t)m * DM, mix_g, H + (size_t)m * DM, WSP(unsigned char, WS_H8) + (size_t)m * DM, lane);
            if (layer == 0) {
                for (size_t i = (size_t)gt; i < (size_t)4096 * 8192 / 8; i += (size_t)NGT) {
                    const int sp = (int)(i >> 10), k0 = (int)(i & 1023) * 8, part = k0 >> 12, s0 = k0 & 4095; float v[8];
#pragma unroll
                    for (int j = 0; j < 8; ++j) { const float ang = (float)(((s0 + j) * sp) & 4095) * (1.f / 4096.f); v[j] = (part ? -__builtin_amdgcn_sinf(ang) : __builtin_amdgcn_cosf(ang)) * (1.f / 64.f); }
                    v4u o; o.x = pk2(v[0], v[1]); o.y = pk2(v[2], v[3]); o.z = pk2(v[4], v[5]); o.w = pk2(v[6], v[7]); ((GAS v4u*)DFT)[i] = o;
                }
                for (int i = gt; i < 65536; i += NGT) { const int r = i >> 8, c = i & 255, part = r >> 7, cp = r & 127; float v = 0.f;
                    if (c < 128) { const float ang = (float)((c * cp) & 127) * (1.f / 128.f); v = (part ? __builtin_amdgcn_sinf(ang) : __builtin_amdgcn_cosf(ang)) * 0.08838834764831845f; }
                    CS[i] = (bf16)f2bf(v); }
                for (int i = gt; i < 16 * 8192; i += NGT) { const int hd = i >> 13, off = (i & 8191) - 4096; float v;
                    if (hd < 12) { const int g = hd >> 2, dil = g == 0 ? 1 : (g == 1 ? 4 : 16); v = (off >= -64 && off <= 64) ? rel_bias[rel_bucket(off * dil) * 16 + hd] * 11.313708498984761f : -1.0e5f; }
                    else v = rel_bias[rel_bucket(off) * 16 + hd] * 11.313708498984761f;
                    TAB[i] = v; }
            }
        }
#endif
        GRID_BAR();

#if PH_B
        {
            { pg8::Gemm g{WSP(bf16, WS_H), WSP(bf16, WS_WIN)}; pg8::StaticOrder S; S.init(MTOK, PJW, G, bx, DM, DM);
              pg8::EpiStore E{WSP(bf16, WS_PROJ), PJW};
              pg8::gemm_phase<pg8::EpiStore, pg8::StaticOrder, true, DM, DM, DM>(ldsl, g, S, E, wave0); }
            { pg8::Gemm g{WSP(bf16, WS_H8), WSP(bf16, WS_WG8)}; pg8::StaticOrder S; S.init(MTOK, GTW, G, bx, DM / 2, DM / 2);
              pg8::EpiProj E{WSP(bf16, WS_PROJ), WSP(bf16, WS_G), INL(5, GTW), 32, 1.f / 32768.f};
              pg8::gemm_phase<pg8::EpiProj, pg8::StaticOrder, true, DM / 2, DM / 2, DM / 2, true>(ldsl, g, S, E, wave0); }
        }
#endif
        GRID_BAR();

#if PH_C
        {
            pg8::Gemm g{WSP(bf16, WS_CS), WSP(bf16, WS_PROJ)}; pg8::F1Order S{G, bx};
            pg8::EpiZT E{WSP(bf16, WS_ZT)};
            pg8::gemm_phase<pg8::EpiZT, pg8::F1Order, false, 256, PJW, 256>(ldsl, g, S, E, wave0);
        }
#endif
        GRID_BAR();

#if PH_D
#if PH_D1
        {
            pg8::Gemm g{WSP(bf16, WS_DFT), WSP(bf16, WS_ZT)}; pg8::F2Order S; S.init(4096, 2048, G, bx, 8192, 8192);
            pg8::EpiStore E{WSP(bf16, WS_OC), DM};
            pg8::gemm_phase<pg8::EpiStore, pg8::F2Order, false, 8192, 8192, 8192>(ldsl, g, S, E, wave0);
        }
#endif
#if PH_D2
        {
            PH_IDS();
            gu32* qhead = ctl + CW_QUEUE + 64 * layer;
            bf16* PROJ = WSP(bf16, WS_PROJ); bf16* DO = WSP(bf16, WS_MG); bf16* DL = WSP(bf16, WS_H); float* LSE = WSP(float, WS_LSE); const float* TAB = WSP(float, WS_TAB);
            const float* cur_tab = nullptr;
            for (;;) {
                __syncthreads();
                if (tid == 0) MISC[0] = __hip_atomic_fetch_add(qhead, 1u, __ATOMIC_RELAXED, __HIP_MEMORY_SCOPE_AGENT);
                __syncthreads();
                const int ui = __builtin_amdgcn_readfirstlane((int)MISC[0]);
                if (ui >= 1792) break;
                attn::Unit u; int hd;
                if (ui < 1024) {
                    const int qb = ui & 15, vh = (ui >> 4) & 1, m = (ui >> 5) & 1, h = (ui >> 6) & 3, b = ui >> 8;
                    const bf16* base = PROJ + (size_t)b * SEQ * PJW;
                    u.Q = base + (size_t)(qb * 256) * PJW + COL_DIFF + (h * 2 + m) * 128; u.K = base + COL_DIFF + 1024 + (h * 2 + m) * 128; u.V = base + COL_DIFF + 2048 + h * 256 + vh * 128;
                    u.O = DO + (size_t)(b * SEQ + qb * 256) * DM + (h * 2 + m) * 256 + vh * 128; u.lse = nullptr; u.ldq = PJW; u.ldk = PJW; u.ldo = DM; u.lse_ld = 0;
                    u.kt0 = 0; u.nt = SEQ / 64; u.qoff = qb * 256; hd = 12 + h;
                } else {
                    const int v = ui - 1024, qb16 = v & 15, hh = (v >> 4) & 3, bg = v >> 6, g = bg % 3, b = bg / 3;
                    const int dil = g == 0 ? 1 : (g == 1 ? 4 : 16), bpc = 16 / dil, r = qb16 / bpc, qblk = qb16 % bpc, q0 = qblk * 256, ntot = (SEQ / dil) / 64;
                    int kt0 = q0 / 64 - 1; if (kt0 < 0) kt0 = 0; int kt1 = q0 / 64 + 5; if (kt1 > ntot) kt1 = ntot;
                    if ((kt1 - kt0) & 1) { if (kt0 > 0) --kt0; else ++kt1; }
                    const bf16* base = PROJ + (size_t)(b * SEQ + r) * PJW + COL_DIL + g * 512 + hh * 128;
                    u.Q = base + (size_t)q0 * dil * PJW; u.K = base + 1536; u.V = base + 3072;
                    u.O = DL + ((size_t)g * MTOK + b * SEQ + r + (size_t)q0 * dil) * 512 + hh * 128; u.lse = LSE + ((size_t)g * MTOK + b * SEQ + r + (size_t)q0 * dil) * 4 + hh;
                    u.ldq = (long)PJW * dil; u.ldk = (long)PJW * dil; u.ldo = 512L * dil; u.lse_ld = 4 * dil; u.kt0 = kt0; u.nt = kt1 - kt0; u.qoff = q0; hd = g * 4 + hh;
                }
                const float* tab = TAB + (size_t)hd * 8192;
                if (tab != cur_tab) {
                    cur_tab = tab;
                    LAS f32x4* tl = (LAS f32x4*)(ldsl + attn::LDS_TAB); const int t2 = opaque_tid(wave0);
#pragma unroll
                    for (int j = 0; j < 4; ++j) tl[t2 + 512 * j] = ((const GAS f32x4*)tab)[t2 + 512 * j];
                }
                attn::attn_unit(u, (char*)lds, wave0);
            }
        }
#endif
#endif
        GRID_BAR();

#if PH_E
        {
            PH_IDS();
            const float* dlam = INL(9, 512); const float* subln = INL(10, 256); const float lambda_init = layer == 0 ? 0.2f : 0.35550906759f;
            const float* LSE = WSP(float, WS_LSE); const bf16* DL = WSP(bf16, WS_H); const bf16* DO = WSP(bf16, WS_MG); bf16* OC = WSP(bf16, WS_OC);
            float s1 = dlam[lane] * dlam[128 + lane] + dlam[64 + lane] * dlam[192 + lane], s2 = dlam[256 + lane] * dlam[384 + lane] + dlam[320 + lane] * dlam[448 + lane];
            s1 = wave_sum(s1); s2 = wave_sum(s2);
            const float lam = __expf(s1) - __expf(s2) + lambda_init, osc = 1.0f - lambda_init;
            const int hq = lane >> 4, l16 = lane & 15;
            for (int t = gw; t < MTOK; t += NGW) {
                float ls[3], mx = -3e38f;
#pragma unroll
                for (int g = 0; g < 3; ++g) { ls[g] = LSE[((size_t)g * MTOK + t) * 4 + hq]; mx = fmaxf(mx, ls[g]); }
                float wsum = 0.f;
#pragma unroll
                for (int g = 0; g < 3; ++g) { ls[g] = __expf(ls[g] - mx); wsum += ls[g]; }
                const float winv = 1.0f / wsum; float acc8[8] = {0.f, 0.f, 0.f, 0.f, 0.f, 0.f, 0.f, 0.f};
#pragma unroll
                for (int g = 0; g < 3; ++g) { const v4u o = *(const GAS v4u*)(DL + ((size_t)g * MTOK + t) * 512 + lane * 8); const float w = ls[g] * winv;
                    acc8[0] += w * bflo(o.x); acc8[1] += w * bfhi(o.x); acc8[2] += w * bflo(o.y); acc8[3] += w * bfhi(o.y); acc8[4] += w * bflo(o.z); acc8[5] += w * bfhi(o.z); acc8[6] += w * bflo(o.w); acc8[7] += w * bfhi(o.w); }
#if defined(DBG_ZERO_OB)
                for (int j = 0; j < 8; ++j) acc8[j] = 0.f;
#endif
                { v4u o; o.x = pk2(acc8[0], acc8[1]); o.y = pk2(acc8[2], acc8[3]); o.z = pk2(acc8[4], acc8[5]); o.w = pk2(acc8[6], acc8[7]); *(GAS v4u*)(OC + (size_t)t * DM + 512 + lane * 8) = o; }
                const bf16* dp = DO + (size_t)t * DM + hq * 512 + l16 * 16;
                const v4u a0 = *(const GAS v4u*)(dp), a1 = *(const GAS v4u*)(dp + 8), b0 = *(const GAS v4u*)(dp + 256), b1 = *(const GAS v4u*)(dp + 264);
                float d[16];
                d[0] = bflo(a0.x) - lam * bflo(b0.x); d[1] = bfhi(a0.x) - lam * bfhi(b0.x); d[2] = bflo(a0.y) - lam * bflo(b0.y); d[3] = bfhi(a0.y) - lam * bfhi(b0.y);
                d[4] = bflo(a0.z) - lam * bflo(b0.z); d[5] = bfhi(a0.z) - lam * bfhi(b0.z); d[6] = bflo(a0.w) - lam * bflo(b0.w); d[7] = bfhi(a0.w) - lam * bfhi(b0.w);
                d[8] = bflo(a1.x) - lam * bflo(b1.x); d[9] = bfhi(a1.x) - lam * bfhi(b1.x); d[10] = bflo(a1.y) - lam * bflo(b1.y); d[11] = bfhi(a1.y) - lam * bfhi(b1.y);
                d[12] = bflo(a1.z) - lam * bflo(b1.z); d[13] = bfhi(a1.z) - lam * bfhi(b1.z); d[14] = bflo(a1.w) - lam * bflo(b1.w); d[15] = bfhi(a1.w) - lam * bfhi(b1.w);
                float ss = 0.f;
#pragma unroll
                for (int j = 0; j < 16; ++j) ss += d[j] * d[j];
                ss += sx_f<1>(ss); ss += sx_f<2>(ss); ss += sx_f<4>(ss); ss += sx_f<8>(ss);
                const float rs = osc / sqrtf(ss * (1.f / 256.f) + RMS_EPS);
                const f32x4 g0 = *(const GAS f32x4*)(subln + l16 * 16), g1 = *(const GAS f32x4*)(subln + l16 * 16 + 4), g2 = *(const GAS f32x4*)(subln + l16 * 16 + 8), g3 = *(const GAS f32x4*)(subln + l16 * 16 + 12);
                v4u o0, o1;
                o0.x = pk2(d[0] * rs * g0.x, d[1] * rs * g0.y); o0.y = pk2(d[2] * rs * g0.z, d[3] * rs * g0.w); o0.z = pk2(d[4] * rs * g1.x, d[5] * rs * g1.y); o0.w = pk2(d[6] * rs * g1.z, d[7] * rs * g1.w);
                o1.x = pk2(d[8] * rs * g2.x, d[9] * rs * g2.y); o1.y = pk2(d[10] * rs * g2.z, d[11] * rs * g2.w); o1.z = pk2(d[12] * rs * g3.x, d[13] * rs * g3.y); o1.w = pk2(d[14] * rs * g3.z, d[15] * rs * g3.w);
                bf16* op = OC + (size_t)t * DM + 1024 + hq * 256 + l16 * 16;
                *(GAS v4u*)(op) = o0; *(GAS v4u*)(op + 8) = o1;
            }
        }
#endif
        GRID_BAR();

#if PH_F
        {
            pg8::MergeOrder S; S.init(MTOK, DM, G, bx, DM, DM);
            pg8::Gemm g{WSP(bf16, WS_OC), WSP(bf16, WS_WCAT)}; pg8::EpiMerge4 E{WSP(bf16, WS_G), WSP(bf16, WS_MG)};
            pg8::gemm_phase<pg8::EpiMerge4, pg8::MergeOrder, true, DM, DM, 512>(ldsl, g, S, E, wave0);
        }
#endif
        GRID_BAR();

#if PH_G
        {
            pg8::Gemm g{WSP(bf16, WS_MG), WSP(bf16, WS_WO)}; pg8::StaticOrder S; S.init(MTOK, DM, G, bx, DM, DM);
            pg8::EpiResF32 E{layer == 0 ? INP(0) : (const float*)X, X, DM};
            pg8::gemm_phase<pg8::EpiResF32, pg8::StaticOrder, true, DM, DM, DM>(ldsl, g, S, E, wave0);
        }
#endif
        GRID_BAR();

#if PH_H
        { PH_IDS(); const float* ffn_g = INL(12, DM); bf16* H = WSP(bf16, WS_H);
          for (int m = gw; m < MTOK; m += NGW) rms_row_to_bf16<false>(X + (size_t)m * DM, ffn_g, H + (size_t)m * DM, nullptr, lane); }
#endif
        GRID_BAR();

#if PH_I
        {
            pg8::Gemm g{WSP(bf16, WS_H), WSP(bf16, WS_WQ)}; pg8::StaticOrder S; S.init(MTOK, DM, G, bx, DM, DM);
            pg8::EpiStore E{WSP(bf16, WS_Q), DM};
            pg8::gemm_phase<pg8::EpiStore, pg8::StaticOrder, true, DM, DM, DM>(ldsl, g, S, E, wave0);
        }
#endif
        GRID_BAR();

#if PH_J
        {
            pg8::Gemm g{WSP(bf16, WS_Q), WSP(bf16, WS_SKBD)}; pg8::StaticOrder S; S.init(MTOK * 8, 256, G, bx, 256, 256);
            pg8::EpiResF32 E{nullptr, WSP(float, WS_SC), 256};
            pg8::gemm_phase<pg8::EpiResF32, pg8::StaticOrder, true, 256, 256, 256>(ldsl, g, S, E, wave0);
        }
#endif
        GRID_BAR();

#if PH_K
        {
            PH_IDS();
            const float* SC = WSP(float, WS_SC); int* IDS = WSP(int, WS_IDS); float* GATES = WSP(float, WS_GATES);
            const int l16 = lane & 15, rbase = lane & 48;
            int cq[4];
#pragma unroll
            for (int q = 0; q < 4; ++q) { int c = l16 + 16 * q, ci = -1, cj = 0; for (int i = 0; i < 16; ++i) { const int cnt = 16 / (i + 1); if (ci < 0) { if (c < cnt) { ci = i; cj = c; } else c -= cnt; } } cq[q] = ci < 0 ? -1 : ci * 16 + cj; }
            for (int row4 = gw * 4; row4 < MTOK * 8; row4 += NGW * 4) {
                const int row = row4 + (lane >> 4);
                const float* sc = SC + (size_t)row * 256 + l16;
                unsigned ka[8], kb[8];
#pragma unroll
                for (int jj = 0; jj < 8; ++jj) { ka[jj] = (okey(sc[jj * 16]) & ~127u) | (unsigned)(127 - (jj * 16 + l16)); kb[jj] = (okey(sc[128 + jj * 16]) & ~127u) | (unsigned)(127 - (jj * 16 + l16)); }
#define SORT8(k) do { CE_DESC(k[0], k[1]); CE_DESC(k[2], k[3]); CE_DESC(k[4], k[5]); CE_DESC(k[6], k[7]); CE_DESC(k[0], k[2]); CE_DESC(k[1], k[3]); CE_DESC(k[4], k[6]); CE_DESC(k[5], k[7]); \
    CE_DESC(k[1], k[2]); CE_DESC(k[5], k[6]); CE_DESC(k[0], k[4]); CE_DESC(k[3], k[7]); CE_DESC(k[1], k[5]); CE_DESC(k[2], k[6]); CE_DESC(k[1], k[4]); CE_DESC(k[3], k[6]); \
    CE_DESC(k[2], k[4]); CE_DESC(k[3], k[5]); CE_DESC(k[3], k[4]); } while (0)
                SORT8(ka); SORT8(kb);
                unsigned ta = 0u, tb = 0u;
#pragma unroll
                for (int r = 0; r < 16; ++r) {
                    const unsigned ma = row_max16_u(ka[0]), mb = row_max16_u(kb[0]);
                    const bool wa = ka[0] == ma, wb = kb[0] == mb;
                    ta = (l16 == r) ? ma : ta; tb = (l16 == r) ? mb : tb;
#pragma unroll
                    for (int q = 0; q < 7; ++q) { ka[q] = wa ? ka[q + 1] : ka[q]; kb[q] = wb ? kb[q + 1] : kb[q]; }
                    ka[7] = wa ? 0u : ka[7]; kb[7] = wb ? 0u : kb[7];
                }
                const int ia = 127 - (int)(ta & 127u), ib = 127 - (int)(tb & 127u);
                const float va = okey_inv(ta & ~127u), vb = okey_inv(tb & ~127u);
                unsigned ck[4];
#pragma unroll
                for (int q = 0; q < 4; ++q) { const int cc = cq[q] < 0 ? 0 : cq[q]; const float cs = bperm_f(va, rbase + (cc >> 4)) + bperm_f(vb, rbase + (cc & 15));
                    ck[q] = cq[q] < 0 ? 0u : ((okey(cs) & ~255u) | (unsigned)(255 - cc)); }
                CE_DESC(ck[0], ck[1]); CE_DESC(ck[2], ck[3]); CE_DESC(ck[0], ck[2]); CE_DESC(ck[1], ck[3]); CE_DESC(ck[1], ck[2]);
                unsigned tw = 0u;
#pragma unroll
                for (int r = 0; r < 16; ++r) { const unsigned mm = row_max16_u(ck[0]); const bool w = ck[0] == mm; tw = (l16 == r) ? mm : tw;
                    ck[0] = w ? ck[1] : ck[0]; ck[1] = w ? ck[2] : ck[1]; ck[2] = w ? ck[3] : ck[2]; ck[3] = w ? 0u : ck[3]; }
                const int code = 255 - (int)(tw & 255u), wi = (code >> 4) & 15, wj = code & 15;
                const float bs = bperm_f(va, rbase + wi) + bperm_f(vb, rbase + wj);
                const int eid = bperm_i(ia, rbase + wi) * 128 + bperm_i(ib, rbase + wj);
                const float mx = row_max16_f(bs), e = __expf(bs - mx), es = row_sum16(e);
                IDS[(size_t)row * 16 + l16] = eid; GATES[(size_t)row * 16 + l16] = e / es;
            }
#undef SORT8
        }
#endif
        GRID_BAR();

#if PH_L
#define L_LDIDS(I, tt, hh) do { const GAS v4u* ip_ = (const GAS v4u*)(IDS + (size_t)(tt) * 128 + (hh) * 64 + lrow * 16); I##0 = ip_[0]; I##1 = ip_[1]; I##2 = ip_[2]; I##3 = ip_[3]; } while (0)
#define L_ISSUE(W, I, base) do { \
    W[0] = *(const GAS v4u*)((base) + (size_t)(I##0).x * DM); W[1] = *(const GAS v4u*)((base) + (size_t)(I##0).y * DM); W[2] = *(const GAS v4u*)((base) + (size_t)(I##0).z * DM); W[3] = *(const GAS v4u*)((base) + (size_t)(I##0).w * DM); \
    W[4] = *(const GAS v4u*)((base) + (size_t)(I##1).x * DM); W[5] = *(const GAS v4u*)((base) + (size_t)(I##1).y * DM); W[6] = *(const GAS v4u*)((base) + (size_t)(I##1).z * DM); W[7] = *(const GAS v4u*)((base) + (size_t)(I##1).w * DM); \
    W[8] = *(const GAS v4u*)((base) + (size_t)(I##2).x * DM); W[9] = *(const GAS v4u*)((base) + (size_t)(I##2).y * DM); W[10] = *(const GAS v4u*)((base) + (size_t)(I##2).z * DM); W[11] = *(const GAS v4u*)((base) + (size_t)(I##2).w * DM); \
    W[12] = *(const GAS v4u*)((base) + (size_t)(I##3).x * DM); W[13] = *(const GAS v4u*)((base) + (size_t)(I##3).y * DM); W[14] = *(const GAS v4u*)((base) + (size_t)(I##3).z * DM); W[15] = *(const GAS v4u*)((base) + (size_t)(I##3).w * DM); } while (0)
#define L_CVT(d, hi) __builtin_amdgcn_cvt_pk_f32_fp8((int)(d), (hi))
        {
            PH_IDS();
            const bf16* H = WSP(bf16, WS_H); const unsigned char* U8 = WSP(unsigned char, WS_U); const int* IDS = WSP(int, WS_IDS); float* PART = WSP(float, WS_G);
            typedef float f32x2 __attribute__((ext_vector_type(2)));
            const int myx = (int)(xb_xcc_id() & 7u); int nx = 0, xi = 0, nloc = 1;
            for (int j = 0; j < 8; ++j) { const int c = (int)__hip_atomic_load(ctl + CW_XRANK + 64 * j, __ATOMIC_RELAXED, __HIP_MEMORY_SCOPE_AGENT); if (c > 0) { ++nx; if (j < myx) ++xi; } if (j == myx) nloc = c; }
            const int rw = (int)MISC[1] * NWAVES + wave, nW = nloc * NWAVES; const int l16 = lane & 15, lrow = lane >> 4;
#define L1_COMPUTE(W, dst) do { float sk[16]; _Pragma("unroll") for (int k = 0; k < 16; ++k) { const v4u ww = W[k]; const unsigned d0 = ww.x, d1 = ww.y, d2 = ww.z, d3 = ww.w; f32x2 s2; \
        s2 = L_CVT(d0, false) * hf[0]; s2 += L_CVT(d0, true) * hf[1]; s2 += L_CVT(d1, false) * hf[2]; s2 += L_CVT(d1, true) * hf[3]; \
        s2 += L_CVT(d2, false) * hf[4]; s2 += L_CVT(d2, true) * hf[5]; s2 += L_CVT(d3, false) * hf[6]; s2 += L_CVT(d3, true) * hf[7]; sk[k] = s2.x + s2.y; } \
          \
        float t8[8]; _Pragma("unroll") for (int j = 0; j < 8; ++j) { const float keep = b8 ? sk[8 + j] : sk[j], send = b8 ? sk[j] : sk[8 + j]; \
            t8[j] = keep + __int_as_float(__builtin_amdgcn_update_dpp(0, __float_as_int(send), 0x128, 0xF, 0xF, false)); } \
        float t4[4]; _Pragma("unroll") for (int j = 0; j < 4; ++j) { const float keep = b4 ? t8[4 + j] : t8[j], send = b4 ? t8[j] : t8[4 + j]; t4[j] = keep + sx_f<4>(send); } \
        float t2[2]; _Pragma("unroll") for (int j = 0; j < 2; ++j) { const float keep = b2 ? t4[2 + j] : t4[j], send = b2 ? t4[j] : t4[2 + j]; \
            t2[j] = keep + __int_as_float(__builtin_amdgcn_update_dpp(0, __float_as_int(send), 0x4E, 0xF, 0xF, false)); } \
        { const float keep = b1 ? t2[1] : t2[0], send = b1 ? t2[0] : t2[1]; dst = keep + __int_as_float(__builtin_amdgcn_update_dpp(0, __float_as_int(send), 0xB1, 0xF, 0xF, false)); } } while (0)
            const bool b8 = (lane & 8) != 0, b4 = (lane & 4) != 0, b2 = (lane & 2) != 0, b1 = (lane & 1) != 0;
            for (int sl = xi; sl < 8; sl += nx) {
                const unsigned char* ub = U8 + sl * 256 + l16 * 16; const bf16* hb = H + sl * 256 + l16 * 16;
                int t = rw;
                if (t < MTOK) {
                    v4u Wa[16], Wb[16]; v4u ia0, ia1, ia2, ia3, ib0, ib1, ib2, ib3; v4u h0, h1;
                    L_LDIDS(ia, t, 0); L_LDIDS(ib, t, 1); { const GAS v4u* hp = (const GAS v4u*)(hb + (size_t)t * DM); h0 = hp[0]; h1 = hp[1]; }
                    L_ISSUE(Wa, ia, ub);
                    for (;;) {
                        const int tn = t + nW; const bool more = tn < MTOK; const int tp = more ? tn : t;
                        L_ISSUE(Wb, ib, ub);
                        L_LDIDS(ia, tp, 0); v4u hn0, hn1; { const GAS v4u* hp = (const GAS v4u*)(hb + (size_t)tp * DM); hn0 = hp[0]; hn1 = hp[1]; }
                        f32x2 hf[8];
                        hf[0] = (f32x2){bflo(h0.x), bfhi(h0.x)}; hf[1] = (f32x2){bflo(h0.y), bfhi(h0.y)}; hf[2] = (f32x2){bflo(h0.z), bfhi(h0.z)}; hf[3] = (f32x2){bflo(h0.w), bfhi(h0.w)};
                        hf[4] = (f32x2){bflo(h1.x), bfhi(h1.x)}; hf[5] = (f32x2){bflo(h1.y), bfhi(h1.y)}; hf[6] = (f32x2){bflo(h1.z), bfhi(h1.z)}; hf[7] = (f32x2){bflo(h1.w), bfhi(h1.w)};
                        float pre0, pre1;
                        L1_COMPUTE(Wa, pre0);
                        L_ISSUE(Wa, ia, ub);
                        L_LDIDS(ib, tp, 1);
                        L1_COMPUTE(Wb, pre1);
                        float* pp = PART + ((size_t)sl * MTOK + t) * 128; pp[lane] = pre0; pp[64 + lane] = pre1;
                        h0 = hn0; h1 = hn1;
                        if (!more) break;
                        t = tn;
                    }
                }
            }
#undef L1_COMPUTE
        }
        GRID_BAR();
        {
            PH_IDS();
            const float* PART = WSP(float, WS_G); const float* GATES = WSP(float, WS_GATES); float* ACTW = WSP(float, WS_ACT);
            for (int t = gw; t < MTOK; t += NGW) {
                float q0 = 0.f, q1 = 0.f;
#pragma unroll
                for (int s8 = 0; s8 < 8; ++s8) { const float* pp = PART + ((size_t)s8 * MTOK + t) * 128; q0 += pp[lane]; q1 += pp[64 + lane]; }
                q0 *= (1.f / 1024.f); q1 *= (1.f / 1024.f);
                const float* gp = GATES + (size_t)t * 128; float* ap = ACTW + (size_t)t * 128;
                const float g0 = gp[lane], g1 = gp[64 + lane];
                ap[lane] = 0.5f * q0 * (1.0f + erff(q0 * 0.70710678118654752f)) * g0 * (1.f / 64.f); ap[64 + lane] = 0.5f * q1 * (1.0f + erff(q1 * 0.70710678118654752f)) * g1 * (1.f / 64.f);
            }
        }
        GRID_BAR();
        {
            PH_IDS();
            const unsigned char* V8 = WSP(unsigned char, WS_V); const int* IDS = WSP(int, WS_IDS); const float* ACT = WSP(float, WS_ACT);
            typedef float f32x2 __attribute__((ext_vector_type(2)));
            const int myx = (int)(xb_xcc_id() & 7u); int nx = 0, xi = 0, nloc = 1;
            for (int j = 0; j < 8; ++j) { const int c = (int)__hip_atomic_load(ctl + CW_XRANK + 64 * j, __ATOMIC_RELAXED, __HIP_MEMORY_SCOPE_AGENT); if (c > 0) { ++nx; if (j < myx) ++xi; } if (j == myx) nloc = c; }
            const int rw = (int)MISC[1] * NWAVES + wave, nW = nloc * NWAVES; const int l16 = lane & 15, lrow = lane >> 4;
#if DBG_MODE == 2
            float* XO = WSP(float, WS_OC);
#else
            float* XO = X;
#endif
#define L2_COMPUTE(W, acr) do { float av[16]; _Pragma("unroll") for (int k = 0; k < 16; ++k) av[k] = bperm_f(acr, (lane & 48) + k); \
        _Pragma("unroll") for (int k = 0; k < 16; ++k) { const float a = av[k]; const f32x2 aa = (f32x2){a, a}; \
        const v4u ww = W[k]; const unsigned d0 = ww.x, d1 = ww.y, d2 = ww.z, d3 = ww.w; \
        oacc[0] += aa * L_CVT(d0, false); oacc[1] += aa * L_CVT(d0, true); oacc[2] += aa * L_CVT(d1, false); oacc[3] += aa * L_CVT(d1, true); \
        oacc[4] += aa * L_CVT(d2, false); oacc[5] += aa * L_CVT(d2, true); oacc[6] += aa * L_CVT(d3, false); oacc[7] += aa * L_CVT(d3, true); } } while (0)
            for (int sl = xi; sl < 8; sl += nx) {
                const unsigned char* vb = V8 + sl * 256 + l16 * 16; float* xb = XO + sl * 256 + l16 * 16;
                int t = rw;
                if (t < MTOK) {
                    v4u Wa[16], Wb[16]; v4u ia0, ia1, ia2, ia3, ib0, ib1, ib2, ib3; float ac0, ac1;
                    L_LDIDS(ia, t, 0); L_LDIDS(ib, t, 1); ac0 = ACT[(size_t)t * 128 + lane]; ac1 = ACT[(size_t)t * 128 + 64 + lane];
                    L_ISSUE(Wa, ia, vb);
                    for (;;) {
                        const int tn = t + nW; const bool more = tn < MTOK; const int tp = more ? tn : t;
                        L_ISSUE(Wb, ib, vb);
                        L_LDIDS(ia, tp, 0); const float an0 = ACT[(size_t)tp * 128 + lane], an1 = ACT[(size_t)tp * 128 + 64 + lane];
                        f32x2 oacc[8];
#pragma unroll
                        for (int k = 0; k < 8; ++k) oacc[k] = (f32x2){0.f, 0.f};
                        L2_COMPUTE(Wa, ac0);
                        L_ISSUE(Wa, ia, vb);
                        L_LDIDS(ib, tp, 1);
                        f32x4 xv[4]; { const GAS f32x4* q = (const GAS f32x4*)(xb + (size_t)t * DM); xv[0] = q[0]; xv[1] = q[1]; xv[2] = q[2]; xv[3] = q[3]; }
                        L2_COMPUTE(Wb, ac1);
#pragma unroll
                        for (int k = 0; k < 8; ++k) { float a = oacc[k].x, b = oacc[k].y; a += sx_f<16>(a); b += sx_f<16>(b); a = add32(a); b = add32(b); oacc[k] = (f32x2){a, b}; }
                        if (lane < 16) { GAS f32x4* q = (GAS f32x4*)(xb + (size_t)t * DM);
#pragma unroll
                            for (int k = 0; k < 4; ++k) { f32x4 v = xv[k];
#if DBG_MODE == 2
                                v = (f32x4){0.f, 0.f, 0.f, 0.f};
#endif
                                v.x += oacc[2 * k].x; v.y += oacc[2 * k].y; v.z += oacc[2 * k + 1].x; v.w += oacc[2 * k + 1].y; q[k] = v; } }
                        ac0 = an0; ac1 = an1;
                        if (!more) break;
                        t = tn;
                    }
                }
            }
#undef L2_COMPUTE
        }
#undef L_LDIDS
#undef L_ISSUE
#undef L_CVT
#endif
        GRID_BAR();
    }

    { PH_IDS();
    for (int m = gw; m < MTOK; m += NGW) {
        GAS f32x4* xr = (GAS f32x4*)(X + (size_t)m * DM) + lane; const GAS f32x4* gr = (const GAS f32x4*)INP(2) + lane;
        f32x4 v[8]; float s = 0.f;
#pragma unroll
        for (int j = 0; j < 8; ++j) { v[j] = xr[64 * j]; s += (v[j].x * v[j].x + v[j].y * v[j].y) + (v[j].z * v[j].z + v[j].w * v[j].w); }
        const float rstd = 1.0f / sqrtf(wave_sum(s) * (1.f / DM) + RMS_EPS);
#pragma unroll
        for (int j = 0; j < 8; ++j) { const f32x4 gg = gr[64 * j]; xr[64 * j] = v[j] * rstd * gg; }
    } }
}

extern "C" void kernel_launch(void* const* d_in, const int* in_sizes, int n_in, void* d_out, int out_size, void* d_ws, size_t ws_size, hipStream_t stream) {
    static int grid = 0;
    if (grid == 0) {
        if (n_in != 17 || in_sizes[0] != MTOK * DM || out_size != MTOK * DM || ws_size < WS_END) {
            fprintf(stderr, "kernel_launch: shape/workspace mismatch: n_in %d in0 %d out %d ws %zu (need %zu); nothing launched\n", n_in, n_in > 0 ? in_sizes[0] : -1, out_size, ws_size, (size_t)WS_END); grid = -1; return; }
        int dev = 0, cus = 0, per_cu = 0;
        if (hipGetDevice(&dev) != hipSuccess || hipDeviceGetAttribute(&cus, hipDeviceAttributeMultiprocessorCount, dev) != hipSuccess) { grid = -1; return; }
        if (hipFuncSetAttribute((const void*)mk_fwd, hipFuncAttributeMaxDynamicSharedMemorySize, LDS_BYTES) != hipSuccess) { fprintf(stderr, "kernel_launch: hipFuncSetAttribute failed\n"); grid = -1; return; }
        if (hipOccupancyMaxActiveBlocksPerMultiprocessor(&per_cu, (const void*)mk_fwd, NWAVES * 64, LDS_BYTES) != hipSuccess || per_cu < 1)
            fprintf(stderr, "kernel_launch: note: occupancy query reports %d workgroups per CU\n", per_cu);
        (void)hipGetLastError();
        grid = cus;
    }
    if (grid < 0) return;
    if (hipMemsetAsync((char*)d_ws + WS_CTL, 0, CTL_ZERO_BYTES, stream) != hipSuccess) { fprintf(stderr, "kernel_launch: memset failed\n"); return; }
    Args a{};
    for (int i = 0; i < 17; ++i) a.in[i] = (const float*)d_in[i];
    a.out = (float*)d_out; a.ws = (unsigned char*)d_ws;
    hipLaunchKernelGGL(mk_fwd, dim3(grid), dim3(NWAVES * 64), LDS_BYTES, stream, a);
    const hipError_t le = hipPeekAtLastError();
    if (le != hipSuccess) fprintf(stderr, "kernel_launch: launch failed: %s\n", hipGetErrorName(le));
}
```

```cpp
#include <hip/hip_runtime.h>
#include <cstdio>
#include <cstdint>

#ifndef DBG_MODE
#define DBG_MODE 0
#endif
constexpr int DM = 2048, NB = 4, SEQ = 4096, MTOK = NB * SEQ;
constexpr int INW = 14336, PJW = 8192, GTW = 6144;
constexpr int COL_DIL = 512, COL_DIFF = 5120;
constexpr int NEXP = 16384;
constexpr float RMS_EPS = 1e-6f;

typedef unsigned short bf16;
#define GAS __attribute__((address_space(1)))
#define LAS __attribute__((address_space(3)))
typedef unsigned v4u __attribute__((ext_vector_type(4)));
typedef float f32x4 __attribute__((ext_vector_type(4)));
typedef GAS unsigned gu32;

__device__ __forceinline__ int opaque_tid(int wave_sgpr) { int l; asm volatile("v_mbcnt_lo_u32_b32 %0, -1, 0\n\tv_mbcnt_hi_u32_b32 %0, -1, %0" : "=v"(l)); return wave_sgpr * 64 + l; }
namespace pg8 {
#define PG8_LAS __attribute__((address_space(3)))
typedef unsigned short bf16_t;
typedef short bf16x8 __attribute__((ext_vector_type(8)));
typedef float f32x4 __attribute__((ext_vector_type(4)));
typedef unsigned u32x4 __attribute__((ext_vector_type(4)));
typedef int i32x4 __attribute__((ext_vector_type(4)));
typedef int i32x8 __attribute__((ext_vector_type(8)));
constexpr int BM = 256, BK = 64, HALF = 128, HTB = HALF * BK * 2, STAGE_BYTES = 8 * HTB, NXCD = 8, WGM = 8;

__host__ __device__ __forceinline__ int lds_byte(int r, int c) { const int st = (r >> 4) * 2 + (c >> 5), rr = r & 15, cc = c & 31, ob = rr * 64 + cc * 2; return st * 1024 + (ob ^ (((ob >> 9) & 1) << 5)); }
__host__ __device__ __forceinline__ void stage_rc(int b, int& R, int& C) { const int st = b / 1024, sb = b % 1024, swz = sb ^ (((sb >> 9) & 1) << 5); R = (st >> 1) * 16 + swz / 64; C = (st & 1) * 32 + (swz % 64) / 2; }
__host__ __device__ __forceinline__ int perm32(int rho) { const int n = rho >> 4, i = rho & 15; return 8 * (i >> 2) + 4 * n + (i & 3); }

struct Unit { int pm, pn; long aoff, boff; int orow, ocol, sub; };
struct Gemm { const bf16_t* A; const bf16_t* Bt; };

struct StaticOrder {
    int nM, nN, nwg, G, c; long sa, sb;
    __device__ void init(int M, int N, int G_, int c_, int lda, int ldb) { nM = M / BM; nN = N / BM; nwg = nM * nN; G = G_; c = c_; sa = 512L * lda; sb = 512L * ldb; }
    __device__ bool next(int i, Unit& u) const {
        const long L = (long)i * G + c; if (L >= nwg) return false;
        int wgid = (int)L; { const int q = nwg / NXCD, r = nwg % NXCD, xcd = wgid % NXCD, off = wgid / NXCD; wgid = (xcd < r ? xcd * (q + 1) : r * (q + 1) + (xcd - r) * q) + off; }
        const int nig = WGM * nN, gid = wgid / nig, fm = gid * WGM, gsz = (nM - fm) < WGM ? (nM - fm) : WGM;
        u.pm = fm + ((wgid % nig) % gsz); u.pn = (wgid % nig) / gsz;
        u.aoff = u.pm * sa; u.boff = u.pn * sb; u.orow = u.pm * BM; u.ocol = u.pn * BM; u.sub = 0; return true;
    }
};
struct MergeOrder : StaticOrder {
    __device__ bool next(int i, Unit& u) const { if (!StaticOrder::next(i >> 2, u)) return false; u.sub = i & 3; u.aoff += 1024L * u.sub; u.boff += 1024L * u.sub; return true; }
};
struct F2Order : StaticOrder {
    __device__ bool next(int i, Unit& u) const { if (!StaticOrder::next(i, u)) return false; u.orow = (u.pn >> 1) * 4096 + u.pm * BM; u.ocol = (u.pn & 1) * BM; return true; }
};
struct F1Order {
    int G, c;
    __device__ bool next(int i, Unit& u) const {
        const int idx = i * G + c; if (idx >= 256) return false;
        const int bg = idx >> 4, st = idx & 15, b = bg >> 2, g = bg & 3;
        u.pm = 0; u.pn = idx; u.aoff = 0; u.boff = ((long)(b * 4096 + st * 256) * PJW + g * 128) * 2; u.orow = bg * 128; u.ocol = st * 256; return true;
    }
};

__device__ __forceinline__ unsigned cvt_pk_bf16(float lo, float hi) { unsigned r; asm volatile("v_cvt_pk_bf16_f32 %0, %1, %2" : "=v"(r) : "v"(lo), "v"(hi)); return r; }
__device__ __forceinline__ float bf_lo(unsigned w) { return __uint_as_float(w << 16); }
__device__ __forceinline__ float bf_hi(unsigned w) { return __uint_as_float(w & 0xffff0000u); }

#define PG8_PACK(v0, v1, w) do { (w).x = cvt_pk_bf16((v0)[0], (v0)[1]); (w).y = cvt_pk_bf16((v0)[2], (v0)[3]); (w).z = cvt_pk_bf16((v1)[0], (v1)[1]); (w).w = cvt_pk_bf16((v1)[2], (v1)[3]); } while (0)

struct EpiStore {
    static constexpr bool PERM = true;
    bf16_t* O; int ldo;
    __device__ __forceinline__ bool operator()(f32x4 (&acc)[2][2][4][2], const Unit& u, int wr, int wc, int fr, int fq) const {
        const int row0 = u.orow + wr * 64 + fr, col0 = u.ocol + wc * 32 + 8 * fq;
#pragma unroll
        for (int ai = 0; ai < 2; ++ai)
#pragma unroll
            for (int m = 0; m < 4; ++m) { bf16_t* rowp = O + (size_t)(row0 + ai * HALF + m * 16) * ldo + col0;
#pragma unroll
                for (int bj = 0; bj < 2; ++bj) { u32x4 w; PG8_PACK(acc[ai][bj][m][0], acc[ai][bj][m][1], w); *(u32x4*)(rowp + bj * HALF) = w; } }
        return true;
    }
};
struct EpiZT {
    static constexpr bool PERM = true;
    bf16_t* O;
    __device__ __forceinline__ bool operator()(f32x4 (&acc)[2][2][4][2], const Unit& u, int wr, int wc, int fr, int fq) const {
        const int row0 = u.orow + wr * 64 + fr, col0 = u.ocol + wc * 32 + 8 * fq;
#pragma unroll
        for (int ai = 0; ai < 2; ++ai)
#pragma unroll
            for (int m = 0; m < 4; ++m) { bf16_t* rowp = O + (size_t)(row0 + m * 16) * 8192 + ai * 4096 + col0;
#pragma unroll
                for (int bj = 0; bj < 2; ++bj) { u32x4 w; PG8_PACK(acc[ai][bj][m][0], acc[ai][bj][m][1], w); *(u32x4*)(rowp + bj * HALF) = w; } }
        return true;
    }
};
struct EpiProj {
    static constexpr bool PERM = true;
    bf16_t* P; bf16_t* Gt; const float* bg; int pnoff; float scale;
    __device__ __forceinline__ bool operator()(f32x4 (&acc)[2][2][4][2], const Unit& u, int wr, int wc, int fr, int fq) const {
        const int pnn = u.pn + pnoff; const bool isg = pnn >= 32;
        const int row0 = u.pm * BM + wr * 64 + fr, col0 = (isg ? pnn - 32 : pnn) * BM + wc * 32 + 8 * fq, ldc = isg ? GTW : PJW;
        bf16_t* base = isg ? Gt : P;
        f32x4 bv[2][2];
#pragma unroll
        for (int bj = 0; bj < 2; ++bj)
#pragma unroll
            for (int n = 0; n < 2; ++n) bv[bj][n] = isg ? *(const f32x4*)(bg + col0 + bj * HALF + 4 * n) : (f32x4){0.f, 0.f, 0.f, 0.f};
#pragma unroll
        for (int ai = 0; ai < 2; ++ai)
#pragma unroll
            for (int m = 0; m < 4; ++m) { bf16_t* rowp = base + (size_t)(row0 + ai * HALF + m * 16) * ldc + col0;
#pragma unroll
                for (int bj = 0; bj < 2; ++bj) { f32x4 v0 = acc[ai][bj][m][0] * scale + bv[bj][0], v1 = acc[ai][bj][m][1] * scale + bv[bj][1];
                    if (isg) {
#pragma unroll
                        for (int j = 0; j < 4; ++j) { v0[j] = __builtin_amdgcn_rcpf(1.0f + __builtin_amdgcn_exp2f(-1.4426950408889634f * v0[j])); v1[j] = __builtin_amdgcn_rcpf(1.0f + __builtin_amdgcn_exp2f(-1.4426950408889634f * v1[j])); } }
                    u32x4 w; PG8_PACK(v0, v1, w); *(u32x4*)(rowp + bj * HALF) = w; } }
        return true;
    }
};
struct EpiMerge4 {
    static constexpr bool PERM = true;
    const bf16_t* Gt; bf16_t* O;
    __device__ __forceinline__ bool operator()(f32x4 (&acc)[2][2][4][2], const Unit& u, int wr, int wc, int fr, int fq) const {
        const int row0 = u.pm * BM + wr * 64 + fr, col0 = u.pn * BM + wc * 32 + 8 * fq;
        if (u.sub == 2) return false;
        if (u.sub < 2) {
#pragma unroll
            for (int ai = 0; ai < 2; ++ai)
#pragma unroll
                for (int m = 0; m < 4; ++m) { const bf16_t* gp = Gt + (size_t)(row0 + ai * HALF + m * 16) * GTW + u.sub * DM + col0;
#pragma unroll
                    for (int bj = 0; bj < 2; ++bj) { const u32x4 gn = *(const u32x4*)(gp + bj * HALF), gd = *(const u32x4*)(gp + DM + bj * HALF);
                        f32x4 r0, r1;
                        r0[0] = bf_lo(gn.x) * __builtin_amdgcn_rcpf(bf_lo(gd.x)); r0[1] = bf_hi(gn.x) * __builtin_amdgcn_rcpf(bf_hi(gd.x));
                        r0[2] = bf_lo(gn.y) * __builtin_amdgcn_rcpf(bf_lo(gd.y)); r0[3] = bf_hi(gn.y) * __builtin_amdgcn_rcpf(bf_hi(gd.y));
                        r1[0] = bf_lo(gn.z) * __builtin_amdgcn_rcpf(bf_lo(gd.z)); r1[1] = bf_hi(gn.z) * __builtin_amdgcn_rcpf(bf_hi(gd.z));
                        r1[2] = bf_lo(gn.w) * __builtin_amdgcn_rcpf(bf_lo(gd.w)); r1[3] = bf_hi(gn.w) * __builtin_amdgcn_rcpf(bf_hi(gd.w));
                        acc[ai][bj][m][0] *= r0; acc[ai][bj][m][1] *= r1; }
                    asm volatile("" ::: "memory"); }
            return false;
        }
#pragma unroll
        for (int ai = 0; ai < 2; ++ai)
#pragma unroll
            for (int m = 0; m < 4; ++m) { const bf16_t* gp = Gt + (size_t)(row0 + ai * HALF + m * 16) * GTW + 2 * DM + col0; bf16_t* rowp = O + (size_t)(row0 + ai * HALF + m * 16) * DM + col0;
#pragma unroll
                for (int bj = 0; bj < 2; ++bj) { const u32x4 g = *(const u32x4*)(gp + bj * HALF);
                    f32x4 v0 = acc[ai][bj][m][0], v1 = acc[ai][bj][m][1];
                    v0[0] *= bf_lo(g.x); v0[1] *= bf_hi(g.x); v0[2] *= bf_lo(g.y); v0[3] *= bf_hi(g.y);
                    v1[0] *= bf_lo(g.z); v1[1] *= bf_hi(g.z); v1[2] *= bf_lo(g.w); v1[3] *= bf_hi(g.w);
                    u32x4 w; PG8_PACK(v0, v1, w); *(u32x4*)(rowp + bj * HALF) = w; }
                asm volatile("" ::: "memory"); }
        return true;
    }
};
struct EpiResF32 {
    static constexpr bool PERM = false;
    const float* base; float* out; int ldc;
    __device__ __forceinline__ bool operator()(f32x4 (&acc)[2][2][4][2], const Unit& u, int wr, int wc, int fr, int fq) const {
        const int row0 = u.orow + wr * 64 + fr, col0 = u.ocol + wc * 32 + 4 * fq;
#pragma unroll
        for (int ai = 0; ai < 2; ++ai)
#pragma unroll
            for (int m = 0; m < 4; ++m) { const size_t off = (size_t)(row0 + ai * HALF + m * 16) * ldc + col0;
#pragma unroll
                for (int bj = 0; bj < 2; ++bj)
#pragma unroll
                    for (int n = 0; n < 2; ++n) { f32x4 v = acc[ai][bj][m][n]; if (base) v += *(const f32x4*)(base + off + bj * HALF + n * 16); *(f32x4*)(out + off + bj * HALF + n * 16) = v; }
                asm volatile("" ::: "memory"); }
        return true;
    }
};

template <class Epi, class Sched, bool ALIGN_EPI, int LDA, int LDB, int KK, bool F8 = false>
__device__ __forceinline__ void gemm_phase(PG8_LAS unsigned char* lds, const Gemm g, const Sched& S, const Epi& E, int wave0) {
    const int tid = opaque_tid(wave0), wid = wave0, lane = tid & 63, wr = wid >> 2, wc = wid & 3, fr = lane & 15, fq = lane >> 4;
    constexpr int nt = KK / BK;
    unsigned voffA[2], voffB[2];
#pragma unroll
    for (int i = 0; i < 2; ++i) { int R, C; stage_rc(tid * 16 + i * 8192, R, C); const int Rb = Epi::PERM ? ((R & ~31) + perm32(R & 31)) : R;
        voffA[i] = (unsigned)(R * LDA + C) * 2u; voffB[i] = (unsigned)(Rb * LDB + C) * 2u; }
    const size_t kstep = (size_t)(BK * 2);
    constexpr size_t hstepA = (size_t)HALF * LDA * 2, hstepB = (size_t)HALF * LDB * 2;
    const unsigned ldsw = (unsigned)wid * 1024u;
    const int aoff = lds_byte(wr * 64 + fr, fq * 8), boff = lds_byte(wc * 32 + fr, fq * 8);
#define PG8_SA(b, h) (((b) * 2 + (h)) * HTB)
#define PG8_SB(b, h) ((4 + (b) * 2 + (h)) * HTB)
#define PG8_STAGE(bufoff, gbase, voff) do { _Pragma("unroll") for (int _i = 0; _i < 2; ++_i) \
        __builtin_amdgcn_global_load_lds((const unsigned*)((const char*)(gbase) + (voff)[_i]), (PG8_LAS unsigned*)(lds + (bufoff) + ldsw + _i * 8192), 16, 0, 0); } while (0)
#define PG8_LDA(dst, b, h) do { _Pragma("unroll") for (int m = 0; m < 4; ++m) _Pragma("unroll") for (int k = 0; k < 2; ++k) dst[m][k] = *(const PG8_LAS bf16x8*)(lds + PG8_SA(b, h) + aoff + m * 2048 + k * 1024); } while (0)
#define PG8_LDB(dst, b, h) do { _Pragma("unroll") for (int n = 0; n < 2; ++n) _Pragma("unroll") for (int k = 0; k < 2; ++k) dst[n][k] = *(const PG8_LAS bf16x8*)(lds + PG8_SB(b, h) + boff + n * 2048 + k * 1024); } while (0)
#define PG8_CAT(x) __builtin_shufflevector(__builtin_bit_cast(i32x4, (x)[0]), __builtin_bit_cast(i32x4, (x)[1]), 0, 1, 2, 3, 4, 5, 6, 7)
#define PG8_MMA(ai, bj, At, Bt) do { __builtin_amdgcn_s_setprio(1); _Pragma("unroll") for (int m = 0; m < 4; ++m) _Pragma("unroll") for (int n = 0; n < 2; ++n) { \
        if constexpr (F8) { const i32x8 a8_ = PG8_CAT(Bt[n]), b8_ = PG8_CAT(At[m]); asm volatile("v_mfma_scale_f32_16x16x128_f8f6f4 %0, %1, %2, %0, %3, %3 op_sel_hi:[0,0,0]" : "+v"(acc[ai][bj][m][n]) : "v"(a8_), "v"(b8_), "v"(one8)); } \
        else { _Pragma("unroll") for (int k = 0; k < 2; ++k) acc[ai][bj][m][n] = __builtin_amdgcn_mfma_f32_16x16x32_bf16(Bt[n][k], At[m][k], acc[ai][bj][m][n], 0, 0, 0); } } __builtin_amdgcn_s_setprio(0); } while (0)
#define PG8_WAIT_V(n) asm volatile("s_waitcnt vmcnt(" #n ")" ::: "memory")
#define PG8_WAIT_L(n) asm volatile("s_waitcnt lgkmcnt(" #n ")" ::: "memory")
#define PG8_BAR __builtin_amdgcn_s_barrier()
#define PG8_SCHED __builtin_amdgcn_sched_barrier(0)
    Unit cur, nxt; int ui = 0;
    if (!S.next(0, cur)) return;
    const int one8 = 0x7f7f7f7f; (void)one8;
    f32x4 acc[2][2][4][2];
#pragma unroll
    for (int a = 0; a < 2; ++a)
#pragma unroll
        for (int b = 0; b < 2; ++b)
#pragma unroll
            for (int m = 0; m < 4; ++m)
#pragma unroll
                for (int n = 0; n < 2; ++n) acc[a][b][m][n] = (f32x4){0.f, 0.f, 0.f, 0.f};
    bf16x8 At[4][2], B0[2][2], B1[2][2];
    const char* cA = (const char*)g.A + cur.aoff; const char* cB = (const char*)g.Bt + cur.boff;
    PG8_STAGE(PG8_SB(0, 0), cB, voffB); PG8_STAGE(PG8_SB(0, 1), cB + hstepB, voffB); PG8_STAGE(PG8_SA(0, 0), cA, voffA); PG8_STAGE(PG8_SA(0, 1), cA + hstepA, voffA);
    if (wr == 1) PG8_BAR;
    PG8_WAIT_V(2); PG8_BAR;
    PG8_STAGE(PG8_SB(1, 0), cB + kstep, voffB); PG8_STAGE(PG8_SA(1, 0), cA + kstep, voffA); PG8_STAGE(PG8_SB(1, 1), cB + hstepB + kstep, voffB);
    PG8_WAIT_V(6); PG8_BAR;
    for (;;) {
        const bool has_next = S.next(ui + 1, nxt);
        const char* nA = has_next ? (const char*)g.A + nxt.aoff : cA; const char* nB = has_next ? (const char*)g.Bt + nxt.boff : cB;
        for (int t = 0; t < nt; t += 2) {
            const bool last = (t == nt - 2);
            const char* a1 = cA + (size_t)(t + 1) * kstep;
            const char* a2 = last ? nA : cA + (size_t)(t + 2) * kstep; const char* b2 = last ? nB : cB + (size_t)(t + 2) * kstep;
            const char* a3 = a2 + kstep; const char* b3 = b2 + kstep;
            PG8_LDB(B0, 0, 0); PG8_LDB(B1, 0, 1); PG8_SCHED; PG8_LDA(At, 0, 0); PG8_STAGE(PG8_SA(1, 1), a1 + hstepA, voffA);
            PG8_WAIT_V(8); PG8_WAIT_L(0); PG8_BAR; PG8_MMA(0, 0, At, B0); PG8_MMA(0, 1, At, B1); PG8_BAR; PG8_SCHED;
            PG8_LDA(At, 0, 1); PG8_STAGE(PG8_SB(0, 0), b2, voffB); PG8_STAGE(PG8_SB(0, 1), b2 + hstepB, voffB); PG8_STAGE(PG8_SA(0, 0), a2, voffA);
            PG8_WAIT_V(8); PG8_WAIT_L(0); PG8_BAR; PG8_MMA(1, 0, At, B0); PG8_MMA(1, 1, At, B1); PG8_BAR; PG8_SCHED;
            PG8_LDB(B0, 1, 0); PG8_LDB(B1, 1, 1); PG8_SCHED; PG8_LDA(At, 1, 0); PG8_STAGE(PG8_SA(0, 1), a2 + hstepA, voffA);
            PG8_WAIT_V(8); PG8_WAIT_L(0); PG8_BAR; PG8_MMA(0, 0, At, B0); PG8_MMA(0, 1, At, B1); PG8_BAR; PG8_SCHED;
            PG8_LDA(At, 1, 1); PG8_STAGE(PG8_SB(1, 0), b3, voffB); PG8_STAGE(PG8_SB(1, 1), b3 + hstepB, voffB); PG8_STAGE(PG8_SA(1, 0), a3, voffA);
            PG8_WAIT_V(8); PG8_WAIT_L(0); PG8_BAR; PG8_MMA(1, 0, At, B0); PG8_MMA(1, 1, At, B1); PG8_BAR; PG8_SCHED;
        }
        if constexpr (ALIGN_EPI) { if (wr == 0) PG8_BAR; }
        if constexpr (F8) asm volatile("s_nop 15\n\ts_nop 15" ::: "memory");
        const bool fin = E(acc, cur, wr, wc, fr, fq);
        if (!has_next) break;
        if (fin) {
#pragma unroll
        for (int a = 0; a < 2; ++a)
#pragma unroll
            for (int b = 0; b < 2; ++b)
#pragma unroll
                for (int m = 0; m < 4; ++m)
#pragma unroll
                    for (int n = 0; n < 2; ++n) acc[a][b][m][n] = (f32x4){0.f, 0.f, 0.f, 0.f};
        }
        cur = nxt; cA = nA; cB = nB; ++ui;
        if constexpr (ALIGN_EPI) { if (wr == 1) PG8_BAR; }
    }
    PG8_WAIT_V(0);
    if constexpr (!ALIGN_EPI) { if (wr == 0) PG8_BAR; }
    PG8_BAR;
#undef PG8_SA
#undef PG8_SB
#undef PG8_STAGE
#undef PG8_LDA
#undef PG8_LDB
#undef PG8_MMA
#undef PG8_CAT
#undef PG8_WAIT_V
#undef PG8_WAIT_L
#undef PG8_BAR
#undef PG8_SCHED
}
}

namespace attn {
using bf16x8 = __attribute__((ext_vector_type(8))) short;
using s16x4  = __attribute__((ext_vector_type(4))) short;
using f32x16 = __attribute__((ext_vector_type(16))) float;
using u32x4  = __attribute__((ext_vector_type(4))) unsigned;
constexpr int   D = 128, NW = 8, QBLK = 32, KVBLK = 64;
constexpr float SCALE = 0.088388347648318440f;
constexpr float THR = 8.f;
constexpr size_t SHM_V = KVBLK * D * 2, SHM_K = KVBLK * D * 2;
constexpr int LDS_WS = 2 * SHM_V + 2 * SHM_K, LDS_TAB = LDS_WS + NW * 64 * 4, LDS_END = LDS_TAB + 8192 * 4;
#define KSWZ(row, colB) ((row) * 256 + ((colB) ^ (((row) & 7) << 4)))
#define SBAR() __builtin_amdgcn_sched_barrier(0)
__device__ __forceinline__ int crow(int r, int hi) { return (r & 3) + 8 * (r >> 2) + 4 * hi; }
__device__ __forceinline__ unsigned cvtpk(float lo, float hi) { unsigned r; asm volatile("v_cvt_pk_bf16_f32 %0, %1, %2" : "=v"(r) : "v"(lo), "v"(hi)); return r; }

__device__ __forceinline__ void partialSM(f32x16& p0, f32x16& p1, float& m_reg, float& mn, float& alpha) {
  constexpr float C = SCALE * 1.4426950408889634f;
  float pmax = p0[0]; for (int r = 1; r < 16; ++r) pmax = fmaxf(pmax, p0[r]); for (int r = 0; r < 16; ++r) pmax = fmaxf(pmax, p1[r]);
  { auto rr = __builtin_amdgcn_permlane32_swap(__float_as_uint(pmax), __float_as_uint(pmax), false, false);
    pmax = fmaxf(__uint_as_float(rr[0]), __uint_as_float(rr[1])); }
  if (__builtin_expect(__all(pmax - m_reg <= THR / SCALE), 1)) { mn = m_reg; alpha = 1.f; }
  else { mn = fmaxf(m_reg, pmax); alpha = __builtin_amdgcn_exp2f((m_reg - mn) * C); m_reg = mn; }
  float mnC = -mn * C;
  for (int r = 0; r < 16; ++r) p0[r] = fmaf(p0[r], C, mnC); for (int r = 0; r < 16; ++r) p1[r] = fmaf(p1[r], C, mnC);
  for (int r = 0; r < 16; ++r) p0[r] = __builtin_amdgcn_exp2f(p0[r]);
}
__device__ __forceinline__ void finishSM(f32x16& p0, f32x16& p1, float alpha, float& l_reg, bf16x8& pa0, bf16x8& pa1, bf16x8& pa2, bf16x8& pa3) {
  for (int r = 0; r < 16; ++r) p1[r] = __builtin_amdgcn_exp2f(p1[r]);
  float ps = 0; for (int r = 0; r < 16; ++r) ps += p0[r]; for (int r = 0; r < 16; ++r) ps += p1[r];
  { auto rr = __builtin_amdgcn_permlane32_swap(__float_as_uint(ps), __float_as_uint(ps), false, false);
    ps = __uint_as_float(rr[0]) + __uint_as_float(rr[1]); }
  l_reg = l_reg * alpha + ps;
#define PK4(P, BASE, OUT) do { unsigned a0 = cvtpk(P[BASE + 0], P[BASE + 1]), a1 = cvtpk(P[BASE + 2], P[BASE + 3]);   \
    unsigned b0 = cvtpk(P[BASE + 4], P[BASE + 5]), b1 = cvtpk(P[BASE + 6], P[BASE + 7]);                              \
    auto r0 = __builtin_amdgcn_permlane32_swap(a0, b0, false, false); auto r1 = __builtin_amdgcn_permlane32_swap(a1, b1, false, false); \
    u32x4 w = {r0[0], r1[0], r0[1], r1[1]}; OUT = *reinterpret_cast<bf16x8*>(&w); } while (0)
  PK4(p0, 0, pa0); PK4(p0, 8, pa1); PK4(p1, 0, pa2); PK4(p1, 8, pa3);
#undef PK4
}
__device__ __forceinline__ void qkt(f32x16& p0, f32x16& p1, const bf16* Ks, const bf16x8* qr, int r32, int hi, const float* tl) {
#pragma unroll
  for (int r = 0; r < 16; ++r) { p0[r] = tl[(r & 3) + 8 * (r >> 2)]; p1[r] = tl[32 + (r & 3) + 8 * (r >> 2)]; }
#pragma unroll
  for (int d0 = 0; d0 < 8; ++d0) { int cb = (d0 * 16 + hi * 8) * 2;
    bf16x8 b0 = *reinterpret_cast<const bf16x8*>((const char*)Ks + KSWZ(r32, cb));
    bf16x8 b1 = *reinterpret_cast<const bf16x8*>((const char*)Ks + KSWZ(32 + r32, cb));
    p0 = __builtin_amdgcn_mfma_f32_32x32x16_bf16(b0, qr[d0], p0, 0, 0, 0);
    p1 = __builtin_amdgcn_mfma_f32_32x32x16_bf16(b1, qr[d0], p1, 0, 0, 0); }
}
__device__ __forceinline__ int v_st(int k, int c) { const int kk = (k & ~0xC) | ((k & 4) << 1) | ((k & 8) >> 1); return ((kk >> 3) * 4 + (c >> 5)) * 512 + ((kk & 7) * 32 + (c & 31)) * 2; }
__device__ __forceinline__ int v_rd_base(int lane) { return ((lane & 3) << 3) | (((lane >> 2) & 3) << 6) | (((lane >> 4) & 1) << 5) | (((lane >> 5) & 1) << 8); }
constexpr int v_rd_off(int d0, int ks, int half) { return d0 * 512 + ks * 4096 + half * 2048; }
template <int OFF> __device__ __forceinline__ s16x4 tr_read(int vb) {
  s16x4 r; asm volatile("ds_read_b64_tr_b16 %0, %1 offset:%2" : "=&v"(r) : "v"(vb), "i"(OFF) : "memory"); return r;
}
template <int D0> __device__ __forceinline__ void pv_one(f32x16& od, int vb, bf16x8 pa0, bf16x8 pa1, bf16x8 pa2, bf16x8 pa3) {
  const s16x4 l0 = tr_read<v_rd_off(D0, 0, 0)>(vb), h0 = tr_read<v_rd_off(D0, 0, 1)>(vb), l1 = tr_read<v_rd_off(D0, 1, 0)>(vb), h1 = tr_read<v_rd_off(D0, 1, 1)>(vb);
  const s16x4 l2 = tr_read<v_rd_off(D0, 2, 0)>(vb), h2 = tr_read<v_rd_off(D0, 2, 1)>(vb), l3 = tr_read<v_rd_off(D0, 3, 0)>(vb), h3 = tr_read<v_rd_off(D0, 3, 1)>(vb);
  asm volatile("s_waitcnt lgkmcnt(0)" ::: "memory"); SBAR();
#define PK(L, H) (bf16x8){L[0], L[1], L[2], L[3], H[0], H[1], H[2], H[3]}
  od = __builtin_amdgcn_mfma_f32_32x32x16_bf16(pa0, PK(l0, h0), od, 0, 0, 0);
  od = __builtin_amdgcn_mfma_f32_32x32x16_bf16(pa1, PK(l1, h1), od, 0, 0, 0);
  od = __builtin_amdgcn_mfma_f32_32x32x16_bf16(pa2, PK(l2, h2), od, 0, 0, 0);
  od = __builtin_amdgcn_mfma_f32_32x32x16_bf16(pa3, PK(l3, h3), od, 0, 0, 0);
#undef PK
}
__device__ __forceinline__ void pv_d0(f32x16* o, int vb, bf16x8 pa0, bf16x8 pa1, bf16x8 pa2, bf16x8 pa3) {
  pv_one<0>(o[0], vb, pa0, pa1, pa2, pa3); pv_one<1>(o[1], vb, pa0, pa1, pa2, pa3); pv_one<2>(o[2], vb, pa0, pa1, pa2, pa3); pv_one<3>(o[3], vb, pa0, pa1, pa2, pa3);
}

struct Unit { const bf16* Q; const bf16* K; const bf16* V; bf16* O; float* lse; long ldq, ldk, ldo; int lse_ld, kt0, nt, qoff; };
__device__ __forceinline__ void attn_unit(const Unit& u, char* lds, int wave0) {
  const int tid = opaque_tid(wave0), wid = wave0, lane = tid & 63, r32 = lane & 31, hi = lane >> 5;
  bf16* V_lds = (bf16*)lds; bf16* K_lds = (bf16*)(lds + 2 * SHM_V);
  float* ws = (float*)(lds + LDS_WS) + wid * 64; float* li_l = ws; float* al_l = ws + 32;
  const float* tabL = (const float*)(lds + LDS_TAB);
  float m_reg = -1e30f, l_reg = 0; f32x16 o[4] = {}; bf16x8 qr[8];
  const bf16* Qw = u.Q + (long)(wid * QBLK + r32) * u.ldq + hi * 8;
#pragma unroll
  for (int d0 = 0; d0 < 8; ++d0) qr[d0] = *reinterpret_cast<const bf16x8*>(Qw + d0 * 16);
  const int sr = tid >> 4, sc = (tid & 15) * 8, vst0 = v_st(sr, sc), vst1 = v_st(32 + sr, sc);
  const int vb0 = (int)(uintptr_t)V_lds + v_rd_base(lane);
  const long tstep = (long)KVBLK * u.ldk * 2;
  const char* Kh = (const char*)u.K + (long)u.kt0 * tstep; const char* Vh = (const char*)u.V + (long)u.kt0 * tstep;
  const unsigned lo0 = (unsigned)((sr * (int)u.ldk + sc) * 2), lo1 = lo0 + (unsigned)(32 * (int)u.ldk * 2);
  const float* tl0 = tabL + (4096 + u.kt0 * KVBLK + 4 * hi - (u.qoff + wid * QBLK + r32));
  struct { bf16x8 vs0, vs1, ks0, ks1; } sr_[2];
#define SLOAD(i, tj) do { const char* vt_ = Vh + (long)(tj) * tstep; const char* kt_ = Kh + (long)(tj) * tstep; \
    sr_[i].vs0 = *reinterpret_cast<const bf16x8*>(vt_ + lo0); sr_[i].vs1 = *reinterpret_cast<const bf16x8*>(vt_ + lo1); \
    sr_[i].ks0 = *reinterpret_cast<const bf16x8*>(kt_ + lo0); sr_[i].ks1 = *reinterpret_cast<const bf16x8*>(kt_ + lo1); } while (0)
#define SWRITE(b, i) do { *(bf16x8*)((char*)V_lds + (b) * SHM_V + vst0) = sr_[i].vs0;          \
    *(bf16x8*)((char*)V_lds + (b) * SHM_V + vst1) = sr_[i].vs1; int kc = sc * 2;               \
    *(bf16x8*)((char*)K_lds + (b) * SHM_K + KSWZ(sr, kc)) = sr_[i].ks0;                       \
    *(bf16x8*)((char*)K_lds + (b) * SHM_K + KSWZ(32 + sr, kc)) = sr_[i].ks1; } while (0)
#define SWAIT() asm volatile("s_waitcnt vmcnt(4)" ::: "memory")
#define RESC(a) do { if (__any((a) < 1.f)) { if (hi == 0) al_l[r32] = (a); asm volatile("s_waitcnt lgkmcnt(0)" ::: "memory"); \
    for (int d = 0; d < 4; ++d) for (int r = 0; r < 16; ++r) o[d][r] *= al_l[crow(r, hi)]; } } while (0)
  f32x16 pA0, pA1, pB0, pB1; float mnA, mnB, alA, alB; bf16x8 pa0, pa1, pa2, pa3; const int NT = u.nt;
  constexpr int SE = 0, SO = 1;
  SLOAD(SE, 0); asm volatile("s_waitcnt vmcnt(0)" ::: "memory"); SWRITE(0, SE); __syncthreads();
  qkt(pA0, pA1, K_lds, qr, r32, hi, tl0); partialSM(pA0, pA1, m_reg, mnA, alA);
  SLOAD(SO, 1); if (2 < NT) SLOAD(SE, 2);
  SWAIT(); SWRITE(1, SO); __syncthreads();
  for (int j = 1; j + 1 < NT; j += 2) {
    SBAR(); qkt(pB0, pB1, (bf16*)((char*)K_lds + SHM_K), qr, r32, hi, tl0 + j * KVBLK);
    finishSM(pA0, pA1, alA, l_reg, pa0, pa1, pa2, pa3); SBAR();
    SLOAD(SO, j + 2); SBAR();
    pv_d0(o, vb0, pa0, pa1, pa2, pa3); partialSM(pB0, pB1, m_reg, mnB, alB);
    __syncthreads(); SWAIT(); SWRITE(0, SE);
    RESC(alB); __syncthreads();
    SBAR(); qkt(pA0, pA1, K_lds, qr, r32, hi, tl0 + (j + 1) * KVBLK);
    finishSM(pB0, pB1, alB, l_reg, pa0, pa1, pa2, pa3); SBAR();
    if (j + 3 < NT) SLOAD(SE, j + 3); SBAR();
    pv_d0(o, vb0 + (int)SHM_V, pa0, pa1, pa2, pa3); partialSM(pA0, pA1, m_reg, mnA, alA);
    __syncthreads(); SWAIT(); SWRITE(1, SO);
    RESC(alA); __syncthreads();
  }
  SBAR(); qkt(pB0, pB1, (bf16*)((char*)K_lds + SHM_K), qr, r32, hi, tl0 + (NT - 1) * KVBLK);
  finishSM(pA0, pA1, alA, l_reg, pa0, pa1, pa2, pa3); SBAR();
  pv_d0(o, vb0, pa0, pa1, pa2, pa3); partialSM(pB0, pB1, m_reg, mnB, alB);
  __syncthreads(); RESC(alB);
  finishSM(pB0, pB1, alB, l_reg, pa0, pa1, pa2, pa3); SBAR();
  pv_d0(o, vb0 + (int)SHM_V, pa0, pa1, pa2, pa3);
  if (hi == 0) li_l[r32] = l_reg; asm volatile("s_waitcnt lgkmcnt(0)" ::: "memory");
  float rli[16];
#pragma unroll
  for (int r = 0; r < 16; ++r) rli[r] = __builtin_amdgcn_rcpf(li_l[crow(r, hi)]);
  bf16* Ow = u.O + (long)(wid * QBLK) * u.ldo;
#pragma unroll
  for (int r = 0; r < 16; ++r) { int orow = crow(r, hi);
#pragma unroll
    for (int d0 = 0; d0 < 4; ++d0) { const float v = o[d0][r] * rli[r]; Ow[(long)orow * u.ldo + d0 * 32 + r32] = (bf16)(cvtpk(v, v) & 0xffffu); } }
  if (u.lse != nullptr && hi == 0) u.lse[(long)(wid * QBLK + r32) * u.lse_ld] = m_reg * SCALE + __logf(l_reg);
#undef SLOAD
#undef SWRITE
#undef SWAIT
#undef RESC
}
#undef KSWZ
#undef SBAR
}

constexpr int NWAVES = 8;
constexpr size_t MiB = 1u << 20;
constexpr size_t WS_CTL = 0, CTL_ZERO_BYTES = 1 * MiB;
constexpr size_t WS_CS   = 1 * MiB;
constexpr size_t WS_SKBD = 1 * MiB + 256 * 1024;
constexpr size_t WS_TAB  = 2 * MiB;
constexpr size_t WS_LSE  = 3 * MiB;
constexpr size_t WS_SU   = 3 * MiB + 768 * 1024;
constexpr size_t WS_SH   = 3 * MiB + 832 * 1024;
constexpr size_t WS_WCAT = 4 * MiB, WS_WO = 12 * MiB, WS_WQ = 20 * MiB;
constexpr size_t WS_WIN  = 28 * MiB;
constexpr size_t WS_WG8  = WS_WIN + 32 * MiB;
constexpr size_t WS_DFT  = 84 * MiB;
constexpr size_t WS_U    = 148 * MiB, WS_V = 180 * MiB;
constexpr size_t WS_H8   = 212 * MiB;
constexpr size_t WS_H    = 276 * MiB;
constexpr size_t WS_PROJ = 340 * MiB;
constexpr size_t WS_G    = 596 * MiB;
constexpr size_t WS_ZT   = 788 * MiB;
constexpr size_t WS_OC   = 820 * MiB;
constexpr size_t WS_MG   = 884 * MiB;
constexpr size_t WS_END  = 948 * MiB;
#if DBG_MODE == 2
constexpr size_t WS_ACT = WS_PROJ + 208 * MiB;
#else
constexpr size_t WS_ACT = WS_PROJ + 200 * MiB;
#endif
constexpr size_t WS_Q = WS_PROJ, WS_SC = WS_PROJ + 64 * MiB, WS_IDS = WS_PROJ + 192 * MiB, WS_GATES = WS_PROJ + 200 * MiB;
constexpr int CW_BAR = 4096;
constexpr int CW_XRANK = 12288;
constexpr int CW_QUEUE = 16384;
constexpr int RING_BYTES = 131072, LDSCTL_OFF = RING_BYTES, MISC_OFF = LDSCTL_OFF + 320, LDS_BYTES = 147456;

#define LDS_WAIT() asm volatile("s_waitcnt lgkmcnt(0)" ::: "memory")
#define VM_WAIT() asm volatile("s_waitcnt vmcnt(0)" ::: "memory")
__device__ __forceinline__ unsigned f2bf(float f) { unsigned u = __builtin_bit_cast(unsigned, f); return (u + 0x7fffu + ((u >> 16) & 1u)) >> 16; }
__device__ __forceinline__ unsigned pk2(float lo, float hi) { return f2bf(lo) | (f2bf(hi) << 16); }
__device__ __forceinline__ float bflo(unsigned w) { return __uint_as_float(w << 16); }
__device__ __forceinline__ float bfhi(unsigned w) { return __uint_as_float(w & 0xffff0000u); }

#define XB_TMO      128
#define XB_XCNT(j)  (256  + 64 * (j))
#define XB_XSUB(j)  (1280 + 64 * (j))
#define XB_XGEN(j)  (2304 + 64 * (j))
#define XB_TOP      3328
#define XB_TOPGEN   3392
#define XCD_BAR_WORDS 3456
#define XB_SPIN_CAP (1u << 20)
__device__ __forceinline__ unsigned xb_ld(unsigned* p)              { return __hip_atomic_load(p, __ATOMIC_RELAXED, __HIP_MEMORY_SCOPE_AGENT); }
__device__ __forceinline__ unsigned xb_add(unsigned* p, unsigned v) { return __hip_atomic_fetch_add(p, v, __ATOMIC_RELAXED, __HIP_MEMORY_SCOPE_AGENT); }
__device__ __forceinline__ unsigned xb_xcc_id() { return (unsigned)__builtin_amdgcn_s_getreg((3 << 11) | 20) & 0xFu; }
#define XB_SPIN(cond, bar) do { unsigned _sp = 0; while (cond) { __builtin_amdgcn_s_sleep(1); \
    if ((++_sp & 255u) == 0u) { if (xb_ld(&(bar)[XB_TMO])) break; if (_sp > XB_SPIN_CAP) { atomicAdd(&(bar)[XB_TMO], 1u); break; } } } } while (0)
struct XcdBarrier { unsigned* bar; unsigned x; volatile LAS unsigned* st; };
__device__ __forceinline__ XcdBarrier xcd_barrier_post(unsigned* bar, volatile LAS unsigned* st) {
    XcdBarrier b; b.bar = bar; b.x = xb_xcc_id(); b.st = st;
    if (threadIdx.x == 0) (void)xb_add(&bar[XB_XCNT(b.x)], 1u);
    return b;
}
__device__ __forceinline__ void xcd_barrier_complete(unsigned* bar, unsigned x, unsigned& nloc, unsigned& nx) {
    const unsigned G = gridDim.x * gridDim.y * gridDim.z;
    unsigned sum, cnt, mine, sp = 0u;
    for (;;) {
        sum = 0u; cnt = 0u; mine = 0u;
#pragma unroll
        for (unsigned j = 0; j < 16; ++j) { const unsigned c = xb_ld(&bar[XB_XCNT(j)]); sum += c; cnt += (c > 0u) ? 1u : 0u; mine = (j == x) ? c : mine; }
        if (sum == G) break;
        __builtin_amdgcn_s_sleep(1);
        if ((++sp & 255u) == 0u) { if (xb_ld(&bar[XB_TMO])) break; if (sp > XB_SPIN_CAP) { atomicAdd(&bar[XB_TMO], 1u); break; } }
    }
    nloc = mine > 0u ? mine : 1u; nx = cnt > 0u ? cnt : 1u;
}
__device__ __forceinline__ void xcd_barrier(const XcdBarrier& b) {
    asm volatile("s_waitcnt vmcnt(0)" ::: "memory");
    __syncthreads();
    if (threadIdx.x == 0) {
        unsigned* bar = b.bar;
        __builtin_amdgcn_s_waitcnt(0);
        unsigned nloc = b.st[0], nx = b.st[1];
        if (nloc == 0u) { xcd_barrier_complete(bar, b.x, nloc, nx); b.st[0] = nloc; b.st[1] = nx; }
        const unsigned old = xb_add(&bar[XB_XSUB(b.x)], 1u);
        const unsigned gen = old / nloc;
        if (old + 1u == (gen + 1u) * nloc) {
            __builtin_amdgcn_fence(__ATOMIC_RELEASE, "agent");
            asm volatile("s_waitcnt vmcnt(0)" ::: "memory");
            const unsigned og = xb_add(&bar[XB_TOP], 1u);
            const unsigned tg = og / nx;
            if (og + 1u == (tg + 1u) * nx) xb_add(&bar[XB_TOPGEN], 1u);
            else XB_SPIN(xb_ld(&bar[XB_TOPGEN]) == tg, bar);
            __builtin_amdgcn_fence(__ATOMIC_ACQUIRE, "agent");
            xb_add(&bar[XB_XGEN(b.x)], 1u);
            asm volatile("s_waitcnt vmcnt(0)" ::: "memory");
        } else {
            XB_SPIN(xb_ld(&bar[XB_XGEN(b.x)]) == gen, bar);
            __builtin_amdgcn_fence(__ATOMIC_ACQUIRE, "agent");
            asm volatile("s_waitcnt vmcnt(0)" ::: "memory");
        }
    }
    __syncthreads();
}

template <int MASK> __device__ __forceinline__ int sx_i(int v) { return __builtin_amdgcn_ds_swizzle(v, 0x1f | (MASK << 10)); }
template <int MASK> __device__ __forceinline__ float sx_f(float v) { return __int_as_float(sx_i<MASK>(__float_as_int(v))); }
__device__ __forceinline__ float add32(float v) { auto rr = __builtin_amdgcn_permlane32_swap(__float_as_uint(v), __float_as_uint(v), false, false); return __uint_as_float(rr[0]) + __uint_as_float(rr[1]); }
__device__ __forceinline__ unsigned max32(unsigned v) { auto rr = __builtin_amdgcn_permlane32_swap(v, v, false, false); return rr[0] > rr[1] ? rr[0] : rr[1]; }
__device__ __forceinline__ float other32(float v, bool upper) { auto rr = __builtin_amdgcn_permlane32_swap(__float_as_uint(v), __float_as_uint(v), false, false); return __uint_as_float(upper ? rr[0] : rr[1]); }
__device__ __forceinline__ float bperm_f(float v, int src_lane) { return __int_as_float(__builtin_amdgcn_ds_bpermute(src_lane * 4, __float_as_int(v))); }
__device__ __forceinline__ int bperm_i(int v, int src_lane) { return __builtin_amdgcn_ds_bpermute(src_lane * 4, v); }
__device__ __forceinline__ float wave_sum(float v) {
    v += sx_f<1>(v); v += sx_f<2>(v); v += sx_f<4>(v); v += sx_f<8>(v); v += sx_f<16>(v); return add32(v);
}
__device__ __forceinline__ unsigned umax(unsigned a, unsigned b) { return a > b ? a : b; }
__device__ __forceinline__ unsigned wave_max_u32(unsigned v) {
    v = umax(v, (unsigned)sx_i<1>((int)v)); v = umax(v, (unsigned)sx_i<2>((int)v)); v = umax(v, (unsigned)sx_i<4>((int)v)); v = umax(v, (unsigned)sx_i<8>((int)v)); v = umax(v, (unsigned)sx_i<16>((int)v)); return max32(v);
}
template <int CTRL, int RMASK> __device__ __forceinline__ unsigned dpp_max_u(unsigned v) { const unsigned t = (unsigned)__builtin_amdgcn_update_dpp((int)v, (int)v, CTRL, RMASK, 0xF, false); return t > v ? t : v; }
__device__ __forceinline__ unsigned wave_max_dpp(unsigned v) {
    v = dpp_max_u<0xB1, 0xF>(v); v = dpp_max_u<0x4E, 0xF>(v); v = dpp_max_u<0x141, 0xF>(v); v = dpp_max_u<0x140, 0xF>(v); v = dpp_max_u<0x142, 0xA>(v); v = dpp_max_u<0x143, 0xC>(v);
    return (unsigned)__builtin_amdgcn_readlane((int)v, 63);
}
template <int CTRL> __device__ __forceinline__ float dpp_add_f(float v) { return v + __int_as_float(__builtin_amdgcn_update_dpp(__float_as_int(v), __float_as_int(v), CTRL, 0xF, 0xF, false)); }
__device__ __forceinline__ float row_sum16(float v) { v = dpp_add_f<0xB1>(v); v = dpp_add_f<0x4E>(v); v = dpp_add_f<0x141>(v); return dpp_add_f<0x140>(v); }
__device__ __forceinline__ unsigned row_max16_u(unsigned v) { v = dpp_max_u<0xB1, 0xF>(v); v = dpp_max_u<0x4E, 0xF>(v); v = dpp_max_u<0x141, 0xF>(v); return dpp_max_u<0x140, 0xF>(v); }
template <int CTRL> __device__ __forceinline__ float dpp_maxf(float v) { return fmaxf(v, __int_as_float(__builtin_amdgcn_update_dpp(__float_as_int(v), __float_as_int(v), CTRL, 0xF, 0xF, false))); }
__device__ __forceinline__ float row_max16_f(float v) { v = dpp_maxf<0xB1>(v); v = dpp_maxf<0x4E>(v); v = dpp_maxf<0x141>(v); return dpp_maxf<0x140>(v); }
__device__ __forceinline__ float okey_inv(unsigned k) { return __uint_as_float((k & 0x80000000u) ? (k & 0x7fffffffu) : ~k); }
#define CE_DESC(a, b) do { const unsigned hi_ = (a) > (b) ? (a) : (b), lo_ = (a) > (b) ? (b) : (a); (a) = hi_; (b) = lo_; } while (0)
__device__ __forceinline__ unsigned okey(float f) { const unsigned u = __float_as_uint(f); return (u & 0x80000000u) ? ~u : (u | 0x80000000u); }

__device__ __forceinline__ void transpose_item(const float* W, int N, bf16* WT, int ldo, int col_off, LAS float* scr, int item, int lane) {
    const int nblk = N / 32, kb = item / nblk, nb = item % nblk, k0 = 64 * kb, n0 = 32 * nb;
#pragma unroll 8
    for (int i = 0; i < 32; ++i) { const int kk = 2 * i + (lane >> 5); scr[kk * 33 + (lane & 31)] = W[(size_t)(k0 + kk) * N + n0 + (lane & 31)]; }
    LDS_WAIT(); asm volatile("" ::: "memory");
    const int c = lane & 7;
#pragma unroll
    for (int j = 0; j < 4; ++j) { const int n = (lane >> 3) + 8 * j; const LAS float* s = scr + (8 * c) * 33 + n;
        v4u o; o.x = pk2(s[0 * 33], s[1 * 33]); o.y = pk2(s[2 * 33], s[3 * 33]); o.z = pk2(s[4 * 33], s[5 * 33]); o.w = pk2(s[6 * 33], s[7 * 33]);
        *(GAS v4u*)(WT + (size_t)(n0 + n) * ldo + col_off + k0 + 8 * c) = o; }
    LDS_WAIT(); asm volatile("" ::: "memory");
}
__device__ __forceinline__ void transpose_item_fp8(const float* W, int N, int ncol0, unsigned char* WT8, int ldo, float scale, LAS float* scr, int item, int lane) {
    const int nblk = N / 32, kb = item / nblk, nb = item % nblk, k0 = 64 * kb, n0 = 32 * nb;
#pragma unroll 8
    for (int i = 0; i < 32; ++i) { const int kk = 2 * i + (lane >> 5); scr[kk * 33 + (lane & 31)] = W[(size_t)(k0 + kk) * N + n0 + (lane & 31)]; }
    LDS_WAIT(); asm volatile("" ::: "memory");
    const int c = lane & 3;
#pragma unroll
    for (int j = 0; j < 2; ++j) { const int n = (lane >> 2) + 16 * j; const LAS float* s = scr + (16 * c) * 33 + n; v4u o; int w;
        w = __builtin_amdgcn_cvt_pk_fp8_f32(s[0 * 33] * scale, s[1 * 33] * scale, 0, false); w = __builtin_amdgcn_cvt_pk_fp8_f32(s[2 * 33] * scale, s[3 * 33] * scale, w, true); o.x = (unsigned)w;
        w = __builtin_amdgcn_cvt_pk_fp8_f32(s[4 * 33] * scale, s[5 * 33] * scale, 0, false); w = __builtin_amdgcn_cvt_pk_fp8_f32(s[6 * 33] * scale, s[7 * 33] * scale, w, true); o.y = (unsigned)w;
        w = __builtin_amdgcn_cvt_pk_fp8_f32(s[8 * 33] * scale, s[9 * 33] * scale, 0, false); w = __builtin_amdgcn_cvt_pk_fp8_f32(s[10 * 33] * scale, s[11 * 33] * scale, w, true); o.z = (unsigned)w;
        w = __builtin_amdgcn_cvt_pk_fp8_f32(s[12 * 33] * scale, s[13 * 33] * scale, 0, false); w = __builtin_amdgcn_cvt_pk_fp8_f32(s[14 * 33] * scale, s[15 * 33] * scale, w, true); o.w = (unsigned)w;
        *(GAS v4u*)(WT8 + (size_t)(n0 + n - ncol0) * ldo + k0 + 16 * c) = o; }
    LDS_WAIT(); asm volatile("" ::: "memory");
}
template <bool FP8> __device__ __forceinline__ void rms_row_to_bf16(const float* xrow, const float* g, bf16* orow, unsigned char* o8row, int lane) {
    const GAS f32x4* xr = (const GAS f32x4*)xrow + lane; const GAS f32x4* gr = (const GAS f32x4*)g + lane;
    f32x4 v[8]; float s = 0.f;
#pragma unroll
    for (int j = 0; j < 8; ++j) { v[j] = xr[64 * j]; s += (v[j].x * v[j].x + v[j].y * v[j].y) + (v[j].z * v[j].z + v[j].w * v[j].w); }
    const float rstd = 1.0f / sqrtf(wave_sum(s) * (1.f / DM) + RMS_EPS);
    GAS unsigned long long* o8 = (GAS unsigned long long*)orow + lane;
#pragma unroll
    for (int j = 0; j < 8; ++j) { const f32x4 gg = gr[64 * j]; const float a = v[j].x * rstd * gg.x, b = v[j].y * rstd * gg.y, c = v[j].z * rstd * gg.z, d = v[j].w * rstd * gg.w;
        o8[64 * j] = (unsigned long long)pk2(a, b) | ((unsigned long long)pk2(c, d) << 32);
        if (FP8) { int w = __builtin_amdgcn_cvt_pk_fp8_f32(a * 32.f, b * 32.f, 0, false); w = __builtin_amdgcn_cvt_pk_fp8_f32(c * 32.f, d * 32.f, w, true); ((GAS unsigned*)o8row)[lane + 64 * j] = (unsigned)w; } }
}
typedef __bf16 bf2_t __attribute__((ext_vector_type(2)));
__device__ __forceinline__ float DOT2(unsigned a, unsigned b, float c) { return __builtin_amdgcn_fdot2_f32_bf16(__builtin_bit_cast(bf2_t, a), __builtin_bit_cast(bf2_t, b), c, false); }
__device__ __forceinline__ unsigned q8x4(float a, float b, float c, float d, float inv) {
    const int ia = (int)__builtin_rintf(a * inv), ib = (int)__builtin_rintf(b * inv), ic = (int)__builtin_rintf(c * inv), id = (int)__builtin_rintf(d * inv);
    return (unsigned)(ia & 0xff) | ((unsigned)(ib & 0xff) << 8) | ((unsigned)(ic & 0xff) << 16) | ((unsigned)(id & 0xff) << 24);
}
__device__ __forceinline__ float wave_maxf(float v) {
    v = fmaxf(v, sx_f<1>(v)); v = fmaxf(v, sx_f<2>(v)); v = fmaxf(v, sx_f<4>(v)); v = fmaxf(v, sx_f<8>(v)); v = fmaxf(v, sx_f<16>(v));
    auto rr = __builtin_amdgcn_permlane32_swap(__float_as_uint(v), __float_as_uint(v), false, false); return fmaxf(__uint_as_float(rr[0]), __uint_as_float(rr[1]));
}
__device__ __forceinline__ int rel_bucket(int rel) {
    const int n = rel < 0 ? -rel : rel;
    int b = n;
    if (n >= 8) { b = 5 + (31 - __builtin_clz((unsigned)n)); if (b > 15) b = 15; }
    return b + (rel > 0 ? 16 : 0);
}

#ifndef PH_D1
#define PH_D1 1
#endif
#ifndef PH_D2
#define PH_D2 1
#endif
#ifndef PH_A
#define PH_A 1
#endif
#ifndef PH_B
#define PH_B 1
#endif
#ifndef PH_C
#define PH_C 1
#endif
#ifndef PH_D
#define PH_D 1
#endif
#ifndef PH_E
#define PH_E 1
#endif
#ifndef PH_F
#define PH_F 1
#endif
#ifndef PH_G
#define PH_G 1
#endif
#ifndef PH_H
#define PH_H 1
#endif
#ifndef PH_I
#define PH_I 1
#endif
#ifndef PH_J
#define PH_J 1
#endif
#ifndef PH_K
#define PH_K 1
#endif
#ifndef PH_L
#define PH_L 1
#endif
struct Args { const float* in[17]; float* out; unsigned char* ws; };

#define CAS __attribute__((address_space(4)))
__device__ __forceinline__ const void* karg(int k) { const CAS char* ka = (const CAS char*)__builtin_amdgcn_kernarg_segment_ptr(); asm volatile("" : "+s"(ka)); return *(const void* const CAS*)(ka + 8 * k); }
#define WSP(T, off) ((T*)((unsigned char*)karg(18) + (off)))
#define INP(k) ((const float*)karg(k))
#define INL(k, stride) (INP(k) + (size_t)layer * (size_t)(stride))
#define X ((float*)karg(17))
__global__ void __launch_bounds__(NWAVES * 64, 2) mk_fwd(Args args_unused) {
    extern __shared__ __attribute__((aligned(16))) unsigned char lds[];
    LAS unsigned char* ldsl = (LAS unsigned char*)lds;
    volatile LAS unsigned* MISC = (volatile LAS unsigned*)(ldsl + MISC_OFF);
    const int wave0 = __builtin_amdgcn_readfirstlane((int)threadIdx.x >> 6);
    const int G = gridDim.x; const int bx = blockIdx.x; const int vcu = (G % 8 == 0) ? (bx % 8) * (G / 8) + bx / 8 : bx;
    const int NGW = G * NWAVES, NGT = NGW * 64;
#define PH_IDS() const int tid = opaque_tid(wave0), lane = tid & 63, wave = wave0, gw = vcu * NWAVES + wave, gt = gw * 64 + lane; (void)gt; (void)gw; (void)lane
    gu32* ctl = (gu32*)WSP(unsigned char, WS_CTL);
    for (int u = threadIdx.x; u < (LDS_BYTES - LDSCTL_OFF) / 4; u += NWAVES * 64) ((LAS unsigned*)(ldsl + LDSCTL_OFF))[u] = 0u;
    __syncthreads();
    XcdBarrier bar = xcd_barrier_post((unsigned*)(ctl + CW_BAR), MISC + 8);
    if (threadIdx.x == 0) MISC[1] = __hip_atomic_fetch_add(ctl + CW_XRANK + 64 * (int)(xb_xcc_id() & 7u), 1u, __ATOMIC_RELAXED, __HIP_MEMORY_SCOPE_AGENT);
#define GRID_BAR() xcd_barrier(bar)

    for (int layer = 0; layer < 2; ++layer) {

#if PH_A
        {
            PH_IDS();
            LAS float* scr = (LAS float*)(ldsl + wave * 16384);
            const float* w_in = INL(4, (size_t)DM * INW); const float* w_up_a = INL(6, 512 * DM); const float* w_up_b = INL(7, 512 * DM); const float* w_up_c = INL(8, 1024 * DM);
            const float* w_o = INL(11, DM * DM); const float* wq = INL(13, DM * DM); const float* subk = INL(14, 2 * 128 * 128);
            const float* pu = INL(15, (size_t)NEXP * DM); const float* pv = INL(16, (size_t)NEXP * DM); const float* mix_g = INL(3, DM); const float* rel_bias = INP(1);
            bf16* WIN = WSP(bf16, WS_WIN); bf16* WCAT = WSP(bf16, WS_WCAT); bf16* WO = WSP(bf16, WS_WO); bf16* WQ = WSP(bf16, WS_WQ); unsigned char* U8 = WSP(unsigned char, WS_U); unsigned char* V8 = WSP(unsigned char, WS_V);
            bf16* SKBD = WSP(bf16, WS_SKBD); bf16* H = WSP(bf16, WS_H); bf16* DFT = WSP(bf16, WS_DFT); bf16* CS = WSP(bf16, WS_CS); float* TAB = WSP(float, WS_TAB);
            constexpr int I_IN = (DM / 64) * (INW / 32), I_A = (512 / 64) * (DM / 32), I_C = (1024 / 64) * (DM / 32), I_SQ = (DM / 64) * (DM / 32);
            constexpr int NITEMS = I_IN + 2 * I_A + I_C + 2 * I_SQ;
            for (int it = gw; it < NITEMS; it += NGW) {
                int r = it;
                if (r < I_IN) { if ((r % (INW / 32)) * 32 < PJW) transpose_item(w_in, INW, WIN, DM, 0, scr, r, lane); else transpose_item_fp8(w_in, INW, PJW, WSP(unsigned char, WS_WG8), DM, 1024.f, scr, r, lane); continue; } r -= I_IN;
                if (r < I_A) { transpose_item(w_up_a, DM, WCAT, DM, 0, scr, r, lane); continue; } r -= I_A;
                if (r < I_A) { transpose_item(w_up_b, DM, WCAT, DM, 512, scr, r, lane); continue; } r -= I_A;
                if (r < I_C) { transpose_item(w_up_c, DM, WCAT, DM, 1024, scr, r, lane); continue; } r -= I_C;
                if (r < I_SQ) { transpose_item(w_o, DM, WO, DM, 0, scr, r, lane); continue; } r -= I_SQ;
                transpose_item(wq, DM, WQ, DM, 0, scr, r, lane);
            }
            for (size_t i = (size_t)gt; i < (size_t)NEXP * DM / 16; i += (size_t)NGT) {
                const GAS f32x4* src = (const GAS f32x4*)pv + 4 * i; const float sc = 64.f;
                const f32x4 a = src[0], b = src[1], c = src[2], d = src[3]; v4u o; int w;
                w = __builtin_amdgcn_cvt_pk_fp8_f32(a.x * sc, a.y * sc, 0, false); w = __builtin_amdgcn_cvt_pk_fp8_f32(a.z * sc, a.w * sc, w, true); o.x = (unsigned)w;
                w = __builtin_amdgcn_cvt_pk_fp8_f32(b.x * sc, b.y * sc, 0, false); w = __builtin_amdgcn_cvt_pk_fp8_f32(b.z * sc, b.w * sc, w, true); o.y = (unsigned)w;
                w = __builtin_amdgcn_cvt_pk_fp8_f32(c.x * sc, c.y * sc, 0, false); w = __builtin_amdgcn_cvt_pk_fp8_f32(c.z * sc, c.w * sc, w, true); o.z = (unsigned)w;
                w = __builtin_amdgcn_cvt_pk_fp8_f32(d.x * sc, d.y * sc, 0, false); w = __builtin_amdgcn_cvt_pk_fp8_f32(d.z * sc, d.w * sc, w, true); o.w = (unsigned)w;
                ((GAS v4u*)V8)[i] = o;
            }
            { float* SU = WSP(float, WS_SU);
              for (int e = gw; e < NEXP; e += NGW) { const GAS f32x4* ur = (const GAS f32x4*)(pu + (size_t)e * DM) + lane; f32x4 y[8]; float mx = 0.f;
#pragma unroll
                for (int j = 0; j < 8; ++j) { y[j] = ur[64 * j]; mx = fmaxf(mx, fmaxf(fmaxf(fabsf(y[j].x), fabsf(y[j].y)), fmaxf(fabsf(y[j].z), fabsf(y[j].w)))); }
                mx = fmaxf(wave_maxf(mx), 1e-30f); const float inv = 127.f / mx;
#pragma unroll
                for (int j = 0; j < 8; ++j) ((GAS unsigned*)(U8 + (size_t)e * DM))[lane + 64 * j] = q8x4(y[j].x, y[j].y, y[j].z, y[j].w, inv);
                if (lane == 0) SU[e] = mx * (1.f / 127.f); } }
            for (int i = gt; i < 65536; i += NGT) { const int n = i >> 8, kk = i & 255, p = n >> 7; SKBD[i] = ((kk >> 7) == p) ? (bf16)f2bf(subk[(size_t)(p * 128 + (n & 127)) * 128 + (kk & 127)]) : (bf16)0; }
            for (int m = gw; m < MTOK; m += NGW) rms_row_to_bf16<true>((layer == 0 ? INP(0) : (const float*)X) + (size_t)m * DM, mix_g, H + (size_t)m * DM, WSP(unsigned char, WS_H8) + (size_t)m * DM, lane);
            if (layer == 0) {
                for (size_t i = (size_t)gt; i < (size_t)4096 * 8192 / 8; i += (size_t)NGT) {
                    const int sp = (int)(i >> 10), k0 = (int)(i & 1023) * 8, part = k0 >> 12, s0 = k0 & 4095; float v[8];
#pragma unroll
                    for (int j = 0; j < 8; ++j) { const float ang = (float)(((s0 + j) * sp) & 4095) * (1.f / 4096.f); v[j] = (part ? -__builtin_amdgcn_sinf(ang) : __builtin_amdgcn_cosf(ang)) * (1.f / 64.f); }
                    v4u o; o.x = pk2(v[0], v[1]); o.y = pk2(v[2], v[3]); o.z = pk2(v[4], v[5]); o.w = pk2(v[6], v[7]); ((GAS v4u*)DFT)[i] = o;
                }
                for (int i = gt; i < 65536; i += NGT) { const int r = i >> 8, c = i & 255, part = r >> 7, cp = r & 127; float v = 0.f;
                    if (c < 128) { const float ang = (float)((c * cp) & 127) * (1.f / 128.f); v = (part ? __builtin_amdgcn_sinf(ang) : __builtin_amdgcn_cosf(ang)) * 0.08838834764831845f; }
                    CS[i] = (bf16)f2bf(v); }
                for (int i = gt; i < 16 * 8192; i += NGT) { const int hd = i >> 13, off = (i & 8191) - 4096; float v;
                    if (hd < 12) { const int g = hd >> 2, dil = g == 0 ? 1 : (g == 1 ? 4 : 16); v = (off >= -64 && off <= 64) ? rel_bias[rel_bucket(off * dil) * 16 + hd] * 11.313708498984761f : -1.0e5f; }
                    else v = rel_bias[rel_bucket(off) * 16 + hd] * 11.313708498984761f;
                    TAB[i] = v; }
            }
        }
#endif
        GRID_BAR();

#if PH_B
        {
            { pg8::Gemm g{WSP(bf16, WS_H), WSP(bf16, WS_WIN)}; pg8::StaticOrder S; S.init(MTOK, PJW, G, bx, DM, DM);
              pg8::EpiStore E{WSP(bf16, WS_PROJ), PJW};
              pg8::gemm_phase<pg8::EpiStore, pg8::StaticOrder, true, DM, DM, DM>(ldsl, g, S, E, wave0); }
            { pg8::Gemm g{WSP(bf16, WS_H8), WSP(bf16, WS_WG8)}; pg8::StaticOrder S; S.init(MTOK, GTW, G, bx, DM / 2, DM / 2);
              pg8::EpiProj E{WSP(bf16, WS_PROJ), WSP(bf16, WS_G), INL(5, GTW), 32, 1.f / 32768.f};
              pg8::gemm_phase<pg8::EpiProj, pg8::StaticOrder, true, DM / 2, DM / 2, DM / 2, true>(ldsl, g, S, E, wave0); }
        }
#endif
        GRID_BAR();

#if PH_C
        {
            pg8::Gemm g{WSP(bf16, WS_CS), WSP(bf16, WS_PROJ)}; pg8::F1Order S{G, bx};
            pg8::EpiZT E{WSP(bf16, WS_ZT)};
            pg8::gemm_phase<pg8::EpiZT, pg8::F1Order, false, 256, PJW, 256>(ldsl, g, S, E, wave0);
        }
#endif
        GRID_BAR();

#if PH_D
#if PH_D1
        {
            pg8::Gemm g{WSP(bf16, WS_DFT), WSP(bf16, WS_ZT)}; pg8::F2Order S; S.init(4096, 2048, G, bx, 8192, 8192);
            pg8::EpiStore E{WSP(bf16, WS_OC), DM};
            pg8::gemm_phase<pg8::EpiStore, pg8::F2Order, false, 8192, 8192, 8192>(ldsl, g, S, E, wave0);
        }
#endif
#if PH_D2
        {
            PH_IDS();
            gu32* qhead = ctl + CW_QUEUE + 64 * layer;
            bf16* PROJ = WSP(bf16, WS_PROJ); bf16* DO = WSP(bf16, WS_MG); bf16* DL = WSP(bf16, WS_H); float* LSE = WSP(float, WS_LSE); const float* TAB = WSP(float, WS_TAB);
            const float* cur_tab = nullptr;
            for (;;) {
                __syncthreads();
                if (tid == 0) MISC[0] = __hip_atomic_fetch_add(qhead, 1u, __ATOMIC_RELAXED, __HIP_MEMORY_SCOPE_AGENT);
                __syncthreads();
                const int ui = __builtin_amdgcn_readfirstlane((int)MISC[0]);
                if (ui >= 1792) break;
                attn::Unit u; int hd;
                if (ui < 1024) {
                    const int qb = ui & 15, vh = (ui >> 4) & 1, m = (ui >> 5) & 1, h = (ui >> 6) & 3, b = ui >> 8;
                    const bf16* base = PROJ + (size_t)b * SEQ * PJW;
                    u.Q = base + (size_t)(qb * 256) * PJW + COL_DIFF + (h * 2 + m) * 128; u.K = base + COL_DIFF + 1024 + (h * 2 + m) * 128; u.V = base + COL_DIFF + 2048 + h * 256 + vh * 128;
                    u.O = DO + (size_t)(b * SEQ + qb * 256) * DM + (h * 2 + m) * 256 + vh * 128; u.lse = nullptr; u.ldq = PJW; u.ldk = PJW; u.ldo = DM; u.lse_ld = 0;
                    u.kt0 = 0; u.nt = SEQ / 64; u.qoff = qb * 256; hd = 12 + h;
                } else {
                    const int v = ui - 1024, qb16 = v & 15, hh = (v >> 4) & 3, bg = v >> 6, g = bg % 3, b = bg / 3;
                    const int dil = g == 0 ? 1 : (g == 1 ? 4 : 16), bpc = 16 / dil, r = qb16 / bpc, qblk = qb16 % bpc, q0 = qblk * 256, ntot = (SEQ / dil) / 64;
                    int kt0 = q0 / 64 - 1; if (kt0 < 0) kt0 = 0; int kt1 = q0 / 64 + 5; if (kt1 > ntot) kt1 = ntot;
                    if ((kt1 - kt0) & 1) { if (kt0 > 0) --kt0; else ++kt1; }
                    const bf16* base = PROJ + (size_t)(b * SEQ + r) * PJW + COL_DIL + g * 512 + hh * 128;
                    u.Q = base + (size_t)q0 * dil * PJW; u.K = base + 1536; u.V = base + 3072;
                    u.O = DL + ((size_t)g * MTOK + b * SEQ + r + (size_t)q0 * dil) * 512 + hh * 128; u.lse = LSE + ((size_t)g * MTOK + b * SEQ + r + (size_t)q0 * dil) * 4 + hh;
                    u.ldq = (long)PJW * dil; u.ldk = (long)PJW * dil; u.ldo = 512L * dil; u.lse_ld = 4 * dil; u.kt0 = kt0; u.nt = kt1 - kt0; u.qoff = q0; hd = g * 4 + hh;
                }
                const float* tab = TAB + (size_t)hd * 8192;
                if (tab != cur_tab) {
                    cur_tab = tab;
                    LAS f32x4* tl = (LAS f32x4*)(ldsl + attn::LDS_TAB); const int t2 = opaque_tid(wave0);
#pragma unroll
                    for (int j = 0; j < 4; ++j) tl[t2 + 512 * j] = ((const GAS f32x4*)tab)[t2 + 512 * j];
                }
                attn::attn_unit(u, (char*)lds, wave0);
            }
        }
#endif
#endif
        GRID_BAR();

#if PH_E
        {
            PH_IDS();
            const float* dlam = INL(9, 512); const float* subln = INL(10, 256); const float lambda_init = layer == 0 ? 0.2f : 0.35550906759f;
            const float* LSE = WSP(float, WS_LSE); const bf16* DL = WSP(bf16, WS_H); const bf16* DO = WSP(bf16, WS_MG); bf16* OC = WSP(bf16, WS_OC);
            float s1 = dlam[lane] * dlam[128 + lane] + dlam[64 + lane] * dlam[192 + lane], s2 = dlam[256 + lane] * dlam[384 + lane] + dlam[320 + lane] * dlam[448 + lane];
            s1 = wave_sum(s1); s2 = wave_sum(s2);
            const float lam = __expf(s1) - __expf(s2) + lambda_init, osc = 1.0f - lambda_init;
            const int hq = lane >> 4, l16 = lane & 15;
            for (int t = gw; t < MTOK; t += NGW) {
                float ls[3], mx = -3e38f;
#pragma unroll
                for (int g = 0; g < 3; ++g) { ls[g] = LSE[((size_t)g * MTOK + t) * 4 + hq]; mx = fmaxf(mx, ls[g]); }
                float wsum = 0.f;
#pragma unroll
                for (int g = 0; g < 3; ++g) { ls[g] = __expf(ls[g] - mx); wsum += ls[g]; }
                const float winv = 1.0f / wsum; float acc8[8] = {0.f, 0.f, 0.f, 0.f, 0.f, 0.f, 0.f, 0.f};
#pragma unroll
                for (int g = 0; g < 3; ++g) { const v4u o = *(const GAS v4u*)(DL + ((size_t)g * MTOK + t) * 512 + lane * 8); const float w = ls[g] * winv;
                    acc8[0] += w * bflo(o.x); acc8[1] += w * bfhi(o.x); acc8[2] += w * bflo(o.y); acc8[3] += w * bfhi(o.y); acc8[4] += w * bflo(o.z); acc8[5] += w * bfhi(o.z); acc8[6] += w * bflo(o.w); acc8[7] += w * bfhi(o.w); }
#if defined(DBG_ZERO_OB)
                for (int j = 0; j < 8; ++j) acc8[j] = 0.f;
#endif
                { v4u o; o.x = pk2(acc8[0], acc8[1]); o.y = pk2(acc8[2], acc8[3]); o.z = pk2(acc8[4], acc8[5]); o.w = pk2(acc8[6], acc8[7]); *(GAS v4u*)(OC + (size_t)t * DM + 512 + lane * 8) = o; }
                const bf16* dp = DO + (size_t)t * DM + hq * 512 + l16 * 16;
                const v4u a0 = *(const GAS v4u*)(dp), a1 = *(const GAS v4u*)(dp + 8), b0 = *(const GAS v4u*)(dp + 256), b1 = *(const GAS v4u*)(dp + 264);
                float d[16];
                d[0] = bflo(a0.x) - lam * bflo(b0.x); d[1] = bfhi(a0.x) - lam * bfhi(b0.x); d[2] = bflo(a0.y) - lam * bflo(b0.y); d[3] = bfhi(a0.y) - lam * bfhi(b0.y);
                d[4] = bflo(a0.z) - lam * bflo(b0.z); d[5] = bfhi(a0.z) - lam * bfhi(b0.z); d[6] = bflo(a0.w) - lam * bflo(b0.w); d[7] = bfhi(a0.w) - lam * bfhi(b0.w);
                d[8] = bflo(a1.x) - lam * bflo(b1.x); d[9] = bfhi(a1.x) - lam * bfhi(b1.x); d[10] = bflo(a1.y) - lam * bflo(b1.y); d[11] = bfhi(a1.y) - lam * bfhi(b1.y);
                d[12] = bflo(a1.z) - lam * bflo(b1.z); d[13] = bfhi(a1.z) - lam * bfhi(b1.z); d[14] = bflo(a1.w) - lam * bflo(b1.w); d[15] = bfhi(a1.w) - lam * bfhi(b1.w);
                float ss = 0.f;
#pragma unroll
                for (int j = 0; j < 16; ++j) ss += d[j] * d[j];
                ss += sx_f<1>(ss); ss += sx_f<2>(ss); ss += sx_f<4>(ss); ss += sx_f<8>(ss);
                const float rs = osc / sqrtf(ss * (1.f / 256.f) + RMS_EPS);
                const f32x4 g0 = *(const GAS f32x4*)(subln + l16 * 16), g1 = *(const GAS f32x4*)(subln + l16 * 16 + 4), g2 = *(const GAS f32x4*)(subln + l16 * 16 + 8), g3 = *(const GAS f32x4*)(subln + l16 * 16 + 12);
                v4u o0, o1;
                o0.x = pk2(d[0] * rs * g0.x, d[1] * rs * g0.y); o0.y = pk2(d[2] * rs * g0.z, d[3] * rs * g0.w); o0.z = pk2(d[4] * rs * g1.x, d[5] * rs * g1.y); o0.w = pk2(d[6] * rs * g1.z, d[7] * rs * g1.w);
                o1.x = pk2(d[8] * rs * g2.x, d[9] * rs * g2.y); o1.y = pk2(d[10] * rs * g2.z, d[11] * rs * g2.w); o1.z = pk2(d[12] * rs * g3.x, d[13] * rs * g3.y); o1.w = pk2(d[14] * rs * g3.z, d[15] * rs * g3.w);
                bf16* op = OC + (size_t)t * DM + 1024 + hq * 256 + l16 * 16;
                *(GAS v4u*)(op) = o0; *(GAS v4u*)(op + 8) = o1;
            }
        }
#endif
        GRID_BAR();

#if PH_F
        {
            pg8::MergeOrder S; S.init(MTOK, DM, G, bx, DM, DM);
            pg8::Gemm g{WSP(bf16, WS_OC), WSP(bf16, WS_WCAT)}; pg8::EpiMerge4 E{WSP(bf16, WS_G), WSP(bf16, WS_MG)};
            pg8::gemm_phase<pg8::EpiMerge4, pg8::MergeOrder, true, DM, DM, 512>(ldsl, g, S, E, wave0);
        }
#endif
        GRID_BAR();

#if PH_G
        {
            pg8::Gemm g{WSP(bf16, WS_MG), WSP(bf16, WS_WO)}; pg8::StaticOrder S; S.init(MTOK, DM, G, bx, DM, DM);
            pg8::EpiResF32 E{layer == 0 ? INP(0) : (const float*)X, X, DM};
            pg8::gemm_phase<pg8::EpiResF32, pg8::StaticOrder, true, DM, DM, DM>(ldsl, g, S, E, wave0);
        }
#endif
        GRID_BAR();

#if PH_H
        { PH_IDS(); const float* ffn_g = INL(12, DM); bf16* H = WSP(bf16, WS_H); unsigned char* H8 = WSP(unsigned char, WS_H8); float* SH = WSP(float, WS_SH);
          for (int m = gw; m < MTOK; m += NGW) {
            const GAS f32x4* xr = (const GAS f32x4*)(X + (size_t)m * DM) + lane; const GAS f32x4* gr = (const GAS f32x4*)ffn_g + lane;
            f32x4 v[8]; float ss = 0.f;
#pragma unroll
            for (int j = 0; j < 8; ++j) { v[j] = xr[64 * j]; ss += (v[j].x * v[j].x + v[j].y * v[j].y) + (v[j].z * v[j].z + v[j].w * v[j].w); }
            const float rstd = 1.0f / sqrtf(wave_sum(ss) * (1.f / DM) + RMS_EPS); float mx = 0.f;
#pragma unroll
            for (int j = 0; j < 8; ++j) { const f32x4 gg = gr[64 * j]; v[j] = v[j] * rstd * gg; mx = fmaxf(mx, fmaxf(fmaxf(fabsf(v[j].x), fabsf(v[j].y)), fmaxf(fabsf(v[j].z), fabsf(v[j].w)))); }
            mx = fmaxf(wave_maxf(mx), 1e-30f); const float inv = 127.f / mx;
            GAS unsigned long long* o8 = (GAS unsigned long long*)(H + (size_t)m * DM) + lane;
#pragma unroll
            for (int j = 0; j < 8; ++j) { o8[64 * j] = (unsigned long long)pk2(v[j].x, v[j].y) | ((unsigned long long)pk2(v[j].z, v[j].w) << 32);
                ((GAS unsigned*)(H8 + (size_t)m * DM))[lane + 64 * j] = q8x4(v[j].x, v[j].y, v[j].z, v[j].w, inv); }
            if (lane == 0) SH[m] = mx * (1.f / 127.f);
          } }
#endif
        GRID_BAR();

#if PH_I
        {
            pg8::Gemm g{WSP(bf16, WS_H), WSP(bf16, WS_WQ)}; pg8::StaticOrder S; S.init(MTOK, DM, G, bx, DM, DM);
            pg8::EpiStore E{WSP(bf16, WS_Q), DM};
            pg8::gemm_phase<pg8::EpiStore, pg8::StaticOrder, true, DM, DM, DM>(ldsl, g, S, E, wave0);
        }
#endif
        GRID_BAR();

#if PH_J
        {
            pg8::Gemm g{WSP(bf16, WS_Q), WSP(bf16, WS_SKBD)}; pg8::StaticOrder S; S.init(MTOK * 8, 256, G, bx, 256, 256);
            pg8::EpiResF32 E{nullptr, WSP(float, WS_SC), 256};
            pg8::gemm_phase<pg8::EpiResF32, pg8::StaticOrder, true, 256, 256, 256>(ldsl, g, S, E, wave0);
        }
#endif
        GRID_BAR();

#if PH_K
        {
            PH_IDS();
            const float* SC = WSP(float, WS_SC); int* IDS = WSP(int, WS_IDS); float* GATES = WSP(float, WS_GATES);
            const int l16 = lane & 15, rbase = lane & 48;
            int cq[4];
#pragma unroll
            for (int q = 0; q < 4; ++q) { int c = l16 + 16 * q, ci = -1, cj = 0; for (int i = 0; i < 16; ++i) { const int cnt = 16 / (i + 1); if (ci < 0) { if (c < cnt) { ci = i; cj = c; } else c -= cnt; } } cq[q] = ci < 0 ? -1 : ci * 16 + cj; }
            for (int row4 = gw * 4; row4 < MTOK * 8; row4 += NGW * 4) {
                const int row = row4 + (lane >> 4);
                const float* sc = SC + (size_t)row * 256 + l16;
                unsigned ka[8], kb[8];
#pragma unroll
                for (int jj = 0; jj < 8; ++jj) { ka[jj] = (okey(sc[jj * 16]) & ~127u) | (unsigned)(127 - (jj * 16 + l16)); kb[jj] = (okey(sc[128 + jj * 16]) & ~127u) | (unsigned)(127 - (jj * 16 + l16)); }
#define SORT8(k) do { CE_DESC(k[0], k[1]); CE_DESC(k[2], k[3]); CE_DESC(k[4], k[5]); CE_DESC(k[6], k[7]); CE_DESC(k[0], k[2]); CE_DESC(k[1], k[3]); CE_DESC(k[4], k[6]); CE_DESC(k[5], k[7]); \
    CE_DESC(k[1], k[2]); CE_DESC(k[5], k[6]); CE_DESC(k[0], k[4]); CE_DESC(k[3], k[7]); CE_DESC(k[1], k[5]); CE_DESC(k[2], k[6]); CE_DESC(k[1], k[4]); CE_DESC(k[3], k[6]); \
    CE_DESC(k[2], k[4]); CE_DESC(k[3], k[5]); CE_DESC(k[3], k[4]); } while (0)
                SORT8(ka); SORT8(kb);
                unsigned ta = 0u, tb = 0u;
#pragma unroll
                for (int r = 0; r < 16; ++r) {
                    const unsigned ma = row_max16_u(ka[0]), mb = row_max16_u(kb[0]);
                    const bool wa = ka[0] == ma, wb = kb[0] == mb;
                    ta = (l16 == r) ? ma : ta; tb = (l16 == r) ? mb : tb;
#pragma unroll
                    for (int q = 0; q < 7; ++q) { ka[q] = wa ? ka[q + 1] : ka[q]; kb[q] = wb ? kb[q + 1] : kb[q]; }
                    ka[7] = wa ? 0u : ka[7]; kb[7] = wb ? 0u : kb[7];
                }
                const int ia = 127 - (int)(ta & 127u), ib = 127 - (int)(tb & 127u);
                const float va = okey_inv(ta & ~127u), vb = okey_inv(tb & ~127u);
                unsigned ck[4];
#pragma unroll
                for (int q = 0; q < 4; ++q) { const int cc = cq[q] < 0 ? 0 : cq[q]; const float cs = bperm_f(va, rbase + (cc >> 4)) + bperm_f(vb, rbase + (cc & 15));
                    ck[q] = cq[q] < 0 ? 0u : ((okey(cs) & ~255u) | (unsigned)(255 - cc)); }
                CE_DESC(ck[0], ck[1]); CE_DESC(ck[2], ck[3]); CE_DESC(ck[0], ck[2]); CE_DESC(ck[1], ck[3]); CE_DESC(ck[1], ck[2]);
                unsigned tw = 0u;
#pragma unroll
                for (int r = 0; r < 16; ++r) { const unsigned mm = row_max16_u(ck[0]); const bool w = ck[0] == mm; tw = (l16 == r) ? mm : tw;
                    ck[0] = w ? ck[1] : ck[0]; ck[1] = w ? ck[2] : ck[1]; ck[2] = w ? ck[3] : ck[2]; ck[3] = w ? 0u : ck[3]; }
                const int code = 255 - (int)(tw & 255u), wi = (code >> 4) & 15, wj = code & 15;
                const float bs = bperm_f(va, rbase + wi) + bperm_f(vb, rbase + wj);
                const int eid = bperm_i(ia, rbase + wi) * 128 + bperm_i(ib, rbase + wj);
                const float mx = row_max16_f(bs), e = __expf(bs - mx), es = row_sum16(e);
                IDS[(size_t)row * 16 + l16] = eid; GATES[(size_t)row * 16 + l16] = e / es;
            }
#undef SORT8
        }
#endif
        GRID_BAR();

#if PH_L
#define L_LDIDS(I, tt, hh) do { const GAS v4u* ip_ = (const GAS v4u*)(IDS + (size_t)(tt) * 128 + (hh) * 64 + lrow * 16); I##0 = ip_[0]; I##1 = ip_[1]; I##2 = ip_[2]; I##3 = ip_[3]; } while (0)
#define L_ISSUE(W, I, base) do { \
    W[0] = *(const GAS v4u*)((base) + (size_t)(I##0).x * DM); W[1] = *(const GAS v4u*)((base) + (size_t)(I##0).y * DM); W[2] = *(const GAS v4u*)((base) + (size_t)(I##0).z * DM); W[3] = *(const GAS v4u*)((base) + (size_t)(I##0).w * DM); \
    W[4] = *(const GAS v4u*)((base) + (size_t)(I##1).x * DM); W[5] = *(const GAS v4u*)((base) + (size_t)(I##1).y * DM); W[6] = *(const GAS v4u*)((base) + (size_t)(I##1).z * DM); W[7] = *(const GAS v4u*)((base) + (size_t)(I##1).w * DM); \
    W[8] = *(const GAS v4u*)((base) + (size_t)(I##2).x * DM); W[9] = *(const GAS v4u*)((base) + (size_t)(I##2).y * DM); W[10] = *(const GAS v4u*)((base) + (size_t)(I##2).z * DM); W[11] = *(const GAS v4u*)((base) + (size_t)(I##2).w * DM); \
    W[12] = *(const GAS v4u*)((base) + (size_t)(I##3).x * DM); W[13] = *(const GAS v4u*)((base) + (size_t)(I##3).y * DM); W[14] = *(const GAS v4u*)((base) + (size_t)(I##3).z * DM); W[15] = *(const GAS v4u*)((base) + (size_t)(I##3).w * DM); } while (0)
#define L_CVT(d, hi) __builtin_amdgcn_cvt_pk_f32_fp8((int)(d), (hi))
        {
            PH_IDS();
            const unsigned char* H8 = WSP(unsigned char, WS_H8); const unsigned char* U8 = WSP(unsigned char, WS_U); const int* IDS = WSP(int, WS_IDS); float* PART = WSP(float, WS_G);
            typedef float f32x2 __attribute__((ext_vector_type(2)));
            const int myx = (int)(xb_xcc_id() & 7u); int nx = 0, xi = 0, nloc = 1;
            for (int j = 0; j < 8; ++j) { const int c = (int)__hip_atomic_load(ctl + CW_XRANK + 64 * j, __ATOMIC_RELAXED, __HIP_MEMORY_SCOPE_AGENT); if (c > 0) { ++nx; if (j < myx) ++xi; } if (j == myx) nloc = c; }
            const int rw = (int)MISC[1] * NWAVES + wave, nW = nloc * NWAVES; const int l16 = lane & 15, lrow = lane >> 4;
#define L1_COMPUTE(W, dst) do { float sk[16]; _Pragma("unroll") for (int k = 0; k < 16; ++k) { const v4u ww = W[k]; int ac = 0; \
        ac = __builtin_amdgcn_sdot4((int)ww.x, (int)h0.x, ac, false); ac = __builtin_amdgcn_sdot4((int)ww.y, (int)h0.y, ac, false); ac = __builtin_amdgcn_sdot4((int)ww.z, (int)h0.z, ac, false); ac = __builtin_amdgcn_sdot4((int)ww.w, (int)h0.w, ac, false); \
        sk[k] = (float)ac; } \
          \
        float t8[8]; _Pragma("unroll") for (int j = 0; j < 8; ++j) { const float keep = b8 ? sk[8 + j] : sk[j], send = b8 ? sk[j] : sk[8 + j]; \
            t8[j] = keep + __int_as_float(__builtin_amdgcn_update_dpp(0, __float_as_int(send), 0x128, 0xF, 0xF, false)); } \
        float t4[4]; _Pragma("unroll") for (int j = 0; j < 4; ++j) { const float keep = b4 ? t8[4 + j] : t8[j], send = b4 ? t8[j] : t8[4 + j]; t4[j] = keep + sx_f<4>(send); } \
        float t2[2]; _Pragma("unroll") for (int j = 0; j < 2; ++j) { const float keep = b2 ? t4[2 + j] : t4[j], send = b2 ? t4[j] : t4[2 + j]; \
            t2[j] = keep + __int_as_float(__builtin_amdgcn_update_dpp(0, __float_as_int(send), 0x4E, 0xF, 0xF, false)); } \
        { const float keep = b1 ? t2[1] : t2[0], send = b1 ? t2[0] : t2[1]; dst = keep + __int_as_float(__builtin_amdgcn_update_dpp(0, __float_as_int(send), 0xB1, 0xF, 0xF, false)); } } while (0)
            const bool b8 = (lane & 8) != 0, b4 = (lane & 4) != 0, b2 = (lane & 2) != 0, b1 = (lane & 1) != 0;
            for (int sl = xi; sl < 8; sl += nx) {
                const unsigned char* ub = U8 + sl * 256 + l16 * 16; const unsigned char* hb = H8 + sl * 256 + l16 * 16;
                int t = rw;
                if (t < MTOK) {
                    v4u Wa[16], Wb[16]; v4u ia0, ia1, ia2, ia3, ib0, ib1, ib2, ib3; v4u h0;
                    L_LDIDS(ia, t, 0); L_LDIDS(ib, t, 1); h0 = *(const GAS v4u*)(hb + (size_t)t * DM);
                    L_ISSUE(Wa, ia, ub);
                    for (;;) {
                        const int tn = t + nW; const bool more = tn < MTOK; const int tp = more ? tn : t;
                        L_ISSUE(Wb, ib, ub);
                        L_LDIDS(ia, tp, 0); const v4u hn0 = *(const GAS v4u*)(hb + (size_t)tp * DM);
                        float pre0, pre1;
                        L1_COMPUTE(Wa, pre0);
                        L_ISSUE(Wa, ia, ub);
                        L_LDIDS(ib, tp, 1);
                        L1_COMPUTE(Wb, pre1);
                        float* pp = PART + ((size_t)sl * MTOK + t) * 128; pp[lane] = pre0; pp[64 + lane] = pre1;
                        h0 = hn0;
                        if (!more) break;
                        t = tn;
                    }
                }
            }
#undef L1_COMPUTE
        }
        GRID_BAR();
        {
            PH_IDS();
            const float* PART = WSP(float, WS_G); const float* GATES = WSP(float, WS_GATES); float* ACTW = WSP(float, WS_ACT);
            for (int t = gw; t < MTOK; t += NGW) {
                float q0 = 0.f, q1 = 0.f;
#pragma unroll
                for (int s8 = 0; s8 < 8; ++s8) { const float* pp = PART + ((size_t)s8 * MTOK + t) * 128; q0 += pp[lane]; q1 += pp[64 + lane]; }
                { const int* ip = WSP(int, WS_IDS) + (size_t)t * 128; const float sh = WSP(float, WS_SH)[t]; const float* SU = WSP(float, WS_SU); q0 *= SU[ip[lane]] * sh; q1 *= SU[ip[64 + lane]] * sh; }
                const float* gp = GATES + (size_t)t * 128; float* ap = ACTW + (size_t)t * 128;
                const float g0 = gp[lane], g1 = gp[64 + lane];
                ap[lane] = 0.5f * q0 * (1.0f + erff(q0 * 0.70710678118654752f)) * g0 * (1.f / 64.f); ap[64 + lane] = 0.5f * q1 * (1.0f + erff(q1 * 0.70710678118654752f)) * g1 * (1.f / 64.f);
            }
        }
        GRID_BAR();
        {
            PH_IDS();
            const unsigned char* V8 = WSP(unsigned char, WS_V); const int* IDS = WSP(int, WS_IDS); const float* ACT = WSP(float, WS_ACT);
            typedef float f32x2 __attribute__((ext_vector_type(2)));
            const int myx = (int)(xb_xcc_id() & 7u); int nx = 0, xi = 0, nloc = 1;
            for (int j = 0; j < 8; ++j) { const int c = (int)__hip_atomic_load(ctl + CW_XRANK + 64 * j, __ATOMIC_RELAXED, __HIP_MEMORY_SCOPE_AGENT); if (c > 0) { ++nx; if (j < myx) ++xi; } if (j == myx) nloc = c; }
            const int rw = (int)MISC[1] * NWAVES + wave, nW = nloc * NWAVES; const int l16 = lane & 15, lrow = lane >> 4;
#if DBG_MODE == 2
            float* XO = WSP(float, WS_OC);
#else
            float* XO = X;
#endif
#define L2_COMPUTE(W, acr) do { float av[16]; _Pragma("unroll") for (int k = 0; k < 16; ++k) av[k] = bperm_f(acr, (lane & 48) + k); \
        _Pragma("unroll") for (int k = 0; k < 16; ++k) { const float a = av[k]; const f32x2 aa = (f32x2){a, a}; \
        const v4u ww = W[k]; const unsigned d0 = ww.x, d1 = ww.y, d2 = ww.z, d3 = ww.w; \
        oacc[0] += aa * L_CVT(d0, false); oacc[1] += aa * L_CVT(d0, true); oacc[2] += aa * L_CVT(d1, false); oacc[3] += aa * L_CVT(d1, true); \
        oacc[4] += aa * L_CVT(d2, false); oacc[5] += aa * L_CVT(d2, true); oacc[6] += aa * L_CVT(d3, false); oacc[7] += aa * L_CVT(d3, true); } } while (0)
            for (int sl = xi; sl < 8; sl += nx) {
                const unsigned char* vb = V8 + sl * 256 + l16 * 16; float* xb = XO + sl * 256 + l16 * 16;
                int t = rw;
                if (t < MTOK) {
                    v4u Wa[16], Wb[16]; v4u ia0, ia1, ia2, ia3, ib0, ib1, ib2, ib3; float ac0, ac1;
                    L_LDIDS(ia, t, 0); L_LDIDS(ib, t, 1); ac0 = ACT[(size_t)t * 128 + lane]; ac1 = ACT[(size_t)t * 128 + 64 + lane];
                    L_ISSUE(Wa, ia, vb);
                    for (;;) {
                        const int tn = t + nW; const bool more = tn < MTOK; const int tp = more ? tn : t;
                        L_ISSUE(Wb, ib, vb);
                        L_LDIDS(ia, tp, 0); const float an0 = ACT[(size_t)tp * 128 + lane], an1 = ACT[(size_t)tp * 128 + 64 + lane];
                        f32x2 oacc[8];
#pragma unroll
                        for (int k = 0; k < 8; ++k) oacc[k] = (f32x2){0.f, 0.f};
                        L2_COMPUTE(Wa, ac0);
                        L_ISSUE(Wa, ia, vb);
                        L_LDIDS(ib, tp, 1);
                        f32x4 xv[4]; { const GAS f32x4* q = (const GAS f32x4*)(xb + (size_t)t * DM); xv[0] = q[0]; xv[1] = q[1]; xv[2] = q[2]; xv[3] = q[3]; }
                        L2_COMPUTE(Wb, ac1);
#pragma unroll
                        for (int k = 0; k < 8; ++k) { float a = oacc[k].x, b = oacc[k].y; a += sx_f<16>(a); b += sx_f<16>(b); a = add32(a); b = add32(b); oacc[k] = (f32x2){a, b}; }
                        if (lane < 16) { GAS f32x4* q = (GAS f32x4*)(xb + (size_t)t * DM);
#pragma unroll
                            for (int k = 0; k < 4; ++k) { f32x4 v = xv[k];
#if DBG_MODE == 2
                                v = (f32x4){0.f, 0.f, 0.f, 0.f};
#endif
                                v.x += oacc[2 * k].x; v.y += oacc[2 * k].y; v.z += oacc[2 * k + 1].x; v.w += oacc[2 * k + 1].y; q[k] = v; } }
                        ac0 = an0; ac1 = an1;
                        if (!more) break;
                        t = tn;
                    }
                }
            }
#undef L2_COMPUTE
        }
#undef L_LDIDS
#undef L_ISSUE
#undef L_CVT
#endif
        GRID_BAR();
    }

    { PH_IDS();
    for (int m = gw; m < MTOK; m += NGW) {
        GAS f32x4* xr = (GAS f32x4*)(X + (size_t)m * DM) + lane; const GAS f32x4* gr = (const GAS f32x4*)INP(2) + lane;
        f32x4 v[8]; float s = 0.f;
#pragma unroll
        for (int j = 0; j < 8; ++j) { v[j] = xr[64 * j]; s += (v[j].x * v[j].x + v[j].y * v[j].y) + (v[j].z * v[j].z + v[j].w * v[j].w); }
        const float rstd = 1.0f / sqrtf(wave_sum(s) * (1.f / DM) + RMS_EPS);
#pragma unroll
        for (int j = 0; j < 8; ++j) { const f32x4 gg = gr[64 * j]; xr[64 * j] = v[j] * rstd * gg; }
    } }
}

extern "C" void kernel_launch(void* const* d_in, const int* in_sizes, int n_in, void* d_out, int out_size, void* d_ws, size_t ws_size, hipStream_t stream) {
    static int grid = 0;
    if (grid == 0) {
        if (n_in != 17 || in_sizes[0] != MTOK * DM || out_size != MTOK * DM || ws_size < WS_END) {
            fprintf(stderr, "kernel_launch: shape/workspace mismatch: n_in %d in0 %d out %d ws %zu (need %zu); nothing launched\n", n_in, n_in > 0 ? in_sizes[0] : -1, out_size, ws_size, (size_t)WS_END); grid = -1; return; }
        int dev = 0, cus = 0, per_cu = 0;
        if (hipGetDevice(&dev) != hipSuccess || hipDeviceGetAttribute(&cus, hipDeviceAttributeMultiprocessorCount, dev) != hipSuccess) { grid = -1; return; }
        if (hipFuncSetAttribute((const void*)mk_fwd, hipFuncAttributeMaxDynamicSharedMemorySize, LDS_BYTES) != hipSuccess) { fprintf(stderr, "kernel_launch: hipFuncSetAttribute failed\n"); grid = -1; return; }
        if (hipOccupancyMaxActiveBlocksPerMultiprocessor(&per_cu, (const void*)mk_fwd, NWAVES * 64, LDS_BYTES) != hipSuccess || per_cu < 1)
            fprintf(stderr, "kernel_launch: note: occupancy query reports %d workgroups per CU\n", per_cu);
        (void)hipGetLastError();
        grid = cus;
    }
    if (grid < 0) return;
    if (hipMemsetAsync((char*)d_ws + WS_CTL, 0, CTL_ZERO_BYTES, stream) != hipSuccess) { fprintf(stderr, "kernel_launch: memset failed\n"); return; }
    Args a{};
    for (int i = 0; i < 17; ++i) a.in[i] = (const float*)d_in[i];
    a.out = (float*)d_out; a.ws = (unsigned char*)d_ws;
    hipLaunchKernelGGL(mk_fwd, dim3(grid), dim3(NWAVES * 64), LDS_BYTES, stream, a);
    const hipError_t le = hipPeekAtLastError();
    if (le != hipSuccess) fprintf(stderr, "kernel_launch: launch failed: %s\n", hipGetErrorName(le));
}
```

```cpp
#include <hip/hip_runtime.h>
#include <cstdio>
#include <cstdint>

#ifndef DBG_MODE
#define DBG_MODE 0
#endif
constexpr int DM = 2048, NB = 4, SEQ = 4096, MTOK = NB * SEQ;
constexpr int INW = 14336, PJW = 8192, GTW = 6144;
constexpr int COL_DIL = 512, COL_DIFF = 5120;
constexpr int NEXP = 16384;
constexpr float RMS_EPS = 1e-6f;

typedef unsigned short bf16;
#define GAS __attribute__((address_space(1)))
#define LAS __attribute__((address_space(3)))
typedef unsigned v4u __attribute__((ext_vector_type(4)));
typedef float f32x4 __attribute__((ext_vector_type(4)));
typedef GAS unsigned gu32;

__device__ __forceinline__ int opaque_tid(int wave_sgpr) { int l; asm volatile("v_mbcnt_lo_u32_b32 %0, -1, 0\n\tv_mbcnt_hi_u32_b32 %0, -1, %0" : "=v"(l)); return wave_sgpr * 64 + l; }
namespace pg8 {
#define PG8_LAS __attribute__((address_space(3)))
typedef unsigned short bf16_t;
typedef short bf16x8 __attribute__((ext_vector_type(8)));
typedef float f32x4 __attribute__((ext_vector_type(4)));
typedef unsigned u32x4 __attribute__((ext_vector_type(4)));
typedef int i32x4 __attribute__((ext_vector_type(4)));
typedef int i32x8 __attribute__((ext_vector_type(8)));
constexpr int BM = 256, BK = 64, HALF = 128, HTB = HALF * BK * 2, STAGE_BYTES = 8 * HTB, NXCD = 8, WGM = 8;

__host__ __device__ __forceinline__ int lds_byte(int r, int c) { const int st = (r >> 4) * 2 + (c >> 5), rr = r & 15, cc = c & 31, ob = rr * 64 + cc * 2; return st * 1024 + (ob ^ (((ob >> 9) & 1) << 5)); }
__host__ __device__ __forceinline__ void stage_rc(int b, int& R, int& C) { const int st = b / 1024, sb = b % 1024, swz = sb ^ (((sb >> 9) & 1) << 5); R = (st >> 1) * 16 + swz / 64; C = (st & 1) * 32 + (swz % 64) / 2; }
__host__ __device__ __forceinline__ int perm32(int rho) { const int n = rho >> 4, i = rho & 15; return 8 * (i >> 2) + 4 * n + (i & 3); }

struct Unit { int pm, pn; long aoff, boff; int orow, ocol, sub; };
struct Gemm { const bf16_t* A; const bf16_t* Bt; };

struct StaticOrder {
    int nM, nN, nwg, G, c; long sa, sb;
    __device__ void init(int M, int N, int G_, int c_, int lda, int ldb) { nM = M / BM; nN = N / BM; nwg = nM * nN; G = G_; c = c_; sa = 512L * lda; sb = 512L * ldb; }
    __device__ bool next(int i, Unit& u) const {
        const long L = (long)i * G + c; if (L >= nwg) return false;
        int wgid = (int)L; { const int q = nwg / NXCD, r = nwg % NXCD, xcd = wgid % NXCD, off = wgid / NXCD; wgid = (xcd < r ? xcd * (q + 1) : r * (q + 1) + (xcd - r) * q) + off; }
        const int nig = WGM * nN, gid = wgid / nig, fm = gid * WGM, gsz = (nM - fm) < WGM ? (nM - fm) : WGM;
        u.pm = fm + ((wgid % nig) % gsz); u.pn = (wgid % nig) / gsz;
        u.aoff = u.pm * sa; u.boff = u.pn * sb; u.orow = u.pm * BM; u.ocol = u.pn * BM; u.sub = 0; return true;
    }
};
struct MergeOrder : StaticOrder {
    __device__ bool next(int i, Unit& u) const { if (!StaticOrder::next(i >> 2, u)) return false; u.sub = i & 3; u.aoff += 1024L * u.sub; u.boff += 1024L * u.sub; return true; }
};
struct F2Order : StaticOrder {
    __device__ bool next(int i, Unit& u) const { if (!StaticOrder::next(i, u)) return false; u.orow = (u.pn >> 1) * 4096 + u.pm * BM; u.ocol = (u.pn & 1) * BM; return true; }
};
struct F1Order {
    int G, c;
    __device__ bool next(int i, Unit& u) const {
        const int idx = i * G + c; if (idx >= 256) return false;
        const int bg = idx >> 4, st = idx & 15, b = bg >> 2, g = bg & 3;
        u.pm = 0; u.pn = idx; u.aoff = 0; u.boff = ((long)(b * 4096 + st * 256) * PJW + g * 128) * 2; u.orow = bg * 128; u.ocol = st * 256; return true;
    }
};

__device__ __forceinline__ unsigned cvt_pk_bf16(float lo, float hi) { unsigned r; asm volatile("v_cvt_pk_bf16_f32 %0, %1, %2" : "=v"(r) : "v"(lo), "v"(hi)); return r; }
__device__ __forceinline__ float bf_lo(unsigned w) { return __uint_as_float(w << 16); }
__device__ __forceinline__ float bf_hi(unsigned w) { return __uint_as_float(w & 0xffff0000u); }

#define PG8_PACK(v0, v1, w) do { (w).x = cvt_pk_bf16((v0)[0], (v0)[1]); (w).y = cvt_pk_bf16((v0)[2], (v0)[3]); (w).z = cvt_pk_bf16((v1)[0], (v1)[1]); (w).w = cvt_pk_bf16((v1)[2], (v1)[3]); } while (0)

struct EpiStore {
    static constexpr bool PERM = true;
    bf16_t* O; int ldo;
    __device__ __forceinline__ bool operator()(f32x4 (&acc)[2][2][4][2], const Unit& u, int wr, int wc, int fr, int fq) const {
        const int row0 = u.orow + wr * 64 + fr, col0 = u.ocol + wc * 32 + 8 * fq;
#pragma unroll
        for (int ai = 0; ai < 2; ++ai)
#pragma unroll
            for (int m = 0; m < 4; ++m) { bf16_t* rowp = O + (size_t)(row0 + ai * HALF + m * 16) * ldo + col0;
#pragma unroll
                for (int bj = 0; bj < 2; ++bj) { u32x4 w; PG8_PACK(acc[ai][bj][m][0], acc[ai][bj][m][1], w); *(u32x4*)(rowp + bj * HALF) = w; } }
        return true;
    }
};
struct EpiF2 {
    static constexpr bool PERM = true;
    bf16_t* O;
    __device__ __forceinline__ bool operator()(f32x4 (&acc)[2][2][4][2], const Unit& u, int wr, int wc, int fr, int fq) const {
        const int b = u.pn >> 1, gcol0 = (u.pn & 1) * BM + wc * 32 + 8 * fq;
#pragma unroll
        for (int ai = 0; ai < 2; ++ai)
#pragma unroll
            for (int m = 0; m < 4; ++m) { const int sp = u.pm * BM + ai * HALF + wr * 64 + m * 16 + fr;
#pragma unroll
                for (int bj = 0; bj < 2; ++bj) { const int gcol = gcol0 + bj * HALF; u32x4 w; PG8_PACK(acc[ai][bj][m][0], acc[ai][bj][m][1], w);
                    if (sp <= 2048) *(u32x4*)(O + (size_t)(b * 4096 + sp) * DM + gcol) = w;
                    if (sp >= 1 && sp <= 2047) { bf16_t* mr = O + (size_t)(b * 4096 + 4096 - sp) * DM + (gcol & ~127); const int c0 = gcol & 127;
                        mr[(128 - c0) & 127] = (bf16_t)(w.x & 0xffffu); mr[127 - c0] = (bf16_t)(w.x >> 16); mr[126 - c0] = (bf16_t)(w.y & 0xffffu); mr[125 - c0] = (bf16_t)(w.y >> 16);
                        mr[124 - c0] = (bf16_t)(w.z & 0xffffu); mr[123 - c0] = (bf16_t)(w.z >> 16); mr[122 - c0] = (bf16_t)(w.w & 0xffffu); mr[121 - c0] = (bf16_t)(w.w >> 16); } } }
        return true;
    }
};
struct EpiZT {
    static constexpr bool PERM = true;
    bf16_t* O;
    __device__ __forceinline__ bool operator()(f32x4 (&acc)[2][2][4][2], const Unit& u, int wr, int wc, int fr, int fq) const {
        const int row0 = u.orow + wr * 64 + fr, col0 = u.ocol + wc * 32 + 8 * fq;
#pragma unroll
        for (int ai = 0; ai < 2; ++ai)
#pragma unroll
            for (int m = 0; m < 4; ++m) { bf16_t* rowp = O + (size_t)(row0 + m * 16) * 8192 + ai * 4096 + col0;
#pragma unroll
                for (int bj = 0; bj < 2; ++bj) { u32x4 w; PG8_PACK(acc[ai][bj][m][0], acc[ai][bj][m][1], w); *(u32x4*)(rowp + bj * HALF) = w; } }
        return true;
    }
};
struct EpiProj {
    static constexpr bool PERM = true;
    bf16_t* P; bf16_t* Gt; const float* bg; int pnoff; float scale;
    __device__ __forceinline__ bool operator()(f32x4 (&acc)[2][2][4][2], const Unit& u, int wr, int wc, int fr, int fq) const {
        const int pnn = u.pn + pnoff; const bool isg = pnn >= 32;
        const int row0 = u.pm * BM + wr * 64 + fr, col0 = (isg ? pnn - 32 : pnn) * BM + wc * 32 + 8 * fq, ldc = isg ? GTW : PJW;
        bf16_t* base = isg ? Gt : P;
        f32x4 bv[2][2];
#pragma unroll
        for (int bj = 0; bj < 2; ++bj)
#pragma unroll
            for (int n = 0; n < 2; ++n) bv[bj][n] = isg ? *(const f32x4*)(bg + col0 + bj * HALF + 4 * n) : (f32x4){0.f, 0.f, 0.f, 0.f};
#pragma unroll
        for (int ai = 0; ai < 2; ++ai)
#pragma unroll
            for (int m = 0; m < 4; ++m) { bf16_t* rowp = base + (size_t)(row0 + ai * HALF + m * 16) * ldc + col0;
#pragma unroll
                for (int bj = 0; bj < 2; ++bj) { f32x4 v0 = acc[ai][bj][m][0] * scale + bv[bj][0], v1 = acc[ai][bj][m][1] * scale + bv[bj][1];
                    if (isg) {
#pragma unroll
                        for (int j = 0; j < 4; ++j) { v0[j] = __builtin_amdgcn_rcpf(1.0f + __builtin_amdgcn_exp2f(-1.4426950408889634f * v0[j])); v1[j] = __builtin_amdgcn_rcpf(1.0f + __builtin_amdgcn_exp2f(-1.4426950408889634f * v1[j])); } }
                    u32x4 w; PG8_PACK(v0, v1, w); *(u32x4*)(rowp + bj * HALF) = w; } }
        return true;
    }
};
struct EpiMerge4 {
    static constexpr bool PERM = true;
    const bf16_t* Gt; bf16_t* O;
    __device__ __forceinline__ bool operator()(f32x4 (&acc)[2][2][4][2], const Unit& u, int wr, int wc, int fr, int fq) const {
        const int row0 = u.pm * BM + wr * 64 + fr, col0 = u.pn * BM + wc * 32 + 8 * fq;
        if (u.sub == 2) return false;
        if (u.sub < 2) {
#pragma unroll
            for (int ai = 0; ai < 2; ++ai)
#pragma unroll
                for (int m = 0; m < 4; ++m) { const bf16_t* gp = Gt + (size_t)(row0 + ai * HALF + m * 16) * GTW + u.sub * DM + col0;
#pragma unroll
                    for (int bj = 0; bj < 2; ++bj) { const u32x4 gn = *(const u32x4*)(gp + bj * HALF), gd = *(const u32x4*)(gp + DM + bj * HALF);
                        f32x4 r0, r1;
                        r0[0] = bf_lo(gn.x) * __builtin_amdgcn_rcpf(bf_lo(gd.x)); r0[1] = bf_hi(gn.x) * __builtin_amdgcn_rcpf(bf_hi(gd.x));
                        r0[2] = bf_lo(gn.y) * __builtin_amdgcn_rcpf(bf_lo(gd.y)); r0[3] = bf_hi(gn.y) * __builtin_amdgcn_rcpf(bf_hi(gd.y));
                        r1[0] = bf_lo(gn.z) * __builtin_amdgcn_rcpf(bf_lo(gd.z)); r1[1] = bf_hi(gn.z) * __builtin_amdgcn_rcpf(bf_hi(gd.z));
                        r1[2] = bf_lo(gn.w) * __builtin_amdgcn_rcpf(bf_lo(gd.w)); r1[3] = bf_hi(gn.w) * __builtin_amdgcn_rcpf(bf_hi(gd.w));
                        acc[ai][bj][m][0] *= r0; acc[ai][bj][m][1] *= r1; }
                    asm volatile("" ::: "memory"); }
            return false;
        }
#pragma unroll
        for (int ai = 0; ai < 2; ++ai)
#pragma unroll
            for (int m = 0; m < 4; ++m) { const bf16_t* gp = Gt + (size_t)(row0 + ai * HALF + m * 16) * GTW + 2 * DM + col0; bf16_t* rowp = O + (size_t)(row0 + ai * HALF + m * 16) * DM + col0;
#pragma unroll
                for (int bj = 0; bj < 2; ++bj) { const u32x4 g = *(const u32x4*)(gp + bj * HALF);
                    f32x4 v0 = acc[ai][bj][m][0], v1 = acc[ai][bj][m][1];
                    v0[0] *= bf_lo(g.x); v0[1] *= bf_hi(g.x); v0[2] *= bf_lo(g.y); v0[3] *= bf_hi(g.y);
                    v1[0] *= bf_lo(g.z); v1[1] *= bf_hi(g.z); v1[2] *= bf_lo(g.w); v1[3] *= bf_hi(g.w);
                    u32x4 w; PG8_PACK(v0, v1, w); *(u32x4*)(rowp + bj * HALF) = w; }
                asm volatile("" ::: "memory"); }
        return true;
    }
};
struct EpiResF32 {
    static constexpr bool PERM = false;
    const float* base; float* out; int ldc;
    __device__ __forceinline__ bool operator()(f32x4 (&acc)[2][2][4][2], const Unit& u, int wr, int wc, int fr, int fq) const {
        const int row0 = u.orow + wr * 64 + fr, col0 = u.ocol + wc * 32 + 4 * fq;
#pragma unroll
        for (int ai = 0; ai < 2; ++ai)
#pragma unroll
            for (int m = 0; m < 4; ++m) { const size_t off = (size_t)(row0 + ai * HALF + m * 16) * ldc + col0;
#pragma unroll
                for (int bj = 0; bj < 2; ++bj)
#pragma unroll
                    for (int n = 0; n < 2; ++n) { f32x4 v = acc[ai][bj][m][n]; if (base) v += *(const f32x4*)(base + off + bj * HALF + n * 16); *(f32x4*)(out + off + bj * HALF + n * 16) = v; }
                asm volatile("" ::: "memory"); }
        return true;
    }
};

template <class Epi, class Sched, bool ALIGN_EPI, int LDA, int LDB, int KK, bool F8 = false>
__device__ __forceinline__ void gemm_phase(PG8_LAS unsigned char* lds, const Gemm g, const Sched& S, const Epi& E, int wave0) {
    const int tid = opaque_tid(wave0), wid = wave0, lane = tid & 63, wr = wid >> 2, wc = wid & 3, fr = lane & 15, fq = lane >> 4;
    constexpr int nt = KK / BK;
    unsigned voffA[2], voffB[2];
#pragma unroll
    for (int i = 0; i < 2; ++i) { int R, C; stage_rc(tid * 16 + i * 8192, R, C); const int Rb = Epi::PERM ? ((R & ~31) + perm32(R & 31)) : R;
        voffA[i] = (unsigned)(R * LDA + C) * 2u; voffB[i] = (unsigned)(Rb * LDB + C) * 2u; }
    const size_t kstep = (size_t)(BK * 2);
    constexpr size_t hstepA = (size_t)HALF * LDA * 2, hstepB = (size_t)HALF * LDB * 2;
    const unsigned ldsw = (unsigned)wid * 1024u;
    const int aoff = lds_byte(wr * 64 + fr, fq * 8), boff = lds_byte(wc * 32 + fr, fq * 8);
#define PG8_SA(b, h) (((b) * 2 + (h)) * HTB)
#define PG8_SB(b, h) ((4 + (b) * 2 + (h)) * HTB)
#define PG8_STAGE(bufoff, gbase, voff) do { _Pragma("unroll") for (int _i = 0; _i < 2; ++_i) \
        __builtin_amdgcn_global_load_lds((const unsigned*)((const char*)(gbase) + (voff)[_i]), (PG8_LAS unsigned*)(lds + (bufoff) + ldsw + _i * 8192), 16, 0, 0); } while (0)
#define PG8_LDA(dst, b, h) do { _Pragma("unroll") for (int m = 0; m < 4; ++m) _Pragma("unroll") for (int k = 0; k < 2; ++k) dst[m][k] = *(const PG8_LAS bf16x8*)(lds + PG8_SA(b, h) + aoff + m * 2048 + k * 1024); } while (0)
#define PG8_LDB(dst, b, h) do { _Pragma("unroll") for (int n = 0; n < 2; ++n) _Pragma("unroll") for (int k = 0; k < 2; ++k) dst[n][k] = *(const PG8_LAS bf16x8*)(lds + PG8_SB(b, h) + boff + n * 2048 + k * 1024); } while (0)
#define PG8_CAT(x) __builtin_shufflevector(__builtin_bit_cast(i32x4, (x)[0]), __builtin_bit_cast(i32x4, (x)[1]), 0, 1, 2, 3, 4, 5, 6, 7)
#define PG8_MMA(ai, bj, At, Bt) do { __builtin_amdgcn_s_setprio(1); _Pragma("unroll") for (int m = 0; m < 4; ++m) _Pragma("unroll") for (int n = 0; n < 2; ++n) { \
        if constexpr (F8) { const i32x8 a8_ = PG8_CAT(Bt[n]), b8_ = PG8_CAT(At[m]); asm volatile("v_mfma_scale_f32_16x16x128_f8f6f4 %0, %1, %2, %0, %3, %3 op_sel_hi:[0,0,0]" : "+v"(acc[ai][bj][m][n]) : "v"(a8_), "v"(b8_), "v"(one8)); } \
        else { _Pragma("unroll") for (int k = 0; k < 2; ++k) acc[ai][bj][m][n] = __builtin_amdgcn_mfma_f32_16x16x32_bf16(Bt[n][k], At[m][k], acc[ai][bj][m][n], 0, 0, 0); } } __builtin_amdgcn_s_setprio(0); } while (0)
#define PG8_WAIT_V(n) asm volatile("s_waitcnt vmcnt(" #n ")" ::: "memory")
#define PG8_WAIT_L(n) asm volatile("s_waitcnt lgkmcnt(" #n ")" ::: "memory")
#define PG8_BAR __builtin_amdgcn_s_barrier()
#define PG8_SCHED __builtin_amdgcn_sched_barrier(0)
    Unit cur, nxt; int ui = 0;
    if (!S.next(0, cur)) return;
    const int one8 = 0x7f7f7f7f; (void)one8;
    f32x4 acc[2][2][4][2];
#pragma unroll
    for (int a = 0; a < 2; ++a)
#pragma unroll
        for (int b = 0; b < 2; ++b)
#pragma unroll
            for (int m = 0; m < 4; ++m)
#pragma unroll
                for (int n = 0; n < 2; ++n) acc[a][b][m][n] = (f32x4){0.f, 0.f, 0.f, 0.f};
    bf16x8 At[4][2], B0[2][2], B1[2][2];
    const char* cA = (const char*)g.A + cur.aoff; const char* cB = (const char*)g.Bt + cur.boff;
    PG8_STAGE(PG8_SB(0, 0), cB, voffB); PG8_STAGE(PG8_SB(0, 1), cB + hstepB, voffB); PG8_STAGE(PG8_SA(0, 0), cA, voffA); PG8_STAGE(PG8_SA(0, 1), cA + hstepA, voffA);
    if (wr == 1) PG8_BAR;
    PG8_WAIT_V(2); PG8_BAR;
    PG8_STAGE(PG8_SB(1, 0), cB + kstep, voffB); PG8_STAGE(PG8_SA(1, 0), cA + kstep, voffA); PG8_STAGE(PG8_SB(1, 1), cB + hstepB + kstep, voffB);
    PG8_WAIT_V(6); PG8_BAR;
    for (;;) {
        const bool has_next = S.next(ui + 1, nxt);
        const char* nA = has_next ? (const char*)g.A + nxt.aoff : cA; const char* nB = has_next ? (const char*)g.Bt + nxt.boff : cB;
        for (int t = 0; t < nt; t += 2) {
            const bool last = (t == nt - 2);
            const char* a1 = cA + (size_t)(t + 1) * kstep;
            const char* a2 = last ? nA : cA + (size_t)(t + 2) * kstep; const char* b2 = last ? nB : cB + (size_t)(t + 2) * kstep;
            const char* a3 = a2 + kstep; const char* b3 = b2 + kstep;
            PG8_LDB(B0, 0, 0); PG8_LDB(B1, 0, 1); PG8_SCHED; PG8_LDA(At, 0, 0); PG8_STAGE(PG8_SA(1, 1), a1 + hstepA, voffA);
            PG8_WAIT_V(8); PG8_WAIT_L(0); PG8_BAR; PG8_MMA(0, 0, At, B0); PG8_MMA(0, 1, At, B1); PG8_BAR; PG8_SCHED;
            PG8_LDA(At, 0, 1); PG8_STAGE(PG8_SB(0, 0), b2, voffB); PG8_STAGE(PG8_SB(0, 1), b2 + hstepB, voffB); PG8_STAGE(PG8_SA(0, 0), a2, voffA);
            PG8_WAIT_V(8); PG8_WAIT_L(0); PG8_BAR; PG8_MMA(1, 0, At, B0); PG8_MMA(1, 1, At, B1); PG8_BAR; PG8_SCHED;
            PG8_LDB(B0, 1, 0); PG8_LDB(B1, 1, 1); PG8_SCHED; PG8_LDA(At, 1, 0); PG8_STAGE(PG8_SA(0, 1), a2 + hstepA, voffA);
            PG8_WAIT_V(8); PG8_WAIT_L(0); PG8_BAR; PG8_MMA(0, 0, At, B0); PG8_MMA(0, 1, At, B1); PG8_BAR; PG8_SCHED;
            PG8_LDA(At, 1, 1); PG8_STAGE(PG8_SB(1, 0), b3, voffB); PG8_STAGE(PG8_SB(1, 1), b3 + hstepB, voffB); PG8_STAGE(PG8_SA(1, 0), a3, voffA);
            PG8_WAIT_V(8); PG8_WAIT_L(0); PG8_BAR; PG8_MMA(1, 0, At, B0); PG8_MMA(1, 1, At, B1); PG8_BAR; PG8_SCHED;
        }
        if constexpr (ALIGN_EPI) { if (wr == 0) PG8_BAR; }
        if constexpr (F8) asm volatile("s_nop 15\n\ts_nop 15" ::: "memory");
        const bool fin = E(acc, cur, wr, wc, fr, fq);
        if (!has_next) break;
        if (fin) {
#pragma unroll
        for (int a = 0; a < 2; ++a)
#pragma unroll
            for (int b = 0; b < 2; ++b)
#pragma unroll
                for (int m = 0; m < 4; ++m)
#pragma unroll
                    for (int n = 0; n < 2; ++n) acc[a][b][m][n] = (f32x4){0.f, 0.f, 0.f, 0.f};
        }
        cur = nxt; cA = nA; cB = nB; ++ui;
        if constexpr (ALIGN_EPI) { if (wr == 1) PG8_BAR; }
    }
    PG8_WAIT_V(0);
    if constexpr (!ALIGN_EPI) { if (wr == 0) PG8_BAR; }
    PG8_BAR;
#undef PG8_SA
#undef PG8_SB
#undef PG8_STAGE
#undef PG8_LDA
#undef PG8_LDB
#undef PG8_MMA
#undef PG8_CAT
#undef PG8_WAIT_V
#undef PG8_WAIT_L
#undef PG8_BAR
#undef PG8_SCHED
}
}

namespace attn {
using bf16x8 = __attribute__((ext_vector_type(8))) short;
using s16x4  = __attribute__((ext_vector_type(4))) short;
using f32x16 = __attribute__((ext_vector_type(16))) float;
using u32x4  = __attribute__((ext_vector_type(4))) unsigned;
constexpr int   D = 128, NW = 8, QBLK = 32, KVBLK = 64;
constexpr float SCALE = 0.088388347648318440f;
constexpr float THR = 8.f;
constexpr size_t SHM_V = KVBLK * D * 2, SHM_K = KVBLK * D * 2;
constexpr int LDS_WS = 2 * SHM_V + 2 * SHM_K, LDS_TAB = LDS_WS + NW * 64 * 4, LDS_END = LDS_TAB + 8192 * 4;
#define KSWZ(row, colB) ((row) * 256 + ((colB) ^ (((row) & 7) << 4)))
#define SBAR() __builtin_amdgcn_sched_barrier(0)
__device__ __forceinline__ int crow(int r, int hi) { return (r & 3) + 8 * (r >> 2) + 4 * hi; }
__device__ __forceinline__ unsigned cvtpk(float lo, float hi) { unsigned r; asm volatile("v_cvt_pk_bf16_f32 %0, %1, %2" : "=v"(r) : "v"(lo), "v"(hi)); return r; }

__device__ __forceinline__ void partialSM(f32x16& p0, f32x16& p1, float& m_reg, float& mn, float& alpha) {
  constexpr float C = SCALE * 1.4426950408889634f;
  float pmax = p0[0]; for (int r = 1; r < 16; ++r) pmax = fmaxf(pmax, p0[r]); for (int r = 0; r < 16; ++r) pmax = fmaxf(pmax, p1[r]);
  { auto rr = __builtin_amdgcn_permlane32_swap(__float_as_uint(pmax), __float_as_uint(pmax), false, false);
    pmax = fmaxf(__uint_as_float(rr[0]), __uint_as_float(rr[1])); }
  if (__builtin_expect(__all(pmax - m_reg <= THR / SCALE), 1)) { mn = m_reg; alpha = 1.f; }
  else { mn = fmaxf(m_reg, pmax); alpha = __builtin_amdgcn_exp2f((m_reg - mn) * C); m_reg = mn; }
  float mnC = -mn * C;
  for (int r = 0; r < 16; ++r) p0[r] = fmaf(p0[r], C, mnC); for (int r = 0; r < 16; ++r) p1[r] = fmaf(p1[r], C, mnC);
  for (int r = 0; r < 16; ++r) p0[r] = __builtin_amdgcn_exp2f(p0[r]);
}
__device__ __forceinline__ void finishSM(f32x16& p0, f32x16& p1, float alpha, float& l_reg, bf16x8& pa0, bf16x8& pa1, bf16x8& pa2, bf16x8& pa3) {
  for (int r = 0; r < 16; ++r) p1[r] = __builtin_amdgcn_exp2f(p1[r]);
  float ps = 0; for (int r = 0; r < 16; ++r) ps += p0[r]; for (int r = 0; r < 16; ++r) ps += p1[r];
  { auto rr = __builtin_amdgcn_permlane32_swap(__float_as_uint(ps), __float_as_uint(ps), false, false);
    ps = __uint_as_float(rr[0]) + __uint_as_float(rr[1]); }
  l_reg = l_reg * alpha + ps;
#define PK4(P, BASE, OUT) do { unsigned a0 = cvtpk(P[BASE + 0], P[BASE + 1]), a1 = cvtpk(P[BASE + 2], P[BASE + 3]);   \
    unsigned b0 = cvtpk(P[BASE + 4], P[BASE + 5]), b1 = cvtpk(P[BASE + 6], P[BASE + 7]);                              \
    auto r0 = __builtin_amdgcn_permlane32_swap(a0, b0, false, false); auto r1 = __builtin_amdgcn_permlane32_swap(a1, b1, false, false); \
    u32x4 w = {r0[0], r1[0], r0[1], r1[1]}; OUT = *reinterpret_cast<bf16x8*>(&w); } while (0)
  PK4(p0, 0, pa0); PK4(p0, 8, pa1); PK4(p1, 0, pa2); PK4(p1, 8, pa3);
#undef PK4
}
__device__ __forceinline__ void qkt(f32x16& p0, f32x16& p1, const bf16* Ks, const bf16x8* qr, int r32, int hi, const float* tl) {
#pragma unroll
  for (int r = 0; r < 16; ++r) { p0[r] = tl[(r & 3) + 8 * (r >> 2)]; p1[r] = tl[32 + (r & 3) + 8 * (r >> 2)]; }
#pragma unroll
  for (int d0 = 0; d0 < 8; ++d0) { int cb = (d0 * 16 + hi * 8) * 2;
    bf16x8 b0 = *reinterpret_cast<const bf16x8*>((const char*)Ks + KSWZ(r32, cb));
    bf16x8 b1 = *reinterpret_cast<const bf16x8*>((const char*)Ks + KSWZ(32 + r32, cb));
    p0 = __builtin_amdgcn_mfma_f32_32x32x16_bf16(b0, qr[d0], p0, 0, 0, 0);
    p1 = __builtin_amdgcn_mfma_f32_32x32x16_bf16(b1, qr[d0], p1, 0, 0, 0); }
}
__device__ __forceinline__ int v_st(int k, int c) { const int kk = (k & ~0xC) | ((k & 4) << 1) | ((k & 8) >> 1); return ((kk >> 3) * 4 + (c >> 5)) * 512 + ((kk & 7) * 32 + (c & 31)) * 2; }
__device__ __forceinline__ int v_rd_base(int lane) { return ((lane & 3) << 3) | (((lane >> 2) & 3) << 6) | (((lane >> 4) & 1) << 5) | (((lane >> 5) & 1) << 8); }
constexpr int v_rd_off(int d0, int ks, int half) { return d0 * 512 + ks * 4096 + half * 2048; }
template <int OFF> __device__ __forceinline__ s16x4 tr_read(int vb) {
  s16x4 r; asm volatile("ds_read_b64_tr_b16 %0, %1 offset:%2" : "=&v"(r) : "v"(vb), "i"(OFF) : "memory"); return r;
}
template <int D0> __device__ __forceinline__ void pv_one(f32x16& od, int vb, bf16x8 pa0, bf16x8 pa1, bf16x8 pa2, bf16x8 pa3) {
  const s16x4 l0 = tr_read<v_rd_off(D0, 0, 0)>(vb), h0 = tr_read<v_rd_off(D0, 0, 1)>(vb), l1 = tr_read<v_rd_off(D0, 1, 0)>(vb), h1 = tr_read<v_rd_off(D0, 1, 1)>(vb);
  const s16x4 l2 = tr_read<v_rd_off(D0, 2, 0)>(vb), h2 = tr_read<v_rd_off(D0, 2, 1)>(vb), l3 = tr_read<v_rd_off(D0, 3, 0)>(vb), h3 = tr_read<v_rd_off(D0, 3, 1)>(vb);
  asm volatile("s_waitcnt lgkmcnt(0)" ::: "memory"); SBAR();
#define PK(L, H) (bf16x8){L[0], L[1], L[2], L[3], H[0], H[1], H[2], H[3]}
  od = __builtin_amdgcn_mfma_f32_32x32x16_bf16(pa0, PK(l0, h0), od, 0, 0, 0);
  od = __builtin_amdgcn_mfma_f32_32x32x16_bf16(pa1, PK(l1, h1), od, 0, 0, 0);
  od = __builtin_amdgcn_mfma_f32_32x32x16_bf16(pa2, PK(l2, h2), od, 0, 0, 0);
  od = __builtin_amdgcn_mfma_f32_32x32x16_bf16(pa3, PK(l3, h3), od, 0, 0, 0);
#undef PK
}
__device__ __forceinline__ void pv_d0(f32x16* o, int vb, bf16x8 pa0, bf16x8 pa1, bf16x8 pa2, bf16x8 pa3) {
  pv_one<0>(o[0], vb, pa0, pa1, pa2, pa3); pv_one<1>(o[1], vb, pa0, pa1, pa2, pa3); pv_one<2>(o[2], vb, pa0, pa1, pa2, pa3); pv_one<3>(o[3], vb, pa0, pa1, pa2, pa3);
}

struct Unit { const bf16* Q; const bf16* K; const bf16* V; bf16* O; float* lse; long ldq, ldk, ldo; int lse_ld, kt0, nt, qoff; };
__device__ __forceinline__ void attn_unit(const Unit& u, char* lds, int wave0) {
  const int tid = opaque_tid(wave0), wid = wave0, lane = tid & 63, r32 = lane & 31, hi = lane >> 5;
  bf16* V_lds = (bf16*)lds; bf16* K_lds = (bf16*)(lds + 2 * SHM_V);
  float* ws = (float*)(lds + LDS_WS) + wid * 64; float* li_l = ws; float* al_l = ws + 32;
  const float* tabL = (const float*)(lds + LDS_TAB);
  float m_reg = -1e30f, l_reg = 0; f32x16 o[4] = {}; bf16x8 qr[8];
  const bf16* Qw = u.Q + (long)(wid * QBLK + r32) * u.ldq + hi * 8;
#pragma unroll
  for (int d0 = 0; d0 < 8; ++d0) qr[d0] = *reinterpret_cast<const bf16x8*>(Qw + d0 * 16);
  const int sr = tid >> 4, sc = (tid & 15) * 8, vst0 = v_st(sr, sc), vst1 = v_st(32 + sr, sc);
  const int vb0 = (int)(uintptr_t)V_lds + v_rd_base(lane);
  const long tstep = (long)KVBLK * u.ldk * 2;
  const char* Kh = (const char*)u.K + (long)u.kt0 * tstep; const char* Vh = (const char*)u.V + (long)u.kt0 * tstep;
  const unsigned lo0 = (unsigned)((sr * (int)u.ldk + sc) * 2), lo1 = lo0 + (unsigned)(32 * (int)u.ldk * 2);
  const float* tl0 = tabL + (4096 + u.kt0 * KVBLK + 4 * hi - (u.qoff + wid * QBLK + r32));
  struct { bf16x8 vs0, vs1, ks0, ks1; } sr_[2];
#define SLOAD(i, tj) do { const char* vt_ = Vh + (long)(tj) * tstep; const char* kt_ = Kh + (long)(tj) * tstep; \
    sr_[i].vs0 = *reinterpret_cast<const bf16x8*>(vt_ + lo0); sr_[i].vs1 = *reinterpret_cast<const bf16x8*>(vt_ + lo1); \
    sr_[i].ks0 = *reinterpret_cast<const bf16x8*>(kt_ + lo0); sr_[i].ks1 = *reinterpret_cast<const bf16x8*>(kt_ + lo1); } while (0)
#define SWRITE(b, i) do { *(bf16x8*)((char*)V_lds + (b) * SHM_V + vst0) = sr_[i].vs0;          \
    *(bf16x8*)((char*)V_lds + (b) * SHM_V + vst1) = sr_[i].vs1; int kc = sc * 2;               \
    *(bf16x8*)((char*)K_lds + (b) * SHM_K + KSWZ(sr, kc)) = sr_[i].ks0;                       \
    *(bf16x8*)((char*)K_lds + (b) * SHM_K + KSWZ(32 + sr, kc)) = sr_[i].ks1; } while (0)
#define SWAIT() asm volatile("s_waitcnt vmcnt(4)" ::: "memory")
#define RESC(a) do { if (__any((a) < 1.f)) { if (hi == 0) al_l[r32] = (a); asm volatile("s_waitcnt lgkmcnt(0)" ::: "memory"); \
    for (int d = 0; d < 4; ++d) for (int r = 0; r < 16; ++r) o[d][r] *= al_l[crow(r, hi)]; } } while (0)
  f32x16 pA0, pA1, pB0, pB1; float mnA, mnB, alA, alB; bf16x8 pa0, pa1, pa2, pa3; const int NT = u.nt;
  constexpr int SE = 0, SO = 1;
  SLOAD(SE, 0); asm volatile("s_waitcnt vmcnt(0)" ::: "memory"); SWRITE(0, SE); __syncthreads();
  qkt(pA0, pA1, K_lds, qr, r32, hi, tl0); partialSM(pA0, pA1, m_reg, mnA, alA);
  SLOAD(SO, 1); if (2 < NT) SLOAD(SE, 2);
  SWAIT(); SWRITE(1, SO); __syncthreads();
  for (int j = 1; j + 1 < NT; j += 2) {
    SBAR(); qkt(pB0, pB1, (bf16*)((char*)K_lds + SHM_K), qr, r32, hi, tl0 + j * KVBLK);
    finishSM(pA0, pA1, alA, l_reg, pa0, pa1, pa2, pa3); SBAR();
    SLOAD(SO, j + 2); SBAR();
    pv_d0(o, vb0, pa0, pa1, pa2, pa3); partialSM(pB0, pB1, m_reg, mnB, alB);
    __syncthreads(); SWAIT(); SWRITE(0, SE);
    RESC(alB); __syncthreads();
    SBAR(); qkt(pA0, pA1, K_lds, qr, r32, hi, tl0 + (j + 1) * KVBLK);
    finishSM(pB0, pB1, alB, l_reg, pa0, pa1, pa2, pa3); SBAR();
    if (j + 3 < NT) SLOAD(SE, j + 3); SBAR();
    pv_d0(o, vb0 + (int)SHM_V, pa0, pa1, pa2, pa3); partialSM(pA0, pA1, m_reg, mnA, alA);
    __syncthreads(); SWAIT(); SWRITE(1, SO);
    RESC(alA); __syncthreads();
  }
  SBAR(); qkt(pB0, pB1, (bf16*)((char*)K_lds + SHM_K), qr, r32, hi, tl0 + (NT - 1) * KVBLK);
  finishSM(pA0, pA1, alA, l_reg, pa0, pa1, pa2, pa3); SBAR();
  pv_d0(o, vb0, pa0, pa1, pa2, pa3); partialSM(pB0, pB1, m_reg, mnB, alB);
  __syncthreads(); RESC(alB);
  finishSM(pB0, pB1, alB, l_reg, pa0, pa1, pa2, pa3); SBAR();
  pv_d0(o, vb0 + (int)SHM_V, pa0, pa1, pa2, pa3);
  if (hi == 0) li_l[r32] = l_reg; asm volatile("s_waitcnt lgkmcnt(0)" ::: "memory");
  float rli[16];
#pragma unroll
  for (int r = 0; r < 16; ++r) rli[r] = __builtin_amdgcn_rcpf(li_l[crow(r, hi)]);
  bf16* Ow = u.O + (long)(wid * QBLK) * u.ldo;
#pragma unroll
  for (int r = 0; r < 16; ++r) { int orow = crow(r, hi);
#pragma unroll
    for (int d0 = 0; d0 < 4; ++d0) { const float v = o[d0][r] * rli[r]; Ow[(long)orow * u.ldo + d0 * 32 + r32] = (bf16)(cvtpk(v, v) & 0xffffu); } }
  if (u.lse != nullptr && hi == 0) u.lse[(long)(wid * QBLK + r32) * u.lse_ld] = m_reg * SCALE + __logf(l_reg);
#undef SLOAD
#undef SWRITE
#undef SWAIT
#undef RESC
}
#undef KSWZ
#undef SBAR
}

constexpr int NWAVES = 8;
constexpr size_t MiB = 1u << 20;
constexpr size_t WS_CTL = 0, CTL_ZERO_BYTES = 1 * MiB;
constexpr size_t WS_CS   = 1 * MiB;
constexpr size_t WS_SKBD = 1 * MiB + 256 * 1024;
constexpr size_t WS_TAB  = 2 * MiB;
constexpr size_t WS_LSE  = 3 * MiB;
constexpr size_t WS_SU   = 3 * MiB + 768 * 1024;
constexpr size_t WS_SH   = 3 * MiB + 832 * 1024;
constexpr size_t WS_WCAT = 4 * MiB, WS_WO = 12 * MiB, WS_WQ = 20 * MiB;
constexpr size_t WS_WIN  = 28 * MiB;
constexpr size_t WS_WG8  = WS_WIN + 32 * MiB;
constexpr size_t WS_DFT  = 84 * MiB;
constexpr size_t WS_U    = 148 * MiB, WS_V = 180 * MiB;
constexpr size_t WS_H8   = 212 * MiB;
constexpr size_t WS_H    = 276 * MiB;
constexpr size_t WS_PROJ = 340 * MiB;
constexpr size_t WS_G    = 596 * MiB;
constexpr size_t WS_ZT   = 788 * MiB;
constexpr size_t WS_OC   = 820 * MiB;
constexpr size_t WS_MG   = 884 * MiB;
constexpr size_t WS_END  = 948 * MiB;
#if DBG_MODE == 2
constexpr size_t WS_ACT = WS_PROJ + 208 * MiB;
#else
constexpr size_t WS_ACT = WS_PROJ + 200 * MiB;
#endif
constexpr size_t WS_Q = WS_PROJ, WS_SC = WS_PROJ + 64 * MiB, WS_IDS = WS_PROJ + 192 * MiB, WS_GATES = WS_PROJ + 200 * MiB;
constexpr int CW_BAR = 4096;
constexpr int CW_XRANK = 12288;
constexpr int CW_QUEUE = 16384;
constexpr int RING_BYTES = 131072, LDSCTL_OFF = RING_BYTES, MISC_OFF = LDSCTL_OFF + 320, LDS_BYTES = 147456;

#define LDS_WAIT() asm volatile("s_waitcnt lgkmcnt(0)" ::: "memory")
#define VM_WAIT() asm volatile("s_waitcnt vmcnt(0)" ::: "memory")
__device__ __forceinline__ unsigned f2bf(float f) { unsigned u = __builtin_bit_cast(unsigned, f); return (u + 0x7fffu + ((u >> 16) & 1u)) >> 16; }
__device__ __forceinline__ unsigned pk2(float lo, float hi) { return f2bf(lo) | (f2bf(hi) << 16); }
__device__ __forceinline__ float bflo(unsigned w) { return __uint_as_float(w << 16); }
__device__ __forceinline__ float bfhi(unsigned w) { return __uint_as_float(w & 0xffff0000u); }

#define XB_TMO      128
#define XB_XCNT(j)  (256  + 64 * (j))
#define XB_XSUB(j)  (1280 + 64 * (j))
#define XB_XGEN(j)  (2304 + 64 * (j))
#define XB_TOP      3328
#define XB_TOPGEN   3392
#define XCD_BAR_WORDS 3456
#define XB_SPIN_CAP (1u << 20)
__device__ __forceinline__ unsigned xb_ld(unsigned* p)              { return __hip_atomic_load(p, __ATOMIC_RELAXED, __HIP_MEMORY_SCOPE_AGENT); }
__device__ __forceinline__ unsigned xb_add(unsigned* p, unsigned v) { return __hip_atomic_fetch_add(p, v, __ATOMIC_RELAXED, __HIP_MEMORY_SCOPE_AGENT); }
__device__ __forceinline__ unsigned xb_xcc_id() { return (unsigned)__builtin_amdgcn_s_getreg((3 << 11) | 20) & 0xFu; }
#define XB_SPIN(cond, bar) do { unsigned _sp = 0; while (cond) { __builtin_amdgcn_s_sleep(1); \
    if ((++_sp & 255u) == 0u) { if (xb_ld(&(bar)[XB_TMO])) break; if (_sp > XB_SPIN_CAP) { atomicAdd(&(bar)[XB_TMO], 1u); break; } } } } while (0)
struct XcdBarrier { unsigned* bar; unsigned x; volatile LAS unsigned* st; };
__device__ __forceinline__ XcdBarrier xcd_barrier_post(unsigned* bar, volatile LAS unsigned* st) {
    XcdBarrier b; b.bar = bar; b.x = xb_xcc_id(); b.st = st;
    if (threadIdx.x == 0) (void)xb_add(&bar[XB_XCNT(b.x)], 1u);
    return b;
}
__device__ __forceinline__ void xcd_barrier_complete(unsigned* bar, unsigned x, unsigned& nloc, unsigned& nx) {
    const unsigned G = gridDim.x * gridDim.y * gridDim.z;
    unsigned sum, cnt, mine, sp = 0u;
    for (;;) {
        sum = 0u; cnt = 0u; mine = 0u;
#pragma unroll
        for (unsigned j = 0; j < 16; ++j) { const unsigned c = xb_ld(&bar[XB_XCNT(j)]); sum += c; cnt += (c > 0u) ? 1u : 0u; mine = (j == x) ? c : mine; }
        if (sum == G) break;
        __builtin_amdgcn_s_sleep(1);
        if ((++sp & 255u) == 0u) { if (xb_ld(&bar[XB_TMO])) break; if (sp > XB_SPIN_CAP) { atomicAdd(&bar[XB_TMO], 1u); break; } }
    }
    nloc = mine > 0u ? mine : 1u; nx = cnt > 0u ? cnt : 1u;
}
__device__ __forceinline__ void xcd_barrier(const XcdBarrier& b) {
    asm volatile("s_waitcnt vmcnt(0)" ::: "memory");
    __syncthreads();
    if (threadIdx.x == 0) {
        unsigned* bar = b.bar;
        __builtin_amdgcn_s_waitcnt(0);
        unsigned nloc = b.st[0], nx = b.st[1];
        if (nloc == 0u) { xcd_barrier_complete(bar, b.x, nloc, nx); b.st[0] = nloc; b.st[1] = nx; }
        const unsigned old = xb_add(&bar[XB_XSUB(b.x)], 1u);
        const unsigned gen = old / nloc;
        if (old + 1u == (gen + 1u) * nloc) {
            __builtin_amdgcn_fence(__ATOMIC_RELEASE, "agent");
            asm volatile("s_waitcnt vmcnt(0)" ::: "memory");
            const unsigned og = xb_add(&bar[XB_TOP], 1u);
            const unsigned tg = og / nx;
            if (og + 1u == (tg + 1u) * nx) xb_add(&bar[XB_TOPGEN], 1u);
            else XB_SPIN(xb_ld(&bar[XB_TOPGEN]) == tg, bar);
            __builtin_amdgcn_fence(__ATOMIC_ACQUIRE, "agent");
            xb_add(&bar[XB_XGEN(b.x)], 1u);
            asm volatile("s_waitcnt vmcnt(0)" ::: "memory");
        } else {
            XB_SPIN(xb_ld(&bar[XB_XGEN(b.x)]) == gen, bar);
            __builtin_amdgcn_fence(__ATOMIC_ACQUIRE, "agent");
            asm volatile("s_waitcnt vmcnt(0)" ::: "memory");
        }
    }
    __syncthreads();
}

template <int MASK> __device__ __forceinline__ int sx_i(int v) { return __builtin_amdgcn_ds_swizzle(v, 0x1f | (MASK << 10)); }
template <int MASK> __device__ __forceinline__ float sx_f(float v) { return __int_as_float(sx_i<MASK>(__float_as_int(v))); }
__device__ __forceinline__ float add32(float v) { auto rr = __builtin_amdgcn_permlane32_swap(__float_as_uint(v), __float_as_uint(v), false, false); return __uint_as_float(rr[0]) + __uint_as_float(rr[1]); }
__device__ __forceinline__ unsigned max32(unsigned v) { auto rr = __builtin_amdgcn_permlane32_swap(v, v, false, false); return rr[0] > rr[1] ? rr[0] : rr[1]; }
__device__ __forceinline__ float other32(float v, bool upper) { auto rr = __builtin_amdgcn_permlane32_swap(__float_as_uint(v), __float_as_uint(v), false, false); return __uint_as_float(upper ? rr[0] : rr[1]); }
__device__ __forceinline__ float bperm_f(float v, int src_lane) { return __int_as_float(__builtin_amdgcn_ds_bpermute(src_lane * 4, __float_as_int(v))); }
__device__ __forceinline__ int bperm_i(int v, int src_lane) { return __builtin_amdgcn_ds_bpermute(src_lane * 4, v); }
__device__ __forceinline__ float wave_sum(float v) {
    v += sx_f<1>(v); v += sx_f<2>(v); v += sx_f<4>(v); v += sx_f<8>(v); v += sx_f<16>(v); return add32(v);
}
__device__ __forceinline__ unsigned umax(unsigned a, unsigned b) { return a > b ? a : b; }
__device__ __forceinline__ unsigned wave_max_u32(unsigned v) {
    v = umax(v, (unsigned)sx_i<1>((int)v)); v = umax(v, (unsigned)sx_i<2>((int)v)); v = umax(v, (unsigned)sx_i<4>((int)v)); v = umax(v, (unsigned)sx_i<8>((int)v)); v = umax(v, (unsigned)sx_i<16>((int)v)); return max32(v);
}
template <int CTRL, int RMASK> __device__ __forceinline__ unsigned dpp_max_u(unsigned v) { const unsigned t = (unsigned)__builtin_amdgcn_update_dpp((int)v, (int)v, CTRL, RMASK, 0xF, false); return t > v ? t : v; }
__device__ __forceinline__ unsigned wave_max_dpp(unsigned v) {
    v = dpp_max_u<0xB1, 0xF>(v); v = dpp_max_u<0x4E, 0xF>(v); v = dpp_max_u<0x141, 0xF>(v); v = dpp_max_u<0x140, 0xF>(v); v = dpp_max_u<0x142, 0xA>(v); v = dpp_max_u<0x143, 0xC>(v);
    return (unsigned)__builtin_amdgcn_readlane((int)v, 63);
}
template <int CTRL> __device__ __forceinline__ float dpp_add_f(float v) { return v + __int_as_float(__builtin_amdgcn_update_dpp(__float_as_int(v), __float_as_int(v), CTRL, 0xF, 0xF, false)); }
__device__ __forceinline__ float row_sum16(float v) { v = dpp_add_f<0xB1>(v); v = dpp_add_f<0x4E>(v); v = dpp_add_f<0x141>(v); return dpp_add_f<0x140>(v); }
__device__ __forceinline__ unsigned row_max16_u(unsigned v) { v = dpp_max_u<0xB1, 0xF>(v); v = dpp_max_u<0x4E, 0xF>(v); v = dpp_max_u<0x141, 0xF>(v); return dpp_max_u<0x140, 0xF>(v); }
template <int CTRL> __device__ __forceinline__ float dpp_maxf(float v) { return fmaxf(v, __int_as_float(__builtin_amdgcn_update_dpp(__float_as_int(v), __float_as_int(v), CTRL, 0xF, 0xF, false))); }
__device__ __forceinline__ float row_max16_f(float v) { v = dpp_maxf<0xB1>(v); v = dpp_maxf<0x4E>(v); v = dpp_maxf<0x141>(v); return dpp_maxf<0x140>(v); }
__device__ __forceinline__ float okey_inv(unsigned k) { return __uint_as_float((k & 0x80000000u) ? (k & 0x7fffffffu) : ~k); }
#define CE_DESC(a, b) do { const unsigned hi_ = (a) > (b) ? (a) : (b), lo_ = (a) > (b) ? (b) : (a); (a) = hi_; (b) = lo_; } while (0)
__device__ __forceinline__ unsigned okey(float f) { const unsigned u = __float_as_uint(f); return (u & 0x80000000u) ? ~u : (u | 0x80000000u); }

__device__ __forceinline__ void transpose_item(const float* W, int N, bf16* WT, int ldo, int col_off, LAS float* scr, int item, int lane) {
    const int nblk = N / 32, kb = item / nblk, nb = item % nblk, k0 = 64 * kb, n0 = 32 * nb;
#pragma unroll 8
    for (int i = 0; i < 32; ++i) { const int kk = 2 * i + (lane >> 5); scr[kk * 33 + (lane & 31)] = W[(size_t)(k0 + kk) * N + n0 + (lane & 31)]; }
    LDS_WAIT(); asm volatile("" ::: "memory");
    const int c = lane & 7;
#pragma unroll
    for (int j = 0; j < 4; ++j) { const int n = (lane >> 3) + 8 * j; const LAS float* s = scr + (8 * c) * 33 + n;
        v4u o; o.x = pk2(s[0 * 33], s[1 * 33]); o.y = pk2(s[2 * 33], s[3 * 33]); o.z = pk2(s[4 * 33], s[5 * 33]); o.w = pk2(s[6 * 33], s[7 * 33]);
        *(GAS v4u*)(WT + (size_t)(n0 + n) * ldo + col_off + k0 + 8 * c) = o; }
    LDS_WAIT(); asm volatile("" ::: "memory");
}
__device__ __forceinline__ void transpose_item_fp8(const float* W, int N, int ncol0, unsigned char* WT8, int ldo, float scale, LAS float* scr, int item, int lane) {
    const int nblk = N / 32, kb = item / nblk, nb = item % nblk, k0 = 64 * kb, n0 = 32 * nb;
#pragma unroll 8
    for (int i = 0; i < 32; ++i) { const int kk = 2 * i + (lane >> 5); scr[kk * 33 + (lane & 31)] = W[(size_t)(k0 + kk) * N + n0 + (lane & 31)]; }
    LDS_WAIT(); asm volatile("" ::: "memory");
    const int c = lane & 3;
#pragma unroll
    for (int j = 0; j < 2; ++j) { const int n = (lane >> 2) + 16 * j; const LAS float* s = scr + (16 * c) * 33 + n; v4u o; int w;
        w = __builtin_amdgcn_cvt_pk_fp8_f32(s[0 * 33] * scale, s[1 * 33] * scale, 0, false); w = __builtin_amdgcn_cvt_pk_fp8_f32(s[2 * 33] * scale, s[3 * 33] * scale, w, true); o.x = (unsigned)w;
        w = __builtin_amdgcn_cvt_pk_fp8_f32(s[4 * 33] * scale, s[5 * 33] * scale, 0, false); w = __builtin_amdgcn_cvt_pk_fp8_f32(s[6 * 33] * scale, s[7 * 33] * scale, w, true); o.y = (unsigned)w;
        w = __builtin_amdgcn_cvt_pk_fp8_f32(s[8 * 33] * scale, s[9 * 33] * scale, 0, false); w = __builtin_amdgcn_cvt_pk_fp8_f32(s[10 * 33] * scale, s[11 * 33] * scale, w, true); o.z = (unsigned)w;
        w = __builtin_amdgcn_cvt_pk_fp8_f32(s[12 * 33] * scale, s[13 * 33] * scale, 0, false); w = __builtin_amdgcn_cvt_pk_fp8_f32(s[14 * 33] * scale, s[15 * 33] * scale, w, true); o.w = (unsigned)w;
        *(GAS v4u*)(WT8 + (size_t)(n0 + n - ncol0) * ldo + k0 + 16 * c) = o; }
    LDS_WAIT(); asm volatile("" ::: "memory");
}
template <bool FP8> __device__ __forceinline__ void rms_row_to_bf16(const float* xrow, const float* g, bf16* orow, unsigned char* o8row, int lane) {
    const GAS f32x4* xr = (const GAS f32x4*)xrow + lane; const GAS f32x4* gr = (const GAS f32x4*)g + lane;
    f32x4 v[8]; float s = 0.f;
#pragma unroll
    for (int j = 0; j < 8; ++j) { v[j] = xr[64 * j]; s += (v[j].x * v[j].x + v[j].y * v[j].y) + (v[j].z * v[j].z + v[j].w * v[j].w); }
    const float rstd = 1.0f / sqrtf(wave_sum(s) * (1.f / DM) + RMS_EPS);
    GAS unsigned long long* o8 = (GAS unsigned long long*)orow + lane;
#pragma unroll
    for (int j = 0; j < 8; ++j) { const f32x4 gg = gr[64 * j]; const float a = v[j].x * rstd * gg.x, b = v[j].y * rstd * gg.y, c = v[j].z * rstd * gg.z, d = v[j].w * rstd * gg.w;
        o8[64 * j] = (unsigned long long)pk2(a, b) | ((unsigned long long)pk2(c, d) << 32);
        if (FP8) { int w = __builtin_amdgcn_cvt_pk_fp8_f32(a * 32.f, b * 32.f, 0, false); w = __builtin_amdgcn_cvt_pk_fp8_f32(c * 32.f, d * 32.f, w, true); ((GAS unsigned*)o8row)[lane + 64 * j] = (unsigned)w; } }
}
typedef __bf16 bf2_t __attribute__((ext_vector_type(2)));
__device__ __forceinline__ float DOT2(unsigned a, unsigned b, float c) { return __builtin_amdgcn_fdot2_f32_bf16(__builtin_bit_cast(bf2_t, a), __builtin_bit_cast(bf2_t, b), c, false); }
__device__ __forceinline__ unsigned q8x4(float a, float b, float c, float d, float inv) {
    const int ia = (int)__builtin_rintf(a * inv), ib = (int)__builtin_rintf(b * inv), ic = (int)__builtin_rintf(c * inv), id = (int)__builtin_rintf(d * inv);
    return (unsigned)(ia & 0xff) | ((unsigned)(ib & 0xff) << 8) | ((unsigned)(ic & 0xff) << 16) | ((unsigned)(id & 0xff) << 24);
}
__device__ __forceinline__ float wave_maxf(float v) {
    v = fmaxf(v, sx_f<1>(v)); v = fmaxf(v, sx_f<2>(v)); v = fmaxf(v, sx_f<4>(v)); v = fmaxf(v, sx_f<8>(v)); v = fmaxf(v, sx_f<16>(v));
    auto rr = __builtin_amdgcn_permlane32_swap(__float_as_uint(v), __float_as_uint(v), false, false); return fmaxf(__uint_as_float(rr[0]), __uint_as_float(rr[1]));
}
__device__ __forceinline__ int rel_bucket(int rel) {
    const int n = rel < 0 ? -rel : rel;
    int b = n;
    if (n >= 8) { b = 5 + (31 - __builtin_clz((unsigned)n)); if (b > 15) b = 15; }
    return b + (rel > 0 ? 16 : 0);
}

#ifndef PH_D1
#define PH_D1 1
#endif
#ifndef PH_D2
#define PH_D2 1
#endif
#ifndef PH_A
#define PH_A 1
#endif
#ifndef PH_B
#define PH_B 1
#endif
#ifndef PH_C
#define PH_C 1
#endif
#ifndef PH_D
#define PH_D 1
#endif
#ifndef PH_E
#define PH_E 1
#endif
#ifndef PH_F
#define PH_F 1
#endif
#ifndef PH_G
#define PH_G 1
#endif
#ifndef PH_H
#define PH_H 1
#endif
#ifndef PH_I
#define PH_I 1
#endif
#ifndef PH_J
#define PH_J 1
#endif
#ifndef PH_K
#define PH_K 1
#endif
#ifndef PH_L
#define PH_L 1
#endif
struct Args { const float* in[17]; float* out; unsigned char* ws; };

#define CAS __attribute__((address_space(4)))
__device__ __forceinline__ const void* karg(int k) { const CAS char* ka = (const CAS char*)__builtin_amdgcn_kernarg_segment_ptr(); asm volatile("" : "+s"(ka)); return *(const void* const CAS*)(ka + 8 * k); }
#define WSP(T, off) ((T*)((unsigned char*)karg(18) + (off)))
#define INP(k) ((const float*)karg(k))
#define INL(k, stride) (INP(k) + (size_t)layer * (size_t)(stride))
#define X ((float*)karg(17))
__global__ void __launch_bounds__(NWAVES * 64, 2) mk_fwd(Args args_unused) {
    extern __shared__ __attribute__((aligned(16))) unsigned char lds[];
    LAS unsigned char* ldsl = (LAS unsigned char*)lds;
    volatile LAS unsigned* MISC = (volatile LAS unsigned*)(ldsl + MISC_OFF);
    const int wave0 = __builtin_amdgcn_readfirstlane((int)threadIdx.x >> 6);
    const int G = gridDim.x; const int bx = blockIdx.x; const int vcu = (G % 8 == 0) ? (bx % 8) * (G / 8) + bx / 8 : bx;
    const int NGW = G * NWAVES, NGT = NGW * 64;
#define PH_IDS() const int tid = opaque_tid(wave0), lane = tid & 63, wave = wave0, gw = vcu * NWAVES + wave, gt = gw * 64 + lane; (void)gt; (void)gw; (void)lane
    gu32* ctl = (gu32*)WSP(unsigned char, WS_CTL);
    for (int u = threadIdx.x; u < (LDS_BYTES - LDSCTL_OFF) / 4; u += NWAVES * 64) ((LAS unsigned*)(ldsl + LDSCTL_OFF))[u] = 0u;
    __syncthreads();
    XcdBarrier bar = xcd_barrier_post((unsigned*)(ctl + CW_BAR), MISC + 8);
    if (threadIdx.x == 0) MISC[1] = __hip_atomic_fetch_add(ctl + CW_XRANK + 64 * (int)(xb_xcc_id() & 7u), 1u, __ATOMIC_RELAXED, __HIP_MEMORY_SCOPE_AGENT);
#define GRID_BAR() xcd_barrier(bar)

    for (int layer = 0; layer < 2; ++layer) {

#if PH_A
        {
            PH_IDS();
            LAS float* scr = (LAS float*)(ldsl + wave * 16384);
            const float* w_in = INL(4, (size_t)DM * INW); const float* w_up_a = INL(6, 512 * DM); const float* w_up_b = INL(7, 512 * DM); const float* w_up_c = INL(8, 1024 * DM);
            const float* w_o = INL(11, DM * DM); const float* wq = INL(13, DM * DM); const float* subk = INL(14, 2 * 128 * 128);
            const float* pu = INL(15, (size_t)NEXP * DM); const float* pv = INL(16, (size_t)NEXP * DM); const float* mix_g = INL(3, DM); const float* rel_bias = INP(1);
            bf16* WIN = WSP(bf16, WS_WIN); bf16* WCAT = WSP(bf16, WS_WCAT); bf16* WO = WSP(bf16, WS_WO); bf16* WQ = WSP(bf16, WS_WQ); unsigned char* U8 = WSP(unsigned char, WS_U); unsigned char* V8 = WSP(unsigned char, WS_V);
            bf16* SKBD = WSP(bf16, WS_SKBD); bf16* H = WSP(bf16, WS_H); bf16* DFT = WSP(bf16, WS_DFT); bf16* CS = WSP(bf16, WS_CS); float* TAB = WSP(float, WS_TAB);
            constexpr int I_IN = (DM / 64) * (INW / 32), I_A = (512 / 64) * (DM / 32), I_C = (1024 / 64) * (DM / 32), I_SQ = (DM / 64) * (DM / 32);
            constexpr int NITEMS = I_IN + 2 * I_A + I_C + 2 * I_SQ;
            for (int it = gw; it < NITEMS; it += NGW) {
                int r = it;
                if (r < I_IN) { if ((r % (INW / 32)) * 32 < PJW) transpose_item(w_in, INW, WIN, DM, 0, scr, r, lane); else transpose_item_fp8(w_in, INW, PJW, WSP(unsigned char, WS_WG8), DM, 1024.f, scr, r, lane); continue; } r -= I_IN;
                if (r < I_A) { transpose_item(w_up_a, DM, WCAT, DM, 0, scr, r, lane); continue; } r -= I_A;
                if (r < I_A) { transpose_item(w_up_b, DM, WCAT, DM, 512, scr, r, lane); continue; } r -= I_A;
                if (r < I_C) { transpose_item(w_up_c, DM, WCAT, DM, 1024, scr, r, lane); continue; } r -= I_C;
                if (r < I_SQ) { transpose_item(w_o, DM, WO, DM, 0, scr, r, lane); continue; } r -= I_SQ;
                transpose_item(wq, DM, WQ, DM, 0, scr, r, lane);
            }
            for (size_t i = (size_t)gt; i < (size_t)NEXP * DM / 16; i += (size_t)NGT) {
                const GAS f32x4* src = (const GAS f32x4*)pv + 4 * i; const float sc = 64.f;
                const f32x4 a = src[0], b = src[1], c = src[2], d = src[3]; v4u o; int w;
                w = __builtin_amdgcn_cvt_pk_fp8_f32(a.x * sc, a.y * sc, 0, false); w = __builtin_amdgcn_cvt_pk_fp8_f32(a.z * sc, a.w * sc, w, true); o.x = (unsigned)w;
                w = __builtin_amdgcn_cvt_pk_fp8_f32(b.x * sc, b.y * sc, 0, false); w = __builtin_amdgcn_cvt_pk_fp8_f32(b.z * sc, b.w * sc, w, true); o.y = (unsigned)w;
                w = __builtin_amdgcn_cvt_pk_fp8_f32(c.x * sc, c.y * sc, 0, false); w = __builtin_amdgcn_cvt_pk_fp8_f32(c.z * sc, c.w * sc, w, true); o.z = (unsigned)w;
                w = __builtin_amdgcn_cvt_pk_fp8_f32(d.x * sc, d.y * sc, 0, false); w = __builtin_amdgcn_cvt_pk_fp8_f32(d.z * sc, d.w * sc, w, true); o.w = (unsigned)w;
                ((GAS v4u*)V8)[i] = o;
            }
            { float* SU = WSP(float, WS_SU);
              for (int e = gw; e < NEXP; e += NGW) { const GAS f32x4* ur = (const GAS f32x4*)(pu + (size_t)e * DM) + lane; f32x4 y[8]; float mx = 0.f;
#pragma unroll
                for (int j = 0; j < 8; ++j) { y[j] = ur[64 * j]; mx = fmaxf(mx, fmaxf(fmaxf(fabsf(y[j].x), fabsf(y[j].y)), fmaxf(fabsf(y[j].z), fabsf(y[j].w)))); }
                mx = fmaxf(wave_maxf(mx), 1e-30f); const float inv = 127.f / mx;
#pragma unroll
                for (int j = 0; j < 8; ++j) ((GAS unsigned*)(U8 + (size_t)e * DM))[lane + 64 * j] = q8x4(y[j].x, y[j].y, y[j].z, y[j].w, inv);
                if (lane == 0) SU[e] = mx * (1.f / 127.f); } }
            for (int i = gt; i < 65536; i += NGT) { const int n = i >> 8, kk = i & 255, p = n >> 7; SKBD[i] = ((kk >> 7) == p) ? (bf16)f2bf(subk[(size_t)(p * 128 + (n & 127)) * 128 + (kk & 127)]) : (bf16)0; }
            for (int m = gw; m < MTOK; m += NGW) rms_row_to_bf16<true>((layer == 0 ? INP(0) : (const float*)X) + (size_t)m * DM, mix_g, H + (size_t)m * DM, WSP(unsigned char, WS_H8) + (size_t)m * DM, lane);
            if (layer == 0) {
                for (size_t i = (size_t)gt; i < (size_t)2304 * 8192 / 8; i += (size_t)NGT) {
                    const int sp = (int)(i >> 10), k0 = (int)(i & 1023) * 8, part = k0 >> 12, s0 = k0 & 4095; float v[8];
#pragma unroll
                    for (int j = 0; j < 8; ++j) { const float ang = (float)(((s0 + j) * sp) & 4095) * (1.f / 4096.f); v[j] = (part ? -__builtin_amdgcn_sinf(ang) : __builtin_amdgcn_cosf(ang)) * (1.f / 64.f); }
                    v4u o; o.x = pk2(v[0], v[1]); o.y = pk2(v[2], v[3]); o.z = pk2(v[4], v[5]); o.w = pk2(v[6], v[7]); ((GAS v4u*)DFT)[i] = o;
                }
                for (int i = gt; i < 65536; i += NGT) { const int r = i >> 8, c = i & 255, part = r >> 7, cp = r & 127; float v = 0.f;
                    if (c < 128) { const float ang = (float)((c * cp) & 127) * (1.f / 128.f); v = (part ? __builtin_amdgcn_sinf(ang) : __builtin_amdgcn_cosf(ang)) * 0.08838834764831845f; }
                    CS[i] = (bf16)f2bf(v); }
                for (int i = gt; i < 16 * 8192; i += NGT) { const int hd = i >> 13, off = (i & 8191) - 4096; float v;
                    if (hd < 12) { const int g = hd >> 2, dil = g == 0 ? 1 : (g == 1 ? 4 : 16); v = (off >= -64 && off <= 64) ? rel_bias[rel_bucket(off * dil) * 16 + hd] * 11.313708498984761f : -1.0e5f; }
                    else v = rel_bias[rel_bucket(off) * 16 + hd] * 11.313708498984761f;
                    TAB[i] = v; }
            }
        }
#endif
        GRID_BAR();

#if PH_B
        {
            { pg8::Gemm g{WSP(bf16, WS_H), WSP(bf16, WS_WIN)}; pg8::StaticOrder S; S.init(MTOK, PJW, G, bx, DM, DM);
              pg8::EpiStore E{WSP(bf16, WS_PROJ), PJW};
              pg8::gemm_phase<pg8::EpiStore, pg8::StaticOrder, true, DM, DM, DM>(ldsl, g, S, E, wave0); }
            { pg8::Gemm g{WSP(bf16, WS_H8), WSP(bf16, WS_WG8)}; pg8::StaticOrder S; S.init(MTOK, GTW, G, bx, DM / 2, DM / 2);
              pg8::EpiProj E{WSP(bf16, WS_PROJ), WSP(bf16, WS_G), INL(5, GTW), 32, 1.f / 32768.f};
              pg8::gemm_phase<pg8::EpiProj, pg8::StaticOrder, true, DM / 2, DM / 2, DM / 2, true>(ldsl, g, S, E, wave0); }
        }
#endif
        GRID_BAR();

#if PH_C
        {
            pg8::Gemm g{WSP(bf16, WS_CS), WSP(bf16, WS_PROJ)}; pg8::F1Order S{G, bx};
            pg8::EpiZT E{WSP(bf16, WS_ZT)};
            pg8::gemm_phase<pg8::EpiZT, pg8::F1Order, false, 256, PJW, 256>(ldsl, g, S, E, wave0);
        }
#endif
        GRID_BAR();

#if PH_D
#if PH_D1
        {
            pg8::Gemm g{WSP(bf16, WS_DFT), WSP(bf16, WS_ZT)}; pg8::StaticOrder S; S.init(2304, 2048, G, bx, 8192, 8192);
            pg8::EpiF2 E{WSP(bf16, WS_OC)};
            pg8::gemm_phase<pg8::EpiF2, pg8::StaticOrder, false, 8192, 8192, 8192>(ldsl, g, S, E, wave0);
        }
#endif
#if PH_D2
        {
            PH_IDS();
            gu32* qhead = ctl + CW_QUEUE + 64 * layer;
            bf16* PROJ = WSP(bf16, WS_PROJ); bf16* DO = WSP(bf16, WS_MG); bf16* DL = WSP(bf16, WS_H); float* LSE = WSP(float, WS_LSE); const float* TAB = WSP(float, WS_TAB);
            const float* cur_tab = nullptr;
            for (;;) {
                __syncthreads();
                if (tid == 0) MISC[0] = __hip_atomic_fetch_add(qhead, 1u, __ATOMIC_RELAXED, __HIP_MEMORY_SCOPE_AGENT);
                __syncthreads();
                const int ui = __builtin_amdgcn_readfirstlane((int)MISC[0]);
                if (ui >= 1792) break;
                attn::Unit u; int hd;
                if (ui < 1024) {
                    const int qb = ui & 15, vh = (ui >> 4) & 1, m = (ui >> 5) & 1, h = (ui >> 6) & 3, b = ui >> 8;
                    const bf16* base = PROJ + (size_t)b * SEQ * PJW;
                    u.Q = base + (size_t)(qb * 256) * PJW + COL_DIFF + (h * 2 + m) * 128; u.K = base + COL_DIFF + 1024 + (h * 2 + m) * 128; u.V = base + COL_DIFF + 2048 + h * 256 + vh * 128;
                    u.O = DO + (size_t)(b * SEQ + qb * 256) * DM + (h * 2 + m) * 256 + vh * 128; u.lse = nullptr; u.ldq = PJW; u.ldk = PJW; u.ldo = DM; u.lse_ld = 0;
                    u.kt0 = 0; u.nt = SEQ / 64; u.qoff = qb * 256; hd = 12 + h;
                } else {
                    const int v = ui - 1024, qb16 = v & 15, hh = (v >> 4) & 3, bg = v >> 6, g = bg % 3, b = bg / 3;
                    const int dil = g == 0 ? 1 : (g == 1 ? 4 : 16), bpc = 16 / dil, r = qb16 / bpc, qblk = qb16 % bpc, q0 = qblk * 256, ntot = (SEQ / dil) / 64;
                    int kt0 = q0 / 64 - 1; if (kt0 < 0) kt0 = 0; int kt1 = q0 / 64 + 5; if (kt1 > ntot) kt1 = ntot;
                    if ((kt1 - kt0) & 1) { if (kt0 > 0) --kt0; else ++kt1; }
                    const bf16* base = PROJ + (size_t)(b * SEQ + r) * PJW + COL_DIL + g * 512 + hh * 128;
                    u.Q = base + (size_t)q0 * dil * PJW; u.K = base + 1536; u.V = base + 3072;
                    u.O = DL + ((size_t)g * MTOK + b * SEQ + r + (size_t)q0 * dil) * 512 + hh * 128; u.lse = LSE + ((size_t)g * MTOK + b * SEQ + r + (size_t)q0 * dil) * 4 + hh;
                    u.ldq = (long)PJW * dil; u.ldk = (long)PJW * dil; u.ldo = 512L * dil; u.lse_ld = 4 * dil; u.kt0 = kt0; u.nt = kt1 - kt0; u.qoff = q0; hd = g * 4 + hh;
                }
                const float* tab = TAB + (size_t)hd * 8192;
                if (tab != cur_tab) {
                    cur_tab = tab;
                    LAS f32x4* tl = (LAS f32x4*)(ldsl + attn::LDS_TAB); const int t2 = opaque_tid(wave0);
#pragma unroll
                    for (int j = 0; j < 4; ++j) tl[t2 + 512 * j] = ((const GAS f32x4*)tab)[t2 + 512 * j];
                }
                attn::attn_unit(u, (char*)lds, wave0);
            }
        }
#endif
#endif
        GRID_BAR();

#if PH_E
        {
            PH_IDS();
            const float* dlam = INL(9, 512); const float* subln = INL(10, 256); const float lambda_init = layer == 0 ? 0.2f : 0.35550906759f;
            const float* LSE = WSP(float, WS_LSE); const bf16* DL = WSP(bf16, WS_H); const bf16* DO = WSP(bf16, WS_MG); bf16* OC = WSP(bf16, WS_OC);
            float s1 = dlam[lane] * dlam[128 + lane] + dlam[64 + lane] * dlam[192 + lane], s2 = dlam[256 + lane] * dlam[384 + lane] + dlam[320 + lane] * dlam[448 + lane];
            s1 = wave_sum(s1); s2 = wave_sum(s2);
            const float lam = __expf(s1) - __expf(s2) + lambda_init, osc = 1.0f - lambda_init;
            const int hq = lane >> 4, l16 = lane & 15;
            for (int t = gw; t < MTOK; t += NGW) {
                float ls[3], mx = -3e38f;
#pragma unroll
                for (int g = 0; g < 3; ++g) { ls[g] = LSE[((size_t)g * MTOK + t) * 4 + hq]; mx = fmaxf(mx, ls[g]); }
                float wsum = 0.f;
#pragma unroll
                for (int g = 0; g < 3; ++g) { ls[g] = __expf(ls[g] - mx); wsum += ls[g]; }
                const float winv = 1.0f / wsum; float acc8[8] = {0.f, 0.f, 0.f, 0.f, 0.f, 0.f, 0.f, 0.f};
#pragma unroll
                for (int g = 0; g < 3; ++g) { const v4u o = *(const GAS v4u*)(DL + ((size_t)g * MTOK + t) * 512 + lane * 8); const float w = ls[g] * winv;
                    acc8[0] += w * bflo(o.x); acc8[1] += w * bfhi(o.x); acc8[2] += w * bflo(o.y); acc8[3] += w * bfhi(o.y); acc8[4] += w * bflo(o.z); acc8[5] += w * bfhi(o.z); acc8[6] += w * bflo(o.w); acc8[7] += w * bfhi(o.w); }
#if defined(DBG_ZERO_OB)
                for (int j = 0; j < 8; ++j) acc8[j] = 0.f;
#endif
                { v4u o; o.x = pk2(acc8[0], acc8[1]); o.y = pk2(acc8[2], acc8[3]); o.z = pk2(acc8[4], acc8[5]); o.w = pk2(acc8[6], acc8[7]); *(GAS v4u*)(OC + (size_t)t * DM + 512 + lane * 8) = o; }
                const bf16* dp = DO + (size_t)t * DM + hq * 512 + l16 * 16;
                const v4u a0 = *(const GAS v4u*)(dp), a1 = *(const GAS v4u*)(dp + 8), b0 = *(const GAS v4u*)(dp + 256), b1 = *(const GAS v4u*)(dp + 264);
                float d[16];
                d[0] = bflo(a0.x) - lam * bflo(b0.x); d[1] = bfhi(a0.x) - lam * bfhi(b0.x); d[2] = bflo(a0.y) - lam * bflo(b0.y); d[3] = bfhi(a0.y) - lam * bfhi(b0.y);
                d[4] = bflo(a0.z) - lam * bflo(b0.z); d[5] = bfhi(a0.z) - lam * bfhi(b0.z); d[6] = bflo(a0.w) - lam * bflo(b0.w); d[7] = bfhi(a0.w) - lam * bfhi(b0.w);
                d[8] = bflo(a1.x) - lam * bflo(b1.x); d[9] = bfhi(a1.x) - lam * bfhi(b1.x); d[10] = bflo(a1.y) - lam * bflo(b1.y); d[11] = bfhi(a1.y) - lam * bfhi(b1.y);
                d[12] = bflo(a1.z) - lam * bflo(b1.z); d[13] = bfhi(a1.z) - lam * bfhi(b1.z); d[14] = bflo(a1.w) - lam * bflo(b1.w); d[15] = bfhi(a1.w) - lam * bfhi(b1.w);
                float ss = 0.f;
#pragma unroll
                for (int j = 0; j < 16; ++j) ss += d[j] * d[j];
                ss += sx_f<1>(ss); ss += sx_f<2>(ss); ss += sx_f<4>(ss); ss += sx_f<8>(ss);
                const float rs = osc / sqrtf(ss * (1.f / 256.f) + RMS_EPS);
                const f32x4 g0 = *(const GAS f32x4*)(subln + l16 * 16), g1 = *(const GAS f32x4*)(subln + l16 * 16 + 4), g2 = *(const GAS f32x4*)(subln + l16 * 16 + 8), g3 = *(const GAS f32x4*)(subln + l16 * 16 + 12);
                v4u o0, o1;
                o0.x = pk2(d[0] * rs * g0.x, d[1] * rs * g0.y); o0.y = pk2(d[2] * rs * g0.z, d[3] * rs * g0.w); o0.z = pk2(d[4] * rs * g1.x, d[5] * rs * g1.y); o0.w = pk2(d[6] * rs * g1.z, d[7] * rs * g1.w);
                o1.x = pk2(d[8] * rs * g2.x, d[9] * rs * g2.y); o1.y = pk2(d[10] * rs * g2.z, d[11] * rs * g2.w); o1.z = pk2(d[12] * rs * g3.x, d[13] * rs * g3.y); o1.w = pk2(d[14] * rs * g3.z, d[15] * rs * g3.w);
                bf16* op = OC + (size_t)t * DM + 1024 + hq * 256 + l16 * 16;
                *(GAS v4u*)(op) = o0; *(GAS v4u*)(op + 8) = o1;
            }
        }
#endif
        GRID_BAR();

#if PH_F
        {
            pg8::MergeOrder S; S.init(MTOK, DM, G, bx, DM, DM);
            pg8::Gemm g{WSP(bf16, WS_OC), WSP(bf16, WS_WCAT)}; pg8::EpiMerge4 E{WSP(bf16, WS_G), WSP(bf16, WS_MG)};
            pg8::gemm_phase<pg8::EpiMerge4, pg8::MergeOrder, true, DM, DM, 512>(ldsl, g, S, E, wave0);
        }
#endif
        GRID_BAR();

#if PH_G
        {
            pg8::Gemm g{WSP(bf16, WS_MG), WSP(bf16, WS_WO)}; pg8::StaticOrder S; S.init(MTOK, DM, G, bx, DM, DM);
            pg8::EpiResF32 E{layer == 0 ? INP(0) : (const float*)X, X, DM};
            pg8::gemm_phase<pg8::EpiResF32, pg8::StaticOrder, true, DM, DM, DM>(ldsl, g, S, E, wave0);
        }
#endif
        GRID_BAR();

#if PH_H
        { PH_IDS(); const float* ffn_g = INL(12, DM); bf16* H = WSP(bf16, WS_H); unsigned char* H8 = WSP(unsigned char, WS_H8); float* SH = WSP(float, WS_SH);
          for (int m = gw; m < MTOK; m += NGW) {
            const GAS f32x4* xr = (const GAS f32x4*)(X + (size_t)m * DM) + lane; const GAS f32x4* gr = (const GAS f32x4*)ffn_g + lane;
            f32x4 v[8]; float ss = 0.f;
#pragma unroll
            for (int j = 0; j < 8; ++j) { v[j] = xr[64 * j]; ss += (v[j].x * v[j].x + v[j].y * v[j].y) + (v[j].z * v[j].z + v[j].w * v[j].w); }
            const float rstd = 1.0f / sqrtf(wave_sum(ss) * (1.f / DM) + RMS_EPS); float mx = 0.f;
#pragma unroll
            for (int j = 0; j < 8; ++j) { const f32x4 gg = gr[64 * j]; v[j] = v[j] * rstd * gg; mx = fmaxf(mx, fmaxf(fmaxf(fabsf(v[j].x), fabsf(v[j].y)), fmaxf(fabsf(v[j].z), fabsf(v[j].w)))); }
            mx = fmaxf(wave_maxf(mx), 1e-30f); const float inv = 127.f / mx;
            GAS unsigned long long* o8 = (GAS unsigned long long*)(H + (size_t)m * DM) + lane;
#pragma unroll
            for (int j = 0; j < 8; ++j) { o8[64 * j] = (unsigned long long)pk2(v[j].x, v[j].y) | ((unsigned long long)pk2(v[j].z, v[j].w) << 32);
                ((GAS unsigned*)(H8 + (size_t)m * DM))[lane + 64 * j] = q8x4(v[j].x, v[j].y, v[j].z, v[j].w, inv); }
            if (lane == 0) SH[m] = mx * (1.f / 127.f);
          } }
#endif
        GRID_BAR();

#if PH_I
        {
            pg8::Gemm g{WSP(bf16, WS_H), WSP(bf16, WS_WQ)}; pg8::StaticOrder S; S.init(MTOK, DM, G, bx, DM, DM);
            pg8::EpiStore E{WSP(bf16, WS_Q), DM};
            pg8::gemm_phase<pg8::EpiStore, pg8::StaticOrder, true, DM, DM, DM>(ldsl, g, S, E, wave0);
        }
#endif
        GRID_BAR();

#if PH_J
        {
            pg8::Gemm g{WSP(bf16, WS_Q), WSP(bf16, WS_SKBD)}; pg8::StaticOrder S; S.init(MTOK * 8, 256, G, bx, 256, 256);
            pg8::EpiResF32 E{nullptr, WSP(float, WS_SC), 256};
            pg8::gemm_phase<pg8::EpiResF32, pg8::StaticOrder, true, 256, 256, 256>(ldsl, g, S, E, wave0);
        }
#endif
        GRID_BAR();

#if PH_K
        {
            PH_IDS();
            const float* SC = WSP(float, WS_SC); int* IDS = WSP(int, WS_IDS); float* GATES = WSP(float, WS_GATES);
            const int l16 = lane & 15, rbase = lane & 48;
            int cq[4];
#pragma unroll
            for (int q = 0; q < 4; ++q) { int c = l16 + 16 * q, ci = -1, cj = 0; for (int i = 0; i < 16; ++i) { const int cnt = 16 / (i + 1); if (ci < 0) { if (c < cnt) { ci = i; cj = c; } else c -= cnt; } } cq[q] = ci < 0 ? -1 : ci * 16 + cj; }
            for (int row4 = gw * 4; row4 < MTOK * 8; row4 += NGW * 4) {
                const int row = row4 + (lane >> 4);
                const float* sc = SC + (size_t)row * 256 + l16;
                unsigned ka[8], kb[8];
#pragma unroll
                for (int jj = 0; jj < 8; ++jj) { ka[jj] = (okey(sc[jj * 16]) & ~127u) | (unsigned)(127 - (jj * 16 + l16)); kb[jj] = (okey(sc[128 + jj * 16]) & ~127u) | (unsigned)(127 - (jj * 16 + l16)); }
#define SORT8(k) do { CE_DESC(k[0], k[1]); CE_DESC(k[2], k[3]); CE_DESC(k[4], k[5]); CE_DESC(k[6], k[7]); CE_DESC(k[0], k[2]); CE_DESC(k[1], k[3]); CE_DESC(k[4], k[6]); CE_DESC(k[5], k[7]); \
    CE_DESC(k[1], k[2]); CE_DESC(k[5], k[6]); CE_DESC(k[0], k[4]); CE_DESC(k[3], k[7]); CE_DESC(k[1], k[5]); CE_DESC(k[2], k[6]); CE_DESC(k[1], k[4]); CE_DESC(k[3], k[6]); \
    CE_DESC(k[2], k[4]); CE_DESC(k[3], k[5]); CE_DESC(k[3], k[4]); } while (0)
                SORT8(ka); SORT8(kb);
                unsigned ta = 0u, tb = 0u;
#pragma unroll
                for (int r = 0; r < 16; ++r) {
                    const unsigned ma = row_max16_u(ka[0]), mb = row_max16_u(kb[0]);
                    const bool wa = ka[0] == ma, wb = kb[0] == mb;
                    ta = (l16 == r) ? ma : ta; tb = (l16 == r) ? mb : tb;
#pragma unroll
                    for (int q = 0; q < 7; ++q) { ka[q] = wa ? ka[q + 1] : ka[q]; kb[q] = wb ? kb[q + 1] : kb[q]; }
                    ka[7] = wa ? 0u : ka[7]; kb[7] = wb ? 0u : kb[7];
                }
                const int ia = 127 - (int)(ta & 127u), ib = 127 - (int)(tb & 127u);
                const float va = okey_inv(ta & ~127u), vb = okey_inv(tb & ~127u);
                unsigned ck[4];
#pragma unroll
                for (int q = 0; q < 4; ++q) { const int cc = cq[q] < 0 ? 0 : cq[q]; const float cs = bperm_f(va, rbase + (cc >> 4)) + bperm_f(vb, rbase + (cc & 15));
                    ck[q] = cq[q] < 0 ? 0u : ((okey(cs) & ~255u) | (unsigned)(255 - cc)); }
                CE_DESC(ck[0], ck[1]); CE_DESC(ck[2], ck[3]); CE_DESC(ck[0], ck[2]); CE_DESC(ck[1], ck[3]); CE_DESC(ck[1], ck[2]);
                unsigned tw = 0u;
#pragma unroll
                for (int r = 0; r < 16; ++r) { const unsigned mm = row_max16_u(ck[0]); const bool w = ck[0] == mm; tw = (l16 == r) ? mm : tw;
                    ck[0] = w ? ck[1] : ck[0]; ck[1] = w ? ck[2] : ck[1]; ck[2] = w ? ck[3] : ck[2]; ck[3] = w ? 0u : ck[3]; }
                const int code = 255 - (int)(tw & 255u), wi = (code >> 4) & 15, wj = code & 15;
                const float bs = bperm_f(va, rbase + wi) + bperm_f(vb, rbase + wj);
                const int eid = bperm_i(ia, rbase + wi) * 128 + bperm_i(ib, rbase + wj);
                const float mx = row_max16_f(bs), e = __expf(bs - mx), es = row_sum16(e);
                IDS[(size_t)row * 16 + l16] = eid; GATES[(size_t)row * 16 + l16] = e / es;
            }
#undef SORT8
        }
#endif
        GRID_BAR();

#if PH_L
#define L_LDIDS(I, tt, hh) do { const GAS v4u* ip_ = (const GAS v4u*)(IDS + (size_t)(tt) * 128 + (hh) * 64 + lrow * 16); I##0 = ip_[0]; I##1 = ip_[1]; I##2 = ip_[2]; I##3 = ip_[3]; } while (0)
#define L_ISSUE(W, I, base) do { \
    W[0] = *(const GAS v4u*)((base) + (size_t)(I##0).x * DM); W[1] = *(const GAS v4u*)((base) + (size_t)(I##0).y * DM); W[2] = *(const GAS v4u*)((base) + (size_t)(I##0).z * DM); W[3] = *(const GAS v4u*)((base) + (size_t)(I##0).w * DM); \
    W[4] = *(const GAS v4u*)((base) + (size_t)(I##1).x * DM); W[5] = *(const GAS v4u*)((base) + (size_t)(I##1).y * DM); W[6] = *(const GAS v4u*)((base) + (size_t)(I##1).z * DM); W[7] = *(const GAS v4u*)((base) + (size_t)(I##1).w * DM); \
    W[8] = *(const GAS v4u*)((base) + (size_t)(I##2).x * DM); W[9] = *(const GAS v4u*)((base) + (size_t)(I##2).y * DM); W[10] = *(const GAS v4u*)((base) + (size_t)(I##2).z * DM); W[11] = *(const GAS v4u*)((base) + (size_t)(I##2).w * DM); \
    W[12] = *(const GAS v4u*)((base) + (size_t)(I##3).x * DM); W[13] = *(const GAS v4u*)((base) + (size_t)(I##3).y * DM); W[14] = *(const GAS v4u*)((base) + (size_t)(I##3).z * DM); W[15] = *(const GAS v4u*)((base) + (size_t)(I##3).w * DM); } while (0)
#define L_CVT(d, hi) __builtin_amdgcn_cvt_pk_f32_fp8((int)(d), (hi))
        {
            PH_IDS();
            const unsigned char* H8 = WSP(unsigned char, WS_H8); const unsigned char* U8 = WSP(unsigned char, WS_U); const int* IDS = WSP(int, WS_IDS); float* PART = WSP(float, WS_G);
            typedef float f32x2 __attribute__((ext_vector_type(2)));
            const int myx = (int)(xb_xcc_id() & 7u); int nx = 0, xi = 0, nloc = 1;
            for (int j = 0; j < 8; ++j) { const int c = (int)__hip_atomic_load(ctl + CW_XRANK + 64 * j, __ATOMIC_RELAXED, __HIP_MEMORY_SCOPE_AGENT); if (c > 0) { ++nx; if (j < myx) ++xi; } if (j == myx) nloc = c; }
            const int rw = (int)MISC[1] * NWAVES + wave, nW = nloc * NWAVES; const int l16 = lane & 15, lrow = lane >> 4;
#define L1_COMPUTE(W, dst) do { float sk[16]; _Pragma("unroll") for (int k = 0; k < 16; ++k) { const v4u ww = W[k]; int ac = 0; \
        ac = __builtin_amdgcn_sdot4((int)ww.x, (int)h0.x, ac, false); ac = __builtin_amdgcn_sdot4((int)ww.y, (int)h0.y, ac, false); ac = __builtin_amdgcn_sdot4((int)ww.z, (int)h0.z, ac, false); ac = __builtin_amdgcn_sdot4((int)ww.w, (int)h0.w, ac, false); \
        sk[k] = (float)ac; } \
          \
        float t8[8]; _Pragma("unroll") for (int j = 0; j < 8; ++j) { const float keep = b8 ? sk[8 + j] : sk[j], send = b8 ? sk[j] : sk[8 + j]; \
            t8[j] = keep + __int_as_float(__builtin_amdgcn_update_dpp(0, __float_as_int(send), 0x128, 0xF, 0xF, false)); } \
        float t4[4]; _Pragma("unroll") for (int j = 0; j < 4; ++j) { const float keep = b4 ? t8[4 + j] : t8[j], send = b4 ? t8[j] : t8[4 + j]; t4[j] = keep + sx_f<4>(send); } \
        float t2[2]; _Pragma("unroll") for (int j = 0; j < 2; ++j) { const float keep = b2 ? t4[2 + j] : t4[j], send = b2 ? t4[j] : t4[2 + j]; \
            t2[j] = keep + __int_as_float(__builtin_amdgcn_update_dpp(0, __float_as_int(send), 0x4E, 0xF, 0xF, false)); } \
        { const float keep = b1 ? t2[1] : t2[0], send = b1 ? t2[0] : t2[1]; dst = keep + __int_as_float(__builtin_amdgcn_update_dpp(0, __float_as_int(send), 0xB1, 0xF, 0xF, false)); } } while (0)
            const bool b8 = (lane & 8) != 0, b4 = (lane & 4) != 0, b2 = (lane & 2) != 0, b1 = (lane & 1) != 0;
            for (int sl = xi; sl < 8; sl += nx) {
                const unsigned char* ub = U8 + sl * 256 + l16 * 16; const unsigned char* hb = H8 + sl * 256 + l16 * 16;
                int t = rw;
                if (t < MTOK) {
                    v4u Wa[16], Wb[16]; v4u ia0, ia1, ia2, ia3, ib0, ib1, ib2, ib3; v4u h0;
                    L_LDIDS(ia, t, 0); L_LDIDS(ib, t, 1); h0 = *(const GAS v4u*)(hb + (size_t)t * DM);
                    L_ISSUE(Wa, ia, ub);
                    for (;;) {
                        const int tn = t + nW; const bool more = tn < MTOK; const int tp = more ? tn : t;
                        L_ISSUE(Wb, ib, ub);
                        L_LDIDS(ia, tp, 0); const v4u hn0 = *(const GAS v4u*)(hb + (size_t)tp * DM);
                        float pre0, pre1;
                        L1_COMPUTE(Wa, pre0);
                        L_ISSUE(Wa, ia, ub);
                        L_LDIDS(ib, tp, 1);
                        L1_COMPUTE(Wb, pre1);
                        float* pp = PART + ((size_t)sl * MTOK + t) * 128; pp[lane] = pre0; pp[64 + lane] = pre1;
                        h0 = hn0;
                        if (!more) break;
                        t = tn;
                    }
                }
            }
#undef L1_COMPUTE
        }
        GRID_BAR();
        {
            PH_IDS();
            const float* PART = WSP(float, WS_G); const float* GATES = WSP(float, WS_GATES); float* ACTW = WSP(float, WS_ACT);
            for (int t = gw; t < MTOK; t += NGW) {
                float q0 = 0.f, q1 = 0.f;
#pragma unroll
                for (int s8 = 0; s8 < 8; ++s8) { const float* pp = PART + ((size_t)s8 * MTOK + t) * 128; q0 += pp[lane]; q1 += pp[64 + lane]; }
                { const int* ip = WSP(int, WS_IDS) + (size_t)t * 128; const float sh = WSP(float, WS_SH)[t]; const float* SU = WSP(float, WS_SU); q0 *= SU[ip[lane]] * sh; q1 *= SU[ip[64 + lane]] * sh; }
                const float* gp = GATES + (size_t)t * 128; float* ap = ACTW + (size_t)t * 128;
                const float g0 = gp[lane], g1 = gp[64 + lane];
                ap[lane] = 0.5f * q0 * (1.0f + erff(q0 * 0.70710678118654752f)) * g0 * (1.f / 64.f); ap[64 + lane] = 0.5f * q1 * (1.0f + erff(q1 * 0.70710678118654752f)) * g1 * (1.f / 64.f);
            }
        }
        GRID_BAR();
        {
            PH_IDS();
            const unsigned char* V8 = WSP(unsigned char, WS_V); const int* IDS = WSP(int, WS_IDS); const float* ACT = WSP(float, WS_ACT);
            typedef float f32x2 __attribute__((ext_vector_type(2)));
            const int myx = (int)(xb_xcc_id() & 7u); int nx = 0, xi = 0, nloc = 1;
            for (int j = 0; j < 8; ++j) { const int c = (int)__hip_atomic_load(ctl + CW_XRANK + 64 * j, __ATOMIC_RELAXED, __HIP_MEMORY_SCOPE_AGENT); if (c > 0) { ++nx; if (j < myx) ++xi; } if (j == myx) nloc = c; }
            const int rw = (int)MISC[1] * NWAVES + wave, nW = nloc * NWAVES; const int l16 = lane & 15, lrow = lane >> 4;
#if DBG_MODE == 2
            float* XO = WSP(float, WS_OC);
#else
            float* XO = X;
#endif
#define L2_COMPUTE(W, acr) do { float av[16]; _Pragma("unroll") for (int k = 0; k < 16; ++k) av[k] = bperm_f(acr, (lane & 48) + k); \
        _Pragma("unroll") for (int k = 0; k < 16; ++k) { const float a = av[k]; const f32x2 aa = (f32x2){a, a}; \
        const v4u ww = W[k]; const unsigned d0 = ww.x, d1 = ww.y, d2 = ww.z, d3 = ww.w; \
        oacc[0] += aa * L_CVT(d0, false); oacc[1] += aa * L_CVT(d0, true); oacc[2] += aa * L_CVT(d1, false); oacc[3] += aa * L_CVT(d1, true); \
        oacc[4] += aa * L_CVT(d2, false); oacc[5] += aa * L_CVT(d2, true); oacc[6] += aa * L_CVT(d3, false); oacc[7] += aa * L_CVT(d3, true); } } while (0)
            for (int sl = xi; sl < 8; sl += nx) {
                const unsigned char* vb = V8 + sl * 256 + l16 * 16; float* xb = XO + sl * 256 + l16 * 16;
                int t = rw;
                if (t < MTOK) {
                    v4u Wa[16], Wb[16]; v4u ia0, ia1, ia2, ia3, ib0, ib1, ib2, ib3; float ac0, ac1;
                    L_LDIDS(ia, t, 0); L_LDIDS(ib, t, 1); ac0 = ACT[(size_t)t * 128 + lane]; ac1 = ACT[(size_t)t * 128 + 64 + lane];
                    L_ISSUE(Wa, ia, vb);
                    for (;;) {
                        const int tn = t + nW; const bool more = tn < MTOK; const int tp = more ? tn : t;
                        L_ISSUE(Wb, ib, vb);
                        L_LDIDS(ia, tp, 0); const float an0 = ACT[(size_t)tp * 128 + lane], an1 = ACT[(size_t)tp * 128 + 64 + lane];
                        f32x2 oacc[8];
#pragma unroll
                        for (int k = 0; k < 8; ++k) oacc[k] = (f32x2){0.f, 0.f};
                        L2_COMPUTE(Wa, ac0);
                        L_ISSUE(Wa, ia, vb);
                        L_LDIDS(ib, tp, 1);
                        f32x4 xv[4]; { const GAS f32x4* q = (const GAS f32x4*)(xb + (size_t)t * DM); xv[0] = q[0]; xv[1] = q[1]; xv[2] = q[2]; xv[3] = q[3]; }
                        L2_COMPUTE(Wb, ac1);
#pragma unroll
                        for (int k = 0; k < 8; ++k) { float a = oacc[k].x, b = oacc[k].y; a += sx_f<16>(a); b += sx_f<16>(b); a = add32(a); b = add32(b); oacc[k] = (f32x2){a, b}; }
                        if (lane < 16) { GAS f32x4* q = (GAS f32x4*)(xb + (size_t)t * DM);
#pragma unroll
                            for (int k = 0; k < 4; ++k) { f32x4 v = xv[k];
#if DBG_MODE == 2
                                v = (f32x4){0.f, 0.f, 0.f, 0.f};
#endif
                                v.x += oacc[2 * k].x; v.y += oacc[2 * k].y; v.z += oacc[2 * k + 1].x; v.w += oacc[2 * k + 1].y; q[k] = v; } }
                        ac0 = an0; ac1 = an1;
                        if (!more) break;
                        t = tn;
                    }
                }
            }
#undef L2_COMPUTE
        }
#undef L_LDIDS
#undef L_ISSUE
#undef L_CVT
#endif
        GRID_BAR();
    }

    { PH_IDS();
    for (int m = gw; m < MTOK; m += NGW) {
        GAS f32x4* xr = (GAS f32x4*)(X + (size_t)m * DM) + lane; const GAS f32x4* gr = (const GAS f32x4*)INP(2) + lane;
        f32x4 v[8]; float s = 0.f;
#pragma unroll
        for (int j = 0; j < 8; ++j) { v[j] = xr[64 * j]; s += (v[j].x * v[j].x + v[j].y * v[j].y) + (v[j].z * v[j].z + v[j].w * v[j].w); }
        const float rstd = 1.0f / sqrtf(wave_sum(s) * (1.f / DM) + RMS_EPS);
#pragma unroll
        for (int j = 0; j < 8; ++j) { const f32x4 gg = gr[64 * j]; xr[64 * j] = v[j] * rstd * gg; }
    } }
}

extern "C" void kernel_launch(void* const* d_in, const int* in_sizes, int n_in, void* d_out, int out_size, void* d_ws, size_t ws_size, hipStream_t stream) {
    static int grid = 0;
    if (grid == 0) {
        if (n_in != 17 || in_sizes[0] != MTOK * DM || out_size != MTOK * DM || ws_size < WS_END) {
            fprintf(stderr, "kernel_launch: shape/workspace mismatch: n_in %d in0 %d out %d ws %zu (need %zu); nothing launched\n", n_in, n_in > 0 ? in_sizes[0] : -1, out_size, ws_size, (size_t)WS_END); grid = -1; return; }
        int dev = 0, cus = 0, per_cu = 0;
        if (hipGetDevice(&dev) != hipSuccess || hipDeviceGetAttribute(&cus, hipDeviceAttributeMultiprocessorCount, dev) != hipSuccess) { grid = -1; return; }
        if (hipFuncSetAttribute((const void*)mk_fwd, hipFuncAttributeMaxDynamicSharedMemorySize, LDS_BYTES) != hipSuccess) { fprintf(stderr, "kernel_launch: hipFuncSetAttribute failed\n"); grid = -1; return; }
        if (hipOccupancyMaxActiveBlocksPerMultiprocessor(&per_cu, (const void*)mk_fwd, NWAVES * 64, LDS_BYTES) != hipSuccess || per_cu < 1)
            fprintf(stderr, "kernel_launch: note: occupancy query reports %d workgroups per CU\n", per_cu);
        (void)hipGetLastError();
        grid = cus;
    }
    if (grid < 0) return;
    if (hipMemsetAsync((char*)d_ws + WS_CTL, 0, CTL_ZERO_BYTES, stream) != hipSuccess) { fprintf(stderr, "kernel_launch: memset failed\n"); return; }
    Args a{};
    for (int i = 0; i < 17; ++i) a.in[i] = (const float*)d_in[i];
    a.out = (float*)d_out; a.ws = (unsigned char*)d_ws;
    hipLaunchKernelGGL(mk_fwd, dim3(grid), dim3(NWAVES * 64), LDS_BYTES, stream, a);
    const hipError_t le = hipPeekAtLastError();
    if (le != hipSuccess) fprintf(stderr, "kernel_launch: launch failed: %s\n", hipGetErrorName(le));
}
```

```cpp
#include <hip/hip_runtime.h>
#include <cstdio>
#include <cstdint>

#ifndef DBG_MODE
#define DBG_MODE 0
#endif
constexpr int DM = 2048, NB = 4, SEQ = 4096, MTOK = NB * SEQ;
constexpr int INW = 14336, PJW = 8192, GTW = 6144;
constexpr int COL_DIL = 512, COL_DIFF = 5120;
constexpr int NEXP = 16384;
constexpr float RMS_EPS = 1e-6f;

typedef unsigned short bf16;
#define GAS __attribute__((address_space(1)))
#define LAS __attribute__((address_space(3)))
typedef unsigned v4u __attribute__((ext_vector_type(4)));
typedef float f32x4 __attribute__((ext_vector_type(4)));
typedef GAS unsigned gu32;

__device__ __forceinline__ int opaque_tid(int wave_sgpr) { int l; asm volatile("v_mbcnt_lo_u32_b32 %0, -1, 0\n\tv_mbcnt_hi_u32_b32 %0, -1, %0" : "=v"(l)); return wave_sgpr * 64 + l; }
namespace pg8 {
#define PG8_LAS __attribute__((address_space(3)))
typedef unsigned short bf16_t;
typedef short bf16x8 __attribute__((ext_vector_type(8)));
typedef float f32x4 __attribute__((ext_vector_type(4)));
typedef unsigned u32x4 __attribute__((ext_vector_type(4)));
typedef int i32x4 __attribute__((ext_vector_type(4)));
typedef int i32x8 __attribute__((ext_vector_type(8)));
constexpr int BM = 256, BK = 64, HALF = 128, HTB = HALF * BK * 2, STAGE_BYTES = 8 * HTB, NXCD = 8, WGM = 8;

__host__ __device__ __forceinline__ int lds_byte(int r, int c) { const int st = (r >> 4) * 2 + (c >> 5), rr = r & 15, cc = c & 31, ob = rr * 64 + cc * 2; return st * 1024 + (ob ^ (((ob >> 9) & 1) << 5)); }
__host__ __device__ __forceinline__ void stage_rc(int b, int& R, int& C) { const int st = b / 1024, sb = b % 1024, swz = sb ^ (((sb >> 9) & 1) << 5); R = (st >> 1) * 16 + swz / 64; C = (st & 1) * 32 + (swz % 64) / 2; }
__host__ __device__ __forceinline__ int perm32(int rho) { const int n = rho >> 4, i = rho & 15; return 8 * (i >> 2) + 4 * n + (i & 3); }

struct Unit { int pm, pn; long aoff, boff; int orow, ocol, sub; };
struct Gemm { const bf16_t* A; const bf16_t* Bt; };

struct StaticOrder {
    int nM, nN, nwg, G, c; long sa, sb;
    __device__ void init(int M, int N, int G_, int c_, int lda, int ldb) { nM = M / BM; nN = N / BM; nwg = nM * nN; G = G_; c = c_; sa = 512L * lda; sb = 512L * ldb; }
    __device__ bool next(int i, Unit& u) const {
        const long L = (long)i * G + c; if (L >= nwg) return false;
        int wgid = (int)L; { const int q = nwg / NXCD, r = nwg % NXCD, xcd = wgid % NXCD, off = wgid / NXCD; wgid = (xcd < r ? xcd * (q + 1) : r * (q + 1) + (xcd - r) * q) + off; }
        const int nig = WGM * nN, gid = wgid / nig, fm = gid * WGM, gsz = (nM - fm) < WGM ? (nM - fm) : WGM;
        u.pm = fm + ((wgid % nig) % gsz); u.pn = (wgid % nig) / gsz;
        u.aoff = u.pm * sa; u.boff = u.pn * sb; u.orow = u.pm * BM; u.ocol = u.pn * BM; u.sub = 0; return true;
    }
};
struct MergeOrder : StaticOrder {
    __device__ bool next(int i, Unit& u) const { if (!StaticOrder::next(i >> 2, u)) return false; u.sub = i & 3; u.aoff += 1024L * u.sub; u.boff += 1024L * u.sub; return true; }
};
struct F2Order : StaticOrder {
    __device__ bool next(int i, Unit& u) const { if (!StaticOrder::next(i, u)) return false; u.orow = (u.pn >> 1) * 4096 + u.pm * BM; u.ocol = (u.pn & 1) * BM; return true; }
};
struct F1Order {
    int G, c;
    __device__ bool next(int i, Unit& u) const {
        const int idx = i * G + c; if (idx >= 256) return false;
        const int bg = idx >> 4, st = idx & 15, b = bg >> 2, g = bg & 3;
        u.pm = 0; u.pn = idx; u.aoff = 0; u.boff = ((long)(b * 4096 + st * 256) * PJW + g * 128) * 2; u.orow = bg * 128; u.ocol = st * 256; return true;
    }
};

__device__ __forceinline__ unsigned cvt_pk_bf16(float lo, float hi) { unsigned r; asm volatile("v_cvt_pk_bf16_f32 %0, %1, %2" : "=v"(r) : "v"(lo), "v"(hi)); return r; }
__device__ __forceinline__ float bf_lo(unsigned w) { return __uint_as_float(w << 16); }
__device__ __forceinline__ float bf_hi(unsigned w) { return __uint_as_float(w & 0xffff0000u); }

#define PG8_PACK(v0, v1, w) do { (w).x = cvt_pk_bf16((v0)[0], (v0)[1]); (w).y = cvt_pk_bf16((v0)[2], (v0)[3]); (w).z = cvt_pk_bf16((v1)[0], (v1)[1]); (w).w = cvt_pk_bf16((v1)[2], (v1)[3]); } while (0)

struct EpiStore {
    static constexpr bool PERM = true;
    bf16_t* O; int ldo;
    __device__ __forceinline__ bool operator()(f32x4 (&acc)[2][2][4][2], const Unit& u, int wr, int wc, int fr, int fq) const {
        const int row0 = u.orow + wr * 64 + fr, col0 = u.ocol + wc * 32 + 8 * fq;
#pragma unroll
        for (int ai = 0; ai < 2; ++ai)
#pragma unroll
            for (int m = 0; m < 4; ++m) { bf16_t* rowp = O + (size_t)(row0 + ai * HALF + m * 16) * ldo + col0;
#pragma unroll
                for (int bj = 0; bj < 2; ++bj) { u32x4 w; PG8_PACK(acc[ai][bj][m][0], acc[ai][bj][m][1], w); *(u32x4*)(rowp + bj * HALF) = w; } }
        return true;
    }
};
struct EpiF2 {
    static constexpr bool PERM = true;
    bf16_t* O;
    __device__ __forceinline__ bool operator()(f32x4 (&acc)[2][2][4][2], const Unit& u, int wr, int wc, int fr, int fq) const {
        const int b = u.pn >> 1, gcol0 = (u.pn & 1) * BM + wc * 32 + 8 * fq;
#pragma unroll
        for (int ai = 0; ai < 2; ++ai)
#pragma unroll
            for (int m = 0; m < 4; ++m) { const int sp = u.pm * BM + ai * HALF + wr * 64 + m * 16 + fr;
#pragma unroll
                for (int bj = 0; bj < 2; ++bj) { const int gcol = gcol0 + bj * HALF; u32x4 w; PG8_PACK(acc[ai][bj][m][0], acc[ai][bj][m][1], w);
                    if (sp <= 2048) *(u32x4*)(O + (size_t)(b * 4096 + sp) * DM + gcol) = w;
                    if (sp >= 1 && sp <= 2047) { bf16_t* mr = O + (size_t)(b * 4096 + 4096 - sp) * DM + (gcol & ~127); const int c0 = gcol & 127;
                        mr[(128 - c0) & 127] = (bf16_t)(w.x & 0xffffu); mr[127 - c0] = (bf16_t)(w.x >> 16); mr[126 - c0] = (bf16_t)(w.y & 0xffffu); mr[125 - c0] = (bf16_t)(w.y >> 16);
                        mr[124 - c0] = (bf16_t)(w.z & 0xffffu); mr[123 - c0] = (bf16_t)(w.z >> 16); mr[122 - c0] = (bf16_t)(w.w & 0xffffu); mr[121 - c0] = (bf16_t)(w.w >> 16); } } }
        return true;
    }
};
struct EpiZT {
    static constexpr bool PERM = true;
    bf16_t* O;
    __device__ __forceinline__ bool operator()(f32x4 (&acc)[2][2][4][2], const Unit& u, int wr, int wc, int fr, int fq) const {
        const int row0 = u.orow + wr * 64 + fr, col0 = u.ocol + wc * 32 + 8 * fq;
#pragma unroll
        for (int ai = 0; ai < 2; ++ai)
#pragma unroll
            for (int m = 0; m < 4; ++m) { bf16_t* rowp = O + (size_t)(row0 + m * 16) * 8192 + ai * 4096 + col0;
#pragma unroll
                for (int bj = 0; bj < 2; ++bj) { u32x4 w; PG8_PACK(acc[ai][bj][m][0], acc[ai][bj][m][1], w); *(u32x4*)(rowp + bj * HALF) = w; } }
        return true;
    }
};
struct EpiProj {
    static constexpr bool PERM = true;
    bf16_t* P; bf16_t* Gt; const float* bg; int split, off_lo, off_hi; float scale;
    __device__ __forceinline__ bool operator()(f32x4 (&acc)[2][2][4][2], const Unit& u, int wr, int wc, int fr, int fq) const {
        const int pnn = u.pn < split ? u.pn + off_lo : u.pn + off_hi; const bool isg = pnn >= 32;
        const int row0 = u.pm * BM + wr * 64 + fr, col0 = (isg ? pnn - 32 : pnn) * BM + wc * 32 + 8 * fq, ldc = isg ? GTW : PJW;
        bf16_t* base = isg ? Gt : P;
        f32x4 bv[2][2];
#pragma unroll
        for (int bj = 0; bj < 2; ++bj)
#pragma unroll
            for (int n = 0; n < 2; ++n) bv[bj][n] = isg ? *(const f32x4*)(bg + col0 + bj * HALF + 4 * n) : (f32x4){0.f, 0.f, 0.f, 0.f};
#pragma unroll
        for (int ai = 0; ai < 2; ++ai)
#pragma unroll
            for (int m = 0; m < 4; ++m) { bf16_t* rowp = base + (size_t)(row0 + ai * HALF + m * 16) * ldc + col0;
#pragma unroll
                for (int bj = 0; bj < 2; ++bj) { f32x4 v0 = acc[ai][bj][m][0] * scale + bv[bj][0], v1 = acc[ai][bj][m][1] * scale + bv[bj][1];
                    if (isg) {
#pragma unroll
                        for (int j = 0; j < 4; ++j) { v0[j] = __builtin_amdgcn_rcpf(1.0f + __builtin_amdgcn_exp2f(-1.4426950408889634f * v0[j])); v1[j] = __builtin_amdgcn_rcpf(1.0f + __builtin_amdgcn_exp2f(-1.4426950408889634f * v1[j])); } }
                    u32x4 w; PG8_PACK(v0, v1, w); *(u32x4*)(rowp + bj * HALF) = w; } }
        return true;
    }
};
struct EpiMerge4 {
    static constexpr bool PERM = true;
    const bf16_t* Gt; bf16_t* O;
    __device__ __forceinline__ bool operator()(f32x4 (&acc)[2][2][4][2], const Unit& u, int wr, int wc, int fr, int fq) const {
        const int row0 = u.pm * BM + wr * 64 + fr, col0 = u.pn * BM + wc * 32 + 8 * fq;
        if (u.sub == 2) return false;
        if (u.sub < 2) {
#pragma unroll
            for (int ai = 0; ai < 2; ++ai)
#pragma unroll
                for (int m = 0; m < 4; ++m) { const bf16_t* gp = Gt + (size_t)(row0 + ai * HALF + m * 16) * GTW + u.sub * DM + col0;
#pragma unroll
                    for (int bj = 0; bj < 2; ++bj) { const u32x4 gn = *(const u32x4*)(gp + bj * HALF), gd = *(const u32x4*)(gp + DM + bj * HALF);
                        f32x4 r0, r1;
                        r0[0] = bf_lo(gn.x) * __builtin_amdgcn_rcpf(bf_lo(gd.x)); r0[1] = bf_hi(gn.x) * __builtin_amdgcn_rcpf(bf_hi(gd.x));
                        r0[2] = bf_lo(gn.y) * __builtin_amdgcn_rcpf(bf_lo(gd.y)); r0[3] = bf_hi(gn.y) * __builtin_amdgcn_rcpf(bf_hi(gd.y));
                        r1[0] = bf_lo(gn.z) * __builtin_amdgcn_rcpf(bf_lo(gd.z)); r1[1] = bf_hi(gn.z) * __builtin_amdgcn_rcpf(bf_hi(gd.z));
                        r1[2] = bf_lo(gn.w) * __builtin_amdgcn_rcpf(bf_lo(gd.w)); r1[3] = bf_hi(gn.w) * __builtin_amdgcn_rcpf(bf_hi(gd.w));
                        acc[ai][bj][m][0] *= r0; acc[ai][bj][m][1] *= r1; }
                    asm volatile("" ::: "memory"); }
            return false;
        }
#pragma unroll
        for (int ai = 0; ai < 2; ++ai)
#pragma unroll
            for (int m = 0; m < 4; ++m) { const bf16_t* gp = Gt + (size_t)(row0 + ai * HALF + m * 16) * GTW + 2 * DM + col0; bf16_t* rowp = O + (size_t)(row0 + ai * HALF + m * 16) * DM + col0;
#pragma unroll
                for (int bj = 0; bj < 2; ++bj) { const u32x4 g = *(const u32x4*)(gp + bj * HALF);
                    f32x4 v0 = acc[ai][bj][m][0], v1 = acc[ai][bj][m][1];
                    v0[0] *= bf_lo(g.x); v0[1] *= bf_hi(g.x); v0[2] *= bf_lo(g.y); v0[3] *= bf_hi(g.y);
                    v1[0] *= bf_lo(g.z); v1[1] *= bf_hi(g.z); v1[2] *= bf_lo(g.w); v1[3] *= bf_hi(g.w);
                    u32x4 w; PG8_PACK(v0, v1, w); *(u32x4*)(rowp + bj * HALF) = w; }
                asm volatile("" ::: "memory"); }
        return true;
    }
};
struct EpiResF32 {
    static constexpr bool PERM = false;
    const float* base; float* out; int ldc;
    __device__ __forceinline__ bool operator()(f32x4 (&acc)[2][2][4][2], const Unit& u, int wr, int wc, int fr, int fq) const {
        const int row0 = u.orow + wr * 64 + fr, col0 = u.ocol + wc * 32 + 4 * fq;
#pragma unroll
        for (int ai = 0; ai < 2; ++ai)
#pragma unroll
            for (int m = 0; m < 4; ++m) { const size_t off = (size_t)(row0 + ai * HALF + m * 16) * ldc + col0;
#pragma unroll
                for (int bj = 0; bj < 2; ++bj)
#pragma unroll
                    for (int n = 0; n < 2; ++n) { f32x4 v = acc[ai][bj][m][n]; if (base) v += *(const f32x4*)(base + off + bj * HALF + n * 16); *(f32x4*)(out + off + bj * HALF + n * 16) = v; }
                asm volatile("" ::: "memory"); }
        return true;
    }
};

template <class Epi, class Sched, bool ALIGN_EPI, int LDA, int LDB, int KK, bool F8 = false>
__device__ __forceinline__ void gemm_phase(PG8_LAS unsigned char* lds, const Gemm g, const Sched& S, const Epi& E, int wave0) {
    const int tid = opaque_tid(wave0), wid = wave0, lane = tid & 63, wr = wid >> 2, wc = wid & 3, fr = lane & 15, fq = lane >> 4;
    constexpr int nt = KK / BK;
    unsigned voffA[2], voffB[2];
#pragma unroll
    for (int i = 0; i < 2; ++i) { int R, C; stage_rc(tid * 16 + i * 8192, R, C); const int Rb = Epi::PERM ? ((R & ~31) + perm32(R & 31)) : R;
        voffA[i] = (unsigned)(R * LDA + C) * 2u; voffB[i] = (unsigned)(Rb * LDB + C) * 2u; }
    const size_t kstep = (size_t)(BK * 2);
    constexpr size_t hstepA = (size_t)HALF * LDA * 2, hstepB = (size_t)HALF * LDB * 2;
    const unsigned ldsw = (unsigned)wid * 1024u;
    const int aoff = lds_byte(wr * 64 + fr, fq * 8), boff = lds_byte(wc * 32 + fr, fq * 8);
#define PG8_SA(b, h) (((b) * 2 + (h)) * HTB)
#define PG8_SB(b, h) ((4 + (b) * 2 + (h)) * HTB)
#define PG8_STAGE(bufoff, gbase, voff) do { _Pragma("unroll") for (int _i = 0; _i < 2; ++_i) \
        __builtin_amdgcn_global_load_lds((const unsigned*)((const char*)(gbase) + (voff)[_i]), (PG8_LAS unsigned*)(lds + (bufoff) + ldsw + _i * 8192), 16, 0, 0); } while (0)
#define PG8_LDA(dst, b, h) do { _Pragma("unroll") for (int m = 0; m < 4; ++m) _Pragma("unroll") for (int k = 0; k < 2; ++k) dst[m][k] = *(const PG8_LAS bf16x8*)(lds + PG8_SA(b, h) + aoff + m * 2048 + k * 1024); } while (0)
#define PG8_LDB(dst, b, h) do { _Pragma("unroll") for (int n = 0; n < 2; ++n) _Pragma("unroll") for (int k = 0; k < 2; ++k) dst[n][k] = *(const PG8_LAS bf16x8*)(lds + PG8_SB(b, h) + boff + n * 2048 + k * 1024); } while (0)
#define PG8_CAT(x) __builtin_shufflevector(__builtin_bit_cast(i32x4, (x)[0]), __builtin_bit_cast(i32x4, (x)[1]), 0, 1, 2, 3, 4, 5, 6, 7)
#define PG8_MMA(ai, bj, At, Bt) do { __builtin_amdgcn_s_setprio(1); _Pragma("unroll") for (int m = 0; m < 4; ++m) _Pragma("unroll") for (int n = 0; n < 2; ++n) { \
        if constexpr (F8) { const i32x8 a8_ = PG8_CAT(Bt[n]), b8_ = PG8_CAT(At[m]); asm volatile("v_mfma_scale_f32_16x16x128_f8f6f4 %0, %1, %2, %0, %3, %3 op_sel_hi:[0,0,0]" : "+v"(acc[ai][bj][m][n]) : "v"(a8_), "v"(b8_), "v"(one8)); } \
        else { _Pragma("unroll") for (int k = 0; k < 2; ++k) acc[ai][bj][m][n] = __builtin_amdgcn_mfma_f32_16x16x32_bf16(Bt[n][k], At[m][k], acc[ai][bj][m][n], 0, 0, 0); } } __builtin_amdgcn_s_setprio(0); } while (0)
#define PG8_WAIT_V(n) asm volatile("s_waitcnt vmcnt(" #n ")" ::: "memory")
#define PG8_WAIT_L(n) asm volatile("s_waitcnt lgkmcnt(" #n ")" ::: "memory")
#define PG8_BAR __builtin_amdgcn_s_barrier()
#define PG8_SCHED __builtin_amdgcn_sched_barrier(0)
    Unit cur, nxt; int ui = 0;
    if (!S.next(0, cur)) return;
    const int one8 = 0x7f7f7f7f; (void)one8;
    f32x4 acc[2][2][4][2];
#pragma unroll
    for (int a = 0; a < 2; ++a)
#pragma unroll
        for (int b = 0; b < 2; ++b)
#pragma unroll
            for (int m = 0; m < 4; ++m)
#pragma unroll
                for (int n = 0; n < 2; ++n) acc[a][b][m][n] = (f32x4){0.f, 0.f, 0.f, 0.f};
    bf16x8 At[4][2], B0[2][2], B1[2][2];
    const char* cA = (const char*)g.A + cur.aoff; const char* cB = (const char*)g.Bt + cur.boff;
    PG8_STAGE(PG8_SB(0, 0), cB, voffB); PG8_STAGE(PG8_SB(0, 1), cB + hstepB, voffB); PG8_STAGE(PG8_SA(0, 0), cA, voffA); PG8_STAGE(PG8_SA(0, 1), cA + hstepA, voffA);
    if (wr == 1) PG8_BAR;
    PG8_WAIT_V(2); PG8_BAR;
    PG8_STAGE(PG8_SB(1, 0), cB + kstep, voffB); PG8_STAGE(PG8_SA(1, 0), cA + kstep, voffA); PG8_STAGE(PG8_SB(1, 1), cB + hstepB + kstep, voffB);
    PG8_WAIT_V(6); PG8_BAR;
    for (;;) {
        const bool has_next = S.next(ui + 1, nxt);
        const char* nA = has_next ? (const char*)g.A + nxt.aoff : cA; const char* nB = has_next ? (const char*)g.Bt + nxt.boff : cB;
        for (int t = 0; t < nt; t += 2) {
            const bool last = (t == nt - 2);
            const char* a1 = cA + (size_t)(t + 1) * kstep;
            const char* a2 = last ? nA : cA + (size_t)(t + 2) * kstep; const char* b2 = last ? nB : cB + (size_t)(t + 2) * kstep;
            const char* a3 = a2 + kstep; const char* b3 = b2 + kstep;
            PG8_LDB(B0, 0, 0); PG8_LDB(B1, 0, 1); PG8_SCHED; PG8_LDA(At, 0, 0); PG8_STAGE(PG8_SA(1, 1), a1 + hstepA, voffA);
            PG8_WAIT_V(8); PG8_WAIT_L(0); PG8_BAR; PG8_MMA(0, 0, At, B0); PG8_MMA(0, 1, At, B1); PG8_BAR; PG8_SCHED;
            PG8_LDA(At, 0, 1); PG8_STAGE(PG8_SB(0, 0), b2, voffB); PG8_STAGE(PG8_SB(0, 1), b2 + hstepB, voffB); PG8_STAGE(PG8_SA(0, 0), a2, voffA);
            PG8_WAIT_V(8); PG8_WAIT_L(0); PG8_BAR; PG8_MMA(1, 0, At, B0); PG8_MMA(1, 1, At, B1); PG8_BAR; PG8_SCHED;
            PG8_LDB(B0, 1, 0); PG8_LDB(B1, 1, 1); PG8_SCHED; PG8_LDA(At, 1, 0); PG8_STAGE(PG8_SA(0, 1), a2 + hstepA, voffA);
            PG8_WAIT_V(8); PG8_WAIT_L(0); PG8_BAR; PG8_MMA(0, 0, At, B0); PG8_MMA(0, 1, At, B1); PG8_BAR; PG8_SCHED;
            PG8_LDA(At, 1, 1); PG8_STAGE(PG8_SB(1, 0), b3, voffB); PG8_STAGE(PG8_SB(1, 1), b3 + hstepB, voffB); PG8_STAGE(PG8_SA(1, 0), a3, voffA);
            PG8_WAIT_V(8); PG8_WAIT_L(0); PG8_BAR; PG8_MMA(1, 0, At, B0); PG8_MMA(1, 1, At, B1); PG8_BAR; PG8_SCHED;
        }
        if constexpr (ALIGN_EPI) { if (wr == 0) PG8_BAR; }
        if constexpr (F8) asm volatile("s_nop 15\n\ts_nop 15" ::: "memory");
        const bool fin = E(acc, cur, wr, wc, fr, fq);
        if (!has_next) break;
        if (fin) {
#pragma unroll
        for (int a = 0; a < 2; ++a)
#pragma unroll
            for (int b = 0; b < 2; ++b)
#pragma unroll
                for (int m = 0; m < 4; ++m)
#pragma unroll
                    for (int n = 0; n < 2; ++n) acc[a][b][m][n] = (f32x4){0.f, 0.f, 0.f, 0.f};
        }
        cur = nxt; cA = nA; cB = nB; ++ui;
        if constexpr (ALIGN_EPI) { if (wr == 1) PG8_BAR; }
    }
    PG8_WAIT_V(0);
    if constexpr (!ALIGN_EPI) { if (wr == 0) PG8_BAR; }
    PG8_BAR;
#undef PG8_SA
#undef PG8_SB
#undef PG8_STAGE
#undef PG8_LDA
#undef PG8_LDB
#undef PG8_MMA
#undef PG8_CAT
#undef PG8_WAIT_V
#undef PG8_WAIT_L
#undef PG8_BAR
#undef PG8_SCHED
}
}

namespace attn {
using bf16x8 = __attribute__((ext_vector_type(8))) short;
using s16x4  = __attribute__((ext_vector_type(4))) short;
using f32x16 = __attribute__((ext_vector_type(16))) float;
using u32x4  = __attribute__((ext_vector_type(4))) unsigned;
constexpr int   D = 128, NW = 8, QBLK = 32, KVBLK = 64;
constexpr float SCALE = 0.088388347648318440f;
constexpr float THR = 8.f;
constexpr size_t SHM_V = KVBLK * D * 2, SHM_K = KVBLK * D * 2;
constexpr int LDS_WS = 2 * SHM_V + 2 * SHM_K, LDS_TAB = LDS_WS + NW * 64 * 4, LDS_END = LDS_TAB + 8192 * 4;
#define KSWZ(row, colB) ((row) * 256 + ((colB) ^ (((row) & 7) << 4)))
#define SBAR() __builtin_amdgcn_sched_barrier(0)
__device__ __forceinline__ int crow(int r, int hi) { return (r & 3) + 8 * (r >> 2) + 4 * hi; }
__device__ __forceinline__ unsigned cvtpk(float lo, float hi) { unsigned r; asm volatile("v_cvt_pk_bf16_f32 %0, %1, %2" : "=v"(r) : "v"(lo), "v"(hi)); return r; }

__device__ __forceinline__ void partialSM(f32x16& p0, f32x16& p1, float& m_reg, float& mn, float& alpha) {
  constexpr float C = SCALE * 1.4426950408889634f;
  float pmax = p0[0]; for (int r = 1; r < 16; ++r) pmax = fmaxf(pmax, p0[r]); for (int r = 0; r < 16; ++r) pmax = fmaxf(pmax, p1[r]);
  { auto rr = __builtin_amdgcn_permlane32_swap(__float_as_uint(pmax), __float_as_uint(pmax), false, false);
    pmax = fmaxf(__uint_as_float(rr[0]), __uint_as_float(rr[1])); }
  if (__builtin_expect(__all(pmax - m_reg <= THR / SCALE), 1)) { mn = m_reg; alpha = 1.f; }
  else { mn = fmaxf(m_reg, pmax); alpha = __builtin_amdgcn_exp2f((m_reg - mn) * C); m_reg = mn; }
  float mnC = -mn * C;
  for (int r = 0; r < 16; ++r) p0[r] = fmaf(p0[r], C, mnC); for (int r = 0; r < 16; ++r) p1[r] = fmaf(p1[r], C, mnC);
  for (int r = 0; r < 16; ++r) p0[r] = __builtin_amdgcn_exp2f(p0[r]);
}
__device__ __forceinline__ void finishSM(f32x16& p0, f32x16& p1, float alpha, float& l_reg, bf16x8& pa0, bf16x8& pa1, bf16x8& pa2, bf16x8& pa3) {
  for (int r = 0; r < 16; ++r) p1[r] = __builtin_amdgcn_exp2f(p1[r]);
  float ps = 0; for (int r = 0; r < 16; ++r) ps += p0[r]; for (int r = 0; r < 16; ++r) ps += p1[r];
  { auto rr = __builtin_amdgcn_permlane32_swap(__float_as_uint(ps), __float_as_uint(ps), false, false);
    ps = __uint_as_float(rr[0]) + __uint_as_float(rr[1]); }
  l_reg = l_reg * alpha + ps;
#define PK4(P, BASE, OUT) do { unsigned a0 = cvtpk(P[BASE + 0], P[BASE + 1]), a1 = cvtpk(P[BASE + 2], P[BASE + 3]);   \
    unsigned b0 = cvtpk(P[BASE + 4], P[BASE + 5]), b1 = cvtpk(P[BASE + 6], P[BASE + 7]);                              \
    auto r0 = __builtin_amdgcn_permlane32_swap(a0, b0, false, false); auto r1 = __builtin_amdgcn_permlane32_swap(a1, b1, false, false); \
    u32x4 w = {r0[0], r1[0], r0[1], r1[1]}; OUT = *reinterpret_cast<bf16x8*>(&w); } while (0)
  PK4(p0, 0, pa0); PK4(p0, 8, pa1); PK4(p1, 0, pa2); PK4(p1, 8, pa3);
#undef PK4
}
__device__ __forceinline__ void qkt(f32x16& p0, f32x16& p1, const bf16* Ks, const bf16x8* qr, int r32, int hi, const float* tl) {
#pragma unroll
  for (int r = 0; r < 16; ++r) { p0[r] = tl[(r & 3) + 8 * (r >> 2)]; p1[r] = tl[32 + (r & 3) + 8 * (r >> 2)]; }
#pragma unroll
  for (int d0 = 0; d0 < 8; ++d0) { int cb = (d0 * 16 + hi * 8) * 2;
    bf16x8 b0 = *reinterpret_cast<const bf16x8*>((const char*)Ks + KSWZ(r32, cb));
    bf16x8 b1 = *reinterpret_cast<const bf16x8*>((const char*)Ks + KSWZ(32 + r32, cb));
    p0 = __builtin_amdgcn_mfma_f32_32x32x16_bf16(b0, qr[d0], p0, 0, 0, 0);
    p1 = __builtin_amdgcn_mfma_f32_32x32x16_bf16(b1, qr[d0], p1, 0, 0, 0); }
}
__device__ __forceinline__ int v_st(int k, int c) { const int kk = (k & ~0xC) | ((k & 4) << 1) | ((k & 8) >> 1); return ((kk >> 3) * 4 + (c >> 5)) * 512 + ((kk & 7) * 32 + (c & 31)) * 2; }
__device__ __forceinline__ int v_rd_base(int lane) { return ((lane & 3) << 3) | (((lane >> 2) & 3) << 6) | (((lane >> 4) & 1) << 5) | (((lane >> 5) & 1) << 8); }
constexpr int v_rd_off(int d0, int ks, int half) { return d0 * 512 + ks * 4096 + half * 2048; }
template <int OFF> __device__ __forceinline__ s16x4 tr_read(int vb) {
  s16x4 r; asm volatile("ds_read_b64_tr_b16 %0, %1 offset:%2" : "=&v"(r) : "v"(vb), "i"(OFF) : "memory"); return r;
}
template <int D0> __device__ __forceinline__ void pv_one(f32x16& od, int vb, bf16x8 pa0, bf16x8 pa1, bf16x8 pa2, bf16x8 pa3) {
  const s16x4 l0 = tr_read<v_rd_off(D0, 0, 0)>(vb), h0 = tr_read<v_rd_off(D0, 0, 1)>(vb), l1 = tr_read<v_rd_off(D0, 1, 0)>(vb), h1 = tr_read<v_rd_off(D0, 1, 1)>(vb);
  const s16x4 l2 = tr_read<v_rd_off(D0, 2, 0)>(vb), h2 = tr_read<v_rd_off(D0, 2, 1)>(vb), l3 = tr_read<v_rd_off(D0, 3, 0)>(vb), h3 = tr_read<v_rd_off(D0, 3, 1)>(vb);
  asm volatile("s_waitcnt lgkmcnt(0)" ::: "memory"); SBAR();
#define PK(L, H) (bf16x8){L[0], L[1], L[2], L[3], H[0], H[1], H[2], H[3]}
  od = __builtin_amdgcn_mfma_f32_32x32x16_bf16(pa0, PK(l0, h0), od, 0, 0, 0);
  od = __builtin_amdgcn_mfma_f32_32x32x16_bf16(pa1, PK(l1, h1), od, 0, 0, 0);
  od = __builtin_amdgcn_mfma_f32_32x32x16_bf16(pa2, PK(l2, h2), od, 0, 0, 0);
  od = __builtin_amdgcn_mfma_f32_32x32x16_bf16(pa3, PK(l3, h3), od, 0, 0, 0);
#undef PK
}
__device__ __forceinline__ void pv_d0(f32x16* o, int vb, bf16x8 pa0, bf16x8 pa1, bf16x8 pa2, bf16x8 pa3) {
  pv_one<0>(o[0], vb, pa0, pa1, pa2, pa3); pv_one<1>(o[1], vb, pa0, pa1, pa2, pa3); pv_one<2>(o[2], vb, pa0, pa1, pa2, pa3); pv_one<3>(o[3], vb, pa0, pa1, pa2, pa3);
}

struct Unit { const bf16* Q; const bf16* K; const bf16* V; bf16* O; float* lse; long ldq, ldk, ldo; int lse_ld, kt0, nt, qoff; };
__device__ __forceinline__ void attn_unit(const Unit& u, char* lds, int wave0) {
  const int tid = opaque_tid(wave0), wid = wave0, lane = tid & 63, r32 = lane & 31, hi = lane >> 5;
  bf16* V_lds = (bf16*)lds; bf16* K_lds = (bf16*)(lds + 2 * SHM_V);
  float* ws = (float*)(lds + LDS_WS) + wid * 64; float* li_l = ws; float* al_l = ws + 32;
  const float* tabL = (const float*)(lds + LDS_TAB);
  float m_reg = -1e30f, l_reg = 0; f32x16 o[4] = {}; bf16x8 qr[8];
  const bf16* Qw = u.Q + (long)(wid * QBLK + r32) * u.ldq + hi * 8;
#pragma unroll
  for (int d0 = 0; d0 < 8; ++d0) qr[d0] = *reinterpret_cast<const bf16x8*>(Qw + d0 * 16);
  const int sr = tid >> 4, sc = (tid & 15) * 8, vst0 = v_st(sr, sc), vst1 = v_st(32 + sr, sc);
  const int vb0 = (int)(uintptr_t)V_lds + v_rd_base(lane);
  const long tstep = (long)KVBLK * u.ldk * 2;
  const char* Kh = (const char*)u.K + (long)u.kt0 * tstep; const char* Vh = (const char*)u.V + (long)u.kt0 * tstep;
  const unsigned lo0 = (unsigned)((sr * (int)u.ldk + sc) * 2), lo1 = lo0 + (unsigned)(32 * (int)u.ldk * 2);
  const float* tl0 = tabL + (4096 + u.kt0 * KVBLK + 4 * hi - (u.qoff + wid * QBLK + r32));
  struct { bf16x8 vs0, vs1, ks0, ks1; } sr_[2];
#define SLOAD(i, tj) do { const char* vt_ = Vh + (long)(tj) * tstep; const char* kt_ = Kh + (long)(tj) * tstep; \
    sr_[i].vs0 = *reinterpret_cast<const bf16x8*>(vt_ + lo0); sr_[i].vs1 = *reinterpret_cast<const bf16x8*>(vt_ + lo1); \
    sr_[i].ks0 = *reinterpret_cast<const bf16x8*>(kt_ + lo0); sr_[i].ks1 = *reinterpret_cast<const bf16x8*>(kt_ + lo1); } while (0)
#define SWRITE(b, i) do { *(bf16x8*)((char*)V_lds + (b) * SHM_V + vst0) = sr_[i].vs0;          \
    *(bf16x8*)((char*)V_lds + (b) * SHM_V + vst1) = sr_[i].vs1; int kc = sc * 2;               \
    *(bf16x8*)((char*)K_lds + (b) * SHM_K + KSWZ(sr, kc)) = sr_[i].ks0;                       \
    *(bf16x8*)((char*)K_lds + (b) * SHM_K + KSWZ(32 + sr, kc)) = sr_[i].ks1; } while (0)
#define SWAIT() asm volatile("s_waitcnt vmcnt(4)" ::: "memory")
#define RESC(a) do { if (__any((a) < 1.f)) { if (hi == 0) al_l[r32] = (a); asm volatile("s_waitcnt lgkmcnt(0)" ::: "memory"); \
    for (int d = 0; d < 4; ++d) for (int r = 0; r < 16; ++r) o[d][r] *= al_l[crow(r, hi)]; } } while (0)
  f32x16 pA0, pA1, pB0, pB1; float mnA, mnB, alA, alB; bf16x8 pa0, pa1, pa2, pa3; const int NT = u.nt;
  constexpr int SE = 0, SO = 1;
  SLOAD(SE, 0); asm volatile("s_waitcnt vmcnt(0)" ::: "memory"); SWRITE(0, SE); __syncthreads();
  qkt(pA0, pA1, K_lds, qr, r32, hi, tl0); partialSM(pA0, pA1, m_reg, mnA, alA);
  SLOAD(SO, 1); if (2 < NT) SLOAD(SE, 2);
  SWAIT(); SWRITE(1, SO); __syncthreads();
  for (int j = 1; j + 1 < NT; j += 2) {
    SBAR(); qkt(pB0, pB1, (bf16*)((char*)K_lds + SHM_K), qr, r32, hi, tl0 + j * KVBLK);
    finishSM(pA0, pA1, alA, l_reg, pa0, pa1, pa2, pa3); SBAR();
    SLOAD(SO, j + 2); SBAR();
    pv_d0(o, vb0, pa0, pa1, pa2, pa3); partialSM(pB0, pB1, m_reg, mnB, alB);
    __syncthreads(); SWAIT(); SWRITE(0, SE);
    RESC(alB); __syncthreads();
    SBAR(); qkt(pA0, pA1, K_lds, qr, r32, hi, tl0 + (j + 1) * KVBLK);
    finishSM(pB0, pB1, alB, l_reg, pa0, pa1, pa2, pa3); SBAR();
    if (j + 3 < NT) SLOAD(SE, j + 3); SBAR();
    pv_d0(o, vb0 + (int)SHM_V, pa0, pa1, pa2, pa3); partialSM(pA0, pA1, m_reg, mnA, alA);
    __syncthreads(); SWAIT(); SWRITE(1, SO);
    RESC(alA); __syncthreads();
  }
  SBAR(); qkt(pB0, pB1, (bf16*)((char*)K_lds + SHM_K), qr, r32, hi, tl0 + (NT - 1) * KVBLK);
  finishSM(pA0, pA1, alA, l_reg, pa0, pa1, pa2, pa3); SBAR();
  pv_d0(o, vb0, pa0, pa1, pa2, pa3); partialSM(pB0, pB1, m_reg, mnB, alB);
  __syncthreads(); RESC(alB);
  finishSM(pB0, pB1, alB, l_reg, pa0, pa1, pa2, pa3); SBAR();
  pv_d0(o, vb0 + (int)SHM_V, pa0, pa1, pa2, pa3);
  if (hi == 0) li_l[r32] = l_reg; asm volatile("s_waitcnt lgkmcnt(0)" ::: "memory");
  float rli[16];
#pragma unroll
  for (int r = 0; r < 16; ++r) rli[r] = __builtin_amdgcn_rcpf(li_l[crow(r, hi)]);
  bf16* Ow = u.O + (long)(wid * QBLK) * u.ldo;
#pragma unroll
  for (int r = 0; r < 16; ++r) { int orow = crow(r, hi);
#pragma unroll
    for (int d0 = 0; d0 < 4; ++d0) { const float v = o[d0][r] * rli[r]; Ow[(long)orow * u.ldo + d0 * 32 + r32] = (bf16)(cvtpk(v, v) & 0xffffu); } }
  if (u.lse != nullptr && hi == 0) u.lse[(long)(wid * QBLK + r32) * u.lse_ld] = m_reg * SCALE + __logf(l_reg);
#undef SLOAD
#undef SWRITE
#undef SWAIT
#undef RESC
}
#undef KSWZ
#undef SBAR
}

constexpr int NWAVES = 8;
constexpr size_t MiB = 1u << 20;
constexpr size_t WS_CTL = 0, CTL_ZERO_BYTES = 1 * MiB;
constexpr size_t WS_CS   = 1 * MiB;
constexpr size_t WS_SKBD = 1 * MiB + 256 * 1024;
constexpr size_t WS_TAB  = 2 * MiB;
constexpr size_t WS_LSE  = 3 * MiB;
constexpr size_t WS_SU   = 3 * MiB + 768 * 1024;
constexpr size_t WS_SH   = 3 * MiB + 832 * 1024;
constexpr size_t WS_WCAT = 4 * MiB, WS_WO = 12 * MiB, WS_WQ = 20 * MiB;
constexpr size_t WS_WIN  = 28 * MiB;
constexpr size_t WS_WG8  = WS_WIN + 16 * MiB;
constexpr size_t WS_DFT  = 84 * MiB;
constexpr size_t WS_U    = 148 * MiB, WS_V = 180 * MiB;
constexpr size_t WS_H8   = 212 * MiB;
constexpr size_t WS_H    = 276 * MiB;
constexpr size_t WS_PROJ = 340 * MiB;
constexpr size_t WS_G    = 596 * MiB;
constexpr size_t WS_ZT   = 788 * MiB;
constexpr size_t WS_OC   = 820 * MiB;
constexpr size_t WS_MG   = 884 * MiB;
constexpr size_t WS_END  = 948 * MiB;
#if DBG_MODE == 2
constexpr size_t WS_ACT = WS_PROJ + 208 * MiB;
#else
constexpr size_t WS_ACT = WS_PROJ + 200 * MiB;
#endif
constexpr size_t WS_Q = WS_PROJ, WS_SC = WS_PROJ + 64 * MiB, WS_IDS = WS_PROJ + 192 * MiB, WS_GATES = WS_PROJ + 200 * MiB;
constexpr int CW_BAR = 4096;
constexpr int CW_XRANK = 12288;
constexpr int CW_QUEUE = 16384;
constexpr int RING_BYTES = 131072, LDSCTL_OFF = RING_BYTES, MISC_OFF = LDSCTL_OFF + 320, LDS_BYTES = 147456;

#define LDS_WAIT() asm volatile("s_waitcnt lgkmcnt(0)" ::: "memory")
#define VM_WAIT() asm volatile("s_waitcnt vmcnt(0)" ::: "memory")
__device__ __forceinline__ unsigned f2bf(float f) { unsigned u = __builtin_bit_cast(unsigned, f); return (u + 0x7fffu + ((u >> 16) & 1u)) >> 16; }
__device__ __forceinline__ unsigned pk2(float lo, float hi) { return f2bf(lo) | (f2bf(hi) << 16); }
__device__ __forceinline__ float bflo(unsigned w) { return __uint_as_float(w << 16); }
__device__ __forceinline__ float bfhi(unsigned w) { return __uint_as_float(w & 0xffff0000u); }

#define XB_TMO      128
#define XB_XCNT(j)  (256  + 64 * (j))
#define XB_XSUB(j)  (1280 + 64 * (j))
#define XB_XGEN(j)  (2304 + 64 * (j))
#define XB_TOP      3328
#define XB_TOPGEN   3392
#define XCD_BAR_WORDS 3456
#define XB_SPIN_CAP (1u << 20)
__device__ __forceinline__ unsigned xb_ld(unsigned* p)              { return __hip_atomic_load(p, __ATOMIC_RELAXED, __HIP_MEMORY_SCOPE_AGENT); }
__device__ __forceinline__ unsigned xb_add(unsigned* p, unsigned v) { return __hip_atomic_fetch_add(p, v, __ATOMIC_RELAXED, __HIP_MEMORY_SCOPE_AGENT); }
__device__ __forceinline__ unsigned xb_xcc_id() { return (unsigned)__builtin_amdgcn_s_getreg((3 << 11) | 20) & 0xFu; }
#define XB_SPIN(cond, bar) do { unsigned _sp = 0; while (cond) { __builtin_amdgcn_s_sleep(1); \
    if ((++_sp & 255u) == 0u) { if (xb_ld(&(bar)[XB_TMO])) break; if (_sp > XB_SPIN_CAP) { atomicAdd(&(bar)[XB_TMO], 1u); break; } } } } while (0)
struct XcdBarrier { unsigned* bar; unsigned x; volatile LAS unsigned* st; };
__device__ __forceinline__ XcdBarrier xcd_barrier_post(unsigned* bar, volatile LAS unsigned* st) {
    XcdBarrier b; b.bar = bar; b.x = xb_xcc_id(); b.st = st;
    if (threadIdx.x == 0) (void)xb_add(&bar[XB_XCNT(b.x)], 1u);
    return b;
}
__device__ __forceinline__ void xcd_barrier_complete(unsigned* bar, unsigned x, unsigned& nloc, unsigned& nx) {
    const unsigned G = gridDim.x * gridDim.y * gridDim.z;
    unsigned sum, cnt, mine, sp = 0u;
    for (;;) {
        sum = 0u; cnt = 0u; mine = 0u;
#pragma unroll
        for (unsigned j = 0; j < 16; ++j) { const unsigned c = xb_ld(&bar[XB_XCNT(j)]); sum += c; cnt += (c > 0u) ? 1u : 0u; mine = (j == x) ? c : mine; }
        if (sum == G) break;
        __builtin_amdgcn_s_sleep(1);
        if ((++sp & 255u) == 0u) { if (xb_ld(&bar[XB_TMO])) break; if (sp > XB_SPIN_CAP) { atomicAdd(&bar[XB_TMO], 1u); break; } }
    }
    nloc = mine > 0u ? mine : 1u; nx = cnt > 0u ? cnt : 1u;
}
__device__ __forceinline__ void xcd_barrier(const XcdBarrier& b) {
    asm volatile("s_waitcnt vmcnt(0)" ::: "memory");
    __syncthreads();
    if (threadIdx.x == 0) {
        unsigned* bar = b.bar;
        __builtin_amdgcn_s_waitcnt(0);
        unsigned nloc = b.st[0], nx = b.st[1];
        if (nloc == 0u) { xcd_barrier_complete(bar, b.x, nloc, nx); b.st[0] = nloc; b.st[1] = nx; }
        const unsigned old = xb_add(&bar[XB_XSUB(b.x)], 1u);
        const unsigned gen = old / nloc;
        if (old + 1u == (gen + 1u) * nloc) {
            __builtin_amdgcn_fence(__ATOMIC_RELEASE, "agent");
            asm volatile("s_waitcnt vmcnt(0)" ::: "memory");
            const unsigned og = xb_add(&bar[XB_TOP], 1u);
            const unsigned tg = og / nx;
            if (og + 1u == (tg + 1u) * nx) xb_add(&bar[XB_TOPGEN], 1u);
            else XB_SPIN(xb_ld(&bar[XB_TOPGEN]) == tg, bar);
            __builtin_amdgcn_fence(__ATOMIC_ACQUIRE, "agent");
            xb_add(&bar[XB_XGEN(b.x)], 1u);
            asm volatile("s_waitcnt vmcnt(0)" ::: "memory");
        } else {
            XB_SPIN(xb_ld(&bar[XB_XGEN(b.x)]) == gen, bar);
            __builtin_amdgcn_fence(__ATOMIC_ACQUIRE, "agent");
            asm volatile("s_waitcnt vmcnt(0)" ::: "memory");
        }
    }
    __syncthreads();
}

template <int MASK> __device__ __forceinline__ int sx_i(int v) { return __builtin_amdgcn_ds_swizzle(v, 0x1f | (MASK << 10)); }
template <int MASK> __device__ __forceinline__ float sx_f(float v) { return __int_as_float(sx_i<MASK>(__float_as_int(v))); }
__device__ __forceinline__ float add32(float v) { auto rr = __builtin_amdgcn_permlane32_swap(__float_as_uint(v), __float_as_uint(v), false, false); return __uint_as_float(rr[0]) + __uint_as_float(rr[1]); }
__device__ __forceinline__ unsigned max32(unsigned v) { auto rr = __builtin_amdgcn_permlane32_swap(v, v, false, false); return rr[0] > rr[1] ? rr[0] : rr[1]; }
__device__ __forceinline__ float other32(float v, bool upper) { auto rr = __builtin_amdgcn_permlane32_swap(__float_as_uint(v), __float_as_uint(v), false, false); return __uint_as_float(upper ? rr[0] : rr[1]); }
__device__ __forceinline__ float bperm_f(float v, int src_lane) { return __int_as_float(__builtin_amdgcn_ds_bpermute(src_lane * 4, __float_as_int(v))); }
__device__ __forceinline__ int bperm_i(int v, int src_lane) { return __builtin_amdgcn_ds_bpermute(src_lane * 4, v); }
__device__ __forceinline__ float wave_sum(float v) {
    v += sx_f<1>(v); v += sx_f<2>(v); v += sx_f<4>(v); v += sx_f<8>(v); v += sx_f<16>(v); return add32(v);
}
__device__ __forceinline__ unsigned umax(unsigned a, unsigned b) { return a > b ? a : b; }
__device__ __forceinline__ unsigned wave_max_u32(unsigned v) {
    v = umax(v, (unsigned)sx_i<1>((int)v)); v = umax(v, (unsigned)sx_i<2>((int)v)); v = umax(v, (unsigned)sx_i<4>((int)v)); v = umax(v, (unsigned)sx_i<8>((int)v)); v = umax(v, (unsigned)sx_i<16>((int)v)); return max32(v);
}
template <int CTRL, int RMASK> __device__ __forceinline__ unsigned dpp_max_u(unsigned v) { const unsigned t = (unsigned)__builtin_amdgcn_update_dpp((int)v, (int)v, CTRL, RMASK, 0xF, false); return t > v ? t : v; }
__device__ __forceinline__ unsigned wave_max_dpp(unsigned v) {
    v = dpp_max_u<0xB1, 0xF>(v); v = dpp_max_u<0x4E, 0xF>(v); v = dpp_max_u<0x141, 0xF>(v); v = dpp_max_u<0x140, 0xF>(v); v = dpp_max_u<0x142, 0xA>(v); v = dpp_max_u<0x143, 0xC>(v);
    return (unsigned)__builtin_amdgcn_readlane((int)v, 63);
}
template <int CTRL> __device__ __forceinline__ float dpp_add_f(float v) { return v + __int_as_float(__builtin_amdgcn_update_dpp(__float_as_int(v), __float_as_int(v), CTRL, 0xF, 0xF, false)); }
__device__ __forceinline__ float row_sum16(float v) { v = dpp_add_f<0xB1>(v); v = dpp_add_f<0x4E>(v); v = dpp_add_f<0x141>(v); return dpp_add_f<0x140>(v); }
__device__ __forceinline__ unsigned row_max16_u(unsigned v) { v = dpp_max_u<0xB1, 0xF>(v); v = dpp_max_u<0x4E, 0xF>(v); v = dpp_max_u<0x141, 0xF>(v); return dpp_max_u<0x140, 0xF>(v); }
template <int CTRL> __device__ __forceinline__ float dpp_maxf(float v) { return fmaxf(v, __int_as_float(__builtin_amdgcn_update_dpp(__float_as_int(v), __float_as_int(v), CTRL, 0xF, 0xF, false))); }
__device__ __forceinline__ float row_max16_f(float v) { v = dpp_maxf<0xB1>(v); v = dpp_maxf<0x4E>(v); v = dpp_maxf<0x141>(v); return dpp_maxf<0x140>(v); }
__device__ __forceinline__ float okey_inv(unsigned k) { return __uint_as_float((k & 0x80000000u) ? (k & 0x7fffffffu) : ~k); }
#define CE_DESC(a, b) do { const unsigned hi_ = (a) > (b) ? (a) : (b), lo_ = (a) > (b) ? (b) : (a); (a) = hi_; (b) = lo_; } while (0)
__device__ __forceinline__ unsigned okey(float f) { const unsigned u = __float_as_uint(f); return (u & 0x80000000u) ? ~u : (u | 0x80000000u); }

__device__ __forceinline__ void transpose_item(const float* W, int N, bf16* WT, int ldo, int col_off, LAS float* scr, int item, int lane, int row_delta = 0) {
    const int nblk = N / 32, kb = item / nblk, nb = item % nblk, k0 = 64 * kb, n0 = 32 * nb;
#pragma unroll 8
    for (int i = 0; i < 32; ++i) { const int kk = 2 * i + (lane >> 5); scr[kk * 33 + (lane & 31)] = W[(size_t)(k0 + kk) * N + n0 + (lane & 31)]; }
    LDS_WAIT(); asm volatile("" ::: "memory");
    const int c = lane & 7;
#pragma unroll
    for (int j = 0; j < 4; ++j) { const int n = (lane >> 3) + 8 * j; const LAS float* s = scr + (8 * c) * 33 + n;
        v4u o; o.x = pk2(s[0 * 33], s[1 * 33]); o.y = pk2(s[2 * 33], s[3 * 33]); o.z = pk2(s[4 * 33], s[5 * 33]); o.w = pk2(s[6 * 33], s[7 * 33]);
        *(GAS v4u*)(WT + (size_t)(n0 + n + row_delta) * ldo + col_off + k0 + 8 * c) = o; }
    LDS_WAIT(); asm volatile("" ::: "memory");
}
__device__ __forceinline__ void transpose_item_fp8(const float* W, int N, int ncol0, unsigned char* WT8, int ldo, float scale, LAS float* scr, int item, int lane) {
    const int nblk = N / 32, kb = item / nblk, nb = item % nblk, k0 = 64 * kb, n0 = 32 * nb;
#pragma unroll 8
    for (int i = 0; i < 32; ++i) { const int kk = 2 * i + (lane >> 5); scr[kk * 33 + (lane & 31)] = W[(size_t)(k0 + kk) * N + n0 + (lane & 31)]; }
    LDS_WAIT(); asm volatile("" ::: "memory");
    const int c = lane & 3;
#pragma unroll
    for (int j = 0; j < 2; ++j) { const int n = (lane >> 2) + 16 * j; const LAS float* s = scr + (16 * c) * 33 + n; v4u o; int w;
        w = __builtin_amdgcn_cvt_pk_fp8_f32(s[0 * 33] * scale, s[1 * 33] * scale, 0, false); w = __builtin_amdgcn_cvt_pk_fp8_f32(s[2 * 33] * scale, s[3 * 33] * scale, w, true); o.x = (unsigned)w;
        w = __builtin_amdgcn_cvt_pk_fp8_f32(s[4 * 33] * scale, s[5 * 33] * scale, 0, false); w = __builtin_amdgcn_cvt_pk_fp8_f32(s[6 * 33] * scale, s[7 * 33] * scale, w, true); o.y = (unsigned)w;
        w = __builtin_amdgcn_cvt_pk_fp8_f32(s[8 * 33] * scale, s[9 * 33] * scale, 0, false); w = __builtin_amdgcn_cvt_pk_fp8_f32(s[10 * 33] * scale, s[11 * 33] * scale, w, true); o.z = (unsigned)w;
        w = __builtin_amdgcn_cvt_pk_fp8_f32(s[12 * 33] * scale, s[13 * 33] * scale, 0, false); w = __builtin_amdgcn_cvt_pk_fp8_f32(s[14 * 33] * scale, s[15 * 33] * scale, w, true); o.w = (unsigned)w;
        *(GAS v4u*)(WT8 + (size_t)(n0 + n - ncol0) * ldo + k0 + 16 * c) = o; }
    LDS_WAIT(); asm volatile("" ::: "memory");
}
template <bool FP8> __device__ __forceinline__ void rms_row_to_bf16(const float* xrow, const float* g, bf16* orow, unsigned char* o8row, int lane) {
    const GAS f32x4* xr = (const GAS f32x4*)xrow + lane; const GAS f32x4* gr = (const GAS f32x4*)g + lane;
    f32x4 v[8]; float s = 0.f;
#pragma unroll
    for (int j = 0; j < 8; ++j) { v[j] = xr[64 * j]; s += (v[j].x * v[j].x + v[j].y * v[j].y) + (v[j].z * v[j].z + v[j].w * v[j].w); }
    const float rstd = 1.0f / sqrtf(wave_sum(s) * (1.f / DM) + RMS_EPS);
    GAS unsigned long long* o8 = (GAS unsigned long long*)orow + lane;
#pragma unroll
    for (int j = 0; j < 8; ++j) { const f32x4 gg = gr[64 * j]; const float a = v[j].x * rstd * gg.x, b = v[j].y * rstd * gg.y, c = v[j].z * rstd * gg.z, d = v[j].w * rstd * gg.w;
        o8[64 * j] = (unsigned long long)pk2(a, b) | ((unsigned long long)pk2(c, d) << 32);
        if (FP8) { int w = __builtin_amdgcn_cvt_pk_fp8_f32(a * 32.f, b * 32.f, 0, false); w = __builtin_amdgcn_cvt_pk_fp8_f32(c * 32.f, d * 32.f, w, true); ((GAS unsigned*)o8row)[lane + 64 * j] = (unsigned)w; } }
}
typedef __bf16 bf2_t __attribute__((ext_vector_type(2)));
__device__ __forceinline__ float DOT2(unsigned a, unsigned b, float c) { return __builtin_amdgcn_fdot2_f32_bf16(__builtin_bit_cast(bf2_t, a), __builtin_bit_cast(bf2_t, b), c, false); }
__device__ __forceinline__ unsigned q8x4(float a, float b, float c, float d, float inv) {
    const int ia = (int)__builtin_rintf(a * inv), ib = (int)__builtin_rintf(b * inv), ic = (int)__builtin_rintf(c * inv), id = (int)__builtin_rintf(d * inv);
    return (unsigned)(ia & 0xff) | ((unsigned)(ib & 0xff) << 8) | ((unsigned)(ic & 0xff) << 16) | ((unsigned)(id & 0xff) << 24);
}
__device__ __forceinline__ float wave_maxf(float v) {
    v = fmaxf(v, sx_f<1>(v)); v = fmaxf(v, sx_f<2>(v)); v = fmaxf(v, sx_f<4>(v)); v = fmaxf(v, sx_f<8>(v)); v = fmaxf(v, sx_f<16>(v));
    auto rr = __builtin_amdgcn_permlane32_swap(__float_as_uint(v), __float_as_uint(v), false, false); return fmaxf(__uint_as_float(rr[0]), __uint_as_float(rr[1]));
}
__device__ __forceinline__ int rel_bucket(int rel) {
    const int n = rel < 0 ? -rel : rel;
    int b = n;
    if (n >= 8) { b = 5 + (31 - __builtin_clz((unsigned)n)); if (b > 15) b = 15; }
    return b + (rel > 0 ? 16 : 0);
}

#ifndef PH_D1
#define PH_D1 1
#endif
#ifndef PH_D2
#define PH_D2 1
#endif
#ifndef PH_A
#define PH_A 1
#endif
#ifndef PH_B
#define PH_B 1
#endif
#ifndef PH_C
#define PH_C 1
#endif
#ifndef PH_D
#define PH_D 1
#endif
#ifndef PH_E
#define PH_E 1
#endif
#ifndef PH_F
#define PH_F 1
#endif
#ifndef PH_G
#define PH_G 1
#endif
#ifndef PH_H
#define PH_H 1
#endif
#ifndef PH_I
#define PH_I 1
#endif
#ifndef PH_J
#define PH_J 1
#endif
#ifndef PH_K
#define PH_K 1
#endif
#ifndef PH_L
#define PH_L 1
#endif
struct Args { const float* in[17]; float* out; unsigned char* ws; };

#define CAS __attribute__((address_space(4)))
__device__ __forceinline__ const void* karg(int k) { const CAS char* ka = (const CAS char*)__builtin_amdgcn_kernarg_segment_ptr(); asm volatile("" : "+s"(ka)); return *(const void* const CAS*)(ka + 8 * k); }
#define WSP(T, off) ((T*)((unsigned char*)karg(18) + (off)))
#define INP(k) ((const float*)karg(k))
#define INL(k, stride) (INP(k) + (size_t)layer * (size_t)(stride))
#define X ((float*)karg(17))
__global__ void __launch_bounds__(NWAVES * 64, 2) mk_fwd(Args args_unused) {
    extern __shared__ __attribute__((aligned(16))) unsigned char lds[];
    LAS unsigned char* ldsl = (LAS unsigned char*)lds;
    volatile LAS unsigned* MISC = (volatile LAS unsigned*)(ldsl + MISC_OFF);
    const int wave0 = __builtin_amdgcn_readfirstlane((int)threadIdx.x >> 6);
    const int G = gridDim.x; const int bx = blockIdx.x; const int vcu = (G % 8 == 0) ? (bx % 8) * (G / 8) + bx / 8 : bx;
    const int NGW = G * NWAVES, NGT = NGW * 64;
#define PH_IDS() const int tid = opaque_tid(wave0), lane = tid & 63, wave = wave0, gw = vcu * NWAVES + wave, gt = gw * 64 + lane; (void)gt; (void)gw; (void)lane
    gu32* ctl = (gu32*)WSP(unsigned char, WS_CTL);
    for (int u = threadIdx.x; u < (LDS_BYTES - LDSCTL_OFF) / 4; u += NWAVES * 64) ((LAS unsigned*)(ldsl + LDSCTL_OFF))[u] = 0u;
    __syncthreads();
    XcdBarrier bar = xcd_barrier_post((unsigned*)(ctl + CW_BAR), MISC + 8);
    if (threadIdx.x == 0) MISC[1] = __hip_atomic_fetch_add(ctl + CW_XRANK + 64 * (int)(xb_xcc_id() & 7u), 1u, __ATOMIC_RELAXED, __HIP_MEMORY_SCOPE_AGENT);
#define GRID_BAR() xcd_barrier(bar)

    for (int layer = 0; layer < 2; ++layer) {

#if PH_A
        {
            PH_IDS();
            LAS float* scr = (LAS float*)(ldsl + wave * 16384);
            const float* w_in = INL(4, (size_t)DM * INW); const float* w_up_a = INL(6, 512 * DM); const float* w_up_b = INL(7, 512 * DM); const float* w_up_c = INL(8, 1024 * DM);
            const float* w_o = INL(11, DM * DM); const float* wq = INL(13, DM * DM); const float* subk = INL(14, 2 * 128 * 128);
            const float* pu = INL(15, (size_t)NEXP * DM); const float* pv = INL(16, (size_t)NEXP * DM); const float* mix_g = INL(3, DM); const float* rel_bias = INP(1);
            bf16* WIN = WSP(bf16, WS_WIN); bf16* WCAT = WSP(bf16, WS_WCAT); bf16* WO = WSP(bf16, WS_WO); bf16* WQ = WSP(bf16, WS_WQ); unsigned char* U8 = WSP(unsigned char, WS_U); unsigned char* V8 = WSP(unsigned char, WS_V);
            bf16* SKBD = WSP(bf16, WS_SKBD); bf16* H = WSP(bf16, WS_H); bf16* DFT = WSP(bf16, WS_DFT); bf16* CS = WSP(bf16, WS_CS); float* TAB = WSP(float, WS_TAB);
            constexpr int I_IN = (DM / 64) * (INW / 32), I_A = (512 / 64) * (DM / 32), I_C = (1024 / 64) * (DM / 32), I_SQ = (DM / 64) * (DM / 32);
            constexpr int NITEMS = I_IN + 2 * I_A + I_C + 2 * I_SQ;
            for (int it = gw; it < NITEMS; it += NGW) {
                int r = it;
                if (r < I_IN) { const int ct = ((r % (INW / 32)) * 32) >> 8;
                    if (ct < 2) transpose_item(w_in, INW, WIN, DM, 0, scr, r, lane); else if (ct >= 20 && ct < 32) transpose_item(w_in, INW, WIN, DM, 0, scr, r, lane, -18 * 256);
                    else transpose_item_fp8(w_in, INW, ct < 20 ? 2 * 256 : 14 * 256, WSP(unsigned char, WS_WG8), DM, 1024.f, scr, r, lane);
                    continue; } r -= I_IN;
                if (r < I_A) { transpose_item(w_up_a, DM, WCAT, DM, 0, scr, r, lane); continue; } r -= I_A;
                if (r < I_A) { transpose_item(w_up_b, DM, WCAT, DM, 512, scr, r, lane); continue; } r -= I_A;
                if (r < I_C) { transpose_item(w_up_c, DM, WCAT, DM, 1024, scr, r, lane); continue; } r -= I_C;
                if (r < I_SQ) { transpose_item(w_o, DM, WO, DM, 0, scr, r, lane); continue; } r -= I_SQ;
                transpose_item(wq, DM, WQ, DM, 0, scr, r, lane);
            }
            for (size_t i = (size_t)gt; i < (size_t)NEXP * DM / 16; i += (size_t)NGT) {
                const GAS f32x4* src = (const GAS f32x4*)pv + 4 * i; const float sc = 64.f;
                const f32x4 a = src[0], b = src[1], c = src[2], d = src[3]; v4u o; int w;
                w = __builtin_amdgcn_cvt_pk_fp8_f32(a.x * sc, a.y * sc, 0, false); w = __builtin_amdgcn_cvt_pk_fp8_f32(a.z * sc, a.w * sc, w, true); o.x = (unsigned)w;
                w = __builtin_amdgcn_cvt_pk_fp8_f32(b.x * sc, b.y * sc, 0, false); w = __builtin_amdgcn_cvt_pk_fp8_f32(b.z * sc, b.w * sc, w, true); o.y = (unsigned)w;
                w = __builtin_amdgcn_cvt_pk_fp8_f32(c.x * sc, c.y * sc, 0, false); w = __builtin_amdgcn_cvt_pk_fp8_f32(c.z * sc, c.w * sc, w, true); o.z = (unsigned)w;
                w = __builtin_amdgcn_cvt_pk_fp8_f32(d.x * sc, d.y * sc, 0, false); w = __builtin_amdgcn_cvt_pk_fp8_f32(d.z * sc, d.w * sc, w, true); o.w = (unsigned)w;
                ((GAS v4u*)V8)[i] = o;
            }
            { float* SU = WSP(float, WS_SU);
              for (int e = gw; e < NEXP; e += NGW) { const GAS f32x4* ur = (const GAS f32x4*)(pu + (size_t)e * DM) + lane; f32x4 y[8]; float mx = 0.f;
#pragma unroll
                for (int j = 0; j < 8; ++j) { y[j] = ur[64 * j]; mx = fmaxf(mx, fmaxf(fmaxf(fabsf(y[j].x), fabsf(y[j].y)), fmaxf(fabsf(y[j].z), fabsf(y[j].w)))); }
                mx = fmaxf(wave_maxf(mx), 1e-30f); const float inv = 127.f / mx;
#pragma unroll
                for (int j = 0; j < 8; ++j) ((GAS unsigned*)(U8 + (size_t)e * DM))[lane + 64 * j] = q8x4(y[j].x, y[j].y, y[j].z, y[j].w, inv);
                if (lane == 0) SU[e] = mx * (1.f / 127.f); } }
            for (int i = gt; i < 65536; i += NGT) { const int n = i >> 8, kk = i & 255, p = n >> 7; SKBD[i] = ((kk >> 7) == p) ? (bf16)f2bf(subk[(size_t)(p * 128 + (n & 127)) * 128 + (kk & 127)]) : (bf16)0; }
            for (int m = gw; m < MTOK; m += NGW) rms_row_to_bf16<true>((layer == 0 ? INP(0) : (const float*)X) + (size_t)m * DM, mix_g, H + (size_t)m * DM, WSP(unsigned char, WS_H8) + (size_t)m * DM, lane);
            if (layer == 0) {
                for (size_t i = (size_t)gt; i < (size_t)2304 * 8192 / 8; i += (size_t)NGT) {
                    const int sp = (int)(i >> 10), k0 = (int)(i & 1023) * 8, part = k0 >> 12, s0 = k0 & 4095; float v[8];
#pragma unroll
                    for (int j = 0; j < 8; ++j) { const float ang = (float)(((s0 + j) * sp) & 4095) * (1.f / 4096.f); v[j] = (part ? -__builtin_amdgcn_sinf(ang) : __builtin_amdgcn_cosf(ang)) * (1.f / 64.f); }
                    v4u o; o.x = pk2(v[0], v[1]); o.y = pk2(v[2], v[3]); o.z = pk2(v[4], v[5]); o.w = pk2(v[6], v[7]); ((GAS v4u*)DFT)[i] = o;
                }
                for (int i = gt; i < 65536; i += NGT) { const int r = i >> 8, c = i & 255, part = r >> 7, cp = r & 127; float v = 0.f;
                    if (c < 128) { const float ang = (float)((c * cp) & 127) * (1.f / 128.f); v = (part ? __builtin_amdgcn_sinf(ang) : __builtin_amdgcn_cosf(ang)) * 0.08838834764831845f; }
                    CS[i] = (bf16)f2bf(v); }
                for (int i = gt; i < 16 * 8192; i += NGT) { const int hd = i >> 13, off = (i & 8191) - 4096; float v;
                    if (hd < 12) { const int g = hd >> 2, dil = g == 0 ? 1 : (g == 1 ? 4 : 16); v = (off >= -64 && off <= 64) ? rel_bias[rel_bucket(off * dil) * 16 + hd] * 11.313708498984761f : -1.0e5f; }
                    else v = rel_bias[rel_bucket(off) * 16 + hd] * 11.313708498984761f;
                    TAB[i] = v; }
            }
        }
#endif
        GRID_BAR();

#if PH_B
        {
            { pg8::Gemm g{WSP(bf16, WS_H), WSP(bf16, WS_WIN)}; pg8::StaticOrder S; S.init(MTOK, 14 * 256, G, bx, DM, DM);
              pg8::EpiProj E{WSP(bf16, WS_PROJ), WSP(bf16, WS_G), INL(5, GTW), 2, 0, 18, 1.f};
              pg8::gemm_phase<pg8::EpiProj, pg8::StaticOrder, true, DM, DM, DM>(ldsl, g, S, E, wave0); }
            { pg8::Gemm g{WSP(bf16, WS_H8), WSP(bf16, WS_WG8)}; pg8::StaticOrder S; S.init(MTOK, 42 * 256, G, (bx + G / 2) % G, DM / 2, DM / 2);
              pg8::EpiProj E{WSP(bf16, WS_PROJ), WSP(bf16, WS_G), INL(5, GTW), 18, 2, 14, 1.f / 32768.f};
              pg8::gemm_phase<pg8::EpiProj, pg8::StaticOrder, true, DM / 2, DM / 2, DM / 2, true>(ldsl, g, S, E, wave0); }
        }
#endif
        GRID_BAR();

#if PH_C
        {
            pg8::Gemm g{WSP(bf16, WS_CS), WSP(bf16, WS_PROJ)}; pg8::F1Order S{G, bx};
            pg8::EpiZT E{WSP(bf16, WS_ZT)};
            pg8::gemm_phase<pg8::EpiZT, pg8::F1Order, false, 256, PJW, 256>(ldsl, g, S, E, wave0);
        }
#endif
        GRID_BAR();

#if PH_D
#if PH_D1
        {
            pg8::Gemm g{WSP(bf16, WS_DFT), WSP(bf16, WS_ZT)}; pg8::StaticOrder S; S.init(2304, 2048, G, bx, 8192, 8192);
            pg8::EpiF2 E{WSP(bf16, WS_OC)};
            pg8::gemm_phase<pg8::EpiF2, pg8::StaticOrder, false, 8192, 8192, 8192>(ldsl, g, S, E, wave0);
        }
#endif
#if PH_D2
        {
            PH_IDS();
            gu32* qhead = ctl + CW_QUEUE + 64 * layer;
            bf16* PROJ = WSP(bf16, WS_PROJ); bf16* DO = WSP(bf16, WS_MG); bf16* DL = WSP(bf16, WS_H); float* LSE = WSP(float, WS_LSE); const float* TAB = WSP(float, WS_TAB);
            const float* cur_tab = nullptr;
            for (;;) {
                __syncthreads();
                if (tid == 0) MISC[0] = __hip_atomic_fetch_add(qhead, 1u, __ATOMIC_RELAXED, __HIP_MEMORY_SCOPE_AGENT);
                __syncthreads();
                const int ui = __builtin_amdgcn_readfirstlane((int)MISC[0]);
                if (ui >= 1792) break;
                attn::Unit u; int hd;
                if (ui < 1024) {
                    const int qb = ui & 15, vh = (ui >> 4) & 1, m = (ui >> 5) & 1, h = (ui >> 6) & 3, b = ui >> 8;
                    const bf16* base = PROJ + (size_t)b * SEQ * PJW;
                    u.Q = base + (size_t)(qb * 256) * PJW + COL_DIFF + (h * 2 + m) * 128; u.K = base + COL_DIFF + 1024 + (h * 2 + m) * 128; u.V = base + COL_DIFF + 2048 + h * 256 + vh * 128;
                    u.O = DO + (size_t)(b * SEQ + qb * 256) * DM + (h * 2 + m) * 256 + vh * 128; u.lse = nullptr; u.ldq = PJW; u.ldk = PJW; u.ldo = DM; u.lse_ld = 0;
                    u.kt0 = 0; u.nt = SEQ / 64; u.qoff = qb * 256; hd = 12 + h;
                } else {
                    const int v = ui - 1024, qb16 = v & 15, hh = (v >> 4) & 3, bg = v >> 6, g = bg % 3, b = bg / 3;
                    const int dil = g == 0 ? 1 : (g == 1 ? 4 : 16), bpc = 16 / dil, r = qb16 / bpc, qblk = qb16 % bpc, q0 = qblk * 256, ntot = (SEQ / dil) / 64;
                    int kt0 = q0 / 64 - 1; if (kt0 < 0) kt0 = 0; int kt1 = q0 / 64 + 5; if (kt1 > ntot) kt1 = ntot;
                    if ((kt1 - kt0) & 1) { if (kt0 > 0) --kt0; else ++kt1; }
                    const bf16* base = PROJ + (size_t)(b * SEQ + r) * PJW + COL_DIL + g * 512 + hh * 128;
                    u.Q = base + (size_t)q0 * dil * PJW; u.K = base + 1536; u.V = base + 3072;
                    u.O = DL + ((size_t)g * MTOK + b * SEQ + r + (size_t)q0 * dil) * 512 + hh * 128; u.lse = LSE + ((size_t)g * MTOK + b * SEQ + r + (size_t)q0 * dil) * 4 + hh;
                    u.ldq = (long)PJW * dil; u.ldk = (long)PJW * dil; u.ldo = 512L * dil; u.lse_ld = 4 * dil; u.kt0 = kt0; u.nt = kt1 - kt0; u.qoff = q0; hd = g * 4 + hh;
                }
                const float* tab = TAB + (size_t)hd * 8192;
                if (tab != cur_tab) {
                    cur_tab = tab;
                    LAS f32x4* tl = (LAS f32x4*)(ldsl + attn::LDS_TAB); const int t2 = opaque_tid(wave0);
#pragma unroll
                    for (int j = 0; j < 4; ++j) tl[t2 + 512 * j] = ((const GAS f32x4*)tab)[t2 + 512 * j];
                }
                attn::attn_unit(u, (char*)lds, wave0);
            }
        }
#endif
#endif
        GRID_BAR();

#if PH_E
        {
            PH_IDS();
            const float* dlam = INL(9, 512); const float* subln = INL(10, 256); const float lambda_init = layer == 0 ? 0.2f : 0.35550906759f;
            const float* LSE = WSP(float, WS_LSE); const bf16* DL = WSP(bf16, WS_H); const bf16* DO = WSP(bf16, WS_MG); bf16* OC = WSP(bf16, WS_OC);
            float s1 = dlam[lane] * dlam[128 + lane] + dlam[64 + lane] * dlam[192 + lane], s2 = dlam[256 + lane] * dlam[384 + lane] + dlam[320 + lane] * dlam[448 + lane];
            s1 = wave_sum(s1); s2 = wave_sum(s2);
            const float lam = __expf(s1) - __expf(s2) + lambda_init, osc = 1.0f - lambda_init;
            const int hq = lane >> 4, l16 = lane & 15;
            for (int t = gw; t < MTOK; t += NGW) {
                float ls[3], mx = -3e38f;
#pragma unroll
                for (int g = 0; g < 3; ++g) { ls[g] = LSE[((size_t)g * MTOK + t) * 4 + hq]; mx = fmaxf(mx, ls[g]); }
                float wsum = 0.f;
#pragma unroll
                for (int g = 0; g < 3; ++g) { ls[g] = __expf(ls[g] - mx); wsum += ls[g]; }
                const float winv = 1.0f / wsum; float acc8[8] = {0.f, 0.f, 0.f, 0.f, 0.f, 0.f, 0.f, 0.f};
#pragma unroll
                for (int g = 0; g < 3; ++g) { const v4u o = *(const GAS v4u*)(DL + ((size_t)g * MTOK + t) * 512 + lane * 8); const float w = ls[g] * winv;
                    acc8[0] += w * bflo(o.x); acc8[1] += w * bfhi(o.x); acc8[2] += w * bflo(o.y); acc8[3] += w * bfhi(o.y); acc8[4] += w * bflo(o.z); acc8[5] += w * bfhi(o.z); acc8[6] += w * bflo(o.w); acc8[7] += w * bfhi(o.w); }
#if defined(DBG_ZERO_OB)
                for (int j = 0; j < 8; ++j) acc8[j] = 0.f;
#endif
                { v4u o; o.x = pk2(acc8[0], acc8[1]); o.y = pk2(acc8[2], acc8[3]); o.z = pk2(acc8[4], acc8[5]); o.w = pk2(acc8[6], acc8[7]); *(GAS v4u*)(OC + (size_t)t * DM + 512 + lane * 8) = o; }
                const bf16* dp = DO + (size_t)t * DM + hq * 512 + l16 * 16;
                const v4u a0 = *(const GAS v4u*)(dp), a1 = *(const GAS v4u*)(dp + 8), b0 = *(const GAS v4u*)(dp + 256), b1 = *(const GAS v4u*)(dp + 264);
                float d[16];
                d[0] = bflo(a0.x) - lam * bflo(b0.x); d[1] = bfhi(a0.x) - lam * bfhi(b0.x); d[2] = bflo(a0.y) - lam * bflo(b0.y); d[3] = bfhi(a0.y) - lam * bfhi(b0.y);
                d[4] = bflo(a0.z) - lam * bflo(b0.z); d[5] = bfhi(a0.z) - lam * bfhi(b0.z); d[6] = bflo(a0.w) - lam * bflo(b0.w); d[7] = bfhi(a0.w) - lam * bfhi(b0.w);
                d[8] = bflo(a1.x) - lam * bflo(b1.x); d[9] = bfhi(a1.x) - lam * bfhi(b1.x); d[10] = bflo(a1.y) - lam * bflo(b1.y); d[11] = bfhi(a1.y) - lam * bfhi(b1.y);
                d[12] = bflo(a1.z) - lam * bflo(b1.z); d[13] = bfhi(a1.z) - lam * bfhi(b1.z); d[14] = bflo(a1.w) - lam * bflo(b1.w); d[15] = bfhi(a1.w) - lam * bfhi(b1.w);
                float ss = 0.f;
#pragma unroll
                for (int j = 0; j < 16; ++j) ss += d[j] * d[j];
                ss += sx_f<1>(ss); ss += sx_f<2>(ss); ss += sx_f<4>(ss); ss += sx_f<8>(ss);
                const float rs = osc / sqrtf(ss * (1.f / 256.f) + RMS_EPS);
                const f32x4 g0 = *(const GAS f32x4*)(subln + l16 * 16), g1 = *(const GAS f32x4*)(subln + l16 * 16 + 4), g2 = *(const GAS f32x4*)(subln + l16 * 16 + 8), g3 = *(const GAS f32x4*)(subln + l16 * 16 + 12);
                v4u o0, o1;
                o0.x = pk2(d[0] * rs * g0.x, d[1] * rs * g0.y); o0.y = pk2(d[2] * rs * g0.z, d[3] * rs * g0.w); o0.z = pk2(d[4] * rs * g1.x, d[5] * rs * g1.y); o0.w = pk2(d[6] * rs * g1.z, d[7] * rs * g1.w);
                o1.x = pk2(d[8] * rs * g2.x, d[9] * rs * g2.y); o1.y = pk2(d[10] * rs * g2.z, d[11] * rs * g2.w); o1.z = pk2(d[12] * rs * g3.x, d[13] * rs * g3.y); o1.w = pk2(d[14] * rs * g3.z, d[15] * rs * g3.w);
                bf16* op = OC + (size_t)t * DM + 1024 + hq * 256 + l16 * 16;
                *(GAS v4u*)(op) = o0; *(GAS v4u*)(op + 8) = o1;
            }
        }
#endif
        GRID_BAR();

#if PH_F
        {
            pg8::MergeOrder S; S.init(MTOK, DM, G, bx, DM, DM);
            pg8::Gemm g{WSP(bf16, WS_OC), WSP(bf16, WS_WCAT)}; pg8::EpiMerge4 E{WSP(bf16, WS_G), WSP(bf16, WS_MG)};
            pg8::gemm_phase<pg8::EpiMerge4, pg8::MergeOrder, true, DM, DM, 512>(ldsl, g, S, E, wave0);
        }
#endif
        GRID_BAR();

#if PH_G
        {
            pg8::Gemm g{WSP(bf16, WS_MG), WSP(bf16, WS_WO)}; pg8::StaticOrder S; S.init(MTOK, DM, G, bx, DM, DM);
            pg8::EpiResF32 E{layer == 0 ? INP(0) : (const float*)X, X, DM};
            pg8::gemm_phase<pg8::EpiResF32, pg8::StaticOrder, true, DM, DM, DM>(ldsl, g, S, E, wave0);
        }
#endif
        GRID_BAR();

#if PH_H
        { PH_IDS(); const float* ffn_g = INL(12, DM); bf16* H = WSP(bf16, WS_H); unsigned char* H8 = WSP(unsigned char, WS_H8); float* SH = WSP(float, WS_SH);
          for (int m = gw; m < MTOK; m += NGW) {
            const GAS f32x4* xr = (const GAS f32x4*)(X + (size_t)m * DM) + lane; const GAS f32x4* gr = (const GAS f32x4*)ffn_g + lane;
            f32x4 v[8]; float ss = 0.f;
#pragma unroll
            for (int j = 0; j < 8; ++j) { v[j] = xr[64 * j]; ss += (v[j].x * v[j].x + v[j].y * v[j].y) + (v[j].z * v[j].z + v[j].w * v[j].w); }
            const float rstd = 1.0f / sqrtf(wave_sum(ss) * (1.f / DM) + RMS_EPS); float mx = 0.f;
#pragma unroll
            for (int j = 0; j < 8; ++j) { const f32x4 gg = gr[64 * j]; v[j] = v[j] * rstd * gg; mx = fmaxf(mx, fmaxf(fmaxf(fabsf(v[j].x), fabsf(v[j].y)), fmaxf(fabsf(v[j].z), fabsf(v[j].w)))); }
            mx = fmaxf(wave_maxf(mx), 1e-30f); const float inv = 127.f / mx;
            GAS unsigned long long* o8 = (GAS unsigned long long*)(H + (size_t)m * DM) + lane;
#pragma unroll
            for (int j = 0; j < 8; ++j) { o8[64 * j] = (unsigned long long)pk2(v[j].x, v[j].y) | ((unsigned long long)pk2(v[j].z, v[j].w) << 32);
                ((GAS unsigned*)(H8 + (size_t)m * DM))[lane + 64 * j] = q8x4(v[j].x, v[j].y, v[j].z, v[j].w, inv); }
            if (lane == 0) SH[m] = mx * (1.f / 127.f);
          } }
#endif
        GRID_BAR();

#if PH_I
        {
            pg8::Gemm g{WSP(bf16, WS_H), WSP(bf16, WS_WQ)}; pg8::StaticOrder S; S.init(MTOK, DM, G, bx, DM, DM);
            pg8::EpiStore E{WSP(bf16, WS_Q), DM};
            pg8::gemm_phase<pg8::EpiStore, pg8::StaticOrder, true, DM, DM, DM>(ldsl, g, S, E, wave0);
        }
#endif
        GRID_BAR();

#if PH_J
        {
            pg8::Gemm g{WSP(bf16, WS_Q), WSP(bf16, WS_SKBD)}; pg8::StaticOrder S; S.init(MTOK * 8, 256, G, bx, 256, 256);
            pg8::EpiResF32 E{nullptr, WSP(float, WS_SC), 256};
            pg8::gemm_phase<pg8::EpiResF32, pg8::StaticOrder, true, 256, 256, 256>(ldsl, g, S, E, wave0);
        }
#endif
        GRID_BAR();

#if PH_K
        {
            PH_IDS();
            const float* SC = WSP(float, WS_SC); int* IDS = WSP(int, WS_IDS); float* GATES = WSP(float, WS_GATES);
            const int l16 = lane & 15, rbase = lane & 48;
            int cq[4];
#pragma unroll
            for (int q = 0; q < 4; ++q) { int c = l16 + 16 * q, ci = -1, cj = 0; for (int i = 0; i < 16; ++i) { const int cnt = 16 / (i + 1); if (ci < 0) { if (c < cnt) { ci = i; cj = c; } else c -= cnt; } } cq[q] = ci < 0 ? -1 : ci * 16 + cj; }
            for (int row4 = gw * 4; row4 < MTOK * 8; row4 += NGW * 4) {
                const int row = row4 + (lane >> 4);
                const float* sc = SC + (size_t)row * 256 + l16;
                unsigned ka[8], kb[8];
#pragma unroll
                for (int jj = 0; jj < 8; ++jj) { ka[jj] = (okey(sc[jj * 16]) & ~127u) | (unsigned)(127 - (jj * 16 + l16)); kb[jj] = (okey(sc[128 + jj * 16]) & ~127u) | (unsigned)(127 - (jj * 16 + l16)); }
#define SORT8(k) do { CE_DESC(k[0], k[1]); CE_DESC(k[2], k[3]); CE_DESC(k[4], k[5]); CE_DESC(k[6], k[7]); CE_DESC(k[0], k[2]); CE_DESC(k[1], k[3]); CE_DESC(k[4], k[6]); CE_DESC(k[5], k[7]); \
    CE_DESC(k[1], k[2]); CE_DESC(k[5], k[6]); CE_DESC(k[0], k[4]); CE_DESC(k[3], k[7]); CE_DESC(k[1], k[5]); CE_DESC(k[2], k[6]); CE_DESC(k[1], k[4]); CE_DESC(k[3], k[6]); \
    CE_DESC(k[2], k[4]); CE_DESC(k[3], k[5]); CE_DESC(k[3], k[4]); } while (0)
                SORT8(ka); SORT8(kb);
                unsigned ta = 0u, tb = 0u;
#pragma unroll
                for (int r = 0; r < 16; ++r) {
                    const unsigned ma = row_max16_u(ka[0]), mb = row_max16_u(kb[0]);
                    const bool wa = ka[0] == ma, wb = kb[0] == mb;
                    ta = (l16 == r) ? ma : ta; tb = (l16 == r) ? mb : tb;
#pragma unroll
                    for (int q = 0; q < 7; ++q) { ka[q] = wa ? ka[q + 1] : ka[q]; kb[q] = wb ? kb[q + 1] : kb[q]; }
                    ka[7] = wa ? 0u : ka[7]; kb[7] = wb ? 0u : kb[7];
                }
                const int ia = 127 - (int)(ta & 127u), ib = 127 - (int)(tb & 127u);
                const float va = okey_inv(ta & ~127u), vb = okey_inv(tb & ~127u);
                unsigned ck[4];
#pragma unroll
                for (int q = 0; q < 4; ++q) { const int cc = cq[q] < 0 ? 0 : cq[q]; const float cs = bperm_f(va, rbase + (cc >> 4)) + bperm_f(vb, rbase + (cc & 15));
                    ck[q] = cq[q] < 0 ? 0u : ((okey(cs) & ~255u) | (unsigned)(255 - cc)); }
                CE_DESC(ck[0], ck[1]); CE_DESC(ck[2], ck[3]); CE_DESC(ck[0], ck[2]); CE_DESC(ck[1], ck[3]); CE_DESC(ck[1], ck[2]);
                unsigned tw = 0u;
#pragma unroll
                for (int r = 0; r < 16; ++r) { const unsigned mm = row_max16_u(ck[0]); const bool w = ck[0] == mm; tw = (l16 == r) ? mm : tw;
                    ck[0] = w ? ck[1] : ck[0]; ck[1] = w ? ck[2] : ck[1]; ck[2] = w ? ck[3] : ck[2]; ck[3] = w ? 0u : ck[3]; }
                const int code = 255 - (int)(tw & 255u), wi = (code >> 4) & 15, wj = code & 15;
                const float bs = bperm_f(va, rbase + wi) + bperm_f(vb, rbase + wj);
                const int eid = bperm_i(ia, rbase + wi) * 128 + bperm_i(ib, rbase + wj);
                const float mx = row_max16_f(bs), e = __expf(bs - mx), es = row_sum16(e);
                IDS[(size_t)row * 16 + l16] = eid; GATES[(size_t)row * 16 + l16] = e / es;
            }
#undef SORT8
        }
#endif
        GRID_BAR();

#if PH_L
#define L_LDIDS(I, tt, hh) do { const GAS v4u* ip_ = (const GAS v4u*)(IDS + (size_t)(tt) * 128 + (hh) * 64 + lrow * 16); I##0 = ip_[0]; I##1 = ip_[1]; I##2 = ip_[2]; I##3 = ip_[3]; } while (0)
#define L_ISSUE(W, I, base) do { \
    W[0] = *(const GAS v4u*)((base) + (size_t)(I##0).x * DM); W[1] = *(const GAS v4u*)((base) + (size_t)(I##0).y * DM); W[2] = *(const GAS v4u*)((base) + (size_t)(I##0).z * DM); W[3] = *(const GAS v4u*)((base) + (size_t)(I##0).w * DM); \
    W[4] = *(const GAS v4u*)((base) + (size_t)(I##1).x * DM); W[5] = *(const GAS v4u*)((base) + (size_t)(I##1).y * DM); W[6] = *(const GAS v4u*)((base) + (size_t)(I##1).z * DM); W[7] = *(const GAS v4u*)((base) + (size_t)(I##1).w * DM); \
    W[8] = *(const GAS v4u*)((base) + (size_t)(I##2).x * DM); W[9] = *(const GAS v4u*)((base) + (size_t)(I##2).y * DM); W[10] = *(const GAS v4u*)((base) + (size_t)(I##2).z * DM); W[11] = *(const GAS v4u*)((base) + (size_t)(I##2).w * DM); \
    W[12] = *(const GAS v4u*)((base) + (size_t)(I##3).x * DM); W[13] = *(const GAS v4u*)((base) + (size_t)(I##3).y * DM); W[14] = *(const GAS v4u*)((base) + (size_t)(I##3).z * DM); W[15] = *(const GAS v4u*)((base) + (size_t)(I##3).w * DM); } while (0)
#define L_CVT(d, hi) __builtin_amdgcn_cvt_pk_f32_fp8((int)(d), (hi))
        {
            PH_IDS();
            const unsigned char* H8 = WSP(unsigned char, WS_H8); const unsigned char* U8 = WSP(unsigned char, WS_U); const int* IDS = WSP(int, WS_IDS); float* PART = WSP(float, WS_G);
            typedef float f32x2 __attribute__((ext_vector_type(2)));
            const int myx = (int)(xb_xcc_id() & 7u); int nx = 0, xi = 0, nloc = 1;
            for (int j = 0; j < 8; ++j) { const int c = (int)__hip_atomic_load(ctl + CW_XRANK + 64 * j, __ATOMIC_RELAXED, __HIP_MEMORY_SCOPE_AGENT); if (c > 0) { ++nx; if (j < myx) ++xi; } if (j == myx) nloc = c; }
            const int rw = (int)MISC[1] * NWAVES + wave, nW = nloc * NWAVES; const int l16 = lane & 15, lrow = lane >> 4;
#define L1_COMPUTE(W, dst) do { float sk[16]; _Pragma("unroll") for (int k = 0; k < 16; ++k) { const v4u ww = W[k]; int ac = 0; \
        ac = __builtin_amdgcn_sdot4((int)ww.x, (int)h0.x, ac, false); ac = __builtin_amdgcn_sdot4((int)ww.y, (int)h0.y, ac, false); ac = __builtin_amdgcn_sdot4((int)ww.z, (int)h0.z, ac, false); ac = __builtin_amdgcn_sdot4((int)ww.w, (int)h0.w, ac, false); \
        sk[k] = (float)ac; } \
          \
        float t8[8]; _Pragma("unroll") for (int j = 0; j < 8; ++j) { const float keep = b8 ? sk[8 + j] : sk[j], send = b8 ? sk[j] : sk[8 + j]; \
            t8[j] = keep + __int_as_float(__builtin_amdgcn_update_dpp(0, __float_as_int(send), 0x128, 0xF, 0xF, false)); } \
        float t4[4]; _Pragma("unroll") for (int j = 0; j < 4; ++j) { const float keep = b4 ? t8[4 + j] : t8[j], send = b4 ? t8[j] : t8[4 + j]; t4[j] = keep + sx_f<4>(send); } \
        float t2[2]; _Pragma("unroll") for (int j = 0; j < 2; ++j) { const float keep = b2 ? t4[2 + j] : t4[j], send = b2 ? t4[j] : t4[2 + j]; \
            t2[j] = keep + __int_as_float(__builtin_amdgcn_update_dpp(0, __float_as_int(send), 0x4E, 0xF, 0xF, false)); } \
        { const float keep = b1 ? t2[1] : t2[0], send = b1 ? t2[0] : t2[1]; dst = keep + __int_as_float(__builtin_amdgcn_update_dpp(0, __float_as_int(send), 0xB1, 0xF, 0xF, false)); } } while (0)
            const bool b8 = (lane & 8) != 0, b4 = (lane & 4) != 0, b2 = (lane & 2) != 0, b1 = (lane & 1) != 0;
            for (int sl = xi; sl < 8; sl += nx) {
                const unsigned char* ub = U8 + sl * 256 + l16 * 16; const unsigned char* hb = H8 + sl * 256 + l16 * 16;
                int t = rw;
                if (t < MTOK) {
                    v4u Wa[16], Wb[16]; v4u ia0, ia1, ia2, ia3, ib0, ib1, ib2, ib3; v4u h0;
                    L_LDIDS(ia, t, 0); L_LDIDS(ib, t, 1); h0 = *(const GAS v4u*)(hb + (size_t)t * DM);
                    L_ISSUE(Wa, ia, ub);
                    for (;;) {
                        const int tn = t + nW; const bool more = tn < MTOK; const int tp = more ? tn : t;
                        L_ISSUE(Wb, ib, ub);
                        L_LDIDS(ia, tp, 0); const v4u hn0 = *(const GAS v4u*)(hb + (size_t)tp * DM);
                        float pre0, pre1;
                        L1_COMPUTE(Wa, pre0);
                        L_ISSUE(Wa, ia, ub);
                        L_LDIDS(ib, tp, 1);
                        L1_COMPUTE(Wb, pre1);
                        float* pp = PART + ((size_t)sl * MTOK + t) * 128; pp[lane] = pre0; pp[64 + lane] = pre1;
                        h0 = hn0;
                        if (!more) break;
                        t = tn;
                    }
                }
            }
#undef L1_COMPUTE
        }
        GRID_BAR();
        {
            PH_IDS();
            const float* PART = WSP(float, WS_G); const float* GATES = WSP(float, WS_GATES); float* ACTW = WSP(float, WS_ACT);
            for (int t = gw; t < MTOK; t += NGW) {
                float q0 = 0.f, q1 = 0.f;
#pragma unroll
                for (int s8 = 0; s8 < 8; ++s8) { const float* pp = PART + ((size_t)s8 * MTOK + t) * 128; q0 += pp[lane]; q1 += pp[64 + lane]; }
                { const int* ip = WSP(int, WS_IDS) + (size_t)t * 128; const float sh = WSP(float, WS_SH)[t]; const float* SU = WSP(float, WS_SU); q0 *= SU[ip[lane]] * sh; q1 *= SU[ip[64 + lane]] * sh; }
                const float* gp = GATES + (size_t)t * 128; float* ap = ACTW + (size_t)t * 128;
                const float g0 = gp[lane], g1 = gp[64 + lane];
                ap[lane] = 0.5f * q0 * (1.0f + erff(q0 * 0.70710678118654752f)) * g0 * (1.f / 64.f); ap[64 + lane] = 0.5f * q1 * (1.0f + erff(q1 * 0.70710678118654752f)) * g1 * (1.f / 64.f);
            }
        }
        GRID_BAR();
        {
            PH_IDS();
            const unsigned char* V8 = WSP(unsigned char, WS_V); const int* IDS = WSP(int, WS_IDS); const float* ACT = WSP(float, WS_ACT);
            typedef float f32x2 __attribute__((ext_vector_type(2)));
            const int myx = (int)(xb_xcc_id() & 7u); int nx = 0, xi = 0, nloc = 1;
            for (int j = 0; j < 8; ++j) { const int c = (int)__hip_atomic_load(ctl + CW_XRANK + 64 * j, __ATOMIC_RELAXED, __HIP_MEMORY_SCOPE_AGENT); if (c > 0) { ++nx; if (j < myx) ++xi; } if (j == myx) nloc = c; }
            const int rw = (int)MISC[1] * NWAVES + wave, nW = nloc * NWAVES; const int l16 = lane & 15, lrow = lane >> 4;
#if DBG_MODE == 2
            float* XO = WSP(float, WS_OC);
#else
            float* XO = X;
#endif
#define L2_COMPUTE(W, acr) do { float av[16]; _Pragma("unroll") for (int k = 0; k < 16; ++k) av[k] = bperm_f(acr, (lane & 48) + k); \
        _Pragma("unroll") for (int k = 0; k < 16; ++k) { const float a = av[k]; const f32x2 aa = (f32x2){a, a}; \
        const v4u ww = W[k]; const unsigned d0 = ww.x, d1 = ww.y, d2 = ww.z, d3 = ww.w; \
        oacc[0] += aa * L_CVT(d0, false); oacc[1] += aa * L_CVT(d0, true); oacc[2] += aa * L_CVT(d1, false); oacc[3] += aa * L_CVT(d1, true); \
        oacc[4] += aa * L_CVT(d2, false); oacc[5] += aa * L_CVT(d2, true); oacc[6] += aa * L_CVT(d3, false); oacc[7] += aa * L_CVT(d3, true); } } while (0)
            for (int sl = xi; sl < 8; sl += nx) {
                const unsigned char* vb = V8 + sl * 256 + l16 * 16; float* xb = XO + sl * 256 + l16 * 16;
                int t = rw;
                if (t < MTOK) {
                    v4u Wa[16], Wb[16]; v4u ia0, ia1, ia2, ia3, ib0, ib1, ib2, ib3; float ac0, ac1;
                    L_LDIDS(ia, t, 0); L_LDIDS(ib, t, 1); ac0 = ACT[(size_t)t * 128 + lane]; ac1 = ACT[(size_t)t * 128 + 64 + lane];
                    L_ISSUE(Wa, ia, vb);
                    for (;;) {
                        const int tn = t + nW; const bool more = tn < MTOK; const int tp = more ? tn : t;
                        L_ISSUE(Wb, ib, vb);
                        L_LDIDS(ia, tp, 0); const float an0 = ACT[(size_t)tp * 128 + lane], an1 = ACT[(size_t)tp * 128 + 64 + lane];
                        f32x2 oacc[8];
#pragma unroll
                        for (int k = 0; k < 8; ++k) oacc[k] = (f32x2){0.f, 0.f};
                        L2_COMPUTE(Wa, ac0);
                        L_ISSUE(Wa, ia, vb);
                        L_LDIDS(ib, tp, 1);
                        f32x4 xv[4]; { const GAS f32x4* q = (const GAS f32x4*)(xb + (size_t)t * DM); xv[0] = q[0]; xv[1] = q[1]; xv[2] = q[2]; xv[3] = q[3]; }
                        L2_COMPUTE(Wb, ac1);
#pragma unroll
                        for (int k = 0; k < 8; ++k) { float a = oacc[k].x, b = oacc[k].y; a += sx_f<16>(a); b += sx_f<16>(b); a = add32(a); b = add32(b); oacc[k] = (f32x2){a, b}; }
                        if (lane < 16) { GAS f32x4* q = (GAS f32x4*)(xb + (size_t)t * DM);
#pragma unroll
                            for (int k = 0; k < 4; ++k) { f32x4 v = xv[k];
#if DBG_MODE == 2
                                v = (f32x4){0.f, 0.f, 0.f, 0.f};
#endif
                                v.x += oacc[2 * k].x; v.y += oacc[2 * k].y; v.z += oacc[2 * k + 1].x; v.w += oacc[2 * k + 1].y; q[k] = v; } }
                        ac0 = an0; ac1 = an1;
                        if (!more) break;
                        t = tn;
                    }
                }
            }
#undef L2_COMPUTE
        }
#undef L_LDIDS
#undef L_ISSUE
#undef L_CVT
#endif
        GRID_BAR();
    }

    { PH_IDS();
    for (int m = gw; m < MTOK; m += NGW) {
        GAS f32x4* xr = (GAS f32x4*)(X + (size_t)m * DM) + lane; const GAS f32x4* gr = (const GAS f32x4*)INP(2) + lane;
        f32x4 v[8]; float s = 0.f;
#pragma unroll
        for (int j = 0; j < 8; ++j) { v[j] = xr[64 * j]; s += (v[j].x * v[j].x + v[j].y * v[j].y) + (v[j].z * v[j].z + v[j].w * v[j].w); }
        const float rstd = 1.0f / sqrtf(wave_sum(s) * (1.f / DM) + RMS_EPS);
#pragma unroll
        for (int j = 0; j < 8; ++j) { const f32x4 gg = gr[64 * j]; xr[64 * j] = v[j] * rstd * gg; }
    } }
}

extern "C" void kernel_launch(void* const* d_in, const int* in_sizes, int n_in, void* d_out, int out_size, void* d_ws, size_t ws_size, hipStream_t stream) {
    static int grid = 0;
    if (grid == 0) {
        if (n_in != 17 || in_sizes[0] != MTOK * DM || out_size != MTOK * DM || ws_size < WS_END) {
            fprintf(stderr, "kernel_launch: shape/workspace mismatch: n_in %d in0 %d out %d ws %zu (need %zu); nothing launched\n", n_in, n_in > 0 ? in_sizes[0] : -1, out_size, ws_size, (size_t)WS_END); grid = -1; return; }
        int dev = 0, cus = 0, per_cu = 0;
        if (hipGetDevice(&dev) != hipSuccess || hipDeviceGetAttribute(&cus, hipDeviceAttributeMultiprocessorCount, dev) != hipSuccess) { grid = -1; return; }
        if (hipFuncSetAttribute((const void*)mk_fwd, hipFuncAttributeMaxDynamicSharedMemorySize, LDS_BYTES) != hipSuccess) { fprintf(stderr, "kernel_launch: hipFuncSetAttribute failed\n"); grid = -1; return; }
        if (hipOccupancyMaxActiveBlocksPerMultiprocessor(&per_cu, (const void*)mk_fwd, NWAVES * 64, LDS_BYTES) != hipSuccess || per_cu < 1)
            fprintf(stderr, "kernel_launch: note: occupancy query reports %d workgroups per CU\n", per_cu);
        (void)hipGetLastError();
        grid = cus;
    }
    if (grid < 0) return;
    if (hipMemsetAsync((char*)d_ws + WS_CTL, 0, CTL_ZERO_BYTES, stream) != hipSuccess) { fprintf(stderr, "kernel_launch: memset failed\n"); return; }
    Args a{};
    for (int i = 0; i < 17; ++i) a.in[i] = (const float*)d_in[i];
    a.out = (float*)d_out; a.ws = (unsigned char*)d_ws;
    hipLaunchKernelGGL(mk_fwd, dim3(grid), dim3(NWAVES * 64), LDS_BYTES, stream, a);
    const hipError_t le = hipPeekAtLastError();
    if (le != hipSuccess) fprintf(stderr, "kernel_launch: launch failed: %s\n", hipGetErrorName(le));
}
```

```cpp
#include <hip/hip_runtime.h>
#include <cstdio>
#include <cstdint>

#ifndef DBG_MODE
#define DBG_MODE 0
#endif
constexpr int DM = 2048, NB = 4, SEQ = 4096, MTOK = NB * SEQ;
constexpr int INW = 14336, PJW = 8192, GTW = 6144;
constexpr int COL_DIL = 512, COL_DIFF = 5120;
constexpr int NEXP = 16384;
constexpr float RMS_EPS = 1e-6f;

typedef unsigned short bf16;
#define GAS __attribute__((address_space(1)))
#define LAS __attribute__((address_space(3)))
typedef unsigned v4u __attribute__((ext_vector_type(4)));
typedef float f32x4 __attribute__((ext_vector_type(4)));
typedef GAS unsigned gu32;

__device__ __forceinline__ int opaque_tid(int wave_sgpr) { int l; asm volatile("v_mbcnt_lo_u32_b32 %0, -1, 0\n\tv_mbcnt_hi_u32_b32 %0, -1, %0" : "=v"(l)); return wave_sgpr * 64 + l; }
namespace pg8 {
#define PG8_LAS __attribute__((address_space(3)))
typedef unsigned short bf16_t;
typedef short bf16x8 __attribute__((ext_vector_type(8)));
typedef float f32x4 __attribute__((ext_vector_type(4)));
typedef unsigned u32x4 __attribute__((ext_vector_type(4)));
typedef unsigned u32x2 __attribute__((ext_vector_type(2)));
typedef int i32x4 __attribute__((ext_vector_type(4)));
typedef int i32x8 __attribute__((ext_vector_type(8)));
constexpr int BM = 256, BK = 64, HALF = 128, HTB = HALF * BK * 2, STAGE_BYTES = 8 * HTB, NXCD = 8, WGM = 8;

__host__ __device__ __forceinline__ int lds_byte(int r, int c) { const int st = (r >> 4) * 2 + (c >> 5), rr = r & 15, cc = c & 31, ob = rr * 64 + cc * 2; return st * 1024 + (ob ^ (((ob >> 9) & 1) << 5)); }
__host__ __device__ __forceinline__ void stage_rc(int b, int& R, int& C) { const int st = b / 1024, sb = b % 1024, swz = sb ^ (((sb >> 9) & 1) << 5); R = (st >> 1) * 16 + swz / 64; C = (st & 1) * 32 + (swz % 64) / 2; }
__host__ __device__ __forceinline__ int perm32(int rho) { const int n = rho >> 4, i = rho & 15; return 8 * (i >> 2) + 4 * n + (i & 3); }

struct Unit { int pm, pn; long aoff, boff; int orow, ocol, sub; };
struct Gemm { const bf16_t* A; const bf16_t* Bt; };

struct StaticOrder {
    int nM, nN, nwg, G, c; long sa, sb;
    __device__ void init(int M, int N, int G_, int c_, int lda, int ldb) { nM = M / BM; nN = N / BM; nwg = nM * nN; G = G_; c = c_; sa = 512L * lda; sb = 512L * ldb; }
    __device__ bool next(int i, Unit& u) const {
        const long L = (long)i * G + c; if (L >= nwg) return false;
        int wgid = (int)L; { const int q = nwg / NXCD, r = nwg % NXCD, xcd = wgid % NXCD, off = wgid / NXCD; wgid = (xcd < r ? xcd * (q + 1) : r * (q + 1) + (xcd - r) * q) + off; }
        const int nig = WGM * nN, gid = wgid / nig, fm = gid * WGM, gsz = (nM - fm) < WGM ? (nM - fm) : WGM;
        u.pm = fm + ((wgid % nig) % gsz); u.pn = (wgid % nig) / gsz;
        u.aoff = u.pm * sa; u.boff = u.pn * sb; u.orow = u.pm * BM; u.ocol = u.pn * BM; u.sub = 0; return true;
    }
};
struct MergeOrder : StaticOrder {
    __device__ bool next(int i, Unit& u) const { if (!StaticOrder::next(i >> 2, u)) return false; u.sub = i & 3; u.aoff += 1024L * u.sub; u.boff += 1024L * u.sub; return true; }
};
struct F2Order : StaticOrder {
    __device__ bool next(int i, Unit& u) const { if (!StaticOrder::next(i, u)) return false; u.orow = (u.pn >> 1) * 4096 + u.pm * BM; u.ocol = (u.pn & 1) * BM; return true; }
};
struct F1Order {
    int G, c;
    __device__ bool next(int i, Unit& u) const {
        const int idx = i * G + c; if (idx >= 256) return false;
        const int bg = idx >> 4, st = idx & 15, b = bg >> 2, g = bg & 3;
        u.pm = 0; u.pn = idx; u.aoff = 0; u.boff = ((long)(b * 4096 + st * 256) * PJW + g * 128) * 2; u.orow = bg * 128; u.ocol = st * 256; return true;
    }
};

__device__ __forceinline__ unsigned cvt_pk_bf16(float lo, float hi) { unsigned r; asm volatile("v_cvt_pk_bf16_f32 %0, %1, %2" : "=v"(r) : "v"(lo), "v"(hi)); return r; }
__device__ __forceinline__ float bf_lo(unsigned w) { return __uint_as_float(w << 16); }
__device__ __forceinline__ float bf_hi(unsigned w) { return __uint_as_float(w & 0xffff0000u); }

#define PG8_PACK(v0, v1, w) do { (w).x = cvt_pk_bf16((v0)[0], (v0)[1]); (w).y = cvt_pk_bf16((v0)[2], (v0)[3]); (w).z = cvt_pk_bf16((v1)[0], (v1)[1]); (w).w = cvt_pk_bf16((v1)[2], (v1)[3]); } while (0)

struct EpiStore {
    static constexpr bool PERM = true;
    bf16_t* O; int ldo;
    __device__ __forceinline__ bool operator()(f32x4 (&acc)[2][2][4][2], const Unit& u, int wr, int wc, int, int) const {
        const int l = opaque_tid(0), fr = l & 15, fq = l >> 4;
        const int row0 = u.orow + wr * 64 + fr, col0 = u.ocol + wc * 32 + 8 * fq;
#pragma unroll
        for (int ai = 0; ai < 2; ++ai)
#pragma unroll
            for (int m = 0; m < 4; ++m) { bf16_t* rowp = O + (size_t)(row0 + ai * HALF + m * 16) * ldo + col0;
#pragma unroll
                for (int bj = 0; bj < 2; ++bj) { u32x4 w; PG8_PACK(acc[ai][bj][m][0], acc[ai][bj][m][1], w); *(u32x4*)(rowp + bj * HALF) = w; } }
        return true;
    }
};
struct EpiF2 {
    static constexpr bool PERM = true;
    bf16_t* O;
    __device__ __forceinline__ bool operator()(f32x4 (&acc)[2][2][4][2], const Unit& u, int wr, int wc, int fr, int fq) const {
        const int b = u.pn >> 1, gcol0 = (u.pn & 1) * BM + wc * 32 + 8 * fq;
#pragma unroll
        for (int ai = 0; ai < 2; ++ai)
#pragma unroll
            for (int m = 0; m < 4; ++m) { const int sp = u.pm * BM + ai * HALF + wr * 64 + m * 16 + fr;
#pragma unroll
                for (int bj = 0; bj < 2; ++bj) { const int gcol = gcol0 + bj * HALF; u32x4 w; PG8_PACK(acc[ai][bj][m][0], acc[ai][bj][m][1], w);
                    if (sp <= 2048) *(u32x4*)(O + (size_t)(b * 4096 + sp) * DM + gcol) = w;
                    if (sp >= 1 && sp <= 2047) { bf16_t* mr = O + (size_t)(b * 4096 + 4096 - sp) * DM + (gcol & ~127); const int c0 = gcol & 127;
                        mr[(128 - c0) & 127] = (bf16_t)(w.x & 0xffffu); mr[127 - c0] = (bf16_t)(w.x >> 16); mr[126 - c0] = (bf16_t)(w.y & 0xffffu); mr[125 - c0] = (bf16_t)(w.y >> 16);
                        mr[124 - c0] = (bf16_t)(w.z & 0xffffu); mr[123 - c0] = (bf16_t)(w.z >> 16); mr[122 - c0] = (bf16_t)(w.w & 0xffffu); mr[121 - c0] = (bf16_t)(w.w >> 16); } } }
        return true;
    }
};
struct EpiZT {
    static constexpr bool PERM = true;
    bf16_t* O;
    __device__ __forceinline__ bool operator()(f32x4 (&acc)[2][2][4][2], const Unit& u, int wr, int wc, int fr, int fq) const {
        const int row0 = u.orow + wr * 64 + fr, col0 = u.ocol + wc * 32 + 8 * fq;
#pragma unroll
        for (int ai = 0; ai < 2; ++ai)
#pragma unroll
            for (int m = 0; m < 4; ++m) { bf16_t* rowp = O + (size_t)(row0 + m * 16) * 8192 + ai * 4096 + col0;
#pragma unroll
                for (int bj = 0; bj < 2; ++bj) { u32x4 w; PG8_PACK(acc[ai][bj][m][0], acc[ai][bj][m][1], w); *(u32x4*)(rowp + bj * HALF) = w; } }
        return true;
    }
};
struct EpiProj {
    static constexpr bool PERM = true;
    bf16_t* P; unsigned char* Gt; const float* bg; int split, off_lo, off_hi; float scale;
    __device__ __forceinline__ bool operator()(f32x4 (&acc)[2][2][4][2], const Unit& u, int wr, int wc, int fr, int fq) const {
        const int pnn = u.pn < split ? u.pn + off_lo : u.pn + off_hi; const bool isg = pnn >= 32;
        const int row0 = u.pm * BM + wr * 64 + fr, col0 = (isg ? pnn - 32 : pnn) * BM + wc * 32 + 8 * fq;
        f32x4 bv[2][2];
#pragma unroll
        for (int bj = 0; bj < 2; ++bj)
#pragma unroll
            for (int n = 0; n < 2; ++n) bv[bj][n] = isg ? *(const f32x4*)(bg + col0 + bj * HALF + 4 * n) : (f32x4){0.f, 0.f, 0.f, 0.f};
#pragma unroll
        for (int ai = 0; ai < 2; ++ai)
#pragma unroll
            for (int m = 0; m < 4; ++m) { const size_t r = (size_t)(row0 + ai * HALF + m * 16);
#pragma unroll
                for (int bj = 0; bj < 2; ++bj) { f32x4 v0 = acc[ai][bj][m][0] * scale + bv[bj][0], v1 = acc[ai][bj][m][1] * scale + bv[bj][1];
                    if (isg) { unsigned q0[4], q1[4];
#pragma unroll
                        for (int j = 0; j < 4; ++j) { const float g0 = __builtin_amdgcn_rcpf(1.0f + __builtin_amdgcn_exp2f(-1.4426950408889634f * v0[j])), g1 = __builtin_amdgcn_rcpf(1.0f + __builtin_amdgcn_exp2f(-1.4426950408889634f * v1[j]));
                            const int i0 = (int)(g0 * 256.f), i1 = (int)(g1 * 256.f); q0[j] = (unsigned)(i0 > 255 ? 255 : i0); q1[j] = (unsigned)(i1 > 255 ? 255 : i1); }
                        u32x2 w; w.x = q0[0] | (q0[1] << 8) | (q0[2] << 16) | (q0[3] << 24); w.y = q1[0] | (q1[1] << 8) | (q1[2] << 16) | (q1[3] << 24);
                        *(u32x2*)(Gt + r * GTW + col0 + bj * HALF) = w;
                    } else { u32x4 w; PG8_PACK(v0, v1, w); *(u32x4*)(P + r * PJW + col0 + bj * HALF) = w; } } }
        return true;
    }
};
struct EpiMerge4 {
    static constexpr bool PERM = true;
    const unsigned char* Gt; bf16_t* O;
#define MG_U(w, k) ((float)(((w) >> (8 * (k))) & 0xffu) + 0.5f)
    __device__ __forceinline__ bool operator()(f32x4 (&acc)[2][2][4][2], const Unit& u, int wr, int wc, int fr, int fq) const {
        const int row0 = u.pm * BM + wr * 64 + fr, col0 = u.pn * BM + wc * 32 + 8 * fq;
        if (u.sub == 2) return false;
        if (u.sub < 2) {
            const unsigned char* gp0 = Gt + (size_t)row0 * GTW + u.sub * DM + col0;
            u32x2 gn[2][2], gd[2][2];
#define MG_LD(st, sx) do { const unsigned char* gp_ = gp0 + (size_t)(((sx) >> 2) * HALF + ((sx) & 3) * 16) * GTW; gn[st][0] = *(const u32x2*)gp_; gd[st][0] = *(const u32x2*)(gp_ + DM); gn[st][1] = *(const u32x2*)(gp_ + HALF); gd[st][1] = *(const u32x2*)(gp_ + DM + HALF); } while (0)
            MG_LD(0, 0);
#pragma unroll
            for (int sx = 0; sx < 8; ++sx) { const int ai = sx >> 2, m = sx & 3, st = sx & 1;
                if (sx + 1 < 8) MG_LD((sx + 1) & 1, sx + 1);
                asm volatile("" ::: "memory");
#pragma unroll
                for (int bj = 0; bj < 2; ++bj) { const u32x2 n2 = gn[st][bj], d2 = gd[st][bj];
                    f32x4 r0, r1;
#pragma unroll
                    for (int k = 0; k < 4; ++k) { r0[k] = MG_U(n2.x, k) * __builtin_amdgcn_rcpf(MG_U(d2.x, k)); r1[k] = MG_U(n2.y, k) * __builtin_amdgcn_rcpf(MG_U(d2.y, k)); }
                    acc[ai][bj][m][0] *= r0; acc[ai][bj][m][1] *= r1; } }
#undef MG_LD
            return false;
        }
        {
            const unsigned char* gp0 = Gt + (size_t)row0 * GTW + 2 * DM + col0; bf16_t* op0 = O + (size_t)row0 * DM + col0;
            u32x2 gg[2][2];
#define MG_LD(st, sx) do { const unsigned char* gp_ = gp0 + (size_t)(((sx) >> 2) * HALF + ((sx) & 3) * 16) * GTW; gg[st][0] = *(const u32x2*)gp_; gg[st][1] = *(const u32x2*)(gp_ + HALF); } while (0)
            MG_LD(0, 0);
#pragma unroll
            for (int sx = 0; sx < 8; ++sx) { const int ai = sx >> 2, m = sx & 3, st = sx & 1;
                if (sx + 1 < 8) MG_LD((sx + 1) & 1, sx + 1);
                asm volatile("" ::: "memory");
                bf16_t* rowp = op0 + (size_t)(ai * HALF + m * 16) * DM;
#pragma unroll
                for (int bj = 0; bj < 2; ++bj) { const u32x2 g = gg[st][bj];
                    f32x4 v0 = acc[ai][bj][m][0], v1 = acc[ai][bj][m][1];
#pragma unroll
                    for (int k = 0; k < 4; ++k) { v0[k] *= MG_U(g.x, k) * (1.f / 256.f); v1[k] *= MG_U(g.y, k) * (1.f / 256.f); }
                    u32x4 w; PG8_PACK(v0, v1, w); *(u32x4*)(rowp + bj * HALF) = w; } }
#undef MG_LD
        }
        return true;
    }
#undef MG_U
};
struct EpiResF32 {
    static constexpr bool PERM = false;
    const float* base; float* out; int ldc;
    __device__ __forceinline__ bool operator()(f32x4 (&acc)[2][2][4][2], const Unit& u, int wr, int wc, int fr, int fq) const {
        const int row0 = u.orow + wr * 64 + fr, col0 = u.ocol + wc * 32 + 4 * fq;
        if (base) {
            f32x4 bb[2][4];
#define RS_LD(st, sx) do { const float* bp_ = base + (size_t)(row0 + ((sx) >> 2) * HALF + ((sx) & 3) * 16) * ldc + col0; bb[st][0] = *(const f32x4*)bp_; bb[st][1] = *(const f32x4*)(bp_ + 16); bb[st][2] = *(const f32x4*)(bp_ + HALF); bb[st][3] = *(const f32x4*)(bp_ + HALF + 16); } while (0)
            RS_LD(0, 0);
#pragma unroll
            for (int sx = 0; sx < 8; ++sx) { const int ai = sx >> 2, m = sx & 3, st = sx & 1;
                if (sx + 1 < 8) RS_LD((sx + 1) & 1, sx + 1);
                asm volatile("" ::: "memory");
                float* op = out + (size_t)(row0 + ai * HALF + m * 16) * ldc + col0;
#pragma unroll
                for (int bj = 0; bj < 2; ++bj)
#pragma unroll
                    for (int n = 0; n < 2; ++n) *(f32x4*)(op + bj * HALF + n * 16) = acc[ai][bj][m][n] + bb[st][bj * 2 + n]; }
#undef RS_LD
            return true;
        }
#pragma unroll
        for (int ai = 0; ai < 2; ++ai)
#pragma unroll
            for (int m = 0; m < 4; ++m) { const size_t off = (size_t)(row0 + ai * HALF + m * 16) * ldc + col0;
#pragma unroll
                for (int bj = 0; bj < 2; ++bj)
#pragma unroll
                    for (int n = 0; n < 2; ++n) *(f32x4*)(out + off + bj * HALF + n * 16) = acc[ai][bj][m][n];
                asm volatile("" ::: "memory"); }
        return true;
    }
};

constexpr float XS8 = 12.f;
__device__ __forceinline__ unsigned q8fix(const f32x4 v) {
    const int a = (int)__builtin_rintf(fminf(fmaxf(v[0] * XS8, -127.f), 127.f)), b = (int)__builtin_rintf(fminf(fmaxf(v[1] * XS8, -127.f), 127.f)),
              c = (int)__builtin_rintf(fminf(fmaxf(v[2] * XS8, -127.f), 127.f)), d = (int)__builtin_rintf(fminf(fmaxf(v[3] * XS8, -127.f), 127.f));
    return (unsigned)(a & 0xff) | ((unsigned)(b & 0xff) << 8) | ((unsigned)(c & 0xff) << 16) | ((unsigned)(d & 0xff) << 24);
}
__device__ __forceinline__ float fq_sum(float v) {
    v += __int_as_float(__builtin_amdgcn_ds_swizzle(__float_as_int(v), 0x1f | (16 << 10)));
    auto rr = __builtin_amdgcn_permlane32_swap(__float_as_uint(v), __float_as_uint(v), false, false); return __uint_as_float(rr[0]) + __uint_as_float(rr[1]);
}
struct EpiResX {
    static constexpr bool PERM = true;
    const float* base32; const bf16_t* base16; bf16_t* out; unsigned char* x8; float* ssp;
    __device__ __forceinline__ bool operator()(f32x4 (&acc)[2][2][4][2], const Unit& u, int wr, int wc, int fr, int fq) const {
        const int row0 = u.orow + wr * 64 + fr, col0 = u.ocol + wc * 32 + 8 * fq;
        bf16_t* op0 = out + (size_t)row0 * DM + col0; unsigned char* xp0 = x8 + (size_t)row0 * DM + col0;
        float ss[8];
        if (base32) {
            const float* bp0 = base32 + (size_t)row0 * DM + col0;
            f32x4 bb[2][4];
#define RX_LD(st, sx) do { const float* bp_ = bp0 + (size_t)(((sx) >> 2) * HALF + ((sx) & 3) * 16) * DM; bb[st][0] = *(const f32x4*)bp_; bb[st][1] = *(const f32x4*)(bp_ + 4); bb[st][2] = *(const f32x4*)(bp_ + HALF); bb[st][3] = *(const f32x4*)(bp_ + HALF + 4); } while (0)
            RX_LD(0, 0);
#pragma unroll
            for (int sx = 0; sx < 8; ++sx) { const int ai = sx >> 2, m = sx & 3, st = sx & 1;
                if (sx + 1 < 8) RX_LD((sx + 1) & 1, sx + 1);
                asm volatile("" ::: "memory");
                const size_t ro = (size_t)(ai * HALF + m * 16) * DM; float sq = 0.f;
#pragma unroll
                for (int bj = 0; bj < 2; ++bj) { const f32x4 v0 = acc[ai][bj][m][0] + bb[st][2 * bj], v1 = acc[ai][bj][m][1] + bb[st][2 * bj + 1];
                    sq += (v0[0] * v0[0] + v0[1] * v0[1]) + (v0[2] * v0[2] + v0[3] * v0[3]) + (v1[0] * v1[0] + v1[1] * v1[1]) + (v1[2] * v1[2] + v1[3] * v1[3]);
                    u32x4 w; PG8_PACK(v0, v1, w); *(u32x4*)(op0 + ro + bj * HALF) = w;
                    u32x2 w8; w8.x = q8fix(v0); w8.y = q8fix(v1); *(u32x2*)(xp0 + ro + bj * HALF) = w8; }
                ss[sx] = sq; }
#undef RX_LD
        } else {
            const bf16_t* bp0 = base16 + (size_t)row0 * DM + col0;
            u32x4 bb[2][2];
#define RX_LD(st, sx) do { const bf16_t* bp_ = bp0 + (size_t)(((sx) >> 2) * HALF + ((sx) & 3) * 16) * DM; bb[st][0] = *(const u32x4*)bp_; bb[st][1] = *(const u32x4*)(bp_ + HALF); } while (0)
            RX_LD(0, 0);
#pragma unroll
            for (int sx = 0; sx < 8; ++sx) { const int ai = sx >> 2, m = sx & 3, st = sx & 1;
                if (sx + 1 < 8) RX_LD((sx + 1) & 1, sx + 1);
                asm volatile("" ::: "memory");
                const size_t ro = (size_t)(ai * HALF + m * 16) * DM; float sq = 0.f;
#pragma unroll
                for (int bj = 0; bj < 2; ++bj) { const u32x4 b = bb[st][bj]; f32x4 v0 = acc[ai][bj][m][0], v1 = acc[ai][bj][m][1];
                    v0[0] += bf_lo(b.x); v0[1] += bf_hi(b.x); v0[2] += bf_lo(b.y); v0[3] += bf_hi(b.y); v1[0] += bf_lo(b.z); v1[1] += bf_hi(b.z); v1[2] += bf_lo(b.w); v1[3] += bf_hi(b.w);
                    sq += (v0[0] * v0[0] + v0[1] * v0[1]) + (v0[2] * v0[2] + v0[3] * v0[3]) + (v1[0] * v1[0] + v1[1] * v1[1]) + (v1[2] * v1[2] + v1[3] * v1[3]);
                    u32x4 w; PG8_PACK(v0, v1, w); *(u32x4*)(op0 + ro + bj * HALF) = w;
                    u32x2 w8; w8.x = q8fix(v0); w8.y = q8fix(v1); *(u32x2*)(xp0 + ro + bj * HALF) = w8; }
                ss[sx] = sq; }
#undef RX_LD
        }
#pragma unroll
        for (int sx = 0; sx < 8; ++sx) { const float t = fq_sum(ss[sx]); if (fq == 0) ssp[(size_t)(row0 + (sx >> 2) * HALF + (sx & 3) * 16) * 32 + u.pn * 4 + wc] = t; }
        return true;
    }
};
struct EpiStoreRS {
    static constexpr bool PERM = true;
    bf16_t* O; int ldo; const float* ssp;
    __device__ __forceinline__ bool operator()(f32x4 (&acc)[2][2][4][2], const Unit& u, int wr, int wc, int, int) const {
        const int l = opaque_tid(0), fr = l & 15, fq = l >> 4;
        const int row0 = u.orow + wr * 64 + fr, col0 = u.ocol + wc * 32 + 8 * fq;
#pragma unroll
        for (int ai = 0; ai < 2; ++ai)
#pragma unroll
            for (int m = 0; m < 4; ++m) { const int row = row0 + ai * HALF + m * 16;
                const f32x4 p0 = *(const f32x4*)(ssp + (size_t)row * 32 + fq * 8), p1 = *(const f32x4*)(ssp + (size_t)row * 32 + fq * 8 + 4);
                const float tot = fq_sum((p0[0] + p0[1]) + (p0[2] + p0[3]) + (p1[0] + p1[1]) + (p1[2] + p1[3]));
                const float rs = 1.0f / __builtin_sqrtf(tot * (1.f / DM) + RMS_EPS);
                bf16_t* rowp = O + (size_t)row * ldo + col0;
#pragma unroll
                for (int bj = 0; bj < 2; ++bj) { const f32x4 v0 = acc[ai][bj][m][0] * rs, v1 = acc[ai][bj][m][1] * rs; u32x4 w; PG8_PACK(v0, v1, w); *(u32x4*)(rowp + bj * HALF) = w; } }
        return true;
    }
};

template <class Epi, class Sched, bool ALIGN_EPI, int LDA, int LDB, int KK, bool F8 = false>
__device__ __forceinline__ void gemm_phase(PG8_LAS unsigned char* lds, const Gemm g, const Sched& S, const Epi& E, int wave0) {
    const int tid = opaque_tid(wave0), wid = wave0, lane = tid & 63, wr = wid >> 2, wc = wid & 3, fr = lane & 15, fq = lane >> 4;
    constexpr int nt = KK / BK;
    unsigned voffA[2], voffB[2];
#pragma unroll
    for (int i = 0; i < 2; ++i) { int R, C; stage_rc(tid * 16 + i * 8192, R, C); const int Rb = Epi::PERM ? ((R & ~31) + perm32(R & 31)) : R;
        voffA[i] = (unsigned)(R * LDA + C) * 2u; voffB[i] = (unsigned)(Rb * LDB + C) * 2u; }
    const size_t kstep = (size_t)(BK * 2);
    constexpr size_t hstepA = (size_t)HALF * LDA * 2, hstepB = (size_t)HALF * LDB * 2;
    const unsigned ldsw = (unsigned)wid * 1024u;
    const int aoff = lds_byte(wr * 64 + fr, fq * 8), boff = lds_byte(wc * 32 + fr, fq * 8);
#define PG8_SA(b, h) (((b) * 2 + (h)) * HTB)
#define PG8_SB(b, h) ((4 + (b) * 2 + (h)) * HTB)
#define PG8_STAGE(bufoff, gbase, voff) do { _Pragma("unroll") for (int _i = 0; _i < 2; ++_i) \
        __builtin_amdgcn_global_load_lds((const unsigned*)((const char*)(gbase) + (voff)[_i]), (PG8_LAS unsigned*)(lds + (bufoff) + ldsw + _i * 8192), 16, 0, 0); } while (0)
#define PG8_LDA(dst, b, h) do { _Pragma("unroll") for (int m = 0; m < 4; ++m) _Pragma("unroll") for (int k = 0; k < 2; ++k) dst[m][k] = *(const PG8_LAS bf16x8*)(lds + PG8_SA(b, h) + aoff + m * 2048 + k * 1024); } while (0)
#define PG8_LDB(dst, b, h) do { _Pragma("unroll") for (int n = 0; n < 2; ++n) _Pragma("unroll") for (int k = 0; k < 2; ++k) dst[n][k] = *(const PG8_LAS bf16x8*)(lds + PG8_SB(b, h) + boff + n * 2048 + k * 1024); } while (0)
#define PG8_CAT(x) __builtin_shufflevector(__builtin_bit_cast(i32x4, (x)[0]), __builtin_bit_cast(i32x4, (x)[1]), 0, 1, 2, 3, 4, 5, 6, 7)
#define PG8_MMA(ai, bj, At, Bt) do { __builtin_amdgcn_s_setprio(1); _Pragma("unroll") for (int m = 0; m < 4; ++m) _Pragma("unroll") for (int n = 0; n < 2; ++n) { \
        if constexpr (F8) { const i32x8 a8_ = PG8_CAT(Bt[n]), b8_ = PG8_CAT(At[m]); asm volatile("v_mfma_scale_f32_16x16x128_f8f6f4 %0, %1, %2, %0, %3, %3 op_sel_hi:[0,0,0]" : "+v"(acc[ai][bj][m][n]) : "v"(a8_), "v"(b8_), "v"(one8)); } \
        else { _Pragma("unroll") for (int k = 0; k < 2; ++k) acc[ai][bj][m][n] = __builtin_amdgcn_mfma_f32_16x16x32_bf16(Bt[n][k], At[m][k], acc[ai][bj][m][n], 0, 0, 0); } } __builtin_amdgcn_s_setprio(0); } while (0)
#define PG8_WAIT_V(n) asm volatile("s_waitcnt vmcnt(" #n ")" ::: "memory")
#define PG8_WAIT_L(n) asm volatile("s_waitcnt lgkmcnt(" #n ")" ::: "memory")
#define PG8_BAR __builtin_amdgcn_s_barrier()
#define PG8_SCHED __builtin_amdgcn_sched_barrier(0)
    Unit cur, nxt; int ui = 0;
    if (!S.next(0, cur)) return;
    const int one8 = 0x7f7f7f7f; (void)one8;
    f32x4 acc[2][2][4][2];
#pragma unroll
    for (int a = 0; a < 2; ++a)
#pragma unroll
        for (int b = 0; b < 2; ++b)
#pragma unroll
            for (int m = 0; m < 4; ++m)
#pragma unroll
                for (int n = 0; n < 2; ++n) acc[a][b][m][n] = (f32x4){0.f, 0.f, 0.f, 0.f};
    bf16x8 At[4][2], B0[2][2], B1[2][2];
    const char* cA = (const char*)g.A + cur.aoff; const char* cB = (const char*)g.Bt + cur.boff;
    PG8_STAGE(PG8_SB(0, 0), cB, voffB); PG8_STAGE(PG8_SB(0, 1), cB + hstepB, voffB); PG8_STAGE(PG8_SA(0, 0), cA, voffA); PG8_STAGE(PG8_SA(0, 1), cA + hstepA, voffA);
    if (wr == 1) PG8_BAR;
    PG8_WAIT_V(2); PG8_BAR;
    PG8_STAGE(PG8_SB(1, 0), cB + kstep, voffB); PG8_STAGE(PG8_SA(1, 0), cA + kstep, voffA); PG8_STAGE(PG8_SB(1, 1), cB + hstepB + kstep, voffB);
    PG8_WAIT_V(6); PG8_BAR;
    for (;;) {
        const bool has_next = S.next(ui + 1, nxt);
        const char* nA = has_next ? (const char*)g.A + nxt.aoff : cA; const char* nB = has_next ? (const char*)g.Bt + nxt.boff : cB;
        for (int t = 0; t < nt; t += 2) {
            const bool last = (t == nt - 2);
            const char* a1 = cA + (size_t)(t + 1) * kstep;
            const char* a2 = last ? nA : cA + (size_t)(t + 2) * kstep; const char* b2 = last ? nB : cB + (size_t)(t + 2) * kstep;
            const char* a3 = a2 + kstep; const char* b3 = b2 + kstep;
            PG8_LDB(B0, 0, 0); PG8_LDB(B1, 0, 1); PG8_SCHED; PG8_LDA(At, 0, 0); PG8_STAGE(PG8_SA(1, 1), a1 + hstepA, voffA);
            PG8_WAIT_V(8); PG8_WAIT_L(0); PG8_BAR; PG8_MMA(0, 0, At, B0); PG8_MMA(0, 1, At, B1); PG8_BAR; PG8_SCHED;
            PG8_LDA(At, 0, 1); PG8_STAGE(PG8_SB(0, 0), b2, voffB); PG8_STAGE(PG8_SB(0, 1), b2 + hstepB, voffB); PG8_STAGE(PG8_SA(0, 0), a2, voffA);
            PG8_WAIT_V(8); PG8_WAIT_L(0); PG8_BAR; PG8_MMA(1, 0, At, B0); PG8_MMA(1, 1, At, B1); PG8_BAR; PG8_SCHED;
            PG8_LDB(B0, 1, 0); PG8_LDB(B1, 1, 1); PG8_SCHED; PG8_LDA(At, 1, 0); PG8_STAGE(PG8_SA(0, 1), a2 + hstepA, voffA);
            PG8_WAIT_V(8); PG8_WAIT_L(0); PG8_BAR; PG8_MMA(0, 0, At, B0); PG8_MMA(0, 1, At, B1); PG8_BAR; PG8_SCHED;
            PG8_LDA(At, 1, 1); PG8_STAGE(PG8_SB(1, 0), b3, voffB); PG8_STAGE(PG8_SB(1, 1), b3 + hstepB, voffB); PG8_STAGE(PG8_SA(1, 0), a3, voffA);
            PG8_WAIT_V(8); PG8_WAIT_L(0); PG8_BAR; PG8_MMA(1, 0, At, B0); PG8_MMA(1, 1, At, B1); PG8_BAR; PG8_SCHED;
        }
        if constexpr (ALIGN_EPI) { if (wr == 0) PG8_BAR; }
        if constexpr (F8) asm volatile("s_nop 15\n\ts_nop 15" ::: "memory");
        const bool fin = E(acc, cur, wr, wc, fr, fq);
        if (!has_next) break;
        if (fin) {
#pragma unroll
        for (int a = 0; a < 2; ++a)
#pragma unroll
            for (int b = 0; b < 2; ++b)
#pragma unroll
                for (int m = 0; m < 4; ++m)
#pragma unroll
                    for (int n = 0; n < 2; ++n) acc[a][b][m][n] = (f32x4){0.f, 0.f, 0.f, 0.f};
        }
        cur = nxt; cA = nA; cB = nB; ++ui;
        if constexpr (ALIGN_EPI) { if (wr == 1) PG8_BAR; }
    }
    PG8_WAIT_V(0);
    if constexpr (!ALIGN_EPI) { if (wr == 0) PG8_BAR; }
    PG8_BAR;
#undef PG8_SA
#undef PG8_SB
#undef PG8_STAGE
#undef PG8_LDA
#undef PG8_LDB
#undef PG8_MMA
#undef PG8_CAT
#undef PG8_WAIT_V
#undef PG8_WAIT_L
#undef PG8_BAR
#undef PG8_SCHED
}
}

namespace attn {
using bf16x8 = __attribute__((ext_vector_type(8))) short;
using s16x4  = __attribute__((ext_vector_type(4))) short;
using f32x16 = __attribute__((ext_vector_type(16))) float;
using u32x4  = __attribute__((ext_vector_type(4))) unsigned;
constexpr int   D = 128, NW = 8, QBLK = 32, KVBLK = 64;
constexpr float SCALE = 0.088388347648318440f;
constexpr float THR = 8.f;
constexpr size_t SHM_V = KVBLK * D * 2, SHM_K = KVBLK * D * 2;
constexpr int NBUF = 3;
constexpr int LDS_K0 = NBUF * (int)SHM_V, LDS_TAB = LDS_K0 + NBUF * (int)SHM_K, LDS_END = LDS_TAB + 8192 * 4, LDS_WS = 131072 + 8192;
#define KSWZ(row, colB) ((row) * 256 + ((colB) ^ (((row) & 7) << 4)))
#define SBAR() __builtin_amdgcn_sched_barrier(0)
__device__ __forceinline__ int crow(int r, int hi) { return (r & 3) + 8 * (r >> 2) + 4 * hi; }
__device__ __forceinline__ unsigned cvtpk(float lo, float hi) { unsigned r; asm volatile("v_cvt_pk_bf16_f32 %0, %1, %2" : "=v"(r) : "v"(lo), "v"(hi)); return r; }

__device__ __forceinline__ void partialSM(f32x16& p0, f32x16& p1, float& m_reg, float& mn, float& alpha) {
  constexpr float C = SCALE * 1.4426950408889634f;
  float pmax = p0[0]; for (int r = 1; r < 16; ++r) pmax = fmaxf(pmax, p0[r]); for (int r = 0; r < 16; ++r) pmax = fmaxf(pmax, p1[r]);
  { auto rr = __builtin_amdgcn_permlane32_swap(__float_as_uint(pmax), __float_as_uint(pmax), false, false);
    pmax = fmaxf(__uint_as_float(rr[0]), __uint_as_float(rr[1])); }
  if (__builtin_expect(__all(pmax - m_reg <= THR / SCALE), 1)) { mn = m_reg; alpha = 1.f; }
  else { mn = fmaxf(m_reg, pmax); alpha = __builtin_amdgcn_exp2f((m_reg - mn) * C); m_reg = mn; }
  float mnC = -mn * C;
  for (int r = 0; r < 16; ++r) p0[r] = fmaf(p0[r], C, mnC); for (int r = 0; r < 16; ++r) p1[r] = fmaf(p1[r], C, mnC);
  for (int r = 0; r < 16; ++r) p0[r] = __builtin_amdgcn_exp2f(p0[r]);
}
__device__ __forceinline__ void finishSM(f32x16& p0, f32x16& p1, float alpha, float& l_reg, bf16x8& pa0, bf16x8& pa1, bf16x8& pa2, bf16x8& pa3) {
  for (int r = 0; r < 16; ++r) p1[r] = __builtin_amdgcn_exp2f(p1[r]);
  float ps = 0; for (int r = 0; r < 16; ++r) ps += p0[r]; for (int r = 0; r < 16; ++r) ps += p1[r];
  { auto rr = __builtin_amdgcn_permlane32_swap(__float_as_uint(ps), __float_as_uint(ps), false, false);
    ps = __uint_as_float(rr[0]) + __uint_as_float(rr[1]); }
  l_reg = l_reg * alpha + ps;
#define PK4(P, BASE, OUT) do { unsigned a0 = cvtpk(P[BASE + 0], P[BASE + 1]), a1 = cvtpk(P[BASE + 2], P[BASE + 3]);   \
    unsigned b0 = cvtpk(P[BASE + 4], P[BASE + 5]), b1 = cvtpk(P[BASE + 6], P[BASE + 7]);                              \
    auto r0 = __builtin_amdgcn_permlane32_swap(a0, b0, false, false); auto r1 = __builtin_amdgcn_permlane32_swap(a1, b1, false, false); \
    u32x4 w = {r0[0], r1[0], r0[1], r1[1]}; OUT = *reinterpret_cast<bf16x8*>(&w); } while (0)
  PK4(p0, 0, pa0); PK4(p0, 8, pa1); PK4(p1, 0, pa2); PK4(p1, 8, pa3);
#undef PK4
}
__device__ __forceinline__ void qkt(f32x16& p0, f32x16& p1, const bf16* Ks, const bf16x8* qr, int r32, int hi, const float* tl) {
#pragma unroll
  for (int r = 0; r < 16; ++r) { p0[r] = tl[(r & 3) + 8 * (r >> 2)]; p1[r] = tl[32 + (r & 3) + 8 * (r >> 2)]; }
#pragma unroll
  for (int d0 = 0; d0 < 8; ++d0) { int cb = (d0 * 16 + hi * 8) * 2;
    bf16x8 b0 = *reinterpret_cast<const bf16x8*>((const char*)Ks + KSWZ(r32, cb));
    bf16x8 b1 = *reinterpret_cast<const bf16x8*>((const char*)Ks + KSWZ(32 + r32, cb));
    p0 = __builtin_amdgcn_mfma_f32_32x32x16_bf16(b0, qr[d0], p0, 0, 0, 0);
    p1 = __builtin_amdgcn_mfma_f32_32x32x16_bf16(b1, qr[d0], p1, 0, 0, 0); }
}
__device__ __forceinline__ int v_st(int k, int c) { const int kk = (k & ~0xC) | ((k & 4) << 1) | ((k & 8) >> 1); return ((kk >> 3) * 4 + (c >> 5)) * 512 + ((kk & 7) * 32 + (c & 31)) * 2; }
__device__ __forceinline__ int v_rd_base(int lane) { return ((lane & 3) << 3) | (((lane >> 2) & 3) << 6) | (((lane >> 4) & 1) << 5) | (((lane >> 5) & 1) << 8); }
constexpr int v_rd_off(int d0, int ks, int half) { return d0 * 512 + ks * 4096 + half * 2048; }
template <int OFF> __device__ __forceinline__ s16x4 tr_read(int vb) {
  s16x4 r; asm volatile("ds_read_b64_tr_b16 %0, %1 offset:%2" : "=&v"(r) : "v"(vb), "i"(OFF) : "memory"); return r;
}
template <int D0> __device__ __forceinline__ void pv_one(f32x16& od, int vb, bf16x8 pa0, bf16x8 pa1, bf16x8 pa2, bf16x8 pa3) {
  const s16x4 l0 = tr_read<v_rd_off(D0, 0, 0)>(vb), h0 = tr_read<v_rd_off(D0, 0, 1)>(vb), l1 = tr_read<v_rd_off(D0, 1, 0)>(vb), h1 = tr_read<v_rd_off(D0, 1, 1)>(vb);
  const s16x4 l2 = tr_read<v_rd_off(D0, 2, 0)>(vb), h2 = tr_read<v_rd_off(D0, 2, 1)>(vb), l3 = tr_read<v_rd_off(D0, 3, 0)>(vb), h3 = tr_read<v_rd_off(D0, 3, 1)>(vb);
  asm volatile("s_waitcnt lgkmcnt(0)" ::: "memory"); SBAR();
#define PK(L, H) (bf16x8){L[0], L[1], L[2], L[3], H[0], H[1], H[2], H[3]}
  od = __builtin_amdgcn_mfma_f32_32x32x16_bf16(pa0, PK(l0, h0), od, 0, 0, 0);
  od = __builtin_amdgcn_mfma_f32_32x32x16_bf16(pa1, PK(l1, h1), od, 0, 0, 0);
  od = __builtin_amdgcn_mfma_f32_32x32x16_bf16(pa2, PK(l2, h2), od, 0, 0, 0);
  od = __builtin_amdgcn_mfma_f32_32x32x16_bf16(pa3, PK(l3, h3), od, 0, 0, 0);
#undef PK
}
__device__ __forceinline__ void pv_d0(f32x16* o, int vb, bf16x8 pa0, bf16x8 pa1, bf16x8 pa2, bf16x8 pa3) {
  pv_one<0>(o[0], vb, pa0, pa1, pa2, pa3); pv_one<1>(o[1], vb, pa0, pa1, pa2, pa3); pv_one<2>(o[2], vb, pa0, pa1, pa2, pa3); pv_one<3>(o[3], vb, pa0, pa1, pa2, pa3);
}

struct VFrag { s16x4 l0, h0, l1, h1, l2, h2, l3, h3; };
template <int D0> __device__ __forceinline__ void v_issue(VFrag& f, int vb) {
  f.l0 = tr_read<v_rd_off(D0, 0, 0)>(vb); f.h0 = tr_read<v_rd_off(D0, 0, 1)>(vb); f.l1 = tr_read<v_rd_off(D0, 1, 0)>(vb); f.h1 = tr_read<v_rd_off(D0, 1, 1)>(vb);
  f.l2 = tr_read<v_rd_off(D0, 2, 0)>(vb); f.h2 = tr_read<v_rd_off(D0, 2, 1)>(vb); f.l3 = tr_read<v_rd_off(D0, 3, 0)>(vb); f.h3 = tr_read<v_rd_off(D0, 3, 1)>(vb);
}
__device__ __forceinline__ void v_mma(f32x16& od, const VFrag& f, bf16x8 pa0, bf16x8 pa1, bf16x8 pa2, bf16x8 pa3) {
#define PK(L, H) (bf16x8){L[0], L[1], L[2], L[3], H[0], H[1], H[2], H[3]}
  od = __builtin_amdgcn_mfma_f32_32x32x16_bf16(pa0, PK(f.l0, f.h0), od, 0, 0, 0);
  od = __builtin_amdgcn_mfma_f32_32x32x16_bf16(pa1, PK(f.l1, f.h1), od, 0, 0, 0);
  od = __builtin_amdgcn_mfma_f32_32x32x16_bf16(pa2, PK(f.l2, f.h2), od, 0, 0, 0);
  od = __builtin_amdgcn_mfma_f32_32x32x16_bf16(pa3, PK(f.l3, f.h3), od, 0, 0, 0);
#undef PK
}
__device__ __forceinline__ void pv_sm(f32x16* o, int vb, bf16x8 pa0, bf16x8 pa1, bf16x8 pa2, bf16x8 pa3, f32x16& p0, f32x16& p1, float& m_reg, float& mn, float& alpha) {
  constexpr float C = SCALE * 1.4426950408889634f;
  VFrag fa, fb;
  v_issue<0>(fa, vb); v_issue<1>(fb, vb);
  asm volatile("s_waitcnt lgkmcnt(8)" ::: "memory"); SBAR();
  v_mma(o[0], fa, pa0, pa1, pa2, pa3);
  float pmax = p0[0];
#pragma unroll
  for (int r = 1; r < 16; ++r) pmax = fmaxf(pmax, p0[r]);
#pragma unroll
  for (int r = 0; r < 16; ++r) pmax = fmaxf(pmax, p1[r]);
  v_issue<2>(fa, vb);
  asm volatile("s_waitcnt lgkmcnt(8)" ::: "memory"); SBAR();
  v_mma(o[1], fb, pa0, pa1, pa2, pa3);
  { auto rr = __builtin_amdgcn_permlane32_swap(__float_as_uint(pmax), __float_as_uint(pmax), false, false);
    pmax = fmaxf(__uint_as_float(rr[0]), __uint_as_float(rr[1])); }
  if (__builtin_expect(__all(pmax - m_reg <= THR / SCALE), 1)) { mn = m_reg; alpha = 1.f; }
  else { mn = fmaxf(m_reg, pmax); alpha = __builtin_amdgcn_exp2f((m_reg - mn) * C); m_reg = mn; }
  const float mnC = -mn * C;
#define PIN(x) do { float t_ = (x); asm volatile("" : "+v"(t_)); (x) = t_; } while (0)
#pragma unroll
  for (int r = 0; r < 16; ++r) { p0[r] = fmaf(p0[r], C, mnC); PIN(p0[r]); }
  v_issue<3>(fb, vb);
  asm volatile("s_waitcnt lgkmcnt(8)" ::: "memory"); SBAR();
  v_mma(o[2], fa, pa0, pa1, pa2, pa3);
#pragma unroll
  for (int r = 0; r < 16; ++r) { p1[r] = fmaf(p1[r], C, mnC); PIN(p1[r]); }
#pragma unroll
  for (int r = 0; r < 8; ++r) { p0[r] = __builtin_amdgcn_exp2f(p0[r]); PIN(p0[r]); }
  asm volatile("s_waitcnt lgkmcnt(0)" ::: "memory"); SBAR();
  v_mma(o[3], fb, pa0, pa1, pa2, pa3);
#pragma unroll
  for (int r = 8; r < 16; ++r) p0[r] = __builtin_amdgcn_exp2f(p0[r]);
#undef PIN
}

struct Unit { const bf16* Q; const bf16* K; const bf16* V; bf16* O; float* lse; long ldq, ldk, ldo; int lse_ld, kt0, nt, qoff; };
__device__ __forceinline__ void attn_unit(const Unit& u, char* lds, int wave0) {
  const int tid = opaque_tid(wave0), wid = wave0, lane = tid & 63, r32 = lane & 31, hi = lane >> 5;
  LAS unsigned char* ldsl = (LAS unsigned char*)lds;
  float* ws = (float*)(lds + LDS_WS) + wid * 64; float* li_l = ws; float* al_l = ws + 32;
  const float* tabL = (const float*)(lds + LDS_TAB);
  float m_reg = -1e30f, l_reg = 0; f32x16 o[4] = {}; bf16x8 qr[8];
  const bf16* Qw = u.Q + (long)(wid * QBLK + r32) * u.ldq + hi * 8;
#pragma unroll
  for (int d0 = 0; d0 < 8; ++d0) qr[d0] = *reinterpret_cast<const bf16x8*>(Qw + d0 * 16);
  const int vrd = (int)(uintptr_t)lds + v_rd_base(lane);
  const long tstep = (long)KVBLK * u.ldk * 2;
  const char* Kh = (const char*)u.K + (long)u.kt0 * tstep; const char* Vh = (const char*)u.V + (long)u.kt0 * tstep;
  unsigned kofs[2], vofs[2];
#pragma unroll
  for (int i = 0; i < 2; ++i) { const int rowk = (wid + 8 * i) * 4 + (lane >> 4), chunk = (lane & 15) ^ (rowk & 7); kofs[i] = (unsigned)(rowk * (int)u.ldk * 2 + chunk * 16);
    const int blk = (wid + 8 * i) * 2 + (lane >> 5), kk = (blk >> 2) * 8 + ((lane & 31) >> 2), c = (blk & 3) * 32 + (lane & 3) * 8, k = (kk & ~0xC) | ((kk & 4) << 1) | ((kk & 8) >> 1);
    vofs[i] = (unsigned)((k * (int)u.ldk + c) * 2); }
  const float* tl0 = tabL + (4096 + u.kt0 * KVBLK + 4 * hi - (u.qoff + wid * QBLK + r32));
#define DMA(tj, b) do { const char* kt_ = Kh + (long)(tj) * tstep; const char* vt_ = Vh + (long)(tj) * tstep; _Pragma("unroll") for (int i_ = 0; i_ < 2; ++i_) { \
    __builtin_amdgcn_global_load_lds((const unsigned*)(kt_ + kofs[i_]), (LAS unsigned*)(ldsl + LDS_K0 + (b) * (int)SHM_K + (wid + 8 * i_) * 1024), 16, 0, 0); \
    __builtin_amdgcn_global_load_lds((const unsigned*)(vt_ + vofs[i_]), (LAS unsigned*)(ldsl + (b) * (int)SHM_V + (wid + 8 * i_) * 1024), 16, 0, 0); } } while (0)
#define KBUF(b) ((const bf16*)(lds + LDS_K0 + (b) * (int)SHM_K))
#define VBUF(b) (vrd + (b) * (int)SHM_V)
#define LANDED() do { asm volatile("s_waitcnt vmcnt(0)" ::: "memory"); __syncthreads(); } while (0)
#define RESC(a) do { if (__any((a) < 1.f)) { if (hi == 0) al_l[r32] = (a); asm volatile("s_waitcnt lgkmcnt(0)" ::: "memory"); \
    for (int d = 0; d < 4; ++d) for (int r = 0; r < 16; ++r) o[d][r] *= al_l[crow(r, hi)]; } } while (0)
  f32x16 pA0, pA1, pB0, pB1; float mnA, mnB, alA, alB; bf16x8 pa0, pa1, pa2, pa3; const int NT = u.nt;
  DMA(0, 0); DMA(1, 1);
  LANDED();
  qkt(pA0, pA1, KBUF(0), qr, r32, hi, tl0); partialSM(pA0, pA1, m_reg, mnA, alA);
  if (2 < NT) DMA(2, 2);
  int bp = 0, bc = 1, bn = 2;
  for (int t = 1; t + 1 < NT; t += 2) {
    SBAR(); qkt(pB0, pB1, KBUF(bc), qr, r32, hi, tl0 + t * KVBLK);
    finishSM(pA0, pA1, alA, l_reg, pa0, pa1, pa2, pa3); SBAR();
    pv_sm(o, VBUF(bp), pa0, pa1, pa2, pa3, pB0, pB1, m_reg, mnB, alB);
    RESC(alB);
    LANDED();
    { const int nb = bp; bp = bc; bc = bn; bn = nb; if (t + 2 < NT) DMA(t + 2, bn); }
    SBAR(); qkt(pA0, pA1, KBUF(bc), qr, r32, hi, tl0 + (t + 1) * KVBLK);
    finishSM(pB0, pB1, alB, l_reg, pa0, pa1, pa2, pa3); SBAR();
    pv_sm(o, VBUF(bp), pa0, pa1, pa2, pa3, pA0, pA1, m_reg, mnA, alA);
    RESC(alA);
    LANDED();
    { const int nb = bp; bp = bc; bc = bn; bn = nb; if (t + 3 < NT) DMA(t + 3, bn); }
  }
  SBAR(); qkt(pB0, pB1, KBUF(bc), qr, r32, hi, tl0 + (NT - 1) * KVBLK);
  finishSM(pA0, pA1, alA, l_reg, pa0, pa1, pa2, pa3); SBAR();
  pv_sm(o, VBUF(bp), pa0, pa1, pa2, pa3, pB0, pB1, m_reg, mnB, alB);
  RESC(alB);
  finishSM(pB0, pB1, alB, l_reg, pa0, pa1, pa2, pa3); SBAR();
  pv_d0(o, VBUF(bc), pa0, pa1, pa2, pa3);
  if (hi == 0) li_l[r32] = l_reg; asm volatile("s_waitcnt lgkmcnt(0)" ::: "memory");
  float rli[16];
#pragma unroll
  for (int r = 0; r < 16; ++r) rli[r] = __builtin_amdgcn_rcpf(li_l[crow(r, hi)]);
  bf16* Ow = u.O + (long)(wid * QBLK) * u.ldo;
#pragma unroll
  for (int r = 0; r < 16; ++r) { int orow = crow(r, hi);
#pragma unroll
    for (int d0 = 0; d0 < 4; ++d0) { const float v = o[d0][r] * rli[r]; Ow[(long)orow * u.ldo + d0 * 32 + r32] = (bf16)(cvtpk(v, v) & 0xffffu); } }
  if (u.lse != nullptr && hi == 0) u.lse[(long)(wid * QBLK + r32) * u.lse_ld] = m_reg * SCALE + __logf(l_reg);
#undef DMA
#undef KBUF
#undef VBUF
#undef LANDED
#undef RESC
}
#undef KSWZ
#undef SBAR
}

constexpr int NWAVES = 8;
constexpr size_t MiB = 1u << 20;
constexpr size_t WS_CTL = 0, CTL_ZERO_BYTES = 1 * MiB;
constexpr size_t WS_CS   = 1 * MiB;
constexpr size_t WS_SKBD = 1 * MiB + 256 * 1024;
constexpr size_t WS_TAB  = 2 * MiB;
constexpr size_t WS_LSE  = 3 * MiB;
constexpr size_t WS_SU   = 3 * MiB + 768 * 1024;
constexpr size_t WS_SH   = 3 * MiB + 832 * 1024;
constexpr size_t WS_WCAT = 4 * MiB, WS_WO = 12 * MiB, WS_WQ = 20 * MiB;
constexpr size_t WS_WIN  = 28 * MiB;
constexpr size_t WS_WG8  = WS_WIN + 16 * MiB;
constexpr size_t WS_DFT  = 84 * MiB;
constexpr size_t WS_U    = 148 * MiB, WS_V = 180 * MiB;
constexpr size_t WS_H8   = 212 * MiB;
constexpr size_t WS_H    = 276 * MiB;
constexpr size_t WS_PROJ = 340 * MiB;
constexpr size_t WS_G    = 596 * MiB;
constexpr size_t WS_ZT   = 788 * MiB;
constexpr size_t WS_OC   = 820 * MiB;
constexpr size_t WS_MG   = 884 * MiB;
constexpr size_t WS_SSP  = 276 * MiB;
constexpr size_t WS_X16  = 948 * MiB;
constexpr size_t WS_END  = 1012 * MiB;
#if DBG_MODE == 2
constexpr size_t WS_ACT = WS_PROJ + 208 * MiB;
#else
constexpr size_t WS_ACT = WS_PROJ + 200 * MiB;
#endif
constexpr size_t WS_Q = WS_PROJ, WS_SC = WS_PROJ + 64 * MiB, WS_IDS = WS_PROJ + 192 * MiB, WS_GATES = WS_PROJ + 200 * MiB;
constexpr int CW_BAR = 4096;
constexpr int CW_XRANK = 12288;
constexpr int CW_QUEUE = 16384;
constexpr int RING_BYTES = 131072, LDSCTL_OFF = RING_BYTES, MISC_OFF = LDSCTL_OFF + 320, LDS_BYTES = 147456;

#define LDS_WAIT() asm volatile("s_waitcnt lgkmcnt(0)" ::: "memory")
#define VM_WAIT() asm volatile("s_waitcnt vmcnt(0)" ::: "memory")
__device__ __forceinline__ unsigned f2bf(float f) { unsigned u = __builtin_bit_cast(unsigned, f); return (u + 0x7fffu + ((u >> 16) & 1u)) >> 16; }
__device__ __forceinline__ unsigned pk2(float lo, float hi) { return f2bf(lo) | (f2bf(hi) << 16); }
__device__ __forceinline__ float bflo(unsigned w) { return __uint_as_float(w << 16); }
__device__ __forceinline__ float bfhi(unsigned w) { return __uint_as_float(w & 0xffff0000u); }

#define XB_TMO      128
#define XB_XCNT(j)  (256  + 64 * (j))
#define XB_XSUB(j)  (1280 + 64 * (j))
#define XB_XGEN(j)  (2304 + 64 * (j))
#define XB_TOP      3328
#define XB_TOPGEN   3392
#define XCD_BAR_WORDS 3456
#define XB_SPIN_CAP (1u << 20)
__device__ __forceinline__ unsigned xb_ld(unsigned* p)              { return __hip_atomic_load(p, __ATOMIC_RELAXED, __HIP_MEMORY_SCOPE_AGENT); }
__device__ __forceinline__ unsigned xb_add(unsigned* p, unsigned v) { return __hip_atomic_fetch_add(p, v, __ATOMIC_RELAXED, __HIP_MEMORY_SCOPE_AGENT); }
__device__ __forceinline__ unsigned xb_xcc_id() { return (unsigned)__builtin_amdgcn_s_getreg((3 << 11) | 20) & 0xFu; }
#define XB_SPIN(cond, bar) do { unsigned _sp = 0; while (cond) { __builtin_amdgcn_s_sleep(1); \
    if ((++_sp & 255u) == 0u) { if (xb_ld(&(bar)[XB_TMO])) break; if (_sp > XB_SPIN_CAP) { atomicAdd(&(bar)[XB_TMO], 1u); break; } } } } while (0)
struct XcdBarrier { unsigned* bar; unsigned x; volatile LAS unsigned* st; };
__device__ __forceinline__ XcdBarrier xcd_barrier_post(unsigned* bar, volatile LAS unsigned* st) {
    XcdBarrier b; b.bar = bar; b.x = xb_xcc_id(); b.st = st;
    if (threadIdx.x == 0) (void)xb_add(&bar[XB_XCNT(b.x)], 1u);
    return b;
}
__device__ __forceinline__ void xcd_barrier_complete(unsigned* bar, unsigned x, unsigned& nloc, unsigned& nx) {
    const unsigned G = gridDim.x * gridDim.y * gridDim.z;
    unsigned sum, cnt, mine, sp = 0u;
    for (;;) {
        sum = 0u; cnt = 0u; mine = 0u;
#pragma unroll
        for (unsigned j = 0; j < 16; ++j) { const unsigned c = xb_ld(&bar[XB_XCNT(j)]); sum += c; cnt += (c > 0u) ? 1u : 0u; mine = (j == x) ? c : mine; }
        if (sum == G) break;
        __builtin_amdgcn_s_sleep(1);
        if ((++sp & 255u) == 0u) { if (xb_ld(&bar[XB_TMO])) break; if (sp > XB_SPIN_CAP) { atomicAdd(&bar[XB_TMO], 1u); break; } }
    }
    nloc = mine > 0u ? mine : 1u; nx = cnt > 0u ? cnt : 1u;
}
__device__ __forceinline__ void xcd_barrier(const XcdBarrier& b) {
    asm volatile("s_waitcnt vmcnt(0)" ::: "memory");
    __syncthreads();
    if (threadIdx.x == 0) {
        unsigned* bar = b.bar;
        __builtin_amdgcn_s_waitcnt(0);
        unsigned nloc = b.st[0], nx = b.st[1];
        if (nloc == 0u) { xcd_barrier_complete(bar, b.x, nloc, nx); b.st[0] = nloc; b.st[1] = nx; }
        const unsigned old = xb_add(&bar[XB_XSUB(b.x)], 1u);
        const unsigned gen = old / nloc;
        if (old + 1u == (gen + 1u) * nloc) {
            __builtin_amdgcn_fence(__ATOMIC_RELEASE, "agent");
            asm volatile("s_waitcnt vmcnt(0)" ::: "memory");
            const unsigned og = xb_add(&bar[XB_TOP], 1u);
            const unsigned tg = og / nx;
            if (og + 1u == (tg + 1u) * nx) xb_add(&bar[XB_TOPGEN], 1u);
            else XB_SPIN(xb_ld(&bar[XB_TOPGEN]) == tg, bar);
            __builtin_amdgcn_fence(__ATOMIC_ACQUIRE, "agent");
            xb_add(&bar[XB_XGEN(b.x)], 1u);
            asm volatile("s_waitcnt vmcnt(0)" ::: "memory");
        } else {
            XB_SPIN(xb_ld(&bar[XB_XGEN(b.x)]) == gen, bar);
            __builtin_amdgcn_fence(__ATOMIC_ACQUIRE, "agent");
            asm volatile("s_waitcnt vmcnt(0)" ::: "memory");
        }
    }
    __syncthreads();
}

template <int MASK> __device__ __forceinline__ int sx_i(int v) { return __builtin_amdgcn_ds_swizzle(v, 0x1f | (MASK << 10)); }
template <int MASK> __device__ __forceinline__ float sx_f(float v) { return __int_as_float(sx_i<MASK>(__float_as_int(v))); }
__device__ __forceinline__ float add32(float v) { auto rr = __builtin_amdgcn_permlane32_swap(__float_as_uint(v), __float_as_uint(v), false, false); return __uint_as_float(rr[0]) + __uint_as_float(rr[1]); }
__device__ __forceinline__ unsigned max32(unsigned v) { auto rr = __builtin_amdgcn_permlane32_swap(v, v, false, false); return rr[0] > rr[1] ? rr[0] : rr[1]; }
__device__ __forceinline__ float other32(float v, bool upper) { auto rr = __builtin_amdgcn_permlane32_swap(__float_as_uint(v), __float_as_uint(v), false, false); return __uint_as_float(upper ? rr[0] : rr[1]); }
__device__ __forceinline__ float bperm_f(float v, int src_lane) { return __int_as_float(__builtin_amdgcn_ds_bpermute(src_lane * 4, __float_as_int(v))); }
__device__ __forceinline__ int bperm_i(int v, int src_lane) { return __builtin_amdgcn_ds_bpermute(src_lane * 4, v); }
__device__ __forceinline__ float wave_sum(float v) {
    v += sx_f<1>(v); v += sx_f<2>(v); v += sx_f<4>(v); v += sx_f<8>(v); v += sx_f<16>(v); return add32(v);
}
__device__ __forceinline__ unsigned umax(unsigned a, unsigned b) { return a > b ? a : b; }
__device__ __forceinline__ unsigned wave_max_u32(unsigned v) {
    v = umax(v, (unsigned)sx_i<1>((int)v)); v = umax(v, (unsigned)sx_i<2>((int)v)); v = umax(v, (unsigned)sx_i<4>((int)v)); v = umax(v, (unsigned)sx_i<8>((int)v)); v = umax(v, (unsigned)sx_i<16>((int)v)); return max32(v);
}
template <int CTRL, int RMASK> __device__ __forceinline__ unsigned dpp_max_u(unsigned v) { const unsigned t = (unsigned)__builtin_amdgcn_update_dpp((int)v, (int)v, CTRL, RMASK, 0xF, false); return t > v ? t : v; }
__device__ __forceinline__ unsigned wave_max_dpp(unsigned v) {
    v = dpp_max_u<0xB1, 0xF>(v); v = dpp_max_u<0x4E, 0xF>(v); v = dpp_max_u<0x141, 0xF>(v); v = dpp_max_u<0x140, 0xF>(v); v = dpp_max_u<0x142, 0xA>(v); v = dpp_max_u<0x143, 0xC>(v);
    return (unsigned)__builtin_amdgcn_readlane((int)v, 63);
}
template <int CTRL> __device__ __forceinline__ float dpp_add_f(float v) { return v + __int_as_float(__builtin_amdgcn_update_dpp(__float_as_int(v), __float_as_int(v), CTRL, 0xF, 0xF, false)); }
__device__ __forceinline__ float row_sum16(float v) { v = dpp_add_f<0xB1>(v); v = dpp_add_f<0x4E>(v); v = dpp_add_f<0x141>(v); return dpp_add_f<0x140>(v); }
__device__ __forceinline__ unsigned row_max16_u(unsigned v) { v = dpp_max_u<0xB1, 0xF>(v); v = dpp_max_u<0x4E, 0xF>(v); v = dpp_max_u<0x141, 0xF>(v); return dpp_max_u<0x140, 0xF>(v); }
template <int CTRL> __device__ __forceinline__ float dpp_maxf(float v) { return fmaxf(v, __int_as_float(__builtin_amdgcn_update_dpp(__float_as_int(v), __float_as_int(v), CTRL, 0xF, 0xF, false))); }
__device__ __forceinline__ float row_max16_f(float v) { v = dpp_maxf<0xB1>(v); v = dpp_maxf<0x4E>(v); v = dpp_maxf<0x141>(v); return dpp_maxf<0x140>(v); }
__device__ __forceinline__ float okey_inv(unsigned k) { return __uint_as_float((k & 0x80000000u) ? (k & 0x7fffffffu) : ~k); }
#define CE_DESC(a, b) do { const unsigned hi_ = (a) > (b) ? (a) : (b), lo_ = (a) > (b) ? (b) : (a); (a) = hi_; (b) = lo_; } while (0)
__device__ __forceinline__ unsigned okey(float f) { const unsigned u = __float_as_uint(f); return (u & 0x80000000u) ? ~u : (u | 0x80000000u); }

__device__ __forceinline__ void tr_issue(f32x4 (&t)[8], const float* W, int N, int k0, int n0, int lane) {
#pragma unroll
    for (int i = 0; i < 8; ++i) t[i] = __builtin_nontemporal_load((const GAS f32x4*)(W + (size_t)(k0 + 8 * i + (lane >> 3)) * N + n0 + 4 * (lane & 7)));
}
__device__ __forceinline__ void tr_to_lds(const f32x4 (&t)[8], LAS float* scr, int lane) {
#pragma unroll
    for (int i = 0; i < 8; ++i) { LAS float* d = scr + (8 * i + (lane >> 3)) * 33 + 4 * (lane & 7); d[0] = t[i].x; d[1] = t[i].y; d[2] = t[i].z; d[3] = t[i].w; }
    LDS_WAIT(); asm volatile("" ::: "memory");
}
__device__ __forceinline__ void tr_finish_bf16(const f32x4 (&t)[8], LAS float* scr, bf16* WT, int ldo, int col_off, int k0, int n0, int row_delta, int lane, const float* gk = nullptr) {
    tr_to_lds(t, scr, lane);
    const int c = lane & 7;
    f32x4 g0 = {1.f, 1.f, 1.f, 1.f}, g1 = {1.f, 1.f, 1.f, 1.f}; if (gk) { g0 = *(const GAS f32x4*)(gk + k0 + 8 * c); g1 = *(const GAS f32x4*)(gk + k0 + 8 * c + 4); }
#pragma unroll
    for (int j = 0; j < 4; ++j) { const int n = (lane >> 3) + 8 * j; const LAS float* s = scr + (8 * c) * 33 + n;
        v4u o; o.x = pk2(s[0 * 33] * g0.x, s[1 * 33] * g0.y); o.y = pk2(s[2 * 33] * g0.z, s[3 * 33] * g0.w); o.z = pk2(s[4 * 33] * g1.x, s[5 * 33] * g1.y); o.w = pk2(s[6 * 33] * g1.z, s[7 * 33] * g1.w);
        *(GAS v4u*)(WT + (size_t)(n0 + n + row_delta) * ldo + col_off + k0 + 8 * c) = o; }
    LDS_WAIT(); asm volatile("" ::: "memory");
}
__device__ __forceinline__ void tr_finish_fp8(const f32x4 (&t)[8], LAS float* scr, unsigned char* WT8, int ldo, float scale, int k0, int n0, int ncol0, int lane) {
    tr_to_lds(t, scr, lane);
    const int c = lane & 3;
#pragma unroll
    for (int j = 0; j < 2; ++j) { const int n = (lane >> 2) + 16 * j; const LAS float* s = scr + (16 * c) * 33 + n; v4u o; int w;
        w = __builtin_amdgcn_cvt_pk_fp8_f32(s[0 * 33] * scale, s[1 * 33] * scale, 0, false); w = __builtin_amdgcn_cvt_pk_fp8_f32(s[2 * 33] * scale, s[3 * 33] * scale, w, true); o.x = (unsigned)w;
        w = __builtin_amdgcn_cvt_pk_fp8_f32(s[4 * 33] * scale, s[5 * 33] * scale, 0, false); w = __builtin_amdgcn_cvt_pk_fp8_f32(s[6 * 33] * scale, s[7 * 33] * scale, w, true); o.y = (unsigned)w;
        w = __builtin_amdgcn_cvt_pk_fp8_f32(s[8 * 33] * scale, s[9 * 33] * scale, 0, false); w = __builtin_amdgcn_cvt_pk_fp8_f32(s[10 * 33] * scale, s[11 * 33] * scale, w, true); o.z = (unsigned)w;
        w = __builtin_amdgcn_cvt_pk_fp8_f32(s[12 * 33] * scale, s[13 * 33] * scale, 0, false); w = __builtin_amdgcn_cvt_pk_fp8_f32(s[14 * 33] * scale, s[15 * 33] * scale, w, true); o.w = (unsigned)w;
        *(GAS v4u*)(WT8 + (size_t)(n0 + n - ncol0) * ldo + k0 + 16 * c) = o; }
    LDS_WAIT(); asm volatile("" ::: "memory");
}
__device__ __forceinline__ void transpose_item(const float* W, int N, bf16* WT, int ldo, int col_off, LAS float* scr, int item, int lane, int row_delta = 0) {
    const int nblk = N / 32, k0 = 64 * (item / nblk), n0 = 32 * (item % nblk); f32x4 t[8]; tr_issue(t, W, N, k0, n0, lane); tr_finish_bf16(t, scr, WT, ldo, col_off, k0, n0, row_delta, lane);
}
__device__ __forceinline__ void transpose_item_fp8(const float* W, int N, int ncol0, unsigned char* WT8, int ldo, float scale, LAS float* scr, int item, int lane) {
    const int nblk = N / 32, k0 = 64 * (item / nblk), n0 = 32 * (item % nblk); f32x4 t[8]; tr_issue(t, W, N, k0, n0, lane); tr_finish_fp8(t, scr, WT8, ldo, scale, k0, n0, ncol0, lane);
}
constexpr int NPCU = 32;
constexpr int NPREP = 512;
constexpr int I_IN = (DM / 64) * (INW / 32), I_A = (512 / 64) * (DM / 32), I_C = (1024 / 64) * (DM / 32), I_SQ = (DM / 64) * (DM / 32), I_OWN = 2 * I_A + I_C + 2 * I_SQ;
__device__ __forceinline__ void prep_win_item(const float* w_in, bf16* WIN, unsigned char* WG8, LAS float* scr, int r, int lane) {
    const int ct = ((r % (INW / 32)) * 32) >> 8;
    if (ct < 2) transpose_item(w_in, INW, WIN, DM, 0, scr, r, lane); else if (ct >= 28 && ct < 32) transpose_item(w_in, INW, WIN, DM, 0, scr, r, lane, -26 * 256);
    else transpose_item_fp8(w_in, INW, ct < 28 ? 2 * 256 : 6 * 256, WG8, DM, 1024.f, scr, r, lane);
}
template <bool FP8> __device__ __forceinline__ void rms_rows2_to_bf16(const float* xrow, size_t rstride, const float* g, bf16* orow, unsigned char* o8row, int lane) {
    const GAS f32x4* gr = (const GAS f32x4*)g + lane;
    f32x4 v[2][8];
#pragma unroll
    for (int u = 0; u < 2; ++u) { const GAS f32x4* xr = (const GAS f32x4*)(xrow + u * rstride) + lane;
#pragma unroll
        for (int j = 0; j < 8; ++j) v[u][j] = xr[64 * j]; }
#pragma unroll
    for (int u = 0; u < 2; ++u) { float s = 0.f;
#pragma unroll
        for (int j = 0; j < 8; ++j) s += (v[u][j].x * v[u][j].x + v[u][j].y * v[u][j].y) + (v[u][j].z * v[u][j].z + v[u][j].w * v[u][j].w);
        const float rstd = 1.0f / sqrtf(wave_sum(s) * (1.f / DM) + RMS_EPS);
        GAS unsigned long long* o8 = (GAS unsigned long long*)(orow + u * rstride) + lane;
#pragma unroll
        for (int j = 0; j < 8; ++j) { const f32x4 gg = gr[64 * j]; const float a = v[u][j].x * rstd * gg.x, b = v[u][j].y * rstd * gg.y, c = v[u][j].z * rstd * gg.z, d = v[u][j].w * rstd * gg.w;
            o8[64 * j] = (unsigned long long)pk2(a, b) | ((unsigned long long)pk2(c, d) << 32);
            if (FP8) { int w = __builtin_amdgcn_cvt_pk_fp8_f32(a * 32.f, b * 32.f, 0, false); w = __builtin_amdgcn_cvt_pk_fp8_f32(c * 32.f, d * 32.f, w, true); ((GAS unsigned*)(o8row + u * rstride))[lane + 64 * j] = (unsigned)w; } } }
}
typedef __bf16 bf2_t __attribute__((ext_vector_type(2)));
__device__ __forceinline__ float DOT2(unsigned a, unsigned b, float c) { return __builtin_amdgcn_fdot2_f32_bf16(__builtin_bit_cast(bf2_t, a), __builtin_bit_cast(bf2_t, b), c, false); }
__device__ __forceinline__ unsigned q8x4(float a, float b, float c, float d, float inv) {
    const int ia = (int)__builtin_rintf(a * inv), ib = (int)__builtin_rintf(b * inv), ic = (int)__builtin_rintf(c * inv), id = (int)__builtin_rintf(d * inv);
    return (unsigned)(ia & 0xff) | ((unsigned)(ib & 0xff) << 8) | ((unsigned)(ic & 0xff) << 16) | ((unsigned)(id & 0xff) << 24);
}
__device__ __forceinline__ float wave_maxf(float v) {
    v = fmaxf(v, sx_f<1>(v)); v = fmaxf(v, sx_f<2>(v)); v = fmaxf(v, sx_f<4>(v)); v = fmaxf(v, sx_f<8>(v)); v = fmaxf(v, sx_f<16>(v));
    auto rr = __builtin_amdgcn_permlane32_swap(__float_as_uint(v), __float_as_uint(v), false, false); return fmaxf(__uint_as_float(rr[0]), __uint_as_float(rr[1]));
}
template <int MODE> __device__ __forceinline__ void rms_rows2_from_bf16(const bf16* xrow, size_t rstride, const float* g, bf16* orow, unsigned char* o8row, float* sh, int shstride, int lane) {
    const GAS f32x4* gr = (const GAS f32x4*)g + 2 * lane;
    v4u xv[2][4];
#pragma unroll
    for (int u = 0; u < 2; ++u) { const GAS v4u* xr = (const GAS v4u*)(xrow + u * rstride) + lane;
#pragma unroll
        for (int j = 0; j < 4; ++j) xv[u][j] = xr[64 * j]; }
#pragma unroll
    for (int u = 0; u < 2; ++u) { float v[4][8]; float s = 0.f;
#pragma unroll
        for (int j = 0; j < 4; ++j) { const v4u w = xv[u][j]; v[j][0] = bflo(w.x); v[j][1] = bfhi(w.x); v[j][2] = bflo(w.y); v[j][3] = bfhi(w.y); v[j][4] = bflo(w.z); v[j][5] = bfhi(w.z); v[j][6] = bflo(w.w); v[j][7] = bfhi(w.w);
#pragma unroll
            for (int k = 0; k < 8; ++k) s += v[j][k] * v[j][k]; }
        const float rstd = 1.0f / sqrtf(wave_sum(s) * (1.f / DM) + RMS_EPS); float mx = 0.f;
#pragma unroll
        for (int j = 0; j < 4; ++j) { const f32x4 ga = gr[128 * j], gb = gr[128 * j + 1];
            v[j][0] *= rstd * ga.x; v[j][1] *= rstd * ga.y; v[j][2] *= rstd * ga.z; v[j][3] *= rstd * ga.w; v[j][4] *= rstd * gb.x; v[j][5] *= rstd * gb.y; v[j][6] *= rstd * gb.z; v[j][7] *= rstd * gb.w;
            if (MODE == 1) {
#pragma unroll
                for (int k = 0; k < 8; ++k) mx = fmaxf(mx, fabsf(v[j][k])); } }
        float inv = 32.f;
        if (MODE == 1) { mx = fmaxf(wave_maxf(mx), 1e-30f); inv = 127.f / mx; if (lane == 0) sh[u * shstride] = mx * (1.f / 127.f); }
        GAS v4u* ob = (GAS v4u*)(orow + u * rstride) + lane; GAS unsigned long long* o8 = (GAS unsigned long long*)(o8row + u * rstride) + lane;
#pragma unroll
        for (int j = 0; j < 4; ++j) { v4u o; o.x = pk2(v[j][0], v[j][1]); o.y = pk2(v[j][2], v[j][3]); o.z = pk2(v[j][4], v[j][5]); o.w = pk2(v[j][6], v[j][7]); ob[64 * j] = o;
            unsigned lo, hi;
            if (MODE == 0) { int w = __builtin_amdgcn_cvt_pk_fp8_f32(v[j][0] * inv, v[j][1] * inv, 0, false); w = __builtin_amdgcn_cvt_pk_fp8_f32(v[j][2] * inv, v[j][3] * inv, w, true); lo = (unsigned)w;
                w = __builtin_amdgcn_cvt_pk_fp8_f32(v[j][4] * inv, v[j][5] * inv, 0, false); w = __builtin_amdgcn_cvt_pk_fp8_f32(v[j][6] * inv, v[j][7] * inv, w, true); hi = (unsigned)w; }
            else { lo = q8x4(v[j][0], v[j][1], v[j][2], v[j][3], inv); hi = q8x4(v[j][4], v[j][5], v[j][6], v[j][7], inv); }
            o8[64 * j] = (unsigned long long)lo | ((unsigned long long)hi << 32); } }
}
__device__ __forceinline__ int rel_bucket(int rel) {
    const int n = rel < 0 ? -rel : rel;
    int b = n;
    if (n >= 8) { b = 5 + (31 - __builtin_clz((unsigned)n)); if (b > 15) b = 15; }
    return b + (rel > 0 ? 16 : 0);
}

#ifndef PH_D1
#define PH_D1 1
#endif
#ifndef PH_D2
#define PH_D2 1
#endif
#ifndef PH_A
#define PH_A 1
#endif
#ifndef PH_B
#define PH_B 1
#endif
#ifndef PH_C
#define PH_C 1
#endif
#ifndef PH_D
#define PH_D 1
#endif
#ifndef PH_E
#define PH_E 1
#endif
#ifndef PH_F
#define PH_F 1
#endif
#ifndef PH_G
#define PH_G 1
#endif
#ifndef PH_H
#define PH_H 1
#endif
#ifndef PH_I
#define PH_I 1
#endif
#ifndef PH_J
#define PH_J 1
#endif
#ifndef PH_K
#define PH_K 1
#endif
#ifndef PH_L
#define PH_L 1
#endif
struct Args { const float* in[17]; float* out; unsigned char* ws; };

#define CAS __attribute__((address_space(4)))
__device__ __forceinline__ const void* karg(int k) { const CAS char* ka = (const CAS char*)__builtin_amdgcn_kernarg_segment_ptr(); asm volatile("" : "+s"(ka)); return *(const void* const CAS*)(ka + 8 * k); }
#define WSP(T, off) ((T*)((unsigned char*)karg(18) + (off)))
#define INP(k) ((const float*)karg(k))
#define INL(k, stride) (INP(k) + (size_t)layer * (size_t)(stride))
#define X ((float*)karg(17))
#define X16 WSP(bf16, WS_X16)
__global__ void __launch_bounds__(NWAVES * 64, 2) mk_fwd(Args args_unused) {
    extern __shared__ __attribute__((aligned(16))) unsigned char lds[];
    LAS unsigned char* ldsl = (LAS unsigned char*)lds;
    volatile LAS unsigned* MISC = (volatile LAS unsigned*)(ldsl + MISC_OFF);
    const int wave0 = __builtin_amdgcn_readfirstlane((int)threadIdx.x >> 6);
    const int G = gridDim.x; const int bx = blockIdx.x; const int vcu = (G % 8 == 0) ? (bx % 8) * (G / 8) + bx / 8 : bx;
    const int NGW = G * NWAVES, NGT = NGW * 64;
#define PH_IDS() int wave_o_ = wave0, vcu_o_ = vcu; asm volatile("" : "+s"(wave_o_), "+s"(vcu_o_));     \
    const int tid = opaque_tid(wave_o_), lane = tid & 63, wave = wave_o_, gw = vcu_o_ * NWAVES + wave, gt = gw * 64 + lane; (void)gt; (void)gw; (void)lane
    gu32* ctl = (gu32*)WSP(unsigned char, WS_CTL);
    for (int u = threadIdx.x; u < (LDS_BYTES - LDSCTL_OFF) / 4; u += NWAVES * 64) ((LAS unsigned*)(ldsl + LDSCTL_OFF))[u] = 0u;
    __syncthreads();
    XcdBarrier bar = xcd_barrier_post((unsigned*)(ctl + CW_BAR), MISC + 8);
    if (threadIdx.x == 0) MISC[1] = __hip_atomic_fetch_add(ctl + CW_XRANK + 64 * (int)(xb_xcc_id() & 7u), 1u, __ATOMIC_RELAXED, __HIP_MEMORY_SCOPE_AGENT);
#define GRID_BAR() xcd_barrier(bar)

    for (int layer = 0; layer < 2; ++layer) {

#if PH_A
        {
            PH_IDS();
            LAS float* scr = (LAS float*)(ldsl + wave * 16384);
            const float* mix_g = INL(3, DM); const float* rel_bias = INP(1);
            bf16* H = WSP(bf16, WS_H); bf16* DFT = WSP(bf16, WS_DFT); bf16* CS = WSP(bf16, WS_CS); float* TAB = WSP(float, WS_TAB);
            if (layer == 0) { const float* w_in = INP(4); bf16* WIN = WSP(bf16, WS_WIN);
                for (int it = gw; it < I_IN; it += NGW) prep_win_item(w_in, WIN, WSP(unsigned char, WS_WG8), scr, it, lane); }
            if (layer == 0) { int m = gw; do { rms_rows2_to_bf16<true>(INP(0) + (size_t)m * DM, (size_t)NGW * DM, mix_g, H + (size_t)m * DM, WSP(unsigned char, WS_H8) + (size_t)m * DM, lane); m += 2 * NGW; } while (m < MTOK); }
            else { int m = gw; do { rms_rows2_from_bf16<0>(X16 + (size_t)m * DM, (size_t)NGW * DM, mix_g, H + (size_t)m * DM, WSP(unsigned char, WS_H8) + (size_t)m * DM, nullptr, 0, lane); m += 2 * NGW; } while (m < MTOK); }
            if (layer == 0) {
                for (size_t i = (size_t)gt; i < (size_t)2304 * 8192 / 8; i += (size_t)NGT) {
                    const int sp = (int)(i >> 10), k0 = (int)(i & 1023) * 8, part = k0 >> 12, s0 = k0 & 4095; float v[8];
#pragma unroll
                    for (int j = 0; j < 8; ++j) { const float ang = (float)(((s0 + j) * sp) & 4095) * (1.f / 4096.f); v[j] = (part ? -__builtin_amdgcn_sinf(ang) : __builtin_amdgcn_cosf(ang)) * (1.f / 64.f); }
                    v4u o; o.x = pk2(v[0], v[1]); o.y = pk2(v[2], v[3]); o.z = pk2(v[4], v[5]); o.w = pk2(v[6], v[7]); ((GAS v4u*)DFT)[i] = o;
                }
                for (int i = gt; i < 65536; i += NGT) { const int r = i >> 8, c = i & 255, part = r >> 7, cp = r & 127; float v = 0.f;
                    if (c < 128) { const float ang = (float)((c * cp) & 127) * (1.f / 128.f); v = (part ? __builtin_amdgcn_sinf(ang) : __builtin_amdgcn_cosf(ang)) * 0.08838834764831845f; }
                    CS[i] = (bf16)f2bf(v); }
                for (int i = gt; i < 16 * 8192; i += NGT) { const int hd = i >> 13, off = (i & 8191) - 4096; float v;
                    if (hd < 12) { const int g = hd >> 2, dil = g == 0 ? 1 : (g == 1 ? 4 : 16); v = (off >= -64 && off <= 64) ? rel_bias[rel_bucket(off * dil) * 16 + hd] * 11.313708498984761f : -1.0e5f; }
                    else v = rel_bias[rel_bucket(off) * 16 + hd] * 11.313708498984761f;
                    TAB[i] = v; }
            }
        }
#endif
        GRID_BAR();

#if PH_B
        {
            { pg8::Gemm g{WSP(bf16, WS_H), WSP(bf16, WS_WIN)}; pg8::StaticOrder S; S.init(MTOK, 6 * 256, G, bx, DM, DM);
              pg8::EpiProj E{WSP(bf16, WS_PROJ), WSP(unsigned char, WS_G), INL(5, GTW), 2, 0, 26, 1.f};
              pg8::gemm_phase<pg8::EpiProj, pg8::StaticOrder, true, DM, DM, DM>(ldsl, g, S, E, wave0); }
            { pg8::Gemm g{WSP(bf16, WS_H8), WSP(bf16, WS_WG8)}; pg8::StaticOrder S; S.init(MTOK, 50 * 256, G, (bx + G / 2) % G, DM / 2, DM / 2);
              pg8::EpiProj E{WSP(bf16, WS_PROJ), WSP(unsigned char, WS_G), INL(5, GTW), 26, 2, 6, 1.f / 32768.f};
              pg8::gemm_phase<pg8::EpiProj, pg8::StaticOrder, true, DM / 2, DM / 2, DM / 2, true>(ldsl, g, S, E, wave0); }
        }
#endif
        GRID_BAR();

#if PH_C
        {
            pg8::Gemm g{WSP(bf16, WS_CS), WSP(bf16, WS_PROJ)}; pg8::F1Order S{G, bx};
            pg8::EpiZT E{WSP(bf16, WS_ZT)};
            pg8::gemm_phase<pg8::EpiZT, pg8::F1Order, false, 256, PJW, 256>(ldsl, g, S, E, wave0);
        }
#endif
        GRID_BAR();

#if PH_D
#if PH_D1
        {
            pg8::Gemm g{WSP(bf16, WS_DFT), WSP(bf16, WS_ZT)}; pg8::StaticOrder S; S.init(2304, 2048, G, bx, 8192, 8192);
            pg8::EpiF2 E{WSP(bf16, WS_OC)};
            pg8::gemm_phase<pg8::EpiF2, pg8::StaticOrder, false, 8192, 8192, 8192>(ldsl, g, S, E, wave0);
        }
#endif
#if PH_D2
        {
            PH_IDS();
            gu32* qhead = ctl + CW_QUEUE + 64 * layer; gu32* phead = ctl + CW_QUEUE + 128 + 64 * layer; const bool pref = bx >= 128 && bx < 128 + NPCU;
            bf16* PROJ = WSP(bf16, WS_PROJ); bf16* DO = WSP(bf16, WS_MG); bf16* DL = WSP(bf16, WS_H); float* LSE = WSP(float, WS_LSE); const float* TAB = WSP(float, WS_TAB);
            const float* cur_tab = nullptr;
            for (;;) {
                __syncthreads();
                if (tid == 0) { unsigned w = 0xffffffffu;
                    if (pref) { const unsigned v = __hip_atomic_fetch_add(phead, 1u, __ATOMIC_RELAXED, __HIP_MEMORY_SCOPE_AGENT); if (v < (unsigned)NPREP) w = 0x8000u | v; }
                    if (w == 0xffffffffu) { const unsigned v = __hip_atomic_fetch_add(qhead, 1u, __ATOMIC_RELAXED, __HIP_MEMORY_SCOPE_AGENT); if (v < 1792u) w = v; }
                    if (w == 0xffffffffu && !pref) { const unsigned v = __hip_atomic_fetch_add(phead, 1u, __ATOMIC_RELAXED, __HIP_MEMORY_SCOPE_AGENT); if (v < (unsigned)NPREP) w = 0x8000u | v; }
                    MISC[0] = w; }
                __syncthreads();
                const int ui0 = __builtin_amdgcn_readfirstlane((int)MISC[0]);
                if (ui0 == -1) break;
                int ui = ui0;
                { const int grp = ui0 & 0x7fff;
                    if (ui0 & 0x8000) {
                        const int pi = grp, t3 = opaque_tid(wave0), ln = t3 & 63;
                        { const float* pu = INL(15, (size_t)NEXP * DM); const float* pv = INL(16, (size_t)NEXP * DM); unsigned char* U8 = WSP(unsigned char, WS_U); unsigned char* V8 = WSP(unsigned char, WS_V); float* SU = WSP(float, WS_SU);
                          const int e0 = 32 * pi + 4 * wave0; LAS float* scr = (LAS float*)(ldsl + wave0 * 8448);
                          const int tpi = layer == 0 ? (I_OWN + I_IN) / NPREP : I_OWN / NPREP;
                          struct TDsc { const float* W; const float* gk; bf16* WT; unsigned char* WT8; int N, k0, n0, col_off, rowd, fp8; };
                          auto tdesc = [&](int r) -> TDsc { TDsc d; d.WT8 = nullptr; d.WT = nullptr; d.gk = nullptr; d.fp8 = 0; d.rowd = 0; d.col_off = 0; d.N = DM;
                              if (r < I_A) { d.W = INL(6, 512 * DM); d.WT = WSP(bf16, WS_WCAT); }
                              else if ((r -= I_A) < I_A) { d.W = INL(7, 512 * DM); d.WT = WSP(bf16, WS_WCAT); d.col_off = 512; }
                              else if ((r -= I_A) < I_C) { d.W = INL(8, 1024 * DM); d.WT = WSP(bf16, WS_WCAT); d.col_off = 1024; }
                              else if ((r -= I_C) < I_SQ) { d.W = INL(11, DM * DM); d.WT = WSP(bf16, WS_WO); }
                              else if ((r -= I_SQ) < I_SQ) { d.W = INL(13, DM * DM); d.WT = WSP(bf16, WS_WQ); d.gk = INL(12, DM); }
                              else { r -= I_SQ; d.W = INP(4) + (size_t)DM * INW; d.N = INW; d.WT = WSP(bf16, WS_WIN); const int ct = ((r % (INW / 32)) * 32) >> 8;
                                  if (ct >= 28 && ct < 32) d.rowd = -26 * 256; else if (ct >= 2) { d.fp8 = 1; d.WT8 = WSP(unsigned char, WS_WG8); d.rowd = ct < 28 ? 2 * 256 : 6 * 256; } }
                              const int nblk = d.N / 32; d.k0 = 64 * (r / nblk); d.n0 = 32 * (r % nblk); return d; };
                          f32x4 buf[4][8];
#define PP_ISSUE(k) do { if ((k) < 8) { const GAS f32x4* rp_ = (const GAS f32x4*)(((k) < 4 ? pu : pv) + (size_t)(e0 + ((k) & 3)) * DM) + ln; \
                              _Pragma("unroll") for (int j_ = 0; j_ < 8; ++j_) buf[(k) & 3][j_] = __builtin_nontemporal_load(rp_ + 64 * j_); } \
                          else if (wave0 + NWAVES * ((k) - 8) < tpi) { const TDsc d_ = tdesc(pi * tpi + wave0 + NWAVES * ((k) - 8)); tr_issue(buf[(k) & 3], d_.W, d_.N, d_.k0, d_.n0, ln); } } while (0)
                          PP_ISSUE(0); PP_ISSUE(1); PP_ISSUE(2); PP_ISSUE(3);
#pragma unroll
                          for (int k = 0; k < 13; ++k) { f32x4 (&y)[8] = buf[k & 3];
                              if (k < 4) { const int e = e0 + k; float mx = 0.f;
                                  { const GAS f32x4* gp_ = (const GAS f32x4*)INL(12, DM) + ln;
#pragma unroll
                                    for (int j = 0; j < 8; ++j) y[j] = y[j] * gp_[64 * j]; }
#pragma unroll
                                  for (int j = 0; j < 8; ++j) mx = fmaxf(mx, fmaxf(fmaxf(fabsf(y[j].x), fabsf(y[j].y)), fmaxf(fabsf(y[j].z), fabsf(y[j].w))));
                                  mx = fmaxf(wave_maxf(mx), 1e-30f); const float inv = 127.f / mx;
#pragma unroll
                                  for (int j = 0; j < 8; ++j) ((GAS unsigned*)(U8 + (size_t)e * DM))[ln + 64 * j] = q8x4(y[j].x, y[j].y, y[j].z, y[j].w, inv);
                                  if (ln == 0) SU[e] = mx * (1.f / 127.f); }
                              else if (k < 8) { const int e = e0 + (k - 4);
#pragma unroll
                                  for (int j = 0; j < 8; ++j) { int w = __builtin_amdgcn_cvt_pk_fp8_f32(y[j].x * 64.f, y[j].y * 64.f, 0, false); w = __builtin_amdgcn_cvt_pk_fp8_f32(y[j].z * 64.f, y[j].w * 64.f, w, true);
                                      ((GAS unsigned*)(V8 + (size_t)e * DM))[ln + 64 * j] = (unsigned)w; } }
                              else if (wave0 + NWAVES * (k - 8) < tpi) { const TDsc d = tdesc(pi * tpi + wave0 + NWAVES * (k - 8));
                                  if (d.fp8) tr_finish_fp8(y, scr, d.WT8, DM, 1024.f, d.k0, d.n0, d.rowd, ln); else tr_finish_bf16(y, scr, d.WT, DM, d.col_off, d.k0, d.n0, d.rowd, ln, d.gk); }
                              if (k + 4 < 13) PP_ISSUE(k + 4);
                          }
#undef PP_ISSUE
                        }
                        continue;
                    }
                }
                attn::Unit u; int hd;
                if (ui < 1024) {
                    const int qb = ui & 15, vh = (ui >> 4) & 1, m = (ui >> 5) & 1, h = (ui >> 6) & 3, b = ui >> 8;
                    const bf16* base = PROJ + (size_t)b * SEQ * PJW;
                    u.Q = base + (size_t)(qb * 256) * PJW + COL_DIFF + (h * 2 + m) * 128; u.K = base + COL_DIFF + 1024 + (h * 2 + m) * 128; u.V = base + COL_DIFF + 2048 + h * 256 + vh * 128;
                    u.O = DO + (size_t)(b * SEQ + qb * 256) * DM + (h * 2 + m) * 256 + vh * 128; u.lse = nullptr; u.ldq = PJW; u.ldk = PJW; u.ldo = DM; u.lse_ld = 0;
                    u.kt0 = 0; u.nt = SEQ / 64; u.qoff = qb * 256; hd = 12 + h;
                } else {
                    const int v = ui - 1024, qb16 = v & 15, hh = (v >> 4) & 3, bg = v >> 6, g = bg % 3, b = bg / 3;
                    const int dil = g == 0 ? 1 : (g == 1 ? 4 : 16), bpc = 16 / dil, r = qb16 / bpc, qblk = qb16 % bpc, q0 = qblk * 256, ntot = (SEQ / dil) / 64;
                    int kt0 = q0 / 64 - 1; if (kt0 < 0) kt0 = 0; int kt1 = q0 / 64 + 5; if (kt1 > ntot) kt1 = ntot;
                    if ((kt1 - kt0) & 1) { if (kt0 > 0) --kt0; else ++kt1; }
                    const bf16* base = PROJ + (size_t)(b * SEQ + r) * PJW + COL_DIL + g * 512 + hh * 128;
                    u.Q = base + (size_t)q0 * dil * PJW; u.K = base + 1536; u.V = base + 3072;
                    u.O = DL + ((size_t)g * MTOK + b * SEQ + r + (size_t)q0 * dil) * 512 + hh * 128; u.lse = LSE + ((size_t)g * MTOK + b * SEQ + r + (size_t)q0 * dil) * 4 + hh;
                    u.ldq = (long)PJW * dil; u.ldk = (long)PJW * dil; u.ldo = 512L * dil; u.lse_ld = 4 * dil; u.kt0 = kt0; u.nt = kt1 - kt0; u.qoff = q0; hd = g * 4 + hh;
                }
                const float* tab = TAB + (size_t)hd * 8192;
                if (tab != cur_tab) {
                    cur_tab = tab;
                    LAS f32x4* tl = (LAS f32x4*)(ldsl + attn::LDS_TAB); const int t2 = opaque_tid(wave0);
#pragma unroll
                    for (int j = 0; j < 4; ++j) tl[t2 + 512 * j] = ((const GAS f32x4*)tab)[t2 + 512 * j];
                }
                attn::attn_unit(u, (char*)lds, wave0);
            }
        }
#endif
#endif
        GRID_BAR();

#if PH_E
        {
            PH_IDS();
            const float* dlam = INL(9, 512); const float* subln = INL(10, 256); const float lambda_init = layer == 0 ? 0.2f : 0.35550906759f;
            const float* LSE = WSP(float, WS_LSE); const bf16* DL = WSP(bf16, WS_H); const bf16* DO = WSP(bf16, WS_MG); bf16* OC = WSP(bf16, WS_OC);
            float s1 = dlam[lane] * dlam[128 + lane] + dlam[64 + lane] * dlam[192 + lane], s2 = dlam[256 + lane] * dlam[384 + lane] + dlam[320 + lane] * dlam[448 + lane];
            s1 = wave_sum(s1); s2 = wave_sum(s2);
            const float lam = __expf(s1) - __expf(s2) + lambda_init, osc = 1.0f - lambda_init;
            const int hq = lane >> 4, l16 = lane & 15;
            const f32x4 g0 = *(const GAS f32x4*)(subln + l16 * 16), g1 = *(const GAS f32x4*)(subln + l16 * 16 + 4), g2 = *(const GAS f32x4*)(subln + l16 * 16 + 8), g3 = *(const GAS f32x4*)(subln + l16 * 16 + 12);
            for (int t = gw; t < MTOK; t += 4 * NGW) {
                float ls[4][3]; v4u dl[4][3], da[4][4];
#pragma unroll
                for (int u = 0; u < 4; ++u) { const int tt = t + u * NGW;
#pragma unroll
                    for (int g = 0; g < 3; ++g) { ls[u][g] = LSE[((size_t)g * MTOK + tt) * 4 + hq]; dl[u][g] = *(const GAS v4u*)(DL + ((size_t)g * MTOK + tt) * 512 + lane * 8); }
                    const bf16* dp = DO + (size_t)tt * DM + hq * 512 + l16 * 16;
                    da[u][0] = *(const GAS v4u*)(dp); da[u][1] = *(const GAS v4u*)(dp + 8); da[u][2] = *(const GAS v4u*)(dp + 256); da[u][3] = *(const GAS v4u*)(dp + 264); }
#pragma unroll
                for (int u = 0; u < 4; ++u) { const int tt = t + u * NGW;
                    float mx = fmaxf(fmaxf(ls[u][0], ls[u][1]), ls[u][2]), wsum = 0.f;
#pragma unroll
                    for (int g = 0; g < 3; ++g) { ls[u][g] = __expf(ls[u][g] - mx); wsum += ls[u][g]; }
                    const float winv = 1.0f / wsum; float acc8[8] = {0.f, 0.f, 0.f, 0.f, 0.f, 0.f, 0.f, 0.f};
#pragma unroll
                    for (int g = 0; g < 3; ++g) { const v4u o = dl[u][g]; const float w = ls[u][g] * winv;
                        acc8[0] += w * bflo(o.x); acc8[1] += w * bfhi(o.x); acc8[2] += w * bflo(o.y); acc8[3] += w * bfhi(o.y); acc8[4] += w * bflo(o.z); acc8[5] += w * bfhi(o.z); acc8[6] += w * bflo(o.w); acc8[7] += w * bfhi(o.w); }
                    { v4u o; o.x = pk2(acc8[0], acc8[1]); o.y = pk2(acc8[2], acc8[3]); o.z = pk2(acc8[4], acc8[5]); o.w = pk2(acc8[6], acc8[7]); *(GAS v4u*)(OC + (size_t)tt * DM + 512 + lane * 8) = o; }
                    const v4u a0 = da[u][0], a1 = da[u][1], b0 = da[u][2], b1 = da[u][3];
                    float d[16];
                    d[0] = bflo(a0.x) - lam * bflo(b0.x); d[1] = bfhi(a0.x) - lam * bfhi(b0.x); d[2] = bflo(a0.y) - lam * bflo(b0.y); d[3] = bfhi(a0.y) - lam * bfhi(b0.y);
                    d[4] = bflo(a0.z) - lam * bflo(b0.z); d[5] = bfhi(a0.z) - lam * bfhi(b0.z); d[6] = bflo(a0.w) - lam * bflo(b0.w); d[7] = bfhi(a0.w) - lam * bfhi(b0.w);
                    d[8] = bflo(a1.x) - lam * bflo(b1.x); d[9] = bfhi(a1.x) - lam * bfhi(b1.x); d[10] = bflo(a1.y) - lam * bflo(b1.y); d[11] = bfhi(a1.y) - lam * bfhi(b1.y);
                    d[12] = bflo(a1.z) - lam * bflo(b1.z); d[13] = bfhi(a1.z) - lam * bfhi(b1.z); d[14] = bflo(a1.w) - lam * bflo(b1.w); d[15] = bfhi(a1.w) - lam * bfhi(b1.w);
                    float ss = 0.f;
#pragma unroll
                    for (int j = 0; j < 16; ++j) ss += d[j] * d[j];
                    ss += sx_f<1>(ss); ss += sx_f<2>(ss); ss += sx_f<4>(ss); ss += sx_f<8>(ss);
                    const float rs = osc / sqrtf(ss * (1.f / 256.f) + RMS_EPS);
                    v4u o0, o1;
                    o0.x = pk2(d[0] * rs * g0.x, d[1] * rs * g0.y); o0.y = pk2(d[2] * rs * g0.z, d[3] * rs * g0.w); o0.z = pk2(d[4] * rs * g1.x, d[5] * rs * g1.y); o0.w = pk2(d[6] * rs * g1.z, d[7] * rs * g1.w);
                    o1.x = pk2(d[8] * rs * g2.x, d[9] * rs * g2.y); o1.y = pk2(d[10] * rs * g2.z, d[11] * rs * g2.w); o1.z = pk2(d[12] * rs * g3.x, d[13] * rs * g3.y); o1.w = pk2(d[14] * rs * g3.z, d[15] * rs * g3.w);
                    bf16* op = OC + (size_t)tt * DM + 1024 + hq * 256 + l16 * 16;
                    *(GAS v4u*)(op) = o0; *(GAS v4u*)(op + 8) = o1; }
            }
        }
#endif
        GRID_BAR();

#if PH_F
        {
            pg8::MergeOrder S; S.init(MTOK, DM, G, bx, DM, DM);
            pg8::Gemm g{WSP(bf16, WS_OC), WSP(bf16, WS_WCAT)}; pg8::EpiMerge4 E{WSP(unsigned char, WS_G), WSP(bf16, WS_MG)};
            pg8::gemm_phase<pg8::EpiMerge4, pg8::MergeOrder, true, DM, DM, 512>(ldsl, g, S, E, wave0);
        }
#endif
        GRID_BAR();

#if PH_G
        {
            pg8::Gemm g{WSP(bf16, WS_MG), WSP(bf16, WS_WO)}; pg8::StaticOrder S; S.init(MTOK, DM, G, bx, DM, DM);
            pg8::EpiResX E{layer == 0 ? INP(0) : (const float*)nullptr, X16, X16, WSP(unsigned char, WS_H8), WSP(float, WS_SSP)};
            pg8::gemm_phase<pg8::EpiResX, pg8::StaticOrder, true, DM, DM, DM>(ldsl, g, S, E, wave0);
        }
#endif
        GRID_BAR();

#if PH_I
        {
            pg8::Gemm g{X16, WSP(bf16, WS_WQ)}; pg8::StaticOrder S; S.init(MTOK, DM, G, bx, DM, DM);
            pg8::EpiStoreRS E{WSP(bf16, WS_Q), DM, WSP(float, WS_SSP)};
            pg8::gemm_phase<pg8::EpiStoreRS, pg8::StaticOrder, true, DM, DM, DM>(ldsl, g, S, E, wave0);
        }
#endif
        GRID_BAR();

#if PH_K
        {
            PH_IDS();
            const bf16* Q = WSP(bf16, WS_Q); int* IDS = WSP(int, WS_IDS); float* GATES = WSP(float, WS_GATES);
            const int l16 = lane & 15, rbase = lane & 48, fq = lane >> 4;
            constexpr int SKP = 272;
            { const float* subk = INL(14, 2 * 128 * 128);
#pragma unroll
              for (int j = 0; j < 8; ++j) { const int ci = tid + 512 * j, kr = ci >> 4, c8 = ci & 15; const GAS f32x4* sp = (const GAS f32x4*)(subk + (size_t)kr * 128 + c8 * 8); const f32x4 lo = sp[0], hi4 = sp[1];
                  v4u w; w.x = pk2(lo.x, lo.y); w.y = pk2(lo.z, lo.w); w.z = pk2(hi4.x, hi4.y); w.w = pk2(hi4.z, hi4.w); *(LAS v4u*)(ldsl + kr * SKP + c8 * 16) = w; } }
            __syncthreads();
            int cq[4];
#pragma unroll
            for (int q = 0; q < 4; ++q) { int c = l16 + 16 * q, ci = -1, cj = 0; for (int i = 0; i < 16; ++i) { const int cnt = 16 / (i + 1); if (ci < 0) { if (c < cnt) { ci = i; cj = c; } else c -= cnt; } } cq[q] = ci < 0 ? -1 : ci * 16 + cj; }
            typedef short bfx8 __attribute__((ext_vector_type(8)));
            const LAS unsigned char* skl = ldsl + l16 * SKP + fq * 16;
            bfx8 nq[8];
            { const GAS bfx8* qp = (const GAS bfx8*)(Q + (size_t)(gw * 16 + l16) * 256 + fq * 8);
#pragma unroll
              for (int j = 0; j < 8; ++j) nq[j] = qp[4 * j]; }
            const int NTRIP = MTOK * 8 / 16;
            for (int trip = gw; trip < NTRIP; trip += NGW) {
                pg8::f32x4 sa[8], sb[8];
#pragma unroll
                for (int nb = 0; nb < 8; ++nb) { sa[nb] = (pg8::f32x4){0.f, 0.f, 0.f, 0.f}; sb[nb] = (pg8::f32x4){0.f, 0.f, 0.f, 0.f}; }
#pragma unroll
                for (int ks = 0; ks < 4; ++ks)
#pragma unroll
                    for (int n4 = 0; n4 < 8; n4 += 4) {
#pragma unroll
                        for (int nb = n4; nb < n4 + 4; ++nb) { const bfx8 ka_ = *(const LAS bfx8*)(skl + (nb * 16) * SKP + ks * 64), kb_ = *(const LAS bfx8*)(skl + (128 + nb * 16) * SKP + ks * 64);
                            sa[nb] = __builtin_amdgcn_mfma_f32_16x16x32_bf16(nq[ks], ka_, sa[nb], 0, 0, 0); sb[nb] = __builtin_amdgcn_mfma_f32_16x16x32_bf16(nq[4 + ks], kb_, sb[nb], 0, 0, 0); }
                        __builtin_amdgcn_sched_barrier(0); }
                { const int nt = trip + NGW < NTRIP ? trip + NGW : trip; const GAS bfx8* qp = (const GAS bfx8*)(Q + (size_t)(nt * 16 + l16) * 256 + fq * 8);
#pragma unroll
                  for (int j = 0; j < 8; ++j) nq[j] = qp[4 * j]; }
#pragma unroll
              for (int p4 = 0; p4 < 4; ++p4) {
                const int row = trip * 16 + 4 * fq + p4;
                unsigned ka[8], kb[8];
#pragma unroll
                for (int jj = 0; jj < 8; ++jj) { const unsigned ix = (unsigned)(127 - (jj * 16 + l16)); ka[jj] = (okey(sa[jj][p4]) & ~127u) | ix; kb[jj] = (okey(sb[jj][p4]) & ~127u) | ix; }
#define SORT8(k) do { CE_DESC(k[0], k[1]); CE_DESC(k[2], k[3]); CE_DESC(k[4], k[5]); CE_DESC(k[6], k[7]); CE_DESC(k[0], k[2]); CE_DESC(k[1], k[3]); CE_DESC(k[4], k[6]); CE_DESC(k[5], k[7]); \
    CE_DESC(k[1], k[2]); CE_DESC(k[5], k[6]); CE_DESC(k[0], k[4]); CE_DESC(k[3], k[7]); CE_DESC(k[1], k[5]); CE_DESC(k[2], k[6]); CE_DESC(k[1], k[4]); CE_DESC(k[3], k[6]); \
    CE_DESC(k[2], k[4]); CE_DESC(k[3], k[5]); CE_DESC(k[3], k[4]); } while (0)
                SORT8(ka); SORT8(kb);
                unsigned ta = 0u, tb = 0u;
#pragma unroll
                for (int r = 0; r < 16; ++r) {
                    const unsigned ma = row_max16_u(ka[0]), mb = row_max16_u(kb[0]);
                    const bool wa = ka[0] == ma, wb = kb[0] == mb;
                    ta = (l16 == r) ? ma : ta; tb = (l16 == r) ? mb : tb;
#pragma unroll
                    for (int q = 0; q < 7; ++q) { ka[q] = wa ? ka[q + 1] : ka[q]; kb[q] = wb ? kb[q + 1] : kb[q]; }
                    ka[7] = wa ? 0u : ka[7]; kb[7] = wb ? 0u : kb[7];
                }
                const int ia = 127 - (int)(ta & 127u), ib = 127 - (int)(tb & 127u);
                const float va = okey_inv(ta & ~127u), vb = okey_inv(tb & ~127u);
                unsigned ck[4];
#pragma unroll
                for (int q = 0; q < 4; ++q) { const int cc = cq[q] < 0 ? 0 : cq[q]; const float cs = bperm_f(va, rbase + (cc >> 4)) + bperm_f(vb, rbase + (cc & 15));
                    ck[q] = cq[q] < 0 ? 0u : ((okey(cs) & ~255u) | (unsigned)(255 - cc)); }
                CE_DESC(ck[0], ck[1]); CE_DESC(ck[2], ck[3]); CE_DESC(ck[0], ck[2]); CE_DESC(ck[1], ck[3]); CE_DESC(ck[1], ck[2]);
                unsigned tw = 0u;
#pragma unroll
                for (int r = 0; r < 16; ++r) { const unsigned mm = row_max16_u(ck[0]); const bool w = ck[0] == mm; tw = (l16 == r) ? mm : tw;
                    ck[0] = w ? ck[1] : ck[0]; ck[1] = w ? ck[2] : ck[1]; ck[2] = w ? ck[3] : ck[2]; ck[3] = w ? 0u : ck[3]; }
                const int code = 255 - (int)(tw & 255u), wi = (code >> 4) & 15, wj = code & 15;
                const float bs = bperm_f(va, rbase + wi) + bperm_f(vb, rbase + wj);
                const int eid = bperm_i(ia, rbase + wi) * 128 + bperm_i(ib, rbase + wj);
                const float mx = row_max16_f(bs), e = __expf(bs - mx), es = row_sum16(e);
                IDS[(size_t)row * 16 + l16] = eid; GATES[(size_t)row * 16 + l16] = e / es;
              }
            }
#undef SORT8
        }
#endif
        GRID_BAR();

#if PH_L
#define L_LDIDS(I, tt, hh) do { const GAS v4u* ip_ = (const GAS v4u*)(IDS + (size_t)(tt) * 128 + (hh) * 64 + lrow * 16); I##0 = ip_[0]; I##1 = ip_[1]; I##2 = ip_[2]; I##3 = ip_[3]; } while (0)
#define L_ISSUE(W, I, base) do { \
    W[0] = *(const GAS v4u*)((base) + (size_t)(I##0).x * DM); W[1] = *(const GAS v4u*)((base) + (size_t)(I##0).y * DM); W[2] = *(const GAS v4u*)((base) + (size_t)(I##0).z * DM); W[3] = *(const GAS v4u*)((base) + (size_t)(I##0).w * DM); \
    W[4] = *(const GAS v4u*)((base) + (size_t)(I##1).x * DM); W[5] = *(const GAS v4u*)((base) + (size_t)(I##1).y * DM); W[6] = *(const GAS v4u*)((base) + (size_t)(I##1).z * DM); W[7] = *(const GAS v4u*)((base) + (size_t)(I##1).w * DM); \
    W[8] = *(const GAS v4u*)((base) + (size_t)(I##2).x * DM); W[9] = *(const GAS v4u*)((base) + (size_t)(I##2).y * DM); W[10] = *(const GAS v4u*)((base) + (size_t)(I##2).z * DM); W[11] = *(const GAS v4u*)((base) + (size_t)(I##2).w * DM); \
    W[12] = *(const GAS v4u*)((base) + (size_t)(I##3).x * DM); W[13] = *(const GAS v4u*)((base) + (size_t)(I##3).y * DM); W[14] = *(const GAS v4u*)((base) + (size_t)(I##3).z * DM); W[15] = *(const GAS v4u*)((base) + (size_t)(I##3).w * DM); } while (0)
#define L_CVT(d, hi) __builtin_amdgcn_cvt_pk_f32_fp8((int)(d), (hi))
        {
            PH_IDS();
            const unsigned char* H8 = WSP(unsigned char, WS_H8); const unsigned char* U8 = WSP(unsigned char, WS_U); const int* IDS = WSP(int, WS_IDS); float* PART = WSP(float, WS_G);
            typedef float f32x2 __attribute__((ext_vector_type(2)));
            const int myx = (int)(xb_xcc_id() & 7u); int nx = 0, xi = 0, nloc = 1;
            for (int j = 0; j < 8; ++j) { const int c = (int)__hip_atomic_load(ctl + CW_XRANK + 64 * j, __ATOMIC_RELAXED, __HIP_MEMORY_SCOPE_AGENT); if (c > 0) { ++nx; if (j < myx) ++xi; } if (j == myx) nloc = c; }
            const int rw = (int)MISC[1] * NWAVES + wave, nW = nloc * NWAVES; const int l16 = lane & 15, lrow = lane >> 4;
#define L1_COMPUTE(W, dst) do { float sk[16]; _Pragma("unroll") for (int k = 0; k < 16; ++k) { const v4u ww = W[k]; int ac = 0; \
        ac = __builtin_amdgcn_sdot4((int)ww.x, (int)h0.x, ac, false); ac = __builtin_amdgcn_sdot4((int)ww.y, (int)h0.y, ac, false); ac = __builtin_amdgcn_sdot4((int)ww.z, (int)h0.z, ac, false); ac = __builtin_amdgcn_sdot4((int)ww.w, (int)h0.w, ac, false); \
        sk[k] = (float)ac; } \
          \
        float t8[8]; _Pragma("unroll") for (int j = 0; j < 8; ++j) { const float keep = b8 ? sk[8 + j] : sk[j], send = b8 ? sk[j] : sk[8 + j]; \
            t8[j] = keep + __int_as_float(__builtin_amdgcn_update_dpp(0, __float_as_int(send), 0x128, 0xF, 0xF, false)); } \
        float t4[4]; _Pragma("unroll") for (int j = 0; j < 4; ++j) { const float keep = b4 ? t8[4 + j] : t8[j], send = b4 ? t8[j] : t8[4 + j]; t4[j] = keep + sx_f<4>(send); } \
        float t2[2]; _Pragma("unroll") for (int j = 0; j < 2; ++j) { const float keep = b2 ? t4[2 + j] : t4[j], send = b2 ? t4[j] : t4[2 + j]; \
            t2[j] = keep + __int_as_float(__builtin_amdgcn_update_dpp(0, __float_as_int(send), 0x4E, 0xF, 0xF, false)); } \
        { const float keep = b1 ? t2[1] : t2[0], send = b1 ? t2[0] : t2[1]; dst = keep + __int_as_float(__builtin_amdgcn_update_dpp(0, __float_as_int(send), 0xB1, 0xF, 0xF, false)); } } while (0)
            const bool b8 = (lane & 8) != 0, b4 = (lane & 4) != 0, b2 = (lane & 2) != 0, b1 = (lane & 1) != 0;
            for (int sl = xi; sl < 8; sl += nx) {
                const unsigned char* ub = U8 + sl * 256 + l16 * 16; const unsigned char* hb = H8 + sl * 256 + l16 * 16;
                int t = rw;
                if (t < MTOK) {
                    v4u Wa[16], Wb[16]; v4u ia0, ia1, ia2, ia3, ib0, ib1, ib2, ib3; v4u h0;
                    L_LDIDS(ia, t, 0); L_LDIDS(ib, t, 1); h0 = *(const GAS v4u*)(hb + (size_t)t * DM);
                    L_ISSUE(Wa, ia, ub);
                    for (;;) {
                        const int tn = t + nW; const bool more = tn < MTOK; const int tp = more ? tn : t;
                        L_ISSUE(Wb, ib, ub);
                        L_LDIDS(ia, tp, 0); const v4u hn0 = *(const GAS v4u*)(hb + (size_t)tp * DM);
                        float pre0, pre1;
                        L1_COMPUTE(Wa, pre0);
                        L_ISSUE(Wa, ia, ub);
                        L_LDIDS(ib, tp, 1);
                        L1_COMPUTE(Wb, pre1);
                        float* pp = PART + ((size_t)sl * MTOK + t) * 128; pp[lane] = pre0; pp[64 + lane] = pre1;
                        h0 = hn0;
                        if (!more) break;
                        t = tn;
                    }
                }
            }
#undef L1_COMPUTE
        }
        GRID_BAR();
        {
            PH_IDS();
            const float* PART = WSP(float, WS_G); const float* GATES = WSP(float, WS_GATES); float* ACTW = WSP(float, WS_ACT);
            for (int t = gw; t < MTOK; t += NGW) {
                float q0 = 0.f, q1 = 0.f;
#pragma unroll
                for (int s8 = 0; s8 < 8; ++s8) { const float* pp = PART + ((size_t)s8 * MTOK + t) * 128; q0 += pp[lane]; q1 += pp[64 + lane]; }
                { const int* ip = WSP(int, WS_IDS) + (size_t)t * 128; float sh; { const float pv = lane < 32 ? WSP(float, WS_SSP)[(size_t)t * 32 + lane] : 0.f; sh = (1.0f / sqrtf(wave_sum(pv) * (1.f / DM) + RMS_EPS)) * (1.f / pg8::XS8); }     const float* SU = WSP(float, WS_SU); q0 *= SU[ip[lane]] * sh; q1 *= SU[ip[64 + lane]] * sh; }
                const float* gp = GATES + (size_t)t * 128; float* ap = ACTW + (size_t)t * 128;
                const float g0 = gp[lane], g1 = gp[64 + lane];
                ap[lane] = 0.5f * q0 * (1.0f + erff(q0 * 0.70710678118654752f)) * g0 * (1.f / 64.f); ap[64 + lane] = 0.5f * q1 * (1.0f + erff(q1 * 0.70710678118654752f)) * g1 * (1.f / 64.f);
            }
        }
        GRID_BAR();
        {
            PH_IDS();
            const unsigned char* V8 = WSP(unsigned char, WS_V); const int* IDS = WSP(int, WS_IDS); const float* ACT = WSP(float, WS_ACT);
            typedef float f32x2 __attribute__((ext_vector_type(2)));
            const int myx = (int)(xb_xcc_id() & 7u); int nx = 0, xi = 0, nloc = 1;
            for (int j = 0; j < 8; ++j) { const int c = (int)__hip_atomic_load(ctl + CW_XRANK + 64 * j, __ATOMIC_RELAXED, __HIP_MEMORY_SCOPE_AGENT); if (c > 0) { ++nx; if (j < myx) ++xi; } if (j == myx) nloc = c; }
            const int rw = (int)MISC[1] * NWAVES + wave, nW = nloc * NWAVES; const int l16 = lane & 15, lrow = lane >> 4;
            bf16* XO = X16;
#define L2_BC(av, acr) do { _Pragma("unroll") for (int k = 0; k < 16; ++k) av[k] = bperm_f(acr, (lane & 48) + k); } while (0)
#define L2_C4(Q, av, o) do { _Pragma("unroll") for (int k = 0; k < 4; ++k) { const float a = av[(o) + k]; const f32x2 aa = (f32x2){a, a}; \
        const v4u ww = Q[k]; const unsigned d0 = ww.x, d1 = ww.y, d2 = ww.z, d3 = ww.w; \
        oacc[0] += aa * L_CVT(d0, false); oacc[1] += aa * L_CVT(d0, true); oacc[2] += aa * L_CVT(d1, false); oacc[3] += aa * L_CVT(d1, true); \
        oacc[4] += aa * L_CVT(d2, false); oacc[5] += aa * L_CVT(d2, true); oacc[6] += aa * L_CVT(d3, false); oacc[7] += aa * L_CVT(d3, true); } } while (0)
#define L_ISS4(Q, Ia) do { Q[0] = *(const GAS v4u*)(vb + (size_t)(Ia).x * DM); Q[1] = *(const GAS v4u*)(vb + (size_t)(Ia).y * DM); Q[2] = *(const GAS v4u*)(vb + (size_t)(Ia).z * DM); Q[3] = *(const GAS v4u*)(vb + (size_t)(Ia).w * DM); } while (0)
            for (int sl = xi; sl < 8; sl += nx) {
                const unsigned char* vb = V8 + sl * 256 + l16 * 16; bf16* xb = XO + sl * 256 + l16 * 16;
                int t = rw;
                if (t < MTOK) {
                    v4u Q0[4], Q1[4], Q2[4], Q3[4], Q4[4], Q5[4], Q6[4], Q7[4]; v4u ia0, ia1, ia2, ia3, ib0, ib1, ib2, ib3; float ac0, ac1;
                    L_LDIDS(ia, t, 0); L_LDIDS(ib, t, 1); ac0 = ACT[(size_t)t * 128 + lane]; ac1 = ACT[(size_t)t * 128 + 64 + lane];
                    L_ISS4(Q0, ia0); L_ISS4(Q1, ia1); L_ISS4(Q2, ia2); L_ISS4(Q3, ia3); L_ISS4(Q4, ib0); L_ISS4(Q5, ib1); L_ISS4(Q6, ib2); L_ISS4(Q7, ib3);
                    for (;;) {
                        const int tn = t + nW; const bool more = tn < MTOK; const int tp = more ? tn : t;
                        L_LDIDS(ia, tp, 0); L_LDIDS(ib, tp, 1); const float an0 = ACT[(size_t)tp * 128 + lane], an1 = ACT[(size_t)tp * 128 + 64 + lane];
                        f32x2 oacc[8];
#pragma unroll
                        for (int k = 0; k < 8; ++k) oacc[k] = (f32x2){0.f, 0.f};
                        float av[16];
                        L2_BC(av, ac0);
                        L2_C4(Q0, av, 0);
                        L2_C4(Q1, av, 4); L_ISS4(Q0, ia0);
                        L2_C4(Q2, av, 8); L_ISS4(Q1, ia1);
                        L2_C4(Q3, av, 12); L_ISS4(Q2, ia2);
                        v4u xv[2]; { const GAS v4u* q = (const GAS v4u*)(xb + (size_t)t * DM); xv[0] = q[0]; xv[1] = q[1]; }
                        L2_BC(av, ac1);
                        L2_C4(Q4, av, 0); L_ISS4(Q3, ia3);
                        L2_C4(Q5, av, 4); L_ISS4(Q4, ib0);
                        L2_C4(Q6, av, 8); L_ISS4(Q5, ib1);
                        L2_C4(Q7, av, 12); L_ISS4(Q6, ib2); L_ISS4(Q7, ib3);
#pragma unroll
                        for (int k = 0; k < 8; ++k) { float a = oacc[k].x, b = oacc[k].y; a += sx_f<16>(a); b += sx_f<16>(b); a = add32(a); b = add32(b); oacc[k] = (f32x2){a, b}; }
                        if (lane < 16) { GAS v4u* q = (GAS v4u*)(xb + (size_t)t * DM);
#pragma unroll
                            for (int k = 0; k < 2; ++k) { const v4u xw = xv[k]; v4u o;
                                o.x = pk2(bflo(xw.x) + oacc[4 * k].x, bfhi(xw.x) + oacc[4 * k].y); o.y = pk2(bflo(xw.y) + oacc[4 * k + 1].x, bfhi(xw.y) + oacc[4 * k + 1].y);
                                o.z = pk2(bflo(xw.z) + oacc[4 * k + 2].x, bfhi(xw.z) + oacc[4 * k + 2].y); o.w = pk2(bflo(xw.w) + oacc[4 * k + 3].x, bfhi(xw.w) + oacc[4 * k + 3].y); q[k] = o; } }
                        ac0 = an0; ac1 = an1;
                        if (!more) break;
                        t = tn;
                    }
                }
            }
#undef L2_BC
#undef L2_C4
#undef L_ISS4
        }
#undef L_LDIDS
#undef L_ISSUE
#undef L_CVT
#endif
        GRID_BAR();
    }

    { PH_IDS(); const bf16* XS = X16;
    for (int m0 = gw; m0 < MTOK; m0 += 4 * NGW) {
        const GAS f32x4* gr = (const GAS f32x4*)INP(2) + 2 * lane;
        v4u xv[4][4];
#pragma unroll
        for (int u = 0; u < 4; ++u) { const GAS v4u* xr = (const GAS v4u*)(XS + (size_t)(m0 + u * NGW) * DM) + lane;
#pragma unroll
            for (int j = 0; j < 4; ++j) xv[u][j] = xr[64 * j]; }
#pragma unroll
        for (int u = 0; u < 4; ++u) { float v[4][8]; float s = 0.f;
#pragma unroll
            for (int j = 0; j < 4; ++j) { const v4u w = xv[u][j]; v[j][0] = bflo(w.x); v[j][1] = bfhi(w.x); v[j][2] = bflo(w.y); v[j][3] = bfhi(w.y); v[j][4] = bflo(w.z); v[j][5] = bfhi(w.z); v[j][6] = bflo(w.w); v[j][7] = bfhi(w.w);
#pragma unroll
                for (int k = 0; k < 8; ++k) s += v[j][k] * v[j][k]; }
            const float rstd = 1.0f / sqrtf(wave_sum(s) * (1.f / DM) + RMS_EPS);
            GAS f32x4* orow = (GAS f32x4*)(X + (size_t)(m0 + u * NGW) * DM) + 2 * lane;
#pragma unroll
            for (int j = 0; j < 4; ++j) { const f32x4 ga = gr[128 * j], gb = gr[128 * j + 1];
                orow[128 * j] = (f32x4){v[j][0] * rstd * ga.x, v[j][1] * rstd * ga.y, v[j][2] * rstd * ga.z, v[j][3] * rstd * ga.w};
                orow[128 * j + 1] = (f32x4){v[j][4] * rstd * gb.x, v[j][5] * rstd * gb.y, v[j][6] * rstd * gb.z, v[j][7] * rstd * gb.w}; } }
    } }
}

extern "C" void kernel_launch(void* const* d_in, const int* in_sizes, int n_in, void* d_out, int out_size, void* d_ws, size_t ws_size, hipStream_t stream) {
    static int grid = 0;
    if (grid == 0) {
        if (n_in != 17 || in_sizes[0] != MTOK * DM || out_size != MTOK * DM || ws_size < WS_END) {
            fprintf(stderr, "kernel_launch: shape/workspace mismatch: n_in %d in0 %d out %d ws %zu (need %zu); nothing launched\n", n_in, n_in > 0 ? in_sizes[0] : -1, out_size, ws_size, (size_t)WS_END); grid = -1; return; }
        int dev = 0, cus = 0, per_cu = 0;
        if (hipGetDevice(&dev) != hipSuccess || hipDeviceGetAttribute(&cus, hipDeviceAttributeMultiprocessorCount, dev) != hipSuccess) { grid = -1; return; }
        if (hipFuncSetAttribute((const void*)mk_fwd, hipFuncAttributeMaxDynamicSharedMemorySize, LDS_BYTES) != hipSuccess) { fprintf(stderr, "kernel_launch: hipFuncSetAttribute failed\n"); grid = -1; return; }
        if (hipOccupancyMaxActiveBlocksPerMultiprocessor(&per_cu, (const void*)mk_fwd, NWAVES * 64, LDS_BYTES) != hipSuccess || per_cu < 1)
            fprintf(stderr, "kernel_launch: note: occupancy query reports %d workgroups per CU\n", per_cu);
        (void)hipGetLastError();
        grid = cus;
    }
    if (grid < 0) return;
    if (hipMemsetAsync((char*)d_ws + WS_CTL, 0, CTL_ZERO_BYTES, stream) != hipSuccess) { fprintf(stderr, "kernel_launch: memset failed\n"); return; }
    Args a{};
    for (int i = 0; i < 17; ++i) a.in[i] = (const float*)d_in[i];
    a.out = (float*)d_out; a.ws = (unsigned char*)d_ws;
    hipLaunchKernelGGL(mk_fwd, dim3(grid), dim3(NWAVES * 64), LDS_BYTES, stream, a);
    const hipError_t le = hipPeekAtLastError();
    if (le != hipSuccess) fprintf(stderr, "kernel_launch: launch failed: %s\n", hipGetErrorName(le));
}
```

```cpp
#include <hip/hip_runtime.h>
#include <cstdio>
#include <cstdint>

#ifndef DBG_MODE
#define DBG_MODE 0
#endif
constexpr int DM = 2048, NB = 4, SEQ = 4096, MTOK = NB * SEQ;
constexpr int INW = 14336, PJW = 8192, GTW = 6144;
constexpr int COL_DIL = 512, COL_DIFF = 5120;
constexpr int NEXP = 16384;
constexpr float RMS_EPS = 1e-6f;

typedef unsigned short bf16;
#define GAS __attribute__((address_space(1)))
#define LAS __attribute__((address_space(3)))
typedef unsigned v4u __attribute__((ext_vector_type(4)));
typedef float f32x4 __attribute__((ext_vector_type(4)));
typedef GAS unsigned gu32;

__device__ __forceinline__ int opaque_tid(int wave_sgpr) { int l; asm volatile("v_mbcnt_lo_u32_b32 %0, -1, 0\n\tv_mbcnt_hi_u32_b32 %0, -1, %0" : "=v"(l)); return wave_sgpr * 64 + l; }
namespace pg8 {
#define PG8_LAS __attribute__((address_space(3)))
typedef unsigned short bf16_t;
typedef short bf16x8 __attribute__((ext_vector_type(8)));
typedef float f32x4 __attribute__((ext_vector_type(4)));
typedef unsigned u32x4 __attribute__((ext_vector_type(4)));
typedef unsigned u32x2 __attribute__((ext_vector_type(2)));
typedef int i32x4 __attribute__((ext_vector_type(4)));
typedef int i32x8 __attribute__((ext_vector_type(8)));
constexpr int BM = 256, BK = 64, HALF = 128, HTB = HALF * BK * 2, STAGE_BYTES = 8 * HTB, NXCD = 8, WGM = 8;

__host__ __device__ __forceinline__ int lds_byte(int r, int c) { const int st = (r >> 4) * 2 + (c >> 5), rr = r & 15, cc = c & 31, ob = rr * 64 + cc * 2; return st * 1024 + (ob ^ (((ob >> 9) & 1) << 5)); }
__host__ __device__ __forceinline__ void stage_rc(int b, int& R, int& C) { const int st = b / 1024, sb = b % 1024, swz = sb ^ (((sb >> 9) & 1) << 5); R = (st >> 1) * 16 + swz / 64; C = (st & 1) * 32 + (swz % 64) / 2; }
__host__ __device__ __forceinline__ int perm32(int rho) { const int n = rho >> 4, i = rho & 15; return 8 * (i >> 2) + 4 * n + (i & 3); }

struct Unit { int pm, pn; long aoff, boff; int orow, ocol, sub; };
struct Gemm { const bf16_t* A; const bf16_t* Bt; };

struct StaticOrder {
    int nM, nN, nwg, G, c; long sa, sb;
    __device__ void init(int M, int N, int G_, int c_, int lda, int ldb) { nM = M / BM; nN = N / BM; nwg = nM * nN; G = G_; c = c_; sa = 512L * lda; sb = 512L * ldb; }
    __device__ bool next(int i, Unit& u) const {
        const long L = (long)i * G + c; if (L >= nwg) return false;
        int wgid = (int)L; { const int q = nwg / NXCD, r = nwg % NXCD, xcd = wgid % NXCD, off = wgid / NXCD; wgid = (xcd < r ? xcd * (q + 1) : r * (q + 1) + (xcd - r) * q) + off; }
        const int nig = WGM * nN, gid = wgid / nig, fm = gid * WGM, gsz = (nM - fm) < WGM ? (nM - fm) : WGM;
        u.pm = fm + ((wgid % nig) % gsz); u.pn = (wgid % nig) / gsz;
        u.aoff = u.pm * sa; u.boff = u.pn * sb; u.orow = u.pm * BM; u.ocol = u.pn * BM; u.sub = 0; return true;
    }
};
struct MergeOrder : StaticOrder {
    __device__ bool next(int i, Unit& u) const { if (!StaticOrder::next(i >> 2, u)) return false; u.sub = i & 3; u.aoff += 1024L * u.sub; u.boff += 1024L * u.sub; return true; }
};
struct F2Order : StaticOrder {
    __device__ bool next(int i, Unit& u) const { if (!StaticOrder::next(i, u)) return false; u.orow = (u.pn >> 1) * 4096 + u.pm * BM; u.ocol = (u.pn & 1) * BM; return true; }
};
struct F1Order {
    int G, c;
    __device__ bool next(int i, Unit& u) const {
        const int idx = i * G + c; if (idx >= 256) return false;
        const int bg = idx >> 4, st = idx & 15, b = bg >> 2, g = bg & 3;
        u.pm = 0; u.pn = idx; u.aoff = 0; u.boff = ((long)(b * 4096 + st * 256) * PJW + g * 128) * 2; u.orow = bg * 128; u.ocol = st * 256; return true;
    }
};

__device__ __forceinline__ unsigned cvt_pk_bf16(float lo, float hi) { unsigned r; asm volatile("v_cvt_pk_bf16_f32 %0, %1, %2" : "=v"(r) : "v"(lo), "v"(hi)); return r; }
__device__ __forceinline__ float bf_lo(unsigned w) { return __uint_as_float(w << 16); }
__device__ __forceinline__ float bf_hi(unsigned w) { return __uint_as_float(w & 0xffff0000u); }

#define PG8_PACK(v0, v1, w) do { (w).x = cvt_pk_bf16((v0)[0], (v0)[1]); (w).y = cvt_pk_bf16((v0)[2], (v0)[3]); (w).z = cvt_pk_bf16((v1)[0], (v1)[1]); (w).w = cvt_pk_bf16((v1)[2], (v1)[3]); } while (0)

struct EpiStore {
    static constexpr bool PERM = true;
    bf16_t* O; int ldo;
    __device__ __forceinline__ bool operator()(f32x4 (&acc)[2][2][4][2], const Unit& u, int wr, int wc, int, int) const {
        const int l = opaque_tid(0), fr = l & 15, fq = l >> 4;
        const int row0 = u.orow + wr * 64 + fr, col0 = u.ocol + wc * 32 + 8 * fq;
#pragma unroll
        for (int ai = 0; ai < 2; ++ai)
#pragma unroll
            for (int m = 0; m < 4; ++m) { bf16_t* rowp = O + (size_t)(row0 + ai * HALF + m * 16) * ldo + col0;
#pragma unroll
                for (int bj = 0; bj < 2; ++bj) { u32x4 w; PG8_PACK(acc[ai][bj][m][0], acc[ai][bj][m][1], w); *(u32x4*)(rowp + bj * HALF) = w; } }
        return true;
    }
};
struct EpiF2 {
    static constexpr bool PERM = true;
    bf16_t* O;
    __device__ __forceinline__ bool operator()(f32x4 (&acc)[2][2][4][2], const Unit& u, int wr, int wc, int fr, int fq) const {
        const int b = u.pn >> 1, gcol0 = (u.pn & 1) * BM + wc * 32 + 8 * fq;
#pragma unroll
        for (int ai = 0; ai < 2; ++ai)
#pragma unroll
            for (int m = 0; m < 4; ++m) { const int sp = u.pm * BM + ai * HALF + wr * 64 + m * 16 + fr;
#pragma unroll
                for (int bj = 0; bj < 2; ++bj) { const int gcol = gcol0 + bj * HALF; u32x4 w; PG8_PACK(acc[ai][bj][m][0], acc[ai][bj][m][1], w);
                    if (sp <= 2048) *(u32x4*)(O + (size_t)(b * 4096 + sp) * DM + gcol) = w;
                    if (sp >= 1 && sp <= 2047) { bf16_t* mr = O + (size_t)(b * 4096 + 4096 - sp) * DM + (gcol & ~127); const int c0 = gcol & 127;
                        mr[(128 - c0) & 127] = (bf16_t)(w.x & 0xffffu); mr[127 - c0] = (bf16_t)(w.x >> 16); mr[126 - c0] = (bf16_t)(w.y & 0xffffu); mr[125 - c0] = (bf16_t)(w.y >> 16);
                        mr[124 - c0] = (bf16_t)(w.z & 0xffffu); mr[123 - c0] = (bf16_t)(w.z >> 16); mr[122 - c0] = (bf16_t)(w.w & 0xffffu); mr[121 - c0] = (bf16_t)(w.w >> 16); } } }
        return true;
    }
};
struct EpiZT {
    static constexpr bool PERM = true;
    bf16_t* O;
    __device__ __forceinline__ bool operator()(f32x4 (&acc)[2][2][4][2], const Unit& u, int wr, int wc, int fr, int fq) const {
        const int row0 = u.orow + wr * 64 + fr, col0 = u.ocol + wc * 32 + 8 * fq;
#pragma unroll
        for (int ai = 0; ai < 2; ++ai)
#pragma unroll
            for (int m = 0; m < 4; ++m) { bf16_t* rowp = O + (size_t)(row0 + m * 16) * 8192 + ai * 4096 + col0;
#pragma unroll
                for (int bj = 0; bj < 2; ++bj) { u32x4 w; PG8_PACK(acc[ai][bj][m][0], acc[ai][bj][m][1], w); *(u32x4*)(rowp + bj * HALF) = w; } }
        return true;
    }
};
struct EpiProj {
    static constexpr bool PERM = true;
    bf16_t* P; unsigned char* Gt; const float* bg; int split, off_lo, off_hi; float scale;
    __device__ __forceinline__ bool operator()(f32x4 (&acc)[2][2][4][2], const Unit& u, int wr, int wc, int fr, int fq) const {
        const int pnn = u.pn < split ? u.pn + off_lo : u.pn + off_hi; const bool isg = pnn >= 32;
        const int row0 = u.pm * BM + wr * 64 + fr, col0 = (isg ? pnn - 32 : pnn) * BM + wc * 32 + 8 * fq;
        f32x4 bv[2][2];
#pragma unroll
        for (int bj = 0; bj < 2; ++bj)
#pragma unroll
            for (int n = 0; n < 2; ++n) bv[bj][n] = isg ? *(const f32x4*)(bg + col0 + bj * HALF + 4 * n) : (f32x4){0.f, 0.f, 0.f, 0.f};
#pragma unroll
        for (int ai = 0; ai < 2; ++ai)
#pragma unroll
            for (int m = 0; m < 4; ++m) { const size_t r = (size_t)(row0 + ai * HALF + m * 16);
#pragma unroll
                for (int bj = 0; bj < 2; ++bj) { f32x4 v0 = acc[ai][bj][m][0] * scale + bv[bj][0], v1 = acc[ai][bj][m][1] * scale + bv[bj][1];
                    if (isg) { unsigned q0[4], q1[4];
#pragma unroll
                        for (int j = 0; j < 4; ++j) { const float g0 = __builtin_amdgcn_rcpf(1.0f + __builtin_amdgcn_exp2f(-1.4426950408889634f * v0[j])), g1 = __builtin_amdgcn_rcpf(1.0f + __builtin_amdgcn_exp2f(-1.4426950408889634f * v1[j]));
                            const int i0 = (int)(g0 * 256.f), i1 = (int)(g1 * 256.f); q0[j] = (unsigned)(i0 > 255 ? 255 : i0); q1[j] = (unsigned)(i1 > 255 ? 255 : i1); }
                        u32x2 w; w.x = q0[0] | (q0[1] << 8) | (q0[2] << 16) | (q0[3] << 24); w.y = q1[0] | (q1[1] << 8) | (q1[2] << 16) | (q1[3] << 24);
                        *(u32x2*)(Gt + r * GTW + col0 + bj * HALF) = w;
                    } else { u32x4 w; PG8_PACK(v0, v1, w); *(u32x4*)(P + r * PJW + col0 + bj * HALF) = w; } } }
        return true;
    }
};
struct EpiMerge4 {
    static constexpr bool PERM = true;
    const unsigned char* Gt; bf16_t* O;
#define MG_U(w, k) ((float)(((w) >> (8 * (k))) & 0xffu) + 0.5f)
    __device__ __forceinline__ bool operator()(f32x4 (&acc)[2][2][4][2], const Unit& u, int wr, int wc, int fr, int fq) const {
        const int row0 = u.pm * BM + wr * 64 + fr, col0 = u.pn * BM + wc * 32 + 8 * fq;
        if (u.sub == 2) return false;
        if (u.sub < 2) {
            const unsigned char* gp0 = Gt + (size_t)row0 * GTW + u.sub * DM + col0;
            u32x2 gn[2][2], gd[2][2];
#define MG_LD(st, sx) do { const unsigned char* gp_ = gp0 + (size_t)(((sx) >> 2) * HALF + ((sx) & 3) * 16) * GTW; gn[st][0] = *(const u32x2*)gp_; gd[st][0] = *(const u32x2*)(gp_ + DM); gn[st][1] = *(const u32x2*)(gp_ + HALF); gd[st][1] = *(const u32x2*)(gp_ + DM + HALF); } while (0)
            MG_LD(0, 0);
#pragma unroll
            for (int sx = 0; sx < 8; ++sx) { const int ai = sx >> 2, m = sx & 3, st = sx & 1;
                if (sx + 1 < 8) MG_LD((sx + 1) & 1, sx + 1);
                asm volatile("" ::: "memory");
#pragma unroll
                for (int bj = 0; bj < 2; ++bj) { const u32x2 n2 = gn[st][bj], d2 = gd[st][bj];
                    f32x4 r0, r1;
#pragma unroll
                    for (int k = 0; k < 4; ++k) { r0[k] = MG_U(n2.x, k) * __builtin_amdgcn_rcpf(MG_U(d2.x, k)); r1[k] = MG_U(n2.y, k) * __builtin_amdgcn_rcpf(MG_U(d2.y, k)); }
                    acc[ai][bj][m][0] *= r0; acc[ai][bj][m][1] *= r1; } }
#undef MG_LD
            return false;
        }
        {
            const unsigned char* gp0 = Gt + (size_t)row0 * GTW + 2 * DM + col0; bf16_t* op0 = O + (size_t)row0 * DM + col0;
            u32x2 gg[2][2];
#define MG_LD(st, sx) do { const unsigned char* gp_ = gp0 + (size_t)(((sx) >> 2) * HALF + ((sx) & 3) * 16) * GTW; gg[st][0] = *(const u32x2*)gp_; gg[st][1] = *(const u32x2*)(gp_ + HALF); } while (0)
            MG_LD(0, 0);
#pragma unroll
            for (int sx = 0; sx < 8; ++sx) { const int ai = sx >> 2, m = sx & 3, st = sx & 1;
                if (sx + 1 < 8) MG_LD((sx + 1) & 1, sx + 1);
                asm volatile("" ::: "memory");
                bf16_t* rowp = op0 + (size_t)(ai * HALF + m * 16) * DM;
#pragma unroll
                for (int bj = 0; bj < 2; ++bj) { const u32x2 g = gg[st][bj];
                    f32x4 v0 = acc[ai][bj][m][0], v1 = acc[ai][bj][m][1];
#pragma unroll
                    for (int k = 0; k < 4; ++k) { v0[k] *= MG_U(g.x, k) * (1.f / 256.f); v1[k] *= MG_U(g.y, k) * (1.f / 256.f); }
                    u32x4 w; PG8_PACK(v0, v1, w); *(u32x4*)(rowp + bj * HALF) = w; } }
#undef MG_LD
        }
        return true;
    }
#undef MG_U
};
struct EpiResF32 {
    static constexpr bool PERM = false;
    const float* base; float* out; int ldc;
    __device__ __forceinline__ bool operator()(f32x4 (&acc)[2][2][4][2], const Unit& u, int wr, int wc, int fr, int fq) const {
        const int row0 = u.orow + wr * 64 + fr, col0 = u.ocol + wc * 32 + 4 * fq;
        if (base) {
            f32x4 bb[2][4];
#define RS_LD(st, sx) do { const float* bp_ = base + (size_t)(row0 + ((sx) >> 2) * HALF + ((sx) & 3) * 16) * ldc + col0; bb[st][0] = *(const f32x4*)bp_; bb[st][1] = *(const f32x4*)(bp_ + 16); bb[st][2] = *(const f32x4*)(bp_ + HALF); bb[st][3] = *(const f32x4*)(bp_ + HALF + 16); } while (0)
            RS_LD(0, 0);
#pragma unroll
            for (int sx = 0; sx < 8; ++sx) { const int ai = sx >> 2, m = sx & 3, st = sx & 1;
                if (sx + 1 < 8) RS_LD((sx + 1) & 1, sx + 1);
                asm volatile("" ::: "memory");
                float* op = out + (size_t)(row0 + ai * HALF + m * 16) * ldc + col0;
#pragma unroll
                for (int bj = 0; bj < 2; ++bj)
#pragma unroll
                    for (int n = 0; n < 2; ++n) *(f32x4*)(op + bj * HALF + n * 16) = acc[ai][bj][m][n] + bb[st][bj * 2 + n]; }
#undef RS_LD
            return true;
        }
#pragma unroll
        for (int ai = 0; ai < 2; ++ai)
#pragma unroll
            for (int m = 0; m < 4; ++m) { const size_t off = (size_t)(row0 + ai * HALF + m * 16) * ldc + col0;
#pragma unroll
                for (int bj = 0; bj < 2; ++bj)
#pragma unroll
                    for (int n = 0; n < 2; ++n) *(f32x4*)(out + off + bj * HALF + n * 16) = acc[ai][bj][m][n];
                asm volatile("" ::: "memory"); }
        return true;
    }
};

constexpr float XS8 = 12.f;
__device__ __forceinline__ unsigned q8fix(const f32x4 v) {
    const int a = (int)__builtin_rintf(fminf(fmaxf(v[0] * XS8, -127.f), 127.f)), b = (int)__builtin_rintf(fminf(fmaxf(v[1] * XS8, -127.f), 127.f)),
              c = (int)__builtin_rintf(fminf(fmaxf(v[2] * XS8, -127.f), 127.f)), d = (int)__builtin_rintf(fminf(fmaxf(v[3] * XS8, -127.f), 127.f));
    return (unsigned)(a & 0xff) | ((unsigned)(b & 0xff) << 8) | ((unsigned)(c & 0xff) << 16) | ((unsigned)(d & 0xff) << 24);
}
__device__ __forceinline__ float fq_sum(float v) {
    v += __int_as_float(__builtin_amdgcn_ds_swizzle(__float_as_int(v), 0x1f | (16 << 10)));
    auto rr = __builtin_amdgcn_permlane32_swap(__float_as_uint(v), __float_as_uint(v), false, false); return __uint_as_float(rr[0]) + __uint_as_float(rr[1]);
}
struct EpiResX {
    static constexpr bool PERM = true;
    const float* base32; const bf16_t* base16; bf16_t* out; unsigned char* x8; float* ssp;
    __device__ __forceinline__ bool operator()(f32x4 (&acc)[2][2][4][2], const Unit& u, int wr, int wc, int fr, int fq) const {
        const int row0 = u.orow + wr * 64 + fr, col0 = u.ocol + wc * 32 + 8 * fq;
        bf16_t* op0 = out + (size_t)row0 * DM + col0; unsigned char* xp0 = x8 + (size_t)row0 * DM + col0;
        float ss[8];
        if (base32) {
            const float* bp0 = base32 + (size_t)row0 * DM + col0;
            f32x4 bb[2][4];
#define RX_LD(st, sx) do { const float* bp_ = bp0 + (size_t)(((sx) >> 2) * HALF + ((sx) & 3) * 16) * DM; bb[st][0] = *(const f32x4*)bp_; bb[st][1] = *(const f32x4*)(bp_ + 4); bb[st][2] = *(const f32x4*)(bp_ + HALF); bb[st][3] = *(const f32x4*)(bp_ + HALF + 4); } while (0)
            RX_LD(0, 0);
#pragma unroll
            for (int sx = 0; sx < 8; ++sx) { const int ai = sx >> 2, m = sx & 3, st = sx & 1;
                if (sx + 1 < 8) RX_LD((sx + 1) & 1, sx + 1);
                asm volatile("" ::: "memory");
                const size_t ro = (size_t)(ai * HALF + m * 16) * DM; float sq = 0.f;
#pragma unroll
                for (int bj = 0; bj < 2; ++bj) { const f32x4 v0 = acc[ai][bj][m][0] + bb[st][2 * bj], v1 = acc[ai][bj][m][1] + bb[st][2 * bj + 1];
                    sq += (v0[0] * v0[0] + v0[1] * v0[1]) + (v0[2] * v0[2] + v0[3] * v0[3]) + (v1[0] * v1[0] + v1[1] * v1[1]) + (v1[2] * v1[2] + v1[3] * v1[3]);
                    u32x4 w; PG8_PACK(v0, v1, w); *(u32x4*)(op0 + ro + bj * HALF) = w;
                    u32x2 w8; w8.x = q8fix(v0); w8.y = q8fix(v1); *(u32x2*)(xp0 + ro + bj * HALF) = w8; }
                ss[sx] = sq; }
#undef RX_LD
        } else {
            const bf16_t* bp0 = base16 + (size_t)row0 * DM + col0;
            u32x4 bb[2][2];
#define RX_LD(st, sx) do { const bf16_t* bp_ = bp0 + (size_t)(((sx) >> 2) * HALF + ((sx) & 3) * 16) * DM; bb[st][0] = *(const u32x4*)bp_; bb[st][1] = *(const u32x4*)(bp_ + HALF); } while (0)
            RX_LD(0, 0);
#pragma unroll
            for (int sx = 0; sx < 8; ++sx) { const int ai = sx >> 2, m = sx & 3, st = sx & 1;
                if (sx + 1 < 8) RX_LD((sx + 1) & 1, sx + 1);
                asm volatile("" ::: "memory");
                const size_t ro = (size_t)(ai * HALF + m * 16) * DM; float sq = 0.f;
#pragma unroll
                for (int bj = 0; bj < 2; ++bj) { const u32x4 b = bb[st][bj]; f32x4 v0 = acc[ai][bj][m][0], v1 = acc[ai][bj][m][1];
                    v0[0] += bf_lo(b.x); v0[1] += bf_hi(b.x); v0[2] += bf_lo(b.y); v0[3] += bf_hi(b.y); v1[0] += bf_lo(b.z); v1[1] += bf_hi(b.z); v1[2] += bf_lo(b.w); v1[3] += bf_hi(b.w);
                    sq += (v0[0] * v0[0] + v0[1] * v0[1]) + (v0[2] * v0[2] + v0[3] * v0[3]) + (v1[0] * v1[0] + v1[1] * v1[1]) + (v1[2] * v1[2] + v1[3] * v1[3]);
                    u32x4 w; PG8_PACK(v0, v1, w); *(u32x4*)(op0 + ro + bj * HALF) = w;
                    u32x2 w8; w8.x = q8fix(v0); w8.y = q8fix(v1); *(u32x2*)(xp0 + ro + bj * HALF) = w8; }
                ss[sx] = sq; }
#undef RX_LD
        }
#pragma unroll
        for (int sx = 0; sx < 8; ++sx) { const float t = fq_sum(ss[sx]); if (fq == 0) ssp[(size_t)(row0 + (sx >> 2) * HALF + (sx & 3) * 16) * 32 + u.pn * 4 + wc] = t; }
        return true;
    }
};
struct EpiStoreRS {
    static constexpr bool PERM = true;
    bf16_t* O; int ldo; const float* ssp;
    __device__ __forceinline__ bool operator()(f32x4 (&acc)[2][2][4][2], const Unit& u, int wr, int wc, int, int) const {
        const int l = opaque_tid(0), fr = l & 15, fq = l >> 4;
        const int row0 = u.orow + wr * 64 + fr, col0 = u.ocol + wc * 32 + 8 * fq;
#pragma unroll
        for (int ai = 0; ai < 2; ++ai)
#pragma unroll
            for (int m = 0; m < 4; ++m) { const int row = row0 + ai * HALF + m * 16;
                const f32x4 p0 = *(const f32x4*)(ssp + (size_t)row * 32 + fq * 8), p1 = *(const f32x4*)(ssp + (size_t)row * 32 + fq * 8 + 4);
                const float tot = fq_sum((p0[0] + p0[1]) + (p0[2] + p0[3]) + (p1[0] + p1[1]) + (p1[2] + p1[3]));
                const float rs = 1.0f / __builtin_sqrtf(tot * (1.f / DM) + RMS_EPS);
                bf16_t* rowp = O + (size_t)row * ldo + col0;
#pragma unroll
                for (int bj = 0; bj < 2; ++bj) { const f32x4 v0 = acc[ai][bj][m][0] * rs, v1 = acc[ai][bj][m][1] * rs; u32x4 w; PG8_PACK(v0, v1, w); *(u32x4*)(rowp + bj * HALF) = w; } }
        return true;
    }
};

template <class Epi, class Sched, bool ALIGN_EPI, int LDA, int LDB, int KK, bool F8 = false>
__device__ __forceinline__ void gemm_phase(PG8_LAS unsigned char* lds, const Gemm g, const Sched& S, const Epi& E, int wave0) {
    const int tid = opaque_tid(wave0), wid = wave0, lane = tid & 63, wr = wid >> 2, wc = wid & 3, fr = lane & 15, fq = lane >> 4;
    constexpr int nt = KK / BK;
    unsigned voffA[2], voffB[2];
#pragma unroll
    for (int i = 0; i < 2; ++i) { int R, C; stage_rc(tid * 16 + i * 8192, R, C); const int Rb = Epi::PERM ? ((R & ~31) + perm32(R & 31)) : R;
        voffA[i] = (unsigned)(R * LDA + C) * 2u; voffB[i] = (unsigned)(Rb * LDB + C) * 2u; }
    const size_t kstep = (size_t)(BK * 2);
    constexpr size_t hstepA = (size_t)HALF * LDA * 2, hstepB = (size_t)HALF * LDB * 2;
    const unsigned ldsw = (unsigned)wid * 1024u;
    const int aoff = lds_byte(wr * 64 + fr, fq * 8), boff = lds_byte(wc * 32 + fr, fq * 8);
#define PG8_SA(b, h) (((b) * 2 + (h)) * HTB)
#define PG8_SB(b, h) ((4 + (b) * 2 + (h)) * HTB)
#define PG8_STAGE(bufoff, gbase, voff) do { _Pragma("unroll") for (int _i = 0; _i < 2; ++_i) \
        __builtin_amdgcn_global_load_lds((const unsigned*)((const char*)(gbase) + (voff)[_i]), (PG8_LAS unsigned*)(lds + (bufoff) + ldsw + _i * 8192), 16, 0, 0); } while (0)
#define PG8_LDA(dst, b, h) do { _Pragma("unroll") for (int m = 0; m < 4; ++m) _Pragma("unroll") for (int k = 0; k < 2; ++k) dst[m][k] = *(const PG8_LAS bf16x8*)(lds + PG8_SA(b, h) + aoff + m * 2048 + k * 1024); } while (0)
#define PG8_LDB(dst, b, h) do { _Pragma("unroll") for (int n = 0; n < 2; ++n) _Pragma("unroll") for (int k = 0; k < 2; ++k) dst[n][k] = *(const PG8_LAS bf16x8*)(lds + PG8_SB(b, h) + boff + n * 2048 + k * 1024); } while (0)
#define PG8_CAT(x) __builtin_shufflevector(__builtin_bit_cast(i32x4, (x)[0]), __builtin_bit_cast(i32x4, (x)[1]), 0, 1, 2, 3, 4, 5, 6, 7)
#define PG8_MMA(ai, bj, At, Bt) do { __builtin_amdgcn_s_setprio(1); _Pragma("unroll") for (int m = 0; m < 4; ++m) _Pragma("unroll") for (int n = 0; n < 2; ++n) { \
        if constexpr (F8) { const i32x8 a8_ = PG8_CAT(Bt[n]), b8_ = PG8_CAT(At[m]); asm volatile("v_mfma_scale_f32_16x16x128_f8f6f4 %0, %1, %2, %0, %3, %3 op_sel_hi:[0,0,0]" : "+v"(acc[ai][bj][m][n]) : "v"(a8_), "v"(b8_), "v"(one8)); } \
        else { _Pragma("unroll") for (int k = 0; k < 2; ++k) acc[ai][bj][m][n] = __builtin_amdgcn_mfma_f32_16x16x32_bf16(Bt[n][k], At[m][k], acc[ai][bj][m][n], 0, 0, 0); } } __builtin_amdgcn_s_setprio(0); } while (0)
#define PG8_WAIT_V(n) asm volatile("s_waitcnt vmcnt(" #n ")" ::: "memory")
#define PG8_WAIT_L(n) asm volatile("s_waitcnt lgkmcnt(" #n ")" ::: "memory")
#define PG8_BAR __builtin_amdgcn_s_barrier()
#define PG8_SCHED __builtin_amdgcn_sched_barrier(0)
    Unit cur, nxt; int ui = 0;
    if (!S.next(0, cur)) return;
    const int one8 = 0x7f7f7f7f; (void)one8;
    f32x4 acc[2][2][4][2];
#pragma unroll
    for (int a = 0; a < 2; ++a)
#pragma unroll
        for (int b = 0; b < 2; ++b)
#pragma unroll
            for (int m = 0; m < 4; ++m)
#pragma unroll
                for (int n = 0; n < 2; ++n) acc[a][b][m][n] = (f32x4){0.f, 0.f, 0.f, 0.f};
    bf16x8 At[4][2], B0[2][2], B1[2][2];
    const char* cA = (const char*)g.A + cur.aoff; const char* cB = (const char*)g.Bt + cur.boff;
    PG8_STAGE(PG8_SB(0, 0), cB, voffB); PG8_STAGE(PG8_SB(0, 1), cB + hstepB, voffB); PG8_STAGE(PG8_SA(0, 0), cA, voffA); PG8_STAGE(PG8_SA(0, 1), cA + hstepA, voffA);
    if (wr == 1) PG8_BAR;
    PG8_WAIT_V(2); PG8_BAR;
    PG8_STAGE(PG8_SB(1, 0), cB + kstep, voffB); PG8_STAGE(PG8_SA(1, 0), cA + kstep, voffA); PG8_STAGE(PG8_SB(1, 1), cB + hstepB + kstep, voffB);
    PG8_WAIT_V(6); PG8_BAR;
    for (;;) {
        const bool has_next = S.next(ui + 1, nxt);
        const char* nA = has_next ? (const char*)g.A + nxt.aoff : cA; const char* nB = has_next ? (const char*)g.Bt + nxt.boff : cB;
        for (int t = 0; t < nt; t += 2) {
            const bool last = (t == nt - 2);
            const char* a1 = cA + (size_t)(t + 1) * kstep;
            const char* a2 = last ? nA : cA + (size_t)(t + 2) * kstep; const char* b2 = last ? nB : cB + (size_t)(t + 2) * kstep;
            const char* a3 = a2 + kstep; const char* b3 = b2 + kstep;
            PG8_LDB(B0, 0, 0); PG8_LDB(B1, 0, 1); PG8_SCHED; PG8_LDA(At, 0, 0); PG8_STAGE(PG8_SA(1, 1), a1 + hstepA, voffA);
            PG8_WAIT_V(8); PG8_WAIT_L(0); PG8_BAR; PG8_MMA(0, 0, At, B0); PG8_MMA(0, 1, At, B1); PG8_BAR; PG8_SCHED;
            PG8_LDA(At, 0, 1); PG8_STAGE(PG8_SB(0, 0), b2, voffB); PG8_STAGE(PG8_SB(0, 1), b2 + hstepB, voffB); PG8_STAGE(PG8_SA(0, 0), a2, voffA);
            PG8_WAIT_V(8); PG8_WAIT_L(0); PG8_BAR; PG8_MMA(1, 0, At, B0); PG8_MMA(1, 1, At, B1); PG8_BAR; PG8_SCHED;
            PG8_LDB(B0, 1, 0); PG8_LDB(B1, 1, 1); PG8_SCHED; PG8_LDA(At, 1, 0); PG8_STAGE(PG8_SA(0, 1), a2 + hstepA, voffA);
            PG8_WAIT_V(8); PG8_WAIT_L(0); PG8_BAR; PG8_MMA(0, 0, At, B0); PG8_MMA(0, 1, At, B1); PG8_BAR; PG8_SCHED;
            PG8_LDA(At, 1, 1); PG8_STAGE(PG8_SB(1, 0), b3, voffB); PG8_STAGE(PG8_SB(1, 1), b3 + hstepB, voffB); PG8_STAGE(PG8_SA(1, 0), a3, voffA);
            PG8_WAIT_V(8); PG8_WAIT_L(0); PG8_BAR; PG8_MMA(1, 0, At, B0); PG8_MMA(1, 1, At, B1); PG8_BAR; PG8_SCHED;
        }
        if constexpr (ALIGN_EPI) { if (wr == 0) PG8_BAR; }
        if constexpr (F8) asm volatile("s_nop 15\n\ts_nop 15" ::: "memory");
        const bool fin = E(acc, cur, wr, wc, fr, fq);
        if (!has_next) break;
        if (fin) {
#pragma unroll
        for (int a = 0; a < 2; ++a)
#pragma unroll
            for (int b = 0; b < 2; ++b)
#pragma unroll
                for (int m = 0; m < 4; ++m)
#pragma unroll
                    for (int n = 0; n < 2; ++n) acc[a][b][m][n] = (f32x4){0.f, 0.f, 0.f, 0.f};
        }
        cur = nxt; cA = nA; cB = nB; ++ui;
        if constexpr (ALIGN_EPI) { if (wr == 1) PG8_BAR; }
    }
    PG8_WAIT_V(0);
    if constexpr (!ALIGN_EPI) { if (wr == 0) PG8_BAR; }
    PG8_BAR;
#undef PG8_SA
#undef PG8_SB
#undef PG8_STAGE
#undef PG8_LDA
#undef PG8_LDB
#undef PG8_MMA
#undef PG8_CAT
#undef PG8_WAIT_V
#undef PG8_WAIT_L
#undef PG8_BAR
#undef PG8_SCHED
}
}

namespace attn {
using bf16x8 = __attribute__((ext_vector_type(8))) short;
using s16x4  = __attribute__((ext_vector_type(4))) short;
using f32x16 = __attribute__((ext_vector_type(16))) float;
using u32x4  = __attribute__((ext_vector_type(4))) unsigned;
constexpr int   D = 128, NW = 8, QBLK = 32, KVBLK = 64;
constexpr float SCALE = 0.088388347648318440f;
constexpr float THR = 8.f;
constexpr size_t SHM_V = KVBLK * D * 2, SHM_K = KVBLK * D * 2;
constexpr int NBUF = 3;
constexpr int LDS_K0 = NBUF * (int)SHM_V, LDS_TAB = LDS_K0 + NBUF * (int)SHM_K, LDS_END = LDS_TAB + 8192 * 4, LDS_WS = 131072 + 8192;
#define KSWZ(row, colB) ((row) * 256 + ((colB) ^ (((row) & 7) << 4)))
#define SBAR() __builtin_amdgcn_sched_barrier(0)
__device__ __forceinline__ int crow(int r, int hi) { return (r & 3) + 8 * (r >> 2) + 4 * hi; }
__device__ __forceinline__ unsigned cvtpk(float lo, float hi) { unsigned r; asm volatile("v_cvt_pk_bf16_f32 %0, %1, %2" : "=v"(r) : "v"(lo), "v"(hi)); return r; }

__device__ __forceinline__ void partialSM(f32x16& p0, f32x16& p1, float& m_reg, float& mn, float& alpha) {
  constexpr float C = SCALE * 1.4426950408889634f;
  float pmax = p0[0]; for (int r = 1; r < 16; ++r) pmax = fmaxf(pmax, p0[r]); for (int r = 0; r < 16; ++r) pmax = fmaxf(pmax, p1[r]);
  { auto rr = __builtin_amdgcn_permlane32_swap(__float_as_uint(pmax), __float_as_uint(pmax), false, false);
    pmax = fmaxf(__uint_as_float(rr[0]), __uint_as_float(rr[1])); }
  if (__builtin_expect(__all(pmax - m_reg <= THR / SCALE), 1)) { mn = m_reg; alpha = 1.f; }
  else { mn = fmaxf(m_reg, pmax); alpha = __builtin_amdgcn_exp2f((m_reg - mn) * C); m_reg = mn; }
  float mnC = -mn * C;
  for (int r = 0; r < 16; ++r) p0[r] = fmaf(p0[r], C, mnC); for (int r = 0; r < 16; ++r) p1[r] = fmaf(p1[r], C, mnC);
  for (int r = 0; r < 16; ++r) p0[r] = __builtin_amdgcn_exp2f(p0[r]);
}
__device__ __forceinline__ void finishSM(f32x16& p0, f32x16& p1, float alpha, float& l_reg, bf16x8& pa0, bf16x8& pa1, bf16x8& pa2, bf16x8& pa3) {
  for (int r = 0; r < 16; ++r) p1[r] = __builtin_amdgcn_exp2f(p1[r]);
  float ps = 0; for (int r = 0; r < 16; ++r) ps += p0[r]; for (int r = 0; r < 16; ++r) ps += p1[r];
  { auto rr = __builtin_amdgcn_permlane32_swap(__float_as_uint(ps), __float_as_uint(ps), false, false);
    ps = __uint_as_float(rr[0]) + __uint_as_float(rr[1]); }
  l_reg = l_reg * alpha + ps;
#define PK4(P, BASE, OUT) do { unsigned a0 = cvtpk(P[BASE + 0], P[BASE + 1]), a1 = cvtpk(P[BASE + 2], P[BASE + 3]);   \
    unsigned b0 = cvtpk(P[BASE + 4], P[BASE + 5]), b1 = cvtpk(P[BASE + 6], P[BASE + 7]);                              \
    auto r0 = __builtin_amdgcn_permlane32_swap(a0, b0, false, false); auto r1 = __builtin_amdgcn_permlane32_swap(a1, b1, false, false); \
    u32x4 w = {r0[0], r1[0], r0[1], r1[1]}; OUT = *reinterpret_cast<bf16x8*>(&w); } while (0)
  PK4(p0, 0, pa0); PK4(p0, 8, pa1); PK4(p1, 0, pa2); PK4(p1, 8, pa3);
#undef PK4
}
__device__ __forceinline__ void qkt(f32x16& p0, f32x16& p1, const bf16* Ks, const bf16x8* qr, int r32, int hi, const float* tl) {
#pragma unroll
  for (int r = 0; r < 16; ++r) { p0[r] = tl[(r & 3) + 8 * (r >> 2)]; p1[r] = tl[32 + (r & 3) + 8 * (r >> 2)]; }
#pragma unroll
  for (int d0 = 0; d0 < 8; ++d0) { int cb = (d0 * 16 + hi * 8) * 2;
    bf16x8 b0 = *reinterpret_cast<const bf16x8*>((const char*)Ks + KSWZ(r32, cb));
    bf16x8 b1 = *reinterpret_cast<const bf16x8*>((const char*)Ks + KSWZ(32 + r32, cb));
    p0 = __builtin_amdgcn_mfma_f32_32x32x16_bf16(b0, qr[d0], p0, 0, 0, 0);
    p1 = __builtin_amdgcn_mfma_f32_32x32x16_bf16(b1, qr[d0], p1, 0, 0, 0); }
}
__device__ __forceinline__ int v_st(int k, int c) { const int kk = (k & ~0xC) | ((k & 4) << 1) | ((k & 8) >> 1); return ((kk >> 3) * 4 + (c >> 5)) * 512 + ((kk & 7) * 32 + (c & 31)) * 2; }
__device__ __forceinline__ int v_rd_base(int lane) { return ((lane & 3) << 3) | (((lane >> 2) & 3) << 6) | (((lane >> 4) & 1) << 5) | (((lane >> 5) & 1) << 8); }
constexpr int v_rd_off(int d0, int ks, int half) { return d0 * 512 + ks * 4096 + half * 2048; }
template <int OFF> __device__ __forceinline__ s16x4 tr_read(int vb) {
  s16x4 r; asm volatile("ds_read_b64_tr_b16 %0, %1 offset:%2" : "=&v"(r) : "v"(vb), "i"(OFF) : "memory"); return r;
}
template <int D0> __device__ __forceinline__ void pv_one(f32x16& od, int vb, bf16x8 pa0, bf16x8 pa1, bf16x8 pa2, bf16x8 pa3) {
  const s16x4 l0 = tr_read<v_rd_off(D0, 0, 0)>(vb), h0 = tr_read<v_rd_off(D0, 0, 1)>(vb), l1 = tr_read<v_rd_off(D0, 1, 0)>(vb), h1 = tr_read<v_rd_off(D0, 1, 1)>(vb);
  const s16x4 l2 = tr_read<v_rd_off(D0, 2, 0)>(vb), h2 = tr_read<v_rd_off(D0, 2, 1)>(vb), l3 = tr_read<v_rd_off(D0, 3, 0)>(vb), h3 = tr_read<v_rd_off(D0, 3, 1)>(vb);
  asm volatile("s_waitcnt lgkmcnt(0)" ::: "memory"); SBAR();
#define PK(L, H) (bf16x8){L[0], L[1], L[2], L[3], H[0], H[1], H[2], H[3]}
  od = __builtin_amdgcn_mfma_f32_32x32x16_bf16(pa0, PK(l0, h0), od, 0, 0, 0);
  od = __builtin_amdgcn_mfma_f32_32x32x16_bf16(pa1, PK(l1, h1), od, 0, 0, 0);
  od = __builtin_amdgcn_mfma_f32_32x32x16_bf16(pa2, PK(l2, h2), od, 0, 0, 0);
  od = __builtin_amdgcn_mfma_f32_32x32x16_bf16(pa3, PK(l3, h3), od, 0, 0, 0);
#undef PK
}
__device__ __forceinline__ void pv_d0(f32x16* o, int vb, bf16x8 pa0, bf16x8 pa1, bf16x8 pa2, bf16x8 pa3) {
  pv_one<0>(o[0], vb, pa0, pa1, pa2, pa3); pv_one<1>(o[1], vb, pa0, pa1, pa2, pa3); pv_one<2>(o[2], vb, pa0, pa1, pa2, pa3); pv_one<3>(o[3], vb, pa0, pa1, pa2, pa3);
}

struct VFrag { s16x4 l0, h0, l1, h1, l2, h2, l3, h3; };
template <int D0> __device__ __forceinline__ void v_issue(VFrag& f, int vb) {
  f.l0 = tr_read<v_rd_off(D0, 0, 0)>(vb); f.h0 = tr_read<v_rd_off(D0, 0, 1)>(vb); f.l1 = tr_read<v_rd_off(D0, 1, 0)>(vb); f.h1 = tr_read<v_rd_off(D0, 1, 1)>(vb);
  f.l2 = tr_read<v_rd_off(D0, 2, 0)>(vb); f.h2 = tr_read<v_rd_off(D0, 2, 1)>(vb); f.l3 = tr_read<v_rd_off(D0, 3, 0)>(vb); f.h3 = tr_read<v_rd_off(D0, 3, 1)>(vb);
}
__device__ __forceinline__ void v_mma(f32x16& od, const VFrag& f, bf16x8 pa0, bf16x8 pa1, bf16x8 pa2, bf16x8 pa3) {
#define PK(L, H) (bf16x8){L[0], L[1], L[2], L[3], H[0], H[1], H[2], H[3]}
  od = __builtin_amdgcn_mfma_f32_32x32x16_bf16(pa0, PK(f.l0, f.h0), od, 0, 0, 0);
  od = __builtin_amdgcn_mfma_f32_32x32x16_bf16(pa1, PK(f.l1, f.h1), od, 0, 0, 0);
  od = __builtin_amdgcn_mfma_f32_32x32x16_bf16(pa2, PK(f.l2, f.h2), od, 0, 0, 0);
  od = __builtin_amdgcn_mfma_f32_32x32x16_bf16(pa3, PK(f.l3, f.h3), od, 0, 0, 0);
#undef PK
}
__device__ __forceinline__ void pv_sm(f32x16* o, int vb, bf16x8 pa0, bf16x8 pa1, bf16x8 pa2, bf16x8 pa3, f32x16& p0, f32x16& p1, float& m_reg, float& mn, float& alpha) {
  constexpr float C = SCALE * 1.4426950408889634f;
  VFrag fa, fb, fc;
  v_issue<0>(fa, vb); v_issue<1>(fb, vb); v_issue<2>(fc, vb);
  asm volatile("s_waitcnt lgkmcnt(15)" ::: "memory"); SBAR();
  v_mma(o[0], fa, pa0, pa1, pa2, pa3);
  float pmax = p0[0];
#pragma unroll
  for (int r = 1; r < 16; ++r) pmax = fmaxf(pmax, p0[r]);
#pragma unroll
  for (int r = 0; r < 16; ++r) pmax = fmaxf(pmax, p1[r]);
  v_issue<3>(fa, vb);
  asm volatile("s_waitcnt lgkmcnt(15)" ::: "memory"); SBAR();
  v_mma(o[1], fb, pa0, pa1, pa2, pa3);
  { auto rr = __builtin_amdgcn_permlane32_swap(__float_as_uint(pmax), __float_as_uint(pmax), false, false);
    pmax = fmaxf(__uint_as_float(rr[0]), __uint_as_float(rr[1])); }
  if (__builtin_expect(__all(pmax - m_reg <= THR / SCALE), 1)) { mn = m_reg; alpha = 1.f; }
  else { mn = fmaxf(m_reg, pmax); alpha = __builtin_amdgcn_exp2f((m_reg - mn) * C); m_reg = mn; }
  const float mnC = -mn * C;
#define PIN(x) do { float t_ = (x); asm volatile("" : "+v"(t_)); (x) = t_; } while (0)
#pragma unroll
  for (int r = 0; r < 16; ++r) { p0[r] = fmaf(p0[r], C, mnC); PIN(p0[r]); }
  asm volatile("s_waitcnt lgkmcnt(8)" ::: "memory"); SBAR();
  v_mma(o[2], fc, pa0, pa1, pa2, pa3);
#pragma unroll
  for (int r = 0; r < 16; ++r) { p1[r] = fmaf(p1[r], C, mnC); PIN(p1[r]); }
#pragma unroll
  for (int r = 0; r < 8; ++r) { p0[r] = __builtin_amdgcn_exp2f(p0[r]); PIN(p0[r]); }
  asm volatile("s_waitcnt lgkmcnt(0)" ::: "memory"); SBAR();
  v_mma(o[3], fa, pa0, pa1, pa2, pa3);
#pragma unroll
  for (int r = 8; r < 16; ++r) p0[r] = __builtin_amdgcn_exp2f(p0[r]);
#undef PIN
}

struct Unit { const bf16* Q; const bf16* K; const bf16* V; bf16* O; float* lse; long ldq, ldk, ldo; int lse_ld, kt0, nt, qoff; };
__device__ __forceinline__ void attn_unit(const Unit& u, char* lds, int wave0) {
  const int tid = opaque_tid(wave0), wid = wave0, lane = tid & 63, r32 = lane & 31, hi = lane >> 5;
  LAS unsigned char* ldsl = (LAS unsigned char*)lds;
  float* ws = (float*)(lds + LDS_WS) + wid * 64; float* li_l = ws; float* al_l = ws + 32;
  const float* tabL = (const float*)(lds + LDS_TAB);
  float m_reg = -1e30f, l_reg = 0; f32x16 o[4] = {}; bf16x8 qr[8];
  const bf16* Qw = u.Q + (long)(wid * QBLK + r32) * u.ldq + hi * 8;
#pragma unroll
  for (int d0 = 0; d0 < 8; ++d0) qr[d0] = *reinterpret_cast<const bf16x8*>(Qw + d0 * 16);
  const int vrd = (int)(uintptr_t)lds + v_rd_base(lane);
  const long tstep = (long)KVBLK * u.ldk * 2;
  const char* Kh = (const char*)u.K + (long)u.kt0 * tstep; const char* Vh = (const char*)u.V + (long)u.kt0 * tstep;
  unsigned kofs[2], vofs[2];
#pragma unroll
  for (int i = 0; i < 2; ++i) { const int rowk = (wid + 8 * i) * 4 + (lane >> 4), chunk = (lane & 15) ^ (rowk & 7); kofs[i] = (unsigned)(rowk * (int)u.ldk * 2 + chunk * 16);
    const int blk = (wid + 8 * i) * 2 + (lane >> 5), kk = (blk >> 2) * 8 + ((lane & 31) >> 2), c = (blk & 3) * 32 + (lane & 3) * 8, k = (kk & ~0xC) | ((kk & 4) << 1) | ((kk & 8) >> 1);
    vofs[i] = (unsigned)((k * (int)u.ldk + c) * 2); }
  const float* tl0 = tabL + (4096 + u.kt0 * KVBLK + 4 * hi - (u.qoff + wid * QBLK + r32));
#define DMA(tj, b) do { const char* kt_ = Kh + (long)(tj) * tstep; const char* vt_ = Vh + (long)(tj) * tstep; _Pragma("unroll") for (int i_ = 0; i_ < 2; ++i_) { \
    __builtin_amdgcn_global_load_lds((const unsigned*)(kt_ + kofs[i_]), (LAS unsigned*)(ldsl + LDS_K0 + (b) * (int)SHM_K + (wid + 8 * i_) * 1024), 16, 0, 0); \
    __builtin_amdgcn_global_load_lds((const unsigned*)(vt_ + vofs[i_]), (LAS unsigned*)(ldsl + (b) * (int)SHM_V + (wid + 8 * i_) * 1024), 16, 0, 0); } } while (0)
#define KBUF(b) ((const bf16*)(lds + LDS_K0 + (b) * (int)SHM_K))
#define VBUF(b) (vrd + (b) * (int)SHM_V)
#define LANDED() do { asm volatile("s_waitcnt vmcnt(0)" ::: "memory"); __syncthreads(); } while (0)
#define RESC(a) do { if (__any((a) < 1.f)) { if (hi == 0) al_l[r32] = (a); asm volatile("s_waitcnt lgkmcnt(0)" ::: "memory"); \
    for (int d = 0; d < 4; ++d) for (int r = 0; r < 16; ++r) o[d][r] *= al_l[crow(r, hi)]; } } while (0)
  f32x16 pA0, pA1, pB0, pB1; float mnA, mnB, alA, alB; bf16x8 pa0, pa1, pa2, pa3; const int NT = u.nt;
  DMA(0, 0); DMA(1, 1);
  LANDED();
  qkt(pA0, pA1, KBUF(0), qr, r32, hi, tl0); partialSM(pA0, pA1, m_reg, mnA, alA);
  if (2 < NT) DMA(2, 2);
  int bp = 0, bc = 1, bn = 2;
  for (int t = 1; t + 1 < NT; t += 2) {
    SBAR(); qkt(pB0, pB1, KBUF(bc), qr, r32, hi, tl0 + t * KVBLK);
    finishSM(pA0, pA1, alA, l_reg, pa0, pa1, pa2, pa3); SBAR();
    pv_sm(o, VBUF(bp), pa0, pa1, pa2, pa3, pB0, pB1, m_reg, mnB, alB);
    RESC(alB);
    LANDED();
    { const int nb = bp; bp = bc; bc = bn; bn = nb; if (t + 2 < NT) DMA(t + 2, bn); }
    SBAR(); qkt(pA0, pA1, KBUF(bc), qr, r32, hi, tl0 + (t + 1) * KVBLK);
    finishSM(pB0, pB1, alB, l_reg, pa0, pa1, pa2, pa3); SBAR();
    pv_sm(o, VBUF(bp), pa0, pa1, pa2, pa3, pA0, pA1, m_reg, mnA, alA);
    RESC(alA);
    LANDED();
    { const int nb = bp; bp = bc; bc = bn; bn = nb; if (t + 3 < NT) DMA(t + 3, bn); }
  }
  SBAR(); qkt(pB0, pB1, KBUF(bc), qr, r32, hi, tl0 + (NT - 1) * KVBLK);
  finishSM(pA0, pA1, alA, l_reg, pa0, pa1, pa2, pa3); SBAR();
  pv_sm(o, VBUF(bp), pa0, pa1, pa2, pa3, pB0, pB1, m_reg, mnB, alB);
  RESC(alB);
  finishSM(pB0, pB1, alB, l_reg, pa0, pa1, pa2, pa3); SBAR();
  pv_d0(o, VBUF(bc), pa0, pa1, pa2, pa3);
  if (hi == 0) li_l[r32] = l_reg; asm volatile("s_waitcnt lgkmcnt(0)" ::: "memory");
  float rli[16];
#pragma unroll
  for (int r = 0; r < 16; ++r) rli[r] = __builtin_amdgcn_rcpf(li_l[crow(r, hi)]);
  bf16* Ow = u.O + (long)(wid * QBLK) * u.ldo;
#pragma unroll
  for (int r = 0; r < 16; ++r) { int orow = crow(r, hi);
#pragma unroll
    for (int d0 = 0; d0 < 4; ++d0) { const float v = o[d0][r] * rli[r]; Ow[(long)orow * u.ldo + d0 * 32 + r32] = (bf16)(cvtpk(v, v) & 0xffffu); } }
  if (u.lse != nullptr && hi == 0) u.lse[(long)(wid * QBLK + r32) * u.lse_ld] = m_reg * SCALE + __logf(l_reg);
#undef DMA
#undef KBUF
#undef VBUF
#undef LANDED
#undef RESC
}
#undef KSWZ
#undef SBAR
}

constexpr int NWAVES = 8;
constexpr size_t MiB = 1u << 20;
constexpr size_t WS_CTL = 0, CTL_ZERO_BYTES = 1 * MiB;
constexpr size_t WS_CS   = 1 * MiB;
constexpr size_t WS_SKBD = 1 * MiB + 256 * 1024;
constexpr size_t WS_TAB  = 2 * MiB;
constexpr size_t WS_LSE  = 3 * MiB;
constexpr size_t WS_SU   = 3 * MiB + 768 * 1024;
constexpr size_t WS_SH   = 3 * MiB + 832 * 1024;
constexpr size_t WS_WCAT = 4 * MiB, WS_WO = 12 * MiB, WS_WQ = 20 * MiB;
constexpr size_t WS_WIN  = 28 * MiB;
constexpr size_t WS_WG8  = WS_WIN + 16 * MiB;
constexpr size_t WS_DFT  = 84 * MiB;
constexpr size_t WS_U    = 148 * MiB, WS_V = 180 * MiB;
constexpr size_t WS_H8   = 212 * MiB;
constexpr size_t WS_H    = 276 * MiB;
constexpr size_t WS_PROJ = 340 * MiB;
constexpr size_t WS_G    = 596 * MiB;
constexpr size_t WS_ZT   = 788 * MiB;
constexpr size_t WS_OC   = 820 * MiB;
constexpr size_t WS_MG   = 884 * MiB;
constexpr size_t WS_SSP  = 276 * MiB;
constexpr size_t WS_X16  = 948 * MiB;
constexpr size_t WS_END  = 1012 * MiB;
#if DBG_MODE == 2
constexpr size_t WS_ACT = WS_PROJ + 208 * MiB;
#else
constexpr size_t WS_ACT = WS_PROJ + 200 * MiB;
#endif
constexpr size_t WS_Q = WS_PROJ, WS_SC = WS_PROJ + 64 * MiB, WS_IDS = WS_PROJ + 192 * MiB, WS_GATES = WS_PROJ + 200 * MiB;
constexpr int CW_BAR = 4096;
constexpr int CW_XRANK = 12288;
constexpr int CW_QUEUE = 16384;
constexpr int RING_BYTES = 131072, LDSCTL_OFF = RING_BYTES, MISC_OFF = LDSCTL_OFF + 320, LDS_BYTES = 147456;

#define LDS_WAIT() asm volatile("s_waitcnt lgkmcnt(0)" ::: "memory")
#define VM_WAIT() asm volatile("s_waitcnt vmcnt(0)" ::: "memory")
__device__ __forceinline__ unsigned f2bf(float f) { unsigned u = __builtin_bit_cast(unsigned, f); return (u + 0x7fffu + ((u >> 16) & 1u)) >> 16; }
__device__ __forceinline__ unsigned pk2(float lo, float hi) { return f2bf(lo) | (f2bf(hi) << 16); }
__device__ __forceinline__ float bflo(unsigned w) { return __uint_as_float(w << 16); }
__device__ __forceinline__ float bfhi(unsigned w) { return __uint_as_float(w & 0xffff0000u); }

#define XB_TMO      128
#define XB_XCNT(j)  (256  + 64 * (j))
#define XB_XSUB(j)  (1280 + 64 * (j))
#define XB_XGEN(j)  (2304 + 64 * (j))
#define XB_TOP      3328
#define XB_TOPGEN   3392
#define XCD_BAR_WORDS 3456
#define XB_SPIN_CAP (1u << 20)
__device__ __forceinline__ unsigned xb_ld(unsigned* p)              { return __hip_atomic_load(p, __ATOMIC_RELAXED, __HIP_MEMORY_SCOPE_AGENT); }
__device__ __forceinline__ unsigned xb_add(unsigned* p, unsigned v) { return __hip_atomic_fetch_add(p, v, __ATOMIC_RELAXED, __HIP_MEMORY_SCOPE_AGENT); }
__device__ __forceinline__ unsigned xb_xcc_id() { return (unsigned)__builtin_amdgcn_s_getreg((3 << 11) | 20) & 0xFu; }
#define XB_SPIN(cond, bar) do { unsigned _sp = 0; while (cond) { __builtin_amdgcn_s_sleep(1); \
    if ((++_sp & 255u) == 0u) { if (xb_ld(&(bar)[XB_TMO])) break; if (_sp > XB_SPIN_CAP) { atomicAdd(&(bar)[XB_TMO], 1u); break; } } } } while (0)
struct XcdBarrier { unsigned* bar; unsigned x; volatile LAS unsigned* st; };
__device__ __forceinline__ XcdBarrier xcd_barrier_post(unsigned* bar, volatile LAS unsigned* st) {
    XcdBarrier b; b.bar = bar; b.x = xb_xcc_id(); b.st = st;
    if (threadIdx.x == 0) (void)xb_add(&bar[XB_XCNT(b.x)], 1u);
    return b;
}
__device__ __forceinline__ void xcd_barrier_complete(unsigned* bar, unsigned x, unsigned& nloc, unsigned& nx) {
    const unsigned G = gridDim.x * gridDim.y * gridDim.z;
    unsigned sum, cnt, mine, sp = 0u;
    for (;;) {
        sum = 0u; cnt = 0u; mine = 0u;
#pragma unroll
        for (unsigned j = 0; j < 16; ++j) { const unsigned c = xb_ld(&bar[XB_XCNT(j)]); sum += c; cnt += (c > 0u) ? 1u : 0u; mine = (j == x) ? c : mine; }
        if (sum == G) break;
        __builtin_amdgcn_s_sleep(1);
        if ((++sp & 255u) == 0u) { if (xb_ld(&bar[XB_TMO])) break; if (sp > XB_SPIN_CAP) { atomicAdd(&bar[XB_TMO], 1u); break; } }
    }
    nloc = mine > 0u ? mine : 1u; nx = cnt > 0u ? cnt : 1u;
}
__device__ __forceinline__ void xcd_barrier(const XcdBarrier& b) {
    asm volatile("s_waitcnt vmcnt(0)" ::: "memory");
    __syncthreads();
    if (threadIdx.x == 0) {
        unsigned* bar = b.bar;
        __builtin_amdgcn_s_waitcnt(0);
        unsigned nloc = b.st[0], nx = b.st[1];
        if (nloc == 0u) { xcd_barrier_complete(bar, b.x, nloc, nx); b.st[0] = nloc; b.st[1] = nx; }
        const unsigned old = xb_add(&bar[XB_XSUB(b.x)], 1u);
        const unsigned gen = old / nloc;
        if (old + 1u == (gen + 1u) * nloc) {
            __builtin_amdgcn_fence(__ATOMIC_RELEASE, "agent");
            asm volatile("s_waitcnt vmcnt(0)" ::: "memory");
            const unsigned og = xb_add(&bar[XB_TOP], 1u);
            const unsigned tg = og / nx;
            if (og + 1u == (tg + 1u) * nx) xb_add(&bar[XB_TOPGEN], 1u);
            else XB_SPIN(xb_ld(&bar[XB_TOPGEN]) == tg, bar);
            __builtin_amdgcn_fence(__ATOMIC_ACQUIRE, "agent");
            xb_add(&bar[XB_XGEN(b.x)], 1u);
            asm volatile("s_waitcnt vmcnt(0)" ::: "memory");
        } else {
            XB_SPIN(xb_ld(&bar[XB_XGEN(b.x)]) == gen, bar);
            __builtin_amdgcn_fence(__ATOMIC_ACQUIRE, "agent");
            asm volatile("s_waitcnt vmcnt(0)" ::: "memory");
        }
    }
    __syncthreads();
}

template <int MASK> __device__ __forceinline__ int sx_i(int v) { return __builtin_amdgcn_ds_swizzle(v, 0x1f | (MASK << 10)); }
template <int MASK> __device__ __forceinline__ float sx_f(float v) { return __int_as_float(sx_i<MASK>(__float_as_int(v))); }
__device__ __forceinline__ float add32(float v) { auto rr = __builtin_amdgcn_permlane32_swap(__float_as_uint(v), __float_as_uint(v), false, false); return __uint_as_float(rr[0]) + __uint_as_float(rr[1]); }
__device__ __forceinline__ unsigned max32(unsigned v) { auto rr = __builtin_amdgcn_permlane32_swap(v, v, false, false); return rr[0] > rr[1] ? rr[0] : rr[1]; }
__device__ __forceinline__ float other32(float v, bool upper) { auto rr = __builtin_amdgcn_permlane32_swap(__float_as_uint(v), __float_as_uint(v), false, false); return __uint_as_float(upper ? rr[0] : rr[1]); }
__device__ __forceinline__ float bperm_f(float v, int src_lane) { return __int_as_float(__builtin_amdgcn_ds_bpermute(src_lane * 4, __float_as_int(v))); }
__device__ __forceinline__ int bperm_i(int v, int src_lane) { return __builtin_amdgcn_ds_bpermute(src_lane * 4, v); }
__device__ __forceinline__ float wave_sum(float v) {
    v += sx_f<1>(v); v += sx_f<2>(v); v += sx_f<4>(v); v += sx_f<8>(v); v += sx_f<16>(v); return add32(v);
}
__device__ __forceinline__ unsigned umax(unsigned a, unsigned b) { return a > b ? a : b; }
__device__ __forceinline__ unsigned wave_max_u32(unsigned v) {
    v = umax(v, (unsigned)sx_i<1>((int)v)); v = umax(v, (unsigned)sx_i<2>((int)v)); v = umax(v, (unsigned)sx_i<4>((int)v)); v = umax(v, (unsigned)sx_i<8>((int)v)); v = umax(v, (unsigned)sx_i<16>((int)v)); return max32(v);
}
template <int CTRL, int RMASK> __device__ __forceinline__ unsigned dpp_max_u(unsigned v) { const unsigned t = (unsigned)__builtin_amdgcn_update_dpp((int)v, (int)v, CTRL, RMASK, 0xF, false); return t > v ? t : v; }
__device__ __forceinline__ unsigned wave_max_dpp(unsigned v) {
    v = dpp_max_u<0xB1, 0xF>(v); v = dpp_max_u<0x4E, 0xF>(v); v = dpp_max_u<0x141, 0xF>(v); v = dpp_max_u<0x140, 0xF>(v); v = dpp_max_u<0x142, 0xA>(v); v = dpp_max_u<0x143, 0xC>(v);
    return (unsigned)__builtin_amdgcn_readlane((int)v, 63);
}
template <int CTRL> __device__ __forceinline__ float dpp_add_f(float v) { return v + __int_as_float(__builtin_amdgcn_update_dpp(__float_as_int(v), __float_as_int(v), CTRL, 0xF, 0xF, false)); }
__device__ __forceinline__ float row_sum16(float v) { v = dpp_add_f<0xB1>(v); v = dpp_add_f<0x4E>(v); v = dpp_add_f<0x141>(v); return dpp_add_f<0x140>(v); }
__device__ __forceinline__ unsigned row_max16_u(unsigned v) { v = dpp_max_u<0xB1, 0xF>(v); v = dpp_max_u<0x4E, 0xF>(v); v = dpp_max_u<0x141, 0xF>(v); return dpp_max_u<0x140, 0xF>(v); }
template <int CTRL> __device__ __forceinline__ float dpp_maxf(float v) { return fmaxf(v, __int_as_float(__builtin_amdgcn_update_dpp(__float_as_int(v), __float_as_int(v), CTRL, 0xF, 0xF, false))); }
__device__ __forceinline__ float row_max16_f(float v) { v = dpp_maxf<0xB1>(v); v = dpp_maxf<0x4E>(v); v = dpp_maxf<0x141>(v); return dpp_maxf<0x140>(v); }
__device__ __forceinline__ float okey_inv(unsigned k) { return __uint_as_float((k & 0x80000000u) ? (k & 0x7fffffffu) : ~k); }
#define CE_DESC(a, b) do { const unsigned hi_ = (a) > (b) ? (a) : (b), lo_ = (a) > (b) ? (b) : (a); (a) = hi_; (b) = lo_; } while (0)
__device__ __forceinline__ unsigned okey(float f) { const unsigned u = __float_as_uint(f); return (u & 0x80000000u) ? ~u : (u | 0x80000000u); }

__device__ __forceinline__ void tr_issue(f32x4 (&t)[8], const float* W, int N, int k0, int n0, int lane) {
#pragma unroll
    for (int i = 0; i < 8; ++i) t[i] = __builtin_nontemporal_load((const GAS f32x4*)(W + (size_t)(k0 + 8 * i + (lane >> 3)) * N + n0 + 4 * (lane & 7)));
}
__device__ __forceinline__ void tr_to_lds(const f32x4 (&t)[8], LAS float* scr, int lane) {
#pragma unroll
    for (int i = 0; i < 8; ++i) { LAS float* d = scr + (8 * i + (lane >> 3)) * 33 + 4 * (lane & 7); d[0] = t[i].x; d[1] = t[i].y; d[2] = t[i].z; d[3] = t[i].w; }
    LDS_WAIT(); asm volatile("" ::: "memory");
}
__device__ __forceinline__ void tr_finish_bf16(const f32x4 (&t)[8], LAS float* scr, bf16* WT, int ldo, int col_off, int k0, int n0, int row_delta, int lane, const float* gk = nullptr) {
    tr_to_lds(t, scr, lane);
    const int c = lane & 7;
    f32x4 g0 = {1.f, 1.f, 1.f, 1.f}, g1 = {1.f, 1.f, 1.f, 1.f}; if (gk) { g0 = *(const GAS f32x4*)(gk + k0 + 8 * c); g1 = *(const GAS f32x4*)(gk + k0 + 8 * c + 4); }
#pragma unroll
    for (int j = 0; j < 4; ++j) { const int n = (lane >> 3) + 8 * j; const LAS float* s = scr + (8 * c) * 33 + n;
        v4u o; o.x = pk2(s[0 * 33] * g0.x, s[1 * 33] * g0.y); o.y = pk2(s[2 * 33] * g0.z, s[3 * 33] * g0.w); o.z = pk2(s[4 * 33] * g1.x, s[5 * 33] * g1.y); o.w = pk2(s[6 * 33] * g1.z, s[7 * 33] * g1.w);
        *(GAS v4u*)(WT + (size_t)(n0 + n + row_delta) * ldo + col_off + k0 + 8 * c) = o; }
    LDS_WAIT(); asm volatile("" ::: "memory");
}
__device__ __forceinline__ void tr_finish_fp8(const f32x4 (&t)[8], LAS float* scr, unsigned char* WT8, int ldo, float scale, int k0, int n0, int ncol0, int lane) {
    tr_to_lds(t, scr, lane);
    const int c = lane & 3;
#pragma unroll
    for (int j = 0; j < 2; ++j) { const int n = (lane >> 2) + 16 * j; const LAS float* s = scr + (16 * c) * 33 + n; v4u o; int w;
        w = __builtin_amdgcn_cvt_pk_fp8_f32(s[0 * 33] * scale, s[1 * 33] * scale, 0, false); w = __builtin_amdgcn_cvt_pk_fp8_f32(s[2 * 33] * scale, s[3 * 33] * scale, w, true); o.x = (unsigned)w;
        w = __builtin_amdgcn_cvt_pk_fp8_f32(s[4 * 33] * scale, s[5 * 33] * scale, 0, false); w = __builtin_amdgcn_cvt_pk_fp8_f32(s[6 * 33] * scale, s[7 * 33] * scale, w, true); o.y = (unsigned)w;
        w = __builtin_amdgcn_cvt_pk_fp8_f32(s[8 * 33] * scale, s[9 * 33] * scale, 0, false); w = __builtin_amdgcn_cvt_pk_fp8_f32(s[10 * 33] * scale, s[11 * 33] * scale, w, true); o.z = (unsigned)w;
        w = __builtin_amdgcn_cvt_pk_fp8_f32(s[12 * 33] * scale, s[13 * 33] * scale, 0, false); w = __builtin_amdgcn_cvt_pk_fp8_f32(s[14 * 33] * scale, s[15 * 33] * scale, w, true); o.w = (unsigned)w;
        *(GAS v4u*)(WT8 + (size_t)(n0 + n - ncol0) * ldo + k0 + 16 * c) = o; }
    LDS_WAIT(); asm volatile("" ::: "memory");
}
__device__ __forceinline__ void transpose_item(const float* W, int N, bf16* WT, int ldo, int col_off, LAS float* scr, int item, int lane, int row_delta = 0) {
    const int nblk = N / 32, k0 = 64 * (item / nblk), n0 = 32 * (item % nblk); f32x4 t[8]; tr_issue(t, W, N, k0, n0, lane); tr_finish_bf16(t, scr, WT, ldo, col_off, k0, n0, row_delta, lane);
}
__device__ __forceinline__ void transpose_item_fp8(const float* W, int N, int ncol0, unsigned char* WT8, int ldo, float scale, LAS float* scr, int item, int lane) {
    const int nblk = N / 32, k0 = 64 * (item / nblk), n0 = 32 * (item % nblk); f32x4 t[8]; tr_issue(t, W, N, k0, n0, lane); tr_finish_fp8(t, scr, WT8, ldo, scale, k0, n0, ncol0, lane);
}
constexpr int NPCU = 32;
constexpr int NPREP = 512;
constexpr int I_IN = (DM / 64) * (INW / 32), I_A = (512 / 64) * (DM / 32), I_C = (1024 / 64) * (DM / 32), I_SQ = (DM / 64) * (DM / 32), I_OWN = 2 * I_A + I_C + 2 * I_SQ;
__device__ __forceinline__ void prep_win_item(const float* w_in, bf16* WIN, unsigned char* WG8, LAS float* scr, int r, int lane) {
    const int ct = ((r % (INW / 32)) * 32) >> 8;
    if (ct < 2) transpose_item(w_in, INW, WIN, DM, 0, scr, r, lane); else if (ct >= 28 && ct < 32) transpose_item(w_in, INW, WIN, DM, 0, scr, r, lane, -26 * 256);
    else transpose_item_fp8(w_in, INW, ct < 28 ? 2 * 256 : 6 * 256, WG8, DM, 1024.f, scr, r, lane);
}
template <bool FP8> __device__ __forceinline__ void rms_rows2_to_bf16(const float* xrow, size_t rstride, const float* g, bf16* orow, unsigned char* o8row, int lane) {
    const GAS f32x4* gr = (const GAS f32x4*)g + lane;
    f32x4 v[2][8];
#pragma unroll
    for (int u = 0; u < 2; ++u) { const GAS f32x4* xr = (const GAS f32x4*)(xrow + u * rstride) + lane;
#pragma unroll
        for (int j = 0; j < 8; ++j) v[u][j] = xr[64 * j]; }
#pragma unroll
    for (int u = 0; u < 2; ++u) { float s = 0.f;
#pragma unroll
        for (int j = 0; j < 8; ++j) s += (v[u][j].x * v[u][j].x + v[u][j].y * v[u][j].y) + (v[u][j].z * v[u][j].z + v[u][j].w * v[u][j].w);
        const float rstd = 1.0f / sqrtf(wave_sum(s) * (1.f / DM) + RMS_EPS);
        GAS unsigned long long* o8 = (GAS unsigned long long*)(orow + u * rstride) + lane;
#pragma unroll
        for (int j = 0; j < 8; ++j) { const f32x4 gg = gr[64 * j]; const float a = v[u][j].x * rstd * gg.x, b = v[u][j].y * rstd * gg.y, c = v[u][j].z * rstd * gg.z, d = v[u][j].w * rstd * gg.w;
            o8[64 * j] = (unsigned long long)pk2(a, b) | ((unsigned long long)pk2(c, d) << 32);
            if (FP8) { int w = __builtin_amdgcn_cvt_pk_fp8_f32(a * 32.f, b * 32.f, 0, false); w = __builtin_amdgcn_cvt_pk_fp8_f32(c * 32.f, d * 32.f, w, true); ((GAS unsigned*)(o8row + u * rstride))[lane + 64 * j] = (unsigned)w; } } }
}
typedef __bf16 bf2_t __attribute__((ext_vector_type(2)));
__device__ __forceinline__ float DOT2(unsigned a, unsigned b, float c) { return __builtin_amdgcn_fdot2_f32_bf16(__builtin_bit_cast(bf2_t, a), __builtin_bit_cast(bf2_t, b), c, false); }
__device__ __forceinline__ unsigned q8x4(float a, float b, float c, float d, float inv) {
    const int ia = (int)__builtin_rintf(a * inv), ib = (int)__builtin_rintf(b * inv), ic = (int)__builtin_rintf(c * inv), id = (int)__builtin_rintf(d * inv);
    return (unsigned)(ia & 0xff) | ((unsigned)(ib & 0xff) << 8) | ((unsigned)(ic & 0xff) << 16) | ((unsigned)(id & 0xff) << 24);
}
__device__ __forceinline__ float wave_maxf(float v) {
    v = fmaxf(v, sx_f<1>(v)); v = fmaxf(v, sx_f<2>(v)); v = fmaxf(v, sx_f<4>(v)); v = fmaxf(v, sx_f<8>(v)); v = fmaxf(v, sx_f<16>(v));
    auto rr = __builtin_amdgcn_permlane32_swap(__float_as_uint(v), __float_as_uint(v), false, false); return fmaxf(__uint_as_float(rr[0]), __uint_as_float(rr[1]));
}
template <int MODE> __device__ __forceinline__ void rms_rows2_from_bf16(const bf16* xrow, size_t rstride, const float* g, bf16* orow, unsigned char* o8row, float* sh, int shstride, int lane) {
    const GAS f32x4* gr = (const GAS f32x4*)g + 2 * lane;
    v4u xv[2][4];
#pragma unroll
    for (int u = 0; u < 2; ++u) { const GAS v4u* xr = (const GAS v4u*)(xrow + u * rstride) + lane;
#pragma unroll
        for (int j = 0; j < 4; ++j) xv[u][j] = xr[64 * j]; }
#pragma unroll
    for (int u = 0; u < 2; ++u) { float v[4][8]; float s = 0.f;
#pragma unroll
        for (int j = 0; j < 4; ++j) { const v4u w = xv[u][j]; v[j][0] = bflo(w.x); v[j][1] = bfhi(w.x); v[j][2] = bflo(w.y); v[j][3] = bfhi(w.y); v[j][4] = bflo(w.z); v[j][5] = bfhi(w.z); v[j][6] = bflo(w.w); v[j][7] = bfhi(w.w);
#pragma unroll
            for (int k = 0; k < 8; ++k) s += v[j][k] * v[j][k]; }
        const float rstd = 1.0f / sqrtf(wave_sum(s) * (1.f / DM) + RMS_EPS); float mx = 0.f;
#pragma unroll
        for (int j = 0; j < 4; ++j) { const f32x4 ga = gr[128 * j], gb = gr[128 * j + 1];
            v[j][0] *= rstd * ga.x; v[j][1] *= rstd * ga.y; v[j][2] *= rstd * ga.z; v[j][3] *= rstd * ga.w; v[j][4] *= rstd * gb.x; v[j][5] *= rstd * gb.y; v[j][6] *= rstd * gb.z; v[j][7] *= rstd * gb.w;
            if (MODE == 1) {
#pragma unroll
                for (int k = 0; k < 8; ++k) mx = fmaxf(mx, fabsf(v[j][k])); } }
        float inv = 32.f;
        if (MODE == 1) { mx = fmaxf(wave_maxf(mx), 1e-30f); inv = 127.f / mx; if (lane == 0) sh[u * shstride] = mx * (1.f / 127.f); }
        GAS v4u* ob = (GAS v4u*)(orow + u * rstride) + lane; GAS unsigned long long* o8 = (GAS unsigned long long*)(o8row + u * rstride) + lane;
#pragma unroll
        for (int j = 0; j < 4; ++j) { v4u o; o.x = pk2(v[j][0], v[j][1]); o.y = pk2(v[j][2], v[j][3]); o.z = pk2(v[j][4], v[j][5]); o.w = pk2(v[j][6], v[j][7]); ob[64 * j] = o;
            unsigned lo, hi;
            if (MODE == 0) { int w = __builtin_amdgcn_cvt_pk_fp8_f32(v[j][0] * inv, v[j][1] * inv, 0, false); w = __builtin_amdgcn_cvt_pk_fp8_f32(v[j][2] * inv, v[j][3] * inv, w, true); lo = (unsigned)w;
                w = __builtin_amdgcn_cvt_pk_fp8_f32(v[j][4] * inv, v[j][5] * inv, 0, false); w = __builtin_amdgcn_cvt_pk_fp8_f32(v[j][6] * inv, v[j][7] * inv, w, true); hi = (unsigned)w; }
            else { lo = q8x4(v[j][0], v[j][1], v[j][2], v[j][3], inv); hi = q8x4(v[j][4], v[j][5], v[j][6], v[j][7], inv); }
            o8[64 * j] = (unsigned long long)lo | ((unsigned long long)hi << 32); } }
}
__device__ __forceinline__ int rel_bucket(int rel) {
    const int n = rel < 0 ? -rel : rel;
    int b = n;
    if (n >= 8) { b = 5 + (31 - __builtin_clz((unsigned)n)); if (b > 15) b = 15; }
    return b + (rel > 0 ? 16 : 0);
}

#ifndef PH_D1
#define PH_D1 1
#endif
#ifndef PH_D2
#define PH_D2 1
#endif
#ifndef PH_A
#define PH_A 1
#endif
#ifndef PH_B
#define PH_B 1
#endif
#ifndef PH_C
#define PH_C 1
#endif
#ifndef PH_D
#define PH_D 1
#endif
#ifndef PH_E
#define PH_E 1
#endif
#ifndef PH_F
#define PH_F 1
#endif
#ifndef PH_G
#define PH_G 1
#endif
#ifndef PH_H
#define PH_H 1
#endif
#ifndef PH_I
#define PH_I 1
#endif
#ifndef PH_J
#define PH_J 1
#endif
#ifndef PH_K
#define PH_K 1
#endif
#ifndef PH_L
#define PH_L 1
#endif
struct Args { const float* in[17]; float* out; unsigned char* ws; };

#define CAS __attribute__((address_space(4)))
__device__ __forceinline__ const void* karg(int k) { const CAS char* ka = (const CAS char*)__builtin_amdgcn_kernarg_segment_ptr(); asm volatile("" : "+s"(ka)); return *(const void* const CAS*)(ka + 8 * k); }
#define WSP(T, off) ((T*)((unsigned char*)karg(18) + (off)))
#define INP(k) ((const float*)karg(k))
#define INL(k, stride) (INP(k) + (size_t)layer * (size_t)(stride))
#define X ((float*)karg(17))
#define X16 WSP(bf16, WS_X16)
__global__ void __launch_bounds__(NWAVES * 64, 2) mk_fwd(Args args_unused) {
    extern __shared__ __attribute__((aligned(16))) unsigned char lds[];
    LAS unsigned char* ldsl = (LAS unsigned char*)lds;
    volatile LAS unsigned* MISC = (volatile LAS unsigned*)(ldsl + MISC_OFF);
    const int wave0 = __builtin_amdgcn_readfirstlane((int)threadIdx.x >> 6);
    const int G = gridDim.x; const int bx = blockIdx.x; const int vcu = (G % 8 == 0) ? (bx % 8) * (G / 8) + bx / 8 : bx;
    const int NGW = G * NWAVES, NGT = NGW * 64;
#define PH_IDS() int wave_o_ = wave0, vcu_o_ = vcu; asm volatile("" : "+s"(wave_o_), "+s"(vcu_o_));     \
    const int tid = opaque_tid(wave_o_), lane = tid & 63, wave = wave_o_, gw = vcu_o_ * NWAVES + wave, gt = gw * 64 + lane; (void)gt; (void)gw; (void)lane
    gu32* ctl = (gu32*)WSP(unsigned char, WS_CTL);
    for (int u = threadIdx.x; u < (LDS_BYTES - LDSCTL_OFF) / 4; u += NWAVES * 64) ((LAS unsigned*)(ldsl + LDSCTL_OFF))[u] = 0u;
    __syncthreads();
    XcdBarrier bar = xcd_barrier_post((unsigned*)(ctl + CW_BAR), MISC + 8);
    if (threadIdx.x == 0) MISC[1] = __hip_atomic_fetch_add(ctl + CW_XRANK + 64 * (int)(xb_xcc_id() & 7u), 1u, __ATOMIC_RELAXED, __HIP_MEMORY_SCOPE_AGENT);
#define GRID_BAR() xcd_barrier(bar)

    for (int layer = 0; layer < 2; ++layer) {

#if PH_A
        {
            PH_IDS();
            LAS float* scr = (LAS float*)(ldsl + wave * 16384);
            const float* mix_g = INL(3, DM); const float* rel_bias = INP(1);
            bf16* H = WSP(bf16, WS_H); bf16* DFT = WSP(bf16, WS_DFT); bf16* CS = WSP(bf16, WS_CS); float* TAB = WSP(float, WS_TAB);
            if (layer == 0) { const float* w_in = INP(4); bf16* WIN = WSP(bf16, WS_WIN);
                for (int it = gw; it < I_IN; it += NGW) prep_win_item(w_in, WIN, WSP(unsigned char, WS_WG8), scr, it, lane); }
            if (layer == 0) { int m = gw; do { rms_rows2_to_bf16<true>(INP(0) + (size_t)m * DM, (size_t)NGW * DM, mix_g, H + (size_t)m * DM, WSP(unsigned char, WS_H8) + (size_t)m * DM, lane); m += 2 * NGW; } while (m < MTOK); }
            else { int m = gw; do { rms_rows2_from_bf16<0>(X16 + (size_t)m * DM, (size_t)NGW * DM, mix_g, H + (size_t)m * DM, WSP(unsigned char, WS_H8) + (size_t)m * DM, nullptr, 0, lane); m += 2 * NGW; } while (m < MTOK); }
            if (layer == 0) {
                for (size_t i = (size_t)gt; i < (size_t)2304 * 8192 / 8; i += (size_t)NGT) {
                    const int sp = (int)(i >> 10), k0 = (int)(i & 1023) * 8, part = k0 >> 12, s0 = k0 & 4095; float v[8];
#pragma unroll
                    for (int j = 0; j < 8; ++j) { const float ang = (float)(((s0 + j) * sp) & 4095) * (1.f / 4096.f); v[j] = (part ? -__builtin_amdgcn_sinf(ang) : __builtin_amdgcn_cosf(ang)) * (1.f / 64.f); }
                    v4u o; o.x = pk2(v[0], v[1]); o.y = pk2(v[2], v[3]); o.z = pk2(v[4], v[5]); o.w = pk2(v[6], v[7]); ((GAS v4u*)DFT)[i] = o;
                }
                for (int i = gt; i < 65536; i += NGT) { const int r = i >> 8, c = i & 255, part = r >> 7, cp = r & 127; float v = 0.f;
                    if (c < 128) { const float ang = (float)((c * cp) & 127) * (1.f / 128.f); v = (part ? __builtin_amdgcn_sinf(ang) : __builtin_amdgcn_cosf(ang)) * 0.08838834764831845f; }
                    CS[i] = (bf16)f2bf(v); }
                for (int i = gt; i < 16 * 8192; i += NGT) { const int hd = i >> 13, off = (i & 8191) - 4096; float v;
                    if (hd < 12) { const int g = hd >> 2, dil = g == 0 ? 1 : (g == 1 ? 4 : 16); v = (off >= -64 && off <= 64) ? rel_bias[rel_bucket(off * dil) * 16 + hd] * 11.313708498984761f : -1.0e5f; }
                    else v = rel_bias[rel_bucket(off) * 16 + hd] * 11.313708498984761f;
                    TAB[i] = v; }
            }
        }
#endif
        GRID_BAR();

#if PH_B
        {
            { pg8::Gemm g{WSP(bf16, WS_H), WSP(bf16, WS_WIN)}; pg8::StaticOrder S; S.init(MTOK, 6 * 256, G, bx, DM, DM);
              pg8::EpiProj E{WSP(bf16, WS_PROJ), WSP(unsigned char, WS_G), INL(5, GTW), 2, 0, 26, 1.f};
              pg8::gemm_phase<pg8::EpiProj, pg8::StaticOrder, true, DM, DM, DM>(ldsl, g, S, E, wave0); }
            { pg8::Gemm g{WSP(bf16, WS_H8), WSP(bf16, WS_WG8)}; pg8::StaticOrder S; S.init(MTOK, 50 * 256, G, (bx + G / 2) % G, DM / 2, DM / 2);
              pg8::EpiProj E{WSP(bf16, WS_PROJ), WSP(unsigned char, WS_G), INL(5, GTW), 26, 2, 6, 1.f / 32768.f};
              pg8::gemm_phase<pg8::EpiProj, pg8::StaticOrder, true, DM / 2, DM / 2, DM / 2, true>(ldsl, g, S, E, wave0); }
        }
#endif
        GRID_BAR();

#if PH_C
        {
            pg8::Gemm g{WSP(bf16, WS_CS), WSP(bf16, WS_PROJ)}; pg8::F1Order S{G, bx};
            pg8::EpiZT E{WSP(bf16, WS_ZT)};
            pg8::gemm_phase<pg8::EpiZT, pg8::F1Order, false, 256, PJW, 256>(ldsl, g, S, E, wave0);
        }
#endif
        GRID_BAR();

#if PH_D
#if PH_D1
        {
            pg8::Gemm g{WSP(bf16, WS_DFT), WSP(bf16, WS_ZT)}; pg8::StaticOrder S; S.init(2304, 2048, G, bx, 8192, 8192);
            pg8::EpiF2 E{WSP(bf16, WS_OC)};
            pg8::gemm_phase<pg8::EpiF2, pg8::StaticOrder, false, 8192, 8192, 8192>(ldsl, g, S, E, wave0);
        }
#endif
#if PH_D2
        {
            PH_IDS();
            gu32* qhead = ctl + CW_QUEUE + 64 * layer; gu32* phead = ctl + CW_QUEUE + 128 + 64 * layer; const bool pref = bx >= 128 && bx < 128 + NPCU;
            bf16* PROJ = WSP(bf16, WS_PROJ); bf16* DO = WSP(bf16, WS_MG); bf16* DL = WSP(bf16, WS_H); float* LSE = WSP(float, WS_LSE); const float* TAB = WSP(float, WS_TAB);
            const float* cur_tab = nullptr;
            for (;;) {
                __syncthreads();
                if (tid == 0) { unsigned w = 0xffffffffu;
                    if (pref) { const unsigned v = __hip_atomic_fetch_add(phead, 1u, __ATOMIC_RELAXED, __HIP_MEMORY_SCOPE_AGENT); if (v < (unsigned)NPREP) w = 0x8000u | v; }
                    if (w == 0xffffffffu) { const unsigned v = __hip_atomic_fetch_add(qhead, 1u, __ATOMIC_RELAXED, __HIP_MEMORY_SCOPE_AGENT); if (v < 1792u) w = v; }
                    if (w == 0xffffffffu && !pref) { const unsigned v = __hip_atomic_fetch_add(phead, 1u, __ATOMIC_RELAXED, __HIP_MEMORY_SCOPE_AGENT); if (v < (unsigned)NPREP) w = 0x8000u | v; }
                    MISC[0] = w; }
                __syncthreads();
                const int ui0 = __builtin_amdgcn_readfirstlane((int)MISC[0]);
                if (ui0 == -1) break;
                int ui = ui0;
                { const int grp = ui0 & 0x7fff;
                    if (ui0 & 0x8000) {
                        const int pi = grp, t3 = opaque_tid(wave0), ln = t3 & 63;
                        { const float* pu = INL(15, (size_t)NEXP * DM); const float* pv = INL(16, (size_t)NEXP * DM); unsigned char* U8 = WSP(unsigned char, WS_U); unsigned char* V8 = WSP(unsigned char, WS_V); float* SU = WSP(float, WS_SU);
                          const int e0 = 32 * pi + 4 * wave0; LAS float* scr = (LAS float*)(ldsl + wave0 * 8448);
                          const int tpi = layer == 0 ? (I_OWN + I_IN) / NPREP : I_OWN / NPREP;
                          struct TDsc { const float* W; const float* gk; bf16* WT; unsigned char* WT8; int N, k0, n0, col_off, rowd, fp8; };
                          auto tdesc = [&](int r) -> TDsc { TDsc d; d.WT8 = nullptr; d.WT = nullptr; d.gk = nullptr; d.fp8 = 0; d.rowd = 0; d.col_off = 0; d.N = DM;
                              if (r < I_A) { d.W = INL(6, 512 * DM); d.WT = WSP(bf16, WS_WCAT); }
                              else if ((r -= I_A) < I_A) { d.W = INL(7, 512 * DM); d.WT = WSP(bf16, WS_WCAT); d.col_off = 512; }
                              else if ((r -= I_A) < I_C) { d.W = INL(8, 1024 * DM); d.WT = WSP(bf16, WS_WCAT); d.col_off = 1024; }
                              else if ((r -= I_C) < I_SQ) { d.W = INL(11, DM * DM); d.WT = WSP(bf16, WS_WO); }
                              else if ((r -= I_SQ) < I_SQ) { d.W = INL(13, DM * DM); d.WT = WSP(bf16, WS_WQ); d.gk = INL(12, DM); }
                              else { r -= I_SQ; d.W = INP(4) + (size_t)DM * INW; d.N = INW; d.WT = WSP(bf16, WS_WIN); const int ct = ((r % (INW / 32)) * 32) >> 8;
                                  if (ct >= 28 && ct < 32) d.rowd = -26 * 256; else if (ct >= 2) { d.fp8 = 1; d.WT8 = WSP(unsigned char, WS_WG8); d.rowd = ct < 28 ? 2 * 256 : 6 * 256; } }
                              const int nblk = d.N / 32; d.k0 = 64 * (r / nblk); d.n0 = 32 * (r % nblk); return d; };
                          f32x4 buf[4][8];
#define PP_ISSUE(k) do { if ((k) < 8) { const GAS f32x4* rp_ = (const GAS f32x4*)(((k) < 4 ? pu : pv) + (size_t)(e0 + ((k) & 3)) * DM) + ln; \
                              _Pragma("unroll") for (int j_ = 0; j_ < 8; ++j_) buf[(k) & 3][j_] = __builtin_nontemporal_load(rp_ + 64 * j_); } \
                          else if (wave0 + NWAVES * ((k) - 8) < tpi) { const TDsc d_ = tdesc(pi * tpi + wave0 + NWAVES * ((k) - 8)); tr_issue(buf[(k) & 3], d_.W, d_.N, d_.k0, d_.n0, ln); } } while (0)
                          PP_ISSUE(0); PP_ISSUE(1); PP_ISSUE(2); PP_ISSUE(3);
#pragma unroll
                          for (int k = 0; k < 13; ++k) { f32x4 (&y)[8] = buf[k & 3];
                              if (k < 4) { const int e = e0 + k; float mx = 0.f;
                                  { const GAS f32x4* gp_ = (const GAS f32x4*)INL(12, DM) + ln;
#pragma unroll
                                    for (int j = 0; j < 8; ++j) y[j] = y[j] * gp_[64 * j]; }
#pragma unroll
                                  for (int j = 0; j < 8; ++j) mx = fmaxf(mx, fmaxf(fmaxf(fabsf(y[j].x), fabsf(y[j].y)), fmaxf(fabsf(y[j].z), fabsf(y[j].w))));
                                  mx = fmaxf(wave_maxf(mx), 1e-30f); const float inv = 127.f / mx;
#pragma unroll
                                  for (int j = 0; j < 8; ++j) ((GAS unsigned*)(U8 + (size_t)e * DM))[ln + 64 * j] = q8x4(y[j].x, y[j].y, y[j].z, y[j].w, inv);
                                  if (ln == 0) SU[e] = mx * (1.f / 127.f); }
                              else if (k < 8) { const int e = e0 + (k - 4);
#pragma unroll
                                  for (int j = 0; j < 8; ++j) { int w = __builtin_amdgcn_cvt_pk_fp8_f32(y[j].x * 64.f, y[j].y * 64.f, 0, false); w = __builtin_amdgcn_cvt_pk_fp8_f32(y[j].z * 64.f, y[j].w * 64.f, w, true);
                                      ((GAS unsigned*)(V8 + (size_t)e * DM))[ln + 64 * j] = (unsigned)w; } }
                              else if (wave0 + NWAVES * (k - 8) < tpi) { const TDsc d = tdesc(pi * tpi + wave0 + NWAVES * (k - 8));
                                  if (d.fp8) tr_finish_fp8(y, scr, d.WT8, DM, 1024.f, d.k0, d.n0, d.rowd, ln); else tr_finish_bf16(y, scr, d.WT, DM, d.col_off, d.k0, d.n0, d.rowd, ln, d.gk); }
                              if (k + 4 < 13) PP_ISSUE(k + 4);
                          }
#undef PP_ISSUE
                        }
                        continue;
                    }
                }
                attn::Unit u; int hd;
                if (ui < 1024) {
                    const int qb = ui & 15, vh = (ui >> 4) & 1, m = (ui >> 5) & 1, h = (ui >> 6) & 3, b = ui >> 8;
                    const bf16* base = PROJ + (size_t)b * SEQ * PJW;
                    u.Q = base + (size_t)(qb * 256) * PJW + COL_DIFF + (h * 2 + m) * 128; u.K = base + COL_DIFF + 1024 + (h * 2 + m) * 128; u.V = base + COL_DIFF + 2048 + h * 256 + vh * 128;
                    u.O = DO + (size_t)(b * SEQ + qb * 256) * DM + (h * 2 + m) * 256 + vh * 128; u.lse = nullptr; u.ldq = PJW; u.ldk = PJW; u.ldo = DM; u.lse_ld = 0;
                    u.kt0 = 0; u.nt = SEQ / 64; u.qoff = qb * 256; hd = 12 + h;
                } else {
                    const int v = ui - 1024, qb16 = v & 15, hh = (v >> 4) & 3, bg = v >> 6, g = bg % 3, b = bg / 3;
                    const int dil = g == 0 ? 1 : (g == 1 ? 4 : 16), bpc = 16 / dil, r = qb16 / bpc, qblk = qb16 % bpc, q0 = qblk * 256, ntot = (SEQ / dil) / 64;
                    int kt0 = q0 / 64 - 1; if (kt0 < 0) kt0 = 0; int kt1 = q0 / 64 + 5; if (kt1 > ntot) kt1 = ntot;
                    if ((kt1 - kt0) & 1) { if (kt0 > 0) --kt0; else ++kt1; }
                    const bf16* base = PROJ + (size_t)(b * SEQ + r) * PJW + COL_DIL + g * 512 + hh * 128;
                    u.Q = base + (size_t)q0 * dil * PJW; u.K = base + 1536; u.V = base + 3072;
                    u.O = DL + ((size_t)g * MTOK + b * SEQ + r + (size_t)q0 * dil) * 512 + hh * 128; u.lse = LSE + ((size_t)g * MTOK + b * SEQ + r + (size_t)q0 * dil) * 4 + hh;
                    u.ldq = (long)PJW * dil; u.ldk = (long)PJW * dil; u.ldo = 512L * dil; u.lse_ld = 4 * dil; u.kt0 = kt0; u.nt = kt1 - kt0; u.qoff = q0; hd = g * 4 + hh;
                }
                const float* tab = TAB + (size_t)hd * 8192;
                if (tab != cur_tab) {
                    cur_tab = tab;
                    LAS f32x4* tl = (LAS f32x4*)(ldsl + attn::LDS_TAB); const int t2 = opaque_tid(wave0);
#pragma unroll
                    for (int j = 0; j < 4; ++j) tl[t2 + 512 * j] = ((const GAS f32x4*)tab)[t2 + 512 * j];
                }
                attn::attn_unit(u, (char*)lds, wave0);
            }
        }
#endif
#endif
        GRID_BAR();

#if PH_E
        {
            PH_IDS();
            const float* dlam = INL(9, 512); const float* subln = INL(10, 256); const float lambda_init = layer == 0 ? 0.2f : 0.35550906759f;
            const float* LSE = WSP(float, WS_LSE); const bf16* DL = WSP(bf16, WS_H); const bf16* DO = WSP(bf16, WS_MG); bf16* OC = WSP(bf16, WS_OC);
            float s1 = dlam[lane] * dlam[128 + lane] + dlam[64 + lane] * dlam[192 + lane], s2 = dlam[256 + lane] * dlam[384 + lane] + dlam[320 + lane] * dlam[448 + lane];
            s1 = wave_sum(s1); s2 = wave_sum(s2);
            const float lam = __expf(s1) - __expf(s2) + lambda_init, osc = 1.0f - lambda_init;
            const int hq = lane >> 4, l16 = lane & 15;
            const f32x4 g0 = *(const GAS f32x4*)(subln + l16 * 16), g1 = *(const GAS f32x4*)(subln + l16 * 16 + 4), g2 = *(const GAS f32x4*)(subln + l16 * 16 + 8), g3 = *(const GAS f32x4*)(subln + l16 * 16 + 12);
            for (int t = gw; t < MTOK; t += 4 * NGW) {
                float ls[4][3]; v4u dl[4][3], da[4][4];
#pragma unroll
                for (int u = 0; u < 4; ++u) { const int tt = t + u * NGW;
#pragma unroll
                    for (int g = 0; g < 3; ++g) { ls[u][g] = LSE[((size_t)g * MTOK + tt) * 4 + hq]; dl[u][g] = *(const GAS v4u*)(DL + ((size_t)g * MTOK + tt) * 512 + lane * 8); }
                    const bf16* dp = DO + (size_t)tt * DM + hq * 512 + l16 * 16;
                    da[u][0] = *(const GAS v4u*)(dp); da[u][1] = *(const GAS v4u*)(dp + 8); da[u][2] = *(const GAS v4u*)(dp + 256); da[u][3] = *(const GAS v4u*)(dp + 264); }
#pragma unroll
                for (int u = 0; u < 4; ++u) { const int tt = t + u * NGW;
                    float mx = fmaxf(fmaxf(ls[u][0], ls[u][1]), ls[u][2]), wsum = 0.f;
#pragma unroll
                    for (int g = 0; g < 3; ++g) { ls[u][g] = __expf(ls[u][g] - mx); wsum += ls[u][g]; }
                    const float winv = 1.0f / wsum; float acc8[8] = {0.f, 0.f, 0.f, 0.f, 0.f, 0.f, 0.f, 0.f};
#pragma unroll
                    for (int g = 0; g < 3; ++g) { const v4u o = dl[u][g]; const float w = ls[u][g] * winv;
                        acc8[0] += w * bflo(o.x); acc8[1] += w * bfhi(o.x); acc8[2] += w * bflo(o.y); acc8[3] += w * bfhi(o.y); acc8[4] += w * bflo(o.z); acc8[5] += w * bfhi(o.z); acc8[6] += w * bflo(o.w); acc8[7] += w * bfhi(o.w); }
                    { v4u o; o.x = pk2(acc8[0], acc8[1]); o.y = pk2(acc8[2], acc8[3]); o.z = pk2(acc8[4], acc8[5]); o.w = pk2(acc8[6], acc8[7]); *(GAS v4u*)(OC + (size_t)tt * DM + 512 + lane * 8) = o; }
                    const v4u a0 = da[u][0], a1 = da[u][1], b0 = da[u][2], b1 = da[u][3];
                    float d[16];
                    d[0] = bflo(a0.x) - lam * bflo(b0.x); d[1] = bfhi(a0.x) - lam * bfhi(b0.x); d[2] = bflo(a0.y) - lam * bflo(b0.y); d[3] = bfhi(a0.y) - lam * bfhi(b0.y);
                    d[4] = bflo(a0.z) - lam * bflo(b0.z); d[5] = bfhi(a0.z) - lam * bfhi(b0.z); d[6] = bflo(a0.w) - lam * bflo(b0.w); d[7] = bfhi(a0.w) - lam * bfhi(b0.w);
                    d[8] = bflo(a1.x) - lam * bflo(b1.x); d[9] = bfhi(a1.x) - lam * bfhi(b1.x); d[10] = bflo(a1.y) - lam * bflo(b1.y); d[11] = bfhi(a1.y) - lam * bfhi(b1.y);
                    d[12] = bflo(a1.z) - lam * bflo(b1.z); d[13] = bfhi(a1.z) - lam * bfhi(b1.z); d[14] = bflo(a1.w) - lam * bflo(b1.w); d[15] = bfhi(a1.w) - lam * bfhi(b1.w);
                    float ss = 0.f;
#pragma unroll
                    for (int j = 0; j < 16; ++j) ss += d[j] * d[j];
                    ss += sx_f<1>(ss); ss += sx_f<2>(ss); ss += sx_f<4>(ss); ss += sx_f<8>(ss);
                    const float rs = osc / sqrtf(ss * (1.f / 256.f) + RMS_EPS);
                    v4u o0, o1;
                    o0.x = pk2(d[0] * rs * g0.x, d[1] * rs * g0.y); o0.y = pk2(d[2] * rs * g0.z, d[3] * rs * g0.w); o0.z = pk2(d[4] * rs * g1.x, d[5] * rs * g1.y); o0.w = pk2(d[6] * rs * g1.z, d[7] * rs * g1.w);
                    o1.x = pk2(d[8] * rs * g2.x, d[9] * rs * g2.y); o1.y = pk2(d[10] * rs * g2.z, d[11] * rs * g2.w); o1.z = pk2(d[12] * rs * g3.x, d[13] * rs * g3.y); o1.w = pk2(d[14] * rs * g3.z, d[15] * rs * g3.w);
                    bf16* op = OC + (size_t)tt * DM + 1024 + hq * 256 + l16 * 16;
                    *(GAS v4u*)(op) = o0; *(GAS v4u*)(op + 8) = o1; }
            }
        }
#endif
        GRID_BAR();

#if PH_F
        {
            pg8::MergeOrder S; S.init(MTOK, DM, G, bx, DM, DM);
            pg8::Gemm g{WSP(bf16, WS_OC), WSP(bf16, WS_WCAT)}; pg8::EpiMerge4 E{WSP(unsigned char, WS_G), WSP(bf16, WS_MG)};
            pg8::gemm_phase<pg8::EpiMerge4, pg8::MergeOrder, true, DM, DM, 512>(ldsl, g, S, E, wave0);
        }
#endif
        GRID_BAR();

#if PH_G
        {
            pg8::Gemm g{WSP(bf16, WS_MG), WSP(bf16, WS_WO)}; pg8::StaticOrder S; S.init(MTOK, DM, G, bx, DM, DM);
            pg8::EpiResX E{layer == 0 ? INP(0) : (const float*)nullptr, X16, X16, WSP(unsigned char, WS_H8), WSP(float, WS_SSP)};
            pg8::gemm_phase<pg8::EpiResX, pg8::StaticOrder, true, DM, DM, DM>(ldsl, g, S, E, wave0);
        }
#endif
        GRID_BAR();

#if PH_I
        {
            pg8::Gemm g{X16, WSP(bf16, WS_WQ)}; pg8::StaticOrder S; S.init(MTOK, DM, G, bx, DM, DM);
            pg8::EpiStoreRS E{WSP(bf16, WS_Q), DM, WSP(float, WS_SSP)};
            pg8::gemm_phase<pg8::EpiStoreRS, pg8::StaticOrder, true, DM, DM, DM>(ldsl, g, S, E, wave0);
        }
#endif
        GRID_BAR();

#if PH_K
        {
            PH_IDS();
            const bf16* Q = WSP(bf16, WS_Q); int* IDS = WSP(int, WS_IDS); float* GATES = WSP(float, WS_GATES);
            const int l16 = lane & 15, rbase = lane & 48, fq = lane >> 4;
            constexpr int SKP = 272;
            { const float* subk = INL(14, 2 * 128 * 128);
#pragma unroll
              for (int j = 0; j < 8; ++j) { const int ci = tid + 512 * j, kr = ci >> 4, c8 = ci & 15; const GAS f32x4* sp = (const GAS f32x4*)(subk + (size_t)kr * 128 + c8 * 8); const f32x4 lo = sp[0], hi4 = sp[1];
                  v4u w; w.x = pk2(lo.x, lo.y); w.y = pk2(lo.z, lo.w); w.z = pk2(hi4.x, hi4.y); w.w = pk2(hi4.z, hi4.w); *(LAS v4u*)(ldsl + kr * SKP + c8 * 16) = w; } }
            __syncthreads();
            int cq[4];
#pragma unroll
            for (int q = 0; q < 4; ++q) { int c = l16 + 16 * q, ci = -1, cj = 0; for (int i = 0; i < 16; ++i) { const int cnt = 16 / (i + 1); if (ci < 0) { if (c < cnt) { ci = i; cj = c; } else c -= cnt; } } cq[q] = ci < 0 ? -1 : ci * 16 + cj; }
            typedef short bfx8 __attribute__((ext_vector_type(8)));
            const LAS unsigned char* skl = ldsl + l16 * SKP + fq * 16;
            bfx8 nq[8];
            { const GAS bfx8* qp = (const GAS bfx8*)(Q + (size_t)(gw * 16 + l16) * 256 + fq * 8);
#pragma unroll
              for (int j = 0; j < 8; ++j) nq[j] = qp[4 * j]; }
            const int NTRIP = MTOK * 8 / 16;
            for (int trip = gw; trip < NTRIP; trip += NGW) {
                pg8::f32x4 sa[8], sb[8];
#pragma unroll
                for (int nb = 0; nb < 8; ++nb) { sa[nb] = (pg8::f32x4){0.f, 0.f, 0.f, 0.f}; sb[nb] = (pg8::f32x4){0.f, 0.f, 0.f, 0.f}; }
#pragma unroll
                for (int ks = 0; ks < 4; ++ks)
#pragma unroll
                    for (int n4 = 0; n4 < 8; n4 += 4) {
#pragma unroll
                        for (int nb = n4; nb < n4 + 4; ++nb) { const bfx8 ka_ = *(const LAS bfx8*)(skl + (nb * 16) * SKP + ks * 64), kb_ = *(const LAS bfx8*)(skl + (128 + nb * 16) * SKP + ks * 64);
                            sa[nb] = __builtin_amdgcn_mfma_f32_16x16x32_bf16(nq[ks], ka_, sa[nb], 0, 0, 0); sb[nb] = __builtin_amdgcn_mfma_f32_16x16x32_bf16(nq[4 + ks], kb_, sb[nb], 0, 0, 0); }
                        __builtin_amdgcn_sched_barrier(0); }
                { const int nt = trip + NGW < NTRIP ? trip + NGW : trip; const GAS bfx8* qp = (const GAS bfx8*)(Q + (size_t)(nt * 16 + l16) * 256 + fq * 8);
#pragma unroll
                  for (int j = 0; j < 8; ++j) nq[j] = qp[4 * j]; }
#pragma unroll
              for (int p4 = 0; p4 < 4; ++p4) {
                const int row = trip * 16 + 4 * fq + p4;
                unsigned ka[8], kb[8];
#pragma unroll
                for (int jj = 0; jj < 8; ++jj) { const unsigned ix = (unsigned)(127 - (jj * 16 + l16)); ka[jj] = (okey(sa[jj][p4]) & ~127u) | ix; kb[jj] = (okey(sb[jj][p4]) & ~127u) | ix; }
#define SORT8(k) do { CE_DESC(k[0], k[1]); CE_DESC(k[2], k[3]); CE_DESC(k[4], k[5]); CE_DESC(k[6], k[7]); CE_DESC(k[0], k[2]); CE_DESC(k[1], k[3]); CE_DESC(k[4], k[6]); CE_DESC(k[5], k[7]); \
    CE_DESC(k[1], k[2]); CE_DESC(k[5], k[6]); CE_DESC(k[0], k[4]); CE_DESC(k[3], k[7]); CE_DESC(k[1], k[5]); CE_DESC(k[2], k[6]); CE_DESC(k[1], k[4]); CE_DESC(k[3], k[6]); \
    CE_DESC(k[2], k[4]); CE_DESC(k[3], k[5]); CE_DESC(k[3], k[4]); } while (0)
                SORT8(ka); SORT8(kb);
                unsigned ta = 0u, tb = 0u;
#pragma unroll
                for (int r = 0; r < 16; ++r) {
                    const unsigned ma = row_max16_u(ka[0]), mb = row_max16_u(kb[0]);
                    const bool wa = ka[0] == ma, wb = kb[0] == mb;
                    ta = (l16 == r) ? ma : ta; tb = (l16 == r) ? mb : tb;
#pragma unroll
                    for (int q = 0; q < 7; ++q) { ka[q] = wa ? ka[q + 1] : ka[q]; kb[q] = wb ? kb[q + 1] : kb[q]; }
                    ka[7] = wa ? 0u : ka[7]; kb[7] = wb ? 0u : kb[7];
                }
                const int ia = 127 - (int)(ta & 127u), ib = 127 - (int)(tb & 127u);
                const float va = okey_inv(ta & ~127u), vb = okey_inv(tb & ~127u);
                unsigned ck[4];
#pragma unroll
                for (int q = 0; q < 4; ++q) { const int cc = cq[q] < 0 ? 0 : cq[q]; const float cs = bperm_f(va, rbase + (cc >> 4)) + bperm_f(vb, rbase + (cc & 15));
                    ck[q] = cq[q] < 0 ? 0u : ((okey(cs) & ~255u) | (unsigned)(255 - cc)); }
                CE_DESC(ck[0], ck[1]); CE_DESC(ck[2], ck[3]); CE_DESC(ck[0], ck[2]); CE_DESC(ck[1], ck[3]); CE_DESC(ck[1], ck[2]);
                unsigned tw = 0u;
#pragma unroll
                for (int r = 0; r < 16; ++r) { const unsigned mm = row_max16_u(ck[0]); const bool w = ck[0] == mm; tw = (l16 == r) ? mm : tw;
                    ck[0] = w ? ck[1] : ck[0]; ck[1] = w ? ck[2] : ck[1]; ck[2] = w ? ck[3] : ck[2]; ck[3] = w ? 0u : ck[3]; }
                const int code = 255 - (int)(tw & 255u), wi = (code >> 4) & 15, wj = code & 15;
                const float bs = bperm_f(va, rbase + wi) + bperm_f(vb, rbase + wj);
                const int eid = bperm_i(ia, rbase + wi) * 128 + bperm_i(ib, rbase + wj);
                const float mx = row_max16_f(bs), e = __expf(bs - mx), es = row_sum16(e);
                IDS[(size_t)row * 16 + l16] = eid; GATES[(size_t)row * 16 + l16] = e / es;
              }
            }
#undef SORT8
        }
#endif
        GRID_BAR();

#if PH_L
#define L_LDIDS(I, tt, hh) do { const GAS v4u* ip_ = (const GAS v4u*)(IDS + (size_t)(tt) * 128 + (hh) * 64 + lrow * 16); I##0 = ip_[0]; I##1 = ip_[1]; I##2 = ip_[2]; I##3 = ip_[3]; } while (0)
#define L_ISSUE(W, I, base) do { \
    W[0] = *(const GAS v4u*)((base) + (size_t)(I##0).x * DM); W[1] = *(const GAS v4u*)((base) + (size_t)(I##0).y * DM); W[2] = *(const GAS v4u*)((base) + (size_t)(I##0).z * DM); W[3] = *(const GAS v4u*)((base) + (size_t)(I##0).w * DM); \
    W[4] = *(const GAS v4u*)((base) + (size_t)(I##1).x * DM); W[5] = *(const GAS v4u*)((base) + (size_t)(I##1).y * DM); W[6] = *(const GAS v4u*)((base) + (size_t)(I##1).z * DM); W[7] = *(const GAS v4u*)((base) + (size_t)(I##1).w * DM); \
    W[8] = *(const GAS v4u*)((base) + (size_t)(I##2).x * DM); W[9] = *(const GAS v4u*)((base) + (size_t)(I##2).y * DM); W[10] = *(const GAS v4u*)((base) + (size_t)(I##2).z * DM); W[11] = *(const GAS v4u*)((base) + (size_t)(I##2).w * DM); \
    W[12] = *(const GAS v4u*)((base) + (size_t)(I##3).x * DM); W[13] = *(const GAS v4u*)((base) + (size_t)(I##3).y * DM); W[14] = *(const GAS v4u*)((base) + (size_t)(I##3).z * DM); W[15] = *(const GAS v4u*)((base) + (size_t)(I##3).w * DM); } while (0)
#define L_CVT(d, hi) __builtin_amdgcn_cvt_pk_f32_fp8((int)(d), (hi))
        {
            PH_IDS();
            const unsigned char* H8 = WSP(unsigned char, WS_H8); const unsigned char* U8 = WSP(unsigned char, WS_U); const int* IDS = WSP(int, WS_IDS); float* PART = WSP(float, WS_G);
            typedef float f32x2 __attribute__((ext_vector_type(2)));
            const int myx = (int)(xb_xcc_id() & 7u); int nx = 0, xi = 0, nloc = 1;
            for (int j = 0; j < 8; ++j) { const int c = (int)__hip_atomic_load(ctl + CW_XRANK + 64 * j, __ATOMIC_RELAXED, __HIP_MEMORY_SCOPE_AGENT); if (c > 0) { ++nx; if (j < myx) ++xi; } if (j == myx) nloc = c; }
            const int rw = (int)MISC[1] * NWAVES + wave, nW = nloc * NWAVES; const int l16 = lane & 15, lrow = lane >> 4;
#define L1_COMPUTE(W, dst) do { float sk[16]; _Pragma("unroll") for (int k = 0; k < 16; ++k) { const v4u ww = W[k]; int ac = 0; \
        ac = __builtin_amdgcn_sdot4((int)ww.x, (int)h0.x, ac, false); ac = __builtin_amdgcn_sdot4((int)ww.y, (int)h0.y, ac, false); ac = __builtin_amdgcn_sdot4((int)ww.z, (int)h0.z, ac, false); ac = __builtin_amdgcn_sdot4((int)ww.w, (int)h0.w, ac, false); \
        sk[k] = (float)ac; } \
          \
        float t8[8]; _Pragma("unroll") for (int j = 0; j < 8; ++j) { const float keep = b8 ? sk[8 + j] : sk[j], send = b8 ? sk[j] : sk[8 + j]; \
            t8[j] = keep + __int_as_float(__builtin_amdgcn_update_dpp(0, __float_as_int(send), 0x128, 0xF, 0xF, false)); } \
        float t4[4]; _Pragma("unroll") for (int j = 0; j < 4; ++j) { const float keep = b4 ? t8[4 + j] : t8[j], send = b4 ? t8[j] : t8[4 + j]; t4[j] = keep + sx_f<4>(send); } \
        float t2[2]; _Pragma("unroll") for (int j = 0; j < 2; ++j) { const float keep = b2 ? t4[2 + j] : t4[j], send = b2 ? t4[j] : t4[2 + j]; \
            t2[j] = keep + __int_as_float(__builtin_amdgcn_update_dpp(0, __float_as_int(send), 0x4E, 0xF, 0xF, false)); } \
        { const float keep = b1 ? t2[1] : t2[0], send = b1 ? t2[0] : t2[1]; dst = keep + __int_as_float(__builtin_amdgcn_update_dpp(0, __float_as_int(send), 0xB1, 0xF, 0xF, false)); } } while (0)
            const bool b8 = (lane & 8) != 0, b4 = (lane & 4) != 0, b2 = (lane & 2) != 0, b1 = (lane & 1) != 0;
            for (int sl = xi; sl < 8; sl += nx) {
                const unsigned char* ub = U8 + sl * 256 + l16 * 16; const unsigned char* hb = H8 + sl * 256 + l16 * 16;
                int t = rw;
                if (t < MTOK) {
                    v4u Wa[16], Wb[16]; v4u ia0, ia1, ia2, ia3, ib0, ib1, ib2, ib3; v4u h0;
                    L_LDIDS(ia, t, 0); L_LDIDS(ib, t, 1); h0 = *(const GAS v4u*)(hb + (size_t)t * DM);
                    L_ISSUE(Wa, ia, ub);
                    for (;;) {
                        const int tn = t + nW; const bool more = tn < MTOK; const int tp = more ? tn : t;
                        L_ISSUE(Wb, ib, ub);
                        L_LDIDS(ia, tp, 0); const v4u hn0 = *(const GAS v4u*)(hb + (size_t)tp * DM);
                        float pre0, pre1;
                        L1_COMPUTE(Wa, pre0);
                        L_ISSUE(Wa, ia, ub);
                        L_LDIDS(ib, tp, 1);
                        L1_COMPUTE(Wb, pre1);
                        float* pp = PART + ((size_t)sl * MTOK + t) * 128; pp[lane] = pre0; pp[64 + lane] = pre1;
                        h0 = hn0;
                        if (!more) break;
                        t = tn;
                    }
                }
            }
#undef L1_COMPUTE
        }
        GRID_BAR();
        {
            PH_IDS();
            const float* PART = WSP(float, WS_G); const float* GATES = WSP(float, WS_GATES); float* ACTW = WSP(float, WS_ACT);
            for (int t = gw; t < MTOK; t += NGW) {
                float q0 = 0.f, q1 = 0.f;
#pragma unroll
                for (int s8 = 0; s8 < 8; ++s8) { const float* pp = PART + ((size_t)s8 * MTOK + t) * 128; q0 += pp[lane]; q1 += pp[64 + lane]; }
                { const int* ip = WSP(int, WS_IDS) + (size_t)t * 128; float sh; { const float pv = lane < 32 ? WSP(float, WS_SSP)[(size_t)t * 32 + lane] : 0.f; sh = (1.0f / sqrtf(wave_sum(pv) * (1.f / DM) + RMS_EPS)) * (1.f / pg8::XS8); }     const float* SU = WSP(float, WS_SU); q0 *= SU[ip[lane]] * sh; q1 *= SU[ip[64 + lane]] * sh; }
                const float* gp = GATES + (size_t)t * 128; float* ap = ACTW + (size_t)t * 128;
                const float g0 = gp[lane], g1 = gp[64 + lane];
                ap[lane] = 0.5f * q0 * (1.0f + erff(q0 * 0.70710678118654752f)) * g0 * (1.f / 64.f); ap[64 + lane] = 0.5f * q1 * (1.0f + erff(q1 * 0.70710678118654752f)) * g1 * (1.f / 64.f);
            }
        }
        GRID_BAR();
        {
            PH_IDS();
            const unsigned char* V8 = WSP(unsigned char, WS_V); const int* IDS = WSP(int, WS_IDS); const float* ACT = WSP(float, WS_ACT);
            typedef float f32x2 __attribute__((ext_vector_type(2)));
            const int myx = (int)(xb_xcc_id() & 7u); int nx = 0, xi = 0, nloc = 1;
            for (int j = 0; j < 8; ++j) { const int c = (int)__hip_atomic_load(ctl + CW_XRANK + 64 * j, __ATOMIC_RELAXED, __HIP_MEMORY_SCOPE_AGENT); if (c > 0) { ++nx; if (j < myx) ++xi; } if (j == myx) nloc = c; }
            const int rw = (int)MISC[1] * NWAVES + wave, nW = nloc * NWAVES; const int l16 = lane & 15, lrow = lane >> 4;
            bf16* XO = X16;
#define L2_BC(av, acr) do { _Pragma("unroll") for (int k = 0; k < 16; ++k) av[k] = bperm_f(acr, (lane & 48) + k); } while (0)
#define L2_C4(Q, av, o) do { _Pragma("unroll") for (int k = 0; k < 4; ++k) { const float a = av[(o) + k]; const f32x2 aa = (f32x2){a, a}; \
        const v4u ww = Q[k]; const unsigned d0 = ww.x, d1 = ww.y, d2 = ww.z, d3 = ww.w; \
        oacc[0] += aa * L_CVT(d0, false); oacc[1] += aa * L_CVT(d0, true); oacc[2] += aa * L_CVT(d1, false); oacc[3] += aa * L_CVT(d1, true); \
        oacc[4] += aa * L_CVT(d2, false); oacc[5] += aa * L_CVT(d2, true); oacc[6] += aa * L_CVT(d3, false); oacc[7] += aa * L_CVT(d3, true); } } while (0)
#define L_ISS4(Q, Ia) do { Q[0] = *(const GAS v4u*)(vb + (size_t)(Ia).x * DM); Q[1] = *(const GAS v4u*)(vb + (size_t)(Ia).y * DM); Q[2] = *(const GAS v4u*)(vb + (size_t)(Ia).z * DM); Q[3] = *(const GAS v4u*)(vb + (size_t)(Ia).w * DM); } while (0)
            for (int sl = xi; sl < 8; sl += nx) {
                const unsigned char* vb = V8 + sl * 256 + l16 * 16; bf16* xb = XO + sl * 256 + l16 * 16;
                int t = rw;
                if (t < MTOK) {
                    v4u Q0[4], Q1[4], Q2[4], Q3[4], Q4[4], Q5[4], Q6[4], Q7[4]; v4u ia0, ia1, ia2, ia3, ib0, ib1, ib2, ib3; float ac0, ac1;
                    L_LDIDS(ia, t, 0); L_LDIDS(ib, t, 1); ac0 = ACT[(size_t)t * 128 + lane]; ac1 = ACT[(size_t)t * 128 + 64 + lane];
                    L_ISS4(Q0, ia0); L_ISS4(Q1, ia1); L_ISS4(Q2, ia2); L_ISS4(Q3, ia3); L_ISS4(Q4, ib0); L_ISS4(Q5, ib1); L_ISS4(Q6, ib2); L_ISS4(Q7, ib3);
                    for (;;) {
                        const int tn = t + nW; const bool more = tn < MTOK; const int tp = more ? tn : t;
                        L_LDIDS(ia, tp, 0); L_LDIDS(ib, tp, 1); const float an0 = ACT[(size_t)tp * 128 + lane], an1 = ACT[(size_t)tp * 128 + 64 + lane];
                        f32x2 oacc[8];
#pragma unroll
                        for (int k = 0; k < 8; ++k) oacc[k] = (f32x2){0.f, 0.f};
                        float av[16];
                        L2_BC(av, ac0);
                        L2_C4(Q0, av, 0); L_ISS4(Q0, ia0);
                        L2_C4(Q1, av, 4); L_ISS4(Q1, ia1);
                        L2_C4(Q2, av, 8); L_ISS4(Q2, ia2);
                        L2_C4(Q3, av, 12); L_ISS4(Q3, ia3);
                        v4u xv[2]; { const GAS v4u* q = (const GAS v4u*)(xb + (size_t)t * DM); xv[0] = q[0]; xv[1] = q[1]; }
                        L2_BC(av, ac1);
                        L2_C4(Q4, av, 0); L_ISS4(Q4, ib0);
                        L2_C4(Q5, av, 4); L_ISS4(Q5, ib1);
                        L2_C4(Q6, av, 8); L_ISS4(Q6, ib2);
                        L2_C4(Q7, av, 12); L_ISS4(Q7, ib3);
#pragma unroll
                        for (int k = 0; k < 8; ++k) { float a = oacc[k].x, b = oacc[k].y; a += sx_f<16>(a); b += sx_f<16>(b); a = add32(a); b = add32(b); oacc[k] = (f32x2){a, b}; }
                        if (lane < 16) { GAS v4u* q = (GAS v4u*)(xb + (size_t)t * DM);
#pragma unroll
                            for (int k = 0; k < 2; ++k) { const v4u xw = xv[k]; v4u o;
                                o.x = pk2(bflo(xw.x) + oacc[4 * k].x, bfhi(xw.x) + oacc[4 * k].y); o.y = pk2(bflo(xw.y) + oacc[4 * k + 1].x, bfhi(xw.y) + oacc[4 * k + 1].y);
                                o.z = pk2(bflo(xw.z) + oacc[4 * k + 2].x, bfhi(xw.z) + oacc[4 * k + 2].y); o.w = pk2(bflo(xw.w) + oacc[4 * k + 3].x, bfhi(xw.w) + oacc[4 * k + 3].y); q[k] = o; } }
                        ac0 = an0; ac1 = an1;
                        if (!more) break;
                        t = tn;
                    }
                }
            }
#undef L2_BC
#undef L2_C4
#undef L_ISS4
        }
#undef L_LDIDS
#undef L_ISSUE
#undef L_CVT
#endif
        GRID_BAR();
    }

    { PH_IDS(); const bf16* XS = X16;
    for (int m0 = gw; m0 < MTOK; m0 += 4 * NGW) {
        const GAS f32x4* gr = (const GAS f32x4*)INP(2) + 2 * lane;
        v4u xv[4][4];
#pragma unroll
        for (int u = 0; u < 4; ++u) { const GAS v4u* xr = (const GAS v4u*)(XS + (size_t)(m0 + u * NGW) * DM) + lane;
#pragma unroll
            for (int j = 0; j < 4; ++j) xv[u][j] = xr[64 * j]; }
#pragma unroll
        for (int u = 0; u < 4; ++u) { float v[4][8]; float s = 0.f;
#pragma unroll
            for (int j = 0; j < 4; ++j) { const v4u w = xv[u][j]; v[j][0] = bflo(w.x); v[j][1] = bfhi(w.x); v[j][2] = bflo(w.y); v[j][3] = bfhi(w.y); v[j][4] = bflo(w.z); v[j][5] = bfhi(w.z); v[j][6] = bflo(w.w); v[j][7] = bfhi(w.w);
#pragma unroll
                for (int k = 0; k < 8; ++k) s += v[j][k] * v[j][k]; }
            const float rstd = 1.0f / sqrtf(wave_sum(s) * (1.f / DM) + RMS_EPS);
            GAS f32x4* orow = (GAS f32x4*)(X + (size_t)(m0 + u * NGW) * DM) + 2 * lane;
#pragma unroll
            for (int j = 0; j < 4; ++j) { const f32x4 ga = gr[128 * j], gb = gr[128 * j + 1];
                orow[128 * j] = (f32x4){v[j][0] * rstd * ga.x, v[j][1] * rstd * ga.y, v[j][2] * rstd * ga.z, v[j][3] * rstd * ga.w};
                orow[128 * j + 1] = (f32x4){v[j][4] * rstd * gb.x, v[j][5] * rstd * gb.y, v[j][6] * rstd * gb.z, v[j][7] * rstd * gb.w}; } }
    } }
}

extern "C" void kernel_launch(void* const* d_in, const int* in_sizes, int n_in, void* d_out, int out_size, void* d_ws, size_t ws_size, hipStream_t stream) {
    static int grid = 0;
    if (grid == 0) {
        if (n_in != 17 || in_sizes[0] != MTOK * DM || out_size != MTOK * DM || ws_size < WS_END) {
            fprintf(stderr, "kernel_launch: shape/workspace mismatch: n_in %d in0 %d out %d ws %zu (need %zu); nothing launched\n", n_in, n_in > 0 ? in_sizes[0] : -1, out_size, ws_size, (size_t)WS_END); grid = -1; return; }
        int dev = 0, cus = 0, per_cu = 0;
        if (hipGetDevice(&dev) != hipSuccess || hipDeviceGetAttribute(&cus, hipDeviceAttributeMultiprocessorCount, dev) != hipSuccess) { grid = -1; return; }
        if (hipFuncSetAttribute((const void*)mk_fwd, hipFuncAttributeMaxDynamicSharedMemorySize, LDS_BYTES) != hipSuccess) { fprintf(stderr, "kernel_launch: hipFuncSetAttribute failed\n"); grid = -1; return; }
        if (hipOccupancyMaxActiveBlocksPerMultiprocessor(&per_cu, (const void*)mk_fwd, NWAVES * 64, LDS_BYTES) != hipSuccess || per_cu < 1)
            fprintf(stderr, "kernel_launch: note: occupancy query reports %d workgroups per CU\n", per_cu);
        (void)hipGetLastError();
        grid = cus;
    }
    if (grid < 0) return;
    if (hipMemsetAsync((char*)d_ws + WS_CTL, 0, CTL_ZERO_BYTES, stream) != hipSuccess) { fprintf(stderr, "kernel_launch: memset failed\n"); return; }
    Args a{};
    for (int i = 0; i < 17; ++i) a.in[i] = (const float*)d_in[i];
    a.out = (float*)d_out; a.ws = (unsigned char*)d_ws;
    hipLaunchKernelGGL(mk_fwd, dim3(grid), dim3(NWAVES * 64), LDS_BYTES, stream, a);
    const hipError_t le = hipPeekAtLastError();
    if (le != hipSuccess) fprintf(stderr, "kernel_launch: launch failed: %s\n", hipGetErrorName(le));
}
```

```cpp
#include <hip/hip_runtime.h>
#include <cstdio>
#include <cstdint>

#ifndef DBG_MODE
#define DBG_MODE 0
#endif
constexpr int DM = 2048, NB = 4, SEQ = 4096, MTOK = NB * SEQ;
constexpr int INW = 14336, PJW = 8192, GTW = 6144;
constexpr int COL_DIL = 512, COL_DIFF = 5120;
constexpr int NEXP = 16384;
constexpr float RMS_EPS = 1e-6f;

typedef unsigned short bf16;
#define GAS __attribute__((address_space(1)))
#define LAS __attribute__((address_space(3)))
typedef unsigned v4u __attribute__((ext_vector_type(4)));
typedef float f32x4 __attribute__((ext_vector_type(4)));
typedef GAS unsigned gu32;

__device__ __forceinline__ int opaque_tid(int wave_sgpr) { int l; asm volatile("v_mbcnt_lo_u32_b32 %0, -1, 0\n\tv_mbcnt_hi_u32_b32 %0, -1, %0" : "=v"(l)); return wave_sgpr * 64 + l; }
namespace pg8 {
#define PG8_LAS __attribute__((address_space(3)))
typedef unsigned short bf16_t;
typedef short bf16x8 __attribute__((ext_vector_type(8)));
typedef float f32x4 __attribute__((ext_vector_type(4)));
typedef unsigned u32x4 __attribute__((ext_vector_type(4)));
typedef unsigned u32x2 __attribute__((ext_vector_type(2)));
typedef int i32x4 __attribute__((ext_vector_type(4)));
typedef int i32x8 __attribute__((ext_vector_type(8)));
constexpr int BM = 256, BK = 64, HALF = 128, HTB = HALF * BK * 2, STAGE_BYTES = 8 * HTB, NXCD = 8, WGM = 8;

__host__ __device__ __forceinline__ int lds_byte(int r, int c) { const int st = (r >> 4) * 2 + (c >> 5), rr = r & 15, cc = c & 31, ob = rr * 64 + cc * 2; return st * 1024 + (ob ^ (((ob >> 9) & 1) << 5)); }
__host__ __device__ __forceinline__ void stage_rc(int b, int& R, int& C) { const int st = b / 1024, sb = b % 1024, swz = sb ^ (((sb >> 9) & 1) << 5); R = (st >> 1) * 16 + swz / 64; C = (st & 1) * 32 + (swz % 64) / 2; }
__host__ __device__ __forceinline__ int perm32(int rho) { const int n = rho >> 4, i = rho & 15; return 8 * (i >> 2) + 4 * n + (i & 3); }

struct Unit { int pm, pn; long aoff, boff; int orow, ocol, sub; };
struct Gemm { const bf16_t* A; const bf16_t* Bt; };

struct StaticOrder {
    int nM, nN, nwg, G, c; long sa, sb;
    __device__ void init(int M, int N, int G_, int c_, int lda, int ldb) { nM = M / BM; nN = N / BM; nwg = nM * nN; G = G_; c = c_; sa = 512L * lda; sb = 512L * ldb; }
    __device__ bool next(int i, Unit& u) const {
        const long L = (long)i * G + c; if (L >= nwg) return false;
        int wgid = (int)L; { const int q = nwg / NXCD, r = nwg % NXCD, xcd = wgid % NXCD, off = wgid / NXCD; wgid = (xcd < r ? xcd * (q + 1) : r * (q + 1) + (xcd - r) * q) + off; }
        const int nig = WGM * nN, gid = wgid / nig, fm = gid * WGM, gsz = (nM - fm) < WGM ? (nM - fm) : WGM;
        u.pm = fm + ((wgid % nig) % gsz); u.pn = (wgid % nig) / gsz;
        u.aoff = u.pm * sa; u.boff = u.pn * sb; u.orow = u.pm * BM; u.ocol = u.pn * BM; u.sub = 0; return true;
    }
};
struct MergeOrder : StaticOrder {
    __device__ bool next(int i, Unit& u) const { if (!StaticOrder::next(i >> 2, u)) return false; u.sub = i & 3; u.aoff += 1024L * u.sub; u.boff += 1024L * u.sub; return true; }
};
struct F2Order : StaticOrder {
    __device__ bool next(int i, Unit& u) const { if (!StaticOrder::next(i, u)) return false; u.orow = (u.pn >> 1) * 4096 + u.pm * BM; u.ocol = (u.pn & 1) * BM; return true; }
};
struct F1Order {
    int G, c;
    __device__ bool next(int i, Unit& u) const {
        const int idx = i * G + c; if (idx >= 256) return false;
        const int bg = idx >> 4, st = idx & 15, b = bg >> 2, g = bg & 3;
        u.pm = 0; u.pn = idx; u.aoff = 0; u.boff = ((long)(b * 4096 + st * 256) * PJW + g * 128) * 2; u.orow = bg * 128; u.ocol = st * 256; return true;
    }
};

__device__ __forceinline__ unsigned cvt_pk_bf16(float lo, float hi) { unsigned r; asm volatile("v_cvt_pk_bf16_f32 %0, %1, %2" : "=v"(r) : "v"(lo), "v"(hi)); return r; }
__device__ __forceinline__ float bf_lo(unsigned w) { return __uint_as_float(w << 16); }
__device__ __forceinline__ float bf_hi(unsigned w) { return __uint_as_float(w & 0xffff0000u); }

#define PG8_PACK(v0, v1, w) do { (w).x = cvt_pk_bf16((v0)[0], (v0)[1]); (w).y = cvt_pk_bf16((v0)[2], (v0)[3]); (w).z = cvt_pk_bf16((v1)[0], (v1)[1]); (w).w = cvt_pk_bf16((v1)[2], (v1)[3]); } while (0)

struct EpiStore {
    static constexpr bool PERM = true;
    bf16_t* O; int ldo;
    __device__ __forceinline__ bool operator()(f32x4 (&acc)[2][2][4][2], const Unit& u, int wr, int wc, int, int) const {
        const int l = opaque_tid(0), fr = l & 15, fq = l >> 4;
        const int row0 = u.orow + wr * 64 + fr, col0 = u.ocol + wc * 32 + 8 * fq;
#pragma unroll
        for (int ai = 0; ai < 2; ++ai)
#pragma unroll
            for (int m = 0; m < 4; ++m) { bf16_t* rowp = O + (size_t)(row0 + ai * HALF + m * 16) * ldo + col0;
#pragma unroll
                for (int bj = 0; bj < 2; ++bj) { u32x4 w; PG8_PACK(acc[ai][bj][m][0], acc[ai][bj][m][1], w); *(u32x4*)(rowp + bj * HALF) = w; } }
        return true;
    }
};
struct EpiF2 {
    static constexpr bool PERM = true;
    bf16_t* O;
    __device__ __forceinline__ bool operator()(f32x4 (&acc)[2][2][4][2], const Unit& u, int wr, int wc, int fr, int fq) const {
        const int b = u.pn >> 1, gcol0 = (u.pn & 1) * BM + wc * 32 + 8 * fq;
#pragma unroll
        for (int ai = 0; ai < 2; ++ai)
#pragma unroll
            for (int m = 0; m < 4; ++m) { const int sp = u.pm * BM + ai * HALF + wr * 64 + m * 16 + fr;
#pragma unroll
                for (int bj = 0; bj < 2; ++bj) { const int gcol = gcol0 + bj * HALF; u32x4 w; PG8_PACK(acc[ai][bj][m][0], acc[ai][bj][m][1], w);
                    if (sp <= 2048) *(u32x4*)(O + (size_t)(b * 4096 + sp) * DM + gcol) = w;
                    if (sp >= 1 && sp <= 2047) { bf16_t* mr = O + (size_t)(b * 4096 + 4096 - sp) * DM + (gcol & ~127); const int c0 = gcol & 127;
                        mr[(128 - c0) & 127] = (bf16_t)(w.x & 0xffffu); mr[127 - c0] = (bf16_t)(w.x >> 16); mr[126 - c0] = (bf16_t)(w.y & 0xffffu); mr[125 - c0] = (bf16_t)(w.y >> 16);
                        mr[124 - c0] = (bf16_t)(w.z & 0xffffu); mr[123 - c0] = (bf16_t)(w.z >> 16); mr[122 - c0] = (bf16_t)(w.w & 0xffffu); mr[121 - c0] = (bf16_t)(w.w >> 16); } } }
        return true;
    }
};
struct EpiZT {
    static constexpr bool PERM = true;
    bf16_t* O;
    __device__ __forceinline__ bool operator()(f32x4 (&acc)[2][2][4][2], const Unit& u, int wr, int wc, int fr, int fq) const {
        const int row0 = u.orow + wr * 64 + fr, col0 = u.ocol + wc * 32 + 8 * fq;
#pragma unroll
        for (int ai = 0; ai < 2; ++ai)
#pragma unroll
            for (int m = 0; m < 4; ++m) { bf16_t* rowp = O + (size_t)(row0 + m * 16) * 8192 + ai * 4096 + col0;
#pragma unroll
                for (int bj = 0; bj < 2; ++bj) { u32x4 w; PG8_PACK(acc[ai][bj][m][0], acc[ai][bj][m][1], w); *(u32x4*)(rowp + bj * HALF) = w; } }
        return true;
    }
};
struct EpiProj {
    static constexpr bool PERM = true;
    bf16_t* P; unsigned char* Gt; const float* bg; int split, off_lo, off_hi; float scale;
    __device__ __forceinline__ bool operator()(f32x4 (&acc)[2][2][4][2], const Unit& u, int wr, int wc, int fr, int fq) const {
        const int pnn = u.pn < split ? u.pn + off_lo : u.pn + off_hi; const bool isg = pnn >= 32;
        const int row0 = u.pm * BM + wr * 64 + fr, col0 = (isg ? pnn - 32 : pnn) * BM + wc * 32 + 8 * fq;
        f32x4 bv[2][2];
#pragma unroll
        for (int bj = 0; bj < 2; ++bj)
#pragma unroll
            for (int n = 0; n < 2; ++n) bv[bj][n] = isg ? *(const f32x4*)(bg + col0 + bj * HALF + 4 * n) : (f32x4){0.f, 0.f, 0.f, 0.f};
#pragma unroll
        for (int ai = 0; ai < 2; ++ai)
#pragma unroll
            for (int m = 0; m < 4; ++m) { const size_t r = (size_t)(row0 + ai * HALF + m * 16);
#pragma unroll
                for (int bj = 0; bj < 2; ++bj) { f32x4 v0 = acc[ai][bj][m][0] * scale + bv[bj][0], v1 = acc[ai][bj][m][1] * scale + bv[bj][1];
                    if (isg) { unsigned q0[4], q1[4];
#pragma unroll
                        for (int j = 0; j < 4; ++j) { const float g0 = __builtin_amdgcn_rcpf(1.0f + __builtin_amdgcn_exp2f(-1.4426950408889634f * v0[j])), g1 = __builtin_amdgcn_rcpf(1.0f + __builtin_amdgcn_exp2f(-1.4426950408889634f * v1[j]));
                            const int i0 = (int)(g0 * 256.f), i1 = (int)(g1 * 256.f); q0[j] = (unsigned)(i0 > 255 ? 255 : i0); q1[j] = (unsigned)(i1 > 255 ? 255 : i1); }
                        u32x2 w; w.x = q0[0] | (q0[1] << 8) | (q0[2] << 16) | (q0[3] << 24); w.y = q1[0] | (q1[1] << 8) | (q1[2] << 16) | (q1[3] << 24);
                        *(u32x2*)(Gt + r * GTW + col0 + bj * HALF) = w;
                    } else { u32x4 w; PG8_PACK(v0, v1, w); *(u32x4*)(P + r * PJW + col0 + bj * HALF) = w; } } }
        return true;
    }
};
struct EpiMerge4 {
    static constexpr bool PERM = true;
    const unsigned char* Gt; bf16_t* O;
#define MG_U(w, k) ((float)(((w) >> (8 * (k))) & 0xffu) + 0.5f)
    __device__ __forceinline__ bool operator()(f32x4 (&acc)[2][2][4][2], const Unit& u, int wr, int wc, int fr, int fq) const {
        const int row0 = u.pm * BM + wr * 64 + fr, col0 = u.pn * BM + wc * 32 + 8 * fq;
        if (u.sub == 2) return false;
        if (u.sub < 2) {
            const unsigned char* gp0 = Gt + (size_t)row0 * GTW + u.sub * DM + col0;
            u32x2 gn[2][2], gd[2][2];
#define MG_LD(st, sx) do { const unsigned char* gp_ = gp0 + (size_t)(((sx) >> 2) * HALF + ((sx) & 3) * 16) * GTW; gn[st][0] = *(const u32x2*)gp_; gd[st][0] = *(const u32x2*)(gp_ + DM); gn[st][1] = *(const u32x2*)(gp_ + HALF); gd[st][1] = *(const u32x2*)(gp_ + DM + HALF); } while (0)
            MG_LD(0, 0);
#pragma unroll
            for (int sx = 0; sx < 8; ++sx) { const int ai = sx >> 2, m = sx & 3, st = sx & 1;
                if (sx + 1 < 8) MG_LD((sx + 1) & 1, sx + 1);
                asm volatile("" ::: "memory");
#pragma unroll
                for (int bj = 0; bj < 2; ++bj) { const u32x2 n2 = gn[st][bj], d2 = gd[st][bj];
                    f32x4 r0, r1;
#pragma unroll
                    for (int k = 0; k < 4; ++k) { r0[k] = MG_U(n2.x, k) * __builtin_amdgcn_rcpf(MG_U(d2.x, k)); r1[k] = MG_U(n2.y, k) * __builtin_amdgcn_rcpf(MG_U(d2.y, k)); }
                    acc[ai][bj][m][0] *= r0; acc[ai][bj][m][1] *= r1; } }
#undef MG_LD
            return false;
        }
        {
            const unsigned char* gp0 = Gt + (size_t)row0 * GTW + 2 * DM + col0; bf16_t* op0 = O + (size_t)row0 * DM + col0;
            u32x2 gg[2][2];
#define MG_LD(st, sx) do { const unsigned char* gp_ = gp0 + (size_t)(((sx) >> 2) * HALF + ((sx) & 3) * 16) * GTW; gg[st][0] = *(const u32x2*)gp_; gg[st][1] = *(const u32x2*)(gp_ + HALF); } while (0)
            MG_LD(0, 0);
#pragma unroll
            for (int sx = 0; sx < 8; ++sx) { const int ai = sx >> 2, m = sx & 3, st = sx & 1;
                if (sx + 1 < 8) MG_LD((sx + 1) & 1, sx + 1);
                asm volatile("" ::: "memory");
                bf16_t* rowp = op0 + (size_t)(ai * HALF + m * 16) * DM;
#pragma unroll
                for (int bj = 0; bj < 2; ++bj) { const u32x2 g = gg[st][bj];
                    f32x4 v0 = acc[ai][bj][m][0], v1 = acc[ai][bj][m][1];
#pragma unroll
                    for (int k = 0; k < 4; ++k) { v0[k] *= MG_U(g.x, k) * (1.f / 256.f); v1[k] *= MG_U(g.y, k) * (1.f / 256.f); }
                    u32x4 w; PG8_PACK(v0, v1, w); *(u32x4*)(rowp + bj * HALF) = w; } }
#undef MG_LD
        }
        return true;
    }
#undef MG_U
};
struct EpiResF32 {
    static constexpr bool PERM = false;
    const float* base; float* out; int ldc;
    __device__ __forceinline__ bool operator()(f32x4 (&acc)[2][2][4][2], const Unit& u, int wr, int wc, int fr, int fq) const {
        const int row0 = u.orow + wr * 64 + fr, col0 = u.ocol + wc * 32 + 4 * fq;
        if (base) {
            f32x4 bb[2][4];
#define RS_LD(st, sx) do { const float* bp_ = base + (size_t)(row0 + ((sx) >> 2) * HALF + ((sx) & 3) * 16) * ldc + col0; bb[st][0] = *(const f32x4*)bp_; bb[st][1] = *(const f32x4*)(bp_ + 16); bb[st][2] = *(const f32x4*)(bp_ + HALF); bb[st][3] = *(const f32x4*)(bp_ + HALF + 16); } while (0)
            RS_LD(0, 0);
#pragma unroll
            for (int sx = 0; sx < 8; ++sx) { const int ai = sx >> 2, m = sx & 3, st = sx & 1;
                if (sx + 1 < 8) RS_LD((sx + 1) & 1, sx + 1);
                asm volatile("" ::: "memory");
                float* op = out + (size_t)(row0 + ai * HALF + m * 16) * ldc + col0;
#pragma unroll
                for (int bj = 0; bj < 2; ++bj)
#pragma unroll
                    for (int n = 0; n < 2; ++n) *(f32x4*)(op + bj * HALF + n * 16) = acc[ai][bj][m][n] + bb[st][bj * 2 + n]; }
#undef RS_LD
            return true;
        }
#pragma unroll
        for (int ai = 0; ai < 2; ++ai)
#pragma unroll
            for (int m = 0; m < 4; ++m) { const size_t off = (size_t)(row0 + ai * HALF + m * 16) * ldc + col0;
#pragma unroll
                for (int bj = 0; bj < 2; ++bj)
#pragma unroll
                    for (int n = 0; n < 2; ++n) *(f32x4*)(out + off + bj * HALF + n * 16) = acc[ai][bj][m][n];
                asm volatile("" ::: "memory"); }
        return true;
    }
};

constexpr float XS8 = 12.f;
__device__ __forceinline__ unsigned q8fix(const f32x4 v) {
    const int a = (int)__builtin_rintf(fminf(fmaxf(v[0] * XS8, -127.f), 127.f)), b = (int)__builtin_rintf(fminf(fmaxf(v[1] * XS8, -127.f), 127.f)),
              c = (int)__builtin_rintf(fminf(fmaxf(v[2] * XS8, -127.f), 127.f)), d = (int)__builtin_rintf(fminf(fmaxf(v[3] * XS8, -127.f), 127.f));
    return (unsigned)(a & 0xff) | ((unsigned)(b & 0xff) << 8) | ((unsigned)(c & 0xff) << 16) | ((unsigned)(d & 0xff) << 24);
}
__device__ __forceinline__ float fq_sum(float v) {
    v += __int_as_float(__builtin_amdgcn_ds_swizzle(__float_as_int(v), 0x1f | (16 << 10)));
    auto rr = __builtin_amdgcn_permlane32_swap(__float_as_uint(v), __float_as_uint(v), false, false); return __uint_as_float(rr[0]) + __uint_as_float(rr[1]);
}
struct EpiResX {
    static constexpr bool PERM = true;
    const float* base32; const bf16_t* base16; bf16_t* out; unsigned char* x8; float* ssp;
    __device__ __forceinline__ bool operator()(f32x4 (&acc)[2][2][4][2], const Unit& u, int wr, int wc, int fr, int fq) const {
        const int row0 = u.orow + wr * 64 + fr, col0 = u.ocol + wc * 32 + 8 * fq;
        bf16_t* op0 = out + (size_t)row0 * DM + col0; unsigned char* xp0 = x8 + (size_t)row0 * DM + col0;
        float ss[8];
        if (base32) {
            const float* bp0 = base32 + (size_t)row0 * DM + col0;
            f32x4 bb[2][4];
#define RX_LD(st, sx) do { const float* bp_ = bp0 + (size_t)(((sx) >> 2) * HALF + ((sx) & 3) * 16) * DM; bb[st][0] = *(const f32x4*)bp_; bb[st][1] = *(const f32x4*)(bp_ + 4); bb[st][2] = *(const f32x4*)(bp_ + HALF); bb[st][3] = *(const f32x4*)(bp_ + HALF + 4); } while (0)
            RX_LD(0, 0);
#pragma unroll
            for (int sx = 0; sx < 8; ++sx) { const int ai = sx >> 2, m = sx & 3, st = sx & 1;
                if (sx + 1 < 8) RX_LD((sx + 1) & 1, sx + 1);
                asm volatile("" ::: "memory");
                const size_t ro = (size_t)(ai * HALF + m * 16) * DM; float sq = 0.f;
#pragma unroll
                for (int bj = 0; bj < 2; ++bj) { const f32x4 v0 = acc[ai][bj][m][0] + bb[st][2 * bj], v1 = acc[ai][bj][m][1] + bb[st][2 * bj + 1];
                    sq += (v0[0] * v0[0] + v0[1] * v0[1]) + (v0[2] * v0[2] + v0[3] * v0[3]) + (v1[0] * v1[0] + v1[1] * v1[1]) + (v1[2] * v1[2] + v1[3] * v1[3]);
                    u32x4 w; PG8_PACK(v0, v1, w); *(u32x4*)(op0 + ro + bj * HALF) = w;
                    u32x2 w8; w8.x = q8fix(v0); w8.y = q8fix(v1); *(u32x2*)(xp0 + ro + bj * HALF) = w8; }
                ss[sx] = sq; }
#undef RX_LD
        } else {
            const bf16_t* bp0 = base16 + (size_t)row0 * DM + col0;
            u32x4 bb[2][2];
#define RX_LD(st, sx) do { const bf16_t* bp_ = bp0 + (size_t)(((sx) >> 2) * HALF + ((sx) & 3) * 16) * DM; bb[st][0] = *(const u32x4*)bp_; bb[st][1] = *(const u32x4*)(bp_ + HALF); } while (0)
            RX_LD(0, 0);
#pragma unroll
            for (int sx = 0; sx < 8; ++sx) { const int ai = sx >> 2, m = sx & 3, st = sx & 1;
                if (sx + 1 < 8) RX_LD((sx + 1) & 1, sx + 1);
                asm volatile("" ::: "memory");
                const size_t ro = (size_t)(ai * HALF + m * 16) * DM; float sq = 0.f;
#pragma unroll
                for (int bj = 0; bj < 2; ++bj) { const u32x4 b = bb[st][bj]; f32x4 v0 = acc[ai][bj][m][0], v1 = acc[ai][bj][m][1];
                    v0[0] += bf_lo(b.x); v0[1] += bf_hi(b.x); v0[2] += bf_lo(b.y); v0[3] += bf_hi(b.y); v1[0] += bf_lo(b.z); v1[1] += bf_hi(b.z); v1[2] += bf_lo(b.w); v1[3] += bf_hi(b.w);
                    sq += (v0[0] * v0[0] + v0[1] * v0[1]) + (v0[2] * v0[2] + v0[3] * v0[3]) + (v1[0] * v1[0] + v1[1] * v1[1]) + (v1[2] * v1[2] + v1[3] * v1[3]);
                    u32x4 w; PG8_PACK(v0, v1, w); *(u32x4*)(op0 + ro + bj * HALF) = w;
                    u32x2 w8; w8.x = q8fix(v0); w8.y = q8fix(v1); *(u32x2*)(xp0 + ro + bj * HALF) = w8; }
                ss[sx] = sq; }
#undef RX_LD
        }
#pragma unroll
        for (int sx = 0; sx < 8; ++sx) { const float t = fq_sum(ss[sx]); if (fq == 0) ssp[(size_t)(row0 + (sx >> 2) * HALF + (sx & 3) * 16) * 32 + u.pn * 4 + wc] = t; }
        return true;
    }
};
struct EpiStoreRS {
    static constexpr bool PERM = true;
    bf16_t* O; int ldo; const float* ssp;
    __device__ __forceinline__ bool operator()(f32x4 (&acc)[2][2][4][2], const Unit& u, int wr, int wc, int, int) const {
        const int l = opaque_tid(0), fr = l & 15, fq = l >> 4;
        const int row0 = u.orow + wr * 64 + fr, col0 = u.ocol + wc * 32 + 8 * fq;
#pragma unroll
        for (int ai = 0; ai < 2; ++ai)
#pragma unroll
            for (int m = 0; m < 4; ++m) { const int row = row0 + ai * HALF + m * 16;
                const f32x4 p0 = *(const f32x4*)(ssp + (size_t)row * 32 + fq * 8), p1 = *(const f32x4*)(ssp + (size_t)row * 32 + fq * 8 + 4);
                const float tot = fq_sum((p0[0] + p0[1]) + (p0[2] + p0[3]) + (p1[0] + p1[1]) + (p1[2] + p1[3]));
                const float rs = 1.0f / __builtin_sqrtf(tot * (1.f / DM) + RMS_EPS);
                bf16_t* rowp = O + (size_t)row * ldo + col0;
#pragma unroll
                for (int bj = 0; bj < 2; ++bj) { const f32x4 v0 = acc[ai][bj][m][0] * rs, v1 = acc[ai][bj][m][1] * rs; u32x4 w; PG8_PACK(v0, v1, w); *(u32x4*)(rowp + bj * HALF) = w; } }
        return true;
    }
};

template <class Epi, class Sched, bool ALIGN_EPI, int LDA, int LDB, int KK, bool F8 = false>
__device__ __forceinline__ void gemm_phase(PG8_LAS unsigned char* lds, const Gemm g, const Sched& S, const Epi& E, int wave0) {
    const int tid = opaque_tid(wave0), wid = wave0, lane = tid & 63, wr = wid >> 2, wc = wid & 3, fr = lane & 15, fq = lane >> 4;
    constexpr int nt = KK / BK;
    unsigned voffA[2], voffB[2];
#pragma unroll
    for (int i = 0; i < 2; ++i) { int R, C; stage_rc(tid * 16 + i * 8192, R, C); const int Rb = Epi::PERM ? ((R & ~31) + perm32(R & 31)) : R;
        voffA[i] = (unsigned)(R * LDA + C) * 2u; voffB[i] = (unsigned)(Rb * LDB + C) * 2u; }
    const size_t kstep = (size_t)(BK * 2);
    constexpr size_t hstepA = (size_t)HALF * LDA * 2, hstepB = (size_t)HALF * LDB * 2;
    const unsigned ldsw = (unsigned)wid * 1024u;
    const int aoff = lds_byte(wr * 64 + fr, fq * 8), boff = lds_byte(wc * 32 + fr, fq * 8);
#define PG8_SA(b, h) (((b) * 2 + (h)) * HTB)
#define PG8_SB(b, h) ((4 + (b) * 2 + (h)) * HTB)
#define PG8_STAGE(bufoff, gbase, voff) do { _Pragma("unroll") for (int _i = 0; _i < 2; ++_i) \
        __builtin_amdgcn_global_load_lds((const unsigned*)((const char*)(gbase) + (voff)[_i]), (PG8_LAS unsigned*)(lds + (bufoff) + ldsw + _i * 8192), 16, 0, 0); } while (0)
#define PG8_LDA(dst, b, h) do { _Pragma("unroll") for (int m = 0; m < 4; ++m) _Pragma("unroll") for (int k = 0; k < 2; ++k) dst[m][k] = *(const PG8_LAS bf16x8*)(lds + PG8_SA(b, h) + aoff + m * 2048 + k * 1024); } while (0)
#define PG8_LDB(dst, b, h) do { _Pragma("unroll") for (int n = 0; n < 2; ++n) _Pragma("unroll") for (int k = 0; k < 2; ++k) dst[n][k] = *(const PG8_LAS bf16x8*)(lds + PG8_SB(b, h) + boff + n * 2048 + k * 1024); } while (0)
#define PG8_CAT(x) __builtin_shufflevector(__builtin_bit_cast(i32x4, (x)[0]), __builtin_bit_cast(i32x4, (x)[1]), 0, 1, 2, 3, 4, 5, 6, 7)
#define PG8_MMA(ai, bj, At, Bt) do { __builtin_amdgcn_s_setprio(1); _Pragma("unroll") for (int m = 0; m < 4; ++m) _Pragma("unroll") for (int n = 0; n < 2; ++n) { \
        if constexpr (F8) { const i32x8 a8_ = PG8_CAT(Bt[n]), b8_ = PG8_CAT(At[m]); asm volatile("v_mfma_scale_f32_16x16x128_f8f6f4 %0, %1, %2, %0, %3, %3 op_sel_hi:[0,0,0]" : "+v"(acc[ai][bj][m][n]) : "v"(a8_), "v"(b8_), "v"(one8)); } \
        else { _Pragma("unroll") for (int k = 0; k < 2; ++k) acc[ai][bj][m][n] = __builtin_amdgcn_mfma_f32_16x16x32_bf16(Bt[n][k], At[m][k], acc[ai][bj][m][n], 0, 0, 0); } } __builtin_amdgcn_s_setprio(0); } while (0)
#define PG8_WAIT_V(n) asm volatile("s_waitcnt vmcnt(" #n ")" ::: "memory")
#define PG8_WAIT_L(n) asm volatile("s_waitcnt lgkmcnt(" #n ")" ::: "memory")
#define PG8_BAR __builtin_amdgcn_s_barrier()
#define PG8_SCHED __builtin_amdgcn_sched_barrier(0)
    Unit cur, nxt; int ui = 0;
    if (!S.next(0, cur)) return;
    const int one8 = 0x7f7f7f7f; (void)one8;
    f32x4 acc[2][2][4][2];
#pragma unroll
    for (int a = 0; a < 2; ++a)
#pragma unroll
        for (int b = 0; b < 2; ++b)
#pragma unroll
            for (int m = 0; m < 4; ++m)
#pragma unroll
                for (int n = 0; n < 2; ++n) acc[a][b][m][n] = (f32x4){0.f, 0.f, 0.f, 0.f};
    bf16x8 At[4][2], B0[2][2], B1[2][2];
    const char* cA = (const char*)g.A + cur.aoff; const char* cB = (const char*)g.Bt + cur.boff;
    PG8_STAGE(PG8_SB(0, 0), cB, voffB); PG8_STAGE(PG8_SB(0, 1), cB + hstepB, voffB); PG8_STAGE(PG8_SA(0, 0), cA, voffA); PG8_STAGE(PG8_SA(0, 1), cA + hstepA, voffA);
    if (wr == 1) PG8_BAR;
    PG8_WAIT_V(2); PG8_BAR;
    PG8_STAGE(PG8_SB(1, 0), cB + kstep, voffB); PG8_STAGE(PG8_SA(1, 0), cA + kstep, voffA); PG8_STAGE(PG8_SB(1, 1), cB + hstepB + kstep, voffB);
    PG8_WAIT_V(6); PG8_BAR;
    for (;;) {
        const bool has_next = S.next(ui + 1, nxt);
        const char* nA = has_next ? (const char*)g.A + nxt.aoff : cA; const char* nB = has_next ? (const char*)g.Bt + nxt.boff : cB;
        for (int t = 0; t < nt; t += 2) {
            const bool last = (t == nt - 2);
            const char* a1 = cA + (size_t)(t + 1) * kstep;
            const char* a2 = last ? nA : cA + (size_t)(t + 2) * kstep; const char* b2 = last ? nB : cB + (size_t)(t + 2) * kstep;
            const char* a3 = a2 + kstep; const char* b3 = b2 + kstep;
            PG8_LDB(B0, 0, 0); PG8_LDB(B1, 0, 1); PG8_SCHED; PG8_LDA(At, 0, 0); PG8_STAGE(PG8_SA(1, 1), a1 + hstepA, voffA);
            PG8_WAIT_V(8); PG8_WAIT_L(0); PG8_BAR; PG8_MMA(0, 0, At, B0); PG8_MMA(0, 1, At, B1); PG8_BAR; PG8_SCHED;
            PG8_LDA(At, 0, 1); PG8_STAGE(PG8_SB(0, 0), b2, voffB); PG8_STAGE(PG8_SB(0, 1), b2 + hstepB, voffB); PG8_STAGE(PG8_SA(0, 0), a2, voffA);
            PG8_WAIT_V(8); PG8_WAIT_L(0); PG8_BAR; PG8_MMA(1, 0, At, B0); PG8_MMA(1, 1, At, B1); PG8_BAR; PG8_SCHED;
            PG8_LDB(B0, 1, 0); PG8_LDB(B1, 1, 1); PG8_SCHED; PG8_LDA(At, 1, 0); PG8_STAGE(PG8_SA(0, 1), a2 + hstepA, voffA);
            PG8_WAIT_V(8); PG8_WAIT_L(0); PG8_BAR; PG8_MMA(0, 0, At, B0); PG8_MMA(0, 1, At, B1); PG8_BAR; PG8_SCHED;
            PG8_LDA(At, 1, 1); PG8_STAGE(PG8_SB(1, 0), b3, voffB); PG8_STAGE(PG8_SB(1, 1), b3 + hstepB, voffB); PG8_STAGE(PG8_SA(1, 0), a3, voffA);
            PG8_WAIT_V(8); PG8_WAIT_L(0); PG8_BAR; PG8_MMA(1, 0, At, B0); PG8_MMA(1, 1, At, B1); PG8_BAR; PG8_SCHED;
        }
        if constexpr (ALIGN_EPI) { if (wr == 0) PG8_BAR; }
        if constexpr (F8) asm volatile("s_nop 15\n\ts_nop 15" ::: "memory");
        const bool fin = E(acc, cur, wr, wc, fr, fq);
        if (!has_next) break;
        if (fin) {
#pragma unroll
        for (int a = 0; a < 2; ++a)
#pragma unroll
            for (int b = 0; b < 2; ++b)
#pragma unroll
                for (int m = 0; m < 4; ++m)
#pragma unroll
                    for (int n = 0; n < 2; ++n) acc[a][b][m][n] = (f32x4){0.f, 0.f, 0.f, 0.f};
        }
        cur = nxt; cA = nA; cB = nB; ++ui;
        if constexpr (ALIGN_EPI) { if (wr == 1) PG8_BAR; }
    }
    PG8_WAIT_V(0);
    if constexpr (!ALIGN_EPI) { if (wr == 0) PG8_BAR; }
    PG8_BAR;
#undef PG8_SA
#undef PG8_SB
#undef PG8_STAGE
#undef PG8_LDA
#undef PG8_LDB
#undef PG8_MMA
#undef PG8_CAT
#undef PG8_WAIT_V
#undef PG8_WAIT_L
#undef PG8_BAR
#undef PG8_SCHED
}
}

namespace attn {
using bf16x8 = __attribute__((ext_vector_type(8))) short;
using s16x4  = __attribute__((ext_vector_type(4))) short;
using f32x16 = __attribute__((ext_vector_type(16))) float;
using u32x4  = __attribute__((ext_vector_type(4))) unsigned;
constexpr int   D = 128, NW = 8, QBLK = 32, KVBLK = 64;
constexpr float SCALE = 0.088388347648318440f;
constexpr float THR = 8.f;
constexpr size_t SHM_V = KVBLK * D * 2, SHM_K = KVBLK * D * 2;
constexpr int NBUF = 3;
constexpr int LDS_K0 = NBUF * (int)SHM_V, LDS_TAB = LDS_K0 + NBUF * (int)SHM_K, LDS_END = LDS_TAB + 8192 * 4, LDS_WS = 131072 + 8192;
#define KSWZ(row, colB) ((row) * 256 + ((colB) ^ (((row) & 7) << 4)))
#define SBAR() __builtin_amdgcn_sched_barrier(0)
__device__ __forceinline__ int crow(int r, int hi) { return (r & 3) + 8 * (r >> 2) + 4 * hi; }
__device__ __forceinline__ unsigned cvtpk(float lo, float hi) { unsigned r; asm volatile("v_cvt_pk_bf16_f32 %0, %1, %2" : "=v"(r) : "v"(lo), "v"(hi)); return r; }

__device__ __forceinline__ void partialSM(f32x16& p0, f32x16& p1, float& m_reg, float& mn, float& alpha) {
  constexpr float C = SCALE * 1.4426950408889634f;
  float pmax = p0[0]; for (int r = 1; r < 16; ++r) pmax = fmaxf(pmax, p0[r]); for (int r = 0; r < 16; ++r) pmax = fmaxf(pmax, p1[r]);
  { auto rr = __builtin_amdgcn_permlane32_swap(__float_as_uint(pmax), __float_as_uint(pmax), false, false);
    pmax = fmaxf(__uint_as_float(rr[0]), __uint_as_float(rr[1])); }
  if (__builtin_expect(__all(pmax - m_reg <= THR / SCALE), 1)) { mn = m_reg; alpha = 1.f; }
  else { mn = fmaxf(m_reg, pmax); alpha = __builtin_amdgcn_exp2f((m_reg - mn) * C); m_reg = mn; }
  float mnC = -mn * C;
  for (int r = 0; r < 16; ++r) p0[r] = fmaf(p0[r], C, mnC); for (int r = 0; r < 16; ++r) p1[r] = fmaf(p1[r], C, mnC);
  for (int r = 0; r < 16; ++r) p0[r] = __builtin_amdgcn_exp2f(p0[r]);
}
__device__ __forceinline__ void finishSM(f32x16& p0, f32x16& p1, float alpha, float& l_reg, bf16x8& pa0, bf16x8& pa1, bf16x8& pa2, bf16x8& pa3) {
  for (int r = 0; r < 16; ++r) p1[r] = __builtin_amdgcn_exp2f(p1[r]);
  float ps = 0; for (int r = 0; r < 16; ++r) ps += p0[r]; for (int r = 0; r < 16; ++r) ps += p1[r];
  { auto rr = __builtin_amdgcn_permlane32_swap(__float_as_uint(ps), __float_as_uint(ps), false, false);
    ps = __uint_as_float(rr[0]) + __uint_as_float(rr[1]); }
  l_reg = l_reg * alpha + ps;
#define PK4(P, BASE, OUT) do { unsigned a0 = cvtpk(P[BASE + 0], P[BASE + 1]), a1 = cvtpk(P[BASE + 2], P[BASE + 3]);   \
    unsigned b0 = cvtpk(P[BASE + 4], P[BASE + 5]), b1 = cvtpk(P[BASE + 6], P[BASE + 7]);                              \
    auto r0 = __builtin_amdgcn_permlane32_swap(a0, b0, false, false); auto r1 = __builtin_amdgcn_permlane32_swap(a1, b1, false, false); \
    u32x4 w = {r0[0], r1[0], r0[1], r1[1]}; OUT = *reinterpret_cast<bf16x8*>(&w); } while (0)
  PK4(p0, 0, pa0); PK4(p0, 8, pa1); PK4(p1, 0, pa2); PK4(p1, 8, pa3);
#undef PK4
}
__device__ __forceinline__ void qkt(f32x16& p0, f32x16& p1, const bf16* Ks, const bf16x8* qr, int r32, int hi, const float* tl) {
#pragma unroll
  for (int r = 0; r < 16; ++r) { p0[r] = tl[(r & 3) + 8 * (r >> 2)]; p1[r] = tl[32 + (r & 3) + 8 * (r >> 2)]; }
#pragma unroll
  for (int d0 = 0; d0 < 8; ++d0) { int cb = (d0 * 16 + hi * 8) * 2;
    bf16x8 b0 = *reinterpret_cast<const bf16x8*>((const char*)Ks + KSWZ(r32, cb));
    bf16x8 b1 = *reinterpret_cast<const bf16x8*>((const char*)Ks + KSWZ(32 + r32, cb));
    p0 = __builtin_amdgcn_mfma_f32_32x32x16_bf16(b0, qr[d0], p0, 0, 0, 0);
    p1 = __builtin_amdgcn_mfma_f32_32x32x16_bf16(b1, qr[d0], p1, 0, 0, 0); }
}
__device__ __forceinline__ int v_st(int k, int c) { const int kk = (k & ~0xC) | ((k & 4) << 1) | ((k & 8) >> 1); return ((kk >> 3) * 4 + (c >> 5)) * 512 + ((kk & 7) * 32 + (c & 31)) * 2; }
__device__ __forceinline__ int v_rd_base(int lane) { return ((lane & 3) << 3) | (((lane >> 2) & 3) << 6) | (((lane >> 4) & 1) << 5) | (((lane >> 5) & 1) << 8); }
constexpr int v_rd_off(int d0, int ks, int half) { return d0 * 512 + ks * 4096 + half * 2048; }
template <int OFF> __device__ __forceinline__ s16x4 tr_read(int vb) {
  s16x4 r; asm volatile("ds_read_b64_tr_b16 %0, %1 offset:%2" : "=&v"(r) : "v"(vb), "i"(OFF) : "memory"); return r;
}
template <int D0> __device__ __forceinline__ void pv_one(f32x16& od, int vb, bf16x8 pa0, bf16x8 pa1, bf16x8 pa2, bf16x8 pa3) {
  const s16x4 l0 = tr_read<v_rd_off(D0, 0, 0)>(vb), h0 = tr_read<v_rd_off(D0, 0, 1)>(vb), l1 = tr_read<v_rd_off(D0, 1, 0)>(vb), h1 = tr_read<v_rd_off(D0, 1, 1)>(vb);
  const s16x4 l2 = tr_read<v_rd_off(D0, 2, 0)>(vb), h2 = tr_read<v_rd_off(D0, 2, 1)>(vb), l3 = tr_read<v_rd_off(D0, 3, 0)>(vb), h3 = tr_read<v_rd_off(D0, 3, 1)>(vb);
  asm volatile("s_waitcnt lgkmcnt(0)" ::: "memory"); SBAR();
#define PK(L, H) (bf16x8){L[0], L[1], L[2], L[3], H[0], H[1], H[2], H[3]}
  od = __builtin_amdgcn_mfma_f32_32x32x16_bf16(pa0, PK(l0, h0), od, 0, 0, 0);
  od = __builtin_amdgcn_mfma_f32_32x32x16_bf16(pa1, PK(l1, h1), od, 0, 0, 0);
  od = __builtin_amdgcn_mfma_f32_32x32x16_bf16(pa2, PK(l2, h2), od, 0, 0, 0);
  od = __builtin_amdgcn_mfma_f32_32x32x16_bf16(pa3, PK(l3, h3), od, 0, 0, 0);
#undef PK
}
__device__ __forceinline__ void pv_d0(f32x16* o, int vb, bf16x8 pa0, bf16x8 pa1, bf16x8 pa2, bf16x8 pa3) {
  pv_one<0>(o[0], vb, pa0, pa1, pa2, pa3); pv_one<1>(o[1], vb, pa0, pa1, pa2, pa3); pv_one<2>(o[2], vb, pa0, pa1, pa2, pa3); pv_one<3>(o[3], vb, pa0, pa1, pa2, pa3);
}

struct VFrag { s16x4 l0, h0, l1, h1, l2, h2, l3, h3; };
template <int D0> __device__ __forceinline__ void v_issue(VFrag& f, int vb) {
  f.l0 = tr_read<v_rd_off(D0, 0, 0)>(vb); f.h0 = tr_read<v_rd_off(D0, 0, 1)>(vb); f.l1 = tr_read<v_rd_off(D0, 1, 0)>(vb); f.h1 = tr_read<v_rd_off(D0, 1, 1)>(vb);
  f.l2 = tr_read<v_rd_off(D0, 2, 0)>(vb); f.h2 = tr_read<v_rd_off(D0, 2, 1)>(vb); f.l3 = tr_read<v_rd_off(D0, 3, 0)>(vb); f.h3 = tr_read<v_rd_off(D0, 3, 1)>(vb);
}
__device__ __forceinline__ void v_mma(f32x16& od, const VFrag& f, bf16x8 pa0, bf16x8 pa1, bf16x8 pa2, bf16x8 pa3) {
#define PK(L, H) (bf16x8){L[0], L[1], L[2], L[3], H[0], H[1], H[2], H[3]}
  od = __builtin_amdgcn_mfma_f32_32x32x16_bf16(pa0, PK(f.l0, f.h0), od, 0, 0, 0);
  od = __builtin_amdgcn_mfma_f32_32x32x16_bf16(pa1, PK(f.l1, f.h1), od, 0, 0, 0);
  od = __builtin_amdgcn_mfma_f32_32x32x16_bf16(pa2, PK(f.l2, f.h2), od, 0, 0, 0);
  od = __builtin_amdgcn_mfma_f32_32x32x16_bf16(pa3, PK(f.l3, f.h3), od, 0, 0, 0);
#undef PK
}
__device__ __forceinline__ void pv_sm(f32x16* o, int vb, bf16x8 pa0, bf16x8 pa1, bf16x8 pa2, bf16x8 pa3, f32x16& p0, f32x16& p1, float& m_reg, float& mn, float& alpha) {
  constexpr float C = SCALE * 1.4426950408889634f;
  VFrag fa, fb;
  v_issue<0>(fa, vb); v_issue<1>(fb, vb);
  asm volatile("s_waitcnt lgkmcnt(8)" ::: "memory"); SBAR();
  v_mma(o[0], fa, pa0, pa1, pa2, pa3);
  float pmax = p0[0];
#pragma unroll
  for (int r = 1; r < 16; ++r) pmax = fmaxf(pmax, p0[r]);
#pragma unroll
  for (int r = 0; r < 16; ++r) pmax = fmaxf(pmax, p1[r]);
  v_issue<2>(fa, vb);
  asm volatile("s_waitcnt lgkmcnt(8)" ::: "memory"); SBAR();
  v_mma(o[1], fb, pa0, pa1, pa2, pa3);
  { auto rr = __builtin_amdgcn_permlane32_swap(__float_as_uint(pmax), __float_as_uint(pmax), false, false);
    pmax = fmaxf(__uint_as_float(rr[0]), __uint_as_float(rr[1])); }
  if (__builtin_expect(__all(pmax - m_reg <= THR / SCALE), 1)) { mn = m_reg; alpha = 1.f; }
  else { mn = fmaxf(m_reg, pmax); alpha = __builtin_amdgcn_exp2f((m_reg - mn) * C); m_reg = mn; }
  const float mnC = -mn * C;
#define PIN(x) do { float t_ = (x); asm volatile("" : "+v"(t_)); (x) = t_; } while (0)
#pragma unroll
  for (int r = 0; r < 16; ++r) { p0[r] = fmaf(p0[r], C, mnC); PIN(p0[r]); }
  v_issue<3>(fb, vb);
  asm volatile("s_waitcnt lgkmcnt(8)" ::: "memory"); SBAR();
  v_mma(o[2], fa, pa0, pa1, pa2, pa3);
#pragma unroll
  for (int r = 0; r < 16; ++r) { p1[r] = fmaf(p1[r], C, mnC); PIN(p1[r]); }
#pragma unroll
  for (int r = 0; r < 8; ++r) { p0[r] = __builtin_amdgcn_exp2f(p0[r]); PIN(p0[r]); }
  asm volatile("s_waitcnt lgkmcnt(0)" ::: "memory"); SBAR();
  v_mma(o[3], fb, pa0, pa1, pa2, pa3);
#pragma unroll
  for (int r = 8; r < 16; ++r) p0[r] = __builtin_amdgcn_exp2f(p0[r]);
#undef PIN
}

struct Unit { const bf16* Q; const bf16* K; const bf16* V; bf16* O; float* lse; long ldq, ldk, ldo; int lse_ld, kt0, nt, qoff; };
__device__ __forceinline__ void attn_unit(const Unit& u, char* lds, int wave0) {
  const int tid = opaque_tid(wave0), wid = wave0, lane = tid & 63, r32 = lane & 31, hi = lane >> 5;
  LAS unsigned char* ldsl = (LAS unsigned char*)lds;
  float* ws = (float*)(lds + LDS_WS) + wid * 64; float* li_l = ws; float* al_l = ws + 32;
  const float* tabL = (const float*)(lds + LDS_TAB);
  float m_reg = -1e30f, l_reg = 0; f32x16 o[4] = {}; bf16x8 qr[8];
  const bf16* Qw = u.Q + (long)(wid * QBLK + r32) * u.ldq + hi * 8;
#pragma unroll
  for (int d0 = 0; d0 < 8; ++d0) qr[d0] = *reinterpret_cast<const bf16x8*>(Qw + d0 * 16);
  const int vrd = (int)(uintptr_t)lds + v_rd_base(lane);
  const long tstep = (long)KVBLK * u.ldk * 2;
  const char* Kh = (const char*)u.K + (long)u.kt0 * tstep; const char* Vh = (const char*)u.V + (long)u.kt0 * tstep;
  unsigned kofs[2], vofs[2];
#pragma unroll
  for (int i = 0; i < 2; ++i) { const int rowk = (wid + 8 * i) * 4 + (lane >> 4), chunk = (lane & 15) ^ (rowk & 7); kofs[i] = (unsigned)(rowk * (int)u.ldk * 2 + chunk * 16);
    const int blk = (wid + 8 * i) * 2 + (lane >> 5), kk = (blk >> 2) * 8 + ((lane & 31) >> 2), c = (blk & 3) * 32 + (lane & 3) * 8, k = (kk & ~0xC) | ((kk & 4) << 1) | ((kk & 8) >> 1);
    vofs[i] = (unsigned)((k * (int)u.ldk + c) * 2); }
  const float* tl0 = tabL + (4096 + u.kt0 * KVBLK + 4 * hi - (u.qoff + wid * QBLK + r32));
#define DMA(tj, b) do { const char* kt_ = Kh + (long)(tj) * tstep; const char* vt_ = Vh + (long)(tj) * tstep; _Pragma("unroll") for (int i_ = 0; i_ < 2; ++i_) { \
    __builtin_amdgcn_global_load_lds((const unsigned*)(kt_ + kofs[i_]), (LAS unsigned*)(ldsl + LDS_K0 + (b) * (int)SHM_K + (wid + 8 * i_) * 1024), 16, 0, 0); \
    __builtin_amdgcn_global_load_lds((const unsigned*)(vt_ + vofs[i_]), (LAS unsigned*)(ldsl + (b) * (int)SHM_V + (wid + 8 * i_) * 1024), 16, 0, 0); } } while (0)
#define KBUF(b) ((const bf16*)(lds + LDS_K0 + (b) * (int)SHM_K))
#define VBUF(b) (vrd + (b) * (int)SHM_V)
#define LANDED() do { asm volatile("s_waitcnt vmcnt(0)" ::: "memory"); __syncthreads(); } while (0)
#define RESC(a) do { if (__any((a) < 1.f)) { if (hi == 0) al_l[r32] = (a); asm volatile("s_waitcnt lgkmcnt(0)" ::: "memory"); \
    for (int d = 0; d < 4; ++d) for (int r = 0; r < 16; ++r) o[d][r] *= al_l[crow(r, hi)]; } } while (0)
  f32x16 pA0, pA1, pB0, pB1; float mnA, mnB, alA, alB; bf16x8 pa0, pa1, pa2, pa3; const int NT = u.nt;
  DMA(0, 0); DMA(1, 1);
  LANDED();
  qkt(pA0, pA1, KBUF(0), qr, r32, hi, tl0); partialSM(pA0, pA1, m_reg, mnA, alA);
  if (2 < NT) DMA(2, 2);
  int bp = 0, bc = 1, bn = 2;
  for (int t = 1; t + 1 < NT; t += 2) {
    SBAR(); qkt(pB0, pB1, KBUF(bc), qr, r32, hi, tl0 + t * KVBLK);
    finishSM(pA0, pA1, alA, l_reg, pa0, pa1, pa2, pa3); SBAR();
    pv_sm(o, VBUF(bp), pa0, pa1, pa2, pa3, pB0, pB1, m_reg, mnB, alB);
    RESC(alB);
    LANDED();
    { const int nb = bp; bp = bc; bc = bn; bn = nb; if (t + 2 < NT) DMA(t + 2, bn); }
    SBAR(); qkt(pA0, pA1, KBUF(bc), qr, r32, hi, tl0 + (t + 1) * KVBLK);
    finishSM(pB0, pB1, alB, l_reg, pa0, pa1, pa2, pa3); SBAR();
    pv_sm(o, VBUF(bp), pa0, pa1, pa2, pa3, pA0, pA1, m_reg, mnA, alA);
    RESC(alA);
    LANDED();
    { const int nb = bp; bp = bc; bc = bn; bn = nb; if (t + 3 < NT) DMA(t + 3, bn); }
  }
  SBAR(); qkt(pB0, pB1, KBUF(bc), qr, r32, hi, tl0 + (NT - 1) * KVBLK);
  finishSM(pA0, pA1, alA, l_reg, pa0, pa1, pa2, pa3); SBAR();
  pv_sm(o, VBUF(bp), pa0, pa1, pa2, pa3, pB0, pB1, m_reg, mnB, alB);
  RESC(alB);
  finishSM(pB0, pB1, alB, l_reg, pa0, pa1, pa2, pa3); SBAR();
  pv_d0(o, VBUF(bc), pa0, pa1, pa2, pa3);
  if (hi == 0) li_l[r32] = l_reg; asm volatile("s_waitcnt lgkmcnt(0)" ::: "memory");
  float rli[16];
#pragma unroll
  for (int r = 0; r < 16; ++r) rli[r] = __builtin_amdgcn_rcpf(li_l[crow(r, hi)]);
  bf16* Ow = u.O + (long)(wid * QBLK) * u.ldo;
#pragma unroll
  for (int r = 0; r < 16; ++r) { int orow = crow(r, hi);
#pragma unroll
    for (int d0 = 0; d0 < 4; ++d0) { const float v = o[d0][r] * rli[r]; Ow[(long)orow * u.ldo + d0 * 32 + r32] = (bf16)(cvtpk(v, v) & 0xffffu); } }
  if (u.lse != nullptr && hi == 0) u.lse[(long)(wid * QBLK + r32) * u.lse_ld] = m_reg * SCALE + __logf(l_reg);
#undef DMA
#undef KBUF
#undef VBUF
#undef LANDED
#undef RESC
}
#undef KSWZ
#undef SBAR
}

constexpr int NWAVES = 8;
constexpr size_t MiB = 1u << 20;
constexpr size_t WS_CTL = 0, CTL_ZERO_BYTES = 1 * MiB;
constexpr size_t WS_CS   = 1 * MiB;
constexpr size_t WS_SKBD = 1 * MiB + 256 * 1024;
constexpr size_t WS_TAB  = 2 * MiB;
constexpr size_t WS_LSE  = 3 * MiB;
constexpr size_t WS_SU   = 3 * MiB + 768 * 1024;
constexpr size_t WS_SH   = 3 * MiB + 832 * 1024;
constexpr size_t WS_WCAT = 4 * MiB, WS_WO = 12 * MiB, WS_WQ = 20 * MiB;
constexpr size_t WS_WIN  = 28 * MiB;
constexpr size_t WS_WG8  = WS_WIN + 16 * MiB;
constexpr size_t WS_DFT  = 84 * MiB;
constexpr size_t WS_U    = 148 * MiB, WS_V = 180 * MiB;
constexpr size_t WS_H8   = 212 * MiB;
constexpr size_t WS_H    = 276 * MiB;
constexpr size_t WS_PROJ = 340 * MiB;
constexpr size_t WS_G    = 596 * MiB;
constexpr size_t WS_ZT   = 788 * MiB;
constexpr size_t WS_OC   = 820 * MiB;
constexpr size_t WS_MG   = 884 * MiB;
constexpr size_t WS_SSP  = 276 * MiB;
constexpr size_t WS_X16  = 948 * MiB;
constexpr size_t WS_END  = 1012 * MiB;
#if DBG_MODE == 2
constexpr size_t WS_ACT = WS_PROJ + 208 * MiB;
#else
constexpr size_t WS_ACT = WS_PROJ + 200 * MiB;
#endif
constexpr size_t WS_Q = WS_PROJ, WS_SC = WS_PROJ + 64 * MiB, WS_IDS = WS_PROJ + 192 * MiB, WS_GATES = WS_PROJ + 200 * MiB;
constexpr int CW_BAR = 4096;
constexpr int CW_XRANK = 12288;
constexpr int CW_QUEUE = 16384;
constexpr int RING_BYTES = 131072, LDSCTL_OFF = RING_BYTES, MISC_OFF = LDSCTL_OFF + 320, LDS_BYTES = 147456;

#define LDS_WAIT() asm volatile("s_waitcnt lgkmcnt(0)" ::: "memory")
#define VM_WAIT() asm volatile("s_waitcnt vmcnt(0)" ::: "memory")
__device__ __forceinline__ unsigned f2bf(float f) { unsigned u = __builtin_bit_cast(unsigned, f); return (u + 0x7fffu + ((u >> 16) & 1u)) >> 16; }
__device__ __forceinline__ unsigned pk2(float lo, float hi) { return f2bf(lo) | (f2bf(hi) << 16); }
__device__ __forceinline__ float bflo(unsigned w) { return __uint_as_float(w << 16); }
__device__ __forceinline__ float bfhi(unsigned w) { return __uint_as_float(w & 0xffff0000u); }

#define XB_TMO      128
#define XB_XCNT(j)  (256  + 64 * (j))
#define XB_XSUB(j)  (1280 + 64 * (j))
#define XB_XGEN(j)  (2304 + 64 * (j))
#define XB_TOP      3328
#define XB_TOPGEN   3392
#define XCD_BAR_WORDS 3456
#define XB_SPIN_CAP (1u << 20)
__device__ __forceinline__ unsigned xb_ld(unsigned* p)              { return __hip_atomic_load(p, __ATOMIC_RELAXED, __HIP_MEMORY_SCOPE_AGENT); }
__device__ __forceinline__ unsigned xb_add(unsigned* p, unsigned v) { return __hip_atomic_fetch_add(p, v, __ATOMIC_RELAXED, __HIP_MEMORY_SCOPE_AGENT); }
__device__ __forceinline__ unsigned xb_xcc_id() { return (unsigned)__builtin_amdgcn_s_getreg((3 << 11) | 20) & 0xFu; }
#define XB_SPIN(cond, bar) do { unsigned _sp = 0; while (cond) { __builtin_amdgcn_s_sleep(1); \
    if ((++_sp & 255u) == 0u) { if (xb_ld(&(bar)[XB_TMO])) break; if (_sp > XB_SPIN_CAP) { atomicAdd(&(bar)[XB_TMO], 1u); break; } } } } while (0)
struct XcdBarrier { unsigned* bar; unsigned x; volatile LAS unsigned* st; };
__device__ __forceinline__ XcdBarrier xcd_barrier_post(unsigned* bar, volatile LAS unsigned* st) {
    XcdBarrier b; b.bar = bar; b.x = xb_xcc_id(); b.st = st;
    if (threadIdx.x == 0) (void)xb_add(&bar[XB_XCNT(b.x)], 1u);
    return b;
}
__device__ __forceinline__ void xcd_barrier_complete(unsigned* bar, unsigned x, unsigned& nloc, unsigned& nx) {
    const unsigned G = gridDim.x * gridDim.y * gridDim.z;
    unsigned sum, cnt, mine, sp = 0u;
    for (;;) {
        sum = 0u; cnt = 0u; mine = 0u;
#pragma unroll
        for (unsigned j = 0; j < 16; ++j) { const unsigned c = xb_ld(&bar[XB_XCNT(j)]); sum += c; cnt += (c > 0u) ? 1u : 0u; mine = (j == x) ? c : mine; }
        if (sum == G) break;
        __builtin_amdgcn_s_sleep(1);
        if ((++sp & 255u) == 0u) { if (xb_ld(&bar[XB_TMO])) break; if (sp > XB_SPIN_CAP) { atomicAdd(&bar[XB_TMO], 1u); break; } }
    }
    nloc = mine > 0u ? mine : 1u; nx = cnt > 0u ? cnt : 1u;
}
__device__ __forceinline__ void xcd_barrier(const XcdBarrier& b) {
    asm volatile("s_waitcnt vmcnt(0)" ::: "memory");
    __syncthreads();
    if (threadIdx.x == 0) {
        unsigned* bar = b.bar;
        __builtin_amdgcn_s_waitcnt(0);
        unsigned nloc = b.st[0], nx = b.st[1];
        if (nloc == 0u) { xcd_barrier_complete(bar, b.x, nloc, nx); b.st[0] = nloc; b.st[1] = nx; }
        const unsigned old = xb_add(&bar[XB_XSUB(b.x)], 1u);
        const unsigned gen = old / nloc;
        if (old + 1u == (gen + 1u) * nloc) {
            __builtin_amdgcn_fence(__ATOMIC_RELEASE, "agent");
            asm volatile("s_waitcnt vmcnt(0)" ::: "memory");
            const unsigned og = xb_add(&bar[XB_TOP], 1u);
            const unsigned tg = og / nx;
            if (og + 1u == (tg + 1u) * nx) xb_add(&bar[XB_TOPGEN], 1u);
            else XB_SPIN(xb_ld(&bar[XB_TOPGEN]) == tg, bar);
            __builtin_amdgcn_fence(__ATOMIC_ACQUIRE, "agent");
            xb_add(&bar[XB_XGEN(b.x)], 1u);
            asm volatile("s_waitcnt vmcnt(0)" ::: "memory");
        } else {
            XB_SPIN(xb_ld(&bar[XB_XGEN(b.x)]) == gen, bar);
            __builtin_amdgcn_fence(__ATOMIC_ACQUIRE, "agent");
            asm volatile("s_waitcnt vmcnt(0)" ::: "memory");
        }
    }
    __syncthreads();
}

template <int MASK> __device__ __forceinline__ int sx_i(int v) { return __builtin_amdgcn_ds_swizzle(v, 0x1f | (MASK << 10)); }
template <int MASK> __device__ __forceinline__ float sx_f(float v) { return __int_as_float(sx_i<MASK>(__float_as_int(v))); }
__device__ __forceinline__ float add32(float v) { auto rr = __builtin_amdgcn_permlane32_swap(__float_as_uint(v), __float_as_uint(v), false, false); return __uint_as_float(rr[0]) + __uint_as_float(rr[1]); }
__device__ __forceinline__ unsigned max32(unsigned v) { auto rr = __builtin_amdgcn_permlane32_swap(v, v, false, false); return rr[0] > rr[1] ? rr[0] : rr[1]; }
__device__ __forceinline__ float other32(float v, bool upper) { auto rr = __builtin_amdgcn_permlane32_swap(__float_as_uint(v), __float_as_uint(v), false, false); return __uint_as_float(upper ? rr[0] : rr[1]); }
__device__ __forceinline__ float bperm_f(float v, int src_lane) { return __int_as_float(__builtin_amdgcn_ds_bpermute(src_lane * 4, __float_as_int(v))); }
__device__ __forceinline__ int bperm_i(int v, int src_lane) { return __builtin_amdgcn_ds_bpermute(src_lane * 4, v); }
__device__ __forceinline__ float wave_sum(float v) {
    v += sx_f<1>(v); v += sx_f<2>(v); v += sx_f<4>(v); v += sx_f<8>(v); v += sx_f<16>(v); return add32(v);
}
__device__ __forceinline__ unsigned umax(unsigned a, unsigned b) { return a > b ? a : b; }
__device__ __forceinline__ unsigned wave_max_u32(unsigned v) {
    v = umax(v, (unsigned)sx_i<1>((int)v)); v = umax(v, (unsigned)sx_i<2>((int)v)); v = umax(v, (unsigned)sx_i<4>((int)v)); v = umax(v, (unsigned)sx_i<8>((int)v)); v = umax(v, (unsigned)sx_i<16>((int)v)); return max32(v);
}
template <int CTRL, int RMASK> __device__ __forceinline__ unsigned dpp_max_u(unsigned v) { const unsigned t = (unsigned)__builtin_amdgcn_update_dpp((int)v, (int)v, CTRL, RMASK, 0xF, false); return t > v ? t : v; }
__device__ __forceinline__ unsigned wave_max_dpp(unsigned v) {
    v = dpp_max_u<0xB1, 0xF>(v); v = dpp_max_u<0x4E, 0xF>(v); v = dpp_max_u<0x141, 0xF>(v); v = dpp_max_u<0x140, 0xF>(v); v = dpp_max_u<0x142, 0xA>(v); v = dpp_max_u<0x143, 0xC>(v);
    return (unsigned)__builtin_amdgcn_readlane((int)v, 63);
}
template <int K> __device__ __forceinline__ float rowb(float v) { return __int_as_float(__builtin_amdgcn_update_dpp(0, __float_as_int(v), 0x150 + K, 0xF, 0xF, false)); }
template <int CTRL> __device__ __forceinline__ float dpp_add_f(float v) { return v + __int_as_float(__builtin_amdgcn_update_dpp(__float_as_int(v), __float_as_int(v), CTRL, 0xF, 0xF, false)); }
__device__ __forceinline__ float row_sum16(float v) { v = dpp_add_f<0xB1>(v); v = dpp_add_f<0x4E>(v); v = dpp_add_f<0x141>(v); return dpp_add_f<0x140>(v); }
__device__ __forceinline__ unsigned row_max16_u(unsigned v) { v = dpp_max_u<0xB1, 0xF>(v); v = dpp_max_u<0x4E, 0xF>(v); v = dpp_max_u<0x141, 0xF>(v); return dpp_max_u<0x140, 0xF>(v); }
template <int CTRL> __device__ __forceinline__ float dpp_maxf(float v) { return fmaxf(v, __int_as_float(__builtin_amdgcn_update_dpp(__float_as_int(v), __float_as_int(v), CTRL, 0xF, 0xF, false))); }
__device__ __forceinline__ float row_max16_f(float v) { v = dpp_maxf<0xB1>(v); v = dpp_maxf<0x4E>(v); v = dpp_maxf<0x141>(v); return dpp_maxf<0x140>(v); }
__device__ __forceinline__ float okey_inv(unsigned k) { return __uint_as_float((k & 0x80000000u) ? (k & 0x7fffffffu) : ~k); }
#define CE_DESC(a, b) do { const unsigned hi_ = (a) > (b) ? (a) : (b), lo_ = (a) > (b) ? (b) : (a); (a) = hi_; (b) = lo_; } while (0)
__device__ __forceinline__ unsigned okey(float f) { const unsigned u = __float_as_uint(f); return (u & 0x80000000u) ? ~u : (u | 0x80000000u); }

__device__ __forceinline__ void tr_issue(f32x4 (&t)[8], const float* W, int N, int k0, int n0, int lane) {
#pragma unroll
    for (int i = 0; i < 8; ++i) t[i] = __builtin_nontemporal_load((const GAS f32x4*)(W + (size_t)(k0 + 8 * i + (lane >> 3)) * N + n0 + 4 * (lane & 7)));
}
__device__ __forceinline__ void tr_to_lds(const f32x4 (&t)[8], LAS float* scr, int lane) {
#pragma unroll
    for (int i = 0; i < 8; ++i) { LAS float* d = scr + (8 * i + (lane >> 3)) * 33 + 4 * (lane & 7); d[0] = t[i].x; d[1] = t[i].y; d[2] = t[i].z; d[3] = t[i].w; }
    LDS_WAIT(); asm volatile("" ::: "memory");
}
__device__ __forceinline__ void tr_finish_bf16(const f32x4 (&t)[8], LAS float* scr, bf16* WT, int ldo, int col_off, int k0, int n0, int row_delta, int lane, const float* gk = nullptr) {
    tr_to_lds(t, scr, lane);
    const int c = lane & 7;
    f32x4 g0 = {1.f, 1.f, 1.f, 1.f}, g1 = {1.f, 1.f, 1.f, 1.f}; if (gk) { g0 = *(const GAS f32x4*)(gk + k0 + 8 * c); g1 = *(const GAS f32x4*)(gk + k0 + 8 * c + 4); }
#pragma unroll
    for (int j = 0; j < 4; ++j) { const int n = (lane >> 3) + 8 * j; const LAS float* s = scr + (8 * c) * 33 + n;
        v4u o; o.x = pk2(s[0 * 33] * g0.x, s[1 * 33] * g0.y); o.y = pk2(s[2 * 33] * g0.z, s[3 * 33] * g0.w); o.z = pk2(s[4 * 33] * g1.x, s[5 * 33] * g1.y); o.w = pk2(s[6 * 33] * g1.z, s[7 * 33] * g1.w);
        *(GAS v4u*)(WT + (size_t)(n0 + n + row_delta) * ldo + col_off + k0 + 8 * c) = o; }
    LDS_WAIT(); asm volatile("" ::: "memory");
}
__device__ __forceinline__ void tr_finish_fp8(const f32x4 (&t)[8], LAS float* scr, unsigned char* WT8, int ldo, float scale, int k0, int n0, int ncol0, int lane) {
    tr_to_lds(t, scr, lane);
    const int c = lane & 3;
#pragma unroll
    for (int j = 0; j < 2; ++j) { const int n = (lane >> 2) + 16 * j; const LAS float* s = scr + (16 * c) * 33 + n; v4u o; int w;
        w = __builtin_amdgcn_cvt_pk_fp8_f32(s[0 * 33] * scale, s[1 * 33] * scale, 0, false); w = __builtin_amdgcn_cvt_pk_fp8_f32(s[2 * 33] * scale, s[3 * 33] * scale, w, true); o.x = (unsigned)w;
        w = __builtin_amdgcn_cvt_pk_fp8_f32(s[4 * 33] * scale, s[5 * 33] * scale, 0, false); w = __builtin_amdgcn_cvt_pk_fp8_f32(s[6 * 33] * scale, s[7 * 33] * scale, w, true); o.y = (unsigned)w;
        w = __builtin_amdgcn_cvt_pk_fp8_f32(s[8 * 33] * scale, s[9 * 33] * scale, 0, false); w = __builtin_amdgcn_cvt_pk_fp8_f32(s[10 * 33] * scale, s[11 * 33] * scale, w, true); o.z = (unsigned)w;
        w = __builtin_amdgcn_cvt_pk_fp8_f32(s[12 * 33] * scale, s[13 * 33] * scale, 0, false); w = __builtin_amdgcn_cvt_pk_fp8_f32(s[14 * 33] * scale, s[15 * 33] * scale, w, true); o.w = (unsigned)w;
        *(GAS v4u*)(WT8 + (size_t)(n0 + n - ncol0) * ldo + k0 + 16 * c) = o; }
    LDS_WAIT(); asm volatile("" ::: "memory");
}
__device__ __forceinline__ void transpose_item(const float* W, int N, bf16* WT, int ldo, int col_off, LAS float* scr, int item, int lane, int row_delta = 0) {
    const int nblk = N / 32, k0 = 64 * (item / nblk), n0 = 32 * (item % nblk); f32x4 t[8]; tr_issue(t, W, N, k0, n0, lane); tr_finish_bf16(t, scr, WT, ldo, col_off, k0, n0, row_delta, lane);
}
__device__ __forceinline__ void transpose_item_fp8(const float* W, int N, int ncol0, unsigned char* WT8, int ldo, float scale, LAS float* scr, int item, int lane) {
    const int nblk = N / 32, k0 = 64 * (item / nblk), n0 = 32 * (item % nblk); f32x4 t[8]; tr_issue(t, W, N, k0, n0, lane); tr_finish_fp8(t, scr, WT8, ldo, scale, k0, n0, ncol0, lane);
}
constexpr int NPCU = 32;
constexpr int NPREP = 512;
constexpr int I_IN = (DM / 64) * (INW / 32), I_A = (512 / 64) * (DM / 32), I_C = (1024 / 64) * (DM / 32), I_SQ = (DM / 64) * (DM / 32), I_OWN = 2 * I_A + I_C + 2 * I_SQ;
__device__ __forceinline__ void prep_win_item(const float* w_in, bf16* WIN, unsigned char* WG8, LAS float* scr, int r, int lane) {
    const int ct = ((r % (INW / 32)) * 32) >> 8;
    if (ct < 2) transpose_item(w_in, INW, WIN, DM, 0, scr, r, lane); else if (ct >= 28 && ct < 32) transpose_item(w_in, INW, WIN, DM, 0, scr, r, lane, -26 * 256);
    else transpose_item_fp8(w_in, INW, ct < 28 ? 2 * 256 : 6 * 256, WG8, DM, 1024.f, scr, r, lane);
}
template <bool FP8> __device__ __forceinline__ void rms_rows2_to_bf16(const float* xrow, size_t rstride, const float* g, bf16* orow, unsigned char* o8row, int lane) {
    const GAS f32x4* gr = (const GAS f32x4*)g + lane;
    f32x4 v[2][8];
#pragma unroll
    for (int u = 0; u < 2; ++u) { const GAS f32x4* xr = (const GAS f32x4*)(xrow + u * rstride) + lane;
#pragma unroll
        for (int j = 0; j < 8; ++j) v[u][j] = xr[64 * j]; }
#pragma unroll
    for (int u = 0; u < 2; ++u) { float s = 0.f;
#pragma unroll
        for (int j = 0; j < 8; ++j) s += (v[u][j].x * v[u][j].x + v[u][j].y * v[u][j].y) + (v[u][j].z * v[u][j].z + v[u][j].w * v[u][j].w);
        const float rstd = 1.0f / sqrtf(wave_sum(s) * (1.f / DM) + RMS_EPS);
        GAS unsigned long long* o8 = (GAS unsigned long long*)(orow + u * rstride) + lane;
#pragma unroll
        for (int j = 0; j < 8; ++j) { const f32x4 gg = gr[64 * j]; const float a = v[u][j].x * rstd * gg.x, b = v[u][j].y * rstd * gg.y, c = v[u][j].z * rstd * gg.z, d = v[u][j].w * rstd * gg.w;
            o8[64 * j] = (unsigned long long)pk2(a, b) | ((unsigned long long)pk2(c, d) << 32);
            if (FP8) { int w = __builtin_amdgcn_cvt_pk_fp8_f32(a * 32.f, b * 32.f, 0, false); w = __builtin_amdgcn_cvt_pk_fp8_f32(c * 32.f, d * 32.f, w, true); ((GAS unsigned*)(o8row + u * rstride))[lane + 64 * j] = (unsigned)w; } } }
}
typedef __bf16 bf2_t __attribute__((ext_vector_type(2)));
__device__ __forceinline__ float DOT2(unsigned a, unsigned b, float c) { return __builtin_amdgcn_fdot2_f32_bf16(__builtin_bit_cast(bf2_t, a), __builtin_bit_cast(bf2_t, b), c, false); }
__device__ __forceinline__ unsigned q8x4(float a, float b, float c, float d, float inv) {
    const int ia = (int)__builtin_rintf(a * inv), ib = (int)__builtin_rintf(b * inv), ic = (int)__builtin_rintf(c * inv), id = (int)__builtin_rintf(d * inv);
    return (unsigned)(ia & 0xff) | ((unsigned)(ib & 0xff) << 8) | ((unsigned)(ic & 0xff) << 16) | ((unsigned)(id & 0xff) << 24);
}
__device__ __forceinline__ float wave_maxf(float v) {
    v = fmaxf(v, sx_f<1>(v)); v = fmaxf(v, sx_f<2>(v)); v = fmaxf(v, sx_f<4>(v)); v = fmaxf(v, sx_f<8>(v)); v = fmaxf(v, sx_f<16>(v));
    auto rr = __builtin_amdgcn_permlane32_swap(__float_as_uint(v), __float_as_uint(v), false, false); return fmaxf(__uint_as_float(rr[0]), __uint_as_float(rr[1]));
}
template <int MODE> __device__ __forceinline__ void rms_rows2_from_bf16(const bf16* xrow, size_t rstride, const float* g, bf16* orow, unsigned char* o8row, float* sh, int shstride, int lane) {
    const GAS f32x4* gr = (const GAS f32x4*)g + 2 * lane;
    v4u xv[2][4];
#pragma unroll
    for (int u = 0; u < 2; ++u) { const GAS v4u* xr = (const GAS v4u*)(xrow + u * rstride) + lane;
#pragma unroll
        for (int j = 0; j < 4; ++j) xv[u][j] = xr[64 * j]; }
#pragma unroll
    for (int u = 0; u < 2; ++u) { float v[4][8]; float s = 0.f;
#pragma unroll
        for (int j = 0; j < 4; ++j) { const v4u w = xv[u][j]; v[j][0] = bflo(w.x); v[j][1] = bfhi(w.x); v[j][2] = bflo(w.y); v[j][3] = bfhi(w.y); v[j][4] = bflo(w.z); v[j][5] = bfhi(w.z); v[j][6] = bflo(w.w); v[j][7] = bfhi(w.w);
#pragma unroll
            for (int k = 0; k < 8; ++k) s += v[j][k] * v[j][k]; }
        const float rstd = 1.0f / sqrtf(wave_sum(s) * (1.f / DM) + RMS_EPS); float mx = 0.f;
#pragma unroll
        for (int j = 0; j < 4; ++j) { const f32x4 ga = gr[128 * j], gb = gr[128 * j + 1];
            v[j][0] *= rstd * ga.x; v[j][1] *= rstd * ga.y; v[j][2] *= rstd * ga.z; v[j][3] *= rstd * ga.w; v[j][4] *= rstd * gb.x; v[j][5] *= rstd * gb.y; v[j][6] *= rstd * gb.z; v[j][7] *= rstd * gb.w;
            if (MODE == 1) {
#pragma unroll
                for (int k = 0; k < 8; ++k) mx = fmaxf(mx, fabsf(v[j][k])); } }
        float inv = 32.f;
        if (MODE == 1) { mx = fmaxf(wave_maxf(mx), 1e-30f); inv = 127.f / mx; if (lane == 0) sh[u * shstride] = mx * (1.f / 127.f); }
        GAS v4u* ob = (GAS v4u*)(orow + u * rstride) + lane; GAS unsigned long long* o8 = (GAS unsigned long long*)(o8row + u * rstride) + lane;
#pragma unroll
        for (int j = 0; j < 4; ++j) { v4u o; o.x = pk2(v[j][0], v[j][1]); o.y = pk2(v[j][2], v[j][3]); o.z = pk2(v[j][4], v[j][5]); o.w = pk2(v[j][6], v[j][7]); ob[64 * j] = o;
            unsigned lo, hi;
            if (MODE == 0) { int w = __builtin_amdgcn_cvt_pk_fp8_f32(v[j][0] * inv, v[j][1] * inv, 0, false); w = __builtin_amdgcn_cvt_pk_fp8_f32(v[j][2] * inv, v[j][3] * inv, w, true); lo = (unsigned)w;
                w = __builtin_amdgcn_cvt_pk_fp8_f32(v[j][4] * inv, v[j][5] * inv, 0, false); w = __builtin_amdgcn_cvt_pk_fp8_f32(v[j][6] * inv, v[j][7] * inv, w, true); hi = (unsigned)w; }
            else { lo = q8x4(v[j][0], v[j][1], v[j][2], v[j][3], inv); hi = q8x4(v[j][4], v[j][5], v[j][6], v[j][7], inv); }
            o8[64 * j] = (unsigned long long)lo | ((unsigned long long)hi << 32); } }
}
__device__ __forceinline__ int rel_bucket(int rel) {
    const int n = rel < 0 ? -rel : rel;
    int b = n;
    if (n >= 8) { b = 5 + (31 - __builtin_clz((unsigned)n)); if (b > 15) b = 15; }
    return b + (rel > 0 ? 16 : 0);
}

#ifndef PH_D1
#define PH_D1 1
#endif
#ifndef PH_D2
#define PH_D2 1
#endif
#ifndef PH_A
#define PH_A 1
#endif
#ifndef PH_B
#define PH_B 1
#endif
#ifndef PH_C
#define PH_C 1
#endif
#ifndef PH_D
#define PH_D 1
#endif
#ifndef PH_E
#define PH_E 1
#endif
#ifndef PH_F
#define PH_F 1
#endif
#ifndef PH_G
#define PH_G 1
#endif
#ifndef PH_H
#define PH_H 1
#endif
#ifndef PH_I
#define PH_I 1
#endif
#ifndef PH_J
#define PH_J 1
#endif
#ifndef PH_K
#define PH_K 1
#endif
#ifndef PH_L
#define PH_L 1
#endif
struct Args { const float* in[17]; float* out; unsigned char* ws; };

#define CAS __attribute__((address_space(4)))
__device__ __forceinline__ const void* karg(int k) { const CAS char* ka = (const CAS char*)__builtin_amdgcn_kernarg_segment_ptr(); asm volatile("" : "+s"(ka)); return *(const void* const CAS*)(ka + 8 * k); }
#define WSP(T, off) ((T*)((unsigned char*)karg(18) + (off)))
#define INP(k) ((const float*)karg(k))
#define INL(k, stride) (INP(k) + (size_t)layer * (size_t)(stride))
#define X ((float*)karg(17))
#define X16 WSP(bf16, WS_X16)
__global__ void __launch_bounds__(NWAVES * 64, 2) mk_fwd(Args args_unused) {
    extern __shared__ __attribute__((aligned(16))) unsigned char lds[];
    LAS unsigned char* ldsl = (LAS unsigned char*)lds;
    volatile LAS unsigned* MISC = (volatile LAS unsigned*)(ldsl + MISC_OFF);
    const int wave0 = __builtin_amdgcn_readfirstlane((int)threadIdx.x >> 6);
    const int G = gridDim.x; const int bx = blockIdx.x; const int vcu = (G % 8 == 0) ? (bx % 8) * (G / 8) + bx / 8 : bx;
    const int NGW = G * NWAVES, NGT = NGW * 64;
#define PH_IDS() int wave_o_ = wave0, vcu_o_ = vcu; asm volatile("" : "+s"(wave_o_), "+s"(vcu_o_));     \
    const int tid = opaque_tid(wave_o_), lane = tid & 63, wave = wave_o_, gw = vcu_o_ * NWAVES + wave, gt = gw * 64 + lane; (void)gt; (void)gw; (void)lane
    gu32* ctl = (gu32*)WSP(unsigned char, WS_CTL);
    for (int u = threadIdx.x; u < (LDS_BYTES - LDSCTL_OFF) / 4; u += NWAVES * 64) ((LAS unsigned*)(ldsl + LDSCTL_OFF))[u] = 0u;
    __syncthreads();
    XcdBarrier bar = xcd_barrier_post((unsigned*)(ctl + CW_BAR), MISC + 8);
    if (threadIdx.x == 0) MISC[1] = __hip_atomic_fetch_add(ctl + CW_XRANK + 64 * (int)(xb_xcc_id() & 7u), 1u, __ATOMIC_RELAXED, __HIP_MEMORY_SCOPE_AGENT);
#define GRID_BAR() xcd_barrier(bar)

    for (int layer = 0; layer < 2; ++layer) {

#if PH_A
        {
            PH_IDS();
            LAS float* scr = (LAS float*)(ldsl + wave * 16384);
            const float* mix_g = INL(3, DM); const float* rel_bias = INP(1);
            bf16* H = WSP(bf16, WS_H); bf16* DFT = WSP(bf16, WS_DFT); bf16* CS = WSP(bf16, WS_CS); float* TAB = WSP(float, WS_TAB);
            if (layer == 0) { const float* w_in = INP(4); bf16* WIN = WSP(bf16, WS_WIN);
                for (int it = gw; it < I_IN; it += NGW) prep_win_item(w_in, WIN, WSP(unsigned char, WS_WG8), scr, it, lane); }
            if (layer == 0) { int m = gw; do { rms_rows2_to_bf16<true>(INP(0) + (size_t)m * DM, (size_t)NGW * DM, mix_g, H + (size_t)m * DM, WSP(unsigned char, WS_H8) + (size_t)m * DM, lane); m += 2 * NGW; } while (m < MTOK); }
            else { int m = gw; do { rms_rows2_from_bf16<0>(X16 + (size_t)m * DM, (size_t)NGW * DM, mix_g, H + (size_t)m * DM, WSP(unsigned char, WS_H8) + (size_t)m * DM, nullptr, 0, lane); m += 2 * NGW; } while (m < MTOK); }
            if (layer == 0) {
                for (size_t i = (size_t)gt; i < (size_t)2304 * 8192 / 8; i += (size_t)NGT) {
                    const int sp = (int)(i >> 10), k0 = (int)(i & 1023) * 8, part = k0 >> 12, s0 = k0 & 4095; float v[8];
#pragma unroll
                    for (int j = 0; j < 8; ++j) { const float ang = (float)(((s0 + j) * sp) & 4095) * (1.f / 4096.f); v[j] = (part ? -__builtin_amdgcn_sinf(ang) : __builtin_amdgcn_cosf(ang)) * (1.f / 64.f); }
                    v4u o; o.x = pk2(v[0], v[1]); o.y = pk2(v[2], v[3]); o.z = pk2(v[4], v[5]); o.w = pk2(v[6], v[7]); ((GAS v4u*)DFT)[i] = o;
                }
                for (int i = gt; i < 65536; i += NGT) { const int r = i >> 8, c = i & 255, part = r >> 7, cp = r & 127; float v = 0.f;
                    if (c < 128) { const float ang = (float)((c * cp) & 127) * (1.f / 128.f); v = (part ? __builtin_amdgcn_sinf(ang) : __builtin_amdgcn_cosf(ang)) * 0.08838834764831845f; }
                    CS[i] = (bf16)f2bf(v); }
                for (int i = gt; i < 16 * 8192; i += NGT) { const int hd = i >> 13, off = (i & 8191) - 4096; float v;
                    if (hd < 12) { const int g = hd >> 2, dil = g == 0 ? 1 : (g == 1 ? 4 : 16); v = (off >= -64 && off <= 64) ? rel_bias[rel_bucket(off * dil) * 16 + hd] * 11.313708498984761f : -1.0e5f; }
                    else v = rel_bias[rel_bucket(off) * 16 + hd] * 11.313708498984761f;
                    TAB[i] = v; }
            }
        }
#endif
        GRID_BAR();

#if PH_B
        {
            { pg8::Gemm g{WSP(bf16, WS_H), WSP(bf16, WS_WIN)}; pg8::StaticOrder S; S.init(MTOK, 6 * 256, G, bx, DM, DM);
              pg8::EpiProj E{WSP(bf16, WS_PROJ), WSP(unsigned char, WS_G), INL(5, GTW), 2, 0, 26, 1.f};
              pg8::gemm_phase<pg8::EpiProj, pg8::StaticOrder, true, DM, DM, DM>(ldsl, g, S, E, wave0); }
            { pg8::Gemm g{WSP(bf16, WS_H8), WSP(bf16, WS_WG8)}; pg8::StaticOrder S; S.init(MTOK, 50 * 256, G, (bx + G / 2) % G, DM / 2, DM / 2);
              pg8::EpiProj E{WSP(bf16, WS_PROJ), WSP(unsigned char, WS_G), INL(5, GTW), 26, 2, 6, 1.f / 32768.f};
              pg8::gemm_phase<pg8::EpiProj, pg8::StaticOrder, true, DM / 2, DM / 2, DM / 2, true>(ldsl, g, S, E, wave0); }
        }
#endif
        GRID_BAR();

#if PH_C
        {
            pg8::Gemm g{WSP(bf16, WS_CS), WSP(bf16, WS_PROJ)}; pg8::F1Order S{G, bx};
            pg8::EpiZT E{WSP(bf16, WS_ZT)};
            pg8::gemm_phase<pg8::EpiZT, pg8::F1Order, false, 256, PJW, 256>(ldsl, g, S, E, wave0);
        }
#endif
        GRID_BAR();

#if PH_D
#if PH_D1
        {
            pg8::Gemm g{WSP(bf16, WS_DFT), WSP(bf16, WS_ZT)}; pg8::StaticOrder S; S.init(2304, 2048, G, bx, 8192, 8192);
            pg8::EpiF2 E{WSP(bf16, WS_OC)};
            pg8::gemm_phase<pg8::EpiF2, pg8::StaticOrder, false, 8192, 8192, 8192>(ldsl, g, S, E, wave0);
        }
#endif
#if PH_D2
        {
            PH_IDS();
            gu32* qhead = ctl + CW_QUEUE + 64 * layer; gu32* phead = ctl + CW_QUEUE + 128 + 64 * layer; const bool pref = bx >= 128 && bx < 128 + NPCU;
            bf16* PROJ = WSP(bf16, WS_PROJ); bf16* DO = WSP(bf16, WS_MG); bf16* DL = WSP(bf16, WS_H); float* LSE = WSP(float, WS_LSE); const float* TAB = WSP(float, WS_TAB);
            const float* cur_tab = nullptr;
            for (;;) {
                __syncthreads();
                if (tid == 0) { unsigned w = 0xffffffffu;
                    if (pref) { const unsigned v = __hip_atomic_fetch_add(phead, 1u, __ATOMIC_RELAXED, __HIP_MEMORY_SCOPE_AGENT); if (v < (unsigned)NPREP) w = 0x8000u | v; }
                    if (w == 0xffffffffu) { const unsigned v = __hip_atomic_fetch_add(qhead, 1u, __ATOMIC_RELAXED, __HIP_MEMORY_SCOPE_AGENT); if (v < 1792u) w = v; }
                    if (w == 0xffffffffu && !pref) { const unsigned v = __hip_atomic_fetch_add(phead, 1u, __ATOMIC_RELAXED, __HIP_MEMORY_SCOPE_AGENT); if (v < (unsigned)NPREP) w = 0x8000u | v; }
                    MISC[0] = w; }
                __syncthreads();
                const int ui0 = __builtin_amdgcn_readfirstlane((int)MISC[0]);
                if (ui0 == -1) break;
                int ui = ui0;
                { const int grp = ui0 & 0x7fff;
                    if (ui0 & 0x8000) {
                        const int pi = grp, t3 = opaque_tid(wave0), ln = t3 & 63;
                        { const float* pu = INL(15, (size_t)NEXP * DM); const float* pv = INL(16, (size_t)NEXP * DM); unsigned char* U8 = WSP(unsigned char, WS_U); unsigned char* V8 = WSP(unsigned char, WS_V); float* SU = WSP(float, WS_SU);
                          const int e0 = 32 * pi + 4 * wave0; LAS float* scr = (LAS float*)(ldsl + wave0 * 8448);
                          const int tpi = layer == 0 ? (I_OWN + I_IN) / NPREP : I_OWN / NPREP;
                          struct TDsc { const float* W; const float* gk; bf16* WT; unsigned char* WT8; int N, k0, n0, col_off, rowd, fp8; };
                          auto tdesc = [&](int r) -> TDsc { TDsc d; d.WT8 = nullptr; d.WT = nullptr; d.gk = nullptr; d.fp8 = 0; d.rowd = 0; d.col_off = 0; d.N = DM;
                              if (r < I_A) { d.W = INL(6, 512 * DM); d.WT = WSP(bf16, WS_WCAT); }
                              else if ((r -= I_A) < I_A) { d.W = INL(7, 512 * DM); d.WT = WSP(bf16, WS_WCAT); d.col_off = 512; }
                              else if ((r -= I_A) < I_C) { d.W = INL(8, 1024 * DM); d.WT = WSP(bf16, WS_WCAT); d.col_off = 1024; }
                              else if ((r -= I_C) < I_SQ) { d.W = INL(11, DM * DM); d.WT = WSP(bf16, WS_WO); }
                              else if ((r -= I_SQ) < I_SQ) { d.W = INL(13, DM * DM); d.WT = WSP(bf16, WS_WQ); d.gk = INL(12, DM); }
                              else { r -= I_SQ; d.W = INP(4) + (size_t)DM * INW; d.N = INW; d.WT = WSP(bf16, WS_WIN); const int ct = ((r % (INW / 32)) * 32) >> 8;
                                  if (ct >= 28 && ct < 32) d.rowd = -26 * 256; else if (ct >= 2) { d.fp8 = 1; d.WT8 = WSP(unsigned char, WS_WG8); d.rowd = ct < 28 ? 2 * 256 : 6 * 256; } }
                              const int nblk = d.N / 32; d.k0 = 64 * (r / nblk); d.n0 = 32 * (r % nblk); return d; };
                          f32x4 buf[4][8];
#define PP_ISSUE(k) do { if ((k) < 8) { const GAS f32x4* rp_ = (const GAS f32x4*)(((k) < 4 ? pu : pv) + (size_t)(e0 + ((k) & 3)) * DM) + ln; \
                              _Pragma("unroll") for (int j_ = 0; j_ < 8; ++j_) buf[(k) & 3][j_] = __builtin_nontemporal_load(rp_ + 64 * j_); } \
                          else if (wave0 + NWAVES * ((k) - 8) < tpi) { const TDsc d_ = tdesc(pi * tpi + wave0 + NWAVES * ((k) - 8)); tr_issue(buf[(k) & 3], d_.W, d_.N, d_.k0, d_.n0, ln); } } while (0)
                          PP_ISSUE(0); PP_ISSUE(1); PP_ISSUE(2); PP_ISSUE(3);
#pragma unroll
                          for (int k = 0; k < 13; ++k) { f32x4 (&y)[8] = buf[k & 3];
                              if (k < 4) { const int e = e0 + k; float mx = 0.f;
                                  { const GAS f32x4* gp_ = (const GAS f32x4*)INL(12, DM) + ln;
#pragma unroll
                                    for (int j = 0; j < 8; ++j) y[j] = y[j] * gp_[64 * j]; }
#pragma unroll
                                  for (int j = 0; j < 8; ++j) mx = fmaxf(mx, fmaxf(fmaxf(fabsf(y[j].x), fabsf(y[j].y)), fmaxf(fabsf(y[j].z), fabsf(y[j].w))));
                                  mx = fmaxf(wave_maxf(mx), 1e-30f); const float inv = 127.f / mx;
#pragma unroll
                                  for (int j = 0; j < 8; ++j) ((GAS unsigned*)(U8 + (size_t)e * DM))[ln + 64 * j] = q8x4(y[j].x, y[j].y, y[j].z, y[j].w, inv);
                                  if (ln == 0) SU[e] = mx * (1.f / 127.f); }
                              else if (k < 8) { const int e = e0 + (k - 4);
#pragma unroll
                                  for (int j = 0; j < 8; ++j) { int w = __builtin_amdgcn_cvt_pk_fp8_f32(y[j].x * 64.f, y[j].y * 64.f, 0, false); w = __builtin_amdgcn_cvt_pk_fp8_f32(y[j].z * 64.f, y[j].w * 64.f, w, true);
                                      ((GAS unsigned*)(V8 + (size_t)e * DM))[ln + 64 * j] = (unsigned)w; } }
                              else if (wave0 + NWAVES * (k - 8) < tpi) { const TDsc d = tdesc(pi * tpi + wave0 + NWAVES * (k - 8));
                                  if (d.fp8) tr_finish_fp8(y, scr, d.WT8, DM, 1024.f, d.k0, d.n0, d.rowd, ln); else tr_finish_bf16(y, scr, d.WT, DM, d.col_off, d.k0, d.n0, d.rowd, ln, d.gk); }
                              if (k + 4 < 13) PP_ISSUE(k + 4);
                          }
#undef PP_ISSUE
                        }
                        continue;
                    }
                }
                attn::Unit u; int hd;
                if (ui < 1024) {
                    const int qb = ui & 15, vh = (ui >> 4) & 1, m = (ui >> 5) & 1, h = (ui >> 6) & 3, b = ui >> 8;
                    const bf16* base = PROJ + (size_t)b * SEQ * PJW;
                    u.Q = base + (size_t)(qb * 256) * PJW + COL_DIFF + (h * 2 + m) * 128; u.K = base + COL_DIFF + 1024 + (h * 2 + m) * 128; u.V = base + COL_DIFF + 2048 + h * 256 + vh * 128;
                    u.O = DO + (size_t)(b * SEQ + qb * 256) * DM + (h * 2 + m) * 256 + vh * 128; u.lse = nullptr; u.ldq = PJW; u.ldk = PJW; u.ldo = DM; u.lse_ld = 0;
                    u.kt0 = 0; u.nt = SEQ / 64; u.qoff = qb * 256; hd = 12 + h;
                } else {
                    const int v = ui - 1024, qb16 = v & 15, hh = (v >> 4) & 3, bg = v >> 6, g = bg % 3, b = bg / 3;
                    const int dil = g == 0 ? 1 : (g == 1 ? 4 : 16), bpc = 16 / dil, r = qb16 / bpc, qblk = qb16 % bpc, q0 = qblk * 256, ntot = (SEQ / dil) / 64;
                    int kt0 = q0 / 64 - 1; if (kt0 < 0) kt0 = 0; int kt1 = q0 / 64 + 5; if (kt1 > ntot) kt1 = ntot;
                    if ((kt1 - kt0) & 1) { if (kt0 > 0) --kt0; else ++kt1; }
                    const bf16* base = PROJ + (size_t)(b * SEQ + r) * PJW + COL_DIL + g * 512 + hh * 128;
                    u.Q = base + (size_t)q0 * dil * PJW; u.K = base + 1536; u.V = base + 3072;
                    u.O = DL + ((size_t)g * MTOK + b * SEQ + r + (size_t)q0 * dil) * 512 + hh * 128; u.lse = LSE + ((size_t)g * MTOK + b * SEQ + r + (size_t)q0 * dil) * 4 + hh;
                    u.ldq = (long)PJW * dil; u.ldk = (long)PJW * dil; u.ldo = 512L * dil; u.lse_ld = 4 * dil; u.kt0 = kt0; u.nt = kt1 - kt0; u.qoff = q0; hd = g * 4 + hh;
                }
                const float* tab = TAB + (size_t)hd * 8192;
                if (tab != cur_tab) {
                    cur_tab = tab;
                    LAS f32x4* tl = (LAS f32x4*)(ldsl + attn::LDS_TAB); const int t2 = opaque_tid(wave0);
#pragma unroll
                    for (int j = 0; j < 4; ++j) tl[t2 + 512 * j] = ((const GAS f32x4*)tab)[t2 + 512 * j];
                }
                attn::attn_unit(u, (char*)lds, wave0);
            }
        }
#endif
#endif
        GRID_BAR();

#if PH_E
        {
            PH_IDS();
            const float* dlam = INL(9, 512); const float* subln = INL(10, 256); const float lambda_init = layer == 0 ? 0.2f : 0.35550906759f;
            const float* LSE = WSP(float, WS_LSE); const bf16* DL = WSP(bf16, WS_H); const bf16* DO = WSP(bf16, WS_MG); bf16* OC = WSP(bf16, WS_OC);
            float s1 = dlam[lane] * dlam[128 + lane] + dlam[64 + lane] * dlam[192 + lane], s2 = dlam[256 + lane] * dlam[384 + lane] + dlam[320 + lane] * dlam[448 + lane];
            s1 = wave_sum(s1); s2 = wave_sum(s2);
            const float lam = __expf(s1) - __expf(s2) + lambda_init, osc = 1.0f - lambda_init;
            const int hq = lane >> 4, l16 = lane & 15;
            const f32x4 g0 = *(const GAS f32x4*)(subln + l16 * 16), g1 = *(const GAS f32x4*)(subln + l16 * 16 + 4), g2 = *(const GAS f32x4*)(subln + l16 * 16 + 8), g3 = *(const GAS f32x4*)(subln + l16 * 16 + 12);
            for (int t = gw; t < MTOK; t += 4 * NGW) {
                float ls[4][3]; v4u dl[4][3], da[4][4];
#pragma unroll
                for (int u = 0; u < 4; ++u) { const int tt = t + u * NGW;
#pragma unroll
                    for (int g = 0; g < 3; ++g) { ls[u][g] = LSE[((size_t)g * MTOK + tt) * 4 + hq]; dl[u][g] = *(const GAS v4u*)(DL + ((size_t)g * MTOK + tt) * 512 + lane * 8); }
                    const bf16* dp = DO + (size_t)tt * DM + hq * 512 + l16 * 16;
                    da[u][0] = *(const GAS v4u*)(dp); da[u][1] = *(const GAS v4u*)(dp + 8); da[u][2] = *(const GAS v4u*)(dp + 256); da[u][3] = *(const GAS v4u*)(dp + 264); }
#pragma unroll
                for (int u = 0; u < 4; ++u) { const int tt = t + u * NGW;
                    float mx = fmaxf(fmaxf(ls[u][0], ls[u][1]), ls[u][2]), wsum = 0.f;
#pragma unroll
                    for (int g = 0; g < 3; ++g) { ls[u][g] = __expf(ls[u][g] - mx); wsum += ls[u][g]; }
                    const float winv = 1.0f / wsum; float acc8[8] = {0.f, 0.f, 0.f, 0.f, 0.f, 0.f, 0.f, 0.f};
#pragma unroll
                    for (int g = 0; g < 3; ++g) { const v4u o = dl[u][g]; const float w = ls[u][g] * winv;
                        acc8[0] += w * bflo(o.x); acc8[1] += w * bfhi(o.x); acc8[2] += w * bflo(o.y); acc8[3] += w * bfhi(o.y); acc8[4] += w * bflo(o.z); acc8[5] += w * bfhi(o.z); acc8[6] += w * bflo(o.w); acc8[7] += w * bfhi(o.w); }
                    { v4u o; o.x = pk2(acc8[0], acc8[1]); o.y = pk2(acc8[2], acc8[3]); o.z = pk2(acc8[4], acc8[5]); o.w = pk2(acc8[6], acc8[7]); *(GAS v4u*)(OC + (size_t)tt * DM + 512 + lane * 8) = o; }
                    const v4u a0 = da[u][0], a1 = da[u][1], b0 = da[u][2], b1 = da[u][3];
                    float d[16];
                    d[0] = bflo(a0.x) - lam * bflo(b0.x); d[1] = bfhi(a0.x) - lam * bfhi(b0.x); d[2] = bflo(a0.y) - lam * bflo(b0.y); d[3] = bfhi(a0.y) - lam * bfhi(b0.y);
                    d[4] = bflo(a0.z) - lam * bflo(b0.z); d[5] = bfhi(a0.z) - lam * bfhi(b0.z); d[6] = bflo(a0.w) - lam * bflo(b0.w); d[7] = bfhi(a0.w) - lam * bfhi(b0.w);
                    d[8] = bflo(a1.x) - lam * bflo(b1.x); d[9] = bfhi(a1.x) - lam * bfhi(b1.x); d[10] = bflo(a1.y) - lam * bflo(b1.y); d[11] = bfhi(a1.y) - lam * bfhi(b1.y);
                    d[12] = bflo(a1.z) - lam * bflo(b1.z); d[13] = bfhi(a1.z) - lam * bfhi(b1.z); d[14] = bflo(a1.w) - lam * bflo(b1.w); d[15] = bfhi(a1.w) - lam * bfhi(b1.w);
                    float ss = 0.f;
#pragma unroll
                    for (int j = 0; j < 16; ++j) ss += d[j] * d[j];
                    ss += sx_f<1>(ss); ss += sx_f<2>(ss); ss += sx_f<4>(ss); ss += sx_f<8>(ss);
                    const float rs = osc / sqrtf(ss * (1.f / 256.f) + RMS_EPS);
                    v4u o0, o1;
                    o0.x = pk2(d[0] * rs * g0.x, d[1] * rs * g0.y); o0.y = pk2(d[2] * rs * g0.z, d[3] * rs * g0.w); o0.z = pk2(d[4] * rs * g1.x, d[5] * rs * g1.y); o0.w = pk2(d[6] * rs * g1.z, d[7] * rs * g1.w);
                    o1.x = pk2(d[8] * rs * g2.x, d[9] * rs * g2.y); o1.y = pk2(d[10] * rs * g2.z, d[11] * rs * g2.w); o1.z = pk2(d[12] * rs * g3.x, d[13] * rs * g3.y); o1.w = pk2(d[14] * rs * g3.z, d[15] * rs * g3.w);
                    bf16* op = OC + (size_t)tt * DM + 1024 + hq * 256 + l16 * 16;
                    *(GAS v4u*)(op) = o0; *(GAS v4u*)(op + 8) = o1; }
            }
        }
#endif
        GRID_BAR();

#if PH_F
        {
            pg8::MergeOrder S; S.init(MTOK, DM, G, bx, DM, DM);
            pg8::Gemm g{WSP(bf16, WS_OC), WSP(bf16, WS_WCAT)}; pg8::EpiMerge4 E{WSP(unsigned char, WS_G), WSP(bf16, WS_MG)};
            pg8::gemm_phase<pg8::EpiMerge4, pg8::MergeOrder, true, DM, DM, 512>(ldsl, g, S, E, wave0);
        }
#endif
        GRID_BAR();

#if PH_G
        {
            pg8::Gemm g{WSP(bf16, WS_MG), WSP(bf16, WS_WO)}; pg8::StaticOrder S; S.init(MTOK, DM, G, bx, DM, DM);
            pg8::EpiResX E{layer == 0 ? INP(0) : (const float*)nullptr, X16, X16, WSP(unsigned char, WS_H8), WSP(float, WS_SSP)};
            pg8::gemm_phase<pg8::EpiResX, pg8::StaticOrder, true, DM, DM, DM>(ldsl, g, S, E, wave0);
        }
#endif
        GRID_BAR();

#if PH_I
        {
            pg8::Gemm g{X16, WSP(bf16, WS_WQ)}; pg8::StaticOrder S; S.init(MTOK, DM, G, bx, DM, DM);
            pg8::EpiStoreRS E{WSP(bf16, WS_Q), DM, WSP(float, WS_SSP)};
            pg8::gemm_phase<pg8::EpiStoreRS, pg8::StaticOrder, true, DM, DM, DM>(ldsl, g, S, E, wave0);
        }
#endif
        GRID_BAR();

#if PH_K
        {
            PH_IDS();
            const bf16* Q = WSP(bf16, WS_Q); int* IDS = WSP(int, WS_IDS); float* GATES = WSP(float, WS_GATES);
            const int l16 = lane & 15, rbase = lane & 48, fq = lane >> 4;
            constexpr int SKP = 272;
            { const float* subk = INL(14, 2 * 128 * 128);
#pragma unroll
              for (int j = 0; j < 8; ++j) { const int ci = tid + 512 * j, kr = ci >> 4, c8 = ci & 15; const GAS f32x4* sp = (const GAS f32x4*)(subk + (size_t)kr * 128 + c8 * 8); const f32x4 lo = sp[0], hi4 = sp[1];
                  v4u w; w.x = pk2(lo.x, lo.y); w.y = pk2(lo.z, lo.w); w.z = pk2(hi4.x, hi4.y); w.w = pk2(hi4.z, hi4.w); *(LAS v4u*)(ldsl + kr * SKP + c8 * 16) = w; } }
            __syncthreads();
            int cq[4];
#pragma unroll
            for (int q = 0; q < 4; ++q) { int c = l16 + 16 * q, ci = -1, cj = 0; for (int i = 0; i < 16; ++i) { const int cnt = 16 / (i + 1); if (ci < 0) { if (c < cnt) { ci = i; cj = c; } else c -= cnt; } } cq[q] = ci < 0 ? -1 : ci * 16 + cj; }
            typedef short bfx8 __attribute__((ext_vector_type(8)));
            const LAS unsigned char* skl = ldsl + l16 * SKP + fq * 16;
            bfx8 nq[8];
            { const GAS bfx8* qp = (const GAS bfx8*)(Q + (size_t)(gw * 16 + l16) * 256 + fq * 8);
#pragma unroll
              for (int j = 0; j < 8; ++j) nq[j] = qp[4 * j]; }
            const int NTRIP = MTOK * 8 / 16;
            for (int trip = gw; trip < NTRIP; trip += NGW) {
                pg8::f32x4 sa[8], sb[8];
#pragma unroll
                for (int nb = 0; nb < 8; ++nb) { sa[nb] = (pg8::f32x4){0.f, 0.f, 0.f, 0.f}; sb[nb] = (pg8::f32x4){0.f, 0.f, 0.f, 0.f}; }
#pragma unroll
                for (int ks = 0; ks < 4; ++ks)
#pragma unroll
                    for (int n4 = 0; n4 < 8; n4 += 4) {
#pragma unroll
                        for (int nb = n4; nb < n4 + 4; ++nb) { const bfx8 ka_ = *(const LAS bfx8*)(skl + (nb * 16) * SKP + ks * 64), kb_ = *(const LAS bfx8*)(skl + (128 + nb * 16) * SKP + ks * 64);
                            sa[nb] = __builtin_amdgcn_mfma_f32_16x16x32_bf16(nq[ks], ka_, sa[nb], 0, 0, 0); sb[nb] = __builtin_amdgcn_mfma_f32_16x16x32_bf16(nq[4 + ks], kb_, sb[nb], 0, 0, 0); }
                        __builtin_amdgcn_sched_barrier(0); }
                { const int nt = trip + NGW < NTRIP ? trip + NGW : trip; const GAS bfx8* qp = (const GAS bfx8*)(Q + (size_t)(nt * 16 + l16) * 256 + fq * 8);
#pragma unroll
                  for (int j = 0; j < 8; ++j) nq[j] = qp[4 * j]; }
#pragma unroll
              for (int p4 = 0; p4 < 4; ++p4) {
                const int row = trip * 16 + 4 * fq + p4;
                unsigned ka[8], kb[8];
#pragma unroll
                for (int jj = 0; jj < 8; ++jj) { const unsigned ix = (unsigned)(127 - (jj * 16 + l16)); ka[jj] = (okey(sa[jj][p4]) & ~127u) | ix; kb[jj] = (okey(sb[jj][p4]) & ~127u) | ix; }
#define SORT8(k) do { CE_DESC(k[0], k[1]); CE_DESC(k[2], k[3]); CE_DESC(k[4], k[5]); CE_DESC(k[6], k[7]); CE_DESC(k[0], k[2]); CE_DESC(k[1], k[3]); CE_DESC(k[4], k[6]); CE_DESC(k[5], k[7]); \
    CE_DESC(k[1], k[2]); CE_DESC(k[5], k[6]); CE_DESC(k[0], k[4]); CE_DESC(k[3], k[7]); CE_DESC(k[1], k[5]); CE_DESC(k[2], k[6]); CE_DESC(k[1], k[4]); CE_DESC(k[3], k[6]); \
    CE_DESC(k[2], k[4]); CE_DESC(k[3], k[5]); CE_DESC(k[3], k[4]); } while (0)
                SORT8(ka); SORT8(kb);
                unsigned ta = 0u, tb = 0u;
#pragma unroll
                for (int r = 0; r < 16; ++r) {
                    const unsigned ma = row_max16_u(ka[0]), mb = row_max16_u(kb[0]);
                    const bool wa = ka[0] == ma, wb = kb[0] == mb;
                    ta = (l16 == r) ? ma : ta; tb = (l16 == r) ? mb : tb;
#pragma unroll
                    for (int q = 0; q < 7; ++q) { ka[q] = wa ? ka[q + 1] : ka[q]; kb[q] = wb ? kb[q + 1] : kb[q]; }
                    ka[7] = wa ? 0u : ka[7]; kb[7] = wb ? 0u : kb[7];
                }
                const int ia = 127 - (int)(ta & 127u), ib = 127 - (int)(tb & 127u);
                const float va = okey_inv(ta & ~127u), vb = okey_inv(tb & ~127u);
                unsigned ck[4];
#pragma unroll
                for (int q = 0; q < 4; ++q) { const int cc = cq[q] < 0 ? 0 : cq[q]; const float cs = bperm_f(va, rbase + (cc >> 4)) + bperm_f(vb, rbase + (cc & 15));
                    ck[q] = cq[q] < 0 ? 0u : ((okey(cs) & ~255u) | (unsigned)(255 - cc)); }
                CE_DESC(ck[0], ck[1]); CE_DESC(ck[2], ck[3]); CE_DESC(ck[0], ck[2]); CE_DESC(ck[1], ck[3]); CE_DESC(ck[1], ck[2]);
                unsigned tw = 0u;
#pragma unroll
                for (int r = 0; r < 16; ++r) { const unsigned mm = row_max16_u(ck[0]); const bool w = ck[0] == mm; tw = (l16 == r) ? mm : tw;
                    ck[0] = w ? ck[1] : ck[0]; ck[1] = w ? ck[2] : ck[1]; ck[2] = w ? ck[3] : ck[2]; ck[3] = w ? 0u : ck[3]; }
                const int code = 255 - (int)(tw & 255u), wi = (code >> 4) & 15, wj = code & 15;
                const float bs = bperm_f(va, rbase + wi) + bperm_f(vb, rbase + wj);
                const int eid = bperm_i(ia, rbase + wi) * 128 + bperm_i(ib, rbase + wj);
                const float mx = row_max16_f(bs), e = __expf(bs - mx), es = row_sum16(e);
                IDS[(size_t)row * 16 + l16] = eid; GATES[(size_t)row * 16 + l16] = e / es;
              }
            }
#undef SORT8
        }
#endif
        GRID_BAR();

#if PH_L
#define L_LDIDS(I, tt, hh) do { const GAS v4u* ip_ = (const GAS v4u*)(IDS + (size_t)(tt) * 128 + (hh) * 64 + lrow * 16); I##0 = ip_[0]; I##1 = ip_[1]; I##2 = ip_[2]; I##3 = ip_[3]; } while (0)
#define L_ISSUE(W, I, base) do { \
    W[0] = *(const GAS v4u*)((base) + (size_t)(I##0).x * DM); W[1] = *(const GAS v4u*)((base) + (size_t)(I##0).y * DM); W[2] = *(const GAS v4u*)((base) + (size_t)(I##0).z * DM); W[3] = *(const GAS v4u*)((base) + (size_t)(I##0).w * DM); \
    W[4] = *(const GAS v4u*)((base) + (size_t)(I##1).x * DM); W[5] = *(const GAS v4u*)((base) + (size_t)(I##1).y * DM); W[6] = *(const GAS v4u*)((base) + (size_t)(I##1).z * DM); W[7] = *(const GAS v4u*)((base) + (size_t)(I##1).w * DM); \
    W[8] = *(const GAS v4u*)((base) + (size_t)(I##2).x * DM); W[9] = *(const GAS v4u*)((base) + (size_t)(I##2).y * DM); W[10] = *(const GAS v4u*)((base) + (size_t)(I##2).z * DM); W[11] = *(const GAS v4u*)((base) + (size_t)(I##2).w * DM); \
    W[12] = *(const GAS v4u*)((base) + (size_t)(I##3).x * DM); W[13] = *(const GAS v4u*)((base) + (size_t)(I##3).y * DM); W[14] = *(const GAS v4u*)((base) + (size_t)(I##3).z * DM); W[15] = *(const GAS v4u*)((base) + (size_t)(I##3).w * DM); } while (0)
#define L_CVT(d, hi) __builtin_amdgcn_cvt_pk_f32_fp8((int)(d), (hi))
        {
            PH_IDS();
            const unsigned char* H8 = WSP(unsigned char, WS_H8); const unsigned char* U8 = WSP(unsigned char, WS_U); const int* IDS = WSP(int, WS_IDS); float* PART = WSP(float, WS_G);
            typedef float f32x2 __attribute__((ext_vector_type(2)));
            const int myx = (int)(xb_xcc_id() & 7u); int nx = 0, xi = 0, nloc = 1;
            for (int j = 0; j < 8; ++j) { const int c = (int)__hip_atomic_load(ctl + CW_XRANK + 64 * j, __ATOMIC_RELAXED, __HIP_MEMORY_SCOPE_AGENT); if (c > 0) { ++nx; if (j < myx) ++xi; } if (j == myx) nloc = c; }
            const int rw = (int)MISC[1] * NWAVES + wave, nW = nloc * NWAVES; const int l16 = lane & 15, lrow = lane >> 4;
#define L1_COMPUTE(W, dst) do { float sk[16]; _Pragma("unroll") for (int k = 0; k < 16; ++k) { const v4u ww = W[k]; int ac = 0; \
        ac = __builtin_amdgcn_sdot4((int)ww.x, (int)h0.x, ac, false); ac = __builtin_amdgcn_sdot4((int)ww.y, (int)h0.y, ac, false); ac = __builtin_amdgcn_sdot4((int)ww.z, (int)h0.z, ac, false); ac = __builtin_amdgcn_sdot4((int)ww.w, (int)h0.w, ac, false); \
        sk[k] = (float)ac; } \
          \
        float t8[8]; _Pragma("unroll") for (int j = 0; j < 8; ++j) { const float keep = b8 ? sk[8 + j] : sk[j], send = b8 ? sk[j] : sk[8 + j]; \
            t8[j] = keep + __int_as_float(__builtin_amdgcn_update_dpp(0, __float_as_int(send), 0x128, 0xF, 0xF, false)); } \
        float t4[4]; _Pragma("unroll") for (int j = 0; j < 4; ++j) { const float keep = b4 ? t8[4 + j] : t8[j], send = b4 ? t8[j] : t8[4 + j]; t4[j] = keep + sx_f<4>(send); } \
        float t2[2]; _Pragma("unroll") for (int j = 0; j < 2; ++j) { const float keep = b2 ? t4[2 + j] : t4[j], send = b2 ? t4[j] : t4[2 + j]; \
            t2[j] = keep + __int_as_float(__builtin_amdgcn_update_dpp(0, __float_as_int(send), 0x4E, 0xF, 0xF, false)); } \
        { const float keep = b1 ? t2[1] : t2[0], send = b1 ? t2[0] : t2[1]; dst = keep + __int_as_float(__builtin_amdgcn_update_dpp(0, __float_as_int(send), 0xB1, 0xF, 0xF, false)); } } while (0)
            const bool b8 = (lane & 8) != 0, b4 = (lane & 4) != 0, b2 = (lane & 2) != 0, b1 = (lane & 1) != 0;
            for (int sl = xi; sl < 8; sl += nx) {
                const unsigned char* ub = U8 + sl * 256 + l16 * 16; const unsigned char* hb = H8 + sl * 256 + l16 * 16;
                int t = rw;
                if (t < MTOK) {
                    v4u Wa[16], Wb[16]; v4u ia0, ia1, ia2, ia3, ib0, ib1, ib2, ib3; v4u h0;
                    L_LDIDS(ia, t, 0); L_LDIDS(ib, t, 1); h0 = *(const GAS v4u*)(hb + (size_t)t * DM);
                    L_ISSUE(Wa, ia, ub);
                    for (;;) {
                        const int tn = t + nW; const bool more = tn < MTOK; const int tp = more ? tn : t;
                        L_ISSUE(Wb, ib, ub);
                        L_LDIDS(ia, tp, 0); const v4u hn0 = *(const GAS v4u*)(hb + (size_t)tp * DM);
                        float pre0, pre1;
                        L1_COMPUTE(Wa, pre0);
                        L_ISSUE(Wa, ia, ub);
                        L_LDIDS(ib, tp, 1);
                        L1_COMPUTE(Wb, pre1);
                        float* pp = PART + ((size_t)sl * MTOK + t) * 128; pp[lane] = pre0; pp[64 + lane] = pre1;
                        h0 = hn0;
                        if (!more) break;
                        t = tn;
                    }
                }
            }
#undef L1_COMPUTE
        }
        GRID_BAR();
        {
            PH_IDS();
            const float* PART = WSP(float, WS_G); const float* GATES = WSP(float, WS_GATES); float* ACTW = WSP(float, WS_ACT);
            for (int t = gw; t < MTOK; t += NGW) {
                float q0 = 0.f, q1 = 0.f;
#pragma unroll
                for (int s8 = 0; s8 < 8; ++s8) { const float* pp = PART + ((size_t)s8 * MTOK + t) * 128; q0 += pp[lane]; q1 += pp[64 + lane]; }
                { const int* ip = WSP(int, WS_IDS) + (size_t)t * 128; float sh; { const float pv = lane < 32 ? WSP(float, WS_SSP)[(size_t)t * 32 + lane] : 0.f; sh = (1.0f / sqrtf(wave_sum(pv) * (1.f / DM) + RMS_EPS)) * (1.f / pg8::XS8); }     const float* SU = WSP(float, WS_SU); q0 *= SU[ip[lane]] * sh; q1 *= SU[ip[64 + lane]] * sh; }
                const float* gp = GATES + (size_t)t * 128; float* ap = ACTW + (size_t)t * 128;
                const float g0 = gp[lane], g1 = gp[64 + lane];
                ap[lane] = 0.5f * q0 * (1.0f + erff(q0 * 0.70710678118654752f)) * g0 * (1.f / 64.f); ap[64 + lane] = 0.5f * q1 * (1.0f + erff(q1 * 0.70710678118654752f)) * g1 * (1.f / 64.f);
            }
        }
        GRID_BAR();
        {
            PH_IDS();
            const unsigned char* V8 = WSP(unsigned char, WS_V); const int* IDS = WSP(int, WS_IDS); const float* ACT = WSP(float, WS_ACT);
            typedef float f32x2 __attribute__((ext_vector_type(2)));
            const int myx = (int)(xb_xcc_id() & 7u); int nx = 0, xi = 0, nloc = 1;
            for (int j = 0; j < 8; ++j) { const int c = (int)__hip_atomic_load(ctl + CW_XRANK + 64 * j, __ATOMIC_RELAXED, __HIP_MEMORY_SCOPE_AGENT); if (c > 0) { ++nx; if (j < myx) ++xi; } if (j == myx) nloc = c; }
            const int rw = (int)MISC[1] * NWAVES + wave, nW = nloc * NWAVES; const int l16 = lane & 15, lrow = lane >> 4;
            bf16* XO = X16;
#define L2_BC(av, acr) do { av[0] = rowb<0>(acr); av[1] = rowb<1>(acr); av[2] = rowb<2>(acr); av[3] = rowb<3>(acr); av[4] = rowb<4>(acr); av[5] = rowb<5>(acr); av[6] = rowb<6>(acr); av[7] = rowb<7>(acr); av[8] = rowb<8>(acr); av[9] = rowb<9>(acr); av[10] = rowb<10>(acr); av[11] = rowb<11>(acr); av[12] = rowb<12>(acr); av[13] = rowb<13>(acr); av[14] = rowb<14>(acr); av[15] = rowb<15>(acr); } while (0)
#define L2_C4(Q, av, o) do { _Pragma("unroll") for (int k = 0; k < 4; ++k) { const float a = av[(o) + k]; const f32x2 aa = (f32x2){a, a}; \
        const v4u ww = Q[k]; const unsigned d0 = ww.x, d1 = ww.y, d2 = ww.z, d3 = ww.w; \
        oacc[0] += aa * L_CVT(d0, false); oacc[1] += aa * L_CVT(d0, true); oacc[2] += aa * L_CVT(d1, false); oacc[3] += aa * L_CVT(d1, true); \
        oacc[4] += aa * L_CVT(d2, false); oacc[5] += aa * L_CVT(d2, true); oacc[6] += aa * L_CVT(d3, false); oacc[7] += aa * L_CVT(d3, true); } } while (0)
#define L_ISS4(Q, Ia) do { Q[0] = *(const GAS v4u*)(vb + (size_t)(Ia).x * DM); Q[1] = *(const GAS v4u*)(vb + (size_t)(Ia).y * DM); Q[2] = *(const GAS v4u*)(vb + (size_t)(Ia).z * DM); Q[3] = *(const GAS v4u*)(vb + (size_t)(Ia).w * DM); } while (0)
            for (int sl = xi; sl < 8; sl += nx) {
                const unsigned char* vb = V8 + sl * 256 + l16 * 16; bf16* xb = XO + sl * 256 + l16 * 16;
                int t = rw;
                if (t < MTOK) {
                    v4u Q0[4], Q1[4], Q2[4], Q3[4], Q4[4], Q5[4], Q6[4], Q7[4]; v4u ia0, ia1, ia2, ia3, ib0, ib1, ib2, ib3; float ac0, ac1;
                    L_LDIDS(ia, t, 0); L_LDIDS(ib, t, 1); ac0 = ACT[(size_t)t * 128 + lane]; ac1 = ACT[(size_t)t * 128 + 64 + lane];
                    L_ISS4(Q0, ia0); L_ISS4(Q1, ia1); L_ISS4(Q2, ia2); L_ISS4(Q3, ia3); L_ISS4(Q4, ib0); L_ISS4(Q5, ib1); L_ISS4(Q6, ib2); L_ISS4(Q7, ib3);
                    for (;;) {
                        const int tn = t + nW; const bool more = tn < MTOK; const int tp = more ? tn : t;
                        L_LDIDS(ia, tp, 0); L_LDIDS(ib, tp, 1); const float an0 = ACT[(size_t)tp * 128 + lane], an1 = ACT[(size_t)tp * 128 + 64 + lane];
                        f32x2 oacc[8];
#pragma unroll
                        for (int k = 0; k < 8; ++k) oacc[k] = (f32x2){0.f, 0.f};
                        float av[16];
                        L2_BC(av, ac0);
                        L2_C4(Q0, av, 0); L_ISS4(Q0, ia0);
                        L2_C4(Q1, av, 4); L_ISS4(Q1, ia1);
                        L2_C4(Q2, av, 8); L_ISS4(Q2, ia2);
                        L2_C4(Q3, av, 12); L_ISS4(Q3, ia3);
                        v4u xv[2]; { const GAS v4u* q = (const GAS v4u*)(xb + (size_t)t * DM); xv[0] = q[0]; xv[1] = q[1]; }
                        L2_BC(av, ac1);
                        L2_C4(Q4, av, 0); L_ISS4(Q4, ib0);
                        L2_C4(Q5, av, 4); L_ISS4(Q5, ib1);
                        L2_C4(Q6, av, 8); L_ISS4(Q6, ib2);
                        L2_C4(Q7, av, 12); L_ISS4(Q7, ib3);
#pragma unroll
                        for (int k = 0; k < 8; ++k) { float a = oacc[k].x, b = oacc[k].y; a += sx_f<16>(a); b += sx_f<16>(b); a = add32(a); b = add32(b); oacc[k] = (f32x2){a, b}; }
                        if (lane < 16) { GAS v4u* q = (GAS v4u*)(xb + (size_t)t * DM);
#pragma unroll
                            for (int k = 0; k < 2; ++k) { const v4u xw = xv[k]; v4u o;
                                o.x = pk2(bflo(xw.x) + oacc[4 * k].x, bfhi(xw.x) + oacc[4 * k].y); o.y = pk2(bflo(xw.y) + oacc[4 * k + 1].x, bfhi(xw.y) + oacc[4 * k + 1].y);
                                o.z = pk2(bflo(xw.z) + oacc[4 * k + 2].x, bfhi(xw.z) + oacc[4 * k + 2].y); o.w = pk2(bflo(xw.w) + oacc[4 * k + 3].x, bfhi(xw.w) + oacc[4 * k + 3].y); q[k] = o; } }
                        ac0 = an0; ac1 = an1;
                        if (!more) break;
                        t = tn;
                    }
                }
            }
#undef L2_BC
#undef L2_C4
#undef L_ISS4
        }
#undef L_LDIDS
#undef L_ISSUE
#undef L_CVT
#endif
        GRID_BAR();
    }

    { PH_IDS(); const bf16* XS = X16;
    for (int m0 = gw; m0 < MTOK; m0 += 4 * NGW) {
        const GAS f32x4* gr = (const GAS f32x4*)INP(2) + 2 * lane;
        v4u xv[4][4];
#pragma unroll
        for (int u = 0; u < 4; ++u) { const GAS v4u* xr = (const GAS v4u*)(XS + (size_t)(m0 + u * NGW) * DM) + lane;
#pragma unroll
            for (int j = 0; j < 4; ++j) xv[u][j] = xr[64 * j]; }
#pragma unroll
        for (int u = 0; u < 4; ++u) { float v[4][8]; float s = 0.f;
#pragma unroll
            for (int j = 0; j < 4; ++j) { const v4u w = xv[u][j]; v[j][0] = bflo(w.x); v[j][1] = bfhi(w.x); v[j][2] = bflo(w.y); v[j][3] = bfhi(w.y); v[j][4] = bflo(w.z); v[j][5] = bfhi(w.z); v[j][6] = bflo(w.w); v[j][7] = bfhi(w.w);
#pragma unroll
                for (int k = 0; k < 8; ++k) s += v[j][k] * v[j][k]; }
            const float rstd = 1.0f / sqrtf(wave_sum(s) * (1.f / DM) + RMS_EPS);
            GAS f32x4* orow = (GAS f32x4*)(X + (size_t)(m0 + u * NGW) * DM) + 2 * lane;
#pragma unroll
            for (int j = 0; j < 4; ++j) { const f32x4 ga = gr[128 * j], gb = gr[128 * j + 1];
                orow[128 * j] = (f32x4){v[j][0] * rstd * ga.x, v[j][1] * rstd * ga.y, v[j][2] * rstd * ga.z, v[j][3] * rstd * ga.w};
                orow[128 * j + 1] = (f32x4){v[j][4] * rstd * gb.x, v[j][5] * rstd * gb.y, v[j][6] * rstd * gb.z, v[j][7] * rstd * gb.w}; } }
    } }
}

extern "C" void kernel_launch(void* const* d_in, const int* in_sizes, int n_in, void* d_out, int out_size, void* d_ws, size_t ws_size, hipStream_t stream) {
    static int grid = 0;
    if (grid == 0) {
        if (n_in != 17 || in_sizes[0] != MTOK * DM || out_size != MTOK * DM || ws_size < WS_END) {
            fprintf(stderr, "kernel_launch: shape/workspace mismatch: n_in %d in0 %d out %d ws %zu (need %zu); nothing launched\n", n_in, n_in > 0 ? in_sizes[0] : -1, out_size, ws_size, (size_t)WS_END); grid = -1; return; }
        int dev = 0, cus = 0, per_cu = 0;
        if (hipGetDevice(&dev) != hipSuccess || hipDeviceGetAttribute(&cus, hipDeviceAttributeMultiprocessorCount, dev) != hipSuccess) { grid = -1; return; }
        if (hipFuncSetAttribute((const void*)mk_fwd, hipFuncAttributeMaxDynamicSharedMemorySize, LDS_BYTES) != hipSuccess) { fprintf(stderr, "kernel_launch: hipFuncSetAttribute failed\n"); grid = -1; return; }
        if (hipOccupancyMaxActiveBlocksPerMultiprocessor(&per_cu, (const void*)mk_fwd, NWAVES * 64, LDS_BYTES) != hipSuccess || per_cu < 1)
            fprintf(stderr, "kernel_launch: note: occupancy query reports %d workgroups per CU\n", per_cu);
        (void)hipGetLastError();
        grid = cus;
    }
    if (grid < 0) return;
    if (hipMemsetAsync((char*)d_ws + WS_CTL, 0, CTL_ZERO_BYTES, stream) != hipSuccess) { fprintf(stderr, "kernel_launch: memset failed\n"); return; }
    Args a{};
    for (int i = 0; i < 17; ++i) a.in[i] = (const float*)d_in[i];
    a.out = (float*)d_out; a.ws = (unsigned char*)d_ws;
    hipLaunchKernelGGL(mk_fwd, dim3(grid), dim3(NWAVES * 64), LDS_BYTES, stream, a);
    const hipError_t le = hipPeekAtLastError();
    if (le != hipSuccess) fprintf(stderr, "kernel_launch: launch failed: %s\n", hipGetErrorName(le));
}
```

```cpp
#include <hip/hip_runtime.h>
#include <cstdio>
#include <cstdint>

#ifndef DBG_MODE
#define DBG_MODE 0
#endif
constexpr int DM = 2048, NB = 4, SEQ = 4096, MTOK = NB * SEQ;
constexpr int INW = 14336, PJW = 8192, GTW = 6144;
constexpr int COL_DIL = 512, COL_DIFF = 5120;
constexpr int NEXP = 16384;
constexpr float RMS_EPS = 1e-6f;

typedef unsigned short bf16;
#define GAS __attribute__((address_space(1)))
#define LAS __attribute__((address_space(3)))
typedef unsigned v4u __attribute__((ext_vector_type(4)));
typedef float f32x4 __attribute__((ext_vector_type(4)));
typedef GAS unsigned gu32;

__device__ __forceinline__ int opaque_tid(int wave_sgpr) { int l; asm volatile("v_mbcnt_lo_u32_b32 %0, -1, 0\n\tv_mbcnt_hi_u32_b32 %0, -1, %0" : "=v"(l)); return wave_sgpr * 64 + l; }
namespace pg8 {
#define PG8_LAS __attribute__((address_space(3)))
typedef unsigned short bf16_t;
typedef short bf16x8 __attribute__((ext_vector_type(8)));
typedef float f32x4 __attribute__((ext_vector_type(4)));
typedef unsigned u32x4 __attribute__((ext_vector_type(4)));
typedef unsigned u32x2 __attribute__((ext_vector_type(2)));
typedef int i32x4 __attribute__((ext_vector_type(4)));
typedef int i32x8 __attribute__((ext_vector_type(8)));
constexpr int BM = 256, BK = 64, HALF = 128, HTB = HALF * BK * 2, STAGE_BYTES = 8 * HTB, NXCD = 8, WGM = 8;

__host__ __device__ __forceinline__ int lds_byte(int r, int c) { const int st = (r >> 4) * 2 + (c >> 5), rr = r & 15, cc = c & 31, ob = rr * 64 + cc * 2; return st * 1024 + (ob ^ (((ob >> 9) & 1) << 5)); }
__host__ __device__ __forceinline__ void stage_rc(int b, int& R, int& C) { const int st = b / 1024, sb = b % 1024, swz = sb ^ (((sb >> 9) & 1) << 5); R = (st >> 1) * 16 + swz / 64; C = (st & 1) * 32 + (swz % 64) / 2; }
__host__ __device__ __forceinline__ int perm32(int rho) { const int n = rho >> 4, i = rho & 15; return 8 * (i >> 2) + 4 * n + (i & 3); }

struct Unit { int pm, pn; long aoff, boff; int orow, ocol, sub; };
struct Gemm { const bf16_t* A; const bf16_t* Bt; };

struct StaticOrder {
    int nM, nN, nwg, G, c; long sa, sb;
    __device__ void init(int M, int N, int G_, int c_, int lda, int ldb) { nM = M / BM; nN = N / BM; nwg = nM * nN; G = G_; c = c_; sa = 512L * lda; sb = 512L * ldb; }
    __device__ bool next(int i, Unit& u) const {
        const long L = (long)i * G + c; if (L >= nwg) return false;
        int wgid = (int)L; { const int q = nwg / NXCD, r = nwg % NXCD, xcd = wgid % NXCD, off = wgid / NXCD; wgid = (xcd < r ? xcd * (q + 1) : r * (q + 1) + (xcd - r) * q) + off; }
        const int nig = WGM * nN, gid = wgid / nig, fm = gid * WGM, gsz = (nM - fm) < WGM ? (nM - fm) : WGM;
        u.pm = fm + ((wgid % nig) % gsz); u.pn = (wgid % nig) / gsz;
        u.aoff = u.pm * sa; u.boff = u.pn * sb; u.orow = u.pm * BM; u.ocol = u.pn * BM; u.sub = 0; return true;
    }
};
struct MergeOrder : StaticOrder {
    __device__ bool next(int i, Unit& u) const { if (!StaticOrder::next(i >> 2, u)) return false; u.sub = i & 3; u.aoff += 1024L * u.sub; u.boff += 1024L * u.sub; return true; }
};
struct F2Order : StaticOrder {
    __device__ bool next(int i, Unit& u) const { if (!StaticOrder::next(i, u)) return false; u.orow = (u.pn >> 1) * 4096 + u.pm * BM; u.ocol = (u.pn & 1) * BM; return true; }
};
struct F1Order {
    int G, c;
    __device__ bool next(int i, Unit& u) const {
        const int idx = i * G + c; if (idx >= 256) return false;
        const int bg = idx >> 4, st = idx & 15, b = bg >> 2, g = bg & 3;
        u.pm = 0; u.pn = idx; u.aoff = 0; u.boff = ((long)(b * 4096 + st * 256) * PJW + g * 128) * 2; u.orow = bg * 128; u.ocol = st * 256; return true;
    }
};

__device__ __forceinline__ unsigned cvt_pk_bf16(float lo, float hi) { unsigned r; asm volatile("v_cvt_pk_bf16_f32 %0, %1, %2" : "=v"(r) : "v"(lo), "v"(hi)); return r; }
__device__ __forceinline__ float bf_lo(unsigned w) { return __uint_as_float(w << 16); }
__device__ __forceinline__ float bf_hi(unsigned w) { return __uint_as_float(w & 0xffff0000u); }

#define PG8_PACK(v0, v1, w) do { (w).x = cvt_pk_bf16((v0)[0], (v0)[1]); (w).y = cvt_pk_bf16((v0)[2], (v0)[3]); (w).z = cvt_pk_bf16((v1)[0], (v1)[1]); (w).w = cvt_pk_bf16((v1)[2], (v1)[3]); } while (0)

struct EpiStore {
    static constexpr bool PERM = true;
    bf16_t* O; int ldo;
    __device__ __forceinline__ bool operator()(f32x4 (&acc)[2][2][4][2], const Unit& u, int wr, int wc, int, int) const {
        const int l = opaque_tid(0), fr = l & 15, fq = l >> 4;
        const int row0 = u.orow + wr * 64 + fr, col0 = u.ocol + wc * 32 + 8 * fq;
#pragma unroll
        for (int ai = 0; ai < 2; ++ai)
#pragma unroll
            for (int m = 0; m < 4; ++m) { bf16_t* rowp = O + (size_t)(row0 + ai * HALF + m * 16) * ldo + col0;
#pragma unroll
                for (int bj = 0; bj < 2; ++bj) { u32x4 w; PG8_PACK(acc[ai][bj][m][0], acc[ai][bj][m][1], w); *(u32x4*)(rowp + bj * HALF) = w; } }
        return true;
    }
};
struct EpiF2 {
    static constexpr bool PERM = true;
    bf16_t* O;
    __device__ __forceinline__ bool operator()(f32x4 (&acc)[2][2][4][2], const Unit& u, int wr, int wc, int fr, int fq) const {
        const int b = u.pn >> 1, gcol0 = (u.pn & 1) * BM + wc * 32 + 8 * fq;
#pragma unroll
        for (int ai = 0; ai < 2; ++ai)
#pragma unroll
            for (int m = 0; m < 4; ++m) { const int sp = u.pm * BM + ai * HALF + wr * 64 + m * 16 + fr;
#pragma unroll
                for (int bj = 0; bj < 2; ++bj) { const int gcol = gcol0 + bj * HALF; u32x4 w; PG8_PACK(acc[ai][bj][m][0], acc[ai][bj][m][1], w);
                    if (sp <= 2048) *(u32x4*)(O + (size_t)(b * 4096 + sp) * DM + gcol) = w;
                    if (sp >= 1 && sp <= 2047) { bf16_t* mr = O + (size_t)(b * 4096 + 4096 - sp) * DM + (gcol & ~127); const int c0 = gcol & 127;
                        mr[(128 - c0) & 127] = (bf16_t)(w.x & 0xffffu); mr[127 - c0] = (bf16_t)(w.x >> 16); mr[126 - c0] = (bf16_t)(w.y & 0xffffu); mr[125 - c0] = (bf16_t)(w.y >> 16);
                        mr[124 - c0] = (bf16_t)(w.z & 0xffffu); mr[123 - c0] = (bf16_t)(w.z >> 16); mr[122 - c0] = (bf16_t)(w.w & 0xffffu); mr[121 - c0] = (bf16_t)(w.w >> 16); } } }
        return true;
    }
};
struct EpiZT {
    static constexpr bool PERM = true;
    bf16_t* O;
    __device__ __forceinline__ bool operator()(f32x4 (&acc)[2][2][4][2], const Unit& u, int wr, int wc, int fr, int fq) const {
        const int row0 = u.orow + wr * 64 + fr, col0 = u.ocol + wc * 32 + 8 * fq;
#pragma unroll
        for (int ai = 0; ai < 2; ++ai)
#pragma unroll
            for (int m = 0; m < 4; ++m) { bf16_t* rowp = O + (size_t)(row0 + m * 16) * 8192 + ai * 4096 + col0;
#pragma unroll
                for (int bj = 0; bj < 2; ++bj) { u32x4 w; PG8_PACK(acc[ai][bj][m][0], acc[ai][bj][m][1], w); *(u32x4*)(rowp + bj * HALF) = w; } }
        return true;
    }
};
struct EpiProj {
    static constexpr bool PERM = true;
    bf16_t* P; unsigned char* Gt; const float* bg; int split, off_lo, off_hi; float scale;
    __device__ __forceinline__ bool operator()(f32x4 (&acc)[2][2][4][2], const Unit& u, int wr, int wc, int fr, int fq) const {
        const int pnn = u.pn < split ? u.pn + off_lo : u.pn + off_hi; const bool isg = pnn >= 32;
        const int row0 = u.pm * BM + wr * 64 + fr, col0 = (isg ? pnn - 32 : pnn) * BM + wc * 32 + 8 * fq;
        f32x4 bv[2][2];
#pragma unroll
        for (int bj = 0; bj < 2; ++bj)
#pragma unroll
            for (int n = 0; n < 2; ++n) bv[bj][n] = isg ? *(const f32x4*)(bg + col0 + bj * HALF + 4 * n) : (f32x4){0.f, 0.f, 0.f, 0.f};
#pragma unroll
        for (int ai = 0; ai < 2; ++ai)
#pragma unroll
            for (int m = 0; m < 4; ++m) { const size_t r = (size_t)(row0 + ai * HALF + m * 16);
#pragma unroll
                for (int bj = 0; bj < 2; ++bj) { f32x4 v0 = acc[ai][bj][m][0] * scale + bv[bj][0], v1 = acc[ai][bj][m][1] * scale + bv[bj][1];
                    if (isg) { unsigned q0[4], q1[4];
#pragma unroll
                        for (int j = 0; j < 4; ++j) { const float g0 = __builtin_amdgcn_rcpf(1.0f + __builtin_amdgcn_exp2f(-1.4426950408889634f * v0[j])), g1 = __builtin_amdgcn_rcpf(1.0f + __builtin_amdgcn_exp2f(-1.4426950408889634f * v1[j]));
                            const int i0 = (int)(g0 * 256.f), i1 = (int)(g1 * 256.f); q0[j] = (unsigned)(i0 > 255 ? 255 : i0); q1[j] = (unsigned)(i1 > 255 ? 255 : i1); }
                        u32x2 w; w.x = q0[0] | (q0[1] << 8) | (q0[2] << 16) | (q0[3] << 24); w.y = q1[0] | (q1[1] << 8) | (q1[2] << 16) | (q1[3] << 24);
                        *(u32x2*)(Gt + r * GTW + col0 + bj * HALF) = w;
                    } else { u32x4 w; PG8_PACK(v0, v1, w); *(u32x4*)(P + r * PJW + col0 + bj * HALF) = w; } } }
        return true;
    }
};
struct EpiMerge4 {
    static constexpr bool PERM = true;
    const unsigned char* Gt; bf16_t* O;
#define MG_U(w, k) ((float)(((w) >> (8 * (k))) & 0xffu) + 0.5f)
    __device__ __forceinline__ bool operator()(f32x4 (&acc)[2][2][4][2], const Unit& u, int wr, int wc, int fr, int fq) const {
        const int row0 = u.pm * BM + wr * 64 + fr, col0 = u.pn * BM + wc * 32 + 8 * fq;
        if (u.sub == 2) return false;
        if (u.sub < 2) {
            const unsigned char* gp0 = Gt + (size_t)row0 * GTW + u.sub * DM + col0;
            u32x2 gn[2][2], gd[2][2];
#define MG_LD(st, sx) do { const unsigned char* gp_ = gp0 + (size_t)(((sx) >> 2) * HALF + ((sx) & 3) * 16) * GTW; gn[st][0] = *(const u32x2*)gp_; gd[st][0] = *(const u32x2*)(gp_ + DM); gn[st][1] = *(const u32x2*)(gp_ + HALF); gd[st][1] = *(const u32x2*)(gp_ + DM + HALF); } while (0)
            MG_LD(0, 0);
#pragma unroll
            for (int sx = 0; sx < 8; ++sx) { const int ai = sx >> 2, m = sx & 3, st = sx & 1;
                if (sx + 1 < 8) MG_LD((sx + 1) & 1, sx + 1);
                asm volatile("" ::: "memory");
#pragma unroll
                for (int bj = 0; bj < 2; ++bj) { const u32x2 n2 = gn[st][bj], d2 = gd[st][bj];
                    f32x4 r0, r1;
#pragma unroll
                    for (int k = 0; k < 4; ++k) { r0[k] = MG_U(n2.x, k) * __builtin_amdgcn_rcpf(MG_U(d2.x, k)); r1[k] = MG_U(n2.y, k) * __builtin_amdgcn_rcpf(MG_U(d2.y, k)); }
                    acc[ai][bj][m][0] *= r0; acc[ai][bj][m][1] *= r1; } }
#undef MG_LD
            return false;
        }
        {
            const unsigned char* gp0 = Gt + (size_t)row0 * GTW + 2 * DM + col0; bf16_t* op0 = O + (size_t)row0 * DM + col0;
            u32x2 gg[2][2];
#define MG_LD(st, sx) do { const unsigned char* gp_ = gp0 + (size_t)(((sx) >> 2) * HALF + ((sx) & 3) * 16) * GTW; gg[st][0] = *(const u32x2*)gp_; gg[st][1] = *(const u32x2*)(gp_ + HALF); } while (0)
            MG_LD(0, 0);
#pragma unroll
            for (int sx = 0; sx < 8; ++sx) { const int ai = sx >> 2, m = sx & 3, st = sx & 1;
                if (sx + 1 < 8) MG_LD((sx + 1) & 1, sx + 1);
                asm volatile("" ::: "memory");
                bf16_t* rowp = op0 + (size_t)(ai * HALF + m * 16) * DM;
#pragma unroll
                for (int bj = 0; bj < 2; ++bj) { const u32x2 g = gg[st][bj];
                    f32x4 v0 = acc[ai][bj][m][0], v1 = acc[ai][bj][m][1];
#pragma unroll
                    for (int k = 0; k < 4; ++k) { v0[k] *= MG_U(g.x, k) * (1.f / 256.f); v1[k] *= MG_U(g.y, k) * (1.f / 256.f); }
                    u32x4 w; PG8_PACK(v0, v1, w); *(u32x4*)(rowp + bj * HALF) = w; } }
#undef MG_LD
        }
        return true;
    }
#undef MG_U
};
struct EpiResF32 {
    static constexpr bool PERM = false;
    const float* base; float* out; int ldc;
    __device__ __forceinline__ bool operator()(f32x4 (&acc)[2][2][4][2], const Unit& u, int wr, int wc, int fr, int fq) const {
        const int row0 = u.orow + wr * 64 + fr, col0 = u.ocol + wc * 32 + 4 * fq;
        if (base) {
            f32x4 bb[2][4];
#define RS_LD(st, sx) do { const float* bp_ = base + (size_t)(row0 + ((sx) >> 2) * HALF + ((sx) & 3) * 16) * ldc + col0; bb[st][0] = *(const f32x4*)bp_; bb[st][1] = *(const f32x4*)(bp_ + 16); bb[st][2] = *(const f32x4*)(bp_ + HALF); bb[st][3] = *(const f32x4*)(bp_ + HALF + 16); } while (0)
            RS_LD(0, 0);
#pragma unroll
            for (int sx = 0; sx < 8; ++sx) { const int ai = sx >> 2, m = sx & 3, st = sx & 1;
                if (sx + 1 < 8) RS_LD((sx + 1) & 1, sx + 1);
                asm volatile("" ::: "memory");
                float* op = out + (size_t)(row0 + ai * HALF + m * 16) * ldc + col0;
#pragma unroll
                for (int bj = 0; bj < 2; ++bj)
#pragma unroll
                    for (int n = 0; n < 2; ++n) *(f32x4*)(op + bj * HALF + n * 16) = acc[ai][bj][m][n] + bb[st][bj * 2 + n]; }
#undef RS_LD
            return true;
        }
#pragma unroll
        for (int ai = 0; ai < 2; ++ai)
#pragma unroll
            for (int m = 0; m < 4; ++m) { const size_t off = (size_t)(row0 + ai * HALF + m * 16) * ldc + col0;
#pragma unroll
                for (int bj = 0; bj < 2; ++bj)
#pragma unroll
                    for (int n = 0; n < 2; ++n) *(f32x4*)(out + off + bj * HALF + n * 16) = acc[ai][bj][m][n];
                asm volatile("" ::: "memory"); }
        return true;
    }
};

constexpr float XS8 = 12.f;
__device__ __forceinline__ unsigned q8fix(const f32x4 v) {
    const int a = (int)__builtin_rintf(fminf(fmaxf(v[0] * XS8, -127.f), 127.f)), b = (int)__builtin_rintf(fminf(fmaxf(v[1] * XS8, -127.f), 127.f)),
              c = (int)__builtin_rintf(fminf(fmaxf(v[2] * XS8, -127.f), 127.f)), d = (int)__builtin_rintf(fminf(fmaxf(v[3] * XS8, -127.f), 127.f));
    return (unsigned)(a & 0xff) | ((unsigned)(b & 0xff) << 8) | ((unsigned)(c & 0xff) << 16) | ((unsigned)(d & 0xff) << 24);
}
__device__ __forceinline__ float fq_sum(float v) {
    v += __int_as_float(__builtin_amdgcn_ds_swizzle(__float_as_int(v), 0x1f | (16 << 10)));
    auto rr = __builtin_amdgcn_permlane32_swap(__float_as_uint(v), __float_as_uint(v), false, false); return __uint_as_float(rr[0]) + __uint_as_float(rr[1]);
}
struct EpiResX {
    static constexpr bool PERM = true;
    const float* base32; const bf16_t* base16; bf16_t* out; unsigned char* x8; float* ssp;
    __device__ __forceinline__ bool operator()(f32x4 (&acc)[2][2][4][2], const Unit& u, int wr, int wc, int fr, int fq) const {
        const int row0 = u.orow + wr * 64 + fr, col0 = u.ocol + wc * 32 + 8 * fq;
        bf16_t* op0 = out + (size_t)row0 * DM + col0; unsigned char* xp0 = x8 + (size_t)row0 * DM + col0;
        float ss[8];
        if (base32) {
            const float* bp0 = base32 + (size_t)row0 * DM + col0;
            f32x4 bb[2][4];
#define RX_LD(st, sx) do { const float* bp_ = bp0 + (size_t)(((sx) >> 2) * HALF + ((sx) & 3) * 16) * DM; bb[st][0] = *(const f32x4*)bp_; bb[st][1] = *(const f32x4*)(bp_ + 4); bb[st][2] = *(const f32x4*)(bp_ + HALF); bb[st][3] = *(const f32x4*)(bp_ + HALF + 4); } while (0)
            RX_LD(0, 0);
#pragma unroll
            for (int sx = 0; sx < 8; ++sx) { const int ai = sx >> 2, m = sx & 3, st = sx & 1;
                if (sx + 1 < 8) RX_LD((sx + 1) & 1, sx + 1);
                asm volatile("" ::: "memory");
                const size_t ro = (size_t)(ai * HALF + m * 16) * DM; float sq = 0.f;
#pragma unroll
                for (int bj = 0; bj < 2; ++bj) { const f32x4 v0 = acc[ai][bj][m][0] + bb[st][2 * bj], v1 = acc[ai][bj][m][1] + bb[st][2 * bj + 1];
                    sq += (v0[0] * v0[0] + v0[1] * v0[1]) + (v0[2] * v0[2] + v0[3] * v0[3]) + (v1[0] * v1[0] + v1[1] * v1[1]) + (v1[2] * v1[2] + v1[3] * v1[3]);
                    u32x4 w; PG8_PACK(v0, v1, w); *(u32x4*)(op0 + ro + bj * HALF) = w;
                    u32x2 w8; w8.x = q8fix(v0); w8.y = q8fix(v1); *(u32x2*)(xp0 + ro + bj * HALF) = w8; }
                ss[sx] = sq; }
#undef RX_LD
        } else {
            const bf16_t* bp0 = base16 + (size_t)row0 * DM + col0;
            u32x4 bb[2][2];
#define RX_LD(st, sx) do { const bf16_t* bp_ = bp0 + (size_t)(((sx) >> 2) * HALF + ((sx) & 3) * 16) * DM; bb[st][0] = *(const u32x4*)bp_; bb[st][1] = *(const u32x4*)(bp_ + HALF); } while (0)
            RX_LD(0, 0);
#pragma unroll
            for (int sx = 0; sx < 8; ++sx) { const int ai = sx >> 2, m = sx & 3, st = sx & 1;
                if (sx + 1 < 8) RX_LD((sx + 1) & 1, sx + 1);
                asm volatile("" ::: "memory");
                const size_t ro = (size_t)(ai * HALF + m * 16) * DM; float sq = 0.f;
#pragma unroll
                for (int bj = 0; bj < 2; ++bj) { const u32x4 b = bb[st][bj]; f32x4 v0 = acc[ai][bj][m][0], v1 = acc[ai][bj][m][1];
                    v0[0] += bf_lo(b.x); v0[1] += bf_hi(b.x); v0[2] += bf_lo(b.y); v0[3] += bf_hi(b.y); v1[0] += bf_lo(b.z); v1[1] += bf_hi(b.z); v1[2] += bf_lo(b.w); v1[3] += bf_hi(b.w);
                    sq += (v0[0] * v0[0] + v0[1] * v0[1]) + (v0[2] * v0[2] + v0[3] * v0[3]) + (v1[0] * v1[0] + v1[1] * v1[1]) + (v1[2] * v1[2] + v1[3] * v1[3]);
                    u32x4 w; PG8_PACK(v0, v1, w); *(u32x4*)(op0 + ro + bj * HALF) = w;
                    u32x2 w8; w8.x = q8fix(v0); w8.y = q8fix(v1); *(u32x2*)(xp0 + ro + bj * HALF) = w8; }
                ss[sx] = sq; }
#undef RX_LD
        }
#pragma unroll
        for (int sx = 0; sx < 8; ++sx) { const float t = fq_sum(ss[sx]); if (fq == 0) ssp[(size_t)(row0 + (sx >> 2) * HALF + (sx & 3) * 16) * 32 + u.pn * 4 + wc] = t; }
        return true;
    }
};
struct EpiStoreRS {
    static constexpr bool PERM = true;
    bf16_t* O; int ldo; const float* ssp;
    __device__ __forceinline__ bool operator()(f32x4 (&acc)[2][2][4][2], const Unit& u, int wr, int wc, int, int) const {
        const int l = opaque_tid(0), fr = l & 15, fq = l >> 4;
        const int row0 = u.orow + wr * 64 + fr, col0 = u.ocol + wc * 32 + 8 * fq;
#pragma unroll
        for (int ai = 0; ai < 2; ++ai)
#pragma unroll
            for (int m = 0; m < 4; ++m) { const int row = row0 + ai * HALF + m * 16;
                const f32x4 p0 = *(const f32x4*)(ssp + (size_t)row * 32 + fq * 8), p1 = *(const f32x4*)(ssp + (size_t)row * 32 + fq * 8 + 4);
                const float tot = fq_sum((p0[0] + p0[1]) + (p0[2] + p0[3]) + (p1[0] + p1[1]) + (p1[2] + p1[3]));
                const float rs = 1.0f / __builtin_sqrtf(tot * (1.f / DM) + RMS_EPS);
                bf16_t* rowp = O + (size_t)row * ldo + col0;
#pragma unroll
                for (int bj = 0; bj < 2; ++bj) { const f32x4 v0 = acc[ai][bj][m][0] * rs, v1 = acc[ai][bj][m][1] * rs; u32x4 w; PG8_PACK(v0, v1, w); *(u32x4*)(rowp + bj * HALF) = w; } }
        return true;
    }
};

template <class Epi, class Sched, bool ALIGN_EPI, int LDA, int LDB, int KK, bool F8 = false>
__device__ __forceinline__ void gemm_phase(PG8_LAS unsigned char* lds, const Gemm g, const Sched& S, const Epi& E, int wave0) {
    const int tid = opaque_tid(wave0), wid = wave0, lane = tid & 63, wr = wid >> 2, wc = wid & 3, fr = lane & 15, fq = lane >> 4;
    constexpr int nt = KK / BK;
    unsigned voffA[2], voffB[2];
#pragma unroll
    for (int i = 0; i < 2; ++i) { int R, C; stage_rc(tid * 16 + i * 8192, R, C); const int Rb = Epi::PERM ? ((R & ~31) + perm32(R & 31)) : R;
        voffA[i] = (unsigned)(R * LDA + C) * 2u; voffB[i] = (unsigned)(Rb * LDB + C) * 2u; }
    const size_t kstep = (size_t)(BK * 2);
    constexpr size_t hstepA = (size_t)HALF * LDA * 2, hstepB = (size_t)HALF * LDB * 2;
    const unsigned ldsw = (unsigned)wid * 1024u;
    const int aoff = lds_byte(wr * 64 + fr, fq * 8), boff = lds_byte(wc * 32 + fr, fq * 8);
#define PG8_SA(b, h) (((b) * 2 + (h)) * HTB)
#define PG8_SB(b, h) ((4 + (b) * 2 + (h)) * HTB)
#define PG8_STAGE(bufoff, gbase, voff) do { _Pragma("unroll") for (int _i = 0; _i < 2; ++_i) \
        __builtin_amdgcn_global_load_lds((const unsigned*)((const char*)(gbase) + (voff)[_i]), (PG8_LAS unsigned*)(lds + (bufoff) + ldsw + _i * 8192), 16, 0, 0); } while (0)
#define PG8_LDA(dst, b, h) do { _Pragma("unroll") for (int m = 0; m < 4; ++m) _Pragma("unroll") for (int k = 0; k < 2; ++k) dst[m][k] = *(const PG8_LAS bf16x8*)(lds + PG8_SA(b, h) + aoff + m * 2048 + k * 1024); } while (0)
#define PG8_LDB(dst, b, h) do { _Pragma("unroll") for (int n = 0; n < 2; ++n) _Pragma("unroll") for (int k = 0; k < 2; ++k) dst[n][k] = *(const PG8_LAS bf16x8*)(lds + PG8_SB(b, h) + boff + n * 2048 + k * 1024); } while (0)
#define PG8_CAT(x) __builtin_shufflevector(__builtin_bit_cast(i32x4, (x)[0]), __builtin_bit_cast(i32x4, (x)[1]), 0, 1, 2, 3, 4, 5, 6, 7)
#define PG8_MMA(ai, bj, At, Bt) do { __builtin_amdgcn_s_setprio(1); _Pragma("unroll") for (int m = 0; m < 4; ++m) _Pragma("unroll") for (int n = 0; n < 2; ++n) { \
        if constexpr (F8) { const i32x8 a8_ = PG8_CAT(Bt[n]), b8_ = PG8_CAT(At[m]); asm volatile("v_mfma_scale_f32_16x16x128_f8f6f4 %0, %1, %2, %0, %3, %3 op_sel_hi:[0,0,0]" : "+v"(acc[ai][bj][m][n]) : "v"(a8_), "v"(b8_), "v"(one8)); } \
        else { _Pragma("unroll") for (int k = 0; k < 2; ++k) acc[ai][bj][m][n] = __builtin_amdgcn_mfma_f32_16x16x32_bf16(Bt[n][k], At[m][k], acc[ai][bj][m][n], 0, 0, 0); } } __builtin_amdgcn_s_setprio(0); } while (0)
#define PG8_WAIT_V(n) asm volatile("s_waitcnt vmcnt(" #n ")" ::: "memory")
#define PG8_WAIT_L(n) asm volatile("s_waitcnt lgkmcnt(" #n ")" ::: "memory")
#define PG8_BAR __builtin_amdgcn_s_barrier()
#define PG8_SCHED __builtin_amdgcn_sched_barrier(0)
    Unit cur, nxt; int ui = 0;
    if (!S.next(0, cur)) return;
    const int one8 = 0x7f7f7f7f; (void)one8;
    f32x4 acc[2][2][4][2];
#pragma unroll
    for (int a = 0; a < 2; ++a)
#pragma unroll
        for (int b = 0; b < 2; ++b)
#pragma unroll
            for (int m = 0; m < 4; ++m)
#pragma unroll
                for (int n = 0; n < 2; ++n) acc[a][b][m][n] = (f32x4){0.f, 0.f, 0.f, 0.f};
    bf16x8 At[4][2], B0[2][2], B1[2][2];
    const char* cA = (const char*)g.A + cur.aoff; const char* cB = (const char*)g.Bt + cur.boff;
    PG8_STAGE(PG8_SB(0, 0), cB, voffB); PG8_STAGE(PG8_SB(0, 1), cB + hstepB, voffB); PG8_STAGE(PG8_SA(0, 0), cA, voffA); PG8_STAGE(PG8_SA(0, 1), cA + hstepA, voffA);
    if (wr == 1) PG8_BAR;
    PG8_WAIT_V(2); PG8_BAR;
    PG8_STAGE(PG8_SB(1, 0), cB + kstep, voffB); PG8_STAGE(PG8_SA(1, 0), cA + kstep, voffA); PG8_STAGE(PG8_SB(1, 1), cB + hstepB + kstep, voffB);
    PG8_WAIT_V(6); PG8_BAR;
    for (;;) {
        const bool has_next = S.next(ui + 1, nxt);
        const char* nA = has_next ? (const char*)g.A + nxt.aoff : cA; const char* nB = has_next ? (const char*)g.Bt + nxt.boff : cB;
        for (int t = 0; t < nt; t += 2) {
            const bool last = (t == nt - 2);
            const char* a1 = cA + (size_t)(t + 1) * kstep;
            const char* a2 = last ? nA : cA + (size_t)(t + 2) * kstep; const char* b2 = last ? nB : cB + (size_t)(t + 2) * kstep;
            const char* a3 = a2 + kstep; const char* b3 = b2 + kstep;
            PG8_LDB(B0, 0, 0); PG8_LDB(B1, 0, 1); PG8_SCHED; PG8_LDA(At, 0, 0); PG8_STAGE(PG8_SA(1, 1), a1 + hstepA, voffA);
            PG8_WAIT_V(8); PG8_WAIT_L(0); PG8_BAR; PG8_MMA(0, 0, At, B0); PG8_MMA(0, 1, At, B1); PG8_BAR; PG8_SCHED;
            PG8_LDA(At, 0, 1); PG8_STAGE(PG8_SB(0, 0), b2, voffB); PG8_STAGE(PG8_SB(0, 1), b2 + hstepB, voffB); PG8_STAGE(PG8_SA(0, 0), a2, voffA);
            PG8_WAIT_V(8); PG8_WAIT_L(0); PG8_BAR; PG8_MMA(1, 0, At, B0); PG8_MMA(1, 1, At, B1); PG8_BAR; PG8_SCHED;
            PG8_LDB(B0, 1, 0); PG8_LDB(B1, 1, 1); PG8_SCHED; PG8_LDA(At, 1, 0); PG8_STAGE(PG8_SA(0, 1), a2 + hstepA, voffA);
            PG8_WAIT_V(8); PG8_WAIT_L(0); PG8_BAR; PG8_MMA(0, 0, At, B0); PG8_MMA(0, 1, At, B1); PG8_BAR; PG8_SCHED;
            PG8_LDA(At, 1, 1); PG8_STAGE(PG8_SB(1, 0), b3, voffB); PG8_STAGE(PG8_SB(1, 1), b3 + hstepB, voffB); PG8_STAGE(PG8_SA(1, 0), a3, voffA);
            PG8_WAIT_V(8); PG8_WAIT_L(0); PG8_BAR; PG8_MMA(1, 0, At, B0); PG8_MMA(1, 1, At, B1); PG8_BAR; PG8_SCHED;
        }
        if constexpr (ALIGN_EPI) { if (wr == 0) PG8_BAR; }
        if constexpr (F8) asm volatile("s_nop 15\n\ts_nop 15" ::: "memory");
        const bool fin = E(acc, cur, wr, wc, fr, fq);
        if (!has_next) break;
        if (fin) {
#pragma unroll
        for (int a = 0; a < 2; ++a)
#pragma unroll
            for (int b = 0; b < 2; ++b)
#pragma unroll
                for (int m = 0; m < 4; ++m)
#pragma unroll
                    for (int n = 0; n < 2; ++n) acc[a][b][m][n] = (f32x4){0.f, 0.f, 0.f, 0.f};
        }
        cur = nxt; cA = nA; cB = nB; ++ui;
        if constexpr (ALIGN_EPI) { if (wr == 1) PG8_BAR; }
    }
    PG8_WAIT_V(0);
    if constexpr (!ALIGN_EPI) { if (wr == 0) PG8_BAR; }
    PG8_BAR;
#undef PG8_SA
#undef PG8_SB
#undef PG8_STAGE
#undef PG8_LDA
#undef PG8_LDB
#undef PG8_MMA
#undef PG8_CAT
#undef PG8_WAIT_V
#undef PG8_WAIT_L
#undef PG8_BAR
#undef PG8_SCHED
}
}

namespace attn {
using bf16x8 = __attribute__((ext_vector_type(8))) short;
using s16x4  = __attribute__((ext_vector_type(4))) short;
using f32x16 = __attribute__((ext_vector_type(16))) float;
using u32x4  = __attribute__((ext_vector_type(4))) unsigned;
constexpr int   D = 128, NW = 8, QBLK = 32, KVBLK = 64;
constexpr float SCALE = 0.088388347648318440f;
constexpr float THR = 8.f;
constexpr size_t SHM_V = KVBLK * D * 2, SHM_K = KVBLK * D * 2;
constexpr int NBUF = 3;
constexpr int LDS_K0 = NBUF * (int)SHM_V, LDS_TAB = LDS_K0 + NBUF * (int)SHM_K, LDS_END = LDS_TAB + 8192 * 4, LDS_WS = 131072 + 8192;
#define KSWZ(row, colB) ((row) * 256 + ((colB) ^ (((row) & 7) << 4)))
#define SBAR() __builtin_amdgcn_sched_barrier(0)
__device__ __forceinline__ int crow(int r, int hi) { return (r & 3) + 8 * (r >> 2) + 4 * hi; }
__device__ __forceinline__ unsigned cvtpk(float lo, float hi) { unsigned r; asm volatile("v_cvt_pk_bf16_f32 %0, %1, %2" : "=v"(r) : "v"(lo), "v"(hi)); return r; }

__device__ __forceinline__ void partialSM(f32x16& p0, f32x16& p1, float& m_reg, float& mn, float& alpha) {
  constexpr float C = SCALE * 1.4426950408889634f;
  float pmax = p0[0]; for (int r = 1; r < 16; ++r) pmax = fmaxf(pmax, p0[r]); for (int r = 0; r < 16; ++r) pmax = fmaxf(pmax, p1[r]);
  { auto rr = __builtin_amdgcn_permlane32_swap(__float_as_uint(pmax), __float_as_uint(pmax), false, false);
    pmax = fmaxf(__uint_as_float(rr[0]), __uint_as_float(rr[1])); }
  if (__builtin_expect(__all(pmax - m_reg <= THR / SCALE), 1)) { mn = m_reg; alpha = 1.f; }
  else { mn = fmaxf(m_reg, pmax); alpha = __builtin_amdgcn_exp2f((m_reg - mn) * C); m_reg = mn; }
  float mnC = -mn * C;
  for (int r = 0; r < 16; ++r) p0[r] = fmaf(p0[r], C, mnC); for (int r = 0; r < 16; ++r) p1[r] = fmaf(p1[r], C, mnC);
  for (int r = 0; r < 16; ++r) p0[r] = __builtin_amdgcn_exp2f(p0[r]);
}
__device__ __forceinline__ void finishSM(f32x16& p0, f32x16& p1, float alpha, float& l_reg, bf16x8& pa0, bf16x8& pa1, bf16x8& pa2, bf16x8& pa3) {
  for (int r = 0; r < 16; ++r) p1[r] = __builtin_amdgcn_exp2f(p1[r]);
  float ps = 0; for (int r = 0; r < 16; ++r) ps += p0[r]; for (int r = 0; r < 16; ++r) ps += p1[r];
  { auto rr = __builtin_amdgcn_permlane32_swap(__float_as_uint(ps), __float_as_uint(ps), false, false);
    ps = __uint_as_float(rr[0]) + __uint_as_float(rr[1]); }
  l_reg = l_reg * alpha + ps;
#define PK4(P, BASE, OUT) do { unsigned a0 = cvtpk(P[BASE + 0], P[BASE + 1]), a1 = cvtpk(P[BASE + 2], P[BASE + 3]);   \
    unsigned b0 = cvtpk(P[BASE + 4], P[BASE + 5]), b1 = cvtpk(P[BASE + 6], P[BASE + 7]);                              \
    auto r0 = __builtin_amdgcn_permlane32_swap(a0, b0, false, false); auto r1 = __builtin_amdgcn_permlane32_swap(a1, b1, false, false); \
    u32x4 w = {r0[0], r1[0], r0[1], r1[1]}; OUT = *reinterpret_cast<bf16x8*>(&w); } while (0)
  PK4(p0, 0, pa0); PK4(p0, 8, pa1); PK4(p1, 0, pa2); PK4(p1, 8, pa3);
#undef PK4
}
__device__ __forceinline__ void qkt(f32x16& p0, f32x16& p1, const bf16* Ks, const bf16x8* qr, int r32, int hi, const float* tl) {
#pragma unroll
  for (int r = 0; r < 16; ++r) { p0[r] = tl[(r & 3) + 8 * (r >> 2)]; p1[r] = tl[32 + (r & 3) + 8 * (r >> 2)]; }
#pragma unroll
  for (int d0 = 0; d0 < 8; ++d0) { int cb = (d0 * 16 + hi * 8) * 2;
    bf16x8 b0 = *reinterpret_cast<const bf16x8*>((const char*)Ks + KSWZ(r32, cb));
    bf16x8 b1 = *reinterpret_cast<const bf16x8*>((const char*)Ks + KSWZ(32 + r32, cb));
    p0 = __builtin_amdgcn_mfma_f32_32x32x16_bf16(b0, qr[d0], p0, 0, 0, 0);
    p1 = __builtin_amdgcn_mfma_f32_32x32x16_bf16(b1, qr[d0], p1, 0, 0, 0); }
}
__device__ __forceinline__ int v_st(int k, int c) { const int kk = (k & ~0xC) | ((k & 4) << 1) | ((k & 8) >> 1); return ((kk >> 3) * 4 + (c >> 5)) * 512 + ((kk & 7) * 32 + (c & 31)) * 2; }
__device__ __forceinline__ int v_rd_base(int lane) { return ((lane & 3) << 3) | (((lane >> 2) & 3) << 6) | (((lane >> 4) & 1) << 5) | (((lane >> 5) & 1) << 8); }
constexpr int v_rd_off(int d0, int ks, int half) { return d0 * 512 + ks * 4096 + half * 2048; }
template <int OFF> __device__ __forceinline__ s16x4 tr_read(int vb) {
  s16x4 r; asm volatile("ds_read_b64_tr_b16 %0, %1 offset:%2" : "=&v"(r) : "v"(vb), "i"(OFF) : "memory"); return r;
}
template <int D0> __device__ __forceinline__ void pv_one(f32x16& od, int vb, bf16x8 pa0, bf16x8 pa1, bf16x8 pa2, bf16x8 pa3) {
  const s16x4 l0 = tr_read<v_rd_off(D0, 0, 0)>(vb), h0 = tr_read<v_rd_off(D0, 0, 1)>(vb), l1 = tr_read<v_rd_off(D0, 1, 0)>(vb), h1 = tr_read<v_rd_off(D0, 1, 1)>(vb);
  const s16x4 l2 = tr_read<v_rd_off(D0, 2, 0)>(vb), h2 = tr_read<v_rd_off(D0, 2, 1)>(vb), l3 = tr_read<v_rd_off(D0, 3, 0)>(vb), h3 = tr_read<v_rd_off(D0, 3, 1)>(vb);
  asm volatile("s_waitcnt lgkmcnt(0)" ::: "memory"); SBAR();
#define PK(L, H) (bf16x8){L[0], L[1], L[2], L[3], H[0], H[1], H[2], H[3]}
  od = __builtin_amdgcn_mfma_f32_32x32x16_bf16(pa0, PK(l0, h0), od, 0, 0, 0);
  od = __builtin_amdgcn_mfma_f32_32x32x16_bf16(pa1, PK(l1, h1), od, 0, 0, 0);
  od = __builtin_amdgcn_mfma_f32_32x32x16_bf16(pa2, PK(l2, h2), od, 0, 0, 0);
  od = __builtin_amdgcn_mfma_f32_32x32x16_bf16(pa3, PK(l3, h3), od, 0, 0, 0);
#undef PK
}
__device__ __forceinline__ void pv_d0(f32x16* o, int vb, bf16x8 pa0, bf16x8 pa1, bf16x8 pa2, bf16x8 pa3) {
  pv_one<0>(o[0], vb, pa0, pa1, pa2, pa3); pv_one<1>(o[1], vb, pa0, pa1, pa2, pa3); pv_one<2>(o[2], vb, pa0, pa1, pa2, pa3); pv_one<3>(o[3], vb, pa0, pa1, pa2, pa3);
}

struct VFrag { s16x4 l0, h0, l1, h1, l2, h2, l3, h3; };
template <int D0> __device__ __forceinline__ void v_issue(VFrag& f, int vb) {
  f.l0 = tr_read<v_rd_off(D0, 0, 0)>(vb); f.h0 = tr_read<v_rd_off(D0, 0, 1)>(vb); f.l1 = tr_read<v_rd_off(D0, 1, 0)>(vb); f.h1 = tr_read<v_rd_off(D0, 1, 1)>(vb);
  f.l2 = tr_read<v_rd_off(D0, 2, 0)>(vb); f.h2 = tr_read<v_rd_off(D0, 2, 1)>(vb); f.l3 = tr_read<v_rd_off(D0, 3, 0)>(vb); f.h3 = tr_read<v_rd_off(D0, 3, 1)>(vb);
}
__device__ __forceinline__ void v_mma(f32x16& od, const VFrag& f, bf16x8 pa0, bf16x8 pa1, bf16x8 pa2, bf16x8 pa3) {
#define PK(L, H) (bf16x8){L[0], L[1], L[2], L[3], H[0], H[1], H[2], H[3]}
  od = __builtin_amdgcn_mfma_f32_32x32x16_bf16(pa0, PK(f.l0, f.h0), od, 0, 0, 0);
  od = __builtin_amdgcn_mfma_f32_32x32x16_bf16(pa1, PK(f.l1, f.h1), od, 0, 0, 0);
  od = __builtin_amdgcn_mfma_f32_32x32x16_bf16(pa2, PK(f.l2, f.h2), od, 0, 0, 0);
  od = __builtin_amdgcn_mfma_f32_32x32x16_bf16(pa3, PK(f.l3, f.h3), od, 0, 0, 0);
#undef PK
}
__device__ __forceinline__ void pv_sm(f32x16* o, int vb, bf16x8 pa0, bf16x8 pa1, bf16x8 pa2, bf16x8 pa3, f32x16& p0, f32x16& p1, float& m_reg, float& mn, float& alpha) {
  constexpr float C = SCALE * 1.4426950408889634f;
  VFrag fa, fb;
  v_issue<0>(fa, vb); v_issue<1>(fb, vb);
  asm volatile("s_waitcnt lgkmcnt(8)" ::: "memory"); SBAR();
  v_mma(o[0], fa, pa0, pa1, pa2, pa3);
  float pmax = p0[0];
#pragma unroll
  for (int r = 1; r < 16; ++r) pmax = fmaxf(pmax, p0[r]);
#pragma unroll
  for (int r = 0; r < 16; ++r) pmax = fmaxf(pmax, p1[r]);
  v_issue<2>(fa, vb);
  asm volatile("s_waitcnt lgkmcnt(8)" ::: "memory"); SBAR();
  v_mma(o[1], fb, pa0, pa1, pa2, pa3);
  { auto rr = __builtin_amdgcn_permlane32_swap(__float_as_uint(pmax), __float_as_uint(pmax), false, false);
    pmax = fmaxf(__uint_as_float(rr[0]), __uint_as_float(rr[1])); }
  if (__builtin_expect(__all(pmax - m_reg <= THR / SCALE), 1)) { mn = m_reg; alpha = 1.f; }
  else { mn = fmaxf(m_reg, pmax); alpha = __builtin_amdgcn_exp2f((m_reg - mn) * C); m_reg = mn; }
  const float mnC = -mn * C;
#define PIN(x) do { float t_ = (x); asm volatile("" : "+v"(t_)); (x) = t_; } while (0)
#pragma unroll
  for (int r = 0; r < 16; ++r) { p0[r] = fmaf(p0[r], C, mnC); PIN(p0[r]); }
  v_issue<3>(fb, vb);
  asm volatile("s_waitcnt lgkmcnt(8)" ::: "memory"); SBAR();
  v_mma(o[2], fa, pa0, pa1, pa2, pa3);
#pragma unroll
  for (int r = 0; r < 16; ++r) { p1[r] = fmaf(p1[r], C, mnC); PIN(p1[r]); }
#pragma unroll
  for (int r = 0; r < 8; ++r) { p0[r] = __builtin_amdgcn_exp2f(p0[r]); PIN(p0[r]); }
  asm volatile("s_waitcnt lgkmcnt(0)" ::: "memory"); SBAR();
  v_mma(o[3], fb, pa0, pa1, pa2, pa3);
#pragma unroll
  for (int r = 8; r < 16; ++r) p0[r] = __builtin_amdgcn_exp2f(p0[r]);
#undef PIN
}

struct Unit { const bf16* Q; const bf16* K; const bf16* V; bf16* O; float* lse; long ldq, ldk, ldo; int lse_ld, kt0, nt, qoff; };
__device__ __forceinline__ void attn_unit(const Unit& u, char* lds, int wave0) {
  const int tid = opaque_tid(wave0), wid = wave0, lane = tid & 63, r32 = lane & 31, hi = lane >> 5;
  LAS unsigned char* ldsl = (LAS unsigned char*)lds;
  float* ws = (float*)(lds + LDS_WS) + wid * 64; float* li_l = ws; float* al_l = ws + 32;
  const float* tabL = (const float*)(lds + LDS_TAB);
  float m_reg = -1e30f, l_reg = 0; f32x16 o[4] = {}; bf16x8 qr[8];
  const bf16* Qw = u.Q + (long)(wid * QBLK + r32) * u.ldq + hi * 8;
#pragma unroll
  for (int d0 = 0; d0 < 8; ++d0) qr[d0] = *reinterpret_cast<const bf16x8*>(Qw + d0 * 16);
  const int vrd = (int)(uintptr_t)lds + v_rd_base(lane);
  const long tstep = (long)KVBLK * u.ldk * 2;
  const char* Kh = (const char*)u.K + (long)u.kt0 * tstep; const char* Vh = (const char*)u.V + (long)u.kt0 * tstep;
  unsigned kofs[2], vofs[2];
#pragma unroll
  for (int i = 0; i < 2; ++i) { const int rowk = (wid + 8 * i) * 4 + (lane >> 4), chunk = (lane & 15) ^ (rowk & 7); kofs[i] = (unsigned)(rowk * (int)u.ldk * 2 + chunk * 16);
    const int blk = (wid + 8 * i) * 2 + (lane >> 5), kk = (blk >> 2) * 8 + ((lane & 31) >> 2), c = (blk & 3) * 32 + (lane & 3) * 8, k = (kk & ~0xC) | ((kk & 4) << 1) | ((kk & 8) >> 1);
    vofs[i] = (unsigned)((k * (int)u.ldk + c) * 2); }
  const float* tl0 = tabL + (4096 + u.kt0 * KVBLK + 4 * hi - (u.qoff + wid * QBLK + r32));
#define DMA(tj, b) do { const char* kt_ = Kh + (long)(tj) * tstep; const char* vt_ = Vh + (long)(tj) * tstep; _Pragma("unroll") for (int i_ = 0; i_ < 2; ++i_) { \
    __builtin_amdgcn_global_load_lds((const unsigned*)(kt_ + kofs[i_]), (LAS unsigned*)(ldsl + LDS_K0 + (b) * (int)SHM_K + (wid + 8 * i_) * 1024), 16, 0, 0); \
    __builtin_amdgcn_global_load_lds((const unsigned*)(vt_ + vofs[i_]), (LAS unsigned*)(ldsl + (b) * (int)SHM_V + (wid + 8 * i_) * 1024), 16, 0, 0); } } while (0)
#define KBUF(b) ((const bf16*)(lds + LDS_K0 + (b) * (int)SHM_K))
#define VBUF(b) (vrd + (b) * (int)SHM_V)
#define LANDED() do { asm volatile("s_waitcnt vmcnt(0)" ::: "memory"); __syncthreads(); } while (0)
#define RESC(a) do { if (__any((a) < 1.f)) { if (hi == 0) al_l[r32] = (a); asm volatile("s_waitcnt lgkmcnt(0)" ::: "memory"); \
    for (int d = 0; d < 4; ++d) for (int r = 0; r < 16; ++r) o[d][r] *= al_l[crow(r, hi)]; } } while (0)
  f32x16 pA0, pA1, pB0, pB1; float mnA, mnB, alA, alB; bf16x8 pa0, pa1, pa2, pa3; const int NT = u.nt;
  DMA(0, 0); DMA(1, 1);
  LANDED();
  qkt(pA0, pA1, KBUF(0), qr, r32, hi, tl0); partialSM(pA0, pA1, m_reg, mnA, alA);
  if (2 < NT) DMA(2, 2);
  int bp = 0, bc = 1, bn = 2;
  for (int t = 1; t + 1 < NT; t += 2) {
    SBAR(); qkt(pB0, pB1, KBUF(bc), qr, r32, hi, tl0 + t * KVBLK);
    finishSM(pA0, pA1, alA, l_reg, pa0, pa1, pa2, pa3); SBAR();
    pv_sm(o, VBUF(bp), pa0, pa1, pa2, pa3, pB0, pB1, m_reg, mnB, alB);
    RESC(alB);
    LANDED();
    { const int nb = bp; bp = bc; bc = bn; bn = nb; if (t + 2 < NT) DMA(t + 2, bn); }
    SBAR(); qkt(pA0, pA1, KBUF(bc), qr, r32, hi, tl0 + (t + 1) * KVBLK);
    finishSM(pB0, pB1, alB, l_reg, pa0, pa1, pa2, pa3); SBAR();
    pv_sm(o, VBUF(bp), pa0, pa1, pa2, pa3, pA0, pA1, m_reg, mnA, alA);
    RESC(alA);
    LANDED();
    { const int nb = bp; bp = bc; bc = bn; bn = nb; if (t + 3 < NT) DMA(t + 3, bn); }
  }
  SBAR(); qkt(pB0, pB1, KBUF(bc), qr, r32, hi, tl0 + (NT - 1) * KVBLK);
  finishSM(pA0, pA1, alA, l_reg, pa0, pa1, pa2, pa3); SBAR();
  pv_sm(o, VBUF(bp), pa0, pa1, pa2, pa3, pB0, pB1, m_reg, mnB, alB);
  RESC(alB);
  finishSM(pB0, pB1, alB, l_reg, pa0, pa1, pa2, pa3); SBAR();
  pv_d0(o, VBUF(bc), pa0, pa1, pa2, pa3);
  if (hi == 0) li_l[r32] = l_reg; asm volatile("s_waitcnt lgkmcnt(0)" ::: "memory");
  float rli[16];
#pragma unroll
  for (int r = 0; r < 16; ++r) rli[r] = __builtin_amdgcn_rcpf(li_l[crow(r, hi)]);
  bf16* Ow = u.O + (long)(wid * QBLK) * u.ldo;
#pragma unroll
  for (int r = 0; r < 16; ++r) { int orow = crow(r, hi);
#pragma unroll
    for (int d0 = 0; d0 < 4; ++d0) { const float v = o[d0][r] * rli[r]; Ow[(long)orow * u.ldo + d0 * 32 + r32] = (bf16)(cvtpk(v, v) & 0xffffu); } }
  if (u.lse != nullptr && hi == 0) u.lse[(long)(wid * QBLK + r32) * u.lse_ld] = m_reg * SCALE + __logf(l_reg);
#undef DMA
#undef KBUF
#undef VBUF
#undef LANDED
#undef RESC
}
#undef KSWZ
#undef SBAR
}

constexpr int NWAVES = 8;
constexpr size_t MiB = 1u << 20;
constexpr size_t WS_CTL = 0, CTL_ZERO_BYTES = 1 * MiB;
constexpr size_t WS_CS   = 1 * MiB;
constexpr size_t WS_SKBD = 1 * MiB + 256 * 1024;
constexpr size_t WS_TAB  = 2 * MiB;
constexpr size_t WS_LSE  = 3 * MiB;
constexpr size_t WS_SU   = 3 * MiB + 768 * 1024;
constexpr size_t WS_SH   = 3 * MiB + 832 * 1024;
constexpr size_t WS_WCAT = 4 * MiB, WS_WO = 12 * MiB, WS_WQ = 20 * MiB;
constexpr size_t WS_WIN  = 28 * MiB;
constexpr size_t WS_WG8  = WS_WIN + 16 * MiB;
constexpr size_t WS_DFT  = 84 * MiB;
constexpr size_t WS_U    = 148 * MiB, WS_V = 180 * MiB;
constexpr size_t WS_H8   = 212 * MiB;
constexpr size_t WS_H    = 276 * MiB;
constexpr size_t WS_PROJ = 340 * MiB;
constexpr size_t WS_G    = 596 * MiB;
constexpr size_t WS_ZT   = 788 * MiB;
constexpr size_t WS_OC   = 820 * MiB;
constexpr size_t WS_MG   = 884 * MiB;
constexpr size_t WS_SSP  = 276 * MiB;
constexpr size_t WS_X16  = 948 * MiB;
constexpr size_t WS_END  = 1012 * MiB;
#if DBG_MODE == 2
constexpr size_t WS_ACT = WS_PROJ + 208 * MiB;
#else
constexpr size_t WS_ACT = WS_PROJ + 200 * MiB;
#endif
constexpr size_t WS_Q = WS_PROJ, WS_SC = WS_PROJ + 64 * MiB, WS_IDS = WS_PROJ + 192 * MiB, WS_GATES = WS_PROJ + 200 * MiB;
constexpr int CW_BAR = 4096;
constexpr int CW_XRANK = 12288;
constexpr int CW_QUEUE = 16384;
constexpr int RING_BYTES = 131072, LDSCTL_OFF = RING_BYTES, MISC_OFF = LDSCTL_OFF + 320, LDS_BYTES = 147456;

#define LDS_WAIT() asm volatile("s_waitcnt lgkmcnt(0)" ::: "memory")
#define VM_WAIT() asm volatile("s_waitcnt vmcnt(0)" ::: "memory")
__device__ __forceinline__ unsigned f2bf(float f) { unsigned u = __builtin_bit_cast(unsigned, f); return (u + 0x7fffu + ((u >> 16) & 1u)) >> 16; }
__device__ __forceinline__ unsigned pk2(float lo, float hi) { return f2bf(lo) | (f2bf(hi) << 16); }
__device__ __forceinline__ float bflo(unsigned w) { return __uint_as_float(w << 16); }
__device__ __forceinline__ float bfhi(unsigned w) { return __uint_as_float(w & 0xffff0000u); }

#define XB_TMO      128
#define XB_XCNT(j)  (256  + 64 * (j))
#define XB_XSUB(j)  (1280 + 64 * (j))
#define XB_XGEN(j)  (2304 + 64 * (j))
#define XB_TOP      3328
#define XB_TOPGEN   3392
#define XCD_BAR_WORDS 3456
#define XB_SPIN_CAP (1u << 20)
__device__ __forceinline__ unsigned xb_ld(unsigned* p)              { return __hip_atomic_load(p, __ATOMIC_RELAXED, __HIP_MEMORY_SCOPE_AGENT); }
__device__ __forceinline__ unsigned xb_add(unsigned* p, unsigned v) { return __hip_atomic_fetch_add(p, v, __ATOMIC_RELAXED, __HIP_MEMORY_SCOPE_AGENT); }
__device__ __forceinline__ unsigned xb_xcc_id() { return (unsigned)__builtin_amdgcn_s_getreg((3 << 11) | 20) & 0xFu; }
#define XB_SPIN(cond, bar) do { unsigned _sp = 0; while (cond) { __builtin_amdgcn_s_sleep(1); \
    if ((++_sp & 255u) == 0u) { if (xb_ld(&(bar)[XB_TMO])) break; if (_sp > XB_SPIN_CAP) { atomicAdd(&(bar)[XB_TMO], 1u); break; } } } } while (0)
struct XcdBarrier { unsigned* bar; unsigned x; volatile LAS unsigned* st; };
__device__ __forceinline__ XcdBarrier xcd_barrier_post(unsigned* bar, volatile LAS unsigned* st) {
    XcdBarrier b; b.bar = bar; b.x = xb_xcc_id(); b.st = st;
    if (threadIdx.x == 0) (void)xb_add(&bar[XB_XCNT(b.x)], 1u);
    return b;
}
__device__ __forceinline__ void xcd_barrier_complete(unsigned* bar, unsigned x, unsigned& nloc, unsigned& nx) {
    const unsigned G = gridDim.x * gridDim.y * gridDim.z;
    unsigned sum, cnt, mine, sp = 0u;
    for (;;) {
        sum = 0u; cnt = 0u; mine = 0u;
#pragma unroll
        for (unsigned j = 0; j < 16; ++j) { const unsigned c = xb_ld(&bar[XB_XCNT(j)]); sum += c; cnt += (c > 0u) ? 1u : 0u; mine = (j == x) ? c : mine; }
        if (sum == G) break;
        __builtin_amdgcn_s_sleep(1);
        if ((++sp & 255u) == 0u) { if (xb_ld(&bar[XB_TMO])) break; if (sp > XB_SPIN_CAP) { atomicAdd(&bar[XB_TMO], 1u); break; } }
    }
    nloc = mine > 0u ? mine : 1u; nx = cnt > 0u ? cnt : 1u;
}
__device__ __forceinline__ void xcd_barrier(const XcdBarrier& b) {
    asm volatile("s_waitcnt vmcnt(0)" ::: "memory");
    __syncthreads();
    if (threadIdx.x == 0) {
        unsigned* bar = b.bar;
        __builtin_amdgcn_s_waitcnt(0);
        unsigned nloc = b.st[0], nx = b.st[1];
        if (nloc == 0u) { xcd_barrier_complete(bar, b.x, nloc, nx); b.st[0] = nloc; b.st[1] = nx; }
        const unsigned old = xb_add(&bar[XB_XSUB(b.x)], 1u);
        const unsigned gen = old / nloc;
        if (old + 1u == (gen + 1u) * nloc) {
            __builtin_amdgcn_fence(__ATOMIC_RELEASE, "agent");
            asm volatile("s_waitcnt vmcnt(0)" ::: "memory");
            const unsigned og = xb_add(&bar[XB_TOP], 1u);
            const unsigned tg = og / nx;
            if (og + 1u == (tg + 1u) * nx) xb_add(&bar[XB_TOPGEN], 1u);
            else XB_SPIN(xb_ld(&bar[XB_TOPGEN]) == tg, bar);
            __builtin_amdgcn_fence(__ATOMIC_ACQUIRE, "agent");
            xb_add(&bar[XB_XGEN(b.x)], 1u);
            asm volatile("s_waitcnt vmcnt(0)" ::: "memory");
        } else {
            XB_SPIN(xb_ld(&bar[XB_XGEN(b.x)]) == gen, bar);
            __builtin_amdgcn_fence(__ATOMIC_ACQUIRE, "agent");
            asm volatile("s_waitcnt vmcnt(0)" ::: "memory");
        }
    }
    __syncthreads();
}

template <int MASK> __device__ __forceinline__ int sx_i(int v) { return __builtin_amdgcn_ds_swizzle(v, 0x1f | (MASK << 10)); }
template <int MASK> __device__ __forceinline__ float sx_f(float v) { return __int_as_float(sx_i<MASK>(__float_as_int(v))); }
__device__ __forceinline__ float add32(float v) { auto rr = __builtin_amdgcn_permlane32_swap(__float_as_uint(v), __float_as_uint(v), false, false); return __uint_as_float(rr[0]) + __uint_as_float(rr[1]); }
__device__ __forceinline__ unsigned max32(unsigned v) { auto rr = __builtin_amdgcn_permlane32_swap(v, v, false, false); return rr[0] > rr[1] ? rr[0] : rr[1]; }
__device__ __forceinline__ float other32(float v, bool upper) { auto rr = __builtin_amdgcn_permlane32_swap(__float_as_uint(v), __float_as_uint(v), false, false); return __uint_as_float(upper ? rr[0] : rr[1]); }
__device__ __forceinline__ float bperm_f(float v, int src_lane) { return __int_as_float(__builtin_amdgcn_ds_bpermute(src_lane * 4, __float_as_int(v))); }
__device__ __forceinline__ int bperm_i(int v, int src_lane) { return __builtin_amdgcn_ds_bpermute(src_lane * 4, v); }
__device__ __forceinline__ float wave_sum(float v) {
    v += sx_f<1>(v); v += sx_f<2>(v); v += sx_f<4>(v); v += sx_f<8>(v); v += sx_f<16>(v); return add32(v);
}
__device__ __forceinline__ unsigned umax(unsigned a, unsigned b) { return a > b ? a : b; }
__device__ __forceinline__ unsigned wave_max_u32(unsigned v) {
    v = umax(v, (unsigned)sx_i<1>((int)v)); v = umax(v, (unsigned)sx_i<2>((int)v)); v = umax(v, (unsigned)sx_i<4>((int)v)); v = umax(v, (unsigned)sx_i<8>((int)v)); v = umax(v, (unsigned)sx_i<16>((int)v)); return max32(v);
}
template <int CTRL, int RMASK> __device__ __forceinline__ unsigned dpp_max_u(unsigned v) { const unsigned t = (unsigned)__builtin_amdgcn_update_dpp((int)v, (int)v, CTRL, RMASK, 0xF, false); return t > v ? t : v; }
__device__ __forceinline__ unsigned wave_max_dpp(unsigned v) {
    v = dpp_max_u<0xB1, 0xF>(v); v = dpp_max_u<0x4E, 0xF>(v); v = dpp_max_u<0x141, 0xF>(v); v = dpp_max_u<0x140, 0xF>(v); v = dpp_max_u<0x142, 0xA>(v); v = dpp_max_u<0x143, 0xC>(v);
    return (unsigned)__builtin_amdgcn_readlane((int)v, 63);
}
template <int CTRL> __device__ __forceinline__ float dpp_add_f(float v) { return v + __int_as_float(__builtin_amdgcn_update_dpp(__float_as_int(v), __float_as_int(v), CTRL, 0xF, 0xF, false)); }
__device__ __forceinline__ float row_sum16(float v) { v = dpp_add_f<0xB1>(v); v = dpp_add_f<0x4E>(v); v = dpp_add_f<0x141>(v); return dpp_add_f<0x140>(v); }
__device__ __forceinline__ unsigned row_max16_u(unsigned v) { v = dpp_max_u<0xB1, 0xF>(v); v = dpp_max_u<0x4E, 0xF>(v); v = dpp_max_u<0x141, 0xF>(v); return dpp_max_u<0x140, 0xF>(v); }
template <int CTRL> __device__ __forceinline__ float dpp_maxf(float v) { return fmaxf(v, __int_as_float(__builtin_amdgcn_update_dpp(__float_as_int(v), __float_as_int(v), CTRL, 0xF, 0xF, false))); }
__device__ __forceinline__ float row_max16_f(float v) { v = dpp_maxf<0xB1>(v); v = dpp_maxf<0x4E>(v); v = dpp_maxf<0x141>(v); return dpp_maxf<0x140>(v); }
__device__ __forceinline__ float okey_inv(unsigned k) { return __uint_as_float((k & 0x80000000u) ? (k & 0x7fffffffu) : ~k); }
#define CE_DESC(a, b) do { const unsigned hi_ = (a) > (b) ? (a) : (b), lo_ = (a) > (b) ? (b) : (a); (a) = hi_; (b) = lo_; } while (0)
__device__ __forceinline__ unsigned okey(float f) { const unsigned u = __float_as_uint(f); return (u & 0x80000000u) ? ~u : (u | 0x80000000u); }

__device__ __forceinline__ void tr_issue(f32x4 (&t)[8], const float* W, int N, int k0, int n0, int lane) {
#pragma unroll
    for (int i = 0; i < 8; ++i) t[i] = __builtin_nontemporal_load((const GAS f32x4*)(W + (size_t)(k0 + 8 * i + (lane >> 3)) * N + n0 + 4 * (lane & 7)));
}
__device__ __forceinline__ void tr_to_lds(const f32x4 (&t)[8], LAS float* scr, int lane) {
#pragma unroll
    for (int i = 0; i < 8; ++i) { LAS float* d = scr + (8 * i + (lane >> 3)) * 33 + 4 * (lane & 7); d[0] = t[i].x; d[1] = t[i].y; d[2] = t[i].z; d[3] = t[i].w; }
    LDS_WAIT(); asm volatile("" ::: "memory");
}
__device__ __forceinline__ void tr_finish_bf16(const f32x4 (&t)[8], LAS float* scr, bf16* WT, int ldo, int col_off, int k0, int n0, int row_delta, int lane, const float* gk = nullptr) {
    tr_to_lds(t, scr, lane);
    const int c = lane & 7;
    f32x4 g0 = {1.f, 1.f, 1.f, 1.f}, g1 = {1.f, 1.f, 1.f, 1.f}; if (gk) { g0 = *(const GAS f32x4*)(gk + k0 + 8 * c); g1 = *(const GAS f32x4*)(gk + k0 + 8 * c + 4); }
#pragma unroll
    for (int j = 0; j < 4; ++j) { const int n = (lane >> 3) + 8 * j; const LAS float* s = scr + (8 * c) * 33 + n;
        v4u o; o.x = pk2(s[0 * 33] * g0.x, s[1 * 33] * g0.y); o.y = pk2(s[2 * 33] * g0.z, s[3 * 33] * g0.w); o.z = pk2(s[4 * 33] * g1.x, s[5 * 33] * g1.y); o.w = pk2(s[6 * 33] * g1.z, s[7 * 33] * g1.w);
        *(GAS v4u*)(WT + (size_t)(n0 + n + row_delta) * ldo + col_off + k0 + 8 * c) = o; }
    LDS_WAIT(); asm volatile("" ::: "memory");
}
__device__ __forceinline__ void tr_finish_fp8(const f32x4 (&t)[8], LAS float* scr, unsigned char* WT8, int ldo, float scale, int k0, int n0, int ncol0, int lane) {
    tr_to_lds(t, scr, lane);
    const int c = lane & 3;
#pragma unroll
    for (int j = 0; j < 2; ++j) { const int n = (lane >> 2) + 16 * j; const LAS float* s = scr + (16 * c) * 33 + n; v4u o; int w;
        w = __builtin_amdgcn_cvt_pk_fp8_f32(s[0 * 33] * scale, s[1 * 33] * scale, 0, false); w = __builtin_amdgcn_cvt_pk_fp8_f32(s[2 * 33] * scale, s[3 * 33] * scale, w, true); o.x = (unsigned)w;
        w = __builtin_amdgcn_cvt_pk_fp8_f32(s[4 * 33] * scale, s[5 * 33] * scale, 0, false); w = __builtin_amdgcn_cvt_pk_fp8_f32(s[6 * 33] * scale, s[7 * 33] * scale, w, true); o.y = (unsigned)w;
        w = __builtin_amdgcn_cvt_pk_fp8_f32(s[8 * 33] * scale, s[9 * 33] * scale, 0, false); w = __builtin_amdgcn_cvt_pk_fp8_f32(s[10 * 33] * scale, s[11 * 33] * scale, w, true); o.z = (unsigned)w;
        w = __builtin_amdgcn_cvt_pk_fp8_f32(s[12 * 33] * scale, s[13 * 33] * scale, 0, false); w = __builtin_amdgcn_cvt_pk_fp8_f32(s[14 * 33] * scale, s[15 * 33] * scale, w, true); o.w = (unsigned)w;
        *(GAS v4u*)(WT8 + (size_t)(n0 + n - ncol0) * ldo + k0 + 16 * c) = o; }
    LDS_WAIT(); asm volatile("" ::: "memory");
}
__device__ __forceinline__ void transpose_item(const float* W, int N, bf16* WT, int ldo, int col_off, LAS float* scr, int item, int lane, int row_delta = 0) {
    const int nblk = N / 32, k0 = 64 * (item / nblk), n0 = 32 * (item % nblk); f32x4 t[8]; tr_issue(t, W, N, k0, n0, lane); tr_finish_bf16(t, scr, WT, ldo, col_off, k0, n0, row_delta, lane);
}
__device__ __forceinline__ void transpose_item_fp8(const float* W, int N, int ncol0, unsigned char* WT8, int ldo, float scale, LAS float* scr, int item, int lane) {
    const int nblk = N / 32, k0 = 64 * (item / nblk), n0 = 32 * (item % nblk); f32x4 t[8]; tr_issue(t, W, N, k0, n0, lane); tr_finish_fp8(t, scr, WT8, ldo, scale, k0, n0, ncol0, lane);
}
constexpr int NPCU = 32;
constexpr int NPREP = 512;
constexpr int I_IN = (DM / 64) * (INW / 32), I_A = (512 / 64) * (DM / 32), I_C = (1024 / 64) * (DM / 32), I_SQ = (DM / 64) * (DM / 32), I_OWN = 2 * I_A + I_C + 2 * I_SQ;
__device__ __forceinline__ void prep_win_item(const float* w_in, bf16* WIN, unsigned char* WG8, LAS float* scr, int r, int lane) {
    const int ct = ((r % (INW / 32)) * 32) >> 8;
    if (ct < 2) transpose_item(w_in, INW, WIN, DM, 0, scr, r, lane); else if (ct >= 28 && ct < 32) transpose_item(w_in, INW, WIN, DM, 0, scr, r, lane, -26 * 256);
    else transpose_item_fp8(w_in, INW, ct < 28 ? 2 * 256 : 6 * 256, WG8, DM, 1024.f, scr, r, lane);
}
template <bool FP8> __device__ __forceinline__ void rms_rows2_to_bf16(const float* xrow, size_t rstride, const float* g, bf16* orow, unsigned char* o8row, int lane) {
    const GAS f32x4* gr = (const GAS f32x4*)g + lane;
    f32x4 v[2][8];
#pragma unroll
    for (int u = 0; u < 2; ++u) { const GAS f32x4* xr = (const GAS f32x4*)(xrow + u * rstride) + lane;
#pragma unroll
        for (int j = 0; j < 8; ++j) v[u][j] = xr[64 * j]; }
#pragma unroll
    for (int u = 0; u < 2; ++u) { float s = 0.f;
#pragma unroll
        for (int j = 0; j < 8; ++j) s += (v[u][j].x * v[u][j].x + v[u][j].y * v[u][j].y) + (v[u][j].z * v[u][j].z + v[u][j].w * v[u][j].w);
        const float rstd = 1.0f / sqrtf(wave_sum(s) * (1.f / DM) + RMS_EPS);
        GAS unsigned long long* o8 = (GAS unsigned long long*)(orow + u * rstride) + lane;
#pragma unroll
        for (int j = 0; j < 8; ++j) { const f32x4 gg = gr[64 * j]; const float a = v[u][j].x * rstd * gg.x, b = v[u][j].y * rstd * gg.y, c = v[u][j].z * rstd * gg.z, d = v[u][j].w * rstd * gg.w;
            o8[64 * j] = (unsigned long long)pk2(a, b) | ((unsigned long long)pk2(c, d) << 32);
            if (FP8) { int w = __builtin_amdgcn_cvt_pk_fp8_f32(a * 32.f, b * 32.f, 0, false); w = __builtin_amdgcn_cvt_pk_fp8_f32(c * 32.f, d * 32.f, w, true); ((GAS unsigned*)(o8row + u * rstride))[lane + 64 * j] = (unsigned)w; } } }
}
typedef __bf16 bf2_t __attribute__((ext_vector_type(2)));
__device__ __forceinline__ float DOT2(unsigned a, unsigned b, float c) { return __builtin_amdgcn_fdot2_f32_bf16(__builtin_bit_cast(bf2_t, a), __builtin_bit_cast(bf2_t, b), c, false); }
__device__ __forceinline__ unsigned q8x4(float a, float b, float c, float d, float inv) {
    const int ia = (int)__builtin_rintf(a * inv), ib = (int)__builtin_rintf(b * inv), ic = (int)__builtin_rintf(c * inv), id = (int)__builtin_rintf(d * inv);
    return (unsigned)(ia & 0xff) | ((unsigned)(ib & 0xff) << 8) | ((unsigned)(ic & 0xff) << 16) | ((unsigned)(id & 0xff) << 24);
}
__device__ __forceinline__ float wave_maxf(float v) {
    v = fmaxf(v, sx_f<1>(v)); v = fmaxf(v, sx_f<2>(v)); v = fmaxf(v, sx_f<4>(v)); v = fmaxf(v, sx_f<8>(v)); v = fmaxf(v, sx_f<16>(v));
    auto rr = __builtin_amdgcn_permlane32_swap(__float_as_uint(v), __float_as_uint(v), false, false); return fmaxf(__uint_as_float(rr[0]), __uint_as_float(rr[1]));
}
template <int MODE> __device__ __forceinline__ void rms_rows2_from_bf16(const bf16* xrow, size_t rstride, const float* g, bf16* orow, unsigned char* o8row, float* sh, int shstride, int lane) {
    const GAS f32x4* gr = (const GAS f32x4*)g + 2 * lane;
    v4u xv[2][4];
#pragma unroll
    for (int u = 0; u < 2; ++u) { const GAS v4u* xr = (const GAS v4u*)(xrow + u * rstride) + lane;
#pragma unroll
        for (int j = 0; j < 4; ++j) xv[u][j] = xr[64 * j]; }
#pragma unroll
    for (int u = 0; u < 2; ++u) { float v[4][8]; float s = 0.f;
#pragma unroll
        for (int j = 0; j < 4; ++j) { const v4u w = xv[u][j]; v[j][0] = bflo(w.x); v[j][1] = bfhi(w.x); v[j][2] = bflo(w.y); v[j][3] = bfhi(w.y); v[j][4] = bflo(w.z); v[j][5] = bfhi(w.z); v[j][6] = bflo(w.w); v[j][7] = bfhi(w.w);
#pragma unroll
            for (int k = 0; k < 8; ++k) s += v[j][k] * v[j][k]; }
        const float rstd = 1.0f / sqrtf(wave_sum(s) * (1.f / DM) + RMS_EPS); float mx = 0.f;
#pragma unroll
        for (int j = 0; j < 4; ++j) { const f32x4 ga = gr[128 * j], gb = gr[128 * j + 1];
            v[j][0] *= rstd * ga.x; v[j][1] *= rstd * ga.y; v[j][2] *= rstd * ga.z; v[j][3] *= rstd * ga.w; v[j][4] *= rstd * gb.x; v[j][5] *= rstd * gb.y; v[j][6] *= rstd * gb.z; v[j][7] *= rstd * gb.w;
            if (MODE == 1) {
#pragma unroll
                for (int k = 0; k < 8; ++k) mx = fmaxf(mx, fabsf(v[j][k])); } }
        float inv = 32.f;
        if (MODE == 1) { mx = fmaxf(wave_maxf(mx), 1e-30f); inv = 127.f / mx; if (lane == 0) sh[u * shstride] = mx * (1.f / 127.f); }
        GAS v4u* ob = (GAS v4u*)(orow + u * rstride) + lane; GAS unsigned long long* o8 = (GAS unsigned long long*)(o8row + u * rstride) + lane;
#pragma unroll
        for (int j = 0; j < 4; ++j) { v4u o; o.x = pk2(v[j][0], v[j][1]); o.y = pk2(v[j][2], v[j][3]); o.z = pk2(v[j][4], v[j][5]); o.w = pk2(v[j][6], v[j][7]); ob[64 * j] = o;
            unsigned lo, hi;
            if (MODE == 0) { int w = __builtin_amdgcn_cvt_pk_fp8_f32(v[j][0] * inv, v[j][1] * inv, 0, false); w = __builtin_amdgcn_cvt_pk_fp8_f32(v[j][2] * inv, v[j][3] * inv, w, true); lo = (unsigned)w;
                w = __builtin_amdgcn_cvt_pk_fp8_f32(v[j][4] * inv, v[j][5] * inv, 0, false); w = __builtin_amdgcn_cvt_pk_fp8_f32(v[j][6] * inv, v[j][7] * inv, w, true); hi = (unsigned)w; }
            else { lo = q8x4(v[j][0], v[j][1], v[j][2], v[j][3], inv); hi = q8x4(v[j][4], v[j][5], v[j][6], v[j][7], inv); }
            o8[64 * j] = (unsigned long long)lo | ((unsigned long long)hi << 32); } }
}
__device__ __forceinline__ int rel_bucket(int rel) {
    const int n = rel < 0 ? -rel : rel;
    int b = n;
    if (n >= 8) { b = 5 + (31 - __builtin_clz((unsigned)n)); if (b > 15) b = 15; }
    return b + (rel > 0 ? 16 : 0);
}

#ifndef PH_D1
#define PH_D1 1
#endif
#ifndef PH_D2
#define PH_D2 1
#endif
#ifndef PH_A
#define PH_A 1
#endif
#ifndef PH_B
#define PH_B 1
#endif
#ifndef PH_C
#define PH_C 1
#endif
#ifndef PH_D
#define PH_D 1
#endif
#ifndef PH_E
#define PH_E 1
#endif
#ifndef PH_F
#define PH_F 1
#endif
#ifndef PH_G
#define PH_G 1
#endif
#ifndef PH_H
#define PH_H 1
#endif
#ifndef PH_I
#define PH_I 1
#endif
#ifndef PH_J
#define PH_J 1
#endif
#ifndef PH_K
#define PH_K 1
#endif
#ifndef PH_L
#define PH_L 1
#endif
struct Args { const float* in[17]; float* out; unsigned char* ws; };

#define CAS __attribute__((address_space(4)))
__device__ __forceinline__ const void* karg(int k) { const CAS char* ka = (const CAS char*)__builtin_amdgcn_kernarg_segment_ptr(); asm volatile("" : "+s"(ka)); return *(const void* const CAS*)(ka + 8 * k); }
#define WSP(T, off) ((T*)((unsigned char*)karg(18) + (off)))
#define INP(k) ((const float*)karg(k))
#define INL(k, stride) (INP(k) + (size_t)layer * (size_t)(stride))
#define X ((float*)karg(17))
#define X16 WSP(bf16, WS_X16)
__global__ void __launch_bounds__(NWAVES * 64, 2) mk_fwd(Args args_unused) {
    extern __shared__ __attribute__((aligned(16))) unsigned char lds[];
    LAS unsigned char* ldsl = (LAS unsigned char*)lds;
    volatile LAS unsigned* MISC = (volatile LAS unsigned*)(ldsl + MISC_OFF);
    const int wave0 = __builtin_amdgcn_readfirstlane((int)threadIdx.x >> 6);
    const int G = gridDim.x; const int bx = blockIdx.x; const int vcu = (G % 8 == 0) ? (bx % 8) * (G / 8) + bx / 8 : bx;
    const int NGW = G * NWAVES, NGT = NGW * 64;
#define PH_IDS() int wave_o_ = wave0, vcu_o_ = vcu; asm volatile("" : "+s"(wave_o_), "+s"(vcu_o_));     \
    const int tid = opaque_tid(wave_o_), lane = tid & 63, wave = wave_o_, gw = vcu_o_ * NWAVES + wave, gt = gw * 64 + lane; (void)gt; (void)gw; (void)lane
    gu32* ctl = (gu32*)WSP(unsigned char, WS_CTL);
    for (int u = threadIdx.x; u < (LDS_BYTES - LDSCTL_OFF) / 4; u += NWAVES * 64) ((LAS unsigned*)(ldsl + LDSCTL_OFF))[u] = 0u;
    __syncthreads();
    XcdBarrier bar = xcd_barrier_post((unsigned*)(ctl + CW_BAR), MISC + 8);
    if (threadIdx.x == 0) MISC[1] = __hip_atomic_fetch_add(ctl + CW_XRANK + 64 * (int)(xb_xcc_id() & 7u), 1u, __ATOMIC_RELAXED, __HIP_MEMORY_SCOPE_AGENT);
#define GRID_BAR() xcd_barrier(bar)

    for (int layer = 0; layer < 2; ++layer) {

#if PH_A
        {
            PH_IDS();
            LAS float* scr = (LAS float*)(ldsl + wave * 16384);
            const float* mix_g = INL(3, DM); const float* rel_bias = INP(1);
            bf16* H = WSP(bf16, WS_H); bf16* DFT = WSP(bf16, WS_DFT); bf16* CS = WSP(bf16, WS_CS); float* TAB = WSP(float, WS_TAB);
            if (layer == 0) { const float* w_in = INP(4); bf16* WIN = WSP(bf16, WS_WIN);
                for (int it = gw; it < I_IN; it += NGW) prep_win_item(w_in, WIN, WSP(unsigned char, WS_WG8), scr, it, lane); }
            if (layer == 0) { int m = gw; do { rms_rows2_to_bf16<true>(INP(0) + (size_t)m * DM, (size_t)NGW * DM, mix_g, H + (size_t)m * DM, WSP(unsigned char, WS_H8) + (size_t)m * DM, lane); m += 2 * NGW; } while (m < MTOK); }
            else { int m = gw; do { rms_rows2_from_bf16<0>(X16 + (size_t)m * DM, (size_t)NGW * DM, mix_g, H + (size_t)m * DM, WSP(unsigned char, WS_H8) + (size_t)m * DM, nullptr, 0, lane); m += 2 * NGW; } while (m < MTOK); }
            if (layer == 0) {
                for (size_t i = (size_t)gt; i < (size_t)2304 * 8192 / 8; i += (size_t)NGT) {
                    const int sp = (int)(i >> 10), k0 = (int)(i & 1023) * 8, part = k0 >> 12, s0 = k0 & 4095; float v[8];
#pragma unroll
                    for (int j = 0; j < 8; ++j) { const float ang = (float)(((s0 + j) * sp) & 4095) * (1.f / 4096.f); v[j] = (part ? -__builtin_amdgcn_sinf(ang) : __builtin_amdgcn_cosf(ang)) * (1.f / 64.f); }
                    v4u o; o.x = pk2(v[0], v[1]); o.y = pk2(v[2], v[3]); o.z = pk2(v[4], v[5]); o.w = pk2(v[6], v[7]); ((GAS v4u*)DFT)[i] = o;
                }
                for (int i = gt; i < 65536; i += NGT) { const int r = i >> 8, c = i & 255, part = r >> 7, cp = r & 127; float v = 0.f;
                    if (c < 128) { const float ang = (float)((c * cp) & 127) * (1.f / 128.f); v = (part ? __builtin_amdgcn_sinf(ang) : __builtin_amdgcn_cosf(ang)) * 0.08838834764831845f; }
                    CS[i] = (bf16)f2bf(v); }
                for (int i = gt; i < 16 * 8192; i += NGT) { const int hd = i >> 13, off = (i & 8191) - 4096; float v;
                    if (hd < 12) { const int g = hd >> 2, dil = g == 0 ? 1 : (g == 1 ? 4 : 16); v = (off >= -64 && off <= 64) ? rel_bias[rel_bucket(off * dil) * 16 + hd] * 11.313708498984761f : -1.0e5f; }
                    else v = rel_bias[rel_bucket(off) * 16 + hd] * 11.313708498984761f;
                    TAB[i] = v; }
            }
        }
#endif
        GRID_BAR();

#if PH_B
        {
            { pg8::Gemm g{WSP(bf16, WS_H), WSP(bf16, WS_WIN)}; pg8::StaticOrder S; S.init(MTOK, 6 * 256, G, bx, DM, DM);
              pg8::EpiProj E{WSP(bf16, WS_PROJ), WSP(unsigned char, WS_G), INL(5, GTW), 2, 0, 26, 1.f};
              pg8::gemm_phase<pg8::EpiProj, pg8::StaticOrder, true, DM, DM, DM>(ldsl, g, S, E, wave0); }
            { pg8::Gemm g{WSP(bf16, WS_H8), WSP(bf16, WS_WG8)}; pg8::StaticOrder S; S.init(MTOK, 50 * 256, G, (bx + G / 2) % G, DM / 2, DM / 2);
              pg8::EpiProj E{WSP(bf16, WS_PROJ), WSP(unsigned char, WS_G), INL(5, GTW), 26, 2, 6, 1.f / 32768.f};
              pg8::gemm_phase<pg8::EpiProj, pg8::StaticOrder, true, DM / 2, DM / 2, DM / 2, true>(ldsl, g, S, E, wave0); }
        }
#endif
        GRID_BAR();

#if PH_C
        {
            pg8::Gemm g{WSP(bf16, WS_CS), WSP(bf16, WS_PROJ)}; pg8::F1Order S{G, bx};
            pg8::EpiZT E{WSP(bf16, WS_ZT)};
            pg8::gemm_phase<pg8::EpiZT, pg8::F1Order, false, 256, PJW, 256>(ldsl, g, S, E, wave0);
        }
#endif
        GRID_BAR();

#if PH_D
#if PH_D1
        {
            pg8::Gemm g{WSP(bf16, WS_DFT), WSP(bf16, WS_ZT)}; pg8::StaticOrder S; S.init(2304, 2048, G, bx, 8192, 8192);
            pg8::EpiF2 E{WSP(bf16, WS_OC)};
            pg8::gemm_phase<pg8::EpiF2, pg8::StaticOrder, false, 8192, 8192, 8192>(ldsl, g, S, E, wave0);
        }
#endif
#if PH_D2
        {
            PH_IDS();
            gu32* qhead = ctl + CW_QUEUE + 64 * layer; gu32* phead = ctl + CW_QUEUE + 128 + 64 * layer; const bool pref = bx >= 128 && bx < 128 + NPCU;
            bf16* PROJ = WSP(bf16, WS_PROJ); bf16* DO = WSP(bf16, WS_MG); bf16* DL = WSP(bf16, WS_H); float* LSE = WSP(float, WS_LSE); const float* TAB = WSP(float, WS_TAB);
            const float* cur_tab = nullptr;
            for (;;) {
                __syncthreads();
                if (tid == 0) { unsigned w = 0xffffffffu;
                    if (pref) { const unsigned v = __hip_atomic_fetch_add(phead, 1u, __ATOMIC_RELAXED, __HIP_MEMORY_SCOPE_AGENT); if (v < (unsigned)NPREP) w = 0x8000u | v; }
                    if (w == 0xffffffffu) { const unsigned v = __hip_atomic_fetch_add(qhead, 1u, __ATOMIC_RELAXED, __HIP_MEMORY_SCOPE_AGENT); if (v < 1792u) w = v; }
                    if (w == 0xffffffffu && !pref) { const unsigned v = __hip_atomic_fetch_add(phead, 1u, __ATOMIC_RELAXED, __HIP_MEMORY_SCOPE_AGENT); if (v < (unsigned)NPREP) w = 0x8000u | v; }
                    MISC[0] = w; }
                __syncthreads();
                const int ui0 = __builtin_amdgcn_readfirstlane((int)MISC[0]);
                if (ui0 == -1) break;
                int ui = ui0;
                { const int grp = ui0 & 0x7fff;
                    if (ui0 & 0x8000) {
                        const int pi = grp, t3 = opaque_tid(wave0), ln = t3 & 63;
                        { const float* pu = INL(15, (size_t)NEXP * DM); const float* pv = INL(16, (size_t)NEXP * DM); unsigned char* U8 = WSP(unsigned char, WS_U); unsigned char* V8 = WSP(unsigned char, WS_V); float* SU = WSP(float, WS_SU);
                          const int e0 = 32 * pi + 4 * wave0; LAS float* scr = (LAS float*)(ldsl + wave0 * 8448);
                          const int tpi = layer == 0 ? (I_OWN + I_IN) / NPREP : I_OWN / NPREP;
                          struct TDsc { const float* W; const float* gk; bf16* WT; unsigned char* WT8; int N, k0, n0, col_off, rowd, fp8; };
                          auto tdesc = [&](int r) -> TDsc { TDsc d; d.WT8 = nullptr; d.WT = nullptr; d.gk = nullptr; d.fp8 = 0; d.rowd = 0; d.col_off = 0; d.N = DM;
                              if (r < I_A) { d.W = INL(6, 512 * DM); d.WT = WSP(bf16, WS_WCAT); }
                              else if ((r -= I_A) < I_A) { d.W = INL(7, 512 * DM); d.WT = WSP(bf16, WS_WCAT); d.col_off = 512; }
                              else if ((r -= I_A) < I_C) { d.W = INL(8, 1024 * DM); d.WT = WSP(bf16, WS_WCAT); d.col_off = 1024; }
                              else if ((r -= I_C) < I_SQ) { d.W = INL(11, DM * DM); d.WT = WSP(bf16, WS_WO); }
                              else if ((r -= I_SQ) < I_SQ) { d.W = INL(13, DM * DM); d.WT = WSP(bf16, WS_WQ); d.gk = INL(12, DM); }
                              else { r -= I_SQ; d.W = INP(4) + (size_t)DM * INW; d.N = INW; d.WT = WSP(bf16, WS_WIN); const int ct = ((r % (INW / 32)) * 32) >> 8;
                                  if (ct >= 28 && ct < 32) d.rowd = -26 * 256; else if (ct >= 2) { d.fp8 = 1; d.WT8 = WSP(unsigned char, WS_WG8); d.rowd = ct < 28 ? 2 * 256 : 6 * 256; } }
                              const int nblk = d.N / 32; d.k0 = 64 * (r / nblk); d.n0 = 32 * (r % nblk); return d; };
                          f32x4 buf[4][8];
#define PP_ISSUE(k) do { if ((k) < 8) { const GAS f32x4* rp_ = (const GAS f32x4*)(((k) < 4 ? pu : pv) + (size_t)(e0 + ((k) & 3)) * DM) + ln; \
                              _Pragma("unroll") for (int j_ = 0; j_ < 8; ++j_) buf[(k) & 3][j_] = __builtin_nontemporal_load(rp_ + 64 * j_); } \
                          else if (wave0 + NWAVES * ((k) - 8) < tpi) { const TDsc d_ = tdesc(pi * tpi + wave0 + NWAVES * ((k) - 8)); tr_issue(buf[(k) & 3], d_.W, d_.N, d_.k0, d_.n0, ln); } } while (0)
                          PP_ISSUE(0); PP_ISSUE(1); PP_ISSUE(2); PP_ISSUE(3);
#pragma unroll
                          for (int k = 0; k < 13; ++k) { f32x4 (&y)[8] = buf[k & 3];
                              if (k < 4) { const int e = e0 + k; float mx = 0.f;
                                  { const GAS f32x4* gp_ = (const GAS f32x4*)INL(12, DM) + ln;
#pragma unroll
                                    for (int j = 0; j < 8; ++j) y[j] = y[j] * gp_[64 * j]; }
#pragma unroll
                                  for (int j = 0; j < 8; ++j) mx = fmaxf(mx, fmaxf(fmaxf(fabsf(y[j].x), fabsf(y[j].y)), fmaxf(fabsf(y[j].z), fabsf(y[j].w))));
                                  mx = fmaxf(wave_maxf(mx), 1e-30f); const float inv = 127.f / mx;
#pragma unroll
                                  for (int j = 0; j < 8; ++j) ((GAS unsigned*)(U8 + (size_t)e * DM))[ln + 64 * j] = q8x4(y[j].x, y[j].y, y[j].z, y[j].w, inv);
                                  if (ln == 0) SU[e] = mx * (1.f / 127.f); }
                              else if (k < 8) { const int e = e0 + (k - 4);
#pragma unroll
                                  for (int j = 0; j < 8; ++j) { int w = __builtin_amdgcn_cvt_pk_fp8_f32(y[j].x * 64.f, y[j].y * 64.f, 0, false); w = __builtin_amdgcn_cvt_pk_fp8_f32(y[j].z * 64.f, y[j].w * 64.f, w, true);
                                      ((GAS unsigned*)(V8 + (size_t)e * DM))[ln + 64 * j] = (unsigned)w; } }
                              else if (wave0 + NWAVES * (k - 8) < tpi) { const TDsc d = tdesc(pi * tpi + wave0 + NWAVES * (k - 8));
                                  if (d.fp8) tr_finish_fp8(y, scr, d.WT8, DM, 1024.f, d.k0, d.n0, d.rowd, ln); else tr_finish_bf16(y, scr, d.WT, DM, d.col_off, d.k0, d.n0, d.rowd, ln, d.gk); }
                              if (k + 4 < 13) PP_ISSUE(k + 4);
                          }
#undef PP_ISSUE
                        }
                        continue;
                    }
                }
                attn::Unit u; int hd;
                if (ui < 1024) {
                    const int qb = ui & 15, vh = (ui >> 4) & 1, m = (ui >> 5) & 1, h = (ui >> 6) & 3, b = ui >> 8;
                    const bf16* base = PROJ + (size_t)b * SEQ * PJW;
                    u.Q = base + (size_t)(qb * 256) * PJW + COL_DIFF + (h * 2 + m) * 128; u.K = base + COL_DIFF + 1024 + (h * 2 + m) * 128; u.V = base + COL_DIFF + 2048 + h * 256 + vh * 128;
                    u.O = DO + (size_t)(b * SEQ + qb * 256) * DM + (h * 2 + m) * 256 + vh * 128; u.lse = nullptr; u.ldq = PJW; u.ldk = PJW; u.ldo = DM; u.lse_ld = 0;
                    u.kt0 = 0; u.nt = SEQ / 64; u.qoff = qb * 256; hd = 12 + h;
                } else {
                    const int v = ui - 1024, qb16 = v & 15, hh = (v >> 4) & 3, bg = v >> 6, g = bg % 3, b = bg / 3;
                    const int dil = g == 0 ? 1 : (g == 1 ? 4 : 16), bpc = 16 / dil, r = qb16 / bpc, qblk = qb16 % bpc, q0 = qblk * 256, ntot = (SEQ / dil) / 64;
                    int kt0 = q0 / 64 - 1; if (kt0 < 0) kt0 = 0; int kt1 = q0 / 64 + 5; if (kt1 > ntot) kt1 = ntot;
                    if ((kt1 - kt0) & 1) { if (kt0 > 0) --kt0; else ++kt1; }
                    const bf16* base = PROJ + (size_t)(b * SEQ + r) * PJW + COL_DIL + g * 512 + hh * 128;
                    u.Q = base + (size_t)q0 * dil * PJW; u.K = base + 1536; u.V = base + 3072;
                    u.O = DL + ((size_t)g * MTOK + b * SEQ + r + (size_t)q0 * dil) * 512 + hh * 128; u.lse = LSE + ((size_t)g * MTOK + b * SEQ + r + (size_t)q0 * dil) * 4 + hh;
                    u.ldq = (long)PJW * dil; u.ldk = (long)PJW * dil; u.ldo = 512L * dil; u.lse_ld = 4 * dil; u.kt0 = kt0; u.nt = kt1 - kt0; u.qoff = q0; hd = g * 4 + hh;
                }
                const float* tab = TAB + (size_t)hd * 8192;
                if (tab != cur_tab) {
                    cur_tab = tab;
                    LAS f32x4* tl = (LAS f32x4*)(ldsl + attn::LDS_TAB); const int t2 = opaque_tid(wave0);
#pragma unroll
                    for (int j = 0; j < 4; ++j) tl[t2 + 512 * j] = ((const GAS f32x4*)tab)[t2 + 512 * j];
                }
                attn::attn_unit(u, (char*)lds, wave0);
            }
        }
#endif
#endif
        GRID_BAR();

#if PH_E
        {
            PH_IDS();
            const float* dlam = INL(9, 512); const float* subln = INL(10, 256); const float lambda_init = layer == 0 ? 0.2f : 0.35550906759f;
            const float* LSE = WSP(float, WS_LSE); const bf16* DL = WSP(bf16, WS_H); const bf16* DO = WSP(bf16, WS_MG); bf16* OC = WSP(bf16, WS_OC);
            float s1 = dlam[lane] * dlam[128 + lane] + dlam[64 + lane] * dlam[192 + lane], s2 = dlam[256 + lane] * dlam[384 + lane] + dlam[320 + lane] * dlam[448 + lane];
            s1 = wave_sum(s1); s2 = wave_sum(s2);
            const float lam = __expf(s1) - __expf(s2) + lambda_init, osc = 1.0f - lambda_init;
            const int hq = lane >> 4, l16 = lane & 15;
            const f32x4 g0 = *(const GAS f32x4*)(subln + l16 * 16), g1 = *(const GAS f32x4*)(subln + l16 * 16 + 4), g2 = *(const GAS f32x4*)(subln + l16 * 16 + 8), g3 = *(const GAS f32x4*)(subln + l16 * 16 + 12);
            for (int t = gw; t < MTOK; t += 4 * NGW) {
                float ls[4][3]; v4u dl[4][3], da[4][4];
#pragma unroll
                for (int u = 0; u < 4; ++u) { const int tt = t + u * NGW;
#pragma unroll
                    for (int g = 0; g < 3; ++g) { ls[u][g] = LSE[((size_t)g * MTOK + tt) * 4 + hq]; dl[u][g] = *(const GAS v4u*)(DL + ((size_t)g * MTOK + tt) * 512 + lane * 8); }
                    const bf16* dp = DO + (size_t)tt * DM + hq * 512 + l16 * 16;
                    da[u][0] = *(const GAS v4u*)(dp); da[u][1] = *(const GAS v4u*)(dp + 8); da[u][2] = *(const GAS v4u*)(dp + 256); da[u][3] = *(const GAS v4u*)(dp + 264); }
#pragma unroll
                for (int u = 0; u < 4; ++u) { const int tt = t + u * NGW;
                    float mx = fmaxf(fmaxf(ls[u][0], ls[u][1]), ls[u][2]), wsum = 0.f;
#pragma unroll
                    for (int g = 0; g < 3; ++g) { ls[u][g] = __expf(ls[u][g] - mx); wsum += ls[u][g]; }
                    const float winv = 1.0f / wsum; float acc8[8] = {0.f, 0.f, 0.f, 0.f, 0.f, 0.f, 0.f, 0.f};
#pragma unroll
                    for (int g = 0; g < 3; ++g) { const v4u o = dl[u][g]; const float w = ls[u][g] * winv;
                        acc8[0] += w * bflo(o.x); acc8[1] += w * bfhi(o.x); acc8[2] += w * bflo(o.y); acc8[3] += w * bfhi(o.y); acc8[4] += w * bflo(o.z); acc8[5] += w * bfhi(o.z); acc8[6] += w * bflo(o.w); acc8[7] += w * bfhi(o.w); }
                    { v4u o; o.x = pk2(acc8[0], acc8[1]); o.y = pk2(acc8[2], acc8[3]); o.z = pk2(acc8[4], acc8[5]); o.w = pk2(acc8[6], acc8[7]); *(GAS v4u*)(OC + (size_t)tt * DM + 512 + lane * 8) = o; }
                    const v4u a0 = da[u][0], a1 = da[u][1], b0 = da[u][2], b1 = da[u][3];
                    float d[16];
                    d[0] = bflo(a0.x) - lam * bflo(b0.x); d[1] = bfhi(a0.x) - lam * bfhi(b0.x); d[2] = bflo(a0.y) - lam * bflo(b0.y); d[3] = bfhi(a0.y) - lam * bfhi(b0.y);
                    d[4] = bflo(a0.z) - lam * bflo(b0.z); d[5] = bfhi(a0.z) - lam * bfhi(b0.z); d[6] = bflo(a0.w) - lam * bflo(b0.w); d[7] = bfhi(a0.w) - lam * bfhi(b0.w);
                    d[8] = bflo(a1.x) - lam * bflo(b1.x); d[9] = bfhi(a1.x) - lam * bfhi(b1.x); d[10] = bflo(a1.y) - lam * bflo(b1.y); d[11] = bfhi(a1.y) - lam * bfhi(b1.y);
                    d[12] = bflo(a1.z) - lam * bflo(b1.z); d[13] = bfhi(a1.z) - lam * bfhi(b1.z); d[14] = bflo(a1.w) - lam * bflo(b1.w); d[15] = bfhi(a1.w) - lam * bfhi(b1.w);
                    float ss = 0.f;
#pragma unroll
                    for (int j = 0; j < 16; ++j) ss += d[j] * d[j];
                    ss += sx_f<1>(ss); ss += sx_f<2>(ss); ss += sx_f<4>(ss); ss += sx_f<8>(ss);
                    const float rs = osc / sqrtf(ss * (1.f / 256.f) + RMS_EPS);
                    v4u o0, o1;
                    o0.x = pk2(d[0] * rs * g0.x, d[1] * rs * g0.y); o0.y = pk2(d[2] * rs * g0.z, d[3] * rs * g0.w); o0.z = pk2(d[4] * rs * g1.x, d[5] * rs * g1.y); o0.w = pk2(d[6] * rs * g1.z, d[7] * rs * g1.w);
                    o1.x = pk2(d[8] * rs * g2.x, d[9] * rs * g2.y); o1.y = pk2(d[10] * rs * g2.z, d[11] * rs * g2.w); o1.z = pk2(d[12] * rs * g3.x, d[13] * rs * g3.y); o1.w = pk2(d[14] * rs * g3.z, d[15] * rs * g3.w);
                    bf16* op = OC + (size_t)tt * DM + 1024 + hq * 256 + l16 * 16;
                    *(GAS v4u*)(op) = o0; *(GAS v4u*)(op + 8) = o1; }
            }
        }
#endif
        GRID_BAR();

#if PH_F
        {
            pg8::MergeOrder S; S.init(MTOK, DM, G, bx, DM, DM);
            pg8::Gemm g{WSP(bf16, WS_OC), WSP(bf16, WS_WCAT)}; pg8::EpiMerge4 E{WSP(unsigned char, WS_G), WSP(bf16, WS_MG)};
            pg8::gemm_phase<pg8::EpiMerge4, pg8::MergeOrder, true, DM, DM, 512>(ldsl, g, S, E, wave0);
        }
#endif
        GRID_BAR();

#if PH_G
        {
            pg8::Gemm g{WSP(bf16, WS_MG), WSP(bf16, WS_WO)}; pg8::StaticOrder S; S.init(MTOK, DM, G, bx, DM, DM);
            pg8::EpiResX E{layer == 0 ? INP(0) : (const float*)nullptr, X16, X16, WSP(unsigned char, WS_H8), WSP(float, WS_SSP)};
            pg8::gemm_phase<pg8::EpiResX, pg8::StaticOrder, true, DM, DM, DM>(ldsl, g, S, E, wave0);
        }
#endif
        GRID_BAR();

#if PH_I
        {
            pg8::Gemm g{X16, WSP(bf16, WS_WQ)}; pg8::StaticOrder S; S.init(MTOK, DM, G, bx, DM, DM);
            pg8::EpiStoreRS E{WSP(bf16, WS_Q), DM, WSP(float, WS_SSP)};
            pg8::gemm_phase<pg8::EpiStoreRS, pg8::StaticOrder, true, DM, DM, DM>(ldsl, g, S, E, wave0);
        }
#endif
        GRID_BAR();

#if PH_K
        {
            PH_IDS();
            const bf16* Q = WSP(bf16, WS_Q); int* IDS = WSP(int, WS_IDS); float* GATES = WSP(float, WS_GATES);
            const int l16 = lane & 15, rbase = lane & 48, fq = lane >> 4;
            constexpr int SKP = 272;
            { const float* subk = INL(14, 2 * 128 * 128);
#pragma unroll
              for (int j = 0; j < 8; ++j) { const int ci = tid + 512 * j, kr = ci >> 4, c8 = ci & 15; const GAS f32x4* sp = (const GAS f32x4*)(subk + (size_t)kr * 128 + c8 * 8); const f32x4 lo = sp[0], hi4 = sp[1];
                  v4u w; w.x = pk2(lo.x, lo.y); w.y = pk2(lo.z, lo.w); w.z = pk2(hi4.x, hi4.y); w.w = pk2(hi4.z, hi4.w); *(LAS v4u*)(ldsl + kr * SKP + c8 * 16) = w; } }
            __syncthreads();
            int cq[4];
#pragma unroll
            for (int q = 0; q < 4; ++q) { int c = l16 + 16 * q, ci = -1, cj = 0; for (int i = 0; i < 16; ++i) { const int cnt = 16 / (i + 1); if (ci < 0) { if (c < cnt) { ci = i; cj = c; } else c -= cnt; } } cq[q] = ci < 0 ? -1 : ci * 16 + cj; }
            typedef short bfx8 __attribute__((ext_vector_type(8)));
            const LAS unsigned char* skl = ldsl + l16 * SKP + fq * 16;
            bfx8 nq[8];
            { const GAS bfx8* qp = (const GAS bfx8*)(Q + (size_t)(gw * 16 + l16) * 256 + fq * 8);
#pragma unroll
              for (int j = 0; j < 8; ++j) nq[j] = qp[4 * j]; }
            const int NTRIP = MTOK * 8 / 16;
            for (int trip = gw; trip < NTRIP; trip += NGW) {
                pg8::f32x4 sa[8], sb[8];
#pragma unroll
                for (int nb = 0; nb < 8; ++nb) { sa[nb] = (pg8::f32x4){0.f, 0.f, 0.f, 0.f}; sb[nb] = (pg8::f32x4){0.f, 0.f, 0.f, 0.f}; }
#pragma unroll
                for (int ks = 0; ks < 4; ++ks)
#pragma unroll
                    for (int n4 = 0; n4 < 8; n4 += 4) {
#pragma unroll
                        for (int nb = n4; nb < n4 + 4; ++nb) { const bfx8 ka_ = *(const LAS bfx8*)(skl + (nb * 16) * SKP + ks * 64), kb_ = *(const LAS bfx8*)(skl + (128 + nb * 16) * SKP + ks * 64);
                            sa[nb] = __builtin_amdgcn_mfma_f32_16x16x32_bf16(nq[ks], ka_, sa[nb], 0, 0, 0); sb[nb] = __builtin_amdgcn_mfma_f32_16x16x32_bf16(nq[4 + ks], kb_, sb[nb], 0, 0, 0); }
                        __builtin_amdgcn_sched_barrier(0); }
                { const int nt = trip + NGW < NTRIP ? trip + NGW : trip; const GAS bfx8* qp = (const GAS bfx8*)(Q + (size_t)(nt * 16 + l16) * 256 + fq * 8);
#pragma unroll
                  for (int j = 0; j < 8; ++j) nq[j] = qp[4 * j]; }
#pragma unroll
              for (int p4 = 0; p4 < 4; ++p4) {
                const int row = trip * 16 + 4 * fq + p4;
                unsigned ka[8], kb[8];
#pragma unroll
                for (int jj = 0; jj < 8; ++jj) { const unsigned ix = (unsigned)(127 - (jj * 16 + l16)); ka[jj] = (okey(sa[jj][p4]) & ~127u) | ix; kb[jj] = (okey(sb[jj][p4]) & ~127u) | ix; }
#define SORT8(k) do { CE_DESC(k[0], k[1]); CE_DESC(k[2], k[3]); CE_DESC(k[4], k[5]); CE_DESC(k[6], k[7]); CE_DESC(k[0], k[2]); CE_DESC(k[1], k[3]); CE_DESC(k[4], k[6]); CE_DESC(k[5], k[7]); \
    CE_DESC(k[1], k[2]); CE_DESC(k[5], k[6]); CE_DESC(k[0], k[4]); CE_DESC(k[3], k[7]); CE_DESC(k[1], k[5]); CE_DESC(k[2], k[6]); CE_DESC(k[1], k[4]); CE_DESC(k[3], k[6]); \
    CE_DESC(k[2], k[4]); CE_DESC(k[3], k[5]); CE_DESC(k[3], k[4]); } while (0)
                SORT8(ka); SORT8(kb);
                unsigned ta = 0u, tb = 0u;
#pragma unroll
                for (int r = 0; r < 16; ++r) {
                    const unsigned ma = row_max16_u(ka[0]), mb = row_max16_u(kb[0]);
                    const bool wa = ka[0] == ma, wb = kb[0] == mb;
                    ta = (l16 == r) ? ma : ta; tb = (l16 == r) ? mb : tb;
#pragma unroll
                    for (int q = 0; q < 7; ++q) { ka[q] = wa ? ka[q + 1] : ka[q]; kb[q] = wb ? kb[q + 1] : kb[q]; }
                    ka[7] = wa ? 0u : ka[7]; kb[7] = wb ? 0u : kb[7];
                }
                const int ia = 127 - (int)(ta & 127u), ib = 127 - (int)(tb & 127u);
                const float va = okey_inv(ta & ~127u), vb = okey_inv(tb & ~127u);
                unsigned ck[4];
#pragma unroll
                for (int q = 0; q < 4; ++q) { const int cc = cq[q] < 0 ? 0 : cq[q]; const float cs = bperm_f(va, rbase + (cc >> 4)) + bperm_f(vb, rbase + (cc & 15));
                    ck[q] = cq[q] < 0 ? 0u : ((okey(cs) & ~255u) | (unsigned)(255 - cc)); }
                CE_DESC(ck[0], ck[1]); CE_DESC(ck[2], ck[3]); CE_DESC(ck[0], ck[2]); CE_DESC(ck[1], ck[3]); CE_DESC(ck[1], ck[2]);
                unsigned tw = 0u;
#pragma unroll
                for (int r = 0; r < 16; ++r) { const unsigned mm = row_max16_u(ck[0]); const bool w = ck[0] == mm; tw = (l16 == r) ? mm : tw;
                    ck[0] = w ? ck[1] : ck[0]; ck[1] = w ? ck[2] : ck[1]; ck[2] = w ? ck[3] : ck[2]; ck[3] = w ? 0u : ck[3]; }
                const int code = 255 - (int)(tw & 255u), wi = (code >> 4) & 15, wj = code & 15;
                const float bs = bperm_f(va, rbase + wi) + bperm_f(vb, rbase + wj);
                const int eid = bperm_i(ia, rbase + wi) * 128 + bperm_i(ib, rbase + wj);
                const float mx = row_max16_f(bs), e = __expf(bs - mx), es = row_sum16(e);
                IDS[(size_t)row * 16 + l16] = eid; GATES[(size_t)row * 16 + l16] = e / es;
              }
            }
#undef SORT8
        }
#endif
        GRID_BAR();

#if PH_L
#define L_LDIDS(I, tt, hh) do { const GAS v4u* ip_ = (const GAS v4u*)(IDS + (size_t)(tt) * 128 + (hh) * 64 + lrow * 16); I##0 = ip_[0]; I##1 = ip_[1]; I##2 = ip_[2]; I##3 = ip_[3]; } while (0)
#define L_ISSUE(W, I, base) do { \
    W[0] = *(const GAS v4u*)((base) + (size_t)(I##0).x * DM); W[1] = *(const GAS v4u*)((base) + (size_t)(I##0).y * DM); W[2] = *(const GAS v4u*)((base) + (size_t)(I##0).z * DM); W[3] = *(const GAS v4u*)((base) + (size_t)(I##0).w * DM); \
    W[4] = *(const GAS v4u*)((base) + (size_t)(I##1).x * DM); W[5] = *(const GAS v4u*)((base) + (size_t)(I##1).y * DM); W[6] = *(const GAS v4u*)((base) + (size_t)(I##1).z * DM); W[7] = *(const GAS v4u*)((base) + (size_t)(I##1).w * DM); \
    W[8] = *(const GAS v4u*)((base) + (size_t)(I##2).x * DM); W[9] = *(const GAS v4u*)((base) + (size_t)(I##2).y * DM); W[10] = *(const GAS v4u*)((base) + (size_t)(I##2).z * DM); W[11] = *(const GAS v4u*)((base) + (size_t)(I##2).w * DM); \
    W[12] = *(const GAS v4u*)((base) + (size_t)(I##3).x * DM); W[13] = *(const GAS v4u*)((base) + (size_t)(I##3).y * DM); W[14] = *(const GAS v4u*)((base) + (size_t)(I##3).z * DM); W[15] = *(const GAS v4u*)((base) + (size_t)(I##3).w * DM); } while (0)
#define L_CVT(d, hi) __builtin_amdgcn_cvt_pk_f32_fp8((int)(d), (hi))
        {
            PH_IDS();
            const unsigned char* H8 = WSP(unsigned char, WS_H8); const unsigned char* U8 = WSP(unsigned char, WS_U); const int* IDS = WSP(int, WS_IDS); float* PART = WSP(float, WS_G);
            typedef float f32x2 __attribute__((ext_vector_type(2)));
            const int myx = (int)(xb_xcc_id() & 7u); int nx = 0, xi = 0, nloc = 1;
            for (int j = 0; j < 8; ++j) { const int c = (int)__hip_atomic_load(ctl + CW_XRANK + 64 * j, __ATOMIC_RELAXED, __HIP_MEMORY_SCOPE_AGENT); if (c > 0) { ++nx; if (j < myx) ++xi; } if (j == myx) nloc = c; }
            const int rw = (int)MISC[1] * NWAVES + wave, nW = nloc * NWAVES; const int l16 = lane & 15, lrow = lane >> 4;
#define L1_COMPUTE(W, dst) do { float sk[16]; _Pragma("unroll") for (int k = 0; k < 16; ++k) { const v4u ww = W[k]; int ac = 0; \
        ac = __builtin_amdgcn_sdot4((int)ww.x, (int)h0.x, ac, false); ac = __builtin_amdgcn_sdot4((int)ww.y, (int)h0.y, ac, false); ac = __builtin_amdgcn_sdot4((int)ww.z, (int)h0.z, ac, false); ac = __builtin_amdgcn_sdot4((int)ww.w, (int)h0.w, ac, false); \
        sk[k] = (float)ac; } \
          \
        float t8[8]; _Pragma("unroll") for (int j = 0; j < 8; ++j) { const float keep = b8 ? sk[8 + j] : sk[j], send = b8 ? sk[j] : sk[8 + j]; \
            t8[j] = keep + __int_as_float(__builtin_amdgcn_update_dpp(0, __float_as_int(send), 0x128, 0xF, 0xF, false)); } \
        float t4[4]; _Pragma("unroll") for (int j = 0; j < 4; ++j) { const float keep = b4 ? t8[4 + j] : t8[j], send = b4 ? t8[j] : t8[4 + j]; t4[j] = keep + sx_f<4>(send); } \
        float t2[2]; _Pragma("unroll") for (int j = 0; j < 2; ++j) { const float keep = b2 ? t4[2 + j] : t4[j], send = b2 ? t4[j] : t4[2 + j]; \
            t2[j] = keep + __int_as_float(__builtin_amdgcn_update_dpp(0, __float_as_int(send), 0x4E, 0xF, 0xF, false)); } \
        { const float keep = b1 ? t2[1] : t2[0], send = b1 ? t2[0] : t2[1]; dst = keep + __int_as_float(__builtin_amdgcn_update_dpp(0, __float_as_int(send), 0xB1, 0xF, 0xF, false)); } } while (0)
            const bool b8 = (lane & 8) != 0, b4 = (lane & 4) != 0, b2 = (lane & 2) != 0, b1 = (lane & 1) != 0;
            for (int sl = xi; sl < 8; sl += nx) {
                const unsigned char* ub = U8 + sl * 256 + l16 * 16; const unsigned char* hb = H8 + sl * 256 + l16 * 16;
                int t = rw;
                if (t < MTOK) {
                    v4u Wa[16], Wb[16]; v4u ia0, ia1, ia2, ia3, ib0, ib1, ib2, ib3; v4u h0;
                    L_LDIDS(ia, t, 0); L_LDIDS(ib, t, 1); h0 = *(const GAS v4u*)(hb + (size_t)t * DM);
                    L_ISSUE(Wa, ia, ub);
                    for (;;) {
                        const int tn = t + nW; const bool more = tn < MTOK; const int tp = more ? tn : t;
                        L_ISSUE(Wb, ib, ub);
                        L_LDIDS(ia, tp, 0); const v4u hn0 = *(const GAS v4u*)(hb + (size_t)tp * DM);
                        float pre0, pre1;
                        L1_COMPUTE(Wa, pre0);
                        L_ISSUE(Wa, ia, ub);
                        L_LDIDS(ib, tp, 1);
                        L1_COMPUTE(Wb, pre1);
                        float* pp = PART + ((size_t)sl * MTOK + t) * 128; pp[lane] = pre0; pp[64 + lane] = pre1;
                        h0 = hn0;
                        if (!more) break;
                        t = tn;
                    }
                }
            }
#undef L1_COMPUTE
        }
        GRID_BAR();
        {
            PH_IDS();
            const float* PART = WSP(float, WS_G); const float* GATES = WSP(float, WS_GATES); float* ACTW = WSP(float, WS_ACT);
            for (int t = gw; t < MTOK; t += NGW) {
                float q0 = 0.f, q1 = 0.f;
#pragma unroll
                for (int s8 = 0; s8 < 8; ++s8) { const float* pp = PART + ((size_t)s8 * MTOK + t) * 128; q0 += pp[lane]; q1 += pp[64 + lane]; }
                { const int* ip = WSP(int, WS_IDS) + (size_t)t * 128; float sh; { const float pv = lane < 32 ? WSP(float, WS_SSP)[(size_t)t * 32 + lane] : 0.f; sh = (1.0f / sqrtf(wave_sum(pv) * (1.f / DM) + RMS_EPS)) * (1.f / pg8::XS8); }     const float* SU = WSP(float, WS_SU); q0 *= SU[ip[lane]] * sh; q1 *= SU[ip[64 + lane]] * sh; }
                const float* gp = GATES + (size_t)t * 128; float* ap = ACTW + (size_t)t * 128;
                const float g0 = gp[lane], g1 = gp[64 + lane];
                ap[lane] = 0.5f * q0 * (1.0f + erff(q0 * 0.70710678118654752f)) * g0 * (1.f / 64.f); ap[64 + lane] = 0.5f * q1 * (1.0f + erff(q1 * 0.70710678118654752f)) * g1 * (1.f / 64.f);
            }
        }
        GRID_BAR();
        {
            PH_IDS();
            const unsigned char* V8 = WSP(unsigned char, WS_V); const int* IDS = WSP(int, WS_IDS); const float* ACT = WSP(float, WS_ACT);
            typedef float f32x2 __attribute__((ext_vector_type(2))); typedef _Float16 h2_t __attribute__((ext_vector_type(2)));
            const int myx = (int)(xb_xcc_id() & 7u); int nx = 0, xi = 0, nloc = 1;
            for (int j = 0; j < 8; ++j) { const int c = (int)__hip_atomic_load(ctl + CW_XRANK + 64 * j, __ATOMIC_RELAXED, __HIP_MEMORY_SCOPE_AGENT); if (c > 0) { ++nx; if (j < myx) ++xi; } if (j == myx) nloc = c; }
            const int rw = (int)MISC[1] * NWAVES + wave, nW = nloc * NWAVES; const int l16 = lane & 15, lrow = lane >> 4;
            bf16* XO = X16;
#define L2_BC(av, acr) do { _Pragma("unroll") for (int k = 0; k < 16; ++k) av[k] = bperm_f(acr, (lane & 48) + k); } while (0)
#define L_CVH(d, hi) __builtin_amdgcn_cvt_scalef32_pk_f16_fp8((d), 1.0f, (hi))
#define L2_C4(Q, av, o) do { _Pragma("unroll") for (int k = 0; k < 4; ++k) { const _Float16 ah_ = (_Float16)av[(o) + k]; const h2_t aa = (h2_t){ah_, ah_}; \
        const v4u ww = Q[k]; const unsigned d0 = ww.x, d1 = ww.y, d2 = ww.z, d3 = ww.w; \
        hacc[0] += aa * L_CVH(d0, false); hacc[1] += aa * L_CVH(d0, true); hacc[2] += aa * L_CVH(d1, false); hacc[3] += aa * L_CVH(d1, true); \
        hacc[4] += aa * L_CVH(d2, false); hacc[5] += aa * L_CVH(d2, true); hacc[6] += aa * L_CVH(d3, false); hacc[7] += aa * L_CVH(d3, true); } } while (0)
#define L_ISS4(Q, Ia) do { Q[0] = *(const GAS v4u*)(vb + (size_t)(Ia).x * DM); Q[1] = *(const GAS v4u*)(vb + (size_t)(Ia).y * DM); Q[2] = *(const GAS v4u*)(vb + (size_t)(Ia).z * DM); Q[3] = *(const GAS v4u*)(vb + (size_t)(Ia).w * DM); } while (0)
            for (int sl = xi; sl < 8; sl += nx) {
                const unsigned char* vb = V8 + sl * 256 + l16 * 16; bf16* xb = XO + sl * 256 + l16 * 16;
                int t = rw;
                if (t < MTOK) {
                    v4u Q0[4], Q1[4], Q2[4], Q3[4], Q4[4], Q5[4], Q6[4], Q7[4]; v4u ia0, ia1, ia2, ia3, ib0, ib1, ib2, ib3; float ac0, ac1;
                    L_LDIDS(ia, t, 0); L_LDIDS(ib, t, 1); ac0 = ACT[(size_t)t * 128 + lane]; ac1 = ACT[(size_t)t * 128 + 64 + lane];
                    L_ISS4(Q0, ia0); L_ISS4(Q1, ia1); L_ISS4(Q2, ia2); L_ISS4(Q3, ia3); L_ISS4(Q4, ib0); L_ISS4(Q5, ib1); L_ISS4(Q6, ib2); L_ISS4(Q7, ib3);
                    for (;;) {
                        const int tn = t + nW; const bool more = tn < MTOK; const int tp = more ? tn : t;
                        L_LDIDS(ia, tp, 0); L_LDIDS(ib, tp, 1); const float an0 = ACT[(size_t)tp * 128 + lane], an1 = ACT[(size_t)tp * 128 + 64 + lane];
                        h2_t hacc[8];
#pragma unroll
                        for (int k = 0; k < 8; ++k) hacc[k] = (h2_t){(_Float16)0.f, (_Float16)0.f};
                        float av[16];
                        L2_BC(av, ac0);
                        L2_C4(Q0, av, 0); L_ISS4(Q0, ia0);
                        L2_C4(Q1, av, 4); L_ISS4(Q1, ia1);
                        L2_C4(Q2, av, 8); L_ISS4(Q2, ia2);
                        L2_C4(Q3, av, 12); L_ISS4(Q3, ia3);
                        v4u xv[2]; { const GAS v4u* q = (const GAS v4u*)(xb + (size_t)t * DM); xv[0] = q[0]; xv[1] = q[1]; }
                        L2_BC(av, ac1);
                        L2_C4(Q4, av, 0); L_ISS4(Q4, ib0);
                        L2_C4(Q5, av, 4); L_ISS4(Q5, ib1);
                        L2_C4(Q6, av, 8); L_ISS4(Q6, ib2);
                        L2_C4(Q7, av, 12); L_ISS4(Q7, ib3);
                        f32x2 oacc[8];
#pragma unroll
                        for (int k = 0; k < 8; ++k) { float a = (float)hacc[k].x, b = (float)hacc[k].y; a += sx_f<16>(a); b += sx_f<16>(b); a = add32(a); b = add32(b); oacc[k] = (f32x2){a, b}; }
                        if (lane < 16) { GAS v4u* q = (GAS v4u*)(xb + (size_t)t * DM);
#pragma unroll
                            for (int k = 0; k < 2; ++k) { const v4u xw = xv[k]; v4u o;
                                o.x = pk2(bflo(xw.x) + oacc[4 * k].x, bfhi(xw.x) + oacc[4 * k].y); o.y = pk2(bflo(xw.y) + oacc[4 * k + 1].x, bfhi(xw.y) + oacc[4 * k + 1].y);
                                o.z = pk2(bflo(xw.z) + oacc[4 * k + 2].x, bfhi(xw.z) + oacc[4 * k + 2].y); o.w = pk2(bflo(xw.w) + oacc[4 * k + 3].x, bfhi(xw.w) + oacc[4 * k + 3].y); q[k] = o; } }
                        ac0 = an0; ac1 = an1;
                        if (!more) break;
                        t = tn;
                    }
                }
            }
#undef L2_BC
#undef L2_C4
#undef L_ISS4
        }
#undef L_LDIDS
#undef L_ISSUE
#undef L_CVT
#endif
        GRID_BAR();
    }

    { PH_IDS(); const bf16* XS = X16;
    for (int m0 = gw; m0 < MTOK; m0 += 4 * NGW) {
        const GAS f32x4* gr = (const GAS f32x4*)INP(2) + 2 * lane;
        v4u xv[4][4];
#pragma unroll
        for (int u = 0; u < 4; ++u) { const GAS v4u* xr = (const GAS v4u*)(XS + (size_t)(m0 + u * NGW) * DM) + lane;
#pragma unroll
            for (int j = 0; j < 4; ++j) xv[u][j] = xr[64 * j]; }
#pragma unroll
        for (int u = 0; u < 4; ++u) { float v[4][8]; float s = 0.f;
#pragma unroll
            for (int j = 0; j < 4; ++j) { const v4u w = xv[u][j]; v[j][0] = bflo(w.x); v[j][1] = bfhi(w.x); v[j][2] = bflo(w.y); v[j][3] = bfhi(w.y); v[j][4] = bflo(w.z); v[j][5] = bfhi(w.z); v[j][6] = bflo(w.w); v[j][7] = bfhi(w.w);
#pragma unroll
                for (int k = 0; k < 8; ++k) s += v[j][k] * v[j][k]; }
            const float rstd = 1.0f / sqrtf(wave_sum(s) * (1.f / DM) + RMS_EPS);
            GAS f32x4* orow = (GAS f32x4*)(X + (size_t)(m0 + u * NGW) * DM) + 2 * lane;
#pragma unroll
            for (int j = 0; j < 4; ++j) { const f32x4 ga = gr[128 * j], gb = gr[128 * j + 1];
                orow[128 * j] = (f32x4){v[j][0] * rstd * ga.x, v[j][1] * rstd * ga.y, v[j][2] * rstd * ga.z, v[j][3] * rstd * ga.w};
                orow[128 * j + 1] = (f32x4){v[j][4] * rstd * gb.x, v[j][5] * rstd * gb.y, v[j][6] * rstd * gb.z, v[j][7] * rstd * gb.w}; } }
    } }
}

extern "C" void kernel_launch(void* const* d_in, const int* in_sizes, int n_in, void* d_out, int out_size, void* d_ws, size_t ws_size, hipStream_t stream) {
    static int grid = 0;
    if (grid == 0) {
        if (n_in != 17 || in_sizes[0] != MTOK * DM || out_size != MTOK * DM || ws_size < WS_END) {
            fprintf(stderr, "kernel_launch: shape/workspace mismatch: n_in %d in0 %d out %d ws %zu (need %zu); nothing launched\n", n_in, n_in > 0 ? in_sizes[0] : -1, out_size, ws_size, (size_t)WS_END); grid = -1; return; }
        int dev = 0, cus = 0, per_cu = 0;
        if (hipGetDevice(&dev) != hipSuccess || hipDeviceGetAttribute(&cus, hipDeviceAttributeMultiprocessorCount, dev) != hipSuccess) { grid = -1; return; }
        if (hipFuncSetAttribute((const void*)mk_fwd, hipFuncAttributeMaxDynamicSharedMemorySize, LDS_BYTES) != hipSuccess) { fprintf(stderr, "kernel_launch: hipFuncSetAttribute failed\n"); grid = -1; return; }
        if (hipOccupancyMaxActiveBlocksPerMultiprocessor(&per_cu, (const void*)mk_fwd, NWAVES * 64, LDS_BYTES) != hipSuccess || per_cu < 1)
            fprintf(stderr, "kernel_launch: note: occupancy query reports %d workgroups per CU\n", per_cu);
        (void)hipGetLastError();
        grid = cus;
    }
    if (grid < 0) return;
    if (hipMemsetAsync((char*)d_ws + WS_CTL, 0, CTL_ZERO_BYTES, stream) != hipSuccess) { fprintf(stderr, "kernel_launch: memset failed\n"); return; }
    Args a{};
    for (int i = 0; i < 17; ++i) a.in[i] = (const float*)d_in[i];
    a.out = (float*)d_out; a.ws = (unsigned char*)d_ws;
    hipLaunchKernelGGL(mk_fwd, dim3(grid), dim3(NWAVES * 64), LDS_BYTES, stream, a);
    const hipError_t le = hipPeekAtLastError();
    if (le != hipSuccess) fprintf(stderr, "kernel_launch: launch failed: %s\n", hipGetErrorName(le));
}
```

```cpp
#include <hip/hip_runtime.h>
#include <cstdio>
#include <cstdint>

#ifndef DBG_MODE
#define DBG_MODE 0
#endif
constexpr int DM = 2048, NB = 4, SEQ = 4096, MTOK = NB * SEQ;
constexpr int INW = 14336, PJW = 8192, GTW = 6144;
constexpr int COL_DIL = 512, COL_DIFF = 5120;
constexpr int NEXP = 16384;
constexpr float RMS_EPS = 1e-6f;

typedef unsigned short bf16;
#define GAS __attribute__((address_space(1)))
#define LAS __attribute__((address_space(3)))
typedef unsigned v4u __attribute__((ext_vector_type(4)));
typedef float f32x4 __attribute__((ext_vector_type(4)));
typedef GAS unsigned gu32;

__device__ __forceinline__ int opaque_tid(int wave_sgpr) { int l; asm volatile("v_mbcnt_lo_u32_b32 %0, -1, 0\n\tv_mbcnt_hi_u32_b32 %0, -1, %0" : "=v"(l)); return wave_sgpr * 64 + l; }
namespace pg8 {
#define PG8_LAS __attribute__((address_space(3)))
typedef unsigned short bf16_t;
typedef short bf16x8 __attribute__((ext_vector_type(8)));
typedef float f32x4 __attribute__((ext_vector_type(4)));
typedef unsigned u32x4 __attribute__((ext_vector_type(4)));
typedef unsigned u32x2 __attribute__((ext_vector_type(2)));
typedef int i32x4 __attribute__((ext_vector_type(4)));
typedef int i32x8 __attribute__((ext_vector_type(8)));
constexpr int BM = 256, BK = 64, HALF = 128, HTB = HALF * BK * 2, STAGE_BYTES = 8 * HTB, NXCD = 8, WGM = 8;

__host__ __device__ __forceinline__ int lds_byte(int r, int c) { const int st = (r >> 4) * 2 + (c >> 5), rr = r & 15, cc = c & 31, ob = rr * 64 + cc * 2; return st * 1024 + (ob ^ (((ob >> 9) & 1) << 5)); }
__host__ __device__ __forceinline__ void stage_rc(int b, int& R, int& C) { const int st = b / 1024, sb = b % 1024, swz = sb ^ (((sb >> 9) & 1) << 5); R = (st >> 1) * 16 + swz / 64; C = (st & 1) * 32 + (swz % 64) / 2; }
__host__ __device__ __forceinline__ int perm32(int rho) { const int n = rho >> 4, i = rho & 15; return 8 * (i >> 2) + 4 * n + (i & 3); }

struct Unit { int pm, pn; long aoff, boff; int orow, ocol, sub; };
struct Gemm { const bf16_t* A; const bf16_t* Bt; };

struct StaticOrder {
    int nM, nN, nwg, G, c; long sa, sb;
    __device__ void init(int M, int N, int G_, int c_, int lda, int ldb) { nM = M / BM; nN = N / BM; nwg = nM * nN; G = G_; c = c_; sa = 512L * lda; sb = 512L * ldb; }
    __device__ bool next(int i, Unit& u) const {
        const long L = (long)i * G + c; if (L >= nwg) return false;
        int wgid = (int)L; { const int q = nwg / NXCD, r = nwg % NXCD, xcd = wgid % NXCD, off = wgid / NXCD; wgid = (xcd < r ? xcd * (q + 1) : r * (q + 1) + (xcd - r) * q) + off; }
        const int nig = WGM * nN, gid = wgid / nig, fm = gid * WGM, gsz = (nM - fm) < WGM ? (nM - fm) : WGM;
        u.pm = fm + ((wgid % nig) % gsz); u.pn = (wgid % nig) / gsz;
        u.aoff = u.pm * sa; u.boff = u.pn * sb; u.orow = u.pm * BM; u.ocol = u.pn * BM; u.sub = 0; return true;
    }
};
struct MergeOrder : StaticOrder {
    __device__ bool next(int i, Unit& u) const { if (!StaticOrder::next(i >> 2, u)) return false; u.sub = i & 3; u.aoff += 1024L * u.sub; u.boff += 1024L * u.sub; return true; }
};
struct F2Order : StaticOrder {
    __device__ bool next(int i, Unit& u) const { if (!StaticOrder::next(i, u)) return false; u.orow = (u.pn >> 1) * 4096 + u.pm * BM; u.ocol = (u.pn & 1) * BM; return true; }
};
struct F1Order {
    int G, c;
    __device__ bool next(int i, Unit& u) const {
        const int idx = i * G + c; if (idx >= 256) return false;
        const int bg = idx >> 4, st = idx & 15, b = bg >> 2, g = bg & 3;
        u.pm = 0; u.pn = idx; u.aoff = 0; u.boff = ((long)(b * 4096 + st * 256) * PJW + g * 128) * 2; u.orow = bg * 128; u.ocol = st * 256; return true;
    }
};

__device__ __forceinline__ unsigned cvt_pk_bf16(float lo, float hi) { unsigned r; asm volatile("v_cvt_pk_bf16_f32 %0, %1, %2" : "=v"(r) : "v"(lo), "v"(hi)); return r; }
__device__ __forceinline__ float bf_lo(unsigned w) { return __uint_as_float(w << 16); }
__device__ __forceinline__ float bf_hi(unsigned w) { return __uint_as_float(w & 0xffff0000u); }

#define PG8_PACK(v0, v1, w) do { (w).x = cvt_pk_bf16((v0)[0], (v0)[1]); (w).y = cvt_pk_bf16((v0)[2], (v0)[3]); (w).z = cvt_pk_bf16((v1)[0], (v1)[1]); (w).w = cvt_pk_bf16((v1)[2], (v1)[3]); } while (0)

struct EpiStore {
    static constexpr bool PERM = true;
    bf16_t* O; int ldo;
    __device__ __forceinline__ bool operator()(f32x4 (&acc)[2][2][4][2], const Unit& u, int wr, int wc, int, int) const {
        const int l = opaque_tid(0), fr = l & 15, fq = l >> 4;
        const int row0 = u.orow + wr * 64 + fr, col0 = u.ocol + wc * 32 + 8 * fq;
#pragma unroll
        for (int ai = 0; ai < 2; ++ai)
#pragma unroll
            for (int m = 0; m < 4; ++m) { bf16_t* rowp = O + (size_t)(row0 + ai * HALF + m * 16) * ldo + col0;
#pragma unroll
                for (int bj = 0; bj < 2; ++bj) { u32x4 w; PG8_PACK(acc[ai][bj][m][0], acc[ai][bj][m][1], w); *(u32x4*)(rowp + bj * HALF) = w; } }
        return true;
    }
};
struct EpiF2 {
    static constexpr bool PERM = true;
    bf16_t* O;
    __device__ __forceinline__ bool operator()(f32x4 (&acc)[2][2][4][2], const Unit& u, int wr, int wc, int fr, int fq) const {
        const int b = u.pn >> 1, gcol0 = (u.pn & 1) * BM + wc * 32 + 8 * fq;
#pragma unroll
        for (int ai = 0; ai < 2; ++ai)
#pragma unroll
            for (int m = 0; m < 4; ++m) { const int sp = u.pm * BM + ai * HALF + wr * 64 + m * 16 + fr;
#pragma unroll
                for (int bj = 0; bj < 2; ++bj) { const int gcol = gcol0 + bj * HALF; u32x4 w; PG8_PACK(acc[ai][bj][m][0], acc[ai][bj][m][1], w);
                    if (sp <= 2048) *(u32x4*)(O + (size_t)(b * 4096 + sp) * DM + gcol) = w;
                    if (sp >= 1 && sp <= 2047) { bf16_t* mr = O + (size_t)(b * 4096 + 4096 - sp) * DM + (gcol & ~127); const int c0 = gcol & 127;
                        mr[(128 - c0) & 127] = (bf16_t)(w.x & 0xffffu); mr[127 - c0] = (bf16_t)(w.x >> 16); mr[126 - c0] = (bf16_t)(w.y & 0xffffu); mr[125 - c0] = (bf16_t)(w.y >> 16);
                        mr[124 - c0] = (bf16_t)(w.z & 0xffffu); mr[123 - c0] = (bf16_t)(w.z >> 16); mr[122 - c0] = (bf16_t)(w.w & 0xffffu); mr[121 - c0] = (bf16_t)(w.w >> 16); } } }
        return true;
    }
};
struct EpiZT {
    static constexpr bool PERM = true;
    bf16_t* O;
    __device__ __forceinline__ bool operator()(f32x4 (&acc)[2][2][4][2], const Unit& u, int wr, int wc, int fr, int fq) const {
        const int row0 = u.orow + wr * 64 + fr, col0 = u.ocol + wc * 32 + 8 * fq;
#pragma unroll
        for (int ai = 0; ai < 2; ++ai)
#pragma unroll
            for (int m = 0; m < 4; ++m) { bf16_t* rowp = O + (size_t)(row0 + m * 16) * 8192 + ai * 4096 + col0;
#pragma unroll
                for (int bj = 0; bj < 2; ++bj) { u32x4 w; PG8_PACK(acc[ai][bj][m][0], acc[ai][bj][m][1], w); *(u32x4*)(rowp + bj * HALF) = w; } }
        return true;
    }
};
struct EpiProj {
    static constexpr bool PERM = true;
    bf16_t* P; unsigned char* Gt; const float* bg; int split, off_lo, off_hi; float scale;
    __device__ __forceinline__ bool operator()(f32x4 (&acc)[2][2][4][2], const Unit& u, int wr, int wc, int fr, int fq) const {
        const int pnn = u.pn < split ? u.pn + off_lo : u.pn + off_hi; const bool isg = pnn >= 32;
        const int row0 = u.pm * BM + wr * 64 + fr, col0 = (isg ? pnn - 32 : pnn) * BM + wc * 32 + 8 * fq;
        f32x4 bv[2][2];
#pragma unroll
        for (int bj = 0; bj < 2; ++bj)
#pragma unroll
            for (int n = 0; n < 2; ++n) bv[bj][n] = isg ? *(const f32x4*)(bg + col0 + bj * HALF + 4 * n) : (f32x4){0.f, 0.f, 0.f, 0.f};
#pragma unroll
        for (int ai = 0; ai < 2; ++ai)
#pragma unroll
            for (int m = 0; m < 4; ++m) { const size_t r = (size_t)(row0 + ai * HALF + m * 16);
#pragma unroll
                for (int bj = 0; bj < 2; ++bj) { f32x4 v0 = acc[ai][bj][m][0] * scale + bv[bj][0], v1 = acc[ai][bj][m][1] * scale + bv[bj][1];
                    if (isg) { unsigned q0[4], q1[4];
#pragma unroll
                        for (int j = 0; j < 4; ++j) { const float g0 = __builtin_amdgcn_rcpf(1.0f + __builtin_amdgcn_exp2f(-1.4426950408889634f * v0[j])), g1 = __builtin_amdgcn_rcpf(1.0f + __builtin_amdgcn_exp2f(-1.4426950408889634f * v1[j]));
                            const int i0 = (int)(g0 * 256.f), i1 = (int)(g1 * 256.f); q0[j] = (unsigned)(i0 > 255 ? 255 : i0); q1[j] = (unsigned)(i1 > 255 ? 255 : i1); }
                        u32x2 w; w.x = q0[0] | (q0[1] << 8) | (q0[2] << 16) | (q0[3] << 24); w.y = q1[0] | (q1[1] << 8) | (q1[2] << 16) | (q1[3] << 24);
                        *(u32x2*)(Gt + r * GTW + col0 + bj * HALF) = w;
                    } else { u32x4 w; PG8_PACK(v0, v1, w); *(u32x4*)(P + r * PJW + col0 + bj * HALF) = w; } } }
        return true;
    }
};
struct EpiMerge4 {
    static constexpr bool PERM = true;
    const unsigned char* Gt; bf16_t* O;
#define MG_U(w, k) ((float)(((w) >> (8 * (k))) & 0xffu) + 0.5f)
    __device__ __forceinline__ bool operator()(f32x4 (&acc)[2][2][4][2], const Unit& u, int wr, int wc, int fr, int fq) const {
        const int row0 = u.pm * BM + wr * 64 + fr, col0 = u.pn * BM + wc * 32 + 8 * fq;
        if (u.sub == 2) return false;
        if (u.sub < 2) {
            const unsigned char* gp0 = Gt + (size_t)row0 * GTW + u.sub * DM + col0;
            u32x2 gn[2][2], gd[2][2];
#define MG_LD(st, sx) do { const unsigned char* gp_ = gp0 + (size_t)(((sx) >> 2) * HALF + ((sx) & 3) * 16) * GTW; gn[st][0] = *(const u32x2*)gp_; gd[st][0] = *(const u32x2*)(gp_ + DM); gn[st][1] = *(const u32x2*)(gp_ + HALF); gd[st][1] = *(const u32x2*)(gp_ + DM + HALF); } while (0)
            MG_LD(0, 0);
#pragma unroll
            for (int sx = 0; sx < 8; ++sx) { const int ai = sx >> 2, m = sx & 3, st = sx & 1;
                if (sx + 1 < 8) MG_LD((sx + 1) & 1, sx + 1);
                asm volatile("" ::: "memory");
#pragma unroll
                for (int bj = 0; bj < 2; ++bj) { const u32x2 n2 = gn[st][bj], d2 = gd[st][bj];
                    f32x4 r0, r1;
#pragma unroll
                    for (int k = 0; k < 4; ++k) { r0[k] = MG_U(n2.x, k) * __builtin_amdgcn_rcpf(MG_U(d2.x, k)); r1[k] = MG_U(n2.y, k) * __builtin_amdgcn_rcpf(MG_U(d2.y, k)); }
                    acc[ai][bj][m][0] *= r0; acc[ai][bj][m][1] *= r1; } }
#undef MG_LD
            return false;
        }
        {
            const unsigned char* gp0 = Gt + (size_t)row0 * GTW + 2 * DM + col0; bf16_t* op0 = O + (size_t)row0 * DM + col0;
            u32x2 gg[2][2];
#define MG_LD(st, sx) do { const unsigned char* gp_ = gp0 + (size_t)(((sx) >> 2) * HALF + ((sx) & 3) * 16) * GTW; gg[st][0] = *(const u32x2*)gp_; gg[st][1] = *(const u32x2*)(gp_ + HALF); } while (0)
            MG_LD(0, 0);
#pragma unroll
            for (int sx = 0; sx < 8; ++sx) { const int ai = sx >> 2, m = sx & 3, st = sx & 1;
                if (sx + 1 < 8) MG_LD((sx + 1) & 1, sx + 1);
                asm volatile("" ::: "memory");
                bf16_t* rowp = op0 + (size_t)(ai * HALF + m * 16) * DM;
#pragma unroll
                for (int bj = 0; bj < 2; ++bj) { const u32x2 g = gg[st][bj];
                    f32x4 v0 = acc[ai][bj][m][0], v1 = acc[ai][bj][m][1];
#pragma unroll
                    for (int k = 0; k < 4; ++k) { v0[k] *= MG_U(g.x, k) * (1.f / 256.f); v1[k] *= MG_U(g.y, k) * (1.f / 256.f); }
                    u32x4 w; PG8_PACK(v0, v1, w); *(u32x4*)(rowp + bj * HALF) = w; } }
#undef MG_LD
        }
        return true;
    }
#undef MG_U
};
struct EpiResF32 {
    static constexpr bool PERM = false;
    const float* base; float* out; int ldc;
    __device__ __forceinline__ bool operator()(f32x4 (&acc)[2][2][4][2], const Unit& u, int wr, int wc, int fr, int fq) const {
        const int row0 = u.orow + wr * 64 + fr, col0 = u.ocol + wc * 32 + 4 * fq;
        if (base) {
            f32x4 bb[2][4];
#define RS_LD(st, sx) do { const float* bp_ = base + (size_t)(row0 + ((sx) >> 2) * HALF + ((sx) & 3) * 16) * ldc + col0; bb[st][0] = *(const f32x4*)bp_; bb[st][1] = *(const f32x4*)(bp_ + 16); bb[st][2] = *(const f32x4*)(bp_ + HALF); bb[st][3] = *(const f32x4*)(bp_ + HALF + 16); } while (0)
            RS_LD(0, 0);
#pragma unroll
            for (int sx = 0; sx < 8; ++sx) { const int ai = sx >> 2, m = sx & 3, st = sx & 1;
                if (sx + 1 < 8) RS_LD((sx + 1) & 1, sx + 1);
                asm volatile("" ::: "memory");
                float* op = out + (size_t)(row0 + ai * HALF + m * 16) * ldc + col0;
#pragma unroll
                for (int bj = 0; bj < 2; ++bj)
#pragma unroll
                    for (int n = 0; n < 2; ++n) *(f32x4*)(op + bj * HALF + n * 16) = acc[ai][bj][m][n] + bb[st][bj * 2 + n]; }
#undef RS_LD
            return true;
        }
#pragma unroll
        for (int ai = 0; ai < 2; ++ai)
#pragma unroll
            for (int m = 0; m < 4; ++m) { const size_t off = (size_t)(row0 + ai * HALF + m * 16) * ldc + col0;
#pragma unroll
                for (int bj = 0; bj < 2; ++bj)
#pragma unroll
                    for (int n = 0; n < 2; ++n) *(f32x4*)(out + off + bj * HALF + n * 16) = acc[ai][bj][m][n];
                asm volatile("" ::: "memory"); }
        return true;
    }
};

constexpr float XS8 = 12.f;
__device__ __forceinline__ unsigned q8fix(const f32x4 v) {
    const int a = (int)__builtin_rintf(fminf(fmaxf(v[0] * XS8, -127.f), 127.f)), b = (int)__builtin_rintf(fminf(fmaxf(v[1] * XS8, -127.f), 127.f)),
              c = (int)__builtin_rintf(fminf(fmaxf(v[2] * XS8, -127.f), 127.f)), d = (int)__builtin_rintf(fminf(fmaxf(v[3] * XS8, -127.f), 127.f));
    return (unsigned)(a & 0xff) | ((unsigned)(b & 0xff) << 8) | ((unsigned)(c & 0xff) << 16) | ((unsigned)(d & 0xff) << 24);
}
__device__ __forceinline__ float fq_sum(float v) {
    v += __int_as_float(__builtin_amdgcn_ds_swizzle(__float_as_int(v), 0x1f | (16 << 10)));
    auto rr = __builtin_amdgcn_permlane32_swap(__float_as_uint(v), __float_as_uint(v), false, false); return __uint_as_float(rr[0]) + __uint_as_float(rr[1]);
}
struct EpiResX {
    static constexpr bool PERM = true;
    const float* base32; const bf16_t* base16; bf16_t* out; unsigned char* x8; float* ssp;
    __device__ __forceinline__ bool operator()(f32x4 (&acc)[2][2][4][2], const Unit& u, int wr, int wc, int fr, int fq) const {
        const int row0 = u.orow + wr * 64 + fr, col0 = u.ocol + wc * 32 + 8 * fq;
        bf16_t* op0 = out + (size_t)row0 * DM + col0; unsigned char* xp0 = x8 + (size_t)row0 * DM + col0;
        float ss[8];
        if (base32) {
            const float* bp0 = base32 + (size_t)row0 * DM + col0;
            f32x4 bb[2][4];
#define RX_LD(st, sx) do { const float* bp_ = bp0 + (size_t)(((sx) >> 2) * HALF + ((sx) & 3) * 16) * DM; bb[st][0] = *(const f32x4*)bp_; bb[st][1] = *(const f32x4*)(bp_ + 4); bb[st][2] = *(const f32x4*)(bp_ + HALF); bb[st][3] = *(const f32x4*)(bp_ + HALF + 4); } while (0)
            RX_LD(0, 0);
#pragma unroll
            for (int sx = 0; sx < 8; ++sx) { const int ai = sx >> 2, m = sx & 3, st = sx & 1;
                if (sx + 1 < 8) RX_LD((sx + 1) & 1, sx + 1);
                asm volatile("" ::: "memory");
                const size_t ro = (size_t)(ai * HALF + m * 16) * DM; float sq = 0.f;
#pragma unroll
                for (int bj = 0; bj < 2; ++bj) { const f32x4 v0 = acc[ai][bj][m][0] + bb[st][2 * bj], v1 = acc[ai][bj][m][1] + bb[st][2 * bj + 1];
                    sq += (v0[0] * v0[0] + v0[1] * v0[1]) + (v0[2] * v0[2] + v0[3] * v0[3]) + (v1[0] * v1[0] + v1[1] * v1[1]) + (v1[2] * v1[2] + v1[3] * v1[3]);
                    u32x4 w; PG8_PACK(v0, v1, w); *(u32x4*)(op0 + ro + bj * HALF) = w;
                    u32x2 w8; w8.x = q8fix(v0); w8.y = q8fix(v1); *(u32x2*)(xp0 + ro + bj * HALF) = w8; }
                ss[sx] = sq; }
#undef RX_LD
        } else {
            const bf16_t* bp0 = base16 + (size_t)row0 * DM + col0;
            u32x4 bb[2][2];
#define RX_LD(st, sx) do { const bf16_t* bp_ = bp0 + (size_t)(((sx) >> 2) * HALF + ((sx) & 3) * 16) * DM; bb[st][0] = *(const u32x4*)bp_; bb[st][1] = *(const u32x4*)(bp_ + HALF); } while (0)
            RX_LD(0, 0);
#pragma unroll
            for (int sx = 0; sx < 8; ++sx) { const int ai = sx >> 2, m = sx & 3, st = sx & 1;
                if (sx + 1 < 8) RX_LD((sx + 1) & 1, sx + 1);
                asm volatile("" ::: "memory");
                const size_t ro = (size_t)(ai * HALF + m * 16) * DM; float sq = 0.f;
#pragma unroll
                for (int bj = 0; bj < 2; ++bj) { const u32x4 b = bb[st][bj]; f32x4 v0 = acc[ai][bj][m][0], v1 = acc[ai][bj][m][1];
                    v0[0] += bf_lo(b.x); v0[1] += bf_hi(b.x); v0[2] += bf_lo(b.y); v0[3] += bf_hi(b.y); v1[0] += bf_lo(b.z); v1[1] += bf_hi(b.z); v1[2] += bf_lo(b.w); v1[3] += bf_hi(b.w);
                    sq += (v0[0] * v0[0] + v0[1] * v0[1]) + (v0[2] * v0[2] + v0[3] * v0[3]) + (v1[0] * v1[0] + v1[1] * v1[1]) + (v1[2] * v1[2] + v1[3] * v1[3]);
                    u32x4 w; PG8_PACK(v0, v1, w); *(u32x4*)(op0 + ro + bj * HALF) = w;
                    u32x2 w8; w8.x = q8fix(v0); w8.y = q8fix(v1); *(u32x2*)(xp0 + ro + bj * HALF) = w8; }
                ss[sx] = sq; }
#undef RX_LD
        }
#pragma unroll
        for (int sx = 0; sx < 8; ++sx) { const float t = fq_sum(ss[sx]); if (fq == 0) ssp[(size_t)(row0 + (sx >> 2) * HALF + (sx & 3) * 16) * 32 + u.pn * 4 + wc] = t; }
        return true;
    }
};
struct EpiStoreRS {
    static constexpr bool PERM = true;
    bf16_t* O; int ldo; const float* ssp;
    __device__ __forceinline__ bool operator()(f32x4 (&acc)[2][2][4][2], const Unit& u, int wr, int wc, int, int) const {
        const int l = opaque_tid(0), fr = l & 15, fq = l >> 4;
        const int row0 = u.orow + wr * 64 + fr, col0 = u.ocol + wc * 32 + 8 * fq;
#pragma unroll
        for (int ai = 0; ai < 2; ++ai)
#pragma unroll
            for (int m = 0; m < 4; ++m) { const int row = row0 + ai * HALF + m * 16;
                const f32x4 p0 = *(const f32x4*)(ssp + (size_t)row * 32 + fq * 8), p1 = *(const f32x4*)(ssp + (size_t)row * 32 + fq * 8 + 4);
                const float tot = fq_sum((p0[0] + p0[1]) + (p0[2] + p0[3]) + (p1[0] + p1[1]) + (p1[2] + p1[3]));
                const float rs = 1.0f / __builtin_sqrtf(tot * (1.f / DM) + RMS_EPS);
                bf16_t* rowp = O + (size_t)row * ldo + col0;
#pragma unroll
                for (int bj = 0; bj < 2; ++bj) { const f32x4 v0 = acc[ai][bj][m][0] * rs, v1 = acc[ai][bj][m][1] * rs; u32x4 w; PG8_PACK(v0, v1, w); *(u32x4*)(rowp + bj * HALF) = w; } }
        return true;
    }
};

template <class Epi, class Sched, bool ALIGN_EPI, int LDA, int LDB, int KK, bool F8 = false>
__device__ __forceinline__ void gemm_phase(PG8_LAS unsigned char* lds, const Gemm g, const Sched& S, const Epi& E, int wave0) {
    const int tid = opaque_tid(wave0), wid = wave0, lane = tid & 63, wr = wid >> 2, wc = wid & 3, fr = lane & 15, fq = lane >> 4;
    constexpr int nt = KK / BK;
    unsigned voffA[2], voffB[2];
#pragma unroll
    for (int i = 0; i < 2; ++i) { int R, C; stage_rc(tid * 16 + i * 8192, R, C); const int Rb = Epi::PERM ? ((R & ~31) + perm32(R & 31)) : R;
        voffA[i] = (unsigned)(R * LDA + C) * 2u; voffB[i] = (unsigned)(Rb * LDB + C) * 2u; }
    const size_t kstep = (size_t)(BK * 2);
    constexpr size_t hstepA = (size_t)HALF * LDA * 2, hstepB = (size_t)HALF * LDB * 2;
    const unsigned ldsw = (unsigned)wid * 1024u;
    const int aoff = lds_byte(wr * 64 + fr, fq * 8), boff = lds_byte(wc * 32 + fr, fq * 8);
#define PG8_SA(b, h) (((b) * 2 + (h)) * HTB)
#define PG8_SB(b, h) ((4 + (b) * 2 + (h)) * HTB)
#define PG8_STAGE(bufoff, gbase, voff) do { _Pragma("unroll") for (int _i = 0; _i < 2; ++_i) \
        __builtin_amdgcn_global_load_lds((const unsigned*)((const char*)(gbase) + (voff)[_i]), (PG8_LAS unsigned*)(lds + (bufoff) + ldsw + _i * 8192), 16, 0, 0); } while (0)
#define PG8_LDA(dst, b, h) do { _Pragma("unroll") for (int m = 0; m < 4; ++m) _Pragma("unroll") for (int k = 0; k < 2; ++k) dst[m][k] = *(const PG8_LAS bf16x8*)(lds + PG8_SA(b, h) + aoff + m * 2048 + k * 1024); } while (0)
#define PG8_LDB(dst, b, h) do { _Pragma("unroll") for (int n = 0; n < 2; ++n) _Pragma("unroll") for (int k = 0; k < 2; ++k) dst[n][k] = *(const PG8_LAS bf16x8*)(lds + PG8_SB(b, h) + boff + n * 2048 + k * 1024); } while (0)
#define PG8_CAT(x) __builtin_shufflevector(__builtin_bit_cast(i32x4, (x)[0]), __builtin_bit_cast(i32x4, (x)[1]), 0, 1, 2, 3, 4, 5, 6, 7)
#define PG8_MMA(ai, bj, At, Bt) do { __builtin_amdgcn_s_setprio(1); _Pragma("unroll") for (int m = 0; m < 4; ++m) _Pragma("unroll") for (int n = 0; n < 2; ++n) { \
        if constexpr (F8) { const i32x8 a8_ = PG8_CAT(Bt[n]), b8_ = PG8_CAT(At[m]); asm volatile("v_mfma_scale_f32_16x16x128_f8f6f4 %0, %1, %2, %0, %3, %3 op_sel_hi:[0,0,0]" : "+v"(acc[ai][bj][m][n]) : "v"(a8_), "v"(b8_), "v"(one8)); } \
        else { _Pragma("unroll") for (int k = 0; k < 2; ++k) acc[ai][bj][m][n] = __builtin_amdgcn_mfma_f32_16x16x32_bf16(Bt[n][k], At[m][k], acc[ai][bj][m][n], 0, 0, 0); } } __builtin_amdgcn_s_setprio(0); } while (0)
#define PG8_WAIT_V(n) asm volatile("s_waitcnt vmcnt(" #n ")" ::: "memory")
#define PG8_WAIT_L(n) asm volatile("s_waitcnt lgkmcnt(" #n ")" ::: "memory")
#define PG8_BAR __builtin_amdgcn_s_barrier()
#define PG8_SCHED __builtin_amdgcn_sched_barrier(0)
    Unit cur, nxt; int ui = 0;
    if (!S.next(0, cur)) return;
    const int one8 = 0x7f7f7f7f; (void)one8;
    f32x4 acc[2][2][4][2];
#pragma unroll
    for (int a = 0; a < 2; ++a)
#pragma unroll
        for (int b = 0; b < 2; ++b)
#pragma unroll
            for (int m = 0; m < 4; ++m)
#pragma unroll
                for (int n = 0; n < 2; ++n) acc[a][b][m][n] = (f32x4){0.f, 0.f, 0.f, 0.f};
    bf16x8 At[4][2], B0[2][2], B1[2][2];
    const char* cA = (const char*)g.A + cur.aoff; const char* cB = (const char*)g.Bt + cur.boff;
    PG8_STAGE(PG8_SB(0, 0), cB, voffB); PG8_STAGE(PG8_SB(0, 1), cB + hstepB, voffB); PG8_STAGE(PG8_SA(0, 0), cA, voffA); PG8_STAGE(PG8_SA(0, 1), cA + hstepA, voffA);
    if (wr == 1) PG8_BAR;
    PG8_WAIT_V(2); PG8_BAR;
    PG8_STAGE(PG8_SB(1, 0), cB + kstep, voffB); PG8_STAGE(PG8_SA(1, 0), cA + kstep, voffA); PG8_STAGE(PG8_SB(1, 1), cB + hstepB + kstep, voffB);
    PG8_WAIT_V(6); PG8_BAR;
    for (;;) {
        const bool has_next = S.next(ui + 1, nxt);
        const char* nA = has_next ? (const char*)g.A + nxt.aoff : cA; const char* nB = has_next ? (const char*)g.Bt + nxt.boff : cB;
        for (int t = 0; t < nt; t += 2) {
            const bool last = (t == nt - 2);
            const char* a1 = cA + (size_t)(t + 1) * kstep;
            const char* a2 = last ? nA : cA + (size_t)(t + 2) * kstep; const char* b2 = last ? nB : cB + (size_t)(t + 2) * kstep;
            const char* a3 = a2 + kstep; const char* b3 = b2 + kstep;
            PG8_LDB(B0, 0, 0); PG8_LDB(B1, 0, 1); PG8_SCHED; PG8_LDA(At, 0, 0); PG8_STAGE(PG8_SA(1, 1), a1 + hstepA, voffA);
            PG8_WAIT_V(8); PG8_WAIT_L(0); PG8_BAR; PG8_MMA(0, 0, At, B0); PG8_MMA(0, 1, At, B1); PG8_BAR; PG8_SCHED;
            PG8_LDA(At, 0, 1); PG8_STAGE(PG8_SB(0, 0), b2, voffB); PG8_STAGE(PG8_SB(0, 1), b2 + hstepB, voffB); PG8_STAGE(PG8_SA(0, 0), a2, voffA);
            PG8_WAIT_V(8); PG8_WAIT_L(0); PG8_BAR; PG8_MMA(1, 0, At, B0); PG8_MMA(1, 1, At, B1); PG8_BAR; PG8_SCHED;
            PG8_LDB(B0, 1, 0); PG8_LDB(B1, 1, 1); PG8_SCHED; PG8_LDA(At, 1, 0); PG8_STAGE(PG8_SA(0, 1), a2 + hstepA, voffA);
            PG8_WAIT_V(8); PG8_WAIT_L(0); PG8_BAR; PG8_MMA(0, 0, At, B0); PG8_MMA(0, 1, At, B1); PG8_BAR; PG8_SCHED;
            PG8_LDA(At, 1, 1); PG8_STAGE(PG8_SB(1, 0), b3, voffB); PG8_STAGE(PG8_SB(1, 1), b3 + hstepB, voffB); PG8_STAGE(PG8_SA(1, 0), a3, voffA);
            PG8_WAIT_V(8); PG8_WAIT_L(0); PG8_BAR; PG8_MMA(1, 0, At, B0); PG8_MMA(1, 1, At, B1); PG8_BAR; PG8_SCHED;
        }
        if constexpr (ALIGN_EPI) { if (wr == 0) PG8_BAR; }
        if constexpr (F8) asm volatile("s_nop 15\n\ts_nop 15" ::: "memory");
        const bool fin = E(acc, cur, wr, wc, fr, fq);
        if (!has_next) break;
        if (fin) {
#pragma unroll
        for (int a = 0; a < 2; ++a)
#pragma unroll
            for (int b = 0; b < 2; ++b)
#pragma unroll
                for (int m = 0; m < 4; ++m)
#pragma unroll
                    for (int n = 0; n < 2; ++n) acc[a][b][m][n] = (f32x4){0.f, 0.f, 0.f, 0.f};
        }
        cur = nxt; cA = nA; cB = nB; ++ui;
        if constexpr (ALIGN_EPI) { if (wr == 1) PG8_BAR; }
    }
    PG8_WAIT_V(0);
    if constexpr (!ALIGN_EPI) { if (wr == 0) PG8_BAR; }
    PG8_BAR;
#undef PG8_SA
#undef PG8_SB
#undef PG8_STAGE
#undef PG8_LDA
#undef PG8_LDB
#undef PG8_MMA
#undef PG8_CAT
#undef PG8_WAIT_V
#undef PG8_WAIT_L
#undef PG8_BAR
#undef PG8_SCHED
}
}

namespace attn {
using bf16x8 = __attribute__((ext_vector_type(8))) short;
using s16x4  = __attribute__((ext_vector_type(4))) short;
using f32x16 = __attribute__((ext_vector_type(16))) float;
using u32x4  = __attribute__((ext_vector_type(4))) unsigned;
constexpr int   D = 128, NW = 8, QBLK = 32, KVBLK = 64;
constexpr float SCALE = 0.088388347648318440f;
constexpr float THR = 8.f;
constexpr size_t SHM_V = KVBLK * D * 2, SHM_K = KVBLK * D * 2;
constexpr int NBUF = 3;
constexpr int LDS_K0 = NBUF * (int)SHM_V, LDS_TAB = LDS_K0 + NBUF * (int)SHM_K, LDS_END = LDS_TAB + 8192 * 4, LDS_WS = 131072 + 8192;
#define KSWZ(row, colB) ((row) * 256 + ((colB) ^ (((row) & 7) << 4)))
#define SBAR() __builtin_amdgcn_sched_barrier(0)
__device__ __forceinline__ int crow(int r, int hi) { return (r & 3) + 8 * (r >> 2) + 4 * hi; }
__device__ __forceinline__ unsigned cvtpk(float lo, float hi) { unsigned r; asm volatile("v_cvt_pk_bf16_f32 %0, %1, %2" : "=v"(r) : "v"(lo), "v"(hi)); return r; }

__device__ __forceinline__ void partialSM(f32x16& p0, f32x16& p1, float& m_reg, float& mn, float& alpha) {
  constexpr float C = SCALE * 1.4426950408889634f;
  float pmax = p0[0]; for (int r = 1; r < 16; ++r) pmax = fmaxf(pmax, p0[r]); for (int r = 0; r < 16; ++r) pmax = fmaxf(pmax, p1[r]);
  { auto rr = __builtin_amdgcn_permlane32_swap(__float_as_uint(pmax), __float_as_uint(pmax), false, false);
    pmax = fmaxf(__uint_as_float(rr[0]), __uint_as_float(rr[1])); }
  if (__builtin_expect(__all(pmax - m_reg <= THR / SCALE), 1)) { mn = m_reg; alpha = 1.f; }
  else { mn = fmaxf(m_reg, pmax); alpha = __builtin_amdgcn_exp2f((m_reg - mn) * C); m_reg = mn; }
  float mnC = -mn * C;
  for (int r = 0; r < 16; ++r) p0[r] = fmaf(p0[r], C, mnC); for (int r = 0; r < 16; ++r) p1[r] = fmaf(p1[r], C, mnC);
  for (int r = 0; r < 16; ++r) p0[r] = __builtin_amdgcn_exp2f(p0[r]);
}
__device__ __forceinline__ void finishSM(f32x16& p0, f32x16& p1, float alpha, float& l_reg, bf16x8& pa0, bf16x8& pa1, bf16x8& pa2, bf16x8& pa3) {
  for (int r = 0; r < 16; ++r) p1[r] = __builtin_amdgcn_exp2f(p1[r]);
  float ps = 0; for (int r = 0; r < 16; ++r) ps += p0[r]; for (int r = 0; r < 16; ++r) ps += p1[r];
  { auto rr = __builtin_amdgcn_permlane32_swap(__float_as_uint(ps), __float_as_uint(ps), false, false);
    ps = __uint_as_float(rr[0]) + __uint_as_float(rr[1]); }
  l_reg = l_reg * alpha + ps;
#define PK4(P, BASE, OUT) do { unsigned a0 = cvtpk(P[BASE + 0], P[BASE + 1]), a1 = cvtpk(P[BASE + 2], P[BASE + 3]);   \
    unsigned b0 = cvtpk(P[BASE + 4], P[BASE + 5]), b1 = cvtpk(P[BASE + 6], P[BASE + 7]);                              \
    auto r0 = __builtin_amdgcn_permlane32_swap(a0, b0, false, false); auto r1 = __builtin_amdgcn_permlane32_swap(a1, b1, false, false); \
    u32x4 w = {r0[0], r1[0], r0[1], r1[1]}; OUT = *reinterpret_cast<bf16x8*>(&w); } while (0)
  PK4(p0, 0, pa0); PK4(p0, 8, pa1); PK4(p1, 0, pa2); PK4(p1, 8, pa3);
#undef PK4
}
__device__ __forceinline__ void qkt(f32x16& p0, f32x16& p1, const bf16* Ks, const bf16x8* qr, int r32, int hi, const float* tl) {
#pragma unroll
  for (int r = 0; r < 16; ++r) { p0[r] = tl[(r & 3) + 8 * (r >> 2)]; p1[r] = tl[32 + (r & 3) + 8 * (r >> 2)]; }
#pragma unroll
  for (int d0 = 0; d0 < 8; ++d0) { int cb = (d0 * 16 + hi * 8) * 2;
    bf16x8 b0 = *reinterpret_cast<const bf16x8*>((const char*)Ks + KSWZ(r32, cb));
    bf16x8 b1 = *reinterpret_cast<const bf16x8*>((const char*)Ks + KSWZ(32 + r32, cb));
    p0 = __builtin_amdgcn_mfma_f32_32x32x16_bf16(b0, qr[d0], p0, 0, 0, 0);
    p1 = __builtin_amdgcn_mfma_f32_32x32x16_bf16(b1, qr[d0], p1, 0, 0, 0); }
}
__device__ __forceinline__ int v_st(int k, int c) { const int kk = (k & ~0xC) | ((k & 4) << 1) | ((k & 8) >> 1); return ((kk >> 3) * 4 + (c >> 5)) * 512 + ((kk & 7) * 32 + (c & 31)) * 2; }
__device__ __forceinline__ int v_rd_base(int lane) { return ((lane & 3) << 3) | (((lane >> 2) & 3) << 6) | (((lane >> 4) & 1) << 5) | (((lane >> 5) & 1) << 8); }
constexpr int v_rd_off(int d0, int ks, int half) { return d0 * 512 + ks * 4096 + half * 2048; }
template <int OFF> __device__ __forceinline__ s16x4 tr_read(int vb) {
  s16x4 r; asm volatile("ds_read_b64_tr_b16 %0, %1 offset:%2" : "=&v"(r) : "v"(vb), "i"(OFF) : "memory"); return r;
}
template <int D0> __device__ __forceinline__ void pv_one(f32x16& od, int vb, bf16x8 pa0, bf16x8 pa1, bf16x8 pa2, bf16x8 pa3) {
  const s16x4 l0 = tr_read<v_rd_off(D0, 0, 0)>(vb), h0 = tr_read<v_rd_off(D0, 0, 1)>(vb), l1 = tr_read<v_rd_off(D0, 1, 0)>(vb), h1 = tr_read<v_rd_off(D0, 1, 1)>(vb);
  const s16x4 l2 = tr_read<v_rd_off(D0, 2, 0)>(vb), h2 = tr_read<v_rd_off(D0, 2, 1)>(vb), l3 = tr_read<v_rd_off(D0, 3, 0)>(vb), h3 = tr_read<v_rd_off(D0, 3, 1)>(vb);
  asm volatile("s_waitcnt lgkmcnt(0)" ::: "memory"); SBAR();
#define PK(L, H) (bf16x8){L[0], L[1], L[2], L[3], H[0], H[1], H[2], H[3]}
  od = __builtin_amdgcn_mfma_f32_32x32x16_bf16(pa0, PK(l0, h0), od, 0, 0, 0);
  od = __builtin_amdgcn_mfma_f32_32x32x16_bf16(pa1, PK(l1, h1), od, 0, 0, 0);
  od = __builtin_amdgcn_mfma_f32_32x32x16_bf16(pa2, PK(l2, h2), od, 0, 0, 0);
  od = __builtin_amdgcn_mfma_f32_32x32x16_bf16(pa3, PK(l3, h3), od, 0, 0, 0);
#undef PK
}
__device__ __forceinline__ void pv_d0(f32x16* o, int vb, bf16x8 pa0, bf16x8 pa1, bf16x8 pa2, bf16x8 pa3) {
  pv_one<0>(o[0], vb, pa0, pa1, pa2, pa3); pv_one<1>(o[1], vb, pa0, pa1, pa2, pa3); pv_one<2>(o[2], vb, pa0, pa1, pa2, pa3); pv_one<3>(o[3], vb, pa0, pa1, pa2, pa3);
}

struct VFrag { s16x4 l0, h0, l1, h1, l2, h2, l3, h3; };
template <int D0> __device__ __forceinline__ void v_issue(VFrag& f, int vb) {
  f.l0 = tr_read<v_rd_off(D0, 0, 0)>(vb); f.h0 = tr_read<v_rd_off(D0, 0, 1)>(vb); f.l1 = tr_read<v_rd_off(D0, 1, 0)>(vb); f.h1 = tr_read<v_rd_off(D0, 1, 1)>(vb);
  f.l2 = tr_read<v_rd_off(D0, 2, 0)>(vb); f.h2 = tr_read<v_rd_off(D0, 2, 1)>(vb); f.l3 = tr_read<v_rd_off(D0, 3, 0)>(vb); f.h3 = tr_read<v_rd_off(D0, 3, 1)>(vb);
}
__device__ __forceinline__ void v_mma(f32x16& od, const VFrag& f, bf16x8 pa0, bf16x8 pa1, bf16x8 pa2, bf16x8 pa3) {
#define PK(L, H) (bf16x8){L[0], L[1], L[2], L[3], H[0], H[1], H[2], H[3]}
  od = __builtin_amdgcn_mfma_f32_32x32x16_bf16(pa0, PK(f.l0, f.h0), od, 0, 0, 0);
  od = __builtin_amdgcn_mfma_f32_32x32x16_bf16(pa1, PK(f.l1, f.h1), od, 0, 0, 0);
  od = __builtin_amdgcn_mfma_f32_32x32x16_bf16(pa2, PK(f.l2, f.h2), od, 0, 0, 0);
  od = __builtin_amdgcn_mfma_f32_32x32x16_bf16(pa3, PK(f.l3, f.h3), od, 0, 0, 0);
#undef PK
}
__device__ __forceinline__ void pv_sm(f32x16* o, int vb, bf16x8 pa0, bf16x8 pa1, bf16x8 pa2, bf16x8 pa3, f32x16& p0, f32x16& p1, float& m_reg, float& mn, float& alpha) {
  constexpr float C = SCALE * 1.4426950408889634f;
  VFrag fa, fb;
  v_issue<0>(fa, vb); v_issue<1>(fb, vb);
  asm volatile("s_waitcnt lgkmcnt(8)" ::: "memory"); SBAR();
  v_mma(o[0], fa, pa0, pa1, pa2, pa3);
  float pmax = p0[0];
#pragma unroll
  for (int r = 1; r < 16; ++r) pmax = fmaxf(pmax, p0[r]);
#pragma unroll
  for (int r = 0; r < 16; ++r) pmax = fmaxf(pmax, p1[r]);
  v_issue<2>(fa, vb);
  asm volatile("s_waitcnt lgkmcnt(8)" ::: "memory"); SBAR();
  v_mma(o[1], fb, pa0, pa1, pa2, pa3);
  { auto rr = __builtin_amdgcn_permlane32_swap(__float_as_uint(pmax), __float_as_uint(pmax), false, false);
    pmax = fmaxf(__uint_as_float(rr[0]), __uint_as_float(rr[1])); }
  if (__builtin_expect(__all(pmax - m_reg <= THR / SCALE), 1)) { mn = m_reg; alpha = 1.f; }
  else { mn = fmaxf(m_reg, pmax); alpha = __builtin_amdgcn_exp2f((m_reg - mn) * C); m_reg = mn; }
  const float mnC = -mn * C;
#define PIN(x) do { float t_ = (x); asm volatile("" : "+v"(t_)); (x) = t_; } while (0)
#pragma unroll
  for (int r = 0; r < 16; ++r) { p0[r] = fmaf(p0[r], C, mnC); PIN(p0[r]); }
  v_issue<3>(fb, vb);
  asm volatile("s_waitcnt lgkmcnt(8)" ::: "memory"); SBAR();
  v_mma(o[2], fa, pa0, pa1, pa2, pa3);
#pragma unroll
  for (int r = 0; r < 16; ++r) { p1[r] = fmaf(p1[r], C, mnC); PIN(p1[r]); }
#pragma unroll
  for (int r = 0; r < 8; ++r) { p0[r] = __builtin_amdgcn_exp2f(p0[r]); PIN(p0[r]); }
  asm volatile("s_waitcnt lgkmcnt(0)" ::: "memory"); SBAR();
  v_mma(o[3], fb, pa0, pa1, pa2, pa3);
#pragma unroll
  for (int r = 8; r < 16; ++r) p0[r] = __builtin_amdgcn_exp2f(p0[r]);
#undef PIN
}

struct Unit { const bf16* Q; const bf16* K; const bf16* V; bf16* O; float* lse; long ldq, ldk, ldo; int lse_ld, kt0, nt, qoff; };
__device__ __forceinline__ void attn_unit(const Unit& u, char* lds, int wave0) {
  const int tid = opaque_tid(wave0), wid = wave0, lane = tid & 63, r32 = lane & 31, hi = lane >> 5;
  LAS unsigned char* ldsl = (LAS unsigned char*)lds;
  float* ws = (float*)(lds + LDS_WS) + wid * 64; float* li_l = ws; float* al_l = ws + 32;
  const float* tabL = (const float*)(lds + LDS_TAB);
  float m_reg = -1e30f, l_reg = 0; f32x16 o[4] = {}; bf16x8 qr[8];
  const bf16* Qw = u.Q + (long)(wid * QBLK + r32) * u.ldq + hi * 8;
#pragma unroll
  for (int d0 = 0; d0 < 8; ++d0) qr[d0] = *reinterpret_cast<const bf16x8*>(Qw + d0 * 16);
  const int vrd = (int)(uintptr_t)lds + v_rd_base(lane);
  const long tstep = (long)KVBLK * u.ldk * 2;
  const char* Kh = (const char*)u.K + (long)u.kt0 * tstep; const char* Vh = (const char*)u.V + (long)u.kt0 * tstep;
  unsigned kofs[2], vofs[2];
#pragma unroll
  for (int i = 0; i < 2; ++i) { const int rowk = (wid + 8 * i) * 4 + (lane >> 4), chunk = (lane & 15) ^ (rowk & 7); kofs[i] = (unsigned)(rowk * (int)u.ldk * 2 + chunk * 16);
    const int blk = (wid + 8 * i) * 2 + (lane >> 5), kk = (blk >> 2) * 8 + ((lane & 31) >> 2), c = (blk & 3) * 32 + (lane & 3) * 8, k = (kk & ~0xC) | ((kk & 4) << 1) | ((kk & 8) >> 1);
    vofs[i] = (unsigned)((k * (int)u.ldk + c) * 2); }
  const float* tl0 = tabL + (4096 + u.kt0 * KVBLK + 4 * hi - (u.qoff + wid * QBLK + r32));
#define DMA(tj, b) do { const char* kt_ = Kh + (long)(tj) * tstep; const char* vt_ = Vh + (long)(tj) * tstep; _Pragma("unroll") for (int i_ = 0; i_ < 2; ++i_) { \
    __builtin_amdgcn_global_load_lds((const unsigned*)(kt_ + kofs[i_]), (LAS unsigned*)(ldsl + LDS_K0 + (b) * (int)SHM_K + (wid + 8 * i_) * 1024), 16, 0, 0); \
    __builtin_amdgcn_global_load_lds((const unsigned*)(vt_ + vofs[i_]), (LAS unsigned*)(ldsl + (b) * (int)SHM_V + (wid + 8 * i_) * 1024), 16, 0, 0); } } while (0)
#define KBUF(b) ((const bf16*)(lds + LDS_K0 + (b) * (int)SHM_K))
#define VBUF(b) (vrd + (b) * (int)SHM_V)
#define LANDED() do { asm volatile("s_waitcnt vmcnt(0)" ::: "memory"); __syncthreads(); } while (0)
#define RESC(a) do { if (__any((a) < 1.f)) { if (hi == 0) al_l[r32] = (a); asm volatile("s_waitcnt lgkmcnt(0)" ::: "memory"); \
    for (int d = 0; d < 4; ++d) for (int r = 0; r < 16; ++r) o[d][r] *= al_l[crow(r, hi)]; } } while (0)
  f32x16 pA0, pA1, pB0, pB1; float mnA, mnB, alA, alB; bf16x8 pa0, pa1, pa2, pa3; const int NT = u.nt;
  DMA(0, 0); DMA(1, 1);
  LANDED();
  qkt(pA0, pA1, KBUF(0), qr, r32, hi, tl0); partialSM(pA0, pA1, m_reg, mnA, alA);
  if (2 < NT) DMA(2, 2);
  int bp = 0, bc = 1, bn = 2;
  for (int t = 1; t + 1 < NT; t += 2) {
    SBAR(); qkt(pB0, pB1, KBUF(bc), qr, r32, hi, tl0 + t * KVBLK);
    finishSM(pA0, pA1, alA, l_reg, pa0, pa1, pa2, pa3); SBAR();
    pv_sm(o, VBUF(bp), pa0, pa1, pa2, pa3, pB0, pB1, m_reg, mnB, alB);
    RESC(alB);
    LANDED();
    { const int nb = bp; bp = bc; bc = bn; bn = nb; if (t + 2 < NT) DMA(t + 2, bn); }
    SBAR(); qkt(pA0, pA1, KBUF(bc), qr, r32, hi, tl0 + (t + 1) * KVBLK);
    finishSM(pB0, pB1, alB, l_reg, pa0, pa1, pa2, pa3); SBAR();
    pv_sm(o, VBUF(bp), pa0, pa1, pa2, pa3, pA0, pA1, m_reg, mnA, alA);
    RESC(alA);
    LANDED();
    { const int nb = bp; bp = bc; bc = bn; bn = nb; if (t + 3 < NT) DMA(t + 3, bn); }
  }
  SBAR(); qkt(pB0, pB1, KBUF(bc), qr, r32, hi, tl0 + (NT - 1) * KVBLK);
  finishSM(pA0, pA1, alA, l_reg, pa0, pa1, pa2, pa3); SBAR();
  pv_sm(o, VBUF(bp), pa0, pa1, pa2, pa3, pB0, pB1, m_reg, mnB, alB);
  RESC(alB);
  finishSM(pB0, pB1, alB, l_reg, pa0, pa1, pa2, pa3); SBAR();
  pv_d0(o, VBUF(bc), pa0, pa1, pa2, pa3);
  if (hi == 0) li_l[r32] = l_reg; asm volatile("s_waitcnt lgkmcnt(0)" ::: "memory");
  float rli[16];
#pragma unroll
  for (int r = 0; r < 16; ++r) rli[r] = __builtin_amdgcn_rcpf(li_l[crow(r, hi)]);
  bf16* Ow = u.O + (long)(wid * QBLK) * u.ldo;
#pragma unroll
  for (int r = 0; r < 16; ++r) { int orow = crow(r, hi);
#pragma unroll
    for (int d0 = 0; d0 < 4; ++d0) { const float v = o[d0][r] * rli[r]; Ow[(long)orow * u.ldo + d0 * 32 + r32] = (bf16)(cvtpk(v, v) & 0xffffu); } }
  if (u.lse != nullptr && hi == 0) u.lse[(long)(wid * QBLK + r32) * u.lse_ld] = m_reg * SCALE + __logf(l_reg);
#undef DMA
#undef KBUF
#undef VBUF
#undef LANDED
#undef RESC
}
#undef KSWZ
#undef SBAR
}

constexpr int NWAVES = 8;
constexpr size_t MiB = 1u << 20;
constexpr size_t WS_CTL = 0, CTL_ZERO_BYTES = 1 * MiB;
constexpr size_t WS_CS   = 1 * MiB;
constexpr size_t WS_SKBD = 1 * MiB + 256 * 1024;
constexpr size_t WS_TAB  = 2 * MiB;
constexpr size_t WS_LSE  = 3 * MiB;
constexpr size_t WS_SU   = 3 * MiB + 768 * 1024;
constexpr size_t WS_SH   = 3 * MiB + 832 * 1024;
constexpr size_t WS_WCAT = 4 * MiB, WS_WO = 12 * MiB, WS_WQ = 20 * MiB;
constexpr size_t WS_WIN  = 28 * MiB;
constexpr size_t WS_WG8  = WS_WIN + 16 * MiB;
constexpr size_t WS_DFT  = 84 * MiB;
constexpr size_t WS_U    = 148 * MiB, WS_V = 180 * MiB;
constexpr size_t WS_H8   = 212 * MiB;
constexpr size_t WS_H    = 276 * MiB;
constexpr size_t WS_PROJ = 340 * MiB;
constexpr size_t WS_G    = 596 * MiB;
constexpr size_t WS_ZT   = 788 * MiB;
constexpr size_t WS_OC   = 820 * MiB;
constexpr size_t WS_MG   = 884 * MiB;
constexpr size_t WS_SSP  = 276 * MiB;
constexpr size_t WS_X16  = 948 * MiB;
constexpr size_t WS_END  = 1012 * MiB;
#if DBG_MODE == 2
constexpr size_t WS_ACT = WS_PROJ + 208 * MiB;
#else
constexpr size_t WS_ACT = WS_PROJ + 200 * MiB;
#endif
constexpr size_t WS_Q = WS_PROJ, WS_SC = WS_PROJ + 64 * MiB, WS_IDS = WS_PROJ + 192 * MiB, WS_GATES = WS_PROJ + 200 * MiB;
constexpr int CW_BAR = 4096;
constexpr int CW_XRANK = 12288;
constexpr int CW_QUEUE = 16384;
constexpr int RING_BYTES = 131072, LDSCTL_OFF = RING_BYTES, MISC_OFF = LDSCTL_OFF + 320, LDS_BYTES = 147456;

#define LDS_WAIT() asm volatile("s_waitcnt lgkmcnt(0)" ::: "memory")
#define VM_WAIT() asm volatile("s_waitcnt vmcnt(0)" ::: "memory")
__device__ __forceinline__ unsigned f2bf(float f) { unsigned u = __builtin_bit_cast(unsigned, f); return (u + 0x7fffu + ((u >> 16) & 1u)) >> 16; }
__device__ __forceinline__ unsigned pk2(float lo, float hi) { return f2bf(lo) | (f2bf(hi) << 16); }
__device__ __forceinline__ float bflo(unsigned w) { return __uint_as_float(w << 16); }
__device__ __forceinline__ float bfhi(unsigned w) { return __uint_as_float(w & 0xffff0000u); }

#define XB_TMO      128
#define XB_XCNT(j)  (256  + 64 * (j))
#define XB_XSUB(j)  (1280 + 64 * (j))
#define XB_XGEN(j)  (2304 + 64 * (j))
#define XB_TOP      3328
#define XB_TOPGEN   3392
#define XCD_BAR_WORDS 3456
#define XB_SPIN_CAP (1u << 20)
__device__ __forceinline__ unsigned xb_ld(unsigned* p)              { return __hip_atomic_load(p, __ATOMIC_RELAXED, __HIP_MEMORY_SCOPE_AGENT); }
__device__ __forceinline__ unsigned xb_add(unsigned* p, unsigned v) { return __hip_atomic_fetch_add(p, v, __ATOMIC_RELAXED, __HIP_MEMORY_SCOPE_AGENT); }
__device__ __forceinline__ unsigned xb_xcc_id() { return (unsigned)__builtin_amdgcn_s_getreg((3 << 11) | 20) & 0xFu; }
#define XB_SPIN(cond, bar) do { unsigned _sp = 0; while (cond) { __builtin_amdgcn_s_sleep(1); \
    if ((++_sp & 255u) == 0u) { if (xb_ld(&(bar)[XB_TMO])) break; if (_sp > XB_SPIN_CAP) { atomicAdd(&(bar)[XB_TMO], 1u); break; } } } } while (0)
struct XcdBarrier { unsigned* bar; unsigned x; volatile LAS unsigned* st; };
__device__ __forceinline__ XcdBarrier xcd_barrier_post(unsigned* bar, volatile LAS unsigned* st) {
    XcdBarrier b; b.bar = bar; b.x = xb_xcc_id(); b.st = st;
    if (threadIdx.x == 0) (void)xb_add(&bar[XB_XCNT(b.x)], 1u);
    return b;
}
__device__ __forceinline__ void xcd_barrier_complete(unsigned* bar, unsigned x, unsigned& nloc, unsigned& nx) {
    const unsigned G = gridDim.x * gridDim.y * gridDim.z;
    unsigned sum, cnt, mine, sp = 0u;
    for (;;) {
        sum = 0u; cnt = 0u; mine = 0u;
#pragma unroll
        for (unsigned j = 0; j < 16; ++j) { const unsigned c = xb_ld(&bar[XB_XCNT(j)]); sum += c; cnt += (c > 0u) ? 1u : 0u; mine = (j == x) ? c : mine; }
        if (sum == G) break;
        __builtin_amdgcn_s_sleep(1);
        if ((++sp & 255u) == 0u) { if (xb_ld(&bar[XB_TMO])) break; if (sp > XB_SPIN_CAP) { atomicAdd(&bar[XB_TMO], 1u); break; } }
    }
    nloc = mine > 0u ? mine : 1u; nx = cnt > 0u ? cnt : 1u;
}
__device__ __forceinline__ void xcd_barrier(const XcdBarrier& b) {
    asm volatile("s_waitcnt vmcnt(0)" ::: "memory");
    __syncthreads();
    if (threadIdx.x == 0) {
        unsigned* bar = b.bar;
        __builtin_amdgcn_s_waitcnt(0);
        unsigned nloc = b.st[0], nx = b.st[1];
        if (nloc == 0u) { xcd_barrier_complete(bar, b.x, nloc, nx); b.st[0] = nloc; b.st[1] = nx; }
        const unsigned old = xb_add(&bar[XB_XSUB(b.x)], 1u);
        const unsigned gen = old / nloc;
        if (old + 1u == (gen + 1u) * nloc) {
            __builtin_amdgcn_fence(__ATOMIC_RELEASE, "agent");
            asm volatile("s_waitcnt vmcnt(0)" ::: "memory");
            const unsigned og = xb_add(&bar[XB_TOP], 1u);
            const unsigned tg = og / nx;
            if (og + 1u == (tg + 1u) * nx) xb_add(&bar[XB_TOPGEN], 1u);
            else XB_SPIN(xb_ld(&bar[XB_TOPGEN]) == tg, bar);
            __builtin_amdgcn_fence(__ATOMIC_ACQUIRE, "agent");
            xb_add(&bar[XB_XGEN(b.x)], 1u);
            asm volatile("s_waitcnt vmcnt(0)" ::: "memory");
        } else {
            XB_SPIN(xb_ld(&bar[XB_XGEN(b.x)]) == gen, bar);
            __builtin_amdgcn_fence(__ATOMIC_ACQUIRE, "agent");
            asm volatile("s_waitcnt vmcnt(0)" ::: "memory");
        }
    }
    __syncthreads();
}

template <int MASK> __device__ __forceinline__ int sx_i(int v) { return __builtin_amdgcn_ds_swizzle(v, 0x1f | (MASK << 10)); }
template <int MASK> __device__ __forceinline__ float sx_f(float v) { return __int_as_float(sx_i<MASK>(__float_as_int(v))); }
__device__ __forceinline__ float add32(float v) { auto rr = __builtin_amdgcn_permlane32_swap(__float_as_uint(v), __float_as_uint(v), false, false); return __uint_as_float(rr[0]) + __uint_as_float(rr[1]); }
__device__ __forceinline__ unsigned max32(unsigned v) { auto rr = __builtin_amdgcn_permlane32_swap(v, v, false, false); return rr[0] > rr[1] ? rr[0] : rr[1]; }
__device__ __forceinline__ float other32(float v, bool upper) { auto rr = __builtin_amdgcn_permlane32_swap(__float_as_uint(v), __float_as_uint(v), false, false); return __uint_as_float(upper ? rr[0] : rr[1]); }
__device__ __forceinline__ float bperm_f(float v, int src_lane) { return __int_as_float(__builtin_amdgcn_ds_bpermute(src_lane * 4, __float_as_int(v))); }
__device__ __forceinline__ int bperm_i(int v, int src_lane) { return __builtin_amdgcn_ds_bpermute(src_lane * 4, v); }
__device__ __forceinline__ float wave_sum(float v) {
    v += sx_f<1>(v); v += sx_f<2>(v); v += sx_f<4>(v); v += sx_f<8>(v); v += sx_f<16>(v); return add32(v);
}
__device__ __forceinline__ unsigned umax(unsigned a, unsigned b) { return a > b ? a : b; }
__device__ __forceinline__ unsigned wave_max_u32(unsigned v) {
    v = umax(v, (unsigned)sx_i<1>((int)v)); v = umax(v, (unsigned)sx_i<2>((int)v)); v = umax(v, (unsigned)sx_i<4>((int)v)); v = umax(v, (unsigned)sx_i<8>((int)v)); v = umax(v, (unsigned)sx_i<16>((int)v)); return max32(v);
}
template <int CTRL, int RMASK> __device__ __forceinline__ unsigned dpp_max_u(unsigned v) { const unsigned t = (unsigned)__builtin_amdgcn_update_dpp((int)v, (int)v, CTRL, RMASK, 0xF, false); return t > v ? t : v; }
__device__ __forceinline__ unsigned wave_max_dpp(unsigned v) {
    v = dpp_max_u<0xB1, 0xF>(v); v = dpp_max_u<0x4E, 0xF>(v); v = dpp_max_u<0x141, 0xF>(v); v = dpp_max_u<0x140, 0xF>(v); v = dpp_max_u<0x142, 0xA>(v); v = dpp_max_u<0x143, 0xC>(v);
    return (unsigned)__builtin_amdgcn_readlane((int)v, 63);
}
template <int CTRL> __device__ __forceinline__ float dpp_add_f(float v) { return v + __int_as_float(__builtin_amdgcn_update_dpp(__float_as_int(v), __float_as_int(v), CTRL, 0xF, 0xF, false)); }
__device__ __forceinline__ float row_sum16(float v) { v = dpp_add_f<0xB1>(v); v = dpp_add_f<0x4E>(v); v = dpp_add_f<0x141>(v); return dpp_add_f<0x140>(v); }
__device__ __forceinline__ unsigned row_max16_u(unsigned v) { v = dpp_max_u<0xB1, 0xF>(v); v = dpp_max_u<0x4E, 0xF>(v); v = dpp_max_u<0x141, 0xF>(v); return dpp_max_u<0x140, 0xF>(v); }
template <int CTRL> __device__ __forceinline__ float dpp_maxf(float v) { return fmaxf(v, __int_as_float(__builtin_amdgcn_update_dpp(__float_as_int(v), __float_as_int(v), CTRL, 0xF, 0xF, false))); }
__device__ __forceinline__ float row_max16_f(float v) { v = dpp_maxf<0xB1>(v); v = dpp_maxf<0x4E>(v); v = dpp_maxf<0x141>(v); return dpp_maxf<0x140>(v); }
__device__ __forceinline__ float okey_inv(unsigned k) { return __uint_as_float((k & 0x80000000u) ? (k & 0x7fffffffu) : ~k); }
#define CE_DESC(a, b) do { const unsigned hi_ = (a) > (b) ? (a) : (b), lo_ = (a) > (b) ? (b) : (a); (a) = hi_; (b) = lo_; } while (0)
__device__ __forceinline__ unsigned okey(float f) { const unsigned u = __float_as_uint(f); return (u & 0x80000000u) ? ~u : (u | 0x80000000u); }

__device__ __forceinline__ void tr_issue(f32x4 (&t)[8], const float* W, int N, int k0, int n0, int lane) {
#pragma unroll
    for (int i = 0; i < 8; ++i) t[i] = __builtin_nontemporal_load((const GAS f32x4*)(W + (size_t)(k0 + 8 * i + (lane >> 3)) * N + n0 + 4 * (lane & 7)));
}
__device__ __forceinline__ void tr_to_lds(const f32x4 (&t)[8], LAS float* scr, int lane) {
#pragma unroll
    for (int i = 0; i < 8; ++i) { LAS float* d = scr + (8 * i + (lane >> 3)) * 33 + 4 * (lane & 7); d[0] = t[i].x; d[1] = t[i].y; d[2] = t[i].z; d[3] = t[i].w; }
    LDS_WAIT(); asm volatile("" ::: "memory");
}
__device__ __forceinline__ void tr_finish_bf16(const f32x4 (&t)[8], LAS float* scr, bf16* WT, int ldo, int col_off, int k0, int n0, int row_delta, int lane, const float* gk = nullptr) {
    tr_to_lds(t, scr, lane);
    const int c = lane & 7;
    f32x4 g0 = {1.f, 1.f, 1.f, 1.f}, g1 = {1.f, 1.f, 1.f, 1.f}; if (gk) { g0 = *(const GAS f32x4*)(gk + k0 + 8 * c); g1 = *(const GAS f32x4*)(gk + k0 + 8 * c + 4); }
#pragma unroll
    for (int j = 0; j < 4; ++j) { const int n = (lane >> 3) + 8 * j; const LAS float* s = scr + (8 * c) * 33 + n;
        v4u o; o.x = pk2(s[0 * 33] * g0.x, s[1 * 33] * g0.y); o.y = pk2(s[2 * 33] * g0.z, s[3 * 33] * g0.w); o.z = pk2(s[4 * 33] * g1.x, s[5 * 33] * g1.y); o.w = pk2(s[6 * 33] * g1.z, s[7 * 33] * g1.w);
        *(GAS v4u*)(WT + (size_t)(n0 + n + row_delta) * ldo + col_off + k0 + 8 * c) = o; }
    LDS_WAIT(); asm volatile("" ::: "memory");
}
__device__ __forceinline__ void tr_finish_fp8(const f32x4 (&t)[8], LAS float* scr, unsigned char* WT8, int ldo, float scale, int k0, int n0, int ncol0, int lane) {
    tr_to_lds(t, scr, lane);
    const int c = lane & 3;
#pragma unroll
    for (int j = 0; j < 2; ++j) { const int n = (lane >> 2) + 16 * j; const LAS float* s = scr + (16 * c) * 33 + n; v4u o; int w;
        w = __builtin_amdgcn_cvt_pk_fp8_f32(s[0 * 33] * scale, s[1 * 33] * scale, 0, false); w = __builtin_amdgcn_cvt_pk_fp8_f32(s[2 * 33] * scale, s[3 * 33] * scale, w, true); o.x = (unsigned)w;
        w = __builtin_amdgcn_cvt_pk_fp8_f32(s[4 * 33] * scale, s[5 * 33] * scale, 0, false); w = __builtin_amdgcn_cvt_pk_fp8_f32(s[6 * 33] * scale, s[7 * 33] * scale, w, true); o.y = (unsigned)w;
        w = __builtin_amdgcn_cvt_pk_fp8_f32(s[8 * 33] * scale, s[9 * 33] * scale, 0, false); w = __builtin_amdgcn_cvt_pk_fp8_f32(s[10 * 33] * scale, s[11 * 33] * scale, w, true); o.z = (unsigned)w;
        w = __builtin_amdgcn_cvt_pk_fp8_f32(s[12 * 33] * scale, s[13 * 33] * scale, 0, false); w = __builtin_amdgcn_cvt_pk_fp8_f32(s[14 * 33] * scale, s[15 * 33] * scale, w, true); o.w = (unsigned)w;
        *(GAS v4u*)(WT8 + (size_t)(n0 + n - ncol0) * ldo + k0 + 16 * c) = o; }
    LDS_WAIT(); asm volatile("" ::: "memory");
}
__device__ __forceinline__ void transpose_item(const float* W, int N, bf16* WT, int ldo, int col_off, LAS float* scr, int item, int lane, int row_delta = 0) {
    const int nblk = N / 32, k0 = 64 * (item / nblk), n0 = 32 * (item % nblk); f32x4 t[8]; tr_issue(t, W, N, k0, n0, lane); tr_finish_bf16(t, scr, WT, ldo, col_off, k0, n0, row_delta, lane);
}
__device__ __forceinline__ void transpose_item_fp8(const float* W, int N, int ncol0, unsigned char* WT8, int ldo, float scale, LAS float* scr, int item, int lane) {
    const int nblk = N / 32, k0 = 64 * (item / nblk), n0 = 32 * (item % nblk); f32x4 t[8]; tr_issue(t, W, N, k0, n0, lane); tr_finish_fp8(t, scr, WT8, ldo, scale, k0, n0, ncol0, lane);
}
constexpr int NPCU = 32;
constexpr int NPREP = 512;
constexpr int I_IN = (DM / 64) * (INW / 32), I_A = (512 / 64) * (DM / 32), I_C = (1024 / 64) * (DM / 32), I_SQ = (DM / 64) * (DM / 32), I_OWN = 2 * I_A + I_C + 2 * I_SQ;
__device__ __forceinline__ void prep_win_item(const float* w_in, bf16* WIN, unsigned char* WG8, LAS float* scr, int r, int lane) {
    const int ct = ((r % (INW / 32)) * 32) >> 8;
    if (ct < 2) transpose_item(w_in, INW, WIN, DM, 0, scr, r, lane); else if (ct >= 28 && ct < 32) transpose_item(w_in, INW, WIN, DM, 0, scr, r, lane, -26 * 256);
    else transpose_item_fp8(w_in, INW, ct < 28 ? 2 * 256 : 6 * 256, WG8, DM, 1024.f, scr, r, lane);
}
template <bool FP8> __device__ __forceinline__ void rms_rows2_to_bf16(const float* xrow, size_t rstride, const float* g, bf16* orow, unsigned char* o8row, int lane) {
    const GAS f32x4* gr = (const GAS f32x4*)g + lane;
    f32x4 v[2][8];
#pragma unroll
    for (int u = 0; u < 2; ++u) { const GAS f32x4* xr = (const GAS f32x4*)(xrow + u * rstride) + lane;
#pragma unroll
        for (int j = 0; j < 8; ++j) v[u][j] = xr[64 * j]; }
#pragma unroll
    for (int u = 0; u < 2; ++u) { float s = 0.f;
#pragma unroll
        for (int j = 0; j < 8; ++j) s += (v[u][j].x * v[u][j].x + v[u][j].y * v[u][j].y) + (v[u][j].z * v[u][j].z + v[u][j].w * v[u][j].w);
        const float rstd = 1.0f / sqrtf(wave_sum(s) * (1.f / DM) + RMS_EPS);
        GAS unsigned long long* o8 = (GAS unsigned long long*)(orow + u * rstride) + lane;
#pragma unroll
        for (int j = 0; j < 8; ++j) { const f32x4 gg = gr[64 * j]; const float a = v[u][j].x * rstd * gg.x, b = v[u][j].y * rstd * gg.y, c = v[u][j].z * rstd * gg.z, d = v[u][j].w * rstd * gg.w;
            o8[64 * j] = (unsigned long long)pk2(a, b) | ((unsigned long long)pk2(c, d) << 32);
            if (FP8) { int w = __builtin_amdgcn_cvt_pk_fp8_f32(a * 32.f, b * 32.f, 0, false); w = __builtin_amdgcn_cvt_pk_fp8_f32(c * 32.f, d * 32.f, w, true); ((GAS unsigned*)(o8row + u * rstride))[lane + 64 * j] = (unsigned)w; } } }
}
typedef __bf16 bf2_t __attribute__((ext_vector_type(2)));
__device__ __forceinline__ float DOT2(unsigned a, unsigned b, float c) { return __builtin_amdgcn_fdot2_f32_bf16(__builtin_bit_cast(bf2_t, a), __builtin_bit_cast(bf2_t, b), c, false); }
__device__ __forceinline__ unsigned q8x4(float a, float b, float c, float d, float inv) {
    const int ia = (int)__builtin_rintf(a * inv), ib = (int)__builtin_rintf(b * inv), ic = (int)__builtin_rintf(c * inv), id = (int)__builtin_rintf(d * inv);
    return (unsigned)(ia & 0xff) | ((unsigned)(ib & 0xff) << 8) | ((unsigned)(ic & 0xff) << 16) | ((unsigned)(id & 0xff) << 24);
}
__device__ __forceinline__ float wave_maxf(float v) {
    v = fmaxf(v, sx_f<1>(v)); v = fmaxf(v, sx_f<2>(v)); v = fmaxf(v, sx_f<4>(v)); v = fmaxf(v, sx_f<8>(v)); v = fmaxf(v, sx_f<16>(v));
    auto rr = __builtin_amdgcn_permlane32_swap(__float_as_uint(v), __float_as_uint(v), false, false); return fmaxf(__uint_as_float(rr[0]), __uint_as_float(rr[1]));
}
template <int MODE> __device__ __forceinline__ void rms_rows2_from_bf16(const bf16* xrow, size_t rstride, const float* g, bf16* orow, unsigned char* o8row, float* sh, int shstride, int lane) {
    const GAS f32x4* gr = (const GAS f32x4*)g + 2 * lane;
    v4u xv[2][4];
#pragma unroll
    for (int u = 0; u < 2; ++u) { const GAS v4u* xr = (const GAS v4u*)(xrow + u * rstride) + lane;
#pragma unroll
        for (int j = 0; j < 4; ++j) xv[u][j] = xr[64 * j]; }
#pragma unroll
    for (int u = 0; u < 2; ++u) { float v[4][8]; float s = 0.f;
#pragma unroll
        for (int j = 0; j < 4; ++j) { const v4u w = xv[u][j]; v[j][0] = bflo(w.x); v[j][1] = bfhi(w.x); v[j][2] = bflo(w.y); v[j][3] = bfhi(w.y); v[j][4] = bflo(w.z); v[j][5] = bfhi(w.z); v[j][6] = bflo(w.w); v[j][7] = bfhi(w.w);
#pragma unroll
            for (int k = 0; k < 8; ++k) s += v[j][k] * v[j][k]; }
        const float rstd = 1.0f / sqrtf(wave_sum(s) * (1.f / DM) + RMS_EPS); float mx = 0.f;
#pragma unroll
        for (int j = 0; j < 4; ++j) { const f32x4 ga = gr[128 * j], gb = gr[128 * j + 1];
            v[j][0] *= rstd * ga.x; v[j][1] *= rstd * ga.y; v[j][2] *= rstd * ga.z; v[j][3] *= rstd * ga.w; v[j][4] *= rstd * gb.x; v[j][5] *= rstd * gb.y; v[j][6] *= rstd * gb.z; v[j][7] *= rstd * gb.w;
            if (MODE == 1) {
#pragma unroll
                for (int k = 0; k < 8; ++k) mx = fmaxf(mx, fabsf(v[j][k])); } }
        float inv = 32.f;
        if (MODE == 1) { mx = fmaxf(wave_maxf(mx), 1e-30f); inv = 127.f / mx; if (lane == 0) sh[u * shstride] = mx * (1.f / 127.f); }
        GAS v4u* ob = (GAS v4u*)(orow + u * rstride) + lane; GAS unsigned long long* o8 = (GAS unsigned long long*)(o8row + u * rstride) + lane;
#pragma unroll
        for (int j = 0; j < 4; ++j) { v4u o; o.x = pk2(v[j][0], v[j][1]); o.y = pk2(v[j][2], v[j][3]); o.z = pk2(v[j][4], v[j][5]); o.w = pk2(v[j][6], v[j][7]); ob[64 * j] = o;
            unsigned lo, hi;
            if (MODE == 0) { int w = __builtin_amdgcn_cvt_pk_fp8_f32(v[j][0] * inv, v[j][1] * inv, 0, false); w = __builtin_amdgcn_cvt_pk_fp8_f32(v[j][2] * inv, v[j][3] * inv, w, true); lo = (unsigned)w;
                w = __builtin_amdgcn_cvt_pk_fp8_f32(v[j][4] * inv, v[j][5] * inv, 0, false); w = __builtin_amdgcn_cvt_pk_fp8_f32(v[j][6] * inv, v[j][7] * inv, w, true); hi = (unsigned)w; }
            else { lo = q8x4(v[j][0], v[j][1], v[j][2], v[j][3], inv); hi = q8x4(v[j][4], v[j][5], v[j][6], v[j][7], inv); }
            o8[64 * j] = (unsigned long long)lo | ((unsigned long long)hi << 32); } }
}
__device__ __forceinline__ int rel_bucket(int rel) {
    const int n = rel < 0 ? -rel : rel;
    int b = n;
    if (n >= 8) { b = 5 + (31 - __builtin_clz((unsigned)n)); if (b > 15) b = 15; }
    return b + (rel > 0 ? 16 : 0);
}

#ifndef PH_D1
#define PH_D1 1
#endif
#ifndef PH_D2
#define PH_D2 1
#endif
#ifndef PH_A
#define PH_A 1
#endif
#ifndef PH_B
#define PH_B 1
#endif
#ifndef PH_C
#define PH_C 1
#endif
#ifndef PH_D
#define PH_D 1
#endif
#ifndef PH_E
#define PH_E 1
#endif
#ifndef PH_F
#define PH_F 1
#endif
#ifndef PH_G
#define PH_G 1
#endif
#ifndef PH_H
#define PH_H 1
#endif
#ifndef PH_I
#define PH_I 1
#endif
#ifndef PH_J
#define PH_J 1
#endif
#ifndef PH_K
#define PH_K 1
#endif
#ifndef PH_L
#define PH_L 1
#endif
struct Args { const float* in[17]; float* out; unsigned char* ws; };

#define CAS __attribute__((address_space(4)))
__device__ __forceinline__ const void* karg(int k) { const CAS char* ka = (const CAS char*)__builtin_amdgcn_kernarg_segment_ptr(); asm volatile("" : "+s"(ka)); return *(const void* const CAS*)(ka + 8 * k); }
#define WSP(T, off) ((T*)((unsigned char*)karg(18) + (off)))
#define INP(k) ((const float*)karg(k))
#define INL(k, stride) (INP(k) + (size_t)layer * (size_t)(stride))
#define X ((float*)karg(17))
#define X16 WSP(bf16, WS_X16)
__global__ void __launch_bounds__(NWAVES * 64, 2) mk_fwd(Args args_unused) {
    extern __shared__ __attribute__((aligned(16))) unsigned char lds[];
    LAS unsigned char* ldsl = (LAS unsigned char*)lds;
    volatile LAS unsigned* MISC = (volatile LAS unsigned*)(ldsl + MISC_OFF);
    const int wave0 = __builtin_amdgcn_readfirstlane((int)threadIdx.x >> 6);
    const int G = gridDim.x; const int bx = blockIdx.x; const int vcu = (G % 8 == 0) ? (bx % 8) * (G / 8) + bx / 8 : bx;
    const int NGW = G * NWAVES, NGT = NGW * 64;
#define PH_IDS() int wave_o_ = wave0, vcu_o_ = vcu; asm volatile("" : "+s"(wave_o_), "+s"(vcu_o_));     \
    const int tid = opaque_tid(wave_o_), lane = tid & 63, wave = wave_o_, gw = vcu_o_ * NWAVES + wave, gt = gw * 64 + lane; (void)gt; (void)gw; (void)lane
    gu32* ctl = (gu32*)WSP(unsigned char, WS_CTL);
    for (int u = threadIdx.x; u < (LDS_BYTES - LDSCTL_OFF) / 4; u += NWAVES * 64) ((LAS unsigned*)(ldsl + LDSCTL_OFF))[u] = 0u;
    __syncthreads();
    XcdBarrier bar = xcd_barrier_post((unsigned*)(ctl + CW_BAR), MISC + 8);
    if (threadIdx.x == 0) MISC[1] = __hip_atomic_fetch_add(ctl + CW_XRANK + 64 * (int)(xb_xcc_id() & 7u), 1u, __ATOMIC_RELAXED, __HIP_MEMORY_SCOPE_AGENT);
#define GRID_BAR() xcd_barrier(bar)

    for (int layer = 0; layer < 2; ++layer) {

#if PH_A
        {
            PH_IDS();
            LAS float* scr = (LAS float*)(ldsl + wave * 16384);
            const float* mix_g = INL(3, DM); const float* rel_bias = INP(1);
            bf16* H = WSP(bf16, WS_H); bf16* DFT = WSP(bf16, WS_DFT); bf16* CS = WSP(bf16, WS_CS); float* TAB = WSP(float, WS_TAB);
            if (layer == 0) { const float* w_in = INP(4); bf16* WIN = WSP(bf16, WS_WIN);
                for (int it = gw; it < I_IN; it += NGW) prep_win_item(w_in, WIN, WSP(unsigned char, WS_WG8), scr, it, lane); }
            if (layer == 0) { int m = gw; do { rms_rows2_to_bf16<true>(INP(0) + (size_t)m * DM, (size_t)NGW * DM, mix_g, H + (size_t)m * DM, WSP(unsigned char, WS_H8) + (size_t)m * DM, lane); m += 2 * NGW; } while (m < MTOK); }
            else { int m = gw; do { rms_rows2_from_bf16<0>(X16 + (size_t)m * DM, (size_t)NGW * DM, mix_g, H + (size_t)m * DM, WSP(unsigned char, WS_H8) + (size_t)m * DM, nullptr, 0, lane); m += 2 * NGW; } while (m < MTOK); }
            if (layer == 0) {
                for (size_t i = (size_t)gt; i < (size_t)2304 * 8192 / 8; i += (size_t)NGT) {
                    const int sp = (int)(i >> 10), k0 = (int)(i & 1023) * 8, part = k0 >> 12, s0 = k0 & 4095; float v[8];
#pragma unroll
                    for (int j = 0; j < 8; ++j) { const float ang = (float)(((s0 + j) * sp) & 4095) * (1.f / 4096.f); v[j] = (part ? -__builtin_amdgcn_sinf(ang) : __builtin_amdgcn_cosf(ang)) * (1.f / 64.f); }
                    v4u o; o.x = pk2(v[0], v[1]); o.y = pk2(v[2], v[3]); o.z = pk2(v[4], v[5]); o.w = pk2(v[6], v[7]); ((GAS v4u*)DFT)[i] = o;
                }
                for (int i = gt; i < 65536; i += NGT) { const int r = i >> 8, c = i & 255, part = r >> 7, cp = r & 127; float v = 0.f;
                    if (c < 128) { const float ang = (float)((c * cp) & 127) * (1.f / 128.f); v = (part ? __builtin_amdgcn_sinf(ang) : __builtin_amdgcn_cosf(ang)) * 0.08838834764831845f; }
                    CS[i] = (bf16)f2bf(v); }
                for (int i = gt; i < 16 * 8192; i += NGT) { const int hd = i >> 13, off = (i & 8191) - 4096; float v;
                    if (hd < 12) { const int g = hd >> 2, dil = g == 0 ? 1 : (g == 1 ? 4 : 16); v = (off >= -64 && off <= 64) ? rel_bias[rel_bucket(off * dil) * 16 + hd] * 11.313708498984761f : -1.0e5f; }
                    else v = rel_bias[rel_bucket(off) * 16 + hd] * 11.313708498984761f;
                    TAB[i] = v; }
            }
        }
#endif
        GRID_BAR();

#if PH_B
        {
            { pg8::Gemm g{WSP(bf16, WS_H), WSP(bf16, WS_WIN)}; pg8::StaticOrder S; S.init(MTOK, 6 * 256, G, bx, DM, DM);
              pg8::EpiProj E{WSP(bf16, WS_PROJ), WSP(unsigned char, WS_G), INL(5, GTW), 2, 0, 26, 1.f};
              pg8::gemm_phase<pg8::EpiProj, pg8::StaticOrder, true, DM, DM, DM>(ldsl, g, S, E, wave0); }
            { pg8::Gemm g{WSP(bf16, WS_H8), WSP(bf16, WS_WG8)}; pg8::StaticOrder S; S.init(MTOK, 50 * 256, G, (bx + G / 2) % G, DM / 2, DM / 2);
              pg8::EpiProj E{WSP(bf16, WS_PROJ), WSP(unsigned char, WS_G), INL(5, GTW), 26, 2, 6, 1.f / 32768.f};
              pg8::gemm_phase<pg8::EpiProj, pg8::StaticOrder, true, DM / 2, DM / 2, DM / 2, true>(ldsl, g, S, E, wave0); }
        }
#endif
        GRID_BAR();

#if PH_C
        {
            pg8::Gemm g{WSP(bf16, WS_CS), WSP(bf16, WS_PROJ)}; pg8::F1Order S{G, bx};
            pg8::EpiZT E{WSP(bf16, WS_ZT)};
            pg8::gemm_phase<pg8::EpiZT, pg8::F1Order, false, 256, PJW, 256>(ldsl, g, S, E, wave0);
        }
#endif
        GRID_BAR();

#if PH_D
#if PH_D1
        {
            pg8::Gemm g{WSP(bf16, WS_DFT), WSP(bf16, WS_ZT)}; pg8::StaticOrder S; S.init(2304, 2048, G, bx, 8192, 8192);
            pg8::EpiF2 E{WSP(bf16, WS_OC)};
            pg8::gemm_phase<pg8::EpiF2, pg8::StaticOrder, false, 8192, 8192, 8192>(ldsl, g, S, E, wave0);
        }
#endif
#if PH_D2
        {
            PH_IDS();
            gu32* qhead = ctl + CW_QUEUE + 64 * layer; gu32* phead = ctl + CW_QUEUE + 128 + 64 * layer; const bool pref = bx >= 128 && bx < 128 + NPCU;
            bf16* PROJ = WSP(bf16, WS_PROJ); bf16* DO = WSP(bf16, WS_MG); bf16* DL = WSP(bf16, WS_H); float* LSE = WSP(float, WS_LSE); const float* TAB = WSP(float, WS_TAB);
            const float* cur_tab = nullptr;
            for (;;) {
                __syncthreads();
                if (tid == 0) { unsigned w = 0xffffffffu;
                    if (pref) { const unsigned v = __hip_atomic_fetch_add(phead, 1u, __ATOMIC_RELAXED, __HIP_MEMORY_SCOPE_AGENT); if (v < (unsigned)NPREP) w = 0x8000u | v; }
                    if (w == 0xffffffffu) { const unsigned v = __hip_atomic_fetch_add(qhead, 1u, __ATOMIC_RELAXED, __HIP_MEMORY_SCOPE_AGENT); if (v < 1792u) w = v; }
                    if (w == 0xffffffffu && !pref) { const unsigned v = __hip_atomic_fetch_add(phead, 1u, __ATOMIC_RELAXED, __HIP_MEMORY_SCOPE_AGENT); if (v < (unsigned)NPREP) w = 0x8000u | v; }
                    MISC[0] = w; }
                __syncthreads();
                const int ui0 = __builtin_amdgcn_readfirstlane((int)MISC[0]);
                if (ui0 == -1) break;
                int ui = ui0;
                { const int grp = ui0 & 0x7fff;
                    if (ui0 & 0x8000) {
                        const int pi = grp, t3 = opaque_tid(wave0), ln = t3 & 63;
                        { const float* pu = INL(15, (size_t)NEXP * DM); const float* pv = INL(16, (size_t)NEXP * DM); unsigned char* U8 = WSP(unsigned char, WS_U); unsigned char* V8 = WSP(unsigned char, WS_V); float* SU = WSP(float, WS_SU);
                          const int e0 = 32 * pi + 4 * wave0; LAS float* scr = (LAS float*)(ldsl + wave0 * 8448);
                          const int tpi = layer == 0 ? (I_OWN + I_IN) / NPREP : I_OWN / NPREP;
                          struct TDsc { const float* W; const float* gk; bf16* WT; unsigned char* WT8; int N, k0, n0, col_off, rowd, fp8; };
                          auto tdesc = [&](int r) -> TDsc { TDsc d; d.WT8 = nullptr; d.WT = nullptr; d.gk = nullptr; d.fp8 = 0; d.rowd = 0; d.col_off = 0; d.N = DM;
                              if (r < I_A) { d.W = INL(6, 512 * DM); d.WT = WSP(bf16, WS_WCAT); }
                              else if ((r -= I_A) < I_A) { d.W = INL(7, 512 * DM); d.WT = WSP(bf16, WS_WCAT); d.col_off = 512; }
                              else if ((r -= I_A) < I_C) { d.W = INL(8, 1024 * DM); d.WT = WSP(bf16, WS_WCAT); d.col_off = 1024; }
                              else if ((r -= I_C) < I_SQ) { d.W = INL(11, DM * DM); d.WT = WSP(bf16, WS_WO); }
                              else if ((r -= I_SQ) < I_SQ) { d.W = INL(13, DM * DM); d.WT = WSP(bf16, WS_WQ); d.gk = INL(12, DM); }
                              else { r -= I_SQ; d.W = INP(4) + (size_t)DM * INW; d.N = INW; d.WT = WSP(bf16, WS_WIN); const int ct = ((r % (INW / 32)) * 32) >> 8;
                                  if (ct >= 28 && ct < 32) d.rowd = -26 * 256; else if (ct >= 2) { d.fp8 = 1; d.WT8 = WSP(unsigned char, WS_WG8); d.rowd = ct < 28 ? 2 * 256 : 6 * 256; } }
                              const int nblk = d.N / 32; d.k0 = 64 * (r / nblk); d.n0 = 32 * (r % nblk); return d; };
                          f32x4 buf[4][8];
#define PP_ISSUE(k) do { if ((k) < 8) { const GAS f32x4* rp_ = (const GAS f32x4*)(((k) < 4 ? pu : pv) + (size_t)(e0 + ((k) & 3)) * DM) + ln; \
                              _Pragma("unroll") for (int j_ = 0; j_ < 8; ++j_) buf[(k) & 3][j_] = __builtin_nontemporal_load(rp_ + 64 * j_); } \
                          else if (wave0 + NWAVES * ((k) - 8) < tpi) { const TDsc d_ = tdesc(pi * tpi + wave0 + NWAVES * ((k) - 8)); tr_issue(buf[(k) & 3], d_.W, d_.N, d_.k0, d_.n0, ln); } } while (0)
                          PP_ISSUE(0); PP_ISSUE(1); PP_ISSUE(2); PP_ISSUE(3);
#pragma unroll
                          for (int k = 0; k < 13; ++k) { f32x4 (&y)[8] = buf[k & 3];
                              if (k < 4) { const int e = e0 + k; float mx = 0.f;
                                  { const GAS f32x4* gp_ = (const GAS f32x4*)INL(12, DM) + ln;
#pragma unroll
                                    for (int j = 0; j < 8; ++j) y[j] = y[j] * gp_[64 * j]; }
#pragma unroll
                                  for (int j = 0; j < 8; ++j) mx = fmaxf(mx, fmaxf(fmaxf(fabsf(y[j].x), fabsf(y[j].y)), fmaxf(fabsf(y[j].z), fabsf(y[j].w))));
                                  mx = fmaxf(wave_maxf(mx), 1e-30f); const float inv = 127.f / mx;
#pragma unroll
                                  for (int j = 0; j < 8; ++j) ((GAS unsigned*)(U8 + (size_t)j * ((size_t)NEXP * 256) + (size_t)e * 256))[ln] = q8x4(y[j].x, y[j].y, y[j].z, y[j].w, inv);
                                  if (ln == 0) SU[e] = mx * (1.f / 127.f); }
                              else if (k < 8) { const int e = e0 + (k - 4);
#pragma unroll
                                  for (int j = 0; j < 8; ++j) { int w = __builtin_amdgcn_cvt_pk_fp8_f32(y[j].x * 64.f, y[j].y * 64.f, 0, false); w = __builtin_amdgcn_cvt_pk_fp8_f32(y[j].z * 64.f, y[j].w * 64.f, w, true);
                                      ((GAS unsigned*)(V8 + (size_t)j * ((size_t)NEXP * 256) + (size_t)e * 256))[ln] = (unsigned)w; } }
                              else if (wave0 + NWAVES * (k - 8) < tpi) { const TDsc d = tdesc(pi * tpi + wave0 + NWAVES * (k - 8));
                                  if (d.fp8) tr_finish_fp8(y, scr, d.WT8, DM, 1024.f, d.k0, d.n0, d.rowd, ln); else tr_finish_bf16(y, scr, d.WT, DM, d.col_off, d.k0, d.n0, d.rowd, ln, d.gk); }
                              if (k + 4 < 13) PP_ISSUE(k + 4);
                          }
#undef PP_ISSUE
                        }
                        continue;
                    }
                }
                attn::Unit u; int hd;
                if (ui < 1024) {
                    const int qb = ui & 15, vh = (ui >> 4) & 1, m = (ui >> 5) & 1, h = (ui >> 6) & 3, b = ui >> 8;
                    const bf16* base = PROJ + (size_t)b * SEQ * PJW;
                    u.Q = base + (size_t)(qb * 256) * PJW + COL_DIFF + (h * 2 + m) * 128; u.K = base + COL_DIFF + 1024 + (h * 2 + m) * 128; u.V = base + COL_DIFF + 2048 + h * 256 + vh * 128;
                    u.O = DO + (size_t)(b * SEQ + qb * 256) * DM + (h * 2 + m) * 256 + vh * 128; u.lse = nullptr; u.ldq = PJW; u.ldk = PJW; u.ldo = DM; u.lse_ld = 0;
                    u.kt0 = 0; u.nt = SEQ / 64; u.qoff = qb * 256; hd = 12 + h;
                } else {
                    const int v = ui - 1024, qb16 = v & 15, hh = (v >> 4) & 3, bg = v >> 6, g = bg % 3, b = bg / 3;
                    const int dil = g == 0 ? 1 : (g == 1 ? 4 : 16), bpc = 16 / dil, r = qb16 / bpc, qblk = qb16 % bpc, q0 = qblk * 256, ntot = (SEQ / dil) / 64;
                    int kt0 = q0 / 64 - 1; if (kt0 < 0) kt0 = 0; int kt1 = q0 / 64 + 5; if (kt1 > ntot) kt1 = ntot;
                    if ((kt1 - kt0) & 1) { if (kt0 > 0) --kt0; else ++kt1; }
                    const bf16* base = PROJ + (size_t)(b * SEQ + r) * PJW + COL_DIL + g * 512 + hh * 128;
                    u.Q = base + (size_t)q0 * dil * PJW; u.K = base + 1536; u.V = base + 3072;
                    u.O = DL + ((size_t)g * MTOK + b * SEQ + r + (size_t)q0 * dil) * 512 + hh * 128; u.lse = LSE + ((size_t)g * MTOK + b * SEQ + r + (size_t)q0 * dil) * 4 + hh;
                    u.ldq = (long)PJW * dil; u.ldk = (long)PJW * dil; u.ldo = 512L * dil; u.lse_ld = 4 * dil; u.kt0 = kt0; u.nt = kt1 - kt0; u.qoff = q0; hd = g * 4 + hh;
                }
                const float* tab = TAB + (size_t)hd * 8192;
                if (tab != cur_tab) {
                    cur_tab = tab;
                    LAS f32x4* tl = (LAS f32x4*)(ldsl + attn::LDS_TAB); const int t2 = opaque_tid(wave0);
#pragma unroll
                    for (int j = 0; j < 4; ++j) tl[t2 + 512 * j] = ((const GAS f32x4*)tab)[t2 + 512 * j];
                }
                attn::attn_unit(u, (char*)lds, wave0);
            }
        }
#endif
#endif
        GRID_BAR();

#if PH_E
        {
            PH_IDS();
            const float* dlam = INL(9, 512); const float* subln = INL(10, 256); const float lambda_init = layer == 0 ? 0.2f : 0.35550906759f;
            const float* LSE = WSP(float, WS_LSE); const bf16* DL = WSP(bf16, WS_H); const bf16* DO = WSP(bf16, WS_MG); bf16* OC = WSP(bf16, WS_OC);
            float s1 = dlam[lane] * dlam[128 + lane] + dlam[64 + lane] * dlam[192 + lane], s2 = dlam[256 + lane] * dlam[384 + lane] + dlam[320 + lane] * dlam[448 + lane];
            s1 = wave_sum(s1); s2 = wave_sum(s2);
            const float lam = __expf(s1) - __expf(s2) + lambda_init, osc = 1.0f - lambda_init;
            const int hq = lane >> 4, l16 = lane & 15;
            const f32x4 g0 = *(const GAS f32x4*)(subln + l16 * 16), g1 = *(const GAS f32x4*)(subln + l16 * 16 + 4), g2 = *(const GAS f32x4*)(subln + l16 * 16 + 8), g3 = *(const GAS f32x4*)(subln + l16 * 16 + 12);
            for (int t = gw; t < MTOK; t += 4 * NGW) {
                float ls[4][3]; v4u dl[4][3], da[4][4];
#pragma unroll
                for (int u = 0; u < 4; ++u) { const int tt = t + u * NGW;
#pragma unroll
                    for (int g = 0; g < 3; ++g) { ls[u][g] = LSE[((size_t)g * MTOK + tt) * 4 + hq]; dl[u][g] = *(const GAS v4u*)(DL + ((size_t)g * MTOK + tt) * 512 + lane * 8); }
                    const bf16* dp = DO + (size_t)tt * DM + hq * 512 + l16 * 16;
                    da[u][0] = *(const GAS v4u*)(dp); da[u][1] = *(const GAS v4u*)(dp + 8); da[u][2] = *(const GAS v4u*)(dp + 256); da[u][3] = *(const GAS v4u*)(dp + 264); }
#pragma unroll
                for (int u = 0; u < 4; ++u) { const int tt = t + u * NGW;
                    float mx = fmaxf(fmaxf(ls[u][0], ls[u][1]), ls[u][2]), wsum = 0.f;
#pragma unroll
                    for (int g = 0; g < 3; ++g) { ls[u][g] = __expf(ls[u][g] - mx); wsum += ls[u][g]; }
                    const float winv = 1.0f / wsum; float acc8[8] = {0.f, 0.f, 0.f, 0.f, 0.f, 0.f, 0.f, 0.f};
#pragma unroll
                    for (int g = 0; g < 3; ++g) { const v4u o = dl[u][g]; const float w = ls[u][g] * winv;
                        acc8[0] += w * bflo(o.x); acc8[1] += w * bfhi(o.x); acc8[2] += w * bflo(o.y); acc8[3] += w * bfhi(o.y); acc8[4] += w * bflo(o.z); acc8[5] += w * bfhi(o.z); acc8[6] += w * bflo(o.w); acc8[7] += w * bfhi(o.w); }
                    { v4u o; o.x = pk2(acc8[0], acc8[1]); o.y = pk2(acc8[2], acc8[3]); o.z = pk2(acc8[4], acc8[5]); o.w = pk2(acc8[6], acc8[7]); *(GAS v4u*)(OC + (size_t)tt * DM + 512 + lane * 8) = o; }
                    const v4u a0 = da[u][0], a1 = da[u][1], b0 = da[u][2], b1 = da[u][3];
                    float d[16];
                    d[0] = bflo(a0.x) - lam * bflo(b0.x); d[1] = bfhi(a0.x) - lam * bfhi(b0.x); d[2] = bflo(a0.y) - lam * bflo(b0.y); d[3] = bfhi(a0.y) - lam * bfhi(b0.y);
                    d[4] = bflo(a0.z) - lam * bflo(b0.z); d[5] = bfhi(a0.z) - lam * bfhi(b0.z); d[6] = bflo(a0.w) - lam * bflo(b0.w); d[7] = bfhi(a0.w) - lam * bfhi(b0.w);
                    d[8] = bflo(a1.x) - lam * bflo(b1.x); d[9] = bfhi(a1.x) - lam * bfhi(b1.x); d[10] = bflo(a1.y) - lam * bflo(b1.y); d[11] = bfhi(a1.y) - lam * bfhi(b1.y);
                    d[12] = bflo(a1.z) - lam * bflo(b1.z); d[13] = bfhi(a1.z) - lam * bfhi(b1.z); d[14] = bflo(a1.w) - lam * bflo(b1.w); d[15] = bfhi(a1.w) - lam * bfhi(b1.w);
                    float ss = 0.f;
#pragma unroll
                    for (int j = 0; j < 16; ++j) ss += d[j] * d[j];
                    ss += sx_f<1>(ss); ss += sx_f<2>(ss); ss += sx_f<4>(ss); ss += sx_f<8>(ss);
                    const float rs = osc / sqrtf(ss * (1.f / 256.f) + RMS_EPS);
                    v4u o0, o1;
                    o0.x = pk2(d[0] * rs * g0.x, d[1] * rs * g0.y); o0.y = pk2(d[2] * rs * g0.z, d[3] * rs * g0.w); o0.z = pk2(d[4] * rs * g1.x, d[5] * rs * g1.y); o0.w = pk2(d[6] * rs * g1.z, d[7] * rs * g1.w);
                    o1.x = pk2(d[8] * rs * g2.x, d[9] * rs * g2.y); o1.y = pk2(d[10] * rs * g2.z, d[11] * rs * g2.w); o1.z = pk2(d[12] * rs * g3.x, d[13] * rs * g3.y); o1.w = pk2(d[14] * rs * g3.z, d[15] * rs * g3.w);
                    bf16* op = OC + (size_t)tt * DM + 1024 + hq * 256 + l16 * 16;
                    *(GAS v4u*)(op) = o0; *(GAS v4u*)(op + 8) = o1; }
            }
        }
#endif
        GRID_BAR();

#if PH_F
        {
            pg8::MergeOrder S; S.init(MTOK, DM, G, bx, DM, DM);
            pg8::Gemm g{WSP(bf16, WS_OC), WSP(bf16, WS_WCAT)}; pg8::EpiMerge4 E{WSP(unsigned char, WS_G), WSP(bf16, WS_MG)};
            pg8::gemm_phase<pg8::EpiMerge4, pg8::MergeOrder, true, DM, DM, 512>(ldsl, g, S, E, wave0);
        }
#endif
        GRID_BAR();

#if PH_G
        {
            pg8::Gemm g{WSP(bf16, WS_MG), WSP(bf16, WS_WO)}; pg8::StaticOrder S; S.init(MTOK, DM, G, bx, DM, DM);
            pg8::EpiResX E{layer == 0 ? INP(0) : (const float*)nullptr, X16, X16, WSP(unsigned char, WS_H8), WSP(float, WS_SSP)};
            pg8::gemm_phase<pg8::EpiResX, pg8::StaticOrder, true, DM, DM, DM>(ldsl, g, S, E, wave0);
        }
#endif
        GRID_BAR();

#if PH_I
        {
            pg8::Gemm g{X16, WSP(bf16, WS_WQ)}; pg8::StaticOrder S; S.init(MTOK, DM, G, bx, DM, DM);
            pg8::EpiStoreRS E{WSP(bf16, WS_Q), DM, WSP(float, WS_SSP)};
            pg8::gemm_phase<pg8::EpiStoreRS, pg8::StaticOrder, true, DM, DM, DM>(ldsl, g, S, E, wave0);
        }
#endif
        GRID_BAR();

#if PH_K
        {
            PH_IDS();
            const bf16* Q = WSP(bf16, WS_Q); int* IDS = WSP(int, WS_IDS); float* GATES = WSP(float, WS_GATES);
            const int l16 = lane & 15, rbase = lane & 48, fq = lane >> 4;
            constexpr int SKP = 272;
            { const float* subk = INL(14, 2 * 128 * 128);
#pragma unroll
              for (int j = 0; j < 8; ++j) { const int ci = tid + 512 * j, kr = ci >> 4, c8 = ci & 15; const GAS f32x4* sp = (const GAS f32x4*)(subk + (size_t)kr * 128 + c8 * 8); const f32x4 lo = sp[0], hi4 = sp[1];
                  v4u w; w.x = pk2(lo.x, lo.y); w.y = pk2(lo.z, lo.w); w.z = pk2(hi4.x, hi4.y); w.w = pk2(hi4.z, hi4.w); *(LAS v4u*)(ldsl + kr * SKP + c8 * 16) = w; } }
            __syncthreads();
            int cq[4];
#pragma unroll
            for (int q = 0; q < 4; ++q) { int c = l16 + 16 * q, ci = -1, cj = 0; for (int i = 0; i < 16; ++i) { const int cnt = 16 / (i + 1); if (ci < 0) { if (c < cnt) { ci = i; cj = c; } else c -= cnt; } } cq[q] = ci < 0 ? -1 : ci * 16 + cj; }
            typedef short bfx8 __attribute__((ext_vector_type(8)));
            const LAS unsigned char* skl = ldsl + l16 * SKP + fq * 16;
            bfx8 nq[8];
            { const GAS bfx8* qp = (const GAS bfx8*)(Q + (size_t)(gw * 16 + l16) * 256 + fq * 8);
#pragma unroll
              for (int j = 0; j < 8; ++j) nq[j] = qp[4 * j]; }
            const int NTRIP = MTOK * 8 / 16;
            for (int trip = gw; trip < NTRIP; trip += NGW) {
                pg8::f32x4 sa[8], sb[8];
#pragma unroll
                for (int nb = 0; nb < 8; ++nb) { sa[nb] = (pg8::f32x4){0.f, 0.f, 0.f, 0.f}; sb[nb] = (pg8::f32x4){0.f, 0.f, 0.f, 0.f}; }
#pragma unroll
                for (int ks = 0; ks < 4; ++ks)
#pragma unroll
                    for (int n4 = 0; n4 < 8; n4 += 4) {
#pragma unroll
                        for (int nb = n4; nb < n4 + 4; ++nb) { const bfx8 ka_ = *(const LAS bfx8*)(skl + (nb * 16) * SKP + ks * 64), kb_ = *(const LAS bfx8*)(skl + (128 + nb * 16) * SKP + ks * 64);
                            sa[nb] = __builtin_amdgcn_mfma_f32_16x16x32_bf16(nq[ks], ka_, sa[nb], 0, 0, 0); sb[nb] = __builtin_amdgcn_mfma_f32_16x16x32_bf16(nq[4 + ks], kb_, sb[nb], 0, 0, 0); }
                        __builtin_amdgcn_sched_barrier(0); }
                { const int nt = trip + NGW < NTRIP ? trip + NGW : trip; const GAS bfx8* qp = (const GAS bfx8*)(Q + (size_t)(nt * 16 + l16) * 256 + fq * 8);
#pragma unroll
                  for (int j = 0; j < 8; ++j) nq[j] = qp[4 * j]; }
#pragma unroll
              for (int p4 = 0; p4 < 4; ++p4) {
                const int row = trip * 16 + 4 * fq + p4;
                unsigned ka[8], kb[8];
#pragma unroll
                for (int jj = 0; jj < 8; ++jj) { const unsigned ix = (unsigned)(127 - (jj * 16 + l16)); ka[jj] = (okey(sa[jj][p4]) & ~127u) | ix; kb[jj] = (okey(sb[jj][p4]) & ~127u) | ix; }
#define SORT8(k) do { CE_DESC(k[0], k[1]); CE_DESC(k[2], k[3]); CE_DESC(k[4], k[5]); CE_DESC(k[6], k[7]); CE_DESC(k[0], k[2]); CE_DESC(k[1], k[3]); CE_DESC(k[4], k[6]); CE_DESC(k[5], k[7]); \
    CE_DESC(k[1], k[2]); CE_DESC(k[5], k[6]); CE_DESC(k[0], k[4]); CE_DESC(k[3], k[7]); CE_DESC(k[1], k[5]); CE_DESC(k[2], k[6]); CE_DESC(k[1], k[4]); CE_DESC(k[3], k[6]); \
    CE_DESC(k[2], k[4]); CE_DESC(k[3], k[5]); CE_DESC(k[3], k[4]); } while (0)
                SORT8(ka); SORT8(kb);
                unsigned ta = 0u, tb = 0u;
#pragma unroll
                for (int r = 0; r < 16; ++r) {
                    const unsigned ma = row_max16_u(ka[0]), mb = row_max16_u(kb[0]);
                    const bool wa = ka[0] == ma, wb = kb[0] == mb;
                    ta = (l16 == r) ? ma : ta; tb = (l16 == r) ? mb : tb;
#pragma unroll
                    for (int q = 0; q < 7; ++q) { ka[q] = wa ? ka[q + 1] : ka[q]; kb[q] = wb ? kb[q + 1] : kb[q]; }
                    ka[7] = wa ? 0u : ka[7]; kb[7] = wb ? 0u : kb[7];
                }
                const int ia = 127 - (int)(ta & 127u), ib = 127 - (int)(tb & 127u);
                const float va = okey_inv(ta & ~127u), vb = okey_inv(tb & ~127u);
                unsigned ck[4];
#pragma unroll
                for (int q = 0; q < 4; ++q) { const int cc = cq[q] < 0 ? 0 : cq[q]; const float cs = bperm_f(va, rbase + (cc >> 4)) + bperm_f(vb, rbase + (cc & 15));
                    ck[q] = cq[q] < 0 ? 0u : ((okey(cs) & ~255u) | (unsigned)(255 - cc)); }
                CE_DESC(ck[0], ck[1]); CE_DESC(ck[2], ck[3]); CE_DESC(ck[0], ck[2]); CE_DESC(ck[1], ck[3]); CE_DESC(ck[1], ck[2]);
                unsigned tw = 0u;
#pragma unroll
                for (int r = 0; r < 16; ++r) { const unsigned mm = row_max16_u(ck[0]); const bool w = ck[0] == mm; tw = (l16 == r) ? mm : tw;
                    ck[0] = w ? ck[1] : ck[0]; ck[1] = w ? ck[2] : ck[1]; ck[2] = w ? ck[3] : ck[2]; ck[3] = w ? 0u : ck[3]; }
                const int code = 255 - (int)(tw & 255u), wi = (code >> 4) & 15, wj = code & 15;
                const float bs = bperm_f(va, rbase + wi) + bperm_f(vb, rbase + wj);
                const int eid = bperm_i(ia, rbase + wi) * 128 + bperm_i(ib, rbase + wj);
                const float mx = row_max16_f(bs), e = __expf(bs - mx), es = row_sum16(e);
                IDS[(size_t)row * 16 + l16] = eid; GATES[(size_t)row * 16 + l16] = e / es;
              }
            }
#undef SORT8
        }
#endif
        GRID_BAR();

#if PH_L
#define L_LDIDS(I, tt, hh) do { const GAS v4u* ip_ = (const GAS v4u*)(IDS + (size_t)(tt) * 128 + (hh) * 64 + lrow * 16); I##0 = ip_[0]; I##1 = ip_[1]; I##2 = ip_[2]; I##3 = ip_[3]; } while (0)
#define L_ISSUE(W, I, base) do { \
    W[0] = *(const GAS v4u*)((base) + (size_t)(I##0).x * 256); W[1] = *(const GAS v4u*)((base) + (size_t)(I##0).y * 256); W[2] = *(const GAS v4u*)((base) + (size_t)(I##0).z * 256); W[3] = *(const GAS v4u*)((base) + (size_t)(I##0).w * 256); \
    W[4] = *(const GAS v4u*)((base) + (size_t)(I##1).x * 256); W[5] = *(const GAS v4u*)((base) + (size_t)(I##1).y * 256); W[6] = *(const GAS v4u*)((base) + (size_t)(I##1).z * 256); W[7] = *(const GAS v4u*)((base) + (size_t)(I##1).w * 256); \
    W[8] = *(const GAS v4u*)((base) + (size_t)(I##2).x * 256); W[9] = *(const GAS v4u*)((base) + (size_t)(I##2).y * 256); W[10] = *(const GAS v4u*)((base) + (size_t)(I##2).z * 256); W[11] = *(const GAS v4u*)((base) + (size_t)(I##2).w * 256); \
    W[12] = *(const GAS v4u*)((base) + (size_t)(I##3).x * 256); W[13] = *(const GAS v4u*)((base) + (size_t)(I##3).y * 256); W[14] = *(const GAS v4u*)((base) + (size_t)(I##3).z * 256); W[15] = *(const GAS v4u*)((base) + (size_t)(I##3).w * 256); } while (0)
#define L_CVT(d, hi) __builtin_amdgcn_cvt_pk_f32_fp8((int)(d), (hi))
        {
            PH_IDS();
            const unsigned char* H8 = WSP(unsigned char, WS_H8); const unsigned char* U8 = WSP(unsigned char, WS_U); const int* IDS = WSP(int, WS_IDS); float* PART = WSP(float, WS_G);
            typedef float f32x2 __attribute__((ext_vector_type(2)));
            const int myx = (int)(xb_xcc_id() & 7u); int nx = 0, xi = 0, nloc = 1;
            for (int j = 0; j < 8; ++j) { const int c = (int)__hip_atomic_load(ctl + CW_XRANK + 64 * j, __ATOMIC_RELAXED, __HIP_MEMORY_SCOPE_AGENT); if (c > 0) { ++nx; if (j < myx) ++xi; } if (j == myx) nloc = c; }
            const int rw = (int)MISC[1] * NWAVES + wave, nW = nloc * NWAVES; const int l16 = lane & 15, lrow = lane >> 4;
#define L1_COMPUTE(W, dst) do { float sk[16]; _Pragma("unroll") for (int k = 0; k < 16; ++k) { const v4u ww = W[k]; int ac = 0; \
        ac = __builtin_amdgcn_sdot4((int)ww.x, (int)h0.x, ac, false); ac = __builtin_amdgcn_sdot4((int)ww.y, (int)h0.y, ac, false); ac = __builtin_amdgcn_sdot4((int)ww.z, (int)h0.z, ac, false); ac = __builtin_amdgcn_sdot4((int)ww.w, (int)h0.w, ac, false); \
        sk[k] = (float)ac; } \
          \
        float t8[8]; _Pragma("unroll") for (int j = 0; j < 8; ++j) { const float keep = b8 ? sk[8 + j] : sk[j], send = b8 ? sk[j] : sk[8 + j]; \
            t8[j] = keep + __int_as_float(__builtin_amdgcn_update_dpp(0, __float_as_int(send), 0x128, 0xF, 0xF, false)); } \
        float t4[4]; _Pragma("unroll") for (int j = 0; j < 4; ++j) { const float keep = b4 ? t8[4 + j] : t8[j], send = b4 ? t8[j] : t8[4 + j]; t4[j] = keep + sx_f<4>(send); } \
        float t2[2]; _Pragma("unroll") for (int j = 0; j < 2; ++j) { const float keep = b2 ? t4[2 + j] : t4[j], send = b2 ? t4[j] : t4[2 + j]; \
            t2[j] = keep + __int_as_float(__builtin_amdgcn_update_dpp(0, __float_as_int(send), 0x4E, 0xF, 0xF, false)); } \
        { const float keep = b1 ? t2[1] : t2[0], send = b1 ? t2[0] : t2[1]; dst = keep + __int_as_float(__builtin_amdgcn_update_dpp(0, __float_as_int(send), 0xB1, 0xF, 0xF, false)); } } while (0)
            const bool b8 = (lane & 8) != 0, b4 = (lane & 4) != 0, b2 = (lane & 2) != 0, b1 = (lane & 1) != 0;
            for (int sl = xi; sl < 8; sl += nx) {
                const unsigned char* ub = U8 + (size_t)sl * ((size_t)NEXP * 256) + l16 * 16; const unsigned char* hb = H8 + sl * 256 + l16 * 16;
                int t = rw;
                if (t < MTOK) {
                    v4u Wa[16], Wb[16]; v4u ia0, ia1, ia2, ia3, ib0, ib1, ib2, ib3; v4u h0;
                    L_LDIDS(ia, t, 0); L_LDIDS(ib, t, 1); h0 = *(const GAS v4u*)(hb + (size_t)t * DM);
                    L_ISSUE(Wa, ia, ub);
                    for (;;) {
                        const int tn = t + nW; const bool more = tn < MTOK; const int tp = more ? tn : t;
                        L_ISSUE(Wb, ib, ub);
                        L_LDIDS(ia, tp, 0); const v4u hn0 = *(const GAS v4u*)(hb + (size_t)tp * DM);
                        float pre0, pre1;
                        L1_COMPUTE(Wa, pre0);
                        L_ISSUE(Wa, ia, ub);
                        L_LDIDS(ib, tp, 1);
                        L1_COMPUTE(Wb, pre1);
                        float* pp = PART + ((size_t)sl * MTOK + t) * 128; pp[lane] = pre0; pp[64 + lane] = pre1;
                        h0 = hn0;
                        if (!more) break;
                        t = tn;
                    }
                }
            }
#undef L1_COMPUTE
        }
        GRID_BAR();
        {
            PH_IDS();
            const float* PART = WSP(float, WS_G); const float* GATES = WSP(float, WS_GATES); float* ACTW = WSP(float, WS_ACT);
            for (int t = gw; t < MTOK; t += NGW) {
                float q0 = 0.f, q1 = 0.f;
#pragma unroll
                for (int s8 = 0; s8 < 8; ++s8) { const float* pp = PART + ((size_t)s8 * MTOK + t) * 128; q0 += pp[lane]; q1 += pp[64 + lane]; }
                { const int* ip = WSP(int, WS_IDS) + (size_t)t * 128; float sh; { const float pv = lane < 32 ? WSP(float, WS_SSP)[(size_t)t * 32 + lane] : 0.f; sh = (1.0f / sqrtf(wave_sum(pv) * (1.f / DM) + RMS_EPS)) * (1.f / pg8::XS8); }     const float* SU = WSP(float, WS_SU); q0 *= SU[ip[lane]] * sh; q1 *= SU[ip[64 + lane]] * sh; }
                const float* gp = GATES + (size_t)t * 128; float* ap = ACTW + (size_t)t * 128;
                const float g0 = gp[lane], g1 = gp[64 + lane];
                ap[lane] = 0.5f * q0 * (1.0f + erff(q0 * 0.70710678118654752f)) * g0 * (1.f / 64.f); ap[64 + lane] = 0.5f * q1 * (1.0f + erff(q1 * 0.70710678118654752f)) * g1 * (1.f / 64.f);
            }
        }
        GRID_BAR();
        {
            PH_IDS();
            const unsigned char* V8 = WSP(unsigned char, WS_V); const int* IDS = WSP(int, WS_IDS); const float* ACT = WSP(float, WS_ACT);
            typedef float f32x2 __attribute__((ext_vector_type(2)));
            const int myx = (int)(xb_xcc_id() & 7u); int nx = 0, xi = 0, nloc = 1;
            for (int j = 0; j < 8; ++j) { const int c = (int)__hip_atomic_load(ctl + CW_XRANK + 64 * j, __ATOMIC_RELAXED, __HIP_MEMORY_SCOPE_AGENT); if (c > 0) { ++nx; if (j < myx) ++xi; } if (j == myx) nloc = c; }
            const int rw = (int)MISC[1] * NWAVES + wave, nW = nloc * NWAVES; const int l16 = lane & 15, lrow = lane >> 4;
            bf16* XO = X16;
#define L2_BC(av, acr) do { _Pragma("unroll") for (int k = 0; k < 16; ++k) av[k] = bperm_f(acr, (lane & 48) + k); } while (0)
#define L2_C4(Q, av, o) do { _Pragma("unroll") for (int k = 0; k < 4; ++k) { const float a = av[(o) + k]; const f32x2 aa = (f32x2){a, a}; \
        const v4u ww = Q[k]; const unsigned d0 = ww.x, d1 = ww.y, d2 = ww.z, d3 = ww.w; \
        oacc[0] += aa * L_CVT(d0, false); oacc[1] += aa * L_CVT(d0, true); oacc[2] += aa * L_CVT(d1, false); oacc[3] += aa * L_CVT(d1, true); \
        oacc[4] += aa * L_CVT(d2, false); oacc[5] += aa * L_CVT(d2, true); oacc[6] += aa * L_CVT(d3, false); oacc[7] += aa * L_CVT(d3, true); } } while (0)
#define L_ISS4(Q, Ia) do { Q[0] = *(const GAS v4u*)(vb + (size_t)(Ia).x * 256); Q[1] = *(const GAS v4u*)(vb + (size_t)(Ia).y * 256); Q[2] = *(const GAS v4u*)(vb + (size_t)(Ia).z * 256); Q[3] = *(const GAS v4u*)(vb + (size_t)(Ia).w * 256); } while (0)
            for (int sl = xi; sl < 8; sl += nx) {
                const unsigned char* vb = V8 + (size_t)sl * ((size_t)NEXP * 256) + l16 * 16; bf16* xb = XO + sl * 256 + l16 * 16;
                int t = rw;
                if (t < MTOK) {
                    v4u Q0[4], Q1[4], Q2[4], Q3[4], Q4[4], Q5[4], Q6[4], Q7[4]; v4u ia0, ia1, ia2, ia3, ib0, ib1, ib2, ib3; float ac0, ac1;
                    L_LDIDS(ia, t, 0); L_LDIDS(ib, t, 1); ac0 = ACT[(size_t)t * 128 + lane]; ac1 = ACT[(size_t)t * 128 + 64 + lane];
                    L_ISS4(Q0, ia0); L_ISS4(Q1, ia1); L_ISS4(Q2, ia2); L_ISS4(Q3, ia3); L_ISS4(Q4, ib0); L_ISS4(Q5, ib1); L_ISS4(Q6, ib2); L_ISS4(Q7, ib3);
                    for (;;) {
                        const int tn = t + nW; const bool more = tn < MTOK; const int tp = more ? tn : t;
                        L_LDIDS(ia, tp, 0); L_LDIDS(ib, tp, 1); const float an0 = ACT[(size_t)tp * 128 + lane], an1 = ACT[(size_t)tp * 128 + 64 + lane];
                        f32x2 oacc[8];
#pragma unroll
                        for (int k = 0; k < 8; ++k) oacc[k] = (f32x2){0.f, 0.f};
                        float av[16];
                        L2_BC(av, ac0);
                        L2_C4(Q0, av, 0); L_ISS4(Q0, ia0);
                        L2_C4(Q1, av, 4); L_ISS4(Q1, ia1);
                        L2_C4(Q2, av, 8); L_ISS4(Q2, ia2);
                        L2_C4(Q3, av, 12); L_ISS4(Q3, ia3);
                        v4u xv[2]; { const GAS v4u* q = (const GAS v4u*)(xb + (size_t)t * DM); xv[0] = q[0]; xv[1] = q[1]; }
                        L2_BC(av, ac1);
                        L2_C4(Q4, av, 0); L_ISS4(Q4, ib0);
                        L2_C4(Q5, av, 4); L_ISS4(Q5, ib1);
                        L2_C4(Q6, av, 8); L_ISS4(Q6, ib2);
                        L2_C4(Q7, av, 12); L_ISS4(Q7, ib3);
#pragma unroll
                        for (int k = 0; k < 8; ++k) { float a = oacc[k].x, b = oacc[k].y; a += sx_f<16>(a); b += sx_f<16>(b); a = add32(a); b = add32(b); oacc[k] = (f32x2){a, b}; }
                        if (lane < 16) { GAS v4u* q = (GAS v4u*)(xb + (size_t)t * DM);
#pragma unroll
                            for (int k = 0; k < 2; ++k) { const v4u xw = xv[k]; v4u o;
                                o.x = pk2(bflo(xw.x) + oacc[4 * k].x, bfhi(xw.x) + oacc[4 * k].y); o.y = pk2(bflo(xw.y) + oacc[4 * k + 1].x, bfhi(xw.y) + oacc[4 * k + 1].y);
                                o.z = pk2(bflo(xw.z) + oacc[4 * k + 2].x, bfhi(xw.z) + oacc[4 * k + 2].y); o.w = pk2(bflo(xw.w) + oacc[4 * k + 3].x, bfhi(xw.w) + oacc[4 * k + 3].y); q[k] = o; } }
                        ac0 = an0; ac1 = an1;
                        if (!more) break;
                        t = tn;
                    }
                }
            }
#undef L2_BC
#undef L2_C4
#undef L_ISS4
        }
#undef L_LDIDS
#undef L_ISSUE
#undef L_CVT
#endif
        GRID_BAR();
    }

    { PH_IDS(); const bf16* XS = X16;
    for (int m0 = gw; m0 < MTOK; m0 += 4 * NGW) {
        const GAS f32x4* gr = (const GAS f32x4*)INP(2) + 2 * lane;
        v4u xv[4][4];
#pragma unroll
        for (int u = 0; u < 4; ++u) { const GAS v4u* xr = (const GAS v4u*)(XS + (size_t)(m0 + u * NGW) * DM) + lane;
#pragma unroll
            for (int j = 0; j < 4; ++j) xv[u][j] = xr[64 * j]; }
#pragma unroll
        for (int u = 0; u < 4; ++u) { float v[4][8]; float s = 0.f;
#pragma unroll
            for (int j = 0; j < 4; ++j) { const v4u w = xv[u][j]; v[j][0] = bflo(w.x); v[j][1] = bfhi(w.x); v[j][2] = bflo(w.y); v[j][3] = bfhi(w.y); v[j][4] = bflo(w.z); v[j][5] = bfhi(w.z); v[j][6] = bflo(w.w); v[j][7] = bfhi(w.w);
#pragma unroll
                for (int k = 0; k < 8; ++k) s += v[j][k] * v[j][k]; }
            const float rstd = 1.0f / sqrtf(wave_sum(s) * (1.f / DM) + RMS_EPS);
            GAS f32x4* orow = (GAS f32x4*)(X + (size_t)(m0 + u * NGW) * DM) + 2 * lane;
#pragma unroll
            for (int j = 0; j < 4; ++j) { const f32x4 ga = gr[128 * j], gb = gr[128 * j + 1];
                orow[128 * j] = (f32x4){v[j][0] * rstd * ga.x, v[j][1] * rstd * ga.y, v[j][2] * rstd * ga.z, v[j][3] * rstd * ga.w};
                orow[128 * j + 1] = (f32x4){v[j][4] * rstd * gb.x, v[j][5] * rstd * gb.y, v[j][6] * rstd * gb.z, v[j][7] * rstd * gb.w}; } }
    } }
}

extern "C" void kernel_launch(void* const* d_in, const int* in_sizes, int n_in, void* d_out, int out_size, void* d_ws, size_t ws_size, hipStream_t stream) {
    static int grid = 0;
    if (grid == 0) {
        if (n_in != 17 || in_sizes[0] != MTOK * DM || out_size != MTOK * DM || ws_size < WS_END) {
            fprintf(stderr, "kernel_launch: shape/workspace mismatch: n_in %d in0 %d out %d ws %zu (need %zu); nothing launched\n", n_in, n_in > 0 ? in_sizes[0] : -1, out_size, ws_size, (size_t)WS_END); grid = -1; return; }
        int dev = 0, cus = 0, per_cu = 0;
        if (hipGetDevice(&dev) != hipSuccess || hipDeviceGetAttribute(&cus, hipDeviceAttributeMultiprocessorCount, dev) != hipSuccess) { grid = -1; return; }
        if (hipFuncSetAttribute((const void*)mk_fwd, hipFuncAttributeMaxDynamicSharedMemorySize, LDS_BYTES) != hipSuccess) { fprintf(stderr, "kernel_launch: hipFuncSetAttribute failed\n"); grid = -1; return; }
        if (hipOccupancyMaxActiveBlocksPerMultiprocessor(&per_cu, (const void*)mk_fwd, NWAVES * 64, LDS_BYTES) != hipSuccess || per_cu < 1)
            fprintf(stderr, "kernel_launch: note: occupancy query reports %d workgroups per CU\n", per_cu);
        (void)hipGetLastError();
        grid = cus;
    }
    if (grid < 0) return;
    if (hipMemsetAsync((char*)d_ws + WS_CTL, 0, CTL_ZERO_BYTES, stream) != hipSuccess) { fprintf(stderr, "kernel_launch: memset failed\n"); return; }
    Args a{};
    for (int i = 0; i < 17; ++i) a.in[i] = (const float*)d_in[i];
    a.out = (float*)d_out; a.ws = (unsigned char*)d_ws;
    hipLaunchKernelGGL(mk_fwd, dim3(grid), dim3(NWAVES * 64), LDS_BYTES, stream, a);
    const hipError_t le = hipPeekAtLastError();
    if (le != hipSuccess) fprintf(stderr, "kernel_launch: launch failed: %s\n", hipGetErrorName(le));
}
```
